# Optimizing an MI355X kernel written in HIP

```python
import jax, jax.numpy as jnp
from jax import lax
import numpy as np

D_MODEL = 1024
BATCH = 8
SEQ = 4096
DEPTH = 2

CHUNK = 64
MIX_W = D_MODEL
N_BRANCH = 3
RWKV_HEAD = 64
RWKV_HEADS = MIX_W // RWKV_HEAD
R_W = 64
R_A = 64
R_V = 32
SGU_BLOCK = 128
SGU_GROUPS = 8
SGU_GW = MIX_W // SGU_GROUPS
HGRN_HEAD = 128
HGRN_HEADS = MIX_W // HGRN_HEAD
EPS = 1e-6
GN_EPS = 64e-5
SPLIT_A = (MIX_W, MIX_W, MIX_W, R_W, R_A)
N_SHIFT = sum(SPLIT_A)
SPLIT_REST = (MIX_W,) * 8 + (N_BRANCH * D_MODEL,)
N_IN = N_SHIFT + sum(SPLIT_REST)

kernel_name = "hybrid_rwkv7_gmlp_hgrn2_encoder"


def _split(h, sizes):
    return jnp.split(h, np.cumsum(sizes)[:-1].tolist(), axis=-1)


def _rmsnorm(x, g):
    xf = x.astype(jnp.float32)
    y = xf * lax.rsqrt(jnp.mean(xf * xf, axis=-1, keepdims=True) + EPS)
    return (y * g.astype(jnp.float32)).astype(x.dtype)


def _token_shift(y):
    return jnp.pad(y[:, :-1], ((0, 0), (1, 0), (0, 0)))


def _rwkv7_scan(r, w, k, v, a, b):
    Bn, S, H, N = r.shape

    def step(state, inp):
        r_t, w_t, k_t, v_t, a_t, b_t = inp
        sa = jnp.einsum('bhij,bhj->bhi', state, a_t)
        state = (state * w_t[:, :, None, :]
                 + sa[..., None] * b_t[:, :, None, :]
                 + v_t[..., None] * k_t[:, :, None, :])
        y_t = jnp.einsum('bhij,bhj->bhi', state, r_t)
        return state, y_t

    s0 = jnp.zeros((Bn, H, N, N), jnp.float32)
    xs = tuple(jnp.moveaxis(z, 1, 0) for z in (r, w, k, v, a, b))
    _, y = lax.scan(step, s0, xs)
    return jnp.moveaxis(y, 0, 1)


def _rwkv7_branch(hA, zA, xn, v_first, mu, w0, w_w2, a0, a_w2, vres,
                  k_k, k_a, r_k, lnx_g, lnx_b):
    Bn, S, _ = hA.shape
    f32 = jnp.float32
    hA = hA + mu * (_token_shift(hA) - hA)
    r, k, v, wlat, alat = _split(hA, SPLIT_A)
    w_log = -jax.nn.softplus(-(w0 + jnp.tanh(wlat) @ w_w2)) - 0.5
    decay = jnp.exp(-jnp.exp(w_log.astype(f32)))
    a = jax.nn.sigmoid(a0 + alat @ a_w2)
    if vres is None:
        v_first = v
    else:
        v0, v_w1, v_w2 = vres
        v = v + (v_first - v) * jax.nn.sigmoid(v0 + (xn @ v_w1) @ v_w2)
    heads = lambda z: z.reshape(Bn, S, RWKV_HEADS, RWKV_HEAD).astype(f32)
    kk = heads(k * k_k)
    kk = kk / jnp.maximum(jnp.sqrt(jnp.sum(kk * kk, axis=-1, keepdims=True)), 1e-12)
    k = k * (1.0 + (a - 1.0) * k_a)
    rh, kh, vh = heads(r), heads(k), heads(v)
    y = _rwkv7_scan(rh, heads(decay), kh, vh, -kk, kk * heads(a))
    mean = jnp.mean(y, axis=-1, keepdims=True)
    var = jnp.var(y, axis=-1, keepdims=True)
    y = ((y - mean) * lax.rsqrt(var + GN_EPS)).reshape(Bn, S, MIX_W) * lnx_g + lnx_b
    r_k_h = r_k.reshape(RWKV_HEADS, RWKV_HEAD).astype(f32)
    bonus = jnp.sum(rh * kh * r_k_h, axis=-1, keepdims=True) * vh
    o = (y + bonus.reshape(Bn, S, MIX_W)).astype(zA.dtype) * jax.nn.silu(zA)
    return o, v_first


def _sgu_branch(uB, vB, zB, ln_g, ln_b, w_s, b_s):
    Bn, S, _ = vB.shape
    vf = vB.astype(jnp.float32)
    mean = jnp.mean(vf, axis=-1, keepdims=True)
    var = jnp.var(vf, axis=-1, keepdims=True)
    vn = ((vf - mean) * lax.rsqrt(var + EPS) * ln_g + ln_b).astype(vB.dtype)
    pos = jnp.arange(SGU_BLOCK)
    mask = (pos[:, None] // CHUNK) >= (pos[None, :] // CHUNK)
    ws = jnp.where(mask[None], w_s, 0.0)
    vb = vn.reshape(Bn, S // SGU_BLOCK, SGU_BLOCK, SGU_GROUPS, SGU_GW)
    mixed = jnp.einsum('gts,bnsgc->bntgc', ws, vb) + b_s.T[None, None, :, :, None]
    return uB * mixed.reshape(Bn, S, MIX_W) * jax.nn.silu(zB)


def _hgrn2_branch(qC, fC, iC, zC, lb, g_norm):
    Bn, S, _ = qC.shape
    f32 = jnp.float32
    NC = S // CHUNK
    q = jax.nn.silu(qC.astype(f32))
    fg = lb + (1.0 - lb) * jax.nn.sigmoid(fC.astype(f32))
    log_f = jnp.log(fg)
    k = 1.0 - fg
    i = iC.astype(f32)

    def chunks(z):
        return z.reshape(Bn, NC, CHUNK, HGRN_HEADS, HGRN_HEAD).transpose(1, 0, 3, 2, 4)

    q_c, k_c, i_c = chunks(q), chunks(k), chunks(i)
    b_c = jnp.cumsum(chunks(log_f), axis=3)
    causal = jnp.tril(jnp.ones((CHUNK, CHUNK), bool))

    def step(state, inp):
        q_t, k_t, i_t, b_t = inp
        rel = b_t[:, :, :, None, :] - b_t[:, :, None, :, :]
        dec = jnp.exp(jnp.where(causal[:, :, None], rel, -jnp.inf))
        att = jnp.einsum('bhtk,bhsk,bhtsk->bhts', q_t, k_t, dec)
        o = (jnp.einsum('bhts,bhsv->bhtv', att, i_t)
             + jnp.einsum('bhtk,bhkv->bhtv', q_t * jnp.exp(b_t), state))
        b_last = b_t[:, :, -1:, :]
        state = (jnp.exp(b_last[:, :, 0, :, None]) * state
                 + jnp.einsum('bhsk,bhsv->bhkv', k_t * jnp.exp(b_last - b_t), i_t))
        return state, o

    s0 = jnp.zeros((Bn, HGRN_HEADS, HGRN_HEAD, HGRN_HEAD), f32)
    _, o = lax.scan(step, s0, (q_c, k_c, i_c, b_c))
    o = o.transpose(1, 0, 3, 2, 4).reshape(Bn, S, HGRN_HEADS, HGRN_HEAD)
    o = o * lax.rsqrt(jnp.mean(o * o, axis=-1, keepdims=True) + EPS)
    o = o.reshape(Bn, S, MIX_W) * g_norm
    return o.astype(zC.dtype) * jax.nn.silu(zC)


def setup_inputs(seed: int = 0) -> dict:
    key = jax.random.key(seed)
    ks = jax.random.split(key, 26)
    f32 = jnp.float32
    nrm = lambda k, shape, s: s * jax.random.normal(k, shape, f32)
    L = DEPTH
    LV = max(DEPTH - 1, 0)
    return {
        "x": nrm(ks[0], (BATCH, SEQ, D_MODEL), 1.0),
        "norm_g": 1.0 + nrm(ks[1], (L, D_MODEL), 0.02),
        "w_in": nrm(ks[2], (L, D_MODEL, N_IN), D_MODEL ** -0.5),
        "b_merge": nrm(ks[3], (L, N_BRANCH, D_MODEL), 0.02),
        "mu_shift": jax.random.uniform(ks[4], (L, N_SHIFT), f32),
        "w0": -1.0 + nrm(ks[5], (L, MIX_W), 0.5),
        "w_w2": nrm(ks[6], (L, R_W, MIX_W), 0.1),
        "a0": nrm(ks[7], (L, MIX_W), 0.1),
        "a_w2": nrm(ks[8], (L, R_A, MIX_W), 0.1),
        "v0": 1.0 + nrm(ks[9], (LV, MIX_W), 0.1),
        "v_w1": nrm(ks[10], (LV, D_MODEL, R_V), D_MODEL ** -0.5),
        "v_w2": nrm(ks[11], (LV, R_V, MIX_W), 0.1),
        "k_k": 0.85 + nrm(ks[12], (L, MIX_W), 0.02),
        "k_a": 1.0 + nrm(ks[13], (L, MIX_W), 0.02),
        "r_k": nrm(ks[14], (L, MIX_W), 0.1),
        "lnx_g": 1.0 + nrm(ks[15], (L, MIX_W), 0.02),
        "lnx_b": nrm(ks[16], (L, MIX_W), 0.02),
        "sgu_ln_g": 1.0 + nrm(ks[17], (L, MIX_W), 0.02),
        "sgu_ln_b": nrm(ks[18], (L, MIX_W), 0.02),
        "sgu_w": nrm(ks[19], (L, SGU_GROUPS, SGU_BLOCK, SGU_BLOCK), 0.5 * SGU_BLOCK ** -0.5),
        "sgu_b": 1.0 + nrm(ks[20], (L, SGU_GROUPS, SGU_BLOCK), 0.02),
        "lb_logits": nrm(ks[21], (L, MIX_W), 0.1),
        "hgrn_g": 1.0 + nrm(ks[22], (L, MIX_W), 0.02),
        "w_branch": nrm(ks[23], (L, N_BRANCH, MIX_W, D_MODEL), MIX_W ** -0.5),
        "w_out": nrm(ks[24], (L, D_MODEL, D_MODEL), D_MODEL ** -0.5),
        "final_g": 1.0 + nrm(ks[25], (D_MODEL,), 0.02),
    }


def reference(x, norm_g, w_in, b_merge, mu_shift, w0, w_w2, a0, a_w2, v0, v_w1, v_w2,
              k_k, k_a, r_k, lnx_g, lnx_b, sgu_ln_g, sgu_ln_b, sgu_w, sgu_b,
              lb_logits, hgrn_g, w_branch, w_out, final_g):
    Bn, S, _ = x.shape
    lb_all = jnp.cumsum(jax.nn.softmax(lb_logits.astype(jnp.float32), axis=0), axis=0)
    lb_all = lb_all - lb_all[0]
    v_first = None
    for l in range(DEPTH):
        xn = _rmsnorm(x, norm_g[l])
        h = xn @ w_in[l]
        hA, hR = jnp.split(h, [N_SHIFT], axis=-1)
        zA, uB, vB, zB, qC, fC, iC, zC, gl = _split(hR, SPLIT_REST)
        vres = None if l == 0 else (v0[l - 1], v_w1[l - 1], v_w2[l - 1])
        oA, v_first = _rwkv7_branch(hA, zA, xn, v_first, mu_shift[l], w0[l], w_w2[l],
                                    a0[l], a_w2[l], vres, k_k[l], k_a[l], r_k[l],
                                    lnx_g[l], lnx_b[l])
        oB = _sgu_branch(uB, vB, zB, sgu_ln_g[l], sgu_ln_b[l], sgu_w[l], sgu_b[l])
        oC = _hgrn2_branch(qC, fC, iC, zC, lb_all[l], hgrn_g[l])
        branches = jnp.stack([oA, oB, oC], axis=2)
        proj = jnp.einsum('bsnw,nwd->bsnd', branches, w_branch[l])
        gates = jax.nn.sigmoid(gl.reshape(Bn, S, N_BRANCH, D_MODEL) + b_merge[l])
        y = jnp.sum(gates * proj, axis=2)
        x = x + y @ w_out[l]
    return _rmsnorm(x, final_g)
```

```cpp
#include <hip/hip_runtime.h>
#include <hip/hip_cooperative_groups.h>
#include <cstdio>
namespace cg = cooperative_groups;

#ifndef SINGLE_LAUNCH
#define SINGLE_LAUNCH 1
#endif

typedef unsigned short bf16_t;
typedef short bf16x8 __attribute__((ext_vector_type(8)));
typedef float f32x4 __attribute__((ext_vector_type(4)));
typedef float f32x2 __attribute__((ext_vector_type(2)));
typedef unsigned u32x4 __attribute__((ext_vector_type(4)));
typedef unsigned u32x2 __attribute__((ext_vector_type(2)));
#define LAS __attribute__((address_space(3)))

constexpr int T_TOK = 32768, DM = 1024, SEQ = 4096, NB = 8;
constexpr int N_IN = 14464;
constexpr int LDA_H = 4352, LDB_H = 3072, LDC_H = 4096;
constexpr int WT_ROWS = 14592;
constexpr int LDS_BYTES = 163840;
constexpr float EPS = 1e-6f, GN_EPS = 64e-5f;

struct Params {
    const float *x, *norm_g, *w_in, *b_merge, *mu, *w0, *w_w2, *a0, *a_w2, *v0, *v_w1, *v_w2, *k_k, *k_a, *r_k, *lnx_g, *lnx_b,
        *sgu_ln_g, *sgu_ln_b, *sgu_w, *sgu_b, *lb_logits, *hgrn_g, *w_branch, *w_out, *final_g;
    float* out;
    bf16_t *Wt, *xn, *vf, *y, *H;
    int phase_lo, phase_hi;
};

__device__ __forceinline__ float bf2f(bf16_t h) { return __uint_as_float(((unsigned)h) << 16); }
__device__ __forceinline__ float bflo(unsigned u) { return __uint_as_float(u << 16); }
__device__ __forceinline__ float bfhi(unsigned u) { return __uint_as_float(u & 0xffff0000u); }
__device__ __forceinline__ unsigned cvt_pk_bf16(float lo, float hi) { unsigned r; asm volatile("v_cvt_pk_bf16_f32 %0, %1, %2" : "=v"(r) : "v"(lo), "v"(hi)); return r; }
__device__ __forceinline__ bf16_t f2bf(float f) { return (bf16_t)(cvt_pk_bf16(f, 0.f) & 0xffffu); }
__device__ __forceinline__ float sigmoidf_(float x) { return 1.0f / (1.0f + __expf(-x)); }
__device__ __forceinline__ float siluf_(float x) { return x / (1.0f + __expf(-x)); }

__device__ __forceinline__ Params load_params() {
#if defined(__HIP_DEVICE_COMPILE__)
    typedef const Params __attribute__((address_space(4)))* KP;
    KP kp = (KP)__builtin_amdgcn_kernarg_segment_ptr(); asm volatile("" : "+s"(kp)); return *kp;
#else
    return Params{};
#endif
}
__device__ __forceinline__ int opaque_tid() { int t = threadIdx.x; asm volatile("" : "+v"(t)); return t; }
__device__ __forceinline__ int opaque_bid() { int t = blockIdx.x; asm volatile("" : "+s"(t)); return t; }

namespace pg8 {
constexpr int BM = 256, BK = 64, HALF = 128, HTB = HALF * BK * 2, STAGE_BYTES = 8 * HTB, NXCD = 8, WGM = 8, KD = 1024;
__device__ __forceinline__ int lds_byte(int r, int c) { const int st = (r >> 4) * 2 + (c >> 5), rr = r & 15, cc = c & 31, ob = rr * 64 + cc * 2; return st * 1024 + (ob ^ (((ob >> 9) & 1) << 5)); }
__device__ __forceinline__ void stage_rc(int b, int& R, int& C) { const int st = b / 1024, sb = b % 1024, swz = sb ^ (((sb >> 9) & 1) << 5); R = (st >> 1) * 16 + swz / 64; C = (st & 1) * 32 + (swz % 64) / 2; }
__device__ __forceinline__ int perm32(int rho) { const int n = rho >> 4, i = rho & 15; return 8 * (i >> 2) + 4 * n + (i & 3); }

struct Unit { int pm, pn, sel; };
struct GemmDesc { const bf16_t* A; const bf16_t* Bt; int lda; };
struct Sched {
    int nM, nN, nwg, G, c, nsel;
    __device__ void init(int M, int N, int G_, int c_, int nsel_) { nM = M / BM; nN = N / BM; nwg = nM * nN; G = G_; c = c_; nsel = nsel_; }
    __device__ bool next(int i, Unit& u) const {
        const int ti = (nsel == 2) ? (i >> 1) : i; u.sel = (nsel == 2) ? (i & 1) : 0;
        const long L = (long)ti * G + c; if (L >= nwg) return false;
        int wgid = (int)L; { const int q = nwg / NXCD, r = nwg % NXCD, xcd = wgid % NXCD, off = wgid / NXCD; wgid = (xcd < r ? xcd * (q + 1) : r * (q + 1) + (xcd - r) * q) + off; }
        const int nig = WGM * nN, gid = wgid / nig, fm = gid * WGM, gsz = (nM - fm) < WGM ? (nM - fm) : WGM;
        u.pm = fm + ((wgid % nig) % gsz); u.pn = (wgid % nig) / gsz; return true;
    }
};

template <class Epi>
__device__ __forceinline__ void gemm_phase(LAS unsigned char* lds, const GemmDesc g0, const GemmDesc g1, const Sched& S, const Epi& E) {
    const int tid = opaque_tid(), wid = __builtin_amdgcn_readfirstlane(tid >> 6), lane = tid & 63, wr = wid >> 2, wc = wid & 3, fr = lane & 15, fq = lane >> 4;
    constexpr int K = KD, nt = K / BK;
    unsigned voffA0[2], voffA1[2], voffB[2];
#pragma unroll
    for (int i = 0; i < 2; ++i) { int R, C; stage_rc(tid * 16 + i * 8192, R, C); const int Rb = Epi::PERM ? ((R & ~31) + perm32(R & 31)) : R;
        voffA0[i] = (unsigned)(R * g0.lda + C) * 2u; voffA1[i] = (unsigned)(R * g1.lda + C) * 2u; voffB[i] = (unsigned)(Rb * K + C) * 2u; }
    const size_t kstep = (size_t)(BK * 2);
    const size_t hstepB = (size_t)HALF * K * 2;
    const unsigned ldsw = (unsigned)wid * 1024u;
    const int aoff = lds_byte(wr * 64 + fr, fq * 8), boff = lds_byte(wc * 32 + fr, fq * 8);
#define PG8_SA(b, h) (((b) * 2 + (h)) * HTB)
#define PG8_SB(b, h) ((4 + (b) * 2 + (h)) * HTB)
#define PG8_STAGE(bufoff, gbase, v0, v1) do { \
        __builtin_amdgcn_global_load_lds((const unsigned*)((const char*)(gbase) + (v0)), (LAS unsigned*)(lds + (bufoff) + ldsw), 16, 0, 0); \
        __builtin_amdgcn_global_load_lds((const unsigned*)((const char*)(gbase) + (v1)), (LAS unsigned*)(lds + (bufoff) + ldsw + 8192), 16, 0, 0); } while (0)
#define PG8_STAGEB(bufoff, gbase) PG8_STAGE(bufoff, gbase, voffB[0], voffB[1])
#define PG8_LDA(dst, b, h) do { _Pragma("unroll") for (int m = 0; m < 4; ++m) _Pragma("unroll") for (int k = 0; k < 2; ++k) dst[m][k] = *(const LAS bf16x8*)(lds + PG8_SA(b, h) + aoff + m * 2048 + k * 1024); } while (0)
#define PG8_LDB(dst, b, h) do { _Pragma("unroll") for (int n = 0; n < 2; ++n) _Pragma("unroll") for (int k = 0; k < 2; ++k) dst[n][k] = *(const LAS bf16x8*)(lds + PG8_SB(b, h) + boff + n * 2048 + k * 1024); } while (0)
#define PG8_MMA(ai, bj, At, Bt) do { __builtin_amdgcn_s_setprio(1); _Pragma("unroll") for (int m = 0; m < 4; ++m) _Pragma("unroll") for (int n = 0; n < 2; ++n) _Pragma("unroll") for (int k = 0; k < 2; ++k) \
        acc[ai][bj][m][n] = __builtin_amdgcn_mfma_f32_16x16x32_bf16(Bt[n][k], At[m][k], acc[ai][bj][m][n], 0, 0, 0); __builtin_amdgcn_s_setprio(0); } while (0)
#define PG8_WAIT_V(n) asm volatile("s_waitcnt vmcnt(" #n ")" ::: "memory")
#define PG8_WAIT_L(n) asm volatile("s_waitcnt lgkmcnt(" #n ")" ::: "memory")
#define PG8_BAR __builtin_amdgcn_s_barrier()
#define PG8_SCHED __builtin_amdgcn_sched_barrier(0)
    Unit cur, nxt; int ui = 0;
    if (!S.next(0, cur)) return;
    f32x4 acc[2][2][4][2];
#pragma unroll
    for (int a = 0; a < 2; ++a)
#pragma unroll
        for (int b = 0; b < 2; ++b)
#pragma unroll
            for (int m = 0; m < 4; ++m)
#pragma unroll
                for (int n = 0; n < 2; ++n) acc[a][b][m][n] = (f32x4){0.f, 0.f, 0.f, 0.f};
    bf16x8 At[4][2], B0[2][2], B1[2][2];
    const char* cA = (const char*)(cur.sel ? g1.A : g0.A) + (size_t)cur.pm * 256 * (size_t)(cur.sel ? g1.lda : g0.lda) * 2;
    const char* cB = (const char*)(cur.sel ? g1.Bt : g0.Bt) + (size_t)cur.pn * 256 * K * 2;
    size_t chA = (size_t)HALF * (cur.sel ? g1.lda : g0.lda) * 2;
    unsigned cv0 = cur.sel ? voffA1[0] : voffA0[0], cv1 = cur.sel ? voffA1[1] : voffA0[1];
    PG8_STAGEB(PG8_SB(0, 0), cB); PG8_STAGE(PG8_SA(0, 0), cA, cv0, cv1); PG8_STAGEB(PG8_SB(0, 1), cB + hstepB); PG8_STAGE(PG8_SA(0, 1), cA + chA, cv0, cv1);
    if (wr == 1) PG8_BAR;
    PG8_WAIT_V(4); PG8_BAR;
    PG8_STAGEB(PG8_SB(1, 0), cB + kstep); PG8_STAGE(PG8_SA(1, 0), cA + kstep, cv0, cv1); PG8_STAGEB(PG8_SB(1, 1), cB + hstepB + kstep);
    PG8_WAIT_V(6); PG8_BAR;
    for (;;) {
        const bool has_next = S.next(ui + 1, nxt);
        const int nsel = has_next ? nxt.sel : cur.sel;
        const char* nA = has_next ? (const char*)(nsel ? g1.A : g0.A) + (size_t)nxt.pm * 256 * (size_t)(nsel ? g1.lda : g0.lda) * 2 : cA;
        const char* nB = has_next ? (const char*)(nsel ? g1.Bt : g0.Bt) + (size_t)nxt.pn * 256 * K * 2 : cB;
        const size_t nhA = (size_t)HALF * (nsel ? g1.lda : g0.lda) * 2;
        const unsigned nv0 = nsel ? voffA1[0] : voffA0[0], nv1 = nsel ? voffA1[1] : voffA0[1];
        for (int t = 0; t < nt; t += 2) {
            const bool last = (t == nt - 2);
            const char* a1 = cA + (size_t)(t + 1) * kstep;
            const char* a2 = last ? nA : cA + (size_t)(t + 2) * kstep; const char* b2 = last ? nB : cB + (size_t)(t + 2) * kstep;
            const char* a3 = a2 + kstep; const char* b3 = b2 + kstep;
            const size_t h2 = last ? nhA : chA; const unsigned w0 = last ? nv0 : cv0, w1 = last ? nv1 : cv1;
            PG8_LDB(B0, 0, 0); PG8_SCHED; PG8_LDA(At, 0, 0); PG8_STAGE(PG8_SA(1, 1), a1 + chA, cv0, cv1);
            PG8_WAIT_L(8); PG8_BAR; PG8_WAIT_L(0); PG8_MMA(0, 0, At, B0); PG8_BAR; PG8_SCHED;
            PG8_LDB(B1, 0, 1); PG8_STAGEB(PG8_SB(0, 0), b2);
            PG8_BAR; PG8_WAIT_L(0); PG8_MMA(0, 1, At, B1); PG8_BAR;
            PG8_LDA(At, 0, 1); PG8_STAGE(PG8_SA(0, 0), a2, w0, w1);
            PG8_BAR; PG8_WAIT_L(0); PG8_MMA(1, 0, At, B0); PG8_BAR; PG8_SCHED;
            PG8_STAGEB(PG8_SB(0, 1), b2 + hstepB);
            PG8_WAIT_V(6); PG8_BAR; PG8_MMA(1, 1, At, B1); PG8_BAR;
            PG8_LDB(B0, 1, 0); PG8_SCHED; PG8_LDA(At, 1, 0); PG8_STAGE(PG8_SA(0, 1), a2 + h2, w0, w1);
            PG8_WAIT_L(8); PG8_BAR; PG8_WAIT_L(0); PG8_MMA(0, 0, At, B0); PG8_BAR; PG8_SCHED;
            PG8_LDB(B1, 1, 1); PG8_STAGEB(PG8_SB(1, 0), b3);
            PG8_BAR; PG8_WAIT_L(0); PG8_MMA(0, 1, At, B1); PG8_BAR;
            PG8_LDA(At, 1, 1); PG8_STAGE(PG8_SA(1, 0), a3, w0, w1);
            PG8_BAR; PG8_WAIT_L(0); PG8_MMA(1, 0, At, B0); PG8_BAR; PG8_SCHED;
            PG8_STAGEB(PG8_SB(1, 1), b3 + hstepB);
            PG8_WAIT_V(6); PG8_BAR; PG8_MMA(1, 1, At, B1); PG8_BAR;
        }
        E(acc, cur, wr, wc, fr, fq);
        if (!has_next) break;
#pragma unroll
        for (int a = 0; a < 2; ++a)
#pragma unroll
            for (int b = 0; b < 2; ++b)
#pragma unroll
                for (int m = 0; m < 4; ++m)
#pragma unroll
                    for (int n = 0; n < 2; ++n) acc[a][b][m][n] = (f32x4){0.f, 0.f, 0.f, 0.f};
        cur = nxt; cA = nA; cB = nB; chA = nhA; cv0 = nv0; cv1 = nv1; ++ui;
    }
    PG8_WAIT_V(0);
    if (wr == 0) PG8_BAR;
    PG8_BAR;
#undef PG8_SA
#undef PG8_SB
#undef PG8_STAGE
#undef PG8_STAGEB
#undef PG8_LDA
#undef PG8_LDB
#undef PG8_MMA
#undef PG8_WAIT_V
#undef PG8_WAIT_L
#undef PG8_BAR
#undef PG8_SCHED
}

struct EpiStore {
    static constexpr bool PERM = true;
    bf16_t* O; int ldc;
    __device__ __forceinline__ void operator()(const f32x4 (&acc)[2][2][4][2], const Unit& u, int wr, int wc, int fr, int fq) const {
        const int row0 = u.pm * BM + wr * 64 + fr, col0 = u.pn * BM + wc * 32 + 8 * fq;
#pragma unroll
        for (int ai = 0; ai < 2; ++ai)
#pragma unroll
            for (int m = 0; m < 4; ++m) { bf16_t* rowp = O + (size_t)(row0 + ai * HALF + m * 16) * ldc + col0;
#pragma unroll
                for (int bj = 0; bj < 2; ++bj) { const f32x4 v0 = acc[ai][bj][m][0], v1 = acc[ai][bj][m][1];
                    u32x4 w; w.x = cvt_pk_bf16(v0[0], v0[1]); w.y = cvt_pk_bf16(v0[2], v0[3]); w.z = cvt_pk_bf16(v1[0], v1[1]); w.w = cvt_pk_bf16(v1[2], v1[3]);
                    *(u32x4*)(rowp + bj * HALF) = w; } }
    }
};
struct EpiMerge {
    static constexpr bool PERM = true;
    bf16_t* G; int ldg; const float* bias; bf16_t* Y; int accum;
    __device__ __forceinline__ void operator()(const f32x4 (&acc)[2][2][4][2], const Unit& u, int wr, int wc, int fr, int fq) const {
        const int row0 = u.pm * BM + wr * 64 + fr, col0 = u.pn * BM + wc * 32 + 8 * fq;
        if (u.sel == 0) {
            f32x4 bv[2][2];
#pragma unroll
            for (int bj = 0; bj < 2; ++bj)
#pragma unroll
                for (int n = 0; n < 2; ++n) bv[bj][n] = *(const f32x4*)(bias + col0 + bj * HALF + 4 * n);
#pragma unroll
            for (int ai = 0; ai < 2; ++ai)
#pragma unroll
                for (int m = 0; m < 4; ++m) { bf16_t* rowp = G + (size_t)(row0 + ai * HALF + m * 16) * ldg + col0;
#pragma unroll
                    for (int bj = 0; bj < 2; ++bj) { f32x4 v0 = acc[ai][bj][m][0] + bv[bj][0], v1 = acc[ai][bj][m][1] + bv[bj][1];
#pragma unroll
                        for (int j = 0; j < 4; ++j) { v0[j] = sigmoidf_(v0[j]); v1[j] = sigmoidf_(v1[j]); }
                        u32x4 w; w.x = cvt_pk_bf16(v0[0], v0[1]); w.y = cvt_pk_bf16(v0[2], v0[3]); w.z = cvt_pk_bf16(v1[0], v1[1]); w.w = cvt_pk_bf16(v1[2], v1[3]);
                        *(u32x4*)(rowp + bj * HALF) = w; } }
        } else {
#pragma unroll
            for (int ai = 0; ai < 2; ++ai)
#pragma unroll
                for (int m = 0; m < 4; ++m) { const size_t r = (size_t)(row0 + ai * HALF + m * 16);
                    const unsigned long long* gp = (const unsigned long long*)(G + r * ldg + col0); bf16_t* yp = Y + r * DM + col0;
#pragma unroll
                    for (int bj = 0; bj < 2; ++bj) {
                        const unsigned long long g0 = __hip_atomic_load(gp + bj * (HALF / 4), __ATOMIC_RELAXED, __HIP_MEMORY_SCOPE_AGENT);
                        const unsigned long long g1 = __hip_atomic_load(gp + bj * (HALF / 4) + 1, __ATOMIC_RELAXED, __HIP_MEMORY_SCOPE_AGENT);
                        const unsigned gw[4] = {(unsigned)g0, (unsigned)(g0 >> 32), (unsigned)g1, (unsigned)(g1 >> 32)};
                        u32x4 yo = {0u, 0u, 0u, 0u}; if (accum) yo = *(const u32x4*)(yp + bj * HALF);
                        const f32x4 v0 = acc[ai][bj][m][0], v1 = acc[ai][bj][m][1];
                        u32x4 w;
                        w.x = cvt_pk_bf16(bflo(yo.x) + bflo(gw[0]) * v0[0], bfhi(yo.x) + bfhi(gw[0]) * v0[1]);
                        w.y = cvt_pk_bf16(bflo(yo.y) + bflo(gw[1]) * v0[2], bfhi(yo.y) + bfhi(gw[1]) * v0[3]);
                        w.z = cvt_pk_bf16(bflo(yo.z) + bflo(gw[2]) * v1[0], bfhi(yo.z) + bfhi(gw[2]) * v1[1]);
                        w.w = cvt_pk_bf16(bflo(yo.w) + bflo(gw[3]) * v1[2], bfhi(yo.w) + bfhi(gw[3]) * v1[3]);
                        *(u32x4*)(yp + bj * HALF) = w; } }
        }
    }
};
struct EpiResid {
    static constexpr bool PERM = false;
    const float* Xin; float* Xout;
    __device__ __forceinline__ void operator()(const f32x4 (&acc)[2][2][4][2], const Unit& u, int wr, int wc, int fr, int fq) const {
        const int row0 = u.pm * BM + wr * 64 + fr, col0 = u.pn * BM + wc * 32 + 4 * fq;
#pragma unroll
        for (int ai = 0; ai < 2; ++ai)
#pragma unroll
            for (int m = 0; m < 4; ++m) { const size_t ro = (size_t)(row0 + ai * HALF + m * 16) * DM + col0;
#pragma unroll
                for (int bj = 0; bj < 2; ++bj)
#pragma unroll
                    for (int n = 0; n < 2; ++n) { const f32x4 xi = *(const f32x4*)(Xin + ro + bj * HALF + n * 16); *(f32x4*)(Xout + ro + bj * HALF + n * 16) = xi + acc[ai][bj][m][n]; } }
    }
};
}

__device__ void phase_convert(int l, unsigned char* smem) {
    const Params p = load_params();
    float* tile = (float*)smem;
    const int tid = opaque_tid();
    const float* win = p.w_in + (size_t)l * DM * N_IN;
    bf16_t* WtIn = p.Wt; bf16_t* WtBr = p.Wt + (size_t)WT_ROWS * DM; bf16_t* WtOut = WtBr + (size_t)3 * DM * DM;
    const int NT_IN = WT_ROWS / 64;
    const int total = (NT_IN + 48 + 16) * 16;
    for (int it = blockIdx.x; it < total; it += gridDim.x) {
        const int ntile = it >> 4, kt = it & 15, k0 = kt * 64;
        const float* src = nullptr; int ld = 0, c0 = 0, valid = 64; bf16_t* dst;
        if (ntile < NT_IN) {
            const int n0 = ntile * 64; dst = WtIn + (size_t)n0 * DM;
            if (n0 < 4224) { src = win; ld = N_IN; c0 = n0; }
            else if (n0 < 4352) { if (n0 == 4224 && l > 0) { src = p.v_w1 + (size_t)(l - 1) * DM * 32; ld = 32; c0 = 0; valid = 32; } else { valid = 0; } }
            else { src = win; ld = N_IN; c0 = n0 - 128; }
        } else if (ntile < NT_IN + 48) {
            const int q = ntile - NT_IN, n = q >> 4, n0 = (q & 15) * 64;
            src = p.w_branch + ((size_t)l * 3 + n) * DM * DM; ld = DM; c0 = n0; dst = WtBr + ((size_t)n * DM + n0) * DM;
        } else {
            const int n0 = (ntile - NT_IN - 48) * 64; src = p.w_out + (size_t)l * DM * DM; ld = DM; c0 = n0; dst = WtOut + (size_t)n0 * DM;
        }
        __syncthreads();
        if (valid == 64) {
            const int kr = tid >> 4, nc = (tid & 15) * 4;
#pragma unroll
            for (int ps = 0; ps < 2; ++ps) { const int k = kr + ps * 32; const f32x4 v = *(const f32x4*)(src + (size_t)(k0 + k) * ld + c0 + nc);
                tile[k * 65 + nc] = v[0]; tile[k * 65 + nc + 1] = v[1]; tile[k * 65 + nc + 2] = v[2]; tile[k * 65 + nc + 3] = v[3]; }
        } else {
            for (int e = tid; e < 4096; e += 512) { const int k = e >> 6, n = e & 63; tile[k * 65 + n] = (n < valid) ? src[(size_t)(k0 + k) * ld + c0 + n] : 0.f; }
        }
        __syncthreads();
        { const int nr = tid >> 3, kc = (tid & 7) * 8; u32x4 w;
          w.x = cvt_pk_bf16(tile[(kc + 0) * 65 + nr], tile[(kc + 1) * 65 + nr]); w.y = cvt_pk_bf16(tile[(kc + 2) * 65 + nr], tile[(kc + 3) * 65 + nr]);
          w.z = cvt_pk_bf16(tile[(kc + 4) * 65 + nr], tile[(kc + 5) * 65 + nr]); w.w = cvt_pk_bf16(tile[(kc + 6) * 65 + nr], tile[(kc + 7) * 65 + nr]);
          *(u32x4*)(dst + (size_t)nr * DM + k0 + kc) = w; }
    }
    __syncthreads();
}

__device__ void phase_rmsnorm(const float* x, const float* g, bf16_t* xn, float* outf) {
    const int tid_ = opaque_tid(); const int lane = tid_ & 63, wv = tid_ >> 6;
    f32x4 gv[4];
#pragma unroll
    for (int q = 0; q < 4; ++q) gv[q] = *(const f32x4*)(g + q * 256 + lane * 4);
    for (int row = blockIdx.x * 8 + wv; row < T_TOK; row += gridDim.x * 8) {
        const float* xr = x + (size_t)row * DM; f32x4 v[4]; float ss = 0.f;
#pragma unroll
        for (int q = 0; q < 4; ++q) { v[q] = *(const f32x4*)(xr + q * 256 + lane * 4); ss += v[q][0] * v[q][0] + v[q][1] * v[q][1] + v[q][2] * v[q][2] + v[q][3] * v[q][3]; }
#pragma unroll
        for (int o = 32; o > 0; o >>= 1) ss += __shfl_xor(ss, o);
        const float rinv = rsqrtf(ss * (1.0f / DM) + EPS);
#pragma unroll
        for (int q = 0; q < 4; ++q) { const f32x4 o = v[q] * rinv * gv[q];
            if (xn) { u32x2 w; w.x = cvt_pk_bf16(o[0], o[1]); w.y = cvt_pk_bf16(o[2], o[3]); *(u32x2*)(xn + (size_t)row * DM + q * 256 + lane * 4) = w; }
            else *(f32x4*)(outf + (size_t)row * DM + q * 256 + lane * 4) = o; }
    }
}

template <int CTRL> __device__ __forceinline__ float dpp_f(float v) { return __int_as_float(__builtin_amdgcn_update_dpp(0, __float_as_int(v), CTRL, 0xf, 0xf, false)); }
__device__ __forceinline__ float red8(float v) { v += dpp_f<0xB1>(v); v += dpp_f<0x4E>(v); v += dpp_f<0x141>(v); return v; }
__device__ __forceinline__ float red16(float v) { v = red8(v); v += dpp_f<0x140>(v); return v; }

__device__ void phase_rwkv(int l, unsigned char* smem) {
    const Params p = load_params();
    constexpr int TC = 32;
    float* w2s = (float*)smem;
    float* a2s = w2s + 4096;
    float* v2s = a2s + 4096;
    float* sR = v2s + 2048;
    float* sW = sR + TC * 64; float* sK = sW + TC * 64; float* sV = sK + TC * 64; float* sA = sV + TC * 64; float* sB = sA + TC * 64;
    float* sTW = sB + TC * 64; float* sAL = sTW + TC * 64; float* sVL = sAL + TC * 64;
    float* sY = sVL + TC * 32; float* sRK = sY + TC * 64;
    const int tid = opaque_tid();
    const int tt = tid >> 4, l16 = tid & 15, j4 = l16 * 4;
    const int si = tid >> 3, seg = tid & 7;
    for (int item = blockIdx.x; item < NB * 16; item += gridDim.x) {
        const int b = item >> 4, h = item & 15, cb = h * 64 + j4;
        __syncthreads();
        for (int e = tid; e < 4096; e += 512) { const int m = e >> 6, j = e & 63; w2s[e] = p.w_w2[((size_t)l * 64 + m) * DM + h * 64 + j]; a2s[e] = p.a_w2[((size_t)l * 64 + m) * DM + h * 64 + j]; }
        if (l > 0) for (int e = tid; e < 2048; e += 512) { const int m = e >> 6, j = e & 63; v2s[e] = p.v_w2[((size_t)(l - 1) * 32 + m) * DM + h * 64 + j]; }
        float mu_r[4], mu_k[4], mu_v[4], mu_w[4], mu_a[4], cw0[4], ca0[4], cv0[4], ckk[4], cka[4], crk[4], cg[4], cbb[4];
#pragma unroll
        for (int e = 0; e < 4; ++e) { const float* mu = p.mu + (size_t)l * 3200;
            mu_r[e] = mu[cb + e]; mu_k[e] = mu[1024 + cb + e]; mu_v[e] = mu[2048 + cb + e]; mu_w[e] = mu[3072 + j4 + e]; mu_a[e] = mu[3136 + j4 + e];
            cw0[e] = p.w0[l * DM + cb + e]; ca0[e] = p.a0[l * DM + cb + e]; cv0[e] = (l > 0) ? p.v0[(l - 1) * DM + cb + e] : 0.f;
            ckk[e] = p.k_k[l * DM + cb + e]; cka[e] = p.k_a[l * DM + cb + e]; crk[e] = p.r_k[l * DM + cb + e]; cg[e] = p.lnx_g[l * DM + cb + e]; cbb[e] = p.lnx_b[l * DM + cb + e]; }
        float st[8];
#pragma unroll
        for (int j = 0; j < 8; ++j) st[j] = 0.f;
        for (int ch = 0; ch < SEQ / TC; ++ch) {
            const int t = ch * TC + tt; const size_t tok = (size_t)b * SEQ + t;
            bf16_t* cur = p.H + tok * LDA_H; const bf16_t* prev = cur - LDA_H; const bool hasp = (t > 0);
            float r4[4], k4[4], v4[4];
            {
                const u32x2 z2 = {0u, 0u};
                u32x2 cr = *(const u32x2*)(cur + cb), ck = *(const u32x2*)(cur + 1024 + cb), cvv = *(const u32x2*)(cur + 2048 + cb), cwl = *(const u32x2*)(cur + 3072 + j4), cal = *(const u32x2*)(cur + 3136 + j4);
                u32x2 pr = z2, pk = z2, pv = z2, pwl = z2, pal = z2;
                if (hasp) { pr = *(const u32x2*)(prev + cb); pk = *(const u32x2*)(prev + 1024 + cb); pv = *(const u32x2*)(prev + 2048 + cb); pwl = *(const u32x2*)(prev + 3072 + j4); pal = *(const u32x2*)(prev + 3136 + j4); }
                const float fr_[4] = {bflo(cr.x), bfhi(cr.x), bflo(cr.y), bfhi(cr.y)}, fpr[4] = {bflo(pr.x), bfhi(pr.x), bflo(pr.y), bfhi(pr.y)};
                const float fk_[4] = {bflo(ck.x), bfhi(ck.x), bflo(ck.y), bfhi(ck.y)}, fpk[4] = {bflo(pk.x), bfhi(pk.x), bflo(pk.y), bfhi(pk.y)};
                const float fv_[4] = {bflo(cvv.x), bfhi(cvv.x), bflo(cvv.y), bfhi(cvv.y)}, fpv[4] = {bflo(pv.x), bfhi(pv.x), bflo(pv.y), bfhi(pv.y)};
                const float fw_[4] = {bflo(cwl.x), bfhi(cwl.x), bflo(cwl.y), bfhi(cwl.y)}, fpw[4] = {bflo(pwl.x), bfhi(pwl.x), bflo(pwl.y), bfhi(pwl.y)};
                const float fa_[4] = {bflo(cal.x), bfhi(cal.x), bflo(cal.y), bfhi(cal.y)}, fpa[4] = {bflo(pal.x), bfhi(pal.x), bflo(pal.y), bfhi(pal.y)};
#pragma unroll
                for (int e = 0; e < 4; ++e) {
                    r4[e] = fr_[e] + mu_r[e] * (fpr[e] - fr_[e]); k4[e] = fk_[e] + mu_k[e] * (fpk[e] - fk_[e]); v4[e] = fv_[e] + mu_v[e] * (fpv[e] - fv_[e]);
                    const float wl = fw_[e] + mu_w[e] * (fpw[e] - fw_[e]), al = fa_[e] + mu_a[e] * (fpa[e] - fa_[e]);
                    sTW[tt * 64 + j4 + e] = tanhf(wl); sAL[tt * 64 + j4 + e] = al; }
                if (l > 0) { const unsigned vl = *(const unsigned*)(cur + 4224 + l16 * 2); sVL[tt * 32 + l16 * 2] = bflo(vl); sVL[tt * 32 + l16 * 2 + 1] = bfhi(vl); }
            }
            __syncthreads();
            {
                float wp[4], ap[4], vp[4];
#pragma unroll
                for (int e = 0; e < 4; ++e) { wp[e] = cw0[e]; ap[e] = ca0[e]; vp[e] = cv0[e]; }
                for (int m = 0; m < 64; ++m) { const float tw = sTW[tt * 64 + m], al = sAL[tt * 64 + m]; const f32x4 w2 = *(const f32x4*)(w2s + m * 64 + j4), a2 = *(const f32x4*)(a2s + m * 64 + j4);
#pragma unroll
                    for (int e = 0; e < 4; ++e) { wp[e] += tw * w2[e]; ap[e] += al * a2[e]; } }
                if (l > 0) {
                    for (int m = 0; m < 32; ++m) { const float vl = sVL[tt * 32 + m]; const f32x4 v2 = *(const f32x4*)(v2s + m * 64 + j4);
#pragma unroll
                        for (int e = 0; e < 4; ++e) vp[e] += vl * v2[e]; }
                    const u32x2 vf2 = *(const u32x2*)(p.vf + tok * DM + cb); const float vfv[4] = {bflo(vf2.x), bfhi(vf2.x), bflo(vf2.y), bfhi(vf2.y)};
#pragma unroll
                    for (int e = 0; e < 4; ++e) v4[e] = v4[e] + (vfv[e] - v4[e]) * sigmoidf_(vp[e]);
                } else {
                    u32x2 w; w.x = cvt_pk_bf16(v4[0], v4[1]); w.y = cvt_pk_bf16(v4[2], v4[3]); *(u32x2*)(p.vf + tok * DM + cb) = w;
                }
                float kk[4], ar[4], ss = 0.f, rk = 0.f;
#pragma unroll
                for (int e = 0; e < 4; ++e) {
                    const float xw = -wp[e]; const float sp = fmaxf(xw, 0.f) + log1pf(__expf(-fabsf(xw)));
                    const float wlog = -sp - 0.5f; sW[tt * 64 + j4 + e] = __expf(-__expf(wlog));
                    ar[e] = sigmoidf_(ap[e]); kk[e] = k4[e] * ckk[e]; ss += kk[e] * kk[e]; }
                ss = red16(ss); const float inv = 1.0f / fmaxf(sqrtf(ss), 1e-12f);
#pragma unroll
                for (int e = 0; e < 4; ++e) { kk[e] *= inv; const float km = k4[e] * (1.0f + (ar[e] - 1.0f) * cka[e]); rk += r4[e] * km * crk[e];
                    sR[tt * 64 + j4 + e] = r4[e]; sK[tt * 64 + j4 + e] = km; sV[tt * 64 + j4 + e] = v4[e]; sA[tt * 64 + j4 + e] = -kk[e]; sB[tt * 64 + j4 + e] = kk[e] * ar[e]; }
                rk = red16(rk); if (l16 == 0) sRK[tt] = rk;
            }
            __syncthreads();
            for (int s = 0; s < TC; ++s) {
                const f32x4 a0 = *(const f32x4*)(sA + s * 64 + seg * 8), a1 = *(const f32x4*)(sA + s * 64 + seg * 8 + 4);
                const f32x4 w0 = *(const f32x4*)(sW + s * 64 + seg * 8), w1 = *(const f32x4*)(sW + s * 64 + seg * 8 + 4);
                const f32x4 b0 = *(const f32x4*)(sB + s * 64 + seg * 8), b1 = *(const f32x4*)(sB + s * 64 + seg * 8 + 4);
                const f32x4 k0 = *(const f32x4*)(sK + s * 64 + seg * 8), k1 = *(const f32x4*)(sK + s * 64 + seg * 8 + 4);
                const f32x4 r0 = *(const f32x4*)(sR + s * 64 + seg * 8), r1 = *(const f32x4*)(sR + s * 64 + seg * 8 + 4);
                const float vi = sV[s * 64 + si];
                float sa = st[0] * a0[0] + st[1] * a0[1] + st[2] * a0[2] + st[3] * a0[3] + st[4] * a1[0] + st[5] * a1[1] + st[6] * a1[2] + st[7] * a1[3];
                sa = red8(sa);
#pragma unroll
                for (int j = 0; j < 4; ++j) { st[j] = st[j] * w0[j] + sa * b0[j] + vi * k0[j]; st[4 + j] = st[4 + j] * w1[j] + sa * b1[j] + vi * k1[j]; }
                float yy = st[0] * r0[0] + st[1] * r0[1] + st[2] * r0[2] + st[3] * r0[3] + st[4] * r1[0] + st[5] * r1[1] + st[6] * r1[2] + st[7] * r1[3];
                yy = red8(yy);
                if (seg == 0) sY[s * 64 + si] = yy;
            }
            __syncthreads();
            {
                const f32x4 y4 = *(const f32x4*)(sY + tt * 64 + j4);
                float sm = red16(y4[0] + y4[1] + y4[2] + y4[3]); const float mean = sm * (1.0f / 64.f);
                float d[4], vs = 0.f;
#pragma unroll
                for (int e = 0; e < 4; ++e) { d[e] = y4[e] - mean; vs += d[e] * d[e]; }
                vs = red16(vs); const float rstd = rsqrtf(vs * (1.0f / 64.f) + GN_EPS);
                const float rk = sRK[tt];
                const u32x2 z2 = *(const u32x2*)(cur + 3200 + cb); const float zf[4] = {bflo(z2.x), bfhi(z2.x), bflo(z2.y), bfhi(z2.y)};
                float o[4];
#pragma unroll
                for (int e = 0; e < 4; ++e) o[e] = (d[e] * rstd * cg[e] + cbb[e] + rk * sV[tt * 64 + j4 + e]) * siluf_(zf[e]);
                u32x2 w; w.x = cvt_pk_bf16(o[0], o[1]); w.y = cvt_pk_bf16(o[2], o[3]); *(u32x2*)(cur + 3200 + cb) = w;
            }
        }
    }
    __syncthreads();
}

__device__ void phase_sgu(int l, unsigned char* smem) {
    const Params p = load_params();
    bf16_t* vnT = (bf16_t*)smem;
    float* stat = (float*)(smem + 128 * 136 * 2);
    const int tid = opaque_tid(), wid = tid >> 6, lane = tid & 63, fr = lane & 15, fq = lane >> 4;
    const float* lng = p.sgu_ln_g + (size_t)l * DM; const float* lnb = p.sgu_ln_b + (size_t)l * DM;
    for (int item = blockIdx.x; item < T_TOK / 128; item += gridDim.x) {
        bf16_t* Hb = p.H + (size_t)item * 128 * LDB_H;
        __syncthreads();
        for (int q = 0; q < 16; ++q) { const int s = wid * 16 + q; const bf16_t* vr = Hb + (size_t)s * LDB_H + 1024 + lane * 16;
            const u32x4 a = *(const u32x4*)vr, bq = *(const u32x4*)(vr + 8);
            const float f[16] = {bflo(a.x), bfhi(a.x), bflo(a.y), bfhi(a.y), bflo(a.z), bfhi(a.z), bflo(a.w), bfhi(a.w), bflo(bq.x), bfhi(bq.x), bflo(bq.y), bfhi(bq.y), bflo(bq.z), bfhi(bq.z), bflo(bq.w), bfhi(bq.w)};
            float sm = 0.f;
#pragma unroll
            for (int e = 0; e < 16; ++e) sm += f[e];
#pragma unroll
            for (int o = 32; o > 0; o >>= 1) sm += __shfl_xor(sm, o);
            const float mean = sm * (1.0f / DM); float vs = 0.f;
#pragma unroll
            for (int e = 0; e < 16; ++e) { const float d = f[e] - mean; vs += d * d; }
#pragma unroll
            for (int o = 32; o > 0; o >>= 1) vs += __shfl_xor(vs, o);
            if (lane == 0) { stat[s * 2] = mean; stat[s * 2 + 1] = rsqrtf(vs * (1.0f / DM) + EPS); } }
        __syncthreads();
        for (int g = 0; g < 8; ++g) {
            { const int s = tid >> 2, c0 = (tid & 3) * 32; const float mean = stat[s * 2], rstd = stat[s * 2 + 1];
              const bf16_t* vr = Hb + (size_t)s * LDB_H + 1024 + g * 128 + c0;
#pragma unroll
              for (int q = 0; q < 4; ++q) { const u32x4 a = *(const u32x4*)(vr + q * 8); const float f[8] = {bflo(a.x), bfhi(a.x), bflo(a.y), bfhi(a.y), bflo(a.z), bfhi(a.z), bflo(a.w), bfhi(a.w)};
#pragma unroll
                  for (int e = 0; e < 8; ++e) { const int c = c0 + q * 8 + e; const float vn = (f[e] - mean) * rstd * lng[g * 128 + c] + lnb[g * 128 + c]; vnT[c * 136 + s] = f2bf(vn); } } }
            __syncthreads();
            f32x4 acc[8];
#pragma unroll
            for (int i = 0; i < 8; ++i) acc[i] = (f32x4){0.f, 0.f, 0.f, 0.f};
            const int trow = wid * 16 + fr;
            const float* Wg = p.sgu_w + (((size_t)l * 8 + g) * 128 + trow) * 128;
            const int nks = (wid < 4) ? 2 : 4;
            for (int ks = 0; ks < nks; ++ks) {
                const f32x4 wa = *(const f32x4*)(Wg + ks * 32 + fq * 8), wb = *(const f32x4*)(Wg + ks * 32 + fq * 8 + 4);
                u32x4 wp; wp.x = cvt_pk_bf16(wa[0], wa[1]); wp.y = cvt_pk_bf16(wa[2], wa[3]); wp.z = cvt_pk_bf16(wb[0], wb[1]); wp.w = cvt_pk_bf16(wb[2], wb[3]);
                const bf16x8 wfrag = __builtin_bit_cast(bf16x8, wp);
#pragma unroll
                for (int ct = 0; ct < 8; ++ct) { const bf16x8 vfrag = *(const bf16x8*)(vnT + (ct * 16 + fr) * 136 + ks * 32 + fq * 8);
                    acc[ct] = __builtin_amdgcn_mfma_f32_16x16x32_bf16(vfrag, wfrag, acc[ct], 0, 0, 0); }
            }
            { const float bs = p.sgu_b[((size_t)l * 8 + g) * 128 + trow]; bf16_t* hr = Hb + (size_t)trow * LDB_H;
#pragma unroll
              for (int ct = 0; ct < 8; ++ct) { const int c = g * 128 + ct * 16 + fq * 4;
                  const u32x2 u2 = *(const u32x2*)(hr + c), z2 = *(const u32x2*)(hr + 2048 + c);
                  const float uf[4] = {bflo(u2.x), bfhi(u2.x), bflo(u2.y), bfhi(u2.y)}, zf[4] = {bflo(z2.x), bfhi(z2.x), bflo(z2.y), bfhi(z2.y)};
                  float o[4];
#pragma unroll
                  for (int j = 0; j < 4; ++j) o[j] = uf[j] * (acc[ct][j] + bs) * siluf_(zf[j]);
                  u32x2 w; w.x = cvt_pk_bf16(o[0], o[1]); w.y = cvt_pk_bf16(o[2], o[3]); *(u32x2*)(hr + 2048 + c) = w; } }
            __syncthreads();
        }
    }
    __syncthreads();
}

__device__ void phase_hgrn(int l, unsigned char* smem) {
    const Params p = load_params();
    constexpr int LQ = 136, LS = 72;
    bf16_t* Qm = (bf16_t*)smem;
    bf16_t* Km = Qm + 64 * LQ;
    bf16_t* Qs = Km + 64 * LQ;
    bf16_t* KsT = Qs + 64 * LQ;
    bf16_t* IT = KsT + 128 * LS;
    bf16_t* att = IT + 128 * LS;
    bf16_t* ST = att + 64 * LS;
    float* psum = (float*)(ST + 128 * LQ);
    float* dec = psum + 512;
    float* obuf = (float*)smem;
    const int tid = opaque_tid(), wid = tid >> 6, lane = tid & 63, fr = lane & 15, fq = lane >> 4;
    const int c = tid & 127, tq = tid >> 7;
    for (int item = blockIdx.x; item < NB * 8; item += gridDim.x) {
        const int b = item >> 3, h = item & 7;
        float lb = 0.f;
        if (l == 1) { const float l0 = p.lb_logits[h * 128 + c], l1 = p.lb_logits[DM + h * 128 + c]; lb = 1.0f / (1.0f + __expf(l0 - l1)); }
        __syncthreads();
        for (int e = tid; e < 128 * LQ / 2; e += 512) ((unsigned*)ST)[e] = 0u;
        f32x4 S[8];
#pragma unroll
        for (int i = 0; i < 8; ++i) S[i] = (f32x4){0.f, 0.f, 0.f, 0.f};
        for (int ch = 0; ch < SEQ / 64; ++ch) {
            bf16_t* Hc = p.H + ((size_t)b * SEQ + ch * 64) * LDC_H + h * 128;
            {
                float qv[16], kv[16], bl[16]; u32x4 ip[2]; float run = 0.f;
                unsigned ipk[8];
#pragma unroll
                for (int tt = 0; tt < 16; ++tt) { const bf16_t* hr = Hc + (size_t)(tq * 16 + tt) * LDC_H + c;
                    const float q = bf2f(hr[0]), f = bf2f(hr[1024]); const bf16_t iv = hr[2048];
                    qv[tt] = siluf_(q); const float fg = lb + (1.0f - lb) * sigmoidf_(f); kv[tt] = 1.0f - fg; run += __logf(fg); bl[tt] = run;
                    if (tt & 1) ipk[tt >> 1] |= ((unsigned)iv) << 16; else ipk[tt >> 1] = (unsigned)iv; }
                ip[0] = (u32x4){ipk[0], ipk[1], ipk[2], ipk[3]}; ip[1] = (u32x4){ipk[4], ipk[5], ipk[6], ipk[7]};
                psum[tq * 128 + c] = run;
                __syncthreads();
                const float p0 = psum[c], p1 = psum[128 + c], p2 = psum[256 + c], p3 = psum[384 + c];
                const float off = (tq > 0 ? p0 : 0.f) + (tq > 1 ? p1 : 0.f) + (tq > 2 ? p2 : 0.f);
                const float bmid = p0 + p1, blast = p0 + p1 + p2 + p3;
                if (tq == 0) dec[c] = __expf(blast);
                unsigned ks[8];
#pragma unroll
                for (int tt = 0; tt < 16; ++tt) { const float bb = bl[tt] + off; const int t = tq * 16 + tt;
                    Qm[t * LQ + c] = f2bf(qv[tt] * __expf(bb - bmid)); Km[t * LQ + c] = f2bf(kv[tt] * __expf(bmid - bb)); Qs[t * LQ + c] = f2bf(qv[tt] * __expf(bb));
                    const float kx = kv[tt] * __expf(blast - bb);
                    if (tt & 1) ks[tt >> 1] |= ((unsigned)f2bf(kx)) << 16; else ks[tt >> 1] = (unsigned)f2bf(kx); }
                *(u32x4*)(KsT + c * LS + tq * 16) = (u32x4){ks[0], ks[1], ks[2], ks[3]}; *(u32x4*)(KsT + c * LS + tq * 16 + 8) = (u32x4){ks[4], ks[5], ks[6], ks[7]};
                *(u32x4*)(IT + c * LS + tq * 16) = ip[0]; *(u32x4*)(IT + c * LS + tq * 16 + 8) = ip[1];
            }
            __syncthreads();
            {
                const int ttile = wid >> 1;
#pragma unroll
                for (int q = 0; q < 2; ++q) { const int stile = (wid & 1) * 2 + q; f32x4 a = (f32x4){0.f, 0.f, 0.f, 0.f};
                    if (stile <= ttile) {
#pragma unroll
                        for (int ks = 0; ks < 4; ++ks) { const bf16x8 af = *(const bf16x8*)(Qm + (ttile * 16 + fr) * LQ + ks * 32 + fq * 8), bfr = *(const bf16x8*)(Km + (stile * 16 + fr) * LQ + ks * 32 + fq * 8);
                            a = __builtin_amdgcn_mfma_f32_16x16x32_bf16(af, bfr, a, 0, 0, 0); } }
#pragma unroll
                    for (int j = 0; j < 4; ++j) { const int t = ttile * 16 + fq * 4 + j, s = stile * 16 + fr; att[t * LS + s] = f2bf(s <= t ? a[j] : 0.f); } }
            }
            __syncthreads();
            {
                const int ttile = wid >> 1; f32x4 o[4];
#pragma unroll
                for (int q = 0; q < 4; ++q) o[q] = (f32x4){0.f, 0.f, 0.f, 0.f};
#pragma unroll
                for (int ks = 0; ks < 2; ++ks) { const bf16x8 af = *(const bf16x8*)(att + (ttile * 16 + fr) * LS + ks * 32 + fq * 8);
#pragma unroll
                    for (int q = 0; q < 4; ++q) { const int vt = (wid & 1) * 4 + q; const bf16x8 bfr = *(const bf16x8*)(IT + (vt * 16 + fr) * LS + ks * 32 + fq * 8);
                        o[q] = __builtin_amdgcn_mfma_f32_16x16x32_bf16(bfr, af, o[q], 0, 0, 0); } }
#pragma unroll
                for (int ks = 0; ks < 4; ++ks) { const bf16x8 af = *(const bf16x8*)(Qs + (ttile * 16 + fr) * LQ + ks * 32 + fq * 8);
#pragma unroll
                    for (int q = 0; q < 4; ++q) { const int vt = (wid & 1) * 4 + q; const bf16x8 bfr = *(const bf16x8*)(ST + (vt * 16 + fr) * LQ + ks * 32 + fq * 8);
                        o[q] = __builtin_amdgcn_mfma_f32_16x16x32_bf16(bfr, af, o[q], 0, 0, 0); } }
#pragma unroll
                for (int q = 0; q < 4; ++q) { const int vt = (wid & 1) * 4 + q; *(f32x4*)(obuf + (ttile * 16 + fr) * 132 + vt * 16 + fq * 4) = o[q]; }
            }
            {
                float dk[4];
#pragma unroll
                for (int j = 0; j < 4; ++j) dk[j] = dec[wid * 16 + fq * 4 + j];
#pragma unroll
                for (int vt = 0; vt < 8; ++vt)
#pragma unroll
                    for (int j = 0; j < 4; ++j) S[vt][j] *= dk[j];
#pragma unroll
                for (int ks = 0; ks < 2; ++ks) { const bf16x8 af = *(const bf16x8*)(KsT + (wid * 16 + fr) * LS + ks * 32 + fq * 8);
#pragma unroll
                    for (int vt = 0; vt < 8; ++vt) { const bf16x8 bfr = *(const bf16x8*)(IT + (vt * 16 + fr) * LS + ks * 32 + fq * 8);
                        S[vt] = __builtin_amdgcn_mfma_f32_16x16x32_bf16(af, bfr, S[vt], 0, 0, 0); } }
            }
            __syncthreads();
#pragma unroll
            for (int vt = 0; vt < 8; ++vt) { u32x2 w; w.x = cvt_pk_bf16(S[vt][0], S[vt][1]); w.y = cvt_pk_bf16(S[vt][2], S[vt][3]); *(u32x2*)(ST + (vt * 16 + fr) * LQ + wid * 16 + fq * 4) = w; }
            {
                const int t = tid >> 3, v0 = (tid & 7) * 16; float ov[16], ss = 0.f;
#pragma unroll
                for (int q = 0; q < 4; ++q) { const f32x4 x = *(const f32x4*)(obuf + t * 132 + v0 + q * 4); ov[q * 4] = x[0]; ov[q * 4 + 1] = x[1]; ov[q * 4 + 2] = x[2]; ov[q * 4 + 3] = x[3]; ss += x[0] * x[0] + x[1] * x[1] + x[2] * x[2] + x[3] * x[3]; }
                ss = red8(ss); const float rinv = rsqrtf(ss * (1.0f / 128.f) + EPS);
                bf16_t* zr = Hc + (size_t)t * LDC_H + 3072 + v0; const float* gn = p.hgrn_g + (size_t)l * DM + h * 128 + v0;
                const u32x4 z0 = *(const u32x4*)zr, z1 = *(const u32x4*)(zr + 8);
                const float zf[16] = {bflo(z0.x), bfhi(z0.x), bflo(z0.y), bfhi(z0.y), bflo(z0.z), bfhi(z0.z), bflo(z0.w), bfhi(z0.w), bflo(z1.x), bfhi(z1.x), bflo(z1.y), bfhi(z1.y), bflo(z1.z), bfhi(z1.z), bflo(z1.w), bfhi(z1.w)};
                float r[16];
#pragma unroll
                for (int e = 0; e < 16; ++e) r[e] = ov[e] * rinv * gn[e] * siluf_(zf[e]);
                u32x4 w0, w1; w0.x = cvt_pk_bf16(r[0], r[1]); w0.y = cvt_pk_bf16(r[2], r[3]); w0.z = cvt_pk_bf16(r[4], r[5]); w0.w = cvt_pk_bf16(r[6], r[7]);
                w1.x = cvt_pk_bf16(r[8], r[9]); w1.y = cvt_pk_bf16(r[10], r[11]); w1.z = cvt_pk_bf16(r[12], r[13]); w1.w = cvt_pk_bf16(r[14], r[15]);
                *(u32x4*)zr = w0; *(u32x4*)(zr + 8) = w1;
            }
        }
    }
    __syncthreads();
}

constexpr int PH_PER_LAYER = 11, N_PHASES = 2 * PH_PER_LAYER + 1;

__global__ void __launch_bounds__(512, 2) fwd_megakernel(Params pk) {
    extern __shared__ __attribute__((aligned(16))) unsigned char shm[];
    LAS unsigned char* lds = (LAS unsigned char*)shm;
    cg::grid_group grid = cg::this_grid();
    const int phase_lo = pk.phase_lo, phase_hi = pk.phase_hi;
    for (int ph = phase_lo; ph < phase_hi; ++ph) {
        const int l = ph / PH_PER_LAYER, q = ph % PH_PER_LAYER;
        if (ph == N_PHASES - 1) {
            const Params p = load_params();
            phase_rmsnorm(p.out, p.final_g, nullptr, p.out);
        } else if (q == 0) {
            phase_convert(l, shm);
            const Params p = load_params();
            phase_rmsnorm(l == 0 ? p.x : p.out, p.norm_g + (size_t)l * DM, p.xn, nullptr);
        } else if (q == 1 || q == 4 || q == 7) {
            const Params p = load_params(); const int G = gridDim.x, cidx = opaque_bid();
            const int N = (q == 1) ? LDA_H : (q == 4) ? LDB_H : LDC_H; const int r0 = (q == 1) ? 0 : (q == 4) ? LDA_H : (LDA_H + LDB_H);
            pg8::GemmDesc g; g.A = p.xn; g.Bt = p.Wt + (size_t)r0 * DM; g.lda = DM;
            pg8::Sched S; S.init(T_TOK, N, G, cidx, 1);
            pg8::EpiStore E; E.O = p.H; E.ldc = N;
            pg8::gemm_phase(lds, g, g, S, E);
        } else if (q == 2) {
            phase_rwkv(l, shm);
        } else if (q == 5) {
            phase_sgu(l, shm);
        } else if (q == 8) {
            phase_hgrn(l, shm);
        } else if (q == 3 || q == 6 || q == 9) {
            const Params p = load_params(); const int G = gridDim.x, cidx = opaque_bid();
            bf16_t* WtBr = p.Wt + (size_t)WT_ROWS * DM;
            const int n = (q - 3) / 3; const int ldh = (n == 0) ? LDA_H : (n == 1) ? LDB_H : LDC_H; const int ocol = (n == 0) ? 3200 : (n == 1) ? 2048 : 3072;
            pg8::GemmDesc g0, g1; g0.A = p.xn; g0.Bt = p.Wt + (size_t)(LDA_H + LDB_H + LDC_H + n * DM) * DM; g0.lda = DM;
            g1.A = p.H + ocol; g1.Bt = WtBr + (size_t)n * DM * DM; g1.lda = ldh;
            pg8::Sched S; S.init(T_TOK, DM, G, cidx, 2);
            pg8::EpiMerge E; E.G = p.H; E.ldg = ldh; E.bias = p.b_merge + ((size_t)l * 3 + n) * DM; E.Y = p.y; E.accum = (n > 0);
            pg8::gemm_phase(lds, g0, g1, S, E);
        } else {
            const Params p = load_params(); const int G = gridDim.x, cidx = opaque_bid();
            bf16_t* WtOut = p.Wt + (size_t)WT_ROWS * DM + (size_t)3 * DM * DM;
            pg8::GemmDesc g; g.A = p.y; g.Bt = WtOut; g.lda = DM;
            pg8::Sched S; S.init(T_TOK, DM, G, cidx, 1);
            pg8::EpiResid E; E.Xin = (l == 0) ? p.x : p.out; E.Xout = p.out;
            pg8::gemm_phase(lds, g, g, S, E);
        }
        if (ph + 1 < phase_hi) grid.sync();
    }
}

extern "C" void kernel_launch(void* const* d_in, const int* in_sizes, int n_in, void* d_out, int out_size, void* d_ws, size_t ws_size, hipStream_t stream) {
    static int grid_blocks = 0;
    if (!grid_blocks) {
        int dev = 0, cus = 0, per_cu = 0;
        hipGetDevice(&dev);
        hipDeviceGetAttribute(&cus, hipDeviceAttributeMultiprocessorCount, dev);
        if (hipFuncSetAttribute((const void*)fwd_megakernel, hipFuncAttributeMaxDynamicSharedMemorySize, LDS_BYTES) != hipSuccess) { fprintf(stderr, "hipFuncSetAttribute failed\n"); return; }
        hipOccupancyMaxActiveBlocksPerMultiprocessor(&per_cu, (const void*)fwd_megakernel, 512, LDS_BYTES);
        if (per_cu < 1) { fprintf(stderr, "occupancy query says 0 blocks per CU\n"); return; }
        grid_blocks = cus * 1;
    }
    Params p{};
    const float** fp = (const float**)&p;
    for (int i = 0; i < 26; ++i) fp[i] = (const float*)d_in[i];
    p.out = (float*)d_out;
    unsigned char* ws = (unsigned char*)d_ws; size_t off = 0;
    auto take = [&](size_t bytes) { unsigned char* r = ws + off; off += (bytes + 255) & ~(size_t)255; return r; };
    p.Wt = (bf16_t*)take(((size_t)WT_ROWS * DM + 4 * (size_t)DM * DM) * 2);
    p.xn = (bf16_t*)take((size_t)T_TOK * DM * 2);
    p.vf = (bf16_t*)take((size_t)T_TOK * DM * 2);
    p.y = (bf16_t*)take((size_t)T_TOK * DM * 2);
    p.H = (bf16_t*)take((size_t)T_TOK * LDA_H * 2);
    if (off > ws_size) { fprintf(stderr, "workspace too small: need %zu have %zu\n", off, ws_size); return; }
#if SINGLE_LAUNCH
    p.phase_lo = 0; p.phase_hi = N_PHASES;
    void* args[] = {&p};
    hipError_t e = hipLaunchCooperativeKernel((const void*)fwd_megakernel, dim3(grid_blocks), dim3(512), args, LDS_BYTES, stream);
    if (e != hipSuccess) fprintf(stderr, "cooperative launch failed: %s (grid %d)\n", hipGetErrorString(e), grid_blocks);
#else
    for (int ph = 0; ph < N_PHASES; ++ph) {
        p.phase_lo = ph; p.phase_hi = ph + 1;
        hipLaunchKernelGGL(fwd_megakernel, dim3(grid_blocks), dim3(512), LDS_BYTES, stream, p);
    }
#endif
}
```

```cpp
#include <hip/hip_runtime.h>
#include <hip/hip_cooperative_groups.h>
#include <cstdio>
namespace cg = cooperative_groups;

#ifndef PROBE_Q
#define PROBE_Q -1
#endif
#ifndef SINGLE_LAUNCH
#define SINGLE_LAUNCH 1
#endif

typedef unsigned short bf16_t;
typedef short bf16x8 __attribute__((ext_vector_type(8)));
typedef float f32x4 __attribute__((ext_vector_type(4)));
typedef float f32x2 __attribute__((ext_vector_type(2)));
typedef unsigned u32x4 __attribute__((ext_vector_type(4)));
typedef unsigned u32x2 __attribute__((ext_vector_type(2)));
#define LAS __attribute__((address_space(3)))

constexpr int T_TOK = 32768, DM = 1024, SEQ = 4096, NB = 8;
constexpr int N_IN = 14464;
constexpr int LDA_H = 4352, LDB_H = 3072, LDC_H = 4096;
constexpr int WT_ROWS = 14592;
constexpr int LDS_BYTES = 163840;
constexpr float EPS = 1e-6f, GN_EPS = 64e-5f;

struct Params {
    const float *x, *norm_g, *w_in, *b_merge, *mu, *w0, *w_w2, *a0, *a_w2, *v0, *v_w1, *v_w2, *k_k, *k_a, *r_k, *lnx_g, *lnx_b,
        *sgu_ln_g, *sgu_ln_b, *sgu_w, *sgu_b, *lb_logits, *hgrn_g, *w_branch, *w_out, *final_g;
    float* out;
    bf16_t *Wt, *xn, *vf, *y, *H;
    float* rkbuf;
    int phase_lo, phase_hi;
};

__device__ __forceinline__ float bf2f(bf16_t h) { return __uint_as_float(((unsigned)h) << 16); }
__device__ __forceinline__ float bflo(unsigned u) { return __uint_as_float(u << 16); }
__device__ __forceinline__ float bfhi(unsigned u) { return __uint_as_float(u & 0xffff0000u); }
typedef __bf16 bf16x2_t __attribute__((ext_vector_type(2)));
__device__ __forceinline__ unsigned cvt_pk_bf16(float lo, float hi) { const f32x2 v = {lo, hi}; const bf16x2_t r = __builtin_convertvector(v, bf16x2_t); return __builtin_bit_cast(unsigned, r); }
__device__ __forceinline__ bf16_t f2bf(float f) { return (bf16_t)(cvt_pk_bf16(f, 0.f) & 0xffffu); }
__device__ __forceinline__ float sigmoidf_(float x) { return __builtin_amdgcn_rcpf(1.0f + __expf(-x)); }
__device__ __forceinline__ float siluf_(float x) { return x * __builtin_amdgcn_rcpf(1.0f + __expf(-x)); }
__device__ __forceinline__ float tanh_fast(float x) { return 1.0f - 2.0f * __builtin_amdgcn_rcpf(1.0f + __expf(2.0f * x)); }

__device__ __forceinline__ Params load_params() {
#if defined(__HIP_DEVICE_COMPILE__)
    typedef const Params __attribute__((address_space(4)))* KP;
    KP kp = (KP)__builtin_amdgcn_kernarg_segment_ptr(); asm volatile("" : "+s"(kp)); return *kp;
#else
    return Params{};
#endif
}
__device__ __forceinline__ int opaque_tid() { int t = threadIdx.x; asm volatile("" : "+v"(t)); return t; }
__device__ __forceinline__ int opaque_bid() { int t = blockIdx.x; asm volatile("" : "+s"(t)); return t; }

namespace pg8 {
constexpr int BM = 256, BK = 64, HALF = 128, HTB = HALF * BK * 2, STAGE_BYTES = 8 * HTB, NXCD = 8, WGM = 8, KD = 1024;
__device__ __forceinline__ int lds_byte(int r, int c) { const int st = (r >> 4) * 2 + (c >> 5), rr = r & 15, cc = c & 31, ob = rr * 64 + cc * 2; return st * 1024 + (ob ^ (((ob >> 9) & 1) << 5)); }
__device__ __forceinline__ void stage_rc(int b, int& R, int& C) { const int st = b / 1024, sb = b % 1024, swz = sb ^ (((sb >> 9) & 1) << 5); R = (st >> 1) * 16 + swz / 64; C = (st & 1) * 32 + (swz % 64) / 2; }
__device__ __forceinline__ int perm32(int rho) { const int n = rho >> 4, i = rho & 15; return 8 * (i >> 2) + 4 * n + (i & 3); }

struct Unit { int pm, pn, sel; };
struct GemmDesc { const bf16_t* A; const bf16_t* Bt; int lda; };
struct Sched {
    int nM, nN, nwg, G, c, nsel;
    __device__ void init(int M, int N, int G_, int c_, int nsel_) { nM = M / BM; nN = N / BM; nwg = nM * nN; G = G_; c = c_; nsel = nsel_; }
    __device__ bool next(int i, Unit& u) const {
        const int ti = (nsel == 2) ? (i >> 1) : i; u.sel = (nsel == 2) ? (i & 1) : 0;
        const long L = (long)ti * G + c; if (L >= nwg) return false;
        int wgid = (int)L; { const int q = nwg / NXCD, r = nwg % NXCD, xcd = wgid % NXCD, off = wgid / NXCD; wgid = (xcd < r ? xcd * (q + 1) : r * (q + 1) + (xcd - r) * q) + off; }
        const int nig = WGM * nN, gid = wgid / nig, fm = gid * WGM, gsz = (nM - fm) < WGM ? (nM - fm) : WGM;
        u.pm = fm + ((wgid % nig) % gsz); u.pn = (wgid % nig) / gsz; return true;
    }
};

template <class Epi>
__device__ __forceinline__ void gemm_phase(LAS unsigned char* lds, const GemmDesc g0, const GemmDesc g1, const Sched& S, const Epi& E) {
    const int tid = opaque_tid(), wid = __builtin_amdgcn_readfirstlane(tid >> 6), lane = tid & 63, wr = wid >> 2, wc = wid & 3, fr = lane & 15, fq = lane >> 4;
    constexpr int K = KD, nt = K / BK;
    unsigned voffA0[2], voffA1[2], voffB[2];
#pragma unroll
    for (int i = 0; i < 2; ++i) { int R, C; stage_rc(tid * 16 + i * 8192, R, C); const int Rb = Epi::PERM ? ((R & ~31) + perm32(R & 31)) : R;
        voffA0[i] = (unsigned)(R * g0.lda + C) * 2u; voffA1[i] = (unsigned)(R * g1.lda + C) * 2u; voffB[i] = (unsigned)(Rb * K + C) * 2u; }
    const size_t kstep = (size_t)(BK * 2);
    const size_t hstepB = (size_t)HALF * K * 2;
    const unsigned ldsw = (unsigned)wid * 1024u;
    const int aoff = lds_byte(wr * 64 + fr, fq * 8), boff = lds_byte(wc * 32 + fr, fq * 8);
#define PG8_SA(b, h) (((b) * 2 + (h)) * HTB)
#define PG8_SB(b, h) ((4 + (b) * 2 + (h)) * HTB)
#define PG8_STAGE(bufoff, gbase, v0, v1) do { \
        __builtin_amdgcn_global_load_lds((const unsigned*)((const char*)(gbase) + (v0)), (LAS unsigned*)(lds + (bufoff) + ldsw), 16, 0, 0); \
        __builtin_amdgcn_global_load_lds((const unsigned*)((const char*)(gbase) + (v1)), (LAS unsigned*)(lds + (bufoff) + ldsw + 8192), 16, 0, 0); } while (0)
#define PG8_STAGEB(bufoff, gbase) PG8_STAGE(bufoff, gbase, voffB[0], voffB[1])
#define PG8_LDA(dst, b, h) do { _Pragma("unroll") for (int m = 0; m < 4; ++m) _Pragma("unroll") for (int k = 0; k < 2; ++k) dst[m][k] = *(const LAS bf16x8*)(lds + PG8_SA(b, h) + aoff + m * 2048 + k * 1024); } while (0)
#define PG8_LDB(dst, b, h) do { _Pragma("unroll") for (int n = 0; n < 2; ++n) _Pragma("unroll") for (int k = 0; k < 2; ++k) dst[n][k] = *(const LAS bf16x8*)(lds + PG8_SB(b, h) + boff + n * 2048 + k * 1024); } while (0)
#define PG8_MMA(ai, bj, At, Bt) do { __builtin_amdgcn_s_setprio(1); _Pragma("unroll") for (int m = 0; m < 4; ++m) _Pragma("unroll") for (int n = 0; n < 2; ++n) _Pragma("unroll") for (int k = 0; k < 2; ++k) \
        acc[ai][bj][m][n] = __builtin_amdgcn_mfma_f32_16x16x32_bf16(Bt[n][k], At[m][k], acc[ai][bj][m][n], 0, 0, 0); __builtin_amdgcn_s_setprio(0); } while (0)
#define PG8_WAIT_V(n) asm volatile("s_waitcnt vmcnt(" #n ")" ::: "memory")
#define PG8_WAIT_L(n) asm volatile("s_waitcnt lgkmcnt(" #n ")" ::: "memory")
#define PG8_BAR __builtin_amdgcn_s_barrier()
#define PG8_SCHED __builtin_amdgcn_sched_barrier(0)
    Unit cur, nxt; int ui = 0;
    if (!S.next(0, cur)) return;
    f32x4 acc[2][2][4][2];
#pragma unroll
    for (int a = 0; a < 2; ++a)
#pragma unroll
        for (int b = 0; b < 2; ++b)
#pragma unroll
            for (int m = 0; m < 4; ++m)
#pragma unroll
                for (int n = 0; n < 2; ++n) acc[a][b][m][n] = (f32x4){0.f, 0.f, 0.f, 0.f};
    bf16x8 At[4][2], B0[2][2], B1[2][2];
    const char* cA = (const char*)(cur.sel ? g1.A : g0.A) + (size_t)cur.pm * 256 * (size_t)(cur.sel ? g1.lda : g0.lda) * 2;
    const char* cB = (const char*)(cur.sel ? g1.Bt : g0.Bt) + (size_t)cur.pn * 256 * K * 2;
    size_t chA = (size_t)HALF * (cur.sel ? g1.lda : g0.lda) * 2;
    unsigned cv0 = cur.sel ? voffA1[0] : voffA0[0], cv1 = cur.sel ? voffA1[1] : voffA0[1];
    PG8_STAGEB(PG8_SB(0, 0), cB); PG8_STAGE(PG8_SA(0, 0), cA, cv0, cv1); PG8_STAGEB(PG8_SB(0, 1), cB + hstepB); PG8_STAGE(PG8_SA(0, 1), cA + chA, cv0, cv1);
    if (wr == 1) PG8_BAR;
    PG8_WAIT_V(4); PG8_BAR;
    PG8_STAGEB(PG8_SB(1, 0), cB + kstep); PG8_STAGE(PG8_SA(1, 0), cA + kstep, cv0, cv1); PG8_STAGEB(PG8_SB(1, 1), cB + hstepB + kstep);
    PG8_WAIT_V(6); PG8_BAR;
    for (;;) {
        const bool has_next = S.next(ui + 1, nxt);
        const int nsel = has_next ? nxt.sel : cur.sel;
        const char* nA = has_next ? (const char*)(nsel ? g1.A : g0.A) + (size_t)nxt.pm * 256 * (size_t)(nsel ? g1.lda : g0.lda) * 2 : cA;
        const char* nB = has_next ? (const char*)(nsel ? g1.Bt : g0.Bt) + (size_t)nxt.pn * 256 * K * 2 : cB;
        const size_t nhA = (size_t)HALF * (nsel ? g1.lda : g0.lda) * 2;
        const unsigned nv0 = nsel ? voffA1[0] : voffA0[0], nv1 = nsel ? voffA1[1] : voffA0[1];
        for (int t = 0; t < nt; t += 2) {
            const bool last = (t == nt - 2);
            const char* a1 = cA + (size_t)(t + 1) * kstep;
            const char* a2 = last ? nA : cA + (size_t)(t + 2) * kstep; const char* b2 = last ? nB : cB + (size_t)(t + 2) * kstep;
            const char* a3 = a2 + kstep; const char* b3 = b2 + kstep;
            const size_t h2 = last ? nhA : chA; const unsigned w0 = last ? nv0 : cv0, w1 = last ? nv1 : cv1;
            PG8_LDB(B0, 0, 0); PG8_SCHED; PG8_LDA(At, 0, 0); PG8_STAGE(PG8_SA(1, 1), a1 + chA, cv0, cv1);
            PG8_WAIT_L(8); PG8_BAR; PG8_WAIT_L(0); PG8_MMA(0, 0, At, B0); PG8_BAR; PG8_SCHED;
            PG8_LDB(B1, 0, 1); PG8_STAGEB(PG8_SB(0, 0), b2);
            PG8_BAR; PG8_WAIT_L(0); PG8_MMA(0, 1, At, B1); PG8_BAR;
            PG8_LDA(At, 0, 1); PG8_STAGE(PG8_SA(0, 0), a2, w0, w1);
            PG8_BAR; PG8_WAIT_L(0); PG8_MMA(1, 0, At, B0); PG8_BAR; PG8_SCHED;
            PG8_STAGEB(PG8_SB(0, 1), b2 + hstepB);
            PG8_WAIT_V(6); PG8_BAR; PG8_MMA(1, 1, At, B1); PG8_BAR;
            PG8_LDB(B0, 1, 0); PG8_SCHED; PG8_LDA(At, 1, 0); PG8_STAGE(PG8_SA(0, 1), a2 + h2, w0, w1);
            PG8_WAIT_L(8); PG8_BAR; PG8_WAIT_L(0); PG8_MMA(0, 0, At, B0); PG8_BAR; PG8_SCHED;
            PG8_LDB(B1, 1, 1); PG8_STAGEB(PG8_SB(1, 0), b3);
            PG8_BAR; PG8_WAIT_L(0); PG8_MMA(0, 1, At, B1); PG8_BAR;
            PG8_LDA(At, 1, 1); PG8_STAGE(PG8_SA(1, 0), a3, w0, w1);
            PG8_BAR; PG8_WAIT_L(0); PG8_MMA(1, 0, At, B0); PG8_BAR; PG8_SCHED;
            PG8_STAGEB(PG8_SB(1, 1), b3 + hstepB);
            PG8_WAIT_V(6); PG8_BAR; PG8_MMA(1, 1, At, B1); PG8_BAR;
        }
        E(acc, cur, wr, wc, fr, fq);
        if (!has_next) break;
#pragma unroll
        for (int a = 0; a < 2; ++a)
#pragma unroll
            for (int b = 0; b < 2; ++b)
#pragma unroll
                for (int m = 0; m < 4; ++m)
#pragma unroll
                    for (int n = 0; n < 2; ++n) acc[a][b][m][n] = (f32x4){0.f, 0.f, 0.f, 0.f};
        cur = nxt; cA = nA; cB = nB; chA = nhA; cv0 = nv0; cv1 = nv1; ++ui;
    }
    PG8_WAIT_V(0);
    if (wr == 0) PG8_BAR;
    PG8_BAR;
#undef PG8_SA
#undef PG8_SB
#undef PG8_STAGE
#undef PG8_STAGEB
#undef PG8_LDA
#undef PG8_LDB
#undef PG8_MMA
#undef PG8_WAIT_V
#undef PG8_WAIT_L
#undef PG8_BAR
#undef PG8_SCHED
}

struct EpiStore {
    static constexpr bool PERM = true;
    bf16_t* O; int ldc;
    __device__ __forceinline__ void operator()(const f32x4 (&acc)[2][2][4][2], const Unit& u, int wr, int wc, int fr, int fq) const {
        const int row0 = u.pm * BM + wr * 64 + fr, col0 = u.pn * BM + wc * 32 + 8 * fq;
#pragma unroll
        for (int ai = 0; ai < 2; ++ai)
#pragma unroll
            for (int m = 0; m < 4; ++m) { bf16_t* rowp = O + (size_t)(row0 + ai * HALF + m * 16) * ldc + col0;
#pragma unroll
                for (int bj = 0; bj < 2; ++bj) { const f32x4 v0 = acc[ai][bj][m][0], v1 = acc[ai][bj][m][1];
                    u32x4 w; w.x = cvt_pk_bf16(v0[0], v0[1]); w.y = cvt_pk_bf16(v0[2], v0[3]); w.z = cvt_pk_bf16(v1[0], v1[1]); w.w = cvt_pk_bf16(v1[2], v1[3]);
                    *(u32x4*)(rowp + bj * HALF) = w; } }
    }
};
struct EpiMerge {
    static constexpr bool PERM = true;
    bf16_t* G; int ldg; const float* bias; bf16_t* Y; int accum;
    __device__ __forceinline__ void operator()(const f32x4 (&acc)[2][2][4][2], const Unit& u, int wr, int wc, int fr, int fq) const {
        const int row0 = u.pm * BM + wr * 64 + fr, col0 = u.pn * BM + wc * 32 + 8 * fq;
        if (u.sel == 0) {
            f32x4 bv[2][2];
#pragma unroll
            for (int bj = 0; bj < 2; ++bj)
#pragma unroll
                for (int n = 0; n < 2; ++n) bv[bj][n] = *(const f32x4*)(bias + col0 + bj * HALF + 4 * n);
#pragma unroll
            for (int ai = 0; ai < 2; ++ai)
#pragma unroll
                for (int m = 0; m < 4; ++m) { bf16_t* rowp = G + (size_t)(row0 + ai * HALF + m * 16) * ldg + col0;
#pragma unroll
                    for (int bj = 0; bj < 2; ++bj) { f32x4 v0 = acc[ai][bj][m][0] + bv[bj][0], v1 = acc[ai][bj][m][1] + bv[bj][1];
#pragma unroll
                        for (int j = 0; j < 4; ++j) { v0[j] = sigmoidf_(v0[j]); v1[j] = sigmoidf_(v1[j]); }
                        u32x4 w; w.x = cvt_pk_bf16(v0[0], v0[1]); w.y = cvt_pk_bf16(v0[2], v0[3]); w.z = cvt_pk_bf16(v1[0], v1[1]); w.w = cvt_pk_bf16(v1[2], v1[3]);
                        *(u32x4*)(rowp + bj * HALF) = w; } }
        } else {
#pragma unroll
            for (int ai = 0; ai < 2; ++ai)
#pragma unroll
                for (int m = 0; m < 4; ++m) { const size_t r = (size_t)(row0 + ai * HALF + m * 16);
                    const unsigned long long* gp = (const unsigned long long*)(G + r * ldg + col0); bf16_t* yp = Y + r * DM + col0;
#pragma unroll
                    for (int bj = 0; bj < 2; ++bj) {
                        const unsigned long long g0 = __hip_atomic_load(gp + bj * (HALF / 4), __ATOMIC_RELAXED, __HIP_MEMORY_SCOPE_AGENT);
                        const unsigned long long g1 = __hip_atomic_load(gp + bj * (HALF / 4) + 1, __ATOMIC_RELAXED, __HIP_MEMORY_SCOPE_AGENT);
                        const unsigned gw[4] = {(unsigned)g0, (unsigned)(g0 >> 32), (unsigned)g1, (unsigned)(g1 >> 32)};
                        u32x4 yo = {0u, 0u, 0u, 0u}; if (accum) yo = *(const u32x4*)(yp + bj * HALF);
                        const f32x4 v0 = acc[ai][bj][m][0], v1 = acc[ai][bj][m][1];
                        u32x4 w;
                        w.x = cvt_pk_bf16(bflo(yo.x) + bflo(gw[0]) * v0[0], bfhi(yo.x) + bfhi(gw[0]) * v0[1]);
                        w.y = cvt_pk_bf16(bflo(yo.y) + bflo(gw[1]) * v0[2], bfhi(yo.y) + bfhi(gw[1]) * v0[3]);
                        w.z = cvt_pk_bf16(bflo(yo.z) + bflo(gw[2]) * v1[0], bfhi(yo.z) + bfhi(gw[2]) * v1[1]);
                        w.w = cvt_pk_bf16(bflo(yo.w) + bflo(gw[3]) * v1[2], bfhi(yo.w) + bfhi(gw[3]) * v1[3]);
                        *(u32x4*)(yp + bj * HALF) = w; } }
        }
    }
};
struct EpiResid {
    static constexpr bool PERM = false;
    const float* Xin; float* Xout;
    __device__ __forceinline__ void operator()(const f32x4 (&acc)[2][2][4][2], const Unit& u, int wr, int wc, int fr, int fq) const {
        const int row0 = u.pm * BM + wr * 64 + fr, col0 = u.pn * BM + wc * 32 + 4 * fq;
#pragma unroll
        for (int ai = 0; ai < 2; ++ai)
#pragma unroll
            for (int m = 0; m < 4; ++m) { const size_t ro = (size_t)(row0 + ai * HALF + m * 16) * DM + col0;
#pragma unroll
                for (int bj = 0; bj < 2; ++bj)
#pragma unroll
                    for (int n = 0; n < 2; ++n) { const f32x4 xi = *(const f32x4*)(Xin + ro + bj * HALF + n * 16); *(f32x4*)(Xout + ro + bj * HALF + n * 16) = xi + acc[ai][bj][m][n]; } }
    }
};
}

__device__ void phase_convert(int l, unsigned char* smem) {
    const Params p = load_params();
    float* tile = (float*)smem;
    const int tid = opaque_tid();
    const float* win = p.w_in + (size_t)l * DM * N_IN;
    bf16_t* WtIn = p.Wt; bf16_t* WtBr = p.Wt + (size_t)WT_ROWS * DM; bf16_t* WtOut = WtBr + (size_t)3 * DM * DM;
    const int NT_IN = WT_ROWS / 64;
    const int total = (NT_IN + 48 + 16) * 16;
    for (int it = blockIdx.x; it < total; it += gridDim.x) {
        const int ntile = it >> 4, kt = it & 15, k0 = kt * 64;
        const float* src = nullptr; int ld = 0, c0 = 0, valid = 64; bf16_t* dst;
        if (ntile < NT_IN) {
            const int n0 = ntile * 64; dst = WtIn + (size_t)n0 * DM;
            if (n0 < 4224) { src = win; ld = N_IN; c0 = n0; }
            else if (n0 < 4352) { if (n0 == 4224 && l > 0) { src = p.v_w1 + (size_t)(l - 1) * DM * 32; ld = 32; c0 = 0; valid = 32; } else { valid = 0; } }
            else { src = win; ld = N_IN; c0 = n0 - 128; }
        } else if (ntile < NT_IN + 48) {
            const int q = ntile - NT_IN, n = q >> 4, n0 = (q & 15) * 64;
            src = p.w_branch + ((size_t)l * 3 + n) * DM * DM; ld = DM; c0 = n0; dst = WtBr + ((size_t)n * DM + n0) * DM;
        } else {
            const int n0 = (ntile - NT_IN - 48) * 64; src = p.w_out + (size_t)l * DM * DM; ld = DM; c0 = n0; dst = WtOut + (size_t)n0 * DM;
        }
        __syncthreads();
        if (valid == 64) {
            const int kr = tid >> 4, nc = (tid & 15) * 4;
#pragma unroll
            for (int ps = 0; ps < 2; ++ps) { const int k = kr + ps * 32; const f32x4 v = *(const f32x4*)(src + (size_t)(k0 + k) * ld + c0 + nc);
                tile[k * 65 + nc] = v[0]; tile[k * 65 + nc + 1] = v[1]; tile[k * 65 + nc + 2] = v[2]; tile[k * 65 + nc + 3] = v[3]; }
        } else {
            for (int e = tid; e < 4096; e += 512) { const int k = e >> 6, n = e & 63; tile[k * 65 + n] = (n < valid) ? src[(size_t)(k0 + k) * ld + c0 + n] : 0.f; }
        }
        __syncthreads();
        { const int nr = tid >> 3, kc = (tid & 7) * 8; u32x4 w;
          w.x = cvt_pk_bf16(tile[(kc + 0) * 65 + nr], tile[(kc + 1) * 65 + nr]); w.y = cvt_pk_bf16(tile[(kc + 2) * 65 + nr], tile[(kc + 3) * 65 + nr]);
          w.z = cvt_pk_bf16(tile[(kc + 4) * 65 + nr], tile[(kc + 5) * 65 + nr]); w.w = cvt_pk_bf16(tile[(kc + 6) * 65 + nr], tile[(kc + 7) * 65 + nr]);
          *(u32x4*)(dst + (size_t)nr * DM + k0 + kc) = w; }
    }
    __syncthreads();
}

__device__ void phase_rmsnorm(const float* x, const float* g, bf16_t* xn, float* outf) {
    const int tid_ = opaque_tid(); const int lane = tid_ & 63, wv = tid_ >> 6;
    f32x4 gv[4];
#pragma unroll
    for (int q = 0; q < 4; ++q) gv[q] = *(const f32x4*)(g + q * 256 + lane * 4);
    for (int row = blockIdx.x * 8 + wv; row < T_TOK; row += gridDim.x * 8) {
        const float* xr = x + (size_t)row * DM; f32x4 v[4]; float ss = 0.f;
#pragma unroll
        for (int q = 0; q < 4; ++q) { v[q] = *(const f32x4*)(xr + q * 256 + lane * 4); ss += v[q][0] * v[q][0] + v[q][1] * v[q][1] + v[q][2] * v[q][2] + v[q][3] * v[q][3]; }
#pragma unroll
        for (int o = 32; o > 0; o >>= 1) ss += __shfl_xor(ss, o);
        const float rinv = rsqrtf(ss * (1.0f / DM) + EPS);
#pragma unroll
        for (int q = 0; q < 4; ++q) { const f32x4 o = v[q] * rinv * gv[q];
            if (xn) { u32x2 w; w.x = cvt_pk_bf16(o[0], o[1]); w.y = cvt_pk_bf16(o[2], o[3]); *(u32x2*)(xn + (size_t)row * DM + q * 256 + lane * 4) = w; }
            else *(f32x4*)(outf + (size_t)row * DM + q * 256 + lane * 4) = o; }
    }
}

template <int CTRL> __device__ __forceinline__ float dpp_f(float v) { return __int_as_float(__builtin_amdgcn_update_dpp(0, __float_as_int(v), CTRL, 0xf, 0xf, false)); }
__device__ __forceinline__ float red8(float v) { v += dpp_f<0xB1>(v); v += dpp_f<0x4E>(v); v += dpp_f<0x141>(v); return v; }
__device__ __forceinline__ float red16(float v) { v = red8(v); v += dpp_f<0x140>(v); return v; }

struct RwRaw { u32x4 cw[2], pw[2], ca[2], pa[2], vl; u32x2 cr[2], pr[2], ck[2], pk[2], cv, pv, vf; };
__device__ __forceinline__ void rw_load(RwRaw& R, const bf16_t* H, const bf16_t* vfp, int l, size_t tok, bool hasp, int h, int chh, int vnt, int fq) {
    const bf16_t* cur = H + tok * LDA_H; const bf16_t* prev = cur - LDA_H;
    const u32x4 z4 = {0u, 0u, 0u, 0u}; const u32x2 z2 = {0u, 0u};
#pragma unroll
    for (int ks = 0; ks < 2; ++ks) { const int m0 = ks * 32 + fq * 8;
        R.cw[ks] = *(const u32x4*)(cur + 3072 + m0); R.ca[ks] = *(const u32x4*)(cur + 3136 + m0);
        R.pw[ks] = hasp ? *(const u32x4*)(prev + 3072 + m0) : z4; R.pa[ks] = hasp ? *(const u32x4*)(prev + 3136 + m0) : z4; }
#pragma unroll
    for (int q = 0; q < 2; ++q) { const int cb = h * 64 + (chh * 2 + q) * 16 + fq * 4;
        R.cr[q] = *(const u32x2*)(cur + cb); R.ck[q] = *(const u32x2*)(cur + 1024 + cb);
        R.pr[q] = hasp ? *(const u32x2*)(prev + cb) : z2; R.pk[q] = hasp ? *(const u32x2*)(prev + 1024 + cb) : z2; }
    const int cbv = h * 64 + vnt * 16 + fq * 4;
    R.cv = *(const u32x2*)(cur + 2048 + cbv); R.pv = hasp ? *(const u32x2*)(prev + 2048 + cbv) : z2;
    R.vf = z2; R.vl = z4;
    if (l > 0) { R.vf = *(const u32x2*)(vfp + tok * DM + cbv); R.vl = *(const u32x4*)(cur + 4224 + fq * 8); }
}

__device__ void phase_rwkv(int l, unsigned char* smem, bf16_t* oalt) {
    const Params p = load_params();
    constexpr int TC = 32, NCH = SEQ / TC, BUFSZ = 5 * TC * 64 + TC * 32 + TC * 2;
    bf16_t* w2T = (bf16_t*)smem;
    bf16_t* a2T = w2T + 64 * 72;
    bf16_t* v2T = a2T + 64 * 72;
    float* cst = (float*)(v2T + 64 * 40);
    float* buf0 = cst + 11 * 64;
    float* ybuf = buf0 + 2 * BUFSZ;
    const int tid = opaque_tid(), wid = __builtin_amdgcn_readfirstlane(tid >> 6), lane = tid & 63, fr = lane & 15, fq = lane >> 4;
    for (int item = blockIdx.x; item < NB * 32; item += gridDim.x) {
        const int b = item >> 5, h = (item >> 1) & 15, half = item & 1;
        __syncthreads();
        for (int e = tid; e < 4096; e += 512) { const int m = e >> 6, j = e & 63; w2T[j * 72 + m] = f2bf(p.w_w2[((size_t)l * 64 + m) * DM + h * 64 + j]); a2T[j * 72 + m] = f2bf(p.a_w2[((size_t)l * 64 + m) * DM + h * 64 + j]); }
        if (l > 0) for (int e = tid; e < 2048; e += 512) { const int m = e >> 6, j = e & 63; v2T[j * 40 + m] = f2bf(p.v_w2[((size_t)(l - 1) * 32 + m) * DM + h * 64 + j]); }
        if (tid < 64) { const float* mu = p.mu + (size_t)l * 3200; const int cc = h * 64 + tid;
            cst[tid] = mu[cc]; cst[64 + tid] = mu[1024 + cc]; cst[128 + tid] = mu[2048 + cc]; cst[192 + tid] = p.w0[l * DM + cc]; cst[256 + tid] = p.a0[l * DM + cc];
            cst[320 + tid] = (l > 0) ? p.v0[(l - 1) * DM + cc] : 0.f; cst[384 + tid] = p.k_k[l * DM + cc]; cst[448 + tid] = p.k_a[l * DM + cc]; cst[512 + tid] = p.r_k[l * DM + cc];
            cst[576 + tid] = mu[3072 + tid]; cst[640 + tid] = mu[3136 + tid]; }
        __syncthreads();
        f32x2 st[4];
#pragma unroll
        for (int j = 0; j < 4; ++j) st[j] = (f32x2){0.f, 0.f};
        const int si = tid >> 3, seg = tid & 7;
        const int pwv = wid - 4, tti = pwv & 1, chh = (pwv >> 1) & 1, vnt = half * 2 + chh, tt = tti * 16 + fr;
        RwRaw raw;
        if (wid >= 4) rw_load(raw, p.H, p.vf, l, (size_t)b * SEQ + tt, tt > 0, h, chh, vnt, fq);
        for (int c = -1; c < NCH; ++c) {
            if (wid >= 4 && c + 1 < NCH) {
                float* B_ = buf0 + ((c + 1) & 1) * BUFSZ;
                float* sR = B_; float* sW = sR + TC * 64; float* sK = sW + TC * 64; float* sA = sK + TC * 64; float* sB = sA + TC * 64; float* sV = sB + TC * 64; float* sS = sV + TC * 32;
                const size_t tok = (size_t)b * SEQ + (c + 1) * TC + tt;
                const RwRaw cr_ = raw;
                if (c + 2 < NCH) rw_load(raw, p.H, p.vf, l, tok + TC, true, h, chh, vnt, fq);
                bf16x8 AfW[2], AfA[2];
#pragma unroll
                for (int ks = 0; ks < 2; ++ks) { const int m0 = ks * 32 + fq * 8;
                    const f32x4 mw0 = *(const f32x4*)(cst + 576 + m0), mw1 = *(const f32x4*)(cst + 576 + m0 + 4), ma0 = *(const f32x4*)(cst + 640 + m0), ma1 = *(const f32x4*)(cst + 640 + m0 + 4);
                    const float muw[8] = {mw0[0], mw0[1], mw0[2], mw0[3], mw1[0], mw1[1], mw1[2], mw1[3]}, mua[8] = {ma0[0], ma0[1], ma0[2], ma0[3], ma1[0], ma1[1], ma1[2], ma1[3]};
                    const unsigned cwv[4] = {cr_.cw[ks].x, cr_.cw[ks].y, cr_.cw[ks].z, cr_.cw[ks].w}, pwq[4] = {cr_.pw[ks].x, cr_.pw[ks].y, cr_.pw[ks].z, cr_.pw[ks].w};
                    const unsigned cav[4] = {cr_.ca[ks].x, cr_.ca[ks].y, cr_.ca[ks].z, cr_.ca[ks].w}, pav[4] = {cr_.pa[ks].x, cr_.pa[ks].y, cr_.pa[ks].z, cr_.pa[ks].w};
                    unsigned ow[4], oa[4];
#pragma unroll
                    for (int e = 0; e < 4; ++e) {
                        const float c0 = bflo(cwv[e]), c1 = bfhi(cwv[e]), q0 = bflo(pwq[e]), q1 = bfhi(pwq[e]);
                        ow[e] = cvt_pk_bf16(tanh_fast(c0 + muw[2 * e] * (q0 - c0)), tanh_fast(c1 + muw[2 * e + 1] * (q1 - c1)));
                        const float d0 = bflo(cav[e]), d1 = bfhi(cav[e]), r0 = bflo(pav[e]), r1 = bfhi(pav[e]);
                        oa[e] = cvt_pk_bf16(d0 + mua[2 * e] * (r0 - d0), d1 + mua[2 * e + 1] * (r1 - d1)); }
                    AfW[ks] = __builtin_bit_cast(bf16x8, ((u32x4){ow[0], ow[1], ow[2], ow[3]})); AfA[ks] = __builtin_bit_cast(bf16x8, ((u32x4){oa[0], oa[1], oa[2], oa[3]})); }
                f32x4 accW[2], accA[2], accV = (f32x4){0.f, 0.f, 0.f, 0.f};
#pragma unroll
                for (int q = 0; q < 2; ++q) { const int nt = chh * 2 + q; accW[q] = (f32x4){0.f, 0.f, 0.f, 0.f}; accA[q] = (f32x4){0.f, 0.f, 0.f, 0.f};
#pragma unroll
                    for (int ks = 0; ks < 2; ++ks) { const bf16x8 bw = *(const bf16x8*)(w2T + (nt * 16 + fr) * 72 + ks * 32 + fq * 8), ba = *(const bf16x8*)(a2T + (nt * 16 + fr) * 72 + ks * 32 + fq * 8);
                        accW[q] = __builtin_amdgcn_mfma_f32_16x16x32_bf16(bw, AfW[ks], accW[q], 0, 0, 0); accA[q] = __builtin_amdgcn_mfma_f32_16x16x32_bf16(ba, AfA[ks], accA[q], 0, 0, 0); } }
                if (l > 0) { const bf16x8 bv = *(const bf16x8*)(v2T + (vnt * 16 + fr) * 40 + fq * 8); accV = __builtin_amdgcn_mfma_f32_16x16x32_bf16(bv, __builtin_bit_cast(bf16x8, cr_.vl), accV, 0, 0, 0); }
                float ss = 0.f, rk = 0.f;
#pragma unroll
                for (int q = 0; q < 2; ++q) { const int ch0 = (chh * 2 + q) * 16 + fq * 4;
                    const float fr_[4] = {bflo(cr_.cr[q].x), bfhi(cr_.cr[q].x), bflo(cr_.cr[q].y), bfhi(cr_.cr[q].y)}, fpr[4] = {bflo(cr_.pr[q].x), bfhi(cr_.pr[q].x), bflo(cr_.pr[q].y), bfhi(cr_.pr[q].y)};
                    const float fk_[4] = {bflo(cr_.ck[q].x), bfhi(cr_.ck[q].x), bflo(cr_.ck[q].y), bfhi(cr_.ck[q].y)}, fpk[4] = {bflo(cr_.pk[q].x), bfhi(cr_.pk[q].x), bflo(cr_.pk[q].y), bfhi(cr_.pk[q].y)};
                    const f32x4 mur = *(const f32x4*)(cst + ch0), muk = *(const f32x4*)(cst + 64 + ch0), w0v = *(const f32x4*)(cst + 192 + ch0), a0v = *(const f32x4*)(cst + 256 + ch0),
                        kkv = *(const f32x4*)(cst + 384 + ch0), kav = *(const f32x4*)(cst + 448 + ch0), rkv = *(const f32x4*)(cst + 512 + ch0);
                    f32x4 ro, wo, ko, ao, bo;
#pragma unroll
                    for (int e = 0; e < 4; ++e) {
                        const float r = fr_[e] + mur[e] * (fpr[e] - fr_[e]), k = fk_[e] + muk[e] * (fpk[e] - fk_[e]);
                        const float xw = -(w0v[e] + accW[q][e]); const float sp = fmaxf(xw, 0.f) + __logf(1.0f + __expf(-fabsf(xw)));
                        wo[e] = __expf(-__expf(-sp - 0.5f));
                        const float a = sigmoidf_(a0v[e] + accA[q][e]);
                        const float kq = k * kkv[e]; ss += kq * kq; ao[e] = -kq; bo[e] = kq * a;
                        const float km = k * (1.0f + (a - 1.0f) * kav[e]); rk += r * km * rkv[e]; ro[e] = r; ko[e] = km; }
                    *(f32x4*)(sR + tt * 64 + ch0) = ro; *(f32x4*)(sW + tt * 64 + ch0) = wo; *(f32x4*)(sK + tt * 64 + ch0) = ko; *(f32x4*)(sA + tt * 64 + ch0) = ao; *(f32x4*)(sB + tt * 64 + ch0) = bo; }
                ss += __shfl_xor(ss, 16); ss += __shfl_xor(ss, 32); rk += __shfl_xor(rk, 16); rk += __shfl_xor(rk, 32);
                if (fq == 0) { sS[tt * 2 + chh] = ss; if (half == 0) p.rkbuf[(size_t)((b * 16 + h) * 2 + chh) * SEQ + (c + 1) * TC + tt] = rk; }
                { const int ch0 = vnt * 16 + fq * 4, cb = h * 64 + ch0;
                  const float fv_[4] = {bflo(cr_.cv.x), bfhi(cr_.cv.x), bflo(cr_.cv.y), bfhi(cr_.cv.y)}, fpv[4] = {bflo(cr_.pv.x), bfhi(cr_.pv.x), bflo(cr_.pv.y), bfhi(cr_.pv.y)};
                  const f32x4 muv = *(const f32x4*)(cst + 128 + ch0), v0v = *(const f32x4*)(cst + 320 + ch0);
                  f32x4 vo;
#pragma unroll
                  for (int e = 0; e < 4; ++e) vo[e] = fv_[e] + muv[e] * (fpv[e] - fv_[e]);
                  if (l > 0) { const float vfv[4] = {bflo(cr_.vf.x), bfhi(cr_.vf.x), bflo(cr_.vf.y), bfhi(cr_.vf.y)};
#pragma unroll
                      for (int e = 0; e < 4; ++e) vo[e] = vo[e] + (vfv[e] - vo[e]) * sigmoidf_(v0v[e] + accV[e]); }
                  u32x2 w; w.x = cvt_pk_bf16(vo[0], vo[1]); w.y = cvt_pk_bf16(vo[2], vo[3]); *(u32x2*)(p.vf + tok * DM + cb) = w;
                  *(f32x4*)(sV + tt * 32 + chh * 16 + fq * 4) = vo; }
            }
            if (wid < 4 && c >= 0) {
                const float* B_ = buf0 + (c & 1) * BUFSZ;
                const float* sR = B_; const float* sW = sR + TC * 64; const float* sK = sW + TC * 64; const float* sA = sK + TC * 64; const float* sB = sA + TC * 64; const float* sV = sB + TC * 64; const float* sS = sV + TC * 32;
#pragma unroll 2
                for (int s = 0; s < TC; ++s) {
                    const int o = s * 64 + seg * 8;
                    const f32x4 a0 = *(const f32x4*)(sA + o), a1 = *(const f32x4*)(sA + o + 4), w0 = *(const f32x4*)(sW + o), w1 = *(const f32x4*)(sW + o + 4);
                    const f32x4 b0 = *(const f32x4*)(sB + o), b1 = *(const f32x4*)(sB + o + 4), k0 = *(const f32x4*)(sK + o), k1 = *(const f32x4*)(sK + o + 4);
                    const f32x4 r0 = *(const f32x4*)(sR + o), r1 = *(const f32x4*)(sR + o + 4);
                    const float vi = sV[s * 32 + si]; const f32x2 ps = *(const f32x2*)(sS + s * 2);
                    const float inv2 = __builtin_amdgcn_rcpf(fmaxf(ps.x + ps.y, 1e-24f));
                    const f32x2 av[4] = {{a0[0], a0[1]}, {a0[2], a0[3]}, {a1[0], a1[1]}, {a1[2], a1[3]}}, wv[4] = {{w0[0], w0[1]}, {w0[2], w0[3]}, {w1[0], w1[1]}, {w1[2], w1[3]}};
                    const f32x2 bv[4] = {{b0[0], b0[1]}, {b0[2], b0[3]}, {b1[0], b1[1]}, {b1[2], b1[3]}}, kv[4] = {{k0[0], k0[1]}, {k0[2], k0[3]}, {k1[0], k1[1]}, {k1[2], k1[3]}};
                    const f32x2 rv[4] = {{r0[0], r0[1]}, {r0[2], r0[3]}, {r1[0], r1[1]}, {r1[2], r1[3]}};
                    const f32x2 vi2 = {vi, vi};
                    f32x2 vk[4];
#pragma unroll
                    for (int j = 0; j < 4; ++j) vk[j] = vi2 * kv[j];
                    const f32x2 pa = st[0] * av[0] + st[1] * av[1], pb = st[2] * av[2] + st[3] * av[3]; const f32x2 pc = pa + pb;
                    const float sa = red8(pc.x + pc.y) * inv2;
                    const f32x2 sa2 = {sa, sa};
#pragma unroll
                    for (int j = 0; j < 4; ++j) st[j] = st[j] * wv[j] + (sa2 * bv[j] + vk[j]);
                    const f32x2 qa = st[0] * rv[0] + st[1] * rv[1], qb = st[2] * rv[2] + st[3] * rv[3]; const f32x2 qc = qa + qb;
                    const float yy = red8(qc.x + qc.y);
                    if (seg == 0) ybuf[s * 32 + si] = yy;
                }
                { const int tk = lane >> 1, rq = (lane & 1) * 4; const f32x4 yv = *(const f32x4*)(ybuf + tk * 32 + wid * 8 + rq);
                  u32x2 w; w.x = cvt_pk_bf16(yv[0], yv[1]); w.y = cvt_pk_bf16(yv[2], yv[3]);
                  *(u32x2*)(p.y + ((size_t)b * SEQ + c * TC + tk) * DM + h * 64 + half * 32 + wid * 8 + rq) = w; }
            }
            __syncthreads();
        }
    }
    __syncthreads();
}

__device__ void phase_rwkv_post(int l, bf16_t* oalt) {
    const Params p = load_params();
    const int tid = opaque_tid(), l8 = tid & 7;
    const int ngrp = T_TOK * 16;
    for (int g = blockIdx.x * 64 + (tid >> 3); g < ngrp; g += gridDim.x * 64) {
        const int tok = g >> 4, h = g & 15, cb = h * 64 + l8 * 8;
        const u32x4 y4 = *(const u32x4*)(p.y + (size_t)tok * DM + cb), b4 = *(const u32x4*)(p.vf + (size_t)tok * DM + cb);
        const int bb = tok / SEQ, tq = tok % SEQ; const float rk = p.rkbuf[(size_t)((bb * 16 + h) * 2) * SEQ + tq] + p.rkbuf[(size_t)((bb * 16 + h) * 2 + 1) * SEQ + tq];
        bf16_t* zp = p.H + (size_t)tok * LDA_H + 3200 + cb; const u32x4 z4 = *(const u32x4*)zp;
        const float yv[8] = {bflo(y4.x), bfhi(y4.x), bflo(y4.y), bfhi(y4.y), bflo(y4.z), bfhi(y4.z), bflo(y4.w), bfhi(y4.w)};
        const float bv[8] = {bflo(b4.x), bfhi(b4.x), bflo(b4.y), bfhi(b4.y), bflo(b4.z), bfhi(b4.z), bflo(b4.w), bfhi(b4.w)};
        const float zv[8] = {bflo(z4.x), bfhi(z4.x), bflo(z4.y), bfhi(z4.y), bflo(z4.z), bfhi(z4.z), bflo(z4.w), bfhi(z4.w)};
        float sm = 0.f;
#pragma unroll
        for (int e = 0; e < 8; ++e) sm += yv[e];
        sm = red8(sm); const float mean = sm * (1.0f / 64.f); float d[8], vs = 0.f;
#pragma unroll
        for (int e = 0; e < 8; ++e) { d[e] = yv[e] - mean; vs += d[e] * d[e]; }
        vs = red8(vs); const float rstd = rsqrtf(vs * (1.0f / 64.f) + GN_EPS);
        const f32x4 g0 = *(const f32x4*)(p.lnx_g + l * DM + cb), g1 = *(const f32x4*)(p.lnx_g + l * DM + cb + 4), c0 = *(const f32x4*)(p.lnx_b + l * DM + cb), c1 = *(const f32x4*)(p.lnx_b + l * DM + cb + 4);
        const float gg[8] = {g0[0], g0[1], g0[2], g0[3], g1[0], g1[1], g1[2], g1[3]}, cc[8] = {c0[0], c0[1], c0[2], c0[3], c1[0], c1[1], c1[2], c1[3]};
        float o[8];
#pragma unroll
        for (int e = 0; e < 8; ++e) o[e] = (d[e] * rstd * gg[e] + cc[e] + rk * bv[e]) * siluf_(zv[e]);
        u32x4 w; w.x = cvt_pk_bf16(o[0], o[1]); w.y = cvt_pk_bf16(o[2], o[3]); w.z = cvt_pk_bf16(o[4], o[5]); w.w = cvt_pk_bf16(o[6], o[7]);
        *(u32x4*)(oalt ? oalt + (size_t)tok * DM + cb : zp) = w;
    }
}

__device__ void phase_sgu(int l, unsigned char* smem, bf16_t* oalt) {
    const Params p = load_params();
    bf16_t* vnT = (bf16_t*)smem;
    float* stat = (float*)(smem + 128 * 136 * 2);
    const int tid = opaque_tid(), wid = tid >> 6, lane = tid & 63, fr = lane & 15, fq = lane >> 4;
    const float* lng = p.sgu_ln_g + (size_t)l * DM; const float* lnb = p.sgu_ln_b + (size_t)l * DM;
    for (int item = blockIdx.x; item < T_TOK / 128; item += gridDim.x) {
        bf16_t* Hb = p.H + (size_t)item * 128 * LDB_H;
        __syncthreads();
        for (int q = 0; q < 16; ++q) { const int s = wid * 16 + q; const bf16_t* vr = Hb + (size_t)s * LDB_H + 1024 + lane * 16;
            const u32x4 a = *(const u32x4*)vr, bq = *(const u32x4*)(vr + 8);
            const float f[16] = {bflo(a.x), bfhi(a.x), bflo(a.y), bfhi(a.y), bflo(a.z), bfhi(a.z), bflo(a.w), bfhi(a.w), bflo(bq.x), bfhi(bq.x), bflo(bq.y), bfhi(bq.y), bflo(bq.z), bfhi(bq.z), bflo(bq.w), bfhi(bq.w)};
            float sm = 0.f;
#pragma unroll
            for (int e = 0; e < 16; ++e) sm += f[e];
#pragma unroll
            for (int o = 32; o > 0; o >>= 1) sm += __shfl_xor(sm, o);
            const float mean = sm * (1.0f / DM); float vs = 0.f;
#pragma unroll
            for (int e = 0; e < 16; ++e) { const float d = f[e] - mean; vs += d * d; }
#pragma unroll
            for (int o = 32; o > 0; o >>= 1) vs += __shfl_xor(vs, o);
            if (lane == 0) { stat[s * 2] = mean; stat[s * 2 + 1] = rsqrtf(vs * (1.0f / DM) + EPS); } }
        __syncthreads();
        for (int g = 0; g < 8; ++g) {
            { const int s = tid >> 2, c0 = (tid & 3) * 32; const float mean = stat[s * 2], rstd = stat[s * 2 + 1];
              const bf16_t* vr = Hb + (size_t)s * LDB_H + 1024 + g * 128 + c0;
#pragma unroll
              for (int q = 0; q < 4; ++q) { const u32x4 a = *(const u32x4*)(vr + q * 8); const float f[8] = {bflo(a.x), bfhi(a.x), bflo(a.y), bfhi(a.y), bflo(a.z), bfhi(a.z), bflo(a.w), bfhi(a.w)};
#pragma unroll
                  for (int e = 0; e < 8; ++e) { const int c = c0 + q * 8 + e; const float vn = (f[e] - mean) * rstd * lng[g * 128 + c] + lnb[g * 128 + c]; vnT[c * 136 + s] = f2bf(vn); } } }
            __syncthreads();
            f32x4 acc[8];
#pragma unroll
            for (int i = 0; i < 8; ++i) acc[i] = (f32x4){0.f, 0.f, 0.f, 0.f};
            const int trow = wid * 16 + fr;
            const float* Wg = p.sgu_w + (((size_t)l * 8 + g) * 128 + trow) * 128;
            const int nks = (wid < 4) ? 2 : 4;
            for (int ks = 0; ks < nks; ++ks) {
                const f32x4 wa = *(const f32x4*)(Wg + ks * 32 + fq * 8), wb = *(const f32x4*)(Wg + ks * 32 + fq * 8 + 4);
                u32x4 wp; wp.x = cvt_pk_bf16(wa[0], wa[1]); wp.y = cvt_pk_bf16(wa[2], wa[3]); wp.z = cvt_pk_bf16(wb[0], wb[1]); wp.w = cvt_pk_bf16(wb[2], wb[3]);
                const bf16x8 wfrag = __builtin_bit_cast(bf16x8, wp);
#pragma unroll
                for (int ct = 0; ct < 8; ++ct) { const bf16x8 vfrag = *(const bf16x8*)(vnT + (ct * 16 + fr) * 136 + ks * 32 + fq * 8);
                    acc[ct] = __builtin_amdgcn_mfma_f32_16x16x32_bf16(vfrag, wfrag, acc[ct], 0, 0, 0); }
            }
            { const float bs = p.sgu_b[((size_t)l * 8 + g) * 128 + trow]; bf16_t* hr = Hb + (size_t)trow * LDB_H;
#pragma unroll
              for (int ct = 0; ct < 8; ++ct) { const int c = g * 128 + ct * 16 + fq * 4;
                  const u32x2 u2 = *(const u32x2*)(hr + c), z2 = *(const u32x2*)(hr + 2048 + c);
                  const float uf[4] = {bflo(u2.x), bfhi(u2.x), bflo(u2.y), bfhi(u2.y)}, zf[4] = {bflo(z2.x), bfhi(z2.x), bflo(z2.y), bfhi(z2.y)};
                  float o[4];
#pragma unroll
                  for (int j = 0; j < 4; ++j) o[j] = uf[j] * (acc[ct][j] + bs) * siluf_(zf[j]);
                  u32x2 w; w.x = cvt_pk_bf16(o[0], o[1]); w.y = cvt_pk_bf16(o[2], o[3]); *(u32x2*)(oalt ? oalt + ((size_t)item * 128 + trow) * DM + c : hr + 2048 + c) = w; } }
            __syncthreads();
        }
    }
    __syncthreads();
}

__device__ void phase_hgrn(int l, unsigned char* smem, bf16_t* oalt) {
    const Params p = load_params();
    constexpr int LQ = 136, LS = 72;
    bf16_t* Qm = (bf16_t*)smem;
    bf16_t* Km = Qm + 64 * LQ;
    bf16_t* Qs = Km + 64 * LQ;
    bf16_t* KsT = Qs + 64 * LQ;
    bf16_t* IT = KsT + 128 * LS;
    bf16_t* att = IT + 128 * LS;
    bf16_t* ST = att + 64 * LS;
    float* psum = (float*)(ST + 128 * LQ);
    float* dec = psum + 512;
    float* obuf = (float*)smem;
    const int tid = opaque_tid(), wid = tid >> 6, lane = tid & 63, fr = lane & 15, fq = lane >> 4;
    const int c = tid & 127, tq = tid >> 7;
    for (int item = blockIdx.x; item < NB * 8; item += gridDim.x) {
        const int b = item >> 3, h = item & 7;
        float lb = 0.f;
        if (l == 1) { const float l0 = p.lb_logits[h * 128 + c], l1 = p.lb_logits[DM + h * 128 + c]; lb = 1.0f / (1.0f + __expf(l0 - l1)); }
        __syncthreads();
        for (int e = tid; e < 128 * LQ / 2; e += 512) ((unsigned*)ST)[e] = 0u;
        f32x4 S[8];
#pragma unroll
        for (int i = 0; i < 8; ++i) S[i] = (f32x4){0.f, 0.f, 0.f, 0.f};
        for (int ch = 0; ch < SEQ / 64; ++ch) {
            bf16_t* Hc = p.H + ((size_t)b * SEQ + ch * 64) * LDC_H + h * 128;
            {
                float qv[16], kv[16], bl[16]; u32x4 ip[2]; float run = 0.f;
                unsigned ipk[8];
#pragma unroll
                for (int tt = 0; tt < 16; ++tt) { const bf16_t* hr = Hc + (size_t)(tq * 16 + tt) * LDC_H + c;
                    const float q = bf2f(hr[0]), f = bf2f(hr[1024]); const bf16_t iv = hr[2048];
                    qv[tt] = siluf_(q); const float fg = lb + (1.0f - lb) * sigmoidf_(f); kv[tt] = 1.0f - fg; run += __logf(fg); bl[tt] = run;
                    if (tt & 1) ipk[tt >> 1] |= ((unsigned)iv) << 16; else ipk[tt >> 1] = (unsigned)iv; }
                ip[0] = (u32x4){ipk[0], ipk[1], ipk[2], ipk[3]}; ip[1] = (u32x4){ipk[4], ipk[5], ipk[6], ipk[7]};
                psum[tq * 128 + c] = run;
                __syncthreads();
                const float p0 = psum[c], p1 = psum[128 + c], p2 = psum[256 + c], p3 = psum[384 + c];
                const float off = (tq > 0 ? p0 : 0.f) + (tq > 1 ? p1 : 0.f) + (tq > 2 ? p2 : 0.f);
                const float bmid = p0 + p1, blast = p0 + p1 + p2 + p3;
                if (tq == 0) dec[c] = __expf(blast);
                unsigned ks[8];
#pragma unroll
                for (int tt = 0; tt < 16; ++tt) { const float bb = bl[tt] + off; const int t = tq * 16 + tt;
                    Qm[t * LQ + c] = f2bf(qv[tt] * __expf(bb - bmid)); Km[t * LQ + c] = f2bf(kv[tt] * __expf(bmid - bb)); Qs[t * LQ + c] = f2bf(qv[tt] * __expf(bb));
                    const float kx = kv[tt] * __expf(blast - bb);
                    if (tt & 1) ks[tt >> 1] |= ((unsigned)f2bf(kx)) << 16; else ks[tt >> 1] = (unsigned)f2bf(kx); }
                *(u32x4*)(KsT + c * LS + tq * 16) = (u32x4){ks[0], ks[1], ks[2], ks[3]}; *(u32x4*)(KsT + c * LS + tq * 16 + 8) = (u32x4){ks[4], ks[5], ks[6], ks[7]};
                *(u32x4*)(IT + c * LS + tq * 16) = ip[0]; *(u32x4*)(IT + c * LS + tq * 16 + 8) = ip[1];
            }
            __syncthreads();
            {
                const int ttile = wid >> 1;
#pragma unroll
                for (int q = 0; q < 2; ++q) { const int stile = (wid & 1) * 2 + q; f32x4 a = (f32x4){0.f, 0.f, 0.f, 0.f};
                    if (stile <= ttile) {
#pragma unroll
                        for (int ks = 0; ks < 4; ++ks) { const bf16x8 af = *(const bf16x8*)(Qm + (ttile * 16 + fr) * LQ + ks * 32 + fq * 8), bfr = *(const bf16x8*)(Km + (stile * 16 + fr) * LQ + ks * 32 + fq * 8);
                            a = __builtin_amdgcn_mfma_f32_16x16x32_bf16(af, bfr, a, 0, 0, 0); } }
#pragma unroll
                    for (int j = 0; j < 4; ++j) { const int t = ttile * 16 + fq * 4 + j, s = stile * 16 + fr; att[t * LS + s] = f2bf(s <= t ? a[j] : 0.f); } }
            }
            __syncthreads();
            {
                const int ttile = wid >> 1; f32x4 o[4];
#pragma unroll
                for (int q = 0; q < 4; ++q) o[q] = (f32x4){0.f, 0.f, 0.f, 0.f};
#pragma unroll
                for (int ks = 0; ks < 2; ++ks) { const bf16x8 af = *(const bf16x8*)(att + (ttile * 16 + fr) * LS + ks * 32 + fq * 8);
#pragma unroll
                    for (int q = 0; q < 4; ++q) { const int vt = (wid & 1) * 4 + q; const bf16x8 bfr = *(const bf16x8*)(IT + (vt * 16 + fr) * LS + ks * 32 + fq * 8);
                        o[q] = __builtin_amdgcn_mfma_f32_16x16x32_bf16(bfr, af, o[q], 0, 0, 0); } }
#pragma unroll
                for (int ks = 0; ks < 4; ++ks) { const bf16x8 af = *(const bf16x8*)(Qs + (ttile * 16 + fr) * LQ + ks * 32 + fq * 8);
#pragma unroll
                    for (int q = 0; q < 4; ++q) { const int vt = (wid & 1) * 4 + q; const bf16x8 bfr = *(const bf16x8*)(ST + (vt * 16 + fr) * LQ + ks * 32 + fq * 8);
                        o[q] = __builtin_amdgcn_mfma_f32_16x16x32_bf16(bfr, af, o[q], 0, 0, 0); } }
#pragma unroll
                for (int q = 0; q < 4; ++q) { const int vt = (wid & 1) * 4 + q; *(f32x4*)(obuf + (ttile * 16 + fr) * 132 + vt * 16 + fq * 4) = o[q]; }
            }
            {
                float dk[4];
#pragma unroll
                for (int j = 0; j < 4; ++j) dk[j] = dec[wid * 16 + fq * 4 + j];
#pragma unroll
                for (int vt = 0; vt < 8; ++vt)
#pragma unroll
                    for (int j = 0; j < 4; ++j) S[vt][j] *= dk[j];
#pragma unroll
                for (int ks = 0; ks < 2; ++ks) { const bf16x8 af = *(const bf16x8*)(KsT + (wid * 16 + fr) * LS + ks * 32 + fq * 8);
#pragma unroll
                    for (int vt = 0; vt < 8; ++vt) { const bf16x8 bfr = *(const bf16x8*)(IT + (vt * 16 + fr) * LS + ks * 32 + fq * 8);
                        S[vt] = __builtin_amdgcn_mfma_f32_16x16x32_bf16(af, bfr, S[vt], 0, 0, 0); } }
            }
            __syncthreads();
#pragma unroll
            for (int vt = 0; vt < 8; ++vt) { u32x2 w; w.x = cvt_pk_bf16(S[vt][0], S[vt][1]); w.y = cvt_pk_bf16(S[vt][2], S[vt][3]); *(u32x2*)(ST + (vt * 16 + fr) * LQ + wid * 16 + fq * 4) = w; }
            {
                const int t = tid >> 3, v0 = (tid & 7) * 16; float ov[16], ss = 0.f;
#pragma unroll
                for (int q = 0; q < 4; ++q) { const f32x4 x = *(const f32x4*)(obuf + t * 132 + v0 + q * 4); ov[q * 4] = x[0]; ov[q * 4 + 1] = x[1]; ov[q * 4 + 2] = x[2]; ov[q * 4 + 3] = x[3]; ss += x[0] * x[0] + x[1] * x[1] + x[2] * x[2] + x[3] * x[3]; }
                ss = red8(ss); const float rinv = rsqrtf(ss * (1.0f / 128.f) + EPS);
                bf16_t* zr = Hc + (size_t)t * LDC_H + 3072 + v0; const float* gn = p.hgrn_g + (size_t)l * DM + h * 128 + v0;
                const u32x4 z0 = *(const u32x4*)zr, z1 = *(const u32x4*)(zr + 8);
                const float zf[16] = {bflo(z0.x), bfhi(z0.x), bflo(z0.y), bfhi(z0.y), bflo(z0.z), bfhi(z0.z), bflo(z0.w), bfhi(z0.w), bflo(z1.x), bfhi(z1.x), bflo(z1.y), bfhi(z1.y), bflo(z1.z), bfhi(z1.z), bflo(z1.w), bfhi(z1.w)};
                float r[16];
#pragma unroll
                for (int e = 0; e < 16; ++e) r[e] = ov[e] * rinv * gn[e] * siluf_(zf[e]);
                u32x4 w0, w1; w0.x = cvt_pk_bf16(r[0], r[1]); w0.y = cvt_pk_bf16(r[2], r[3]); w0.z = cvt_pk_bf16(r[4], r[5]); w0.w = cvt_pk_bf16(r[6], r[7]);
                w1.x = cvt_pk_bf16(r[8], r[9]); w1.y = cvt_pk_bf16(r[10], r[11]); w1.z = cvt_pk_bf16(r[12], r[13]); w1.w = cvt_pk_bf16(r[14], r[15]);
                bf16_t* zo = oalt ? oalt + ((size_t)b * SEQ + ch * 64 + t) * DM + h * 128 + v0 : zr; *(u32x4*)zo = w0; *(u32x4*)(zo + 8) = w1;
            }
        }
    }
    __syncthreads();
}

constexpr int PH_PER_LAYER = 12, N_PHASES = 2 * PH_PER_LAYER + 1;

__global__ void __launch_bounds__(512, 2) fwd_megakernel(Params pk) {
    extern __shared__ __attribute__((aligned(16))) unsigned char shm[];
    LAS unsigned char* lds = (LAS unsigned char*)shm;
    cg::grid_group grid = cg::this_grid();
    const int phase_lo = pk.phase_lo, phase_hi = pk.phase_hi;
    for (int ph = phase_lo; ph < phase_hi; ++ph) {
        const int l = ph / PH_PER_LAYER, q = ph % PH_PER_LAYER;
        if (ph == N_PHASES - 1) {
            const Params p = load_params();
            phase_rmsnorm(p.out, p.final_g, nullptr, p.out);
        } else if (q == 0) {
            phase_convert(l, shm);
            const Params p = load_params();
            phase_rmsnorm(l == 0 ? p.x : p.out, p.norm_g + (size_t)l * DM, p.xn, nullptr);
        } else if (q == 1 || q == 5 || q == 8) {
            const Params p = load_params(); const int G = gridDim.x, cidx = opaque_bid();
            const int N = (q == 1) ? LDA_H : (q == 5) ? LDB_H : LDC_H; const int r0 = (q == 1) ? 0 : (q == 5) ? LDA_H : (LDA_H + LDB_H);
            pg8::GemmDesc g; g.A = p.xn; g.Bt = p.Wt + (size_t)r0 * DM; g.lda = DM;
            pg8::Sched S; S.init(T_TOK, N, G, cidx, 1);
            pg8::EpiStore E; E.O = p.H; E.ldc = N;
{ const int nrep = (PROBE_Q == 1 && l == 0 && q == 1) ? 2 : 1; for (int rep = 0; rep < nrep; ++rep) pg8::gemm_phase(lds, g, g, S, E); }
        } else if (q == 2) {
{ const int nrep = (PROBE_Q == 2 && l == 0) ? 2 : 1; for (int rep = 0; rep < nrep; ++rep) phase_rwkv(l, shm, nullptr); }
        } else if (q == 3) {
            phase_rwkv_post(l, nullptr);
        } else if (q == 6) {
{ const int nrep = (PROBE_Q == 6 && l == 0) ? 2 : 1; for (int rep = 0; rep < nrep; ++rep) { const Params p = load_params(); phase_sgu(l, shm, rep + 1 < nrep ? (bf16_t*)p.out : nullptr); } }
        } else if (q == 9) {
{ const int nrep = (PROBE_Q == 9 && l == 0) ? 2 : 1; for (int rep = 0; rep < nrep; ++rep) { const Params p = load_params(); phase_hgrn(l, shm, rep + 1 < nrep ? (bf16_t*)p.out : nullptr); } }
        } else if (q == 4 || q == 7 || q == 10) {
            const Params p = load_params(); const int G = gridDim.x, cidx = opaque_bid();
            bf16_t* WtBr = p.Wt + (size_t)WT_ROWS * DM;
            const int n = (q - 4) / 3; const int ldh = (n == 0) ? LDA_H : (n == 1) ? LDB_H : LDC_H; const int ocol = (n == 0) ? 3200 : (n == 1) ? 2048 : 3072;
            pg8::GemmDesc g0, g1; g0.A = p.xn; g0.Bt = p.Wt + (size_t)(LDA_H + LDB_H + LDC_H + n * DM) * DM; g0.lda = DM;
            g1.A = p.H + ocol; g1.Bt = WtBr + (size_t)n * DM * DM; g1.lda = ldh;
            pg8::Sched S; S.init(T_TOK, DM, G, cidx, 2);
            pg8::EpiMerge E; E.G = p.H; E.ldg = ldh; E.bias = p.b_merge + ((size_t)l * 3 + n) * DM; E.Y = p.y; E.accum = (n > 0);
            pg8::gemm_phase(lds, g0, g1, S, E);
        } else {
            const Params p = load_params(); const int G = gridDim.x, cidx = opaque_bid();
            bf16_t* WtOut = p.Wt + (size_t)WT_ROWS * DM + (size_t)3 * DM * DM;
            pg8::GemmDesc g; g.A = p.y; g.Bt = WtOut; g.lda = DM;
            pg8::Sched S; S.init(T_TOK, DM, G, cidx, 1);
            pg8::EpiResid E; E.Xin = (l == 0) ? p.x : p.out; E.Xout = p.out;
            pg8::gemm_phase(lds, g, g, S, E);
        }
        if (ph + 1 < phase_hi) grid.sync();
    }
}

extern "C" void kernel_launch(void* const* d_in, const int* in_sizes, int n_in, void* d_out, int out_size, void* d_ws, size_t ws_size, hipStream_t stream) {
    static int grid_blocks = 0;
    if (!grid_blocks) {
        int dev = 0, cus = 0, per_cu = 0;
        hipGetDevice(&dev);
        hipDeviceGetAttribute(&cus, hipDeviceAttributeMultiprocessorCount, dev);
        if (hipFuncSetAttribute((const void*)fwd_megakernel, hipFuncAttributeMaxDynamicSharedMemorySize, LDS_BYTES) != hipSuccess) { fprintf(stderr, "hipFuncSetAttribute failed\n"); return; }
        hipOccupancyMaxActiveBlocksPerMultiprocessor(&per_cu, (const void*)fwd_megakernel, 512, LDS_BYTES);
        if (per_cu < 1) { fprintf(stderr, "occupancy query says 0 blocks per CU\n"); return; }
        grid_blocks = cus * 1;
    }
    Params p{};
    const float** fp = (const float**)&p;
    for (int i = 0; i < 26; ++i) fp[i] = (const float*)d_in[i];
    p.out = (float*)d_out;
    unsigned char* ws = (unsigned char*)d_ws; size_t off = 0;
    auto take = [&](size_t bytes) { unsigned char* r = ws + off; off += (bytes + 255) & ~(size_t)255; return r; };
    p.Wt = (bf16_t*)take(((size_t)WT_ROWS * DM + 4 * (size_t)DM * DM) * 2);
    p.xn = (bf16_t*)take((size_t)T_TOK * DM * 2);
    p.vf = (bf16_t*)take((size_t)T_TOK * DM * 2);
    p.y = (bf16_t*)take((size_t)T_TOK * DM * 2);
    p.H = (bf16_t*)take((size_t)T_TOK * LDA_H * 2);
    p.rkbuf = (float*)take((size_t)T_TOK * 16 * 2 * 4);
    if (off > ws_size) { fprintf(stderr, "workspace too small: need %zu have %zu\n", off, ws_size); return; }
#if SINGLE_LAUNCH
    p.phase_lo = 0; p.phase_hi = N_PHASES;
    void* args[] = {&p};
    hipError_t e = hipLaunchCooperativeKernel((const void*)fwd_megakernel, dim3(grid_blocks), dim3(512), args, LDS_BYTES, stream);
    if (e != hipSuccess) fprintf(stderr, "cooperative launch failed: %s (grid %d)\n", hipGetErrorString(e), grid_blocks);
#else
    for (int ph = 0; ph < N_PHASES; ++ph) {
        p.phase_lo = ph; p.phase_hi = ph + 1;
        hipLaunchKernelGGL(fwd_megakernel, dim3(grid_blocks), dim3(512), LDS_BYTES, stream, p);
    }
#endif
}
```

```cpp
#include <hip/hip_runtime.h>
#include <hip/hip_cooperative_groups.h>
#include <cstdio>
namespace cg = cooperative_groups;

#ifndef PROBE_Q
#define PROBE_Q -1
#endif
#ifndef SINGLE_LAUNCH
#define SINGLE_LAUNCH 1
#endif

typedef unsigned short bf16_t;
typedef short bf16x8 __attribute__((ext_vector_type(8)));
typedef float f32x4 __attribute__((ext_vector_type(4)));
typedef float f32x2 __attribute__((ext_vector_type(2)));
typedef unsigned u32x4 __attribute__((ext_vector_type(4)));
typedef unsigned u32x2 __attribute__((ext_vector_type(2)));
#define LAS __attribute__((address_space(3)))

constexpr int T_TOK = 32768, DM = 1024, SEQ = 4096, NB = 8;
constexpr int N_IN = 14464;
constexpr int LDA_H = 4352, LDB_H = 3072, LDC_H = 4096;
constexpr int WT_ROWS = 14592;
constexpr int LDS_BYTES = 163840;
constexpr float EPS = 1e-6f, GN_EPS = 64e-5f;

struct Params {
    const float *x, *norm_g, *w_in, *b_merge, *mu, *w0, *w_w2, *a0, *a_w2, *v0, *v_w1, *v_w2, *k_k, *k_a, *r_k, *lnx_g, *lnx_b,
        *sgu_ln_g, *sgu_ln_b, *sgu_w, *sgu_b, *lb_logits, *hgrn_g, *w_branch, *w_out, *final_g;
    float* out;
    bf16_t *Wt, *xn, *vf, *y, *H;
    float* rkbuf;
    unsigned* bar;
    int phase_lo, phase_hi;
};

__device__ __forceinline__ float bf2f(bf16_t h) { return __uint_as_float(((unsigned)h) << 16); }
__device__ __forceinline__ float bflo(unsigned u) { return __uint_as_float(u << 16); }
__device__ __forceinline__ float bfhi(unsigned u) { return __uint_as_float(u & 0xffff0000u); }
typedef __bf16 bf16x2_t __attribute__((ext_vector_type(2)));
__device__ __forceinline__ unsigned cvt_pk_bf16(float lo, float hi) { const f32x2 v = {lo, hi}; const bf16x2_t r = __builtin_convertvector(v, bf16x2_t); return __builtin_bit_cast(unsigned, r); }
__device__ __forceinline__ bf16_t f2bf(float f) { return (bf16_t)(cvt_pk_bf16(f, 0.f) & 0xffffu); }
__device__ __forceinline__ float sigmoidf_(float x) { return __builtin_amdgcn_rcpf(1.0f + __expf(-x)); }
__device__ __forceinline__ float siluf_(float x) { return x * __builtin_amdgcn_rcpf(1.0f + __expf(-x)); }
__device__ __forceinline__ float tanh_fast(float x) { return 1.0f - 2.0f * __builtin_amdgcn_rcpf(1.0f + __expf(2.0f * x)); }

__device__ __forceinline__ Params load_params() {
#if defined(__HIP_DEVICE_COMPILE__)
    typedef const Params __attribute__((address_space(4)))* KP;
    KP kp = (KP)__builtin_amdgcn_kernarg_segment_ptr(); asm volatile("" : "+s"(kp)); return *kp;
#else
    return Params{};
#endif
}
__device__ __forceinline__ int opaque_tid() { int t = threadIdx.x; asm volatile("" : "+v"(t)); return t; }
__device__ __forceinline__ int opaque_bid() { int t = blockIdx.x; asm volatile("" : "+s"(t)); return t; }

namespace pg8 {
constexpr int BM = 256, BK = 64, HALF = 128, HTB = HALF * BK * 2, STAGE_BYTES = 8 * HTB, NXCD = 8, WGM = 8, KD = 1024;
__device__ __forceinline__ int lds_byte(int r, int c) { const int st = (r >> 4) * 2 + (c >> 5), rr = r & 15, cc = c & 31, ob = rr * 64 + cc * 2; return st * 1024 + (ob ^ (((ob >> 9) & 1) << 5)); }
__device__ __forceinline__ void stage_rc(int b, int& R, int& C) { const int st = b / 1024, sb = b % 1024, swz = sb ^ (((sb >> 9) & 1) << 5); R = (st >> 1) * 16 + swz / 64; C = (st & 1) * 32 + (swz % 64) / 2; }
__device__ __forceinline__ int perm32(int rho) { const int n = rho >> 4, i = rho & 15; return 8 * (i >> 2) + 4 * n + (i & 3); }

struct Unit { int pm, pn, sel; };
struct GemmDesc { const bf16_t* A; const bf16_t* Bt; int lda; };
struct Sched {
    int nM, nN, nwg, G, c, nsel;
    __device__ void init(int M, int N, int G_, int c_, int nsel_) { nM = M / BM; nN = N / BM; nwg = nM * nN; G = G_; c = c_; nsel = nsel_; }
    __device__ bool next(int i, Unit& u) const {
        const int ti = (nsel == 2) ? (i >> 1) : i; u.sel = (nsel == 2) ? (i & 1) : 0;
        const long L = (long)ti * G + c; if (L >= nwg) return false;
        int wgid = (int)L; { const int q = nwg / NXCD, r = nwg % NXCD, xcd = wgid % NXCD, off = wgid / NXCD; wgid = (xcd < r ? xcd * (q + 1) : r * (q + 1) + (xcd - r) * q) + off; }
        const int nig = WGM * nN, gid = wgid / nig, fm = gid * WGM, gsz = (nM - fm) < WGM ? (nM - fm) : WGM;
        u.pm = fm + ((wgid % nig) % gsz); u.pn = (wgid % nig) / gsz; return true;
    }
};

template <class Epi>
__device__ __forceinline__ void gemm_phase(LAS unsigned char* lds, const GemmDesc g0, const GemmDesc g1, const Sched& S, const Epi& E) {
    const int tid = opaque_tid(), wid = __builtin_amdgcn_readfirstlane(tid >> 6), lane = tid & 63, wr = wid >> 2, wc = wid & 3, fr = lane & 15, fq = lane >> 4;
    constexpr int K = KD, nt = K / BK;
    unsigned voffA0[2], voffA1[2], voffB[2];
#pragma unroll
    for (int i = 0; i < 2; ++i) { int R, C; stage_rc(tid * 16 + i * 8192, R, C); const int Rb = Epi::PERM ? ((R & ~31) + perm32(R & 31)) : R;
        voffA0[i] = (unsigned)(R * g0.lda + C) * 2u; voffA1[i] = (unsigned)(R * g1.lda + C) * 2u; voffB[i] = (unsigned)(Rb * K + C) * 2u; }
    const size_t kstep = (size_t)(BK * 2);
    const size_t hstepB = (size_t)HALF * K * 2;
    const unsigned ldsw = (unsigned)wid * 1024u;
    const int aoff = lds_byte(wr * 64 + fr, fq * 8), boff = lds_byte(wc * 32 + fr, fq * 8);
#define PG8_SA(b, h) (((b) * 2 + (h)) * HTB)
#define PG8_SB(b, h) ((4 + (b) * 2 + (h)) * HTB)
#define PG8_STAGE(bufoff, gbase, v0, v1) do { \
        __builtin_amdgcn_global_load_lds((const unsigned*)((const char*)(gbase) + (v0)), (LAS unsigned*)(lds + (bufoff) + ldsw), 16, 0, 0); \
        __builtin_amdgcn_global_load_lds((const unsigned*)((const char*)(gbase) + (v1)), (LAS unsigned*)(lds + (bufoff) + ldsw + 8192), 16, 0, 0); } while (0)
#define PG8_STAGEB(bufoff, gbase) PG8_STAGE(bufoff, gbase, voffB[0], voffB[1])
#define PG8_LDA(dst, b, h) do { _Pragma("unroll") for (int m = 0; m < 4; ++m) _Pragma("unroll") for (int k = 0; k < 2; ++k) dst[m][k] = *(const LAS bf16x8*)(lds + PG8_SA(b, h) + aoff + m * 2048 + k * 1024); } while (0)
#define PG8_LDB(dst, b, h) do { _Pragma("unroll") for (int n = 0; n < 2; ++n) _Pragma("unroll") for (int k = 0; k < 2; ++k) dst[n][k] = *(const LAS bf16x8*)(lds + PG8_SB(b, h) + boff + n * 2048 + k * 1024); } while (0)
#define PG8_MMA(ai, bj, At, Bt) do { __builtin_amdgcn_s_setprio(1); _Pragma("unroll") for (int m = 0; m < 4; ++m) _Pragma("unroll") for (int n = 0; n < 2; ++n) _Pragma("unroll") for (int k = 0; k < 2; ++k) \
        acc[ai][bj][m][n] = __builtin_amdgcn_mfma_f32_16x16x32_bf16(Bt[n][k], At[m][k], acc[ai][bj][m][n], 0, 0, 0); __builtin_amdgcn_s_setprio(0); } while (0)
#define PG8_WAIT_V(n) asm volatile("s_waitcnt vmcnt(" #n ")" ::: "memory")
#define PG8_WAIT_L(n) asm volatile("s_waitcnt lgkmcnt(" #n ")" ::: "memory")
#define PG8_BAR __builtin_amdgcn_s_barrier()
#define PG8_SCHED __builtin_amdgcn_sched_barrier(0)
    Unit cur, nxt; int ui = 0;
    if (!S.next(0, cur)) return;
    f32x4 acc[2][2][4][2];
#pragma unroll
    for (int a = 0; a < 2; ++a)
#pragma unroll
        for (int b = 0; b < 2; ++b)
#pragma unroll
            for (int m = 0; m < 4; ++m)
#pragma unroll
                for (int n = 0; n < 2; ++n) acc[a][b][m][n] = (f32x4){0.f, 0.f, 0.f, 0.f};
    bf16x8 At[4][2], B0[2][2], B1[2][2];
    const char* cA = (const char*)(cur.sel ? g1.A : g0.A) + (size_t)cur.pm * 256 * (size_t)(cur.sel ? g1.lda : g0.lda) * 2;
    const char* cB = (const char*)(cur.sel ? g1.Bt : g0.Bt) + (size_t)cur.pn * 256 * K * 2;
    size_t chA = (size_t)HALF * (cur.sel ? g1.lda : g0.lda) * 2;
    unsigned cv0 = cur.sel ? voffA1[0] : voffA0[0], cv1 = cur.sel ? voffA1[1] : voffA0[1];
    PG8_STAGEB(PG8_SB(0, 0), cB); PG8_STAGE(PG8_SA(0, 0), cA, cv0, cv1); PG8_STAGEB(PG8_SB(0, 1), cB + hstepB); PG8_STAGE(PG8_SA(0, 1), cA + chA, cv0, cv1);
    if (wr == 1) PG8_BAR;
    PG8_WAIT_V(4); PG8_BAR;
    PG8_STAGEB(PG8_SB(1, 0), cB + kstep); PG8_STAGE(PG8_SA(1, 0), cA + kstep, cv0, cv1); PG8_STAGEB(PG8_SB(1, 1), cB + hstepB + kstep);
    PG8_WAIT_V(6); PG8_BAR;
    for (;;) {
        const bool has_next = S.next(ui + 1, nxt);
        const int nsel = has_next ? nxt.sel : cur.sel;
        const char* nA = has_next ? (const char*)(nsel ? g1.A : g0.A) + (size_t)nxt.pm * 256 * (size_t)(nsel ? g1.lda : g0.lda) * 2 : cA;
        const char* nB = has_next ? (const char*)(nsel ? g1.Bt : g0.Bt) + (size_t)nxt.pn * 256 * K * 2 : cB;
        const size_t nhA = (size_t)HALF * (nsel ? g1.lda : g0.lda) * 2;
        const unsigned nv0 = nsel ? voffA1[0] : voffA0[0], nv1 = nsel ? voffA1[1] : voffA0[1];
        for (int t = 0; t < nt; t += 2) {
            const bool last = (t == nt - 2);
            const char* a1 = cA + (size_t)(t + 1) * kstep;
            const char* a2 = last ? nA : cA + (size_t)(t + 2) * kstep; const char* b2 = last ? nB : cB + (size_t)(t + 2) * kstep;
            const char* a3 = a2 + kstep; const char* b3 = b2 + kstep;
            const size_t h2 = last ? nhA : chA; const unsigned w0 = last ? nv0 : cv0, w1 = last ? nv1 : cv1;
            PG8_LDB(B0, 0, 0); PG8_SCHED; PG8_LDA(At, 0, 0); PG8_STAGE(PG8_SA(1, 1), a1 + chA, cv0, cv1);
            PG8_WAIT_L(8); PG8_BAR; PG8_WAIT_L(0); PG8_MMA(0, 0, At, B0); PG8_BAR; PG8_SCHED;
            PG8_LDB(B1, 0, 1); PG8_STAGEB(PG8_SB(0, 0), b2);
            PG8_BAR; PG8_WAIT_L(0); PG8_MMA(0, 1, At, B1); PG8_BAR;
            PG8_LDA(At, 0, 1); PG8_STAGE(PG8_SA(0, 0), a2, w0, w1);
            PG8_BAR; PG8_WAIT_L(0); PG8_MMA(1, 0, At, B0); PG8_BAR; PG8_SCHED;
            PG8_STAGEB(PG8_SB(0, 1), b2 + hstepB);
            PG8_WAIT_V(6); PG8_BAR; PG8_MMA(1, 1, At, B1); PG8_BAR;
            PG8_LDB(B0, 1, 0); PG8_SCHED; PG8_LDA(At, 1, 0); PG8_STAGE(PG8_SA(0, 1), a2 + h2, w0, w1);
            PG8_WAIT_L(8); PG8_BAR; PG8_WAIT_L(0); PG8_MMA(0, 0, At, B0); PG8_BAR; PG8_SCHED;
            PG8_LDB(B1, 1, 1); PG8_STAGEB(PG8_SB(1, 0), b3);
            PG8_BAR; PG8_WAIT_L(0); PG8_MMA(0, 1, At, B1); PG8_BAR;
            PG8_LDA(At, 1, 1); PG8_STAGE(PG8_SA(1, 0), a3, w0, w1);
            PG8_BAR; PG8_WAIT_L(0); PG8_MMA(1, 0, At, B0); PG8_BAR; PG8_SCHED;
            PG8_STAGEB(PG8_SB(1, 1), b3 + hstepB);
            PG8_WAIT_V(6); PG8_BAR; PG8_MMA(1, 1, At, B1); PG8_BAR;
        }
        E(acc, cur, wr, wc, fr, fq);
        if (!has_next) break;
#pragma unroll
        for (int a = 0; a < 2; ++a)
#pragma unroll
            for (int b = 0; b < 2; ++b)
#pragma unroll
                for (int m = 0; m < 4; ++m)
#pragma unroll
                    for (int n = 0; n < 2; ++n) acc[a][b][m][n] = (f32x4){0.f, 0.f, 0.f, 0.f};
        cur = nxt; cA = nA; cB = nB; chA = nhA; cv0 = nv0; cv1 = nv1; ++ui;
    }
    PG8_WAIT_V(0);
    if (wr == 0) PG8_BAR;
    PG8_BAR;
#undef PG8_SA
#undef PG8_SB
#undef PG8_STAGE
#undef PG8_STAGEB
#undef PG8_LDA
#undef PG8_LDB
#undef PG8_MMA
#undef PG8_WAIT_V
#undef PG8_WAIT_L
#undef PG8_BAR
#undef PG8_SCHED
}

struct EpiStore {
    static constexpr bool PERM = true;
    bf16_t* O; int ldc;
    __device__ __forceinline__ void operator()(const f32x4 (&acc)[2][2][4][2], const Unit& u, int wr, int wc, int fr, int fq) const {
        const int row0 = u.pm * BM + wr * 64 + fr, col0 = u.pn * BM + wc * 32 + 8 * fq;
#pragma unroll
        for (int ai = 0; ai < 2; ++ai)
#pragma unroll
            for (int m = 0; m < 4; ++m) { bf16_t* rowp = O + (size_t)(row0 + ai * HALF + m * 16) * ldc + col0;
#pragma unroll
                for (int bj = 0; bj < 2; ++bj) { const f32x4 v0 = acc[ai][bj][m][0], v1 = acc[ai][bj][m][1];
                    u32x4 w; w.x = cvt_pk_bf16(v0[0], v0[1]); w.y = cvt_pk_bf16(v0[2], v0[3]); w.z = cvt_pk_bf16(v1[0], v1[1]); w.w = cvt_pk_bf16(v1[2], v1[3]);
                    *(u32x4*)(rowp + bj * HALF) = w; } }
    }
};
struct EpiMerge {
    static constexpr bool PERM = true;
    bf16_t* G; int ldg; const float* bias; bf16_t* Y; int accum;
    __device__ __forceinline__ void operator()(const f32x4 (&acc)[2][2][4][2], const Unit& u, int wr, int wc, int fr, int fq) const {
        const int row0 = u.pm * BM + wr * 64 + fr, col0 = u.pn * BM + wc * 32 + 8 * fq;
        if (u.sel == 0) {
            f32x4 bv[2][2];
#pragma unroll
            for (int bj = 0; bj < 2; ++bj)
#pragma unroll
                for (int n = 0; n < 2; ++n) bv[bj][n] = *(const f32x4*)(bias + col0 + bj * HALF + 4 * n);
#pragma unroll
            for (int ai = 0; ai < 2; ++ai)
#pragma unroll
                for (int m = 0; m < 4; ++m) { bf16_t* rowp = G + (size_t)(row0 + ai * HALF + m * 16) * ldg + col0;
#pragma unroll
                    for (int bj = 0; bj < 2; ++bj) { f32x4 v0 = acc[ai][bj][m][0] + bv[bj][0], v1 = acc[ai][bj][m][1] + bv[bj][1];
#pragma unroll
                        for (int j = 0; j < 4; ++j) { v0[j] = sigmoidf_(v0[j]); v1[j] = sigmoidf_(v1[j]); }
                        u32x4 w; w.x = cvt_pk_bf16(v0[0], v0[1]); w.y = cvt_pk_bf16(v0[2], v0[3]); w.z = cvt_pk_bf16(v1[0], v1[1]); w.w = cvt_pk_bf16(v1[2], v1[3]);
                        *(u32x4*)(rowp + bj * HALF) = w; } }
        } else {
#pragma unroll
            for (int ai = 0; ai < 2; ++ai)
#pragma unroll
                for (int m = 0; m < 4; ++m) { const size_t r = (size_t)(row0 + ai * HALF + m * 16);
                    const unsigned long long* gp = (const unsigned long long*)(G + r * ldg + col0); bf16_t* yp = Y + r * DM + col0;
#pragma unroll
                    for (int bj = 0; bj < 2; ++bj) {
                        const unsigned long long g0 = __hip_atomic_load(gp + bj * (HALF / 4), __ATOMIC_RELAXED, __HIP_MEMORY_SCOPE_AGENT);
                        const unsigned long long g1 = __hip_atomic_load(gp + bj * (HALF / 4) + 1, __ATOMIC_RELAXED, __HIP_MEMORY_SCOPE_AGENT);
                        const unsigned gw[4] = {(unsigned)g0, (unsigned)(g0 >> 32), (unsigned)g1, (unsigned)(g1 >> 32)};
                        u32x4 yo = {0u, 0u, 0u, 0u}; if (accum) yo = *(const u32x4*)(yp + bj * HALF);
                        const f32x4 v0 = acc[ai][bj][m][0], v1 = acc[ai][bj][m][1];
                        u32x4 w;
                        w.x = cvt_pk_bf16(bflo(yo.x) + bflo(gw[0]) * v0[0], bfhi(yo.x) + bfhi(gw[0]) * v0[1]);
                        w.y = cvt_pk_bf16(bflo(yo.y) + bflo(gw[1]) * v0[2], bfhi(yo.y) + bfhi(gw[1]) * v0[3]);
                        w.z = cvt_pk_bf16(bflo(yo.z) + bflo(gw[2]) * v1[0], bfhi(yo.z) + bfhi(gw[2]) * v1[1]);
                        w.w = cvt_pk_bf16(bflo(yo.w) + bflo(gw[3]) * v1[2], bfhi(yo.w) + bfhi(gw[3]) * v1[3]);
                        *(u32x4*)(yp + bj * HALF) = w; } }
        }
    }
};
struct EpiResid {
    static constexpr bool PERM = false;
    const float* Xin; float* Xout;
    __device__ __forceinline__ void operator()(const f32x4 (&acc)[2][2][4][2], const Unit& u, int wr, int wc, int fr, int fq) const {
        const int row0 = u.pm * BM + wr * 64 + fr, col0 = u.pn * BM + wc * 32 + 4 * fq;
#pragma unroll
        for (int ai = 0; ai < 2; ++ai)
#pragma unroll
            for (int m = 0; m < 4; ++m) { const size_t ro = (size_t)(row0 + ai * HALF + m * 16) * DM + col0;
#pragma unroll
                for (int bj = 0; bj < 2; ++bj)
#pragma unroll
                    for (int n = 0; n < 2; ++n) { const f32x4 xi = *(const f32x4*)(Xin + ro + bj * HALF + n * 16); *(f32x4*)(Xout + ro + bj * HALF + n * 16) = xi + acc[ai][bj][m][n]; } }
    }
};
}

__device__ void phase_convert(int l, unsigned char* smem) {
    const Params p = load_params();
    float* tile = (float*)smem;
    const int tid = opaque_tid();
    const float* win = p.w_in + (size_t)l * DM * N_IN;
    bf16_t* WtIn = p.Wt; bf16_t* WtBr = p.Wt + (size_t)WT_ROWS * DM; bf16_t* WtOut = WtBr + (size_t)3 * DM * DM;
    const int NT_IN = WT_ROWS / 64;
    const int total = (NT_IN + 48 + 16) * 16;
    for (int it = blockIdx.x; it < total; it += gridDim.x) {
        const int ntile = it >> 4, kt = it & 15, k0 = kt * 64;
        const float* src = nullptr; int ld = 0, c0 = 0, valid = 64; bf16_t* dst;
        if (ntile < NT_IN) {
            const int n0 = ntile * 64; dst = WtIn + (size_t)n0 * DM;
            if (n0 < 4224) { src = win; ld = N_IN; c0 = n0; }
            else if (n0 < 4352) { if (n0 == 4224 && l > 0) { src = p.v_w1 + (size_t)(l - 1) * DM * 32; ld = 32; c0 = 0; valid = 32; } else { valid = 0; } }
            else { src = win; ld = N_IN; c0 = n0 - 128; }
        } else if (ntile < NT_IN + 48) {
            const int q = ntile - NT_IN, n = q >> 4, n0 = (q & 15) * 64;
            src = p.w_branch + ((size_t)l * 3 + n) * DM * DM; ld = DM; c0 = n0; dst = WtBr + ((size_t)n * DM + n0) * DM;
        } else {
            const int n0 = (ntile - NT_IN - 48) * 64; src = p.w_out + (size_t)l * DM * DM; ld = DM; c0 = n0; dst = WtOut + (size_t)n0 * DM;
        }
        __syncthreads();
        if (valid == 64) {
            const int kr = tid >> 4, nc = (tid & 15) * 4;
#pragma unroll
            for (int ps = 0; ps < 2; ++ps) { const int k = kr + ps * 32; const f32x4 v = *(const f32x4*)(src + (size_t)(k0 + k) * ld + c0 + nc);
                tile[k * 65 + nc] = v[0]; tile[k * 65 + nc + 1] = v[1]; tile[k * 65 + nc + 2] = v[2]; tile[k * 65 + nc + 3] = v[3]; }
        } else {
            for (int e = tid; e < 4096; e += 512) { const int k = e >> 6, n = e & 63; tile[k * 65 + n] = (n < valid) ? src[(size_t)(k0 + k) * ld + c0 + n] : 0.f; }
        }
        __syncthreads();
        { const int nr = tid >> 3, kc = (tid & 7) * 8; u32x4 w;
          w.x = cvt_pk_bf16(tile[(kc + 0) * 65 + nr], tile[(kc + 1) * 65 + nr]); w.y = cvt_pk_bf16(tile[(kc + 2) * 65 + nr], tile[(kc + 3) * 65 + nr]);
          w.z = cvt_pk_bf16(tile[(kc + 4) * 65 + nr], tile[(kc + 5) * 65 + nr]); w.w = cvt_pk_bf16(tile[(kc + 6) * 65 + nr], tile[(kc + 7) * 65 + nr]);
          *(u32x4*)(dst + (size_t)nr * DM + k0 + kc) = w; }
    }
    __syncthreads();
}

__device__ void phase_rmsnorm(const float* x, const float* g, bf16_t* xn, float* outf) {
    const int tid_ = opaque_tid(); const int lane = tid_ & 63, wv = tid_ >> 6;
    f32x4 gv[4];
#pragma unroll
    for (int q = 0; q < 4; ++q) gv[q] = *(const f32x4*)(g + q * 256 + lane * 4);
    for (int row = blockIdx.x * 8 + wv; row < T_TOK; row += gridDim.x * 8) {
        const float* xr = x + (size_t)row * DM; f32x4 v[4]; float ss = 0.f;
#pragma unroll
        for (int q = 0; q < 4; ++q) { v[q] = *(const f32x4*)(xr + q * 256 + lane * 4); ss += v[q][0] * v[q][0] + v[q][1] * v[q][1] + v[q][2] * v[q][2] + v[q][3] * v[q][3]; }
#pragma unroll
        for (int o = 32; o > 0; o >>= 1) ss += __shfl_xor(ss, o);
        const float rinv = rsqrtf(ss * (1.0f / DM) + EPS);
#pragma unroll
        for (int q = 0; q < 4; ++q) { const f32x4 o = v[q] * rinv * gv[q];
            if (xn) { u32x2 w; w.x = cvt_pk_bf16(o[0], o[1]); w.y = cvt_pk_bf16(o[2], o[3]); *(u32x2*)(xn + (size_t)row * DM + q * 256 + lane * 4) = w; }
            else *(f32x4*)(outf + (size_t)row * DM + q * 256 + lane * 4) = o; }
    }
}

template <int CTRL> __device__ __forceinline__ float dpp_f(float v) { return __int_as_float(__builtin_amdgcn_update_dpp(0, __float_as_int(v), CTRL, 0xf, 0xf, false)); }
__device__ __forceinline__ float red8(float v) { v += dpp_f<0xB1>(v); v += dpp_f<0x4E>(v); v += dpp_f<0x141>(v); return v; }
__device__ __forceinline__ float red16(float v) { v = red8(v); v += dpp_f<0x140>(v); return v; }

struct RwRaw { u32x4 cw[2], pw[2], ca[2], pa[2], vl; u32x2 cr[2], pr[2], ck[2], pk[2], cv, pv, vf; };
__device__ __forceinline__ void rw_load(RwRaw& R, const bf16_t* H, const bf16_t* vfp, int l, size_t tok, bool hasp, int h, int chh, int vnt, int fq) {
    const bf16_t* cur = H + tok * LDA_H; const bf16_t* prev = cur - LDA_H;
    const u32x4 z4 = {0u, 0u, 0u, 0u}; const u32x2 z2 = {0u, 0u};
#pragma unroll
    for (int ks = 0; ks < 2; ++ks) { const int m0 = ks * 32 + fq * 8;
        R.cw[ks] = *(const u32x4*)(cur + 3072 + m0); R.ca[ks] = *(const u32x4*)(cur + 3136 + m0);
        R.pw[ks] = hasp ? *(const u32x4*)(prev + 3072 + m0) : z4; R.pa[ks] = hasp ? *(const u32x4*)(prev + 3136 + m0) : z4; }
#pragma unroll
    for (int q = 0; q < 2; ++q) { const int cb = h * 64 + (chh * 2 + q) * 16 + fq * 4;
        R.cr[q] = *(const u32x2*)(cur + cb); R.ck[q] = *(const u32x2*)(cur + 1024 + cb);
        R.pr[q] = hasp ? *(const u32x2*)(prev + cb) : z2; R.pk[q] = hasp ? *(const u32x2*)(prev + 1024 + cb) : z2; }
    const int cbv = h * 64 + vnt * 16 + fq * 4;
    R.cv = *(const u32x2*)(cur + 2048 + cbv); R.pv = hasp ? *(const u32x2*)(prev + 2048 + cbv) : z2;
    R.vf = z2; R.vl = z4;
    if (l > 0) { R.vf = *(const u32x2*)(vfp + tok * DM + cbv); R.vl = *(const u32x4*)(cur + 4224 + fq * 8); }
}

__device__ void phase_rwkv(int l, unsigned char* smem, bf16_t* oalt) {
    const Params p = load_params();
    constexpr int TC = 32, NCH = SEQ / TC, BUFSZ = 5 * TC * 64 + TC * 32 + TC * 2;
    bf16_t* w2T = (bf16_t*)smem;
    bf16_t* a2T = w2T + 64 * 72;
    bf16_t* v2T = a2T + 64 * 72;
    float* cst = (float*)(v2T + 64 * 40);
    float* buf0 = cst + 11 * 64;
    float* ybuf = buf0 + 2 * BUFSZ;
    const int tid = opaque_tid(), wid = __builtin_amdgcn_readfirstlane(tid >> 6), lane = tid & 63, fr = lane & 15, fq = lane >> 4;
    for (int item = blockIdx.x; item < NB * 32; item += gridDim.x) {
        const int b = item >> 5, h = (item >> 1) & 15, half = item & 1;
        __syncthreads();
        for (int e = tid; e < 4096; e += 512) { const int m = e >> 6, j = e & 63; w2T[j * 72 + m] = f2bf(p.w_w2[((size_t)l * 64 + m) * DM + h * 64 + j]); a2T[j * 72 + m] = f2bf(p.a_w2[((size_t)l * 64 + m) * DM + h * 64 + j]); }
        if (l > 0) for (int e = tid; e < 2048; e += 512) { const int m = e >> 6, j = e & 63; v2T[j * 40 + m] = f2bf(p.v_w2[((size_t)(l - 1) * 32 + m) * DM + h * 64 + j]); }
        if (tid < 64) { const float* mu = p.mu + (size_t)l * 3200; const int cc = h * 64 + tid;
            cst[tid] = mu[cc]; cst[64 + tid] = mu[1024 + cc]; cst[128 + tid] = mu[2048 + cc]; cst[192 + tid] = p.w0[l * DM + cc]; cst[256 + tid] = p.a0[l * DM + cc];
            cst[320 + tid] = (l > 0) ? p.v0[(l - 1) * DM + cc] : 0.f; cst[384 + tid] = p.k_k[l * DM + cc]; cst[448 + tid] = p.k_a[l * DM + cc]; cst[512 + tid] = p.r_k[l * DM + cc];
            cst[576 + tid] = mu[3072 + tid]; cst[640 + tid] = mu[3136 + tid]; }
        __syncthreads();
        f32x2 st[4];
#pragma unroll
        for (int j = 0; j < 4; ++j) st[j] = (f32x2){0.f, 0.f};
        const int si = tid >> 3, seg = tid & 7;
        const int pwv = wid - 4, tti = pwv & 1, chh = (pwv >> 1) & 1, vnt = half * 2 + chh, tt = tti * 16 + fr;
        RwRaw raw;
        if (wid >= 4) rw_load(raw, p.H, p.vf, l, (size_t)b * SEQ + tt, tt > 0, h, chh, vnt, fq);
        for (int c = -1; c < NCH; ++c) {
            if (wid >= 4 && c + 1 < NCH) {
                float* B_ = buf0 + ((c + 1) & 1) * BUFSZ;
                float* sR = B_; float* sW = sR + TC * 64; float* sK = sW + TC * 64; float* sA = sK + TC * 64; float* sB = sA + TC * 64; float* sV = sB + TC * 64; float* sS = sV + TC * 32;
                const size_t tok = (size_t)b * SEQ + (c + 1) * TC + tt;
                const RwRaw cr_ = raw;
                if (c + 2 < NCH) rw_load(raw, p.H, p.vf, l, tok + TC, true, h, chh, vnt, fq);
                bf16x8 AfW[2], AfA[2];
#pragma unroll
                for (int ks = 0; ks < 2; ++ks) { const int m0 = ks * 32 + fq * 8;
                    const f32x4 mw0 = *(const f32x4*)(cst + 576 + m0), mw1 = *(const f32x4*)(cst + 576 + m0 + 4), ma0 = *(const f32x4*)(cst + 640 + m0), ma1 = *(const f32x4*)(cst + 640 + m0 + 4);
                    const float muw[8] = {mw0[0], mw0[1], mw0[2], mw0[3], mw1[0], mw1[1], mw1[2], mw1[3]}, mua[8] = {ma0[0], ma0[1], ma0[2], ma0[3], ma1[0], ma1[1], ma1[2], ma1[3]};
                    const unsigned cwv[4] = {cr_.cw[ks].x, cr_.cw[ks].y, cr_.cw[ks].z, cr_.cw[ks].w}, pwq[4] = {cr_.pw[ks].x, cr_.pw[ks].y, cr_.pw[ks].z, cr_.pw[ks].w};
                    const unsigned cav[4] = {cr_.ca[ks].x, cr_.ca[ks].y, cr_.ca[ks].z, cr_.ca[ks].w}, pav[4] = {cr_.pa[ks].x, cr_.pa[ks].y, cr_.pa[ks].z, cr_.pa[ks].w};
                    unsigned ow[4], oa[4];
#pragma unroll
                    for (int e = 0; e < 4; ++e) {
                        const float c0 = bflo(cwv[e]), c1 = bfhi(cwv[e]), q0 = bflo(pwq[e]), q1 = bfhi(pwq[e]);
                        ow[e] = cvt_pk_bf16(tanh_fast(c0 + muw[2 * e] * (q0 - c0)), tanh_fast(c1 + muw[2 * e + 1] * (q1 - c1)));
                        const float d0 = bflo(cav[e]), d1 = bfhi(cav[e]), r0 = bflo(pav[e]), r1 = bfhi(pav[e]);
                        oa[e] = cvt_pk_bf16(d0 + mua[2 * e] * (r0 - d0), d1 + mua[2 * e + 1] * (r1 - d1)); }
                    AfW[ks] = __builtin_bit_cast(bf16x8, ((u32x4){ow[0], ow[1], ow[2], ow[3]})); AfA[ks] = __builtin_bit_cast(bf16x8, ((u32x4){oa[0], oa[1], oa[2], oa[3]})); }
                f32x4 accW[2], accA[2], accV = (f32x4){0.f, 0.f, 0.f, 0.f};
#pragma unroll
                for (int q = 0; q < 2; ++q) { const int nt = chh * 2 + q; accW[q] = (f32x4){0.f, 0.f, 0.f, 0.f}; accA[q] = (f32x4){0.f, 0.f, 0.f, 0.f};
#pragma unroll
                    for (int ks = 0; ks < 2; ++ks) { const bf16x8 bw = *(const bf16x8*)(w2T + (nt * 16 + fr) * 72 + ks * 32 + fq * 8), ba = *(const bf16x8*)(a2T + (nt * 16 + fr) * 72 + ks * 32 + fq * 8);
                        accW[q] = __builtin_amdgcn_mfma_f32_16x16x32_bf16(bw, AfW[ks], accW[q], 0, 0, 0); accA[q] = __builtin_amdgcn_mfma_f32_16x16x32_bf16(ba, AfA[ks], accA[q], 0, 0, 0); } }
                if (l > 0) { const bf16x8 bv = *(const bf16x8*)(v2T + (vnt * 16 + fr) * 40 + fq * 8); accV = __builtin_amdgcn_mfma_f32_16x16x32_bf16(bv, __builtin_bit_cast(bf16x8, cr_.vl), accV, 0, 0, 0); }
                float ss = 0.f, rk = 0.f;
#pragma unroll
                for (int q = 0; q < 2; ++q) { const int ch0 = (chh * 2 + q) * 16 + fq * 4;
                    const float fr_[4] = {bflo(cr_.cr[q].x), bfhi(cr_.cr[q].x), bflo(cr_.cr[q].y), bfhi(cr_.cr[q].y)}, fpr[4] = {bflo(cr_.pr[q].x), bfhi(cr_.pr[q].x), bflo(cr_.pr[q].y), bfhi(cr_.pr[q].y)};
                    const float fk_[4] = {bflo(cr_.ck[q].x), bfhi(cr_.ck[q].x), bflo(cr_.ck[q].y), bfhi(cr_.ck[q].y)}, fpk[4] = {bflo(cr_.pk[q].x), bfhi(cr_.pk[q].x), bflo(cr_.pk[q].y), bfhi(cr_.pk[q].y)};
                    const f32x4 mur = *(const f32x4*)(cst + ch0), muk = *(const f32x4*)(cst + 64 + ch0), w0v = *(const f32x4*)(cst + 192 + ch0), a0v = *(const f32x4*)(cst + 256 + ch0),
                        kkv = *(const f32x4*)(cst + 384 + ch0), kav = *(const f32x4*)(cst + 448 + ch0), rkv = *(const f32x4*)(cst + 512 + ch0);
                    f32x4 ro, wo, ko, ao, bo;
#pragma unroll
                    for (int e = 0; e < 4; ++e) {
                        const float r = fr_[e] + mur[e] * (fpr[e] - fr_[e]), k = fk_[e] + muk[e] * (fpk[e] - fk_[e]);
                        const float xw = -(w0v[e] + accW[q][e]); const float sp = fmaxf(xw, 0.f) + __logf(1.0f + __expf(-fabsf(xw)));
                        wo[e] = __expf(-__expf(-sp - 0.5f));
                        const float a = sigmoidf_(a0v[e] + accA[q][e]);
                        const float kq = k * kkv[e]; ss += kq * kq; ao[e] = -kq; bo[e] = kq * a;
                        const float km = k * (1.0f + (a - 1.0f) * kav[e]); rk += r * km * rkv[e]; ro[e] = r; ko[e] = km; }
                    *(f32x4*)(sR + tt * 64 + ch0) = ro; *(f32x4*)(sW + tt * 64 + ch0) = wo; *(f32x4*)(sK + tt * 64 + ch0) = ko; *(f32x4*)(sA + tt * 64 + ch0) = ao; *(f32x4*)(sB + tt * 64 + ch0) = bo; }
                ss += __shfl_xor(ss, 16); ss += __shfl_xor(ss, 32); rk += __shfl_xor(rk, 16); rk += __shfl_xor(rk, 32);
                if (fq == 0) { sS[tt * 2 + chh] = ss; if (half == 0) p.rkbuf[(size_t)((b * 16 + h) * 2 + chh) * SEQ + (c + 1) * TC + tt] = rk; }
                { const int ch0 = vnt * 16 + fq * 4, cb = h * 64 + ch0;
                  const float fv_[4] = {bflo(cr_.cv.x), bfhi(cr_.cv.x), bflo(cr_.cv.y), bfhi(cr_.cv.y)}, fpv[4] = {bflo(cr_.pv.x), bfhi(cr_.pv.x), bflo(cr_.pv.y), bfhi(cr_.pv.y)};
                  const f32x4 muv = *(const f32x4*)(cst + 128 + ch0), v0v = *(const f32x4*)(cst + 320 + ch0);
                  f32x4 vo;
#pragma unroll
                  for (int e = 0; e < 4; ++e) vo[e] = fv_[e] + muv[e] * (fpv[e] - fv_[e]);
                  if (l > 0) { const float vfv[4] = {bflo(cr_.vf.x), bfhi(cr_.vf.x), bflo(cr_.vf.y), bfhi(cr_.vf.y)};
#pragma unroll
                      for (int e = 0; e < 4; ++e) vo[e] = vo[e] + (vfv[e] - vo[e]) * sigmoidf_(v0v[e] + accV[e]); }
                  u32x2 w; w.x = cvt_pk_bf16(vo[0], vo[1]); w.y = cvt_pk_bf16(vo[2], vo[3]); *(u32x2*)(p.vf + tok * DM + cb) = w;
                  *(f32x4*)(sV + tt * 32 + chh * 16 + fq * 4) = vo; }
            }
            if (wid < 4 && c >= 0) {
                const float* B_ = buf0 + (c & 1) * BUFSZ;
                const float* sR = B_; const float* sW = sR + TC * 64; const float* sK = sW + TC * 64; const float* sA = sK + TC * 64; const float* sB = sA + TC * 64; const float* sV = sB + TC * 64; const float* sS = sV + TC * 32;
#pragma unroll 2
                for (int s = 0; s < TC; ++s) {
                    const int o = s * 64 + seg * 8;
                    const f32x4 a0 = *(const f32x4*)(sA + o), a1 = *(const f32x4*)(sA + o + 4), w0 = *(const f32x4*)(sW + o), w1 = *(const f32x4*)(sW + o + 4);
                    const f32x4 b0 = *(const f32x4*)(sB + o), b1 = *(const f32x4*)(sB + o + 4), k0 = *(const f32x4*)(sK + o), k1 = *(const f32x4*)(sK + o + 4);
                    const f32x4 r0 = *(const f32x4*)(sR + o), r1 = *(const f32x4*)(sR + o + 4);
                    const float vi = sV[s * 32 + si]; const f32x2 ps = *(const f32x2*)(sS + s * 2);
                    const float inv2 = __builtin_amdgcn_rcpf(fmaxf(ps.x + ps.y, 1e-24f));
                    const f32x2 av[4] = {{a0[0], a0[1]}, {a0[2], a0[3]}, {a1[0], a1[1]}, {a1[2], a1[3]}}, wv[4] = {{w0[0], w0[1]}, {w0[2], w0[3]}, {w1[0], w1[1]}, {w1[2], w1[3]}};
                    const f32x2 bv[4] = {{b0[0], b0[1]}, {b0[2], b0[3]}, {b1[0], b1[1]}, {b1[2], b1[3]}}, kv[4] = {{k0[0], k0[1]}, {k0[2], k0[3]}, {k1[0], k1[1]}, {k1[2], k1[3]}};
                    const f32x2 rv[4] = {{r0[0], r0[1]}, {r0[2], r0[3]}, {r1[0], r1[1]}, {r1[2], r1[3]}};
                    const f32x2 vi2 = {vi, vi};
                    f32x2 vk[4];
#pragma unroll
                    for (int j = 0; j < 4; ++j) vk[j] = vi2 * kv[j];
                    const f32x2 pa = st[0] * av[0] + st[1] * av[1], pb = st[2] * av[2] + st[3] * av[3]; const f32x2 pc = pa + pb;
                    const float sa = red8(pc.x + pc.y) * inv2;
                    const f32x2 sa2 = {sa, sa};
#pragma unroll
                    for (int j = 0; j < 4; ++j) st[j] = st[j] * wv[j] + (sa2 * bv[j] + vk[j]);
                    const f32x2 qa = st[0] * rv[0] + st[1] * rv[1], qb = st[2] * rv[2] + st[3] * rv[3]; const f32x2 qc = qa + qb;
                    const float yy = red8(qc.x + qc.y);
                    if (seg == 0) ybuf[s * 32 + si] = yy;
                }
                { const int tk = lane >> 1, rq = (lane & 1) * 4; const f32x4 yv = *(const f32x4*)(ybuf + tk * 32 + wid * 8 + rq);
                  u32x2 w; w.x = cvt_pk_bf16(yv[0], yv[1]); w.y = cvt_pk_bf16(yv[2], yv[3]);
                  *(u32x2*)(p.y + ((size_t)b * SEQ + c * TC + tk) * DM + h * 64 + half * 32 + wid * 8 + rq) = w; }
            }
            __syncthreads();
        }
    }
    __syncthreads();
}

__device__ void phase_rwkv_post(int l, bf16_t* oalt) {
    const Params p = load_params();
    const int tid = opaque_tid(), l8 = tid & 7;
    const int ngrp = T_TOK * 16;
    for (int g = blockIdx.x * 64 + (tid >> 3); g < ngrp; g += gridDim.x * 64) {
        const int tok = g >> 4, h = g & 15, cb = h * 64 + l8 * 8;
        const u32x4 y4 = *(const u32x4*)(p.y + (size_t)tok * DM + cb), b4 = *(const u32x4*)(p.vf + (size_t)tok * DM + cb);
        const int bb = tok / SEQ, tq = tok % SEQ; const float rk = p.rkbuf[(size_t)((bb * 16 + h) * 2) * SEQ + tq] + p.rkbuf[(size_t)((bb * 16 + h) * 2 + 1) * SEQ + tq];
        bf16_t* zp = p.H + (size_t)tok * LDA_H + 3200 + cb; const u32x4 z4 = *(const u32x4*)zp;
        const float yv[8] = {bflo(y4.x), bfhi(y4.x), bflo(y4.y), bfhi(y4.y), bflo(y4.z), bfhi(y4.z), bflo(y4.w), bfhi(y4.w)};
        const float bv[8] = {bflo(b4.x), bfhi(b4.x), bflo(b4.y), bfhi(b4.y), bflo(b4.z), bfhi(b4.z), bflo(b4.w), bfhi(b4.w)};
        const float zv[8] = {bflo(z4.x), bfhi(z4.x), bflo(z4.y), bfhi(z4.y), bflo(z4.z), bfhi(z4.z), bflo(z4.w), bfhi(z4.w)};
        float sm = 0.f;
#pragma unroll
        for (int e = 0; e < 8; ++e) sm += yv[e];
        sm = red8(sm); const float mean = sm * (1.0f / 64.f); float d[8], vs = 0.f;
#pragma unroll
        for (int e = 0; e < 8; ++e) { d[e] = yv[e] - mean; vs += d[e] * d[e]; }
        vs = red8(vs); const float rstd = rsqrtf(vs * (1.0f / 64.f) + GN_EPS);
        const f32x4 g0 = *(const f32x4*)(p.lnx_g + l * DM + cb), g1 = *(const f32x4*)(p.lnx_g + l * DM + cb + 4), c0 = *(const f32x4*)(p.lnx_b + l * DM + cb), c1 = *(const f32x4*)(p.lnx_b + l * DM + cb + 4);
        const float gg[8] = {g0[0], g0[1], g0[2], g0[3], g1[0], g1[1], g1[2], g1[3]}, cc[8] = {c0[0], c0[1], c0[2], c0[3], c1[0], c1[1], c1[2], c1[3]};
        float o[8];
#pragma unroll
        for (int e = 0; e < 8; ++e) o[e] = (d[e] * rstd * gg[e] + cc[e] + rk * bv[e]) * siluf_(zv[e]);
        u32x4 w; w.x = cvt_pk_bf16(o[0], o[1]); w.y = cvt_pk_bf16(o[2], o[3]); w.z = cvt_pk_bf16(o[4], o[5]); w.w = cvt_pk_bf16(o[6], o[7]);
        *(u32x4*)(oalt ? oalt + (size_t)tok * DM + cb : zp) = w;
    }
}

__device__ void phase_sgu(int l, unsigned char* smem, bf16_t* oalt) {
    const Params p = load_params();
    bf16_t* vnT = (bf16_t*)smem;
    float* stat = (float*)(smem + 128 * 136 * 2);
    const int tid = opaque_tid(), wid = tid >> 6, lane = tid & 63, fr = lane & 15, fq = lane >> 4;
    const float* lng = p.sgu_ln_g + (size_t)l * DM; const float* lnb = p.sgu_ln_b + (size_t)l * DM;
    for (int item = blockIdx.x; item < T_TOK / 128; item += gridDim.x) {
        bf16_t* Hb = p.H + (size_t)item * 128 * LDB_H;
        __syncthreads();
        for (int q = 0; q < 16; ++q) { const int s = wid * 16 + q; const bf16_t* vr = Hb + (size_t)s * LDB_H + 1024 + lane * 16;
            const u32x4 a = *(const u32x4*)vr, bq = *(const u32x4*)(vr + 8);
            const float f[16] = {bflo(a.x), bfhi(a.x), bflo(a.y), bfhi(a.y), bflo(a.z), bfhi(a.z), bflo(a.w), bfhi(a.w), bflo(bq.x), bfhi(bq.x), bflo(bq.y), bfhi(bq.y), bflo(bq.z), bfhi(bq.z), bflo(bq.w), bfhi(bq.w)};
            float sm = 0.f;
#pragma unroll
            for (int e = 0; e < 16; ++e) sm += f[e];
#pragma unroll
            for (int o = 32; o > 0; o >>= 1) sm += __shfl_xor(sm, o);
            const float mean = sm * (1.0f / DM); float vs = 0.f;
#pragma unroll
            for (int e = 0; e < 16; ++e) { const float d = f[e] - mean; vs += d * d; }
#pragma unroll
            for (int o = 32; o > 0; o >>= 1) vs += __shfl_xor(vs, o);
            if (lane == 0) { stat[s * 2] = mean; stat[s * 2 + 1] = rsqrtf(vs * (1.0f / DM) + EPS); } }
        __syncthreads();
        for (int g = 0; g < 8; ++g) {
            { const int s = tid >> 2, c0 = (tid & 3) * 32; const float mean = stat[s * 2], rstd = stat[s * 2 + 1];
              const bf16_t* vr = Hb + (size_t)s * LDB_H + 1024 + g * 128 + c0;
#pragma unroll
              for (int q = 0; q < 4; ++q) { const u32x4 a = *(const u32x4*)(vr + q * 8); const float f[8] = {bflo(a.x), bfhi(a.x), bflo(a.y), bfhi(a.y), bflo(a.z), bfhi(a.z), bflo(a.w), bfhi(a.w)};
#pragma unroll
                  for (int e = 0; e < 8; ++e) { const int c = c0 + q * 8 + e; const float vn = (f[e] - mean) * rstd * lng[g * 128 + c] + lnb[g * 128 + c]; vnT[c * 136 + s] = f2bf(vn); } } }
            __syncthreads();
            f32x4 acc[8];
#pragma unroll
            for (int i = 0; i < 8; ++i) acc[i] = (f32x4){0.f, 0.f, 0.f, 0.f};
            const int trow = wid * 16 + fr;
            const float* Wg = p.sgu_w + (((size_t)l * 8 + g) * 128 + trow) * 128;
            const int nks = (wid < 4) ? 2 : 4;
            for (int ks = 0; ks < nks; ++ks) {
                const f32x4 wa = *(const f32x4*)(Wg + ks * 32 + fq * 8), wb = *(const f32x4*)(Wg + ks * 32 + fq * 8 + 4);
                u32x4 wp; wp.x = cvt_pk_bf16(wa[0], wa[1]); wp.y = cvt_pk_bf16(wa[2], wa[3]); wp.z = cvt_pk_bf16(wb[0], wb[1]); wp.w = cvt_pk_bf16(wb[2], wb[3]);
                const bf16x8 wfrag = __builtin_bit_cast(bf16x8, wp);
#pragma unroll
                for (int ct = 0; ct < 8; ++ct) { const bf16x8 vfrag = *(const bf16x8*)(vnT + (ct * 16 + fr) * 136 + ks * 32 + fq * 8);
                    acc[ct] = __builtin_amdgcn_mfma_f32_16x16x32_bf16(vfrag, wfrag, acc[ct], 0, 0, 0); }
            }
            { const float bs = p.sgu_b[((size_t)l * 8 + g) * 128 + trow]; bf16_t* hr = Hb + (size_t)trow * LDB_H;
#pragma unroll
              for (int ct = 0; ct < 8; ++ct) { const int c = g * 128 + ct * 16 + fq * 4;
                  const u32x2 u2 = *(const u32x2*)(hr + c), z2 = *(const u32x2*)(hr + 2048 + c);
                  const float uf[4] = {bflo(u2.x), bfhi(u2.x), bflo(u2.y), bfhi(u2.y)}, zf[4] = {bflo(z2.x), bfhi(z2.x), bflo(z2.y), bfhi(z2.y)};
                  float o[4];
#pragma unroll
                  for (int j = 0; j < 4; ++j) o[j] = uf[j] * (acc[ct][j] + bs) * siluf_(zf[j]);
                  u32x2 w; w.x = cvt_pk_bf16(o[0], o[1]); w.y = cvt_pk_bf16(o[2], o[3]); *(u32x2*)(oalt ? oalt + ((size_t)item * 128 + trow) * DM + c : hr + 2048 + c) = w; } }
            __syncthreads();
        }
    }
    __syncthreads();
}

__device__ void phase_hgrn_pre(int l, unsigned char* smem, bool dry) {
    const Params p = load_params();
    float* LF = (float*)smem;
    bf16_t* IB = (bf16_t*)(LF + 64 * 132);
    bf16_t* KB = IB + 64 * 136;
    float* psum = (float*)(KB + 64 * 136);
    float* lbs = psum + 512;
    const int tid = opaque_tid();
    bf16_t* xtra = (l == 0) ? (bf16_t*)p.out : p.vf;
    __syncthreads();
    for (int e = tid; e < DM; e += 512) { float lb = 0.f; if (l == 1) { const float l0 = p.lb_logits[e], l1 = p.lb_logits[DM + e]; lb = __builtin_amdgcn_rcpf(1.0f + __expf(l0 - l1)); } lbs[e] = lb; }
    __syncthreads();
    const int t = tid >> 3, c0 = (tid & 7) * 16;
    const int cc = tid & 127, tq = tid >> 7;
    for (int item = blockIdx.x; item < NB * 64 * 8; item += gridDim.x) {
        const int h = item & 7, ch = (item >> 3) & 63, b = item >> 9;
        const size_t r0 = (size_t)b * SEQ + ch * 64;
        bf16_t* hr = p.H + (r0 + t) * LDC_H + h * 128 + c0;
        float qv[16], kv[16];
        {
            const u32x4 q0 = *(const u32x4*)hr, q1 = *(const u32x4*)(hr + 8), f0 = *(const u32x4*)(hr + 1024), f1 = *(const u32x4*)(hr + 1032), i0 = *(const u32x4*)(hr + 2048), i1 = *(const u32x4*)(hr + 2056);
            const unsigned qa[8] = {q0.x, q0.y, q0.z, q0.w, q1.x, q1.y, q1.z, q1.w}, fa[8] = {f0.x, f0.y, f0.z, f0.w, f1.x, f1.y, f1.z, f1.w};
            *(u32x4*)(IB + t * 136 + c0) = i0; *(u32x4*)(IB + t * 136 + c0 + 8) = i1;
            float lf[16];
#pragma unroll
            for (int e = 0; e < 8; ++e) {
                const float lb0 = lbs[h * 128 + c0 + 2 * e], lb1 = lbs[h * 128 + c0 + 2 * e + 1];
                qv[2 * e] = siluf_(bflo(qa[e])); qv[2 * e + 1] = siluf_(bfhi(qa[e]));
                const float g0 = lb0 + (1.0f - lb0) * sigmoidf_(bflo(fa[e])), g1 = lb1 + (1.0f - lb1) * sigmoidf_(bfhi(fa[e]));
                kv[2 * e] = 1.0f - g0; kv[2 * e + 1] = 1.0f - g1; lf[2 * e] = __logf(g0); lf[2 * e + 1] = __logf(g1); }
#pragma unroll
            for (int e = 0; e < 4; ++e) *(f32x4*)(LF + t * 132 + c0 + e * 4) = (f32x4){lf[e * 4], lf[e * 4 + 1], lf[e * 4 + 2], lf[e * 4 + 3]};
        }
        __syncthreads();
        { float run = 0.f;
#pragma unroll
          for (int e = 0; e < 16; ++e) { run += LF[(tq * 16 + e) * 132 + cc]; LF[(tq * 16 + e) * 132 + cc] = run; }
          psum[tq * 128 + cc] = run; }
        __syncthreads();
        {
            const int tqt = t >> 4;
            unsigned qo[8], ko[8];
#pragma unroll
            for (int e4 = 0; e4 < 4; ++e4) {
                const f32x4 p0 = *(const f32x4*)(psum + c0 + e4 * 4), p1 = *(const f32x4*)(psum + 128 + c0 + e4 * 4), p2 = *(const f32x4*)(psum + 256 + c0 + e4 * 4), p3 = *(const f32x4*)(psum + 384 + c0 + e4 * 4);
                const f32x4 bl = *(const f32x4*)(LF + t * 132 + c0 + e4 * 4);
                float q2[4], k2[4];
#pragma unroll
                for (int j = 0; j < 4; ++j) {
                    const float off = (tqt > 0 ? p0[j] : 0.f) + (tqt > 1 ? p1[j] : 0.f) + (tqt > 2 ? p2[j] : 0.f);
                    const float bmid = p0[j] + p1[j], bb = bl[j] + off;
                    q2[j] = qv[e4 * 4 + j] * __expf(bb - bmid); k2[j] = kv[e4 * 4 + j] * __expf(bmid - bb); }
                qo[e4 * 2] = cvt_pk_bf16(q2[0], q2[1]); qo[e4 * 2 + 1] = cvt_pk_bf16(q2[2], q2[3]); ko[e4 * 2] = cvt_pk_bf16(k2[0], k2[1]); ko[e4 * 2 + 1] = cvt_pk_bf16(k2[2], k2[3]);
                if (t == 0) { f32x4 e1, e3;
#pragma unroll
                    for (int j = 0; j < 4; ++j) { e1[j] = __expf(p0[j] + p1[j]); e3[j] = __expf(p2[j] + p3[j]); }
                    float* gs = p.rkbuf + (size_t)(((b * 64 + ch) * 8 + h)) * 256 + c0 + e4 * 4; *(f32x4*)gs = e1; *(f32x4*)(gs + 128) = e3; }
            }
            const u32x4 qw0 = {qo[0], qo[1], qo[2], qo[3]}, qw1 = {qo[4], qo[5], qo[6], qo[7]}, kw0 = {ko[0], ko[1], ko[2], ko[3]}, kw1 = {ko[4], ko[5], ko[6], ko[7]};
            if (!dry) { *(u32x4*)hr = qw0; *(u32x4*)(hr + 8) = qw1; *(u32x4*)(hr + 1024) = kw0; *(u32x4*)(hr + 1032) = kw1; }
            *(u32x4*)(KB + t * 136 + c0) = kw0; *(u32x4*)(KB + t * 136 + c0 + 8) = kw1;
        }
        __syncthreads();
        {
            unsigned iw[8], kw[8];
#pragma unroll
            for (int e = 0; e < 8; ++e) {
                iw[e] = (unsigned)IB[(tq * 16 + 2 * e) * 136 + cc] | ((unsigned)IB[(tq * 16 + 2 * e + 1) * 136 + cc] << 16);
                kw[e] = (unsigned)KB[(tq * 16 + 2 * e) * 136 + cc] | ((unsigned)KB[(tq * 16 + 2 * e + 1) * 136 + cc] << 16); }
            bf16_t* ir = p.H + (r0 + (cc >> 1)) * LDC_H + 2048 + h * 128 + (cc & 1) * 64 + tq * 16;
            if (!dry) { *(u32x4*)ir = (u32x4){iw[0], iw[1], iw[2], iw[3]}; *(u32x4*)(ir + 8) = (u32x4){iw[4], iw[5], iw[6], iw[7]}; }
            bf16_t* kr = xtra + (r0 + (cc >> 1)) * DM + h * 128 + (cc & 1) * 64 + tq * 16;
            *(u32x4*)kr = (u32x4){kw[0], kw[1], kw[2], kw[3]}; *(u32x4*)(kr + 8) = (u32x4){kw[4], kw[5], kw[6], kw[7]};
        }
        __syncthreads();
    }
}

struct HgRaw { u32x4 qm[4], km[2][4], it[2][2], kt[2]; f32x4 e1, e3; };
__device__ __forceinline__ void hg_load(HgRaw& R, const bf16_t* H, const bf16_t* xtra, const float* gsc, size_t r0, int b, int ch, int h, int vs, int w, int fr, int fq) {
    const int tt_ = w >> 1, sp = w & 1;
#pragma unroll
    for (int ks = 0; ks < 4; ++ks) R.qm[ks] = *(const u32x4*)(H + (r0 + tt_ * 16 + fr) * LDC_H + h * 128 + ks * 32 + fq * 8);
#pragma unroll
    for (int q = 0; q < 2; ++q)
#pragma unroll
        for (int ks = 0; ks < 4; ++ks) R.km[q][ks] = *(const u32x4*)(H + (r0 + (sp * 2 + q) * 16 + fr) * LDC_H + 1024 + h * 128 + ks * 32 + fq * 8);
#pragma unroll
    for (int vt = 0; vt < 2; ++vt) { const int v = vs * 32 + vt * 16 + fr;
#pragma unroll
        for (int ks = 0; ks < 2; ++ks) R.it[vt][ks] = *(const u32x4*)(H + (r0 + (v >> 1)) * LDC_H + 2048 + h * 128 + (v & 1) * 64 + ks * 32 + fq * 8); }
    { const int k = w * 16 + fr;
#pragma unroll
      for (int ks = 0; ks < 2; ++ks) R.kt[ks] = *(const u32x4*)(xtra + (r0 + (k >> 1)) * DM + h * 128 + (k & 1) * 64 + ks * 32 + fq * 8); }
    const float* gs = gsc + (size_t)(((b * 64 + ch) * 8 + h)) * 256 + w * 16 + fq * 4;
    R.e1 = *(const f32x4*)gs; R.e3 = *(const f32x4*)(gs + 128);
}

__device__ void phase_hgrn_seq(int l, unsigned char* smem, bool dry) {
    const Params p = load_params();
    bf16_t* att = (bf16_t*)smem;
    bf16_t* STs = att + 64 * 72;
    const int tid = opaque_tid(), w = __builtin_amdgcn_readfirstlane(tid >> 6), lane = tid & 63, fr = lane & 15, fq = lane >> 4;
    const bf16_t* xtra = (l == 0) ? (const bf16_t*)p.out : p.vf;
    const int tt_ = w >> 1, sp = w & 1;
    for (int item = blockIdx.x; item < NB * 32; item += gridDim.x) {
        const int vs = item & 3, h = (item >> 2) & 7, b = item >> 5;
        __syncthreads();
        for (int e = tid; e < 32 * 136 / 2; e += 512) ((unsigned*)STs)[e] = 0u;
        f32x4 S[2] = {{0.f, 0.f, 0.f, 0.f}, {0.f, 0.f, 0.f, 0.f}};
        u32x2 o0 = {0u, 0u};
        HgRaw raw; hg_load(raw, p.H, xtra, p.rkbuf, (size_t)b * SEQ, b, 0, h, vs, w, fr, fq);
        __syncthreads();
        for (int ch = 0; ch < 64; ++ch) {
            const size_t r0 = (size_t)b * SEQ + ch * 64;
            const HgRaw cr = raw;
            if (ch + 1 < 64) hg_load(raw, p.H, xtra, p.rkbuf, r0 + 64, b, ch + 1, h, vs, w, fr, fq);
#pragma unroll
            for (int q = 0; q < 2; ++q) { const int stile = sp * 2 + q; f32x4 a = {0.f, 0.f, 0.f, 0.f};
                if (stile <= tt_) {
#pragma unroll
                    for (int ks = 0; ks < 4; ++ks) a = __builtin_amdgcn_mfma_f32_16x16x32_bf16(__builtin_bit_cast(bf16x8, cr.qm[ks]), __builtin_bit_cast(bf16x8, cr.km[q][ks]), a, 0, 0, 0); }
#pragma unroll
                for (int j = 0; j < 4; ++j) { const int t = tt_ * 16 + fq * 4 + j, s = stile * 16 + fr; att[t * 72 + s] = f2bf(s <= t ? a[j] : 0.f); } }
            __syncthreads();
            f32x4 o = {0.f, 0.f, 0.f, 0.f};
#pragma unroll
            for (int ks = 0; ks < 2; ++ks) { const bf16x8 af = *(const bf16x8*)(att + (tt_ * 16 + fr) * 72 + ks * 32 + fq * 8);
                o = __builtin_amdgcn_mfma_f32_16x16x32_bf16(__builtin_bit_cast(bf16x8, sp ? cr.it[1][ks] : cr.it[0][ks]), af, o, 0, 0, 0); }
#pragma unroll
            for (int ks = 0; ks < 4; ++ks) { const bf16x8 sf = *(const bf16x8*)(STs + (sp * 16 + fr) * 136 + ks * 32 + fq * 8);
                o = __builtin_amdgcn_mfma_f32_16x16x32_bf16(sf, __builtin_bit_cast(bf16x8, cr.qm[ks]), o, 0, 0, 0); }
            { u32x2 ow; ow.x = cvt_pk_bf16(o[0], o[1]); ow.y = cvt_pk_bf16(o[2], o[3]);
              if (ch == 0) o0 = ow;
              else if (!dry) { const int t = tt_ * 16 + fr; *(u32x2*)(p.H + (r0 - 64 + vs * 16 + (t >> 2)) * LDC_H + 2048 + h * 128 + (t & 3) * 32 + sp * 16 + fq * 4) = ow; } }
#pragma unroll
            for (int vt = 0; vt < 2; ++vt) { f32x4 u = {0.f, 0.f, 0.f, 0.f};
#pragma unroll
                for (int ks = 0; ks < 2; ++ks) u = __builtin_amdgcn_mfma_f32_16x16x32_bf16(__builtin_bit_cast(bf16x8, cr.kt[ks]), __builtin_bit_cast(bf16x8, cr.it[vt][ks]), u, 0, 0, 0);
#pragma unroll
                for (int j = 0; j < 4; ++j) S[vt][j] = cr.e3[j] * (cr.e1[j] * S[vt][j] + u[j]); }
            __syncthreads();
            if (ch + 1 < 64) {
#pragma unroll
                for (int vt = 0; vt < 2; ++vt) { u32x2 sw; sw.x = cvt_pk_bf16(S[vt][0] * raw.e1[0], S[vt][1] * raw.e1[1]); sw.y = cvt_pk_bf16(S[vt][2] * raw.e1[2], S[vt][3] * raw.e1[3]);
                    *(u32x2*)(STs + (vt * 16 + fr) * 136 + w * 16 + fq * 4) = sw; } }
        }
        if (!dry) { const int t = tt_ * 16 + fr; *(u32x2*)(p.H + ((size_t)b * SEQ + 63 * 64 + vs * 16 + (t >> 2)) * LDC_H + 2048 + h * 128 + (t & 3) * 32 + sp * 16 + fq * 4) = o0; }
    }
    __syncthreads();
}

__device__ void phase_hgrn_post(int l) {
    const Params p = load_params();
    const int tid = opaque_tid(), l8 = tid & 7;
    const int ngrp = T_TOK * 8;
    for (int g = blockIdx.x * 64 + (tid >> 3); g < ngrp; g += gridDim.x * 64) {
        const int tok = g >> 3, h = g & 7, b = tok / SEQ, tin = tok % SEQ, ch = tin >> 6, t = tin & 63, slot = (ch + 63) & 63, vs = l8 >> 1, vv0 = (l8 & 1) * 16;
        const bf16_t* op = p.H + ((size_t)b * SEQ + slot * 64 + vs * 16 + (t >> 2)) * LDC_H + 2048 + h * 128 + (t & 3) * 32 + vv0;
        bf16_t* zp = p.H + (size_t)tok * LDC_H + 3072 + h * 128 + l8 * 16;
        const u32x4 a0 = *(const u32x4*)op, a1 = *(const u32x4*)(op + 8), z0 = *(const u32x4*)zp, z1 = *(const u32x4*)(zp + 8);
        const float ov[16] = {bflo(a0.x), bfhi(a0.x), bflo(a0.y), bfhi(a0.y), bflo(a0.z), bfhi(a0.z), bflo(a0.w), bfhi(a0.w), bflo(a1.x), bfhi(a1.x), bflo(a1.y), bfhi(a1.y), bflo(a1.z), bfhi(a1.z), bflo(a1.w), bfhi(a1.w)};
        const float zf[16] = {bflo(z0.x), bfhi(z0.x), bflo(z0.y), bfhi(z0.y), bflo(z0.z), bfhi(z0.z), bflo(z0.w), bfhi(z0.w), bflo(z1.x), bfhi(z1.x), bflo(z1.y), bfhi(z1.y), bflo(z1.z), bfhi(z1.z), bflo(z1.w), bfhi(z1.w)};
        float ss = 0.f;
#pragma unroll
        for (int e = 0; e < 16; ++e) ss += ov[e] * ov[e];
        ss = red8(ss); const float rinv = rsqrtf(ss * (1.0f / 128.f) + EPS);
        const float* gn = p.hgrn_g + (size_t)l * DM + h * 128 + l8 * 16;
        float r[16];
#pragma unroll
        for (int e = 0; e < 16; ++e) r[e] = ov[e] * rinv * gn[e] * siluf_(zf[e]);
        u32x4 w0, w1; w0.x = cvt_pk_bf16(r[0], r[1]); w0.y = cvt_pk_bf16(r[2], r[3]); w0.z = cvt_pk_bf16(r[4], r[5]); w0.w = cvt_pk_bf16(r[6], r[7]);
        w1.x = cvt_pk_bf16(r[8], r[9]); w1.y = cvt_pk_bf16(r[10], r[11]); w1.z = cvt_pk_bf16(r[12], r[13]); w1.w = cvt_pk_bf16(r[14], r[15]);
        *(u32x4*)zp = w0; *(u32x4*)(zp + 8) = w1;
    }
}


#define XB_TMO      128
#define XB_XCNT(j)  (256  + 64 * (j))
#define XB_XSUB(j)  (1280 + 64 * (j))
#define XB_XGEN(j)  (2304 + 64 * (j))
#define XB_TOP      3328
#define XB_TOPGEN   3392
#define XCD_BAR_WORDS 3456
#define XB_SPIN_CAP (1u << 18)
__device__ __forceinline__ unsigned xb_ld(unsigned* p)              { return __hip_atomic_load(p, __ATOMIC_RELAXED, __HIP_MEMORY_SCOPE_AGENT); }
__device__ __forceinline__ unsigned xb_add(unsigned* p, unsigned v) { return __hip_atomic_fetch_add(p, v, __ATOMIC_RELAXED, __HIP_MEMORY_SCOPE_AGENT); }
__device__ __forceinline__ unsigned xb_xcc_id() { return (unsigned)__builtin_amdgcn_s_getreg((3 << 11) | 20) & 0xFu; }
#define XB_SPIN(cond, bar) do { unsigned _sp = 0; while (cond) { __builtin_amdgcn_s_sleep(1); \
    if ((++_sp & 255u) == 0u) { if (xb_ld(&(bar)[XB_TMO])) break; if (_sp > XB_SPIN_CAP) { atomicAdd(&(bar)[XB_TMO], 1u); break; } } } } while (0)
struct XcdBarrier { unsigned* bar; unsigned x; volatile LAS unsigned* st; };
__device__ __forceinline__ XcdBarrier xcd_barrier_post(unsigned* bar, volatile LAS unsigned* st) {
    XcdBarrier b; b.bar = bar; b.x = xb_xcc_id(); b.st = st;
    if (threadIdx.x == 0) (void)xb_add(&bar[XB_XCNT(b.x)], 1u);
    return b;
}
__device__ __forceinline__ void xcd_barrier_complete(unsigned* bar, unsigned x, unsigned& nloc, unsigned& nx) {
    const unsigned G = gridDim.x * gridDim.y * gridDim.z;
    unsigned sum, cnt, mine, sp = 0u;
    for (;;) {
        sum = 0u; cnt = 0u; mine = 0u;
#pragma unroll
        for (unsigned j = 0; j < 16; ++j) { const unsigned c = xb_ld(&bar[XB_XCNT(j)]); sum += c; cnt += (c > 0u) ? 1u : 0u; mine = (j == x) ? c : mine; }
        if (sum == G) break;
        __builtin_amdgcn_s_sleep(1);
        if ((++sp & 255u) == 0u) { if (xb_ld(&bar[XB_TMO])) break; if (sp > XB_SPIN_CAP) { atomicAdd(&bar[XB_TMO], 1u); break; } }
    }
    nloc = mine > 0u ? mine : 1u; nx = cnt > 0u ? cnt : 1u;
}
__device__ __forceinline__ void xcd_barrier(const XcdBarrier& b) {
    asm volatile("s_waitcnt vmcnt(0)" ::: "memory");
    __syncthreads();
    if (threadIdx.x == 0) {
        unsigned* bar = b.bar;
        __builtin_amdgcn_s_waitcnt(0);
        unsigned nloc = b.st[0], nx = b.st[1];
        if (nloc == 0u) { xcd_barrier_complete(bar, b.x, nloc, nx); b.st[0] = nloc; b.st[1] = nx; }
        const unsigned old = xb_add(&bar[XB_XSUB(b.x)], 1u);
        const unsigned gen = old / nloc;
        if (old + 1u == (gen + 1u) * nloc) {
            __builtin_amdgcn_fence(__ATOMIC_RELEASE, "agent");
            asm volatile("s_waitcnt vmcnt(0)" ::: "memory");
            const unsigned og = xb_add(&bar[XB_TOP], 1u);
            const unsigned tg = og / nx;
            if (og + 1u == (tg + 1u) * nx) xb_add(&bar[XB_TOPGEN], 1u);
            else XB_SPIN(xb_ld(&bar[XB_TOPGEN]) == tg, bar);
            __builtin_amdgcn_fence(__ATOMIC_ACQUIRE, "agent");
            xb_add(&bar[XB_XGEN(b.x)], 1u);
            asm volatile("s_waitcnt vmcnt(0)" ::: "memory");
        } else {
            XB_SPIN(xb_ld(&bar[XB_XGEN(b.x)]) == gen, bar);
            __builtin_amdgcn_fence(__ATOMIC_ACQUIRE, "agent");
            asm volatile("s_waitcnt vmcnt(0)" ::: "memory");
        }
    }
    __syncthreads();
}

constexpr int PH_PER_LAYER = 14, N_PHASES = 2 * PH_PER_LAYER + 1;

__global__ void __launch_bounds__(512, 2) fwd_megakernel(Params pk) {
    extern __shared__ __attribute__((aligned(16))) unsigned char shm[];
    LAS unsigned char* lds = (LAS unsigned char*)shm;
    cg::grid_group grid = cg::this_grid();
    const int phase_lo = pk.phase_lo, phase_hi = pk.phase_hi;
    volatile LAS unsigned* xst = (volatile LAS unsigned*)(lds + LDS_BYTES - 16);
    XcdBarrier xb; xb.bar = pk.bar; xb.x = 0; xb.st = xst;
    if (phase_hi - phase_lo > 1) { if (threadIdx.x == 0) { xst[0] = 0u; xst[1] = 0u; } __syncthreads(); xb = xcd_barrier_post(pk.bar, xst); }
    for (int ph = phase_lo; ph < phase_hi; ++ph) {
        const int l = ph / PH_PER_LAYER, q = ph % PH_PER_LAYER;
        if (ph == N_PHASES - 1) {
            const Params p = load_params();
            phase_rmsnorm(p.out, p.final_g, nullptr, p.out);
        } else if (q == 0) {
            phase_convert(l, shm);
            const Params p = load_params();
            phase_rmsnorm(l == 0 ? p.x : p.out, p.norm_g + (size_t)l * DM, p.xn, nullptr);
        } else if (q == 1 || q == 5 || q == 8) {
            const Params p = load_params(); const int G = gridDim.x, cidx = opaque_bid();
            const int N = (q == 1) ? LDA_H : (q == 5) ? LDB_H : LDC_H; const int r0 = (q == 1) ? 0 : (q == 5) ? LDA_H : (LDA_H + LDB_H);
            pg8::GemmDesc g; g.A = p.xn; g.Bt = p.Wt + (size_t)r0 * DM; g.lda = DM;
            pg8::Sched S; S.init(T_TOK, N, G, cidx, 1);
            pg8::EpiStore E; E.O = p.H; E.ldc = N;
{ const int nrep = (PROBE_Q == 1 && l == 0 && q == 1) ? 2 : 1; for (int rep = 0; rep < nrep; ++rep) pg8::gemm_phase(lds, g, g, S, E); }
        } else if (q == 2) {
{ const int nrep = (PROBE_Q == 2 && l == 0) ? 2 : 1; for (int rep = 0; rep < nrep; ++rep) phase_rwkv(l, shm, nullptr); }
        } else if (q == 3) {
            phase_rwkv_post(l, nullptr);
        } else if (q == 6) {
{ const int nrep = (PROBE_Q == 6 && l == 0) ? 2 : 1; for (int rep = 0; rep < nrep; ++rep) { const Params p = load_params(); phase_sgu(l, shm, rep + 1 < nrep ? (bf16_t*)p.out : nullptr); } }
        } else if (q == 9) {
            { const int nrep = (PROBE_Q == 9 && l == 0) ? 2 : 1; for (int rep = 0; rep < nrep; ++rep) phase_hgrn_pre(l, shm, rep + 1 < nrep); }
        } else if (q == 10) {
            { const int nrep = (PROBE_Q == 10 && l == 0) ? 2 : 1; for (int rep = 0; rep < nrep; ++rep) phase_hgrn_seq(l, shm, rep + 1 < nrep); }
        } else if (q == 11) {
            phase_hgrn_post(l);
        } else if (q == 4 || q == 7 || q == 12) {
            const Params p = load_params(); const int G = gridDim.x, cidx = opaque_bid();
            bf16_t* WtBr = p.Wt + (size_t)WT_ROWS * DM;
            const int n = (q == 4) ? 0 : (q == 7) ? 1 : 2; const int ldh = (n == 0) ? LDA_H : (n == 1) ? LDB_H : LDC_H; const int ocol = (n == 0) ? 3200 : (n == 1) ? 2048 : 3072;
            pg8::GemmDesc g0, g1; g0.A = p.xn; g0.Bt = p.Wt + (size_t)(LDA_H + LDB_H + LDC_H + n * DM) * DM; g0.lda = DM;
            g1.A = p.H + ocol; g1.Bt = WtBr + (size_t)n * DM * DM; g1.lda = ldh;
            pg8::Sched S; S.init(T_TOK, DM, G, cidx, 2);
            pg8::EpiMerge E; E.G = p.H; E.ldg = ldh; E.bias = p.b_merge + ((size_t)l * 3 + n) * DM; E.Y = p.y; E.accum = (n > 0);
            { const int nrep = (PROBE_Q == 4 && l == 0 && q == 4) ? 2 : 1; for (int rep = 0; rep < nrep; ++rep) pg8::gemm_phase(lds, g0, g1, S, E); }
        } else {
            const Params p = load_params(); const int G = gridDim.x, cidx = opaque_bid();
            bf16_t* WtOut = p.Wt + (size_t)WT_ROWS * DM + (size_t)3 * DM * DM;
            pg8::GemmDesc g; g.A = p.y; g.Bt = WtOut; g.lda = DM;
            pg8::Sched S; S.init(T_TOK, DM, G, cidx, 1);
            pg8::EpiResid E; E.Xin = (l == 0) ? p.x : p.out; E.Xout = p.out;
            pg8::gemm_phase(lds, g, g, S, E);
        }
        if (ph + 1 < phase_hi) { if (ph == phase_lo) grid.sync(); else xcd_barrier(xb); }
    }
}

extern "C" void kernel_launch(void* const* d_in, const int* in_sizes, int n_in, void* d_out, int out_size, void* d_ws, size_t ws_size, hipStream_t stream) {
    static int grid_blocks = 0;
    if (!grid_blocks) {
        int dev = 0, cus = 0, per_cu = 0;
        hipGetDevice(&dev);
        hipDeviceGetAttribute(&cus, hipDeviceAttributeMultiprocessorCount, dev);
        if (hipFuncSetAttribute((const void*)fwd_megakernel, hipFuncAttributeMaxDynamicSharedMemorySize, LDS_BYTES) != hipSuccess) { fprintf(stderr, "hipFuncSetAttribute failed\n"); return; }
        hipOccupancyMaxActiveBlocksPerMultiprocessor(&per_cu, (const void*)fwd_megakernel, 512, LDS_BYTES);
        if (per_cu < 1) { fprintf(stderr, "occupancy query says 0 blocks per CU\n"); return; }
        grid_blocks = cus * 1;
    }
    Params p{};
    const float** fp = (const float**)&p;
    for (int i = 0; i < 26; ++i) fp[i] = (const float*)d_in[i];
    p.out = (float*)d_out;
    unsigned char* ws = (unsigned char*)d_ws; size_t off = 0;
    auto take = [&](size_t bytes) { unsigned char* r = ws + off; off += (bytes + 255) & ~(size_t)255; return r; };
    p.Wt = (bf16_t*)take(((size_t)WT_ROWS * DM + 4 * (size_t)DM * DM) * 2);
    p.xn = (bf16_t*)take((size_t)T_TOK * DM * 2);
    p.vf = (bf16_t*)take((size_t)T_TOK * DM * 2);
    p.y = (bf16_t*)take((size_t)T_TOK * DM * 2);
    p.H = (bf16_t*)take((size_t)T_TOK * LDA_H * 2);
    p.rkbuf = (float*)take((size_t)T_TOK * 16 * 2 * 4);
    p.bar = (unsigned*)take((size_t)XCD_BAR_WORDS * 4);
    if (off > ws_size) { fprintf(stderr, "workspace too small: need %zu have %zu\n", off, ws_size); return; }
#if SINGLE_LAUNCH
    p.phase_lo = 0; p.phase_hi = N_PHASES;
    void* args[] = {&p};
    if (hipMemsetAsync(p.bar, 0, (size_t)XCD_BAR_WORDS * 4, stream) != hipSuccess) { fprintf(stderr, "memset failed\n"); return; }
    hipError_t e = hipLaunchCooperativeKernel((const void*)fwd_megakernel, dim3(grid_blocks), dim3(512), args, LDS_BYTES, stream);
    if (e != hipSuccess) fprintf(stderr, "cooperative launch failed: %s (grid %d)\n", hipGetErrorString(e), grid_blocks);
#else
    for (int ph = 0; ph < N_PHASES; ++ph) {
        p.phase_lo = ph; p.phase_hi = ph + 1;
        hipLaunchKernelGGL(fwd_megakernel, dim3(grid_blocks), dim3(512), LDS_BYTES, stream, p);
    }
#endif
}
```

```cpp
#include <hip/hip_runtime.h>
#include <hip/hip_cooperative_groups.h>
#include <cstdio>
namespace cg = cooperative_groups;

#ifndef PROBE_Q
#define PROBE_Q -1
#endif
#ifndef SINGLE_LAUNCH
#define SINGLE_LAUNCH 1
#endif

typedef unsigned short bf16_t;
typedef short bf16x8 __attribute__((ext_vector_type(8)));
typedef float f32x4 __attribute__((ext_vector_type(4)));
typedef float f32x2 __attribute__((ext_vector_type(2)));
typedef unsigned u32x4 __attribute__((ext_vector_type(4)));
typedef unsigned u32x2 __attribute__((ext_vector_type(2)));
#define LAS __attribute__((address_space(3)))

constexpr int T_TOK = 32768, DM = 1024, SEQ = 4096, NB = 8;
constexpr int N_IN = 14464;
constexpr int LDA_H = 4352, LDB_H = 3072, LDC_H = 4096;
constexpr int WT_ROWS = 14592;
constexpr int LDS_BYTES = 163840;
constexpr float EPS = 1e-6f, GN_EPS = 64e-5f;

struct Params {
    const float *x, *norm_g, *w_in, *b_merge, *mu, *w0, *w_w2, *a0, *a_w2, *v0, *v_w1, *v_w2, *k_k, *k_a, *r_k, *lnx_g, *lnx_b,
        *sgu_ln_g, *sgu_ln_b, *sgu_w, *sgu_b, *lb_logits, *hgrn_g, *w_branch, *w_out, *final_g;
    float* out;
    bf16_t *Wt, *xn, *vf, *y, *H;
    float* rkbuf;
    unsigned* bar;
    int phase_lo, phase_hi;
};

__device__ __forceinline__ float bf2f(bf16_t h) { return __uint_as_float(((unsigned)h) << 16); }
__device__ __forceinline__ float bflo(unsigned u) { return __uint_as_float(u << 16); }
__device__ __forceinline__ float bfhi(unsigned u) { return __uint_as_float(u & 0xffff0000u); }
typedef __bf16 bf16x2_t __attribute__((ext_vector_type(2)));
__device__ __forceinline__ unsigned cvt_pk_bf16(float lo, float hi) { const f32x2 v = {lo, hi}; const bf16x2_t r = __builtin_convertvector(v, bf16x2_t); return __builtin_bit_cast(unsigned, r); }
__device__ __forceinline__ bf16_t f2bf(float f) { return (bf16_t)(cvt_pk_bf16(f, 0.f) & 0xffffu); }
__device__ __forceinline__ float sigmoidf_(float x) { return __builtin_amdgcn_rcpf(1.0f + __expf(-x)); }
__device__ __forceinline__ float siluf_(float x) { return x * __builtin_amdgcn_rcpf(1.0f + __expf(-x)); }
__device__ __forceinline__ float tanh_fast(float x) { return 1.0f - 2.0f * __builtin_amdgcn_rcpf(1.0f + __expf(2.0f * x)); }

__device__ __forceinline__ Params load_params() {
#if defined(__HIP_DEVICE_COMPILE__)
    typedef const Params __attribute__((address_space(4)))* KP;
    KP kp = (KP)__builtin_amdgcn_kernarg_segment_ptr(); asm volatile("" : "+s"(kp)); return *kp;
#else
    return Params{};
#endif
}
__device__ __forceinline__ int opaque_tid() { int t = threadIdx.x; asm volatile("" : "+v"(t)); return t; }
__device__ __forceinline__ int opaque_bid() { int t = blockIdx.x; asm volatile("" : "+s"(t)); return t; }

namespace pg8 {
constexpr int BM = 256, BK = 64, HALF = 128, HTB = HALF * BK * 2, STAGE_BYTES = 8 * HTB, NXCD = 8, WGM = 8, KD = 1024;
__device__ __forceinline__ int lds_byte(int r, int c) { const int st = (r >> 4) * 2 + (c >> 5), rr = r & 15, cc = c & 31, ob = rr * 64 + cc * 2; return st * 1024 + (ob ^ (((ob >> 9) & 1) << 5)); }
__device__ __forceinline__ void stage_rc(int b, int& R, int& C) { const int st = b / 1024, sb = b % 1024, swz = sb ^ (((sb >> 9) & 1) << 5); R = (st >> 1) * 16 + swz / 64; C = (st & 1) * 32 + (swz % 64) / 2; }
__device__ __forceinline__ int perm32(int rho) { const int n = rho >> 4, i = rho & 15; return 8 * (i >> 2) + 4 * n + (i & 3); }

struct Unit { int pm, pn, sel; };
struct GemmDesc { const bf16_t* A; const bf16_t* Bt; int lda; };
struct Sched {
    int nM, nN, nwg, G, c, nsel;
    __device__ void init(int M, int N, int G_, int c_, int nsel_) { nM = M / BM; nN = N / BM; nwg = nM * nN; G = G_; c = c_; nsel = nsel_; }
    __device__ bool next(int i, Unit& u) const {
        const int ti = (nsel == 2) ? (i >> 1) : i; u.sel = (nsel == 2) ? (i & 1) : 0;
        const long L = (long)ti * G + c; if (L >= nwg) return false;
        int wgid = (int)L; { const int q = nwg / NXCD, r = nwg % NXCD, xcd = wgid % NXCD, off = wgid / NXCD; wgid = (xcd < r ? xcd * (q + 1) : r * (q + 1) + (xcd - r) * q) + off; }
        const int nig = WGM * nN, gid = wgid / nig, fm = gid * WGM, gsz = (nM - fm) < WGM ? (nM - fm) : WGM;
        u.pm = fm + ((wgid % nig) % gsz); u.pn = (wgid % nig) / gsz; return true;
    }
};

template <class Epi>
__device__ __forceinline__ void gemm_phase(LAS unsigned char* lds, const GemmDesc g0, const GemmDesc g1, const Sched& S, const Epi& E) {
    const int tid = opaque_tid(), wid = __builtin_amdgcn_readfirstlane(tid >> 6), lane = tid & 63, wr = wid >> 2, wc = wid & 3, fr = lane & 15, fq = lane >> 4;
    constexpr int K = KD, nt = K / BK;
    unsigned voffA0[2], voffA1[2], voffB[2];
#pragma unroll
    for (int i = 0; i < 2; ++i) { int R, C; stage_rc(tid * 16 + i * 8192, R, C); const int Rb = Epi::PERM ? ((R & ~31) + perm32(R & 31)) : R;
        voffA0[i] = (unsigned)(R * g0.lda + C) * 2u; voffA1[i] = (unsigned)(R * g1.lda + C) * 2u; voffB[i] = (unsigned)(Rb * K + C) * 2u; }
    const size_t kstep = (size_t)(BK * 2);
    const size_t hstepB = (size_t)HALF * K * 2;
    const unsigned ldsw = (unsigned)wid * 1024u;
    const int aoff = lds_byte(wr * 64 + fr, fq * 8), boff = lds_byte(wc * 32 + fr, fq * 8);
#define PG8_SA(b, h) (((b) * 2 + (h)) * HTB)
#define PG8_SB(b, h) ((4 + (b) * 2 + (h)) * HTB)
#define PG8_STAGE(bufoff, gbase, v0, v1) do { \
        __builtin_amdgcn_global_load_lds((const unsigned*)((const char*)(gbase) + (v0)), (LAS unsigned*)(lds + (bufoff) + ldsw), 16, 0, 0); \
        __builtin_amdgcn_global_load_lds((const unsigned*)((const char*)(gbase) + (v1)), (LAS unsigned*)(lds + (bufoff) + ldsw + 8192), 16, 0, 0); } while (0)
#define PG8_STAGEB(bufoff, gbase) PG8_STAGE(bufoff, gbase, voffB[0], voffB[1])
#define PG8_LDA(dst, b, h) do { _Pragma("unroll") for (int m = 0; m < 4; ++m) _Pragma("unroll") for (int k = 0; k < 2; ++k) dst[m][k] = *(const LAS bf16x8*)(lds + PG8_SA(b, h) + aoff + m * 2048 + k * 1024); } while (0)
#define PG8_LDB(dst, b, h) do { _Pragma("unroll") for (int n = 0; n < 2; ++n) _Pragma("unroll") for (int k = 0; k < 2; ++k) dst[n][k] = *(const LAS bf16x8*)(lds + PG8_SB(b, h) + boff + n * 2048 + k * 1024); } while (0)
#define PG8_MMA(ai, bj, At, Bt) do { __builtin_amdgcn_s_setprio(1); _Pragma("unroll") for (int m = 0; m < 4; ++m) _Pragma("unroll") for (int n = 0; n < 2; ++n) _Pragma("unroll") for (int k = 0; k < 2; ++k) \
        acc[ai][bj][m][n] = __builtin_amdgcn_mfma_f32_16x16x32_bf16(Bt[n][k], At[m][k], acc[ai][bj][m][n], 0, 0, 0); __builtin_amdgcn_s_setprio(0); } while (0)
#define PG8_WAIT_V(n) asm volatile("s_waitcnt vmcnt(" #n ")" ::: "memory")
#define PG8_WAIT_L(n) asm volatile("s_waitcnt lgkmcnt(" #n ")" ::: "memory")
#define PG8_BAR __builtin_amdgcn_s_barrier()
#define PG8_SCHED __builtin_amdgcn_sched_barrier(0)
    Unit cur, nxt; int ui = 0;
    if (!S.next(0, cur)) return;
    f32x4 acc[2][2][4][2];
#pragma unroll
    for (int a = 0; a < 2; ++a)
#pragma unroll
        for (int b = 0; b < 2; ++b)
#pragma unroll
            for (int m = 0; m < 4; ++m)
#pragma unroll
                for (int n = 0; n < 2; ++n) acc[a][b][m][n] = (f32x4){0.f, 0.f, 0.f, 0.f};
    bf16x8 At[4][2], B0[2][2], B1[2][2];
    const char* cA = (const char*)(cur.sel ? g1.A : g0.A) + (size_t)cur.pm * 256 * (size_t)(cur.sel ? g1.lda : g0.lda) * 2;
    const char* cB = (const char*)(cur.sel ? g1.Bt : g0.Bt) + (size_t)cur.pn * 256 * K * 2;
    size_t chA = (size_t)HALF * (cur.sel ? g1.lda : g0.lda) * 2;
    unsigned cv0 = cur.sel ? voffA1[0] : voffA0[0], cv1 = cur.sel ? voffA1[1] : voffA0[1];
    PG8_STAGEB(PG8_SB(0, 0), cB); PG8_STAGE(PG8_SA(0, 0), cA, cv0, cv1); PG8_STAGEB(PG8_SB(0, 1), cB + hstepB); PG8_STAGE(PG8_SA(0, 1), cA + chA, cv0, cv1);
    if (wr == 1) PG8_BAR;
    PG8_WAIT_V(4); PG8_BAR;
    PG8_STAGEB(PG8_SB(1, 0), cB + kstep); PG8_STAGE(PG8_SA(1, 0), cA + kstep, cv0, cv1); PG8_STAGEB(PG8_SB(1, 1), cB + hstepB + kstep);
    PG8_WAIT_V(6); PG8_BAR;
    for (;;) {
        const bool has_next = S.next(ui + 1, nxt);
        const int nsel = has_next ? nxt.sel : cur.sel;
        const char* nA = has_next ? (const char*)(nsel ? g1.A : g0.A) + (size_t)nxt.pm * 256 * (size_t)(nsel ? g1.lda : g0.lda) * 2 : cA;
        const char* nB = has_next ? (const char*)(nsel ? g1.Bt : g0.Bt) + (size_t)nxt.pn * 256 * K * 2 : cB;
        const size_t nhA = (size_t)HALF * (nsel ? g1.lda : g0.lda) * 2;
        const unsigned nv0 = nsel ? voffA1[0] : voffA0[0], nv1 = nsel ? voffA1[1] : voffA0[1];
        for (int t = 0; t < nt; t += 2) {
            const bool last = (t == nt - 2);
            const char* a1 = cA + (size_t)(t + 1) * kstep;
            const char* a2 = last ? nA : cA + (size_t)(t + 2) * kstep; const char* b2 = last ? nB : cB + (size_t)(t + 2) * kstep;
            const char* a3 = a2 + kstep; const char* b3 = b2 + kstep;
            const size_t h2 = last ? nhA : chA; const unsigned w0 = last ? nv0 : cv0, w1 = last ? nv1 : cv1;
            PG8_LDB(B0, 0, 0); PG8_SCHED; PG8_LDA(At, 0, 0); PG8_STAGE(PG8_SA(1, 1), a1 + chA, cv0, cv1);
            PG8_WAIT_L(8); PG8_BAR; PG8_WAIT_L(0); PG8_MMA(0, 0, At, B0); PG8_BAR; PG8_SCHED;
            PG8_LDB(B1, 0, 1); PG8_STAGEB(PG8_SB(0, 0), b2);
            PG8_BAR; PG8_WAIT_L(0); PG8_MMA(0, 1, At, B1); PG8_BAR;
            PG8_LDA(At, 0, 1); PG8_STAGE(PG8_SA(0, 0), a2, w0, w1);
            PG8_BAR; PG8_WAIT_L(0); PG8_MMA(1, 0, At, B0); PG8_BAR; PG8_SCHED;
            PG8_STAGEB(PG8_SB(0, 1), b2 + hstepB);
            PG8_WAIT_V(6); PG8_BAR; PG8_MMA(1, 1, At, B1); PG8_BAR;
            PG8_LDB(B0, 1, 0); PG8_SCHED; PG8_LDA(At, 1, 0); PG8_STAGE(PG8_SA(0, 1), a2 + h2, w0, w1);
            PG8_WAIT_L(8); PG8_BAR; PG8_WAIT_L(0); PG8_MMA(0, 0, At, B0); PG8_BAR; PG8_SCHED;
            PG8_LDB(B1, 1, 1); PG8_STAGEB(PG8_SB(1, 0), b3);
            PG8_BAR; PG8_WAIT_L(0); PG8_MMA(0, 1, At, B1); PG8_BAR;
            PG8_LDA(At, 1, 1); PG8_STAGE(PG8_SA(1, 0), a3, w0, w1);
            PG8_BAR; PG8_WAIT_L(0); PG8_MMA(1, 0, At, B0); PG8_BAR; PG8_SCHED;
            PG8_STAGEB(PG8_SB(1, 1), b3 + hstepB);
            PG8_WAIT_V(6); PG8_BAR; PG8_MMA(1, 1, At, B1); PG8_BAR;
        }
        E(acc, cur, wr, wc, fr, fq);
        if (!has_next) break;
#pragma unroll
        for (int a = 0; a < 2; ++a)
#pragma unroll
            for (int b = 0; b < 2; ++b)
#pragma unroll
                for (int m = 0; m < 4; ++m)
#pragma unroll
                    for (int n = 0; n < 2; ++n) acc[a][b][m][n] = (f32x4){0.f, 0.f, 0.f, 0.f};
        cur = nxt; cA = nA; cB = nB; chA = nhA; cv0 = nv0; cv1 = nv1; ++ui;
    }
    PG8_WAIT_V(0);
    if (wr == 0) PG8_BAR;
    PG8_BAR;
#undef PG8_SA
#undef PG8_SB
#undef PG8_STAGE
#undef PG8_STAGEB
#undef PG8_LDA
#undef PG8_LDB
#undef PG8_MMA
#undef PG8_WAIT_V
#undef PG8_WAIT_L
#undef PG8_BAR
#undef PG8_SCHED
}

struct EpiStore {
    static constexpr bool PERM = true;
    bf16_t* O; int ldc;
    __device__ __forceinline__ void operator()(const f32x4 (&acc)[2][2][4][2], const Unit& u, int wr, int wc, int fr, int fq) const {
        const int row0 = u.pm * BM + wr * 64 + fr, col0 = u.pn * BM + wc * 32 + 8 * fq;
#pragma unroll
        for (int ai = 0; ai < 2; ++ai)
#pragma unroll
            for (int m = 0; m < 4; ++m) { bf16_t* rowp = O + (size_t)(row0 + ai * HALF + m * 16) * ldc + col0;
#pragma unroll
                for (int bj = 0; bj < 2; ++bj) { const f32x4 v0 = acc[ai][bj][m][0], v1 = acc[ai][bj][m][1];
                    u32x4 w; w.x = cvt_pk_bf16(v0[0], v0[1]); w.y = cvt_pk_bf16(v0[2], v0[3]); w.z = cvt_pk_bf16(v1[0], v1[1]); w.w = cvt_pk_bf16(v1[2], v1[3]);
                    *(u32x4*)(rowp + bj * HALF) = w; } }
    }
};
struct EpiMerge {
    static constexpr bool PERM = true;
    bf16_t* G; int ldg; const float* bias; bf16_t* Y; int accum;
    __device__ __forceinline__ void operator()(const f32x4 (&acc)[2][2][4][2], const Unit& u, int wr, int wc, int fr, int fq) const {
        const int row0 = u.pm * BM + wr * 64 + fr, col0 = u.pn * BM + wc * 32 + 8 * fq;
        if (u.sel == 0) {
            f32x4 bv[2][2];
#pragma unroll
            for (int bj = 0; bj < 2; ++bj)
#pragma unroll
                for (int n = 0; n < 2; ++n) bv[bj][n] = *(const f32x4*)(bias + col0 + bj * HALF + 4 * n);
#pragma unroll
            for (int ai = 0; ai < 2; ++ai)
#pragma unroll
                for (int m = 0; m < 4; ++m) { bf16_t* rowp = G + (size_t)(row0 + ai * HALF + m * 16) * ldg + col0;
#pragma unroll
                    for (int bj = 0; bj < 2; ++bj) { f32x4 v0 = acc[ai][bj][m][0] + bv[bj][0], v1 = acc[ai][bj][m][1] + bv[bj][1];
#pragma unroll
                        for (int j = 0; j < 4; ++j) { v0[j] = sigmoidf_(v0[j]); v1[j] = sigmoidf_(v1[j]); }
                        u32x4 w; w.x = cvt_pk_bf16(v0[0], v0[1]); w.y = cvt_pk_bf16(v0[2], v0[3]); w.z = cvt_pk_bf16(v1[0], v1[1]); w.w = cvt_pk_bf16(v1[2], v1[3]);
                        *(u32x4*)(rowp + bj * HALF) = w; } }
        } else {
#pragma unroll
            for (int ai = 0; ai < 2; ++ai)
#pragma unroll
                for (int m = 0; m < 4; ++m) { const size_t r = (size_t)(row0 + ai * HALF + m * 16);
                    const unsigned long long* gp = (const unsigned long long*)(G + r * ldg + col0); bf16_t* yp = Y + r * DM + col0;
#pragma unroll
                    for (int bj = 0; bj < 2; ++bj) {
                        const unsigned long long g0 = __hip_atomic_load(gp + bj * (HALF / 4), __ATOMIC_RELAXED, __HIP_MEMORY_SCOPE_AGENT);
                        const unsigned long long g1 = __hip_atomic_load(gp + bj * (HALF / 4) + 1, __ATOMIC_RELAXED, __HIP_MEMORY_SCOPE_AGENT);
                        const unsigned gw[4] = {(unsigned)g0, (unsigned)(g0 >> 32), (unsigned)g1, (unsigned)(g1 >> 32)};
                        u32x4 yo = {0u, 0u, 0u, 0u}; if (accum) yo = *(const u32x4*)(yp + bj * HALF);
                        const f32x4 v0 = acc[ai][bj][m][0], v1 = acc[ai][bj][m][1];
                        u32x4 w;
                        w.x = cvt_pk_bf16(bflo(yo.x) + bflo(gw[0]) * v0[0], bfhi(yo.x) + bfhi(gw[0]) * v0[1]);
                        w.y = cvt_pk_bf16(bflo(yo.y) + bflo(gw[1]) * v0[2], bfhi(yo.y) + bfhi(gw[1]) * v0[3]);
                        w.z = cvt_pk_bf16(bflo(yo.z) + bflo(gw[2]) * v1[0], bfhi(yo.z) + bfhi(gw[2]) * v1[1]);
                        w.w = cvt_pk_bf16(bflo(yo.w) + bflo(gw[3]) * v1[2], bfhi(yo.w) + bfhi(gw[3]) * v1[3]);
                        *(u32x4*)(yp + bj * HALF) = w; } }
        }
    }
};
struct EpiResid {
    static constexpr bool PERM = false;
    const float* Xin; float* Xout;
    __device__ __forceinline__ void operator()(const f32x4 (&acc)[2][2][4][2], const Unit& u, int wr, int wc, int fr, int fq) const {
        const int row0 = u.pm * BM + wr * 64 + fr, col0 = u.pn * BM + wc * 32 + 4 * fq;
#pragma unroll
        for (int ai = 0; ai < 2; ++ai)
#pragma unroll
            for (int m = 0; m < 4; ++m) { const size_t ro = (size_t)(row0 + ai * HALF + m * 16) * DM + col0;
#pragma unroll
                for (int bj = 0; bj < 2; ++bj)
#pragma unroll
                    for (int n = 0; n < 2; ++n) { const f32x4 xi = *(const f32x4*)(Xin + ro + bj * HALF + n * 16); *(f32x4*)(Xout + ro + bj * HALF + n * 16) = xi + acc[ai][bj][m][n]; } }
    }
};
}

__device__ void phase_convert(int l, unsigned char* smem) {
    const Params p = load_params();
    float* tile = (float*)smem;
    const int tid = opaque_tid();
    const float* win = p.w_in + (size_t)l * DM * N_IN;
    bf16_t* WtIn = p.Wt; bf16_t* WtBr = p.Wt + (size_t)WT_ROWS * DM; bf16_t* WtOut = WtBr + (size_t)3 * DM * DM;
    const int NT_IN = WT_ROWS / 64;
    const int total = (NT_IN + 48 + 16) * 16;
    for (int it = blockIdx.x; it < total; it += gridDim.x) {
        const int ntile = it >> 4, kt = it & 15, k0 = kt * 64;
        const float* src = nullptr; int ld = 0, c0 = 0, valid = 64; bf16_t* dst;
        if (ntile < NT_IN) {
            const int n0 = ntile * 64; dst = WtIn + (size_t)n0 * DM;
            if (n0 < 4224) { src = win; ld = N_IN; c0 = n0; }
            else if (n0 < 4352) { if (n0 == 4224 && l > 0) { src = p.v_w1 + (size_t)(l - 1) * DM * 32; ld = 32; c0 = 0; valid = 32; } else { valid = 0; } }
            else { src = win; ld = N_IN; c0 = n0 - 128; }
        } else if (ntile < NT_IN + 48) {
            const int q = ntile - NT_IN, n = q >> 4, n0 = (q & 15) * 64;
            src = p.w_branch + ((size_t)l * 3 + n) * DM * DM; ld = DM; c0 = n0; dst = WtBr + ((size_t)n * DM + n0) * DM;
        } else {
            const int n0 = (ntile - NT_IN - 48) * 64; src = p.w_out + (size_t)l * DM * DM; ld = DM; c0 = n0; dst = WtOut + (size_t)n0 * DM;
        }
        __syncthreads();
        if (valid == 64) {
            const int kr = tid >> 4, nc = (tid & 15) * 4;
#pragma unroll
            for (int ps = 0; ps < 2; ++ps) { const int k = kr + ps * 32; const f32x4 v = *(const f32x4*)(src + (size_t)(k0 + k) * ld + c0 + nc);
                tile[k * 65 + nc] = v[0]; tile[k * 65 + nc + 1] = v[1]; tile[k * 65 + nc + 2] = v[2]; tile[k * 65 + nc + 3] = v[3]; }
        } else {
            for (int e = tid; e < 4096; e += 512) { const int k = e >> 6, n = e & 63; tile[k * 65 + n] = (n < valid) ? src[(size_t)(k0 + k) * ld + c0 + n] : 0.f; }
        }
        __syncthreads();
        { const int nr = tid >> 3, kc = (tid & 7) * 8; u32x4 w;
          w.x = cvt_pk_bf16(tile[(kc + 0) * 65 + nr], tile[(kc + 1) * 65 + nr]); w.y = cvt_pk_bf16(tile[(kc + 2) * 65 + nr], tile[(kc + 3) * 65 + nr]);
          w.z = cvt_pk_bf16(tile[(kc + 4) * 65 + nr], tile[(kc + 5) * 65 + nr]); w.w = cvt_pk_bf16(tile[(kc + 6) * 65 + nr], tile[(kc + 7) * 65 + nr]);
          *(u32x4*)(dst + (size_t)nr * DM + k0 + kc) = w; }
    }
    __syncthreads();
}

__device__ void phase_rmsnorm(const float* x, const float* g, bf16_t* xn, float* outf) {
    const int tid_ = opaque_tid(); const int lane = tid_ & 63, wv = tid_ >> 6;
    f32x4 gv[4];
#pragma unroll
    for (int q = 0; q < 4; ++q) gv[q] = *(const f32x4*)(g + q * 256 + lane * 4);
    for (int row = blockIdx.x * 8 + wv; row < T_TOK; row += gridDim.x * 8) {
        const float* xr = x + (size_t)row * DM; f32x4 v[4]; float ss = 0.f;
#pragma unroll
        for (int q = 0; q < 4; ++q) { v[q] = *(const f32x4*)(xr + q * 256 + lane * 4); ss += v[q][0] * v[q][0] + v[q][1] * v[q][1] + v[q][2] * v[q][2] + v[q][3] * v[q][3]; }
#pragma unroll
        for (int o = 32; o > 0; o >>= 1) ss += __shfl_xor(ss, o);
        const float rinv = rsqrtf(ss * (1.0f / DM) + EPS);
#pragma unroll
        for (int q = 0; q < 4; ++q) { const f32x4 o = v[q] * rinv * gv[q];
            if (xn) { u32x2 w; w.x = cvt_pk_bf16(o[0], o[1]); w.y = cvt_pk_bf16(o[2], o[3]); *(u32x2*)(xn + (size_t)row * DM + q * 256 + lane * 4) = w; }
            else *(f32x4*)(outf + (size_t)row * DM + q * 256 + lane * 4) = o; }
    }
}

template <int CTRL> __device__ __forceinline__ float dpp_f(float v) { return __int_as_float(__builtin_amdgcn_update_dpp(0, __float_as_int(v), CTRL, 0xf, 0xf, false)); }
__device__ __forceinline__ float red8(float v) { v += dpp_f<0xB1>(v); v += dpp_f<0x4E>(v); v += dpp_f<0x141>(v); return v; }
__device__ __forceinline__ float red16(float v) { v = red8(v); v += dpp_f<0x140>(v); return v; }

struct RwRaw { u32x4 cw[2], pw[2], ca[2], pa[2], vl; u32x2 cr[2], pr[2], ck[2], pk[2], cv, pv, vf; };
__device__ __forceinline__ void rw_load(RwRaw& R, const bf16_t* H, const bf16_t* vfp, int l, size_t tok, bool hasp, int h, int chh, int vnt, int fq) {
    const bf16_t* cur = H + tok * LDA_H; const bf16_t* prev = cur - LDA_H;
    const u32x4 z4 = {0u, 0u, 0u, 0u}; const u32x2 z2 = {0u, 0u};
#pragma unroll
    for (int ks = 0; ks < 2; ++ks) { const int m0 = ks * 32 + fq * 8;
        R.cw[ks] = *(const u32x4*)(cur + 3072 + m0); R.ca[ks] = *(const u32x4*)(cur + 3136 + m0);
        R.pw[ks] = hasp ? *(const u32x4*)(prev + 3072 + m0) : z4; R.pa[ks] = hasp ? *(const u32x4*)(prev + 3136 + m0) : z4; }
#pragma unroll
    for (int q = 0; q < 2; ++q) { const int cb = h * 64 + (chh * 2 + q) * 16 + fq * 4;
        R.cr[q] = *(const u32x2*)(cur + cb); R.ck[q] = *(const u32x2*)(cur + 1024 + cb);
        R.pr[q] = hasp ? *(const u32x2*)(prev + cb) : z2; R.pk[q] = hasp ? *(const u32x2*)(prev + 1024 + cb) : z2; }
    const int cbv = h * 64 + vnt * 16 + fq * 4;
    R.cv = *(const u32x2*)(cur + 2048 + cbv); R.pv = hasp ? *(const u32x2*)(prev + 2048 + cbv) : z2;
    R.vf = z2; R.vl = z4;
    if (l > 0) { R.vf = *(const u32x2*)(vfp + tok * DM + cbv); R.vl = *(const u32x4*)(cur + 4224 + fq * 8); }
}

__device__ void phase_rwkv(int l, unsigned char* smem, bf16_t* oalt) {
    const Params p = load_params();
    constexpr int TC = 32, NCH = SEQ / TC, BUFSZ = 5 * TC * 64 + TC * 32 + TC * 2;
    bf16_t* w2T = (bf16_t*)smem;
    bf16_t* a2T = w2T + 64 * 72;
    bf16_t* v2T = a2T + 64 * 72;
    float* cst = (float*)(v2T + 64 * 40);
    float* buf0 = cst + 11 * 64;
    float* ybuf = buf0 + 2 * BUFSZ;
    const int tid = opaque_tid(), wid = __builtin_amdgcn_readfirstlane(tid >> 6), lane = tid & 63, fr = lane & 15, fq = lane >> 4;
    for (int item = blockIdx.x; item < NB * 32; item += gridDim.x) {
        const int xc_ = item & 7, sl_ = item >> 3, half = sl_ & 1, pi_ = (sl_ >> 1) * 8 + xc_, b = pi_ >> 4, h = pi_ & 15;
        __syncthreads();
        for (int e = tid; e < 4096; e += 512) { const int m = e >> 6, j = e & 63; w2T[j * 72 + m] = f2bf(p.w_w2[((size_t)l * 64 + m) * DM + h * 64 + j]); a2T[j * 72 + m] = f2bf(p.a_w2[((size_t)l * 64 + m) * DM + h * 64 + j]); }
        if (l > 0) for (int e = tid; e < 2048; e += 512) { const int m = e >> 6, j = e & 63; v2T[j * 40 + m] = f2bf(p.v_w2[((size_t)(l - 1) * 32 + m) * DM + h * 64 + j]); }
        if (tid < 64) { const float* mu = p.mu + (size_t)l * 3200; const int cc = h * 64 + tid;
            cst[tid] = mu[cc]; cst[64 + tid] = mu[1024 + cc]; cst[128 + tid] = mu[2048 + cc]; cst[192 + tid] = p.w0[l * DM + cc]; cst[256 + tid] = p.a0[l * DM + cc];
            cst[320 + tid] = (l > 0) ? p.v0[(l - 1) * DM + cc] : 0.f; cst[384 + tid] = p.k_k[l * DM + cc]; cst[448 + tid] = p.k_a[l * DM + cc]; cst[512 + tid] = p.r_k[l * DM + cc];
            cst[576 + tid] = mu[3072 + tid]; cst[640 + tid] = mu[3136 + tid]; }
        __syncthreads();
        f32x2 st[4];
#pragma unroll
        for (int j = 0; j < 4; ++j) st[j] = (f32x2){0.f, 0.f};
        const int si = tid >> 3, seg = tid & 7;
        const int pwv = wid - 4, tti = pwv & 1, chh = (pwv >> 1) & 1, vnt = half * 2 + chh, tt = tti * 16 + fr;
        RwRaw raw;
        if (wid >= 4) rw_load(raw, p.H, p.vf, l, (size_t)b * SEQ + tt, tt > 0, h, chh, vnt, fq);
        for (int c = -1; c < NCH; ++c) {
            if (wid >= 4 && c + 1 < NCH) {
                float* B_ = buf0 + ((c + 1) & 1) * BUFSZ;
                float* sR = B_; float* sW = sR + TC * 64; float* sK = sW + TC * 64; float* sA = sK + TC * 64; float* sB = sA + TC * 64; float* sV = sB + TC * 64; float* sS = sV + TC * 32;
                const size_t tok = (size_t)b * SEQ + (c + 1) * TC + tt;
                const RwRaw cr_ = raw;
                if (c + 2 < NCH) rw_load(raw, p.H, p.vf, l, tok + TC, true, h, chh, vnt, fq);
                bf16x8 AfW[2], AfA[2];
#pragma unroll
                for (int ks = 0; ks < 2; ++ks) { const int m0 = ks * 32 + fq * 8;
                    const f32x4 mw0 = *(const f32x4*)(cst + 576 + m0), mw1 = *(const f32x4*)(cst + 576 + m0 + 4), ma0 = *(const f32x4*)(cst + 640 + m0), ma1 = *(const f32x4*)(cst + 640 + m0 + 4);
                    const float muw[8] = {mw0[0], mw0[1], mw0[2], mw0[3], mw1[0], mw1[1], mw1[2], mw1[3]}, mua[8] = {ma0[0], ma0[1], ma0[2], ma0[3], ma1[0], ma1[1], ma1[2], ma1[3]};
                    const unsigned cwv[4] = {cr_.cw[ks].x, cr_.cw[ks].y, cr_.cw[ks].z, cr_.cw[ks].w}, pwq[4] = {cr_.pw[ks].x, cr_.pw[ks].y, cr_.pw[ks].z, cr_.pw[ks].w};
                    const unsigned cav[4] = {cr_.ca[ks].x, cr_.ca[ks].y, cr_.ca[ks].z, cr_.ca[ks].w}, pav[4] = {cr_.pa[ks].x, cr_.pa[ks].y, cr_.pa[ks].z, cr_.pa[ks].w};
                    unsigned ow[4], oa[4];
#pragma unroll
                    for (int e = 0; e < 4; ++e) {
                        const float c0 = bflo(cwv[e]), c1 = bfhi(cwv[e]), q0 = bflo(pwq[e]), q1 = bfhi(pwq[e]);
                        ow[e] = cvt_pk_bf16(tanh_fast(c0 + muw[2 * e] * (q0 - c0)), tanh_fast(c1 + muw[2 * e + 1] * (q1 - c1)));
                        const float d0 = bflo(cav[e]), d1 = bfhi(cav[e]), r0 = bflo(pav[e]), r1 = bfhi(pav[e]);
                        oa[e] = cvt_pk_bf16(d0 + mua[2 * e] * (r0 - d0), d1 + mua[2 * e + 1] * (r1 - d1)); }
                    AfW[ks] = __builtin_bit_cast(bf16x8, ((u32x4){ow[0], ow[1], ow[2], ow[3]})); AfA[ks] = __builtin_bit_cast(bf16x8, ((u32x4){oa[0], oa[1], oa[2], oa[3]})); }
                f32x4 accW[2], accA[2], accV = (f32x4){0.f, 0.f, 0.f, 0.f};
#pragma unroll
                for (int q = 0; q < 2; ++q) { const int nt = chh * 2 + q; accW[q] = (f32x4){0.f, 0.f, 0.f, 0.f}; accA[q] = (f32x4){0.f, 0.f, 0.f, 0.f};
#pragma unroll
                    for (int ks = 0; ks < 2; ++ks) { const bf16x8 bw = *(const bf16x8*)(w2T + (nt * 16 + fr) * 72 + ks * 32 + fq * 8), ba = *(const bf16x8*)(a2T + (nt * 16 + fr) * 72 + ks * 32 + fq * 8);
                        accW[q] = __builtin_amdgcn_mfma_f32_16x16x32_bf16(bw, AfW[ks], accW[q], 0, 0, 0); accA[q] = __builtin_amdgcn_mfma_f32_16x16x32_bf16(ba, AfA[ks], accA[q], 0, 0, 0); } }
                if (l > 0) { const bf16x8 bv = *(const bf16x8*)(v2T + (vnt * 16 + fr) * 40 + fq * 8); accV = __builtin_amdgcn_mfma_f32_16x16x32_bf16(bv, __builtin_bit_cast(bf16x8, cr_.vl), accV, 0, 0, 0); }
                float ss = 0.f, rk = 0.f;
#pragma unroll
                for (int q = 0; q < 2; ++q) { const int ch0 = (chh * 2 + q) * 16 + fq * 4;
                    const float fr_[4] = {bflo(cr_.cr[q].x), bfhi(cr_.cr[q].x), bflo(cr_.cr[q].y), bfhi(cr_.cr[q].y)}, fpr[4] = {bflo(cr_.pr[q].x), bfhi(cr_.pr[q].x), bflo(cr_.pr[q].y), bfhi(cr_.pr[q].y)};
                    const float fk_[4] = {bflo(cr_.ck[q].x), bfhi(cr_.ck[q].x), bflo(cr_.ck[q].y), bfhi(cr_.ck[q].y)}, fpk[4] = {bflo(cr_.pk[q].x), bfhi(cr_.pk[q].x), bflo(cr_.pk[q].y), bfhi(cr_.pk[q].y)};
                    const f32x4 mur = *(const f32x4*)(cst + ch0), muk = *(const f32x4*)(cst + 64 + ch0), w0v = *(const f32x4*)(cst + 192 + ch0), a0v = *(const f32x4*)(cst + 256 + ch0),
                        kkv = *(const f32x4*)(cst + 384 + ch0), kav = *(const f32x4*)(cst + 448 + ch0), rkv = *(const f32x4*)(cst + 512 + ch0);
                    f32x4 ro, wo, ko, ao, bo;
#pragma unroll
                    for (int e = 0; e < 4; ++e) {
                        const float r = fr_[e] + mur[e] * (fpr[e] - fr_[e]), k = fk_[e] + muk[e] * (fpk[e] - fk_[e]);
                        const float xw = -(w0v[e] + accW[q][e]); const float sp = fmaxf(xw, 0.f) + __logf(1.0f + __expf(-fabsf(xw)));
                        wo[e] = __expf(-__expf(-sp - 0.5f));
                        const float a = sigmoidf_(a0v[e] + accA[q][e]);
                        const float kq = k * kkv[e]; ss += kq * kq; ao[e] = -kq; bo[e] = kq * a;
                        const float km = k * (1.0f + (a - 1.0f) * kav[e]); rk += r * km * rkv[e]; ro[e] = r; ko[e] = km; }
                    *(f32x4*)(sR + tt * 64 + ch0) = ro; *(f32x4*)(sW + tt * 64 + ch0) = wo; *(f32x4*)(sK + tt * 64 + ch0) = ko; *(f32x4*)(sA + tt * 64 + ch0) = ao; *(f32x4*)(sB + tt * 64 + ch0) = bo; }
                ss += __shfl_xor(ss, 16); ss += __shfl_xor(ss, 32); rk += __shfl_xor(rk, 16); rk += __shfl_xor(rk, 32);
                if (fq == 0) { sS[tt * 2 + chh] = ss; if (half == 0) p.rkbuf[(size_t)((b * 16 + h) * 2 + chh) * SEQ + (c + 1) * TC + tt] = rk; }
                { const int ch0 = vnt * 16 + fq * 4, cb = h * 64 + ch0;
                  const float fv_[4] = {bflo(cr_.cv.x), bfhi(cr_.cv.x), bflo(cr_.cv.y), bfhi(cr_.cv.y)}, fpv[4] = {bflo(cr_.pv.x), bfhi(cr_.pv.x), bflo(cr_.pv.y), bfhi(cr_.pv.y)};
                  const f32x4 muv = *(const f32x4*)(cst + 128 + ch0), v0v = *(const f32x4*)(cst + 320 + ch0);
                  f32x4 vo;
#pragma unroll
                  for (int e = 0; e < 4; ++e) vo[e] = fv_[e] + muv[e] * (fpv[e] - fv_[e]);
                  if (l > 0) { const float vfv[4] = {bflo(cr_.vf.x), bfhi(cr_.vf.x), bflo(cr_.vf.y), bfhi(cr_.vf.y)};
#pragma unroll
                      for (int e = 0; e < 4; ++e) vo[e] = vo[e] + (vfv[e] - vo[e]) * sigmoidf_(v0v[e] + accV[e]); }
                  u32x2 w; w.x = cvt_pk_bf16(vo[0], vo[1]); w.y = cvt_pk_bf16(vo[2], vo[3]); *(u32x2*)(p.vf + tok * DM + cb) = w;
                  *(f32x4*)(sV + tt * 32 + chh * 16 + fq * 4) = vo; }
            }
            if (wid < 4 && c >= 0) {
                const float* B_ = buf0 + (c & 1) * BUFSZ;
                const float* sR = B_; const float* sW = sR + TC * 64; const float* sK = sW + TC * 64; const float* sA = sK + TC * 64; const float* sB = sA + TC * 64; const float* sV = sB + TC * 64; const float* sS = sV + TC * 32;
                f32x4 A0, A1, W0, W1, B0, B1, K0, K1, R0, R1; float VI; f32x2 PS;
#define SC_LOAD(s_) do { const int o_ = (s_) * 64 + seg * 8; \
                    A0 = *(const f32x4*)(sA + o_); A1 = *(const f32x4*)(sA + o_ + 4); W0 = *(const f32x4*)(sW + o_); W1 = *(const f32x4*)(sW + o_ + 4); \
                    B0 = *(const f32x4*)(sB + o_); B1 = *(const f32x4*)(sB + o_ + 4); K0 = *(const f32x4*)(sK + o_); K1 = *(const f32x4*)(sK + o_ + 4); \
                    R0 = *(const f32x4*)(sR + o_); R1 = *(const f32x4*)(sR + o_ + 4); VI = sV[(s_) * 32 + si]; PS = *(const f32x2*)(sS + (s_) * 2); } while (0)
                SC_LOAD(0);
#pragma unroll 4
                for (int s = 0; s < TC; ++s) {
                    const f32x4 a0 = A0, a1 = A1, w0 = W0, w1 = W1, b0 = B0, b1 = B1, k0 = K0, k1 = K1, r0 = R0, r1 = R1; const float vi = VI; const f32x2 ps = PS;
                    if (s + 1 < TC) SC_LOAD(s + 1);
                    __builtin_amdgcn_sched_barrier(0);
                    const float inv2 = __builtin_amdgcn_rcpf(fmaxf(ps.x + ps.y, 1e-24f));
                    const f32x2 av[4] = {{a0[0], a0[1]}, {a0[2], a0[3]}, {a1[0], a1[1]}, {a1[2], a1[3]}}, wv[4] = {{w0[0], w0[1]}, {w0[2], w0[3]}, {w1[0], w1[1]}, {w1[2], w1[3]}};
                    const f32x2 bv[4] = {{b0[0], b0[1]}, {b0[2], b0[3]}, {b1[0], b1[1]}, {b1[2], b1[3]}}, kv[4] = {{k0[0], k0[1]}, {k0[2], k0[3]}, {k1[0], k1[1]}, {k1[2], k1[3]}};
                    const f32x2 rv[4] = {{r0[0], r0[1]}, {r0[2], r0[3]}, {r1[0], r1[1]}, {r1[2], r1[3]}};
                    const f32x2 vi2 = {vi, vi};
                    f32x2 vk[4];
#pragma unroll
                    for (int j = 0; j < 4; ++j) vk[j] = vi2 * kv[j];
                    const f32x2 pa = st[0] * av[0] + st[1] * av[1], pb = st[2] * av[2] + st[3] * av[3]; const f32x2 pc = pa + pb;
                    const float sa = red8(pc.x + pc.y) * inv2;
                    const f32x2 sa2 = {sa, sa};
#pragma unroll
                    for (int j = 0; j < 4; ++j) st[j] = st[j] * wv[j] + (sa2 * bv[j] + vk[j]);
                    const f32x2 qa = st[0] * rv[0] + st[1] * rv[1], qb = st[2] * rv[2] + st[3] * rv[3]; const f32x2 qc = qa + qb;
                    const float yy = red8(qc.x + qc.y);
                    if (seg == 0) ybuf[s * 32 + si] = yy;
                }
#undef SC_LOAD
                { const int tk = lane >> 1, rq = (lane & 1) * 4; const f32x4 yv = *(const f32x4*)(ybuf + tk * 32 + wid * 8 + rq);
                  u32x2 w; w.x = cvt_pk_bf16(yv[0], yv[1]); w.y = cvt_pk_bf16(yv[2], yv[3]);
                  *(u32x2*)(p.y + ((size_t)b * SEQ + c * TC + tk) * DM + h * 64 + half * 32 + wid * 8 + rq) = w; }
            }
            __syncthreads();
        }
    }
    __syncthreads();
}

__device__ void phase_rwkv_post(int l, bf16_t* oalt) {
    const Params p = load_params();
    const int tid = opaque_tid(), l8 = tid & 7;
    const int ngrp = T_TOK * 16;
    for (int g = blockIdx.x * 64 + (tid >> 3); g < ngrp; g += gridDim.x * 64) {
        const int tok = g >> 4, h = g & 15, cb = h * 64 + l8 * 8;
        const u32x4 y4 = *(const u32x4*)(p.y + (size_t)tok * DM + cb), b4 = *(const u32x4*)(p.vf + (size_t)tok * DM + cb);
        const int bb = tok / SEQ, tq = tok % SEQ; const float rk = p.rkbuf[(size_t)((bb * 16 + h) * 2) * SEQ + tq] + p.rkbuf[(size_t)((bb * 16 + h) * 2 + 1) * SEQ + tq];
        bf16_t* zp = p.H + (size_t)tok * LDA_H + 3200 + cb; const u32x4 z4 = *(const u32x4*)zp;
        const float yv[8] = {bflo(y4.x), bfhi(y4.x), bflo(y4.y), bfhi(y4.y), bflo(y4.z), bfhi(y4.z), bflo(y4.w), bfhi(y4.w)};
        const float bv[8] = {bflo(b4.x), bfhi(b4.x), bflo(b4.y), bfhi(b4.y), bflo(b4.z), bfhi(b4.z), bflo(b4.w), bfhi(b4.w)};
        const float zv[8] = {bflo(z4.x), bfhi(z4.x), bflo(z4.y), bfhi(z4.y), bflo(z4.z), bfhi(z4.z), bflo(z4.w), bfhi(z4.w)};
        float sm = 0.f;
#pragma unroll
        for (int e = 0; e < 8; ++e) sm += yv[e];
        sm = red8(sm); const float mean = sm * (1.0f / 64.f); float d[8], vs = 0.f;
#pragma unroll
        for (int e = 0; e < 8; ++e) { d[e] = yv[e] - mean; vs += d[e] * d[e]; }
        vs = red8(vs); const float rstd = rsqrtf(vs * (1.0f / 64.f) + GN_EPS);
        const f32x4 g0 = *(const f32x4*)(p.lnx_g + l * DM + cb), g1 = *(const f32x4*)(p.lnx_g + l * DM + cb + 4), c0 = *(const f32x4*)(p.lnx_b + l * DM + cb), c1 = *(const f32x4*)(p.lnx_b + l * DM + cb + 4);
        const float gg[8] = {g0[0], g0[1], g0[2], g0[3], g1[0], g1[1], g1[2], g1[3]}, cc[8] = {c0[0], c0[1], c0[2], c0[3], c1[0], c1[1], c1[2], c1[3]};
        float o[8];
#pragma unroll
        for (int e = 0; e < 8; ++e) o[e] = (d[e] * rstd * gg[e] + cc[e] + rk * bv[e]) * siluf_(zv[e]);
        u32x4 w; w.x = cvt_pk_bf16(o[0], o[1]); w.y = cvt_pk_bf16(o[2], o[3]); w.z = cvt_pk_bf16(o[4], o[5]); w.w = cvt_pk_bf16(o[6], o[7]);
        *(u32x4*)(oalt ? oalt + (size_t)tok * DM + cb : zp) = w;
    }
}

__device__ void phase_sgu(int l, unsigned char* smem, bf16_t* oalt) {
    const Params p = load_params();
    bf16_t* vnT = (bf16_t*)smem;
    float* stat = (float*)(smem + 128 * 136 * 2);
    const int tid = opaque_tid(), wid = tid >> 6, lane = tid & 63, fr = lane & 15, fq = lane >> 4;
    const float* lng = p.sgu_ln_g + (size_t)l * DM; const float* lnb = p.sgu_ln_b + (size_t)l * DM;
    for (int item = blockIdx.x; item < T_TOK / 128; item += gridDim.x) {
        bf16_t* Hb = p.H + (size_t)item * 128 * LDB_H;
        __syncthreads();
        for (int q = 0; q < 16; ++q) { const int s = wid * 16 + q; const bf16_t* vr = Hb + (size_t)s * LDB_H + 1024 + lane * 16;
            const u32x4 a = *(const u32x4*)vr, bq = *(const u32x4*)(vr + 8);
            const float f[16] = {bflo(a.x), bfhi(a.x), bflo(a.y), bfhi(a.y), bflo(a.z), bfhi(a.z), bflo(a.w), bfhi(a.w), bflo(bq.x), bfhi(bq.x), bflo(bq.y), bfhi(bq.y), bflo(bq.z), bfhi(bq.z), bflo(bq.w), bfhi(bq.w)};
            float sm = 0.f;
#pragma unroll
            for (int e = 0; e < 16; ++e) sm += f[e];
#pragma unroll
            for (int o = 32; o > 0; o >>= 1) sm += __shfl_xor(sm, o);
            const float mean = sm * (1.0f / DM); float vs = 0.f;
#pragma unroll
            for (int e = 0; e < 16; ++e) { const float d = f[e] - mean; vs += d * d; }
#pragma unroll
            for (int o = 32; o > 0; o >>= 1) vs += __shfl_xor(vs, o);
            if (lane == 0) { stat[s * 2] = mean; stat[s * 2 + 1] = rsqrtf(vs * (1.0f / DM) + EPS); } }
        __syncthreads();
        for (int g = 0; g < 8; ++g) {
            { const int s = tid >> 2, c0 = (tid & 3) * 32; const float mean = stat[s * 2], rstd = stat[s * 2 + 1];
              const bf16_t* vr = Hb + (size_t)s * LDB_H + 1024 + g * 128 + c0;
#pragma unroll
              for (int q = 0; q < 4; ++q) { const u32x4 a = *(const u32x4*)(vr + q * 8); const float f[8] = {bflo(a.x), bfhi(a.x), bflo(a.y), bfhi(a.y), bflo(a.z), bfhi(a.z), bflo(a.w), bfhi(a.w)};
#pragma unroll
                  for (int e = 0; e < 8; ++e) { const int c = c0 + q * 8 + e; const float vn = (f[e] - mean) * rstd * lng[g * 128 + c] + lnb[g * 128 + c]; vnT[c * 136 + s] = f2bf(vn); } } }
            __syncthreads();
            f32x4 acc[8];
#pragma unroll
            for (int i = 0; i < 8; ++i) acc[i] = (f32x4){0.f, 0.f, 0.f, 0.f};
            const int trow = wid * 16 + fr;
            const float* Wg = p.sgu_w + (((size_t)l * 8 + g) * 128 + trow) * 128;
            const int nks = (wid < 4) ? 2 : 4;
            for (int ks = 0; ks < nks; ++ks) {
                const f32x4 wa = *(const f32x4*)(Wg + ks * 32 + fq * 8), wb = *(const f32x4*)(Wg + ks * 32 + fq * 8 + 4);
                u32x4 wp; wp.x = cvt_pk_bf16(wa[0], wa[1]); wp.y = cvt_pk_bf16(wa[2], wa[3]); wp.z = cvt_pk_bf16(wb[0], wb[1]); wp.w = cvt_pk_bf16(wb[2], wb[3]);
                const bf16x8 wfrag = __builtin_bit_cast(bf16x8, wp);
#pragma unroll
                for (int ct = 0; ct < 8; ++ct) { const bf16x8 vfrag = *(const bf16x8*)(vnT + (ct * 16 + fr) * 136 + ks * 32 + fq * 8);
                    acc[ct] = __builtin_amdgcn_mfma_f32_16x16x32_bf16(vfrag, wfrag, acc[ct], 0, 0, 0); }
            }
            { const float bs = p.sgu_b[((size_t)l * 8 + g) * 128 + trow]; bf16_t* hr = Hb + (size_t)trow * LDB_H;
#pragma unroll
              for (int ct = 0; ct < 8; ++ct) { const int c = g * 128 + ct * 16 + fq * 4;
                  const u32x2 u2 = *(const u32x2*)(hr + c), z2 = *(const u32x2*)(hr + 2048 + c);
                  const float uf[4] = {bflo(u2.x), bfhi(u2.x), bflo(u2.y), bfhi(u2.y)}, zf[4] = {bflo(z2.x), bfhi(z2.x), bflo(z2.y), bfhi(z2.y)};
                  float o[4];
#pragma unroll
                  for (int j = 0; j < 4; ++j) o[j] = uf[j] * (acc[ct][j] + bs) * siluf_(zf[j]);
                  u32x2 w; w.x = cvt_pk_bf16(o[0], o[1]); w.y = cvt_pk_bf16(o[2], o[3]); *(u32x2*)(oalt ? oalt + ((size_t)item * 128 + trow) * DM + c : hr + 2048 + c) = w; } }
            __syncthreads();
        }
    }
    __syncthreads();
}

__device__ void phase_hgrn_pre(int l, unsigned char* smem, bool dry) {
    const Params p = load_params();
    float* LF = (float*)smem;
    bf16_t* IB = (bf16_t*)(LF + 64 * 132);
    bf16_t* KB = IB + 64 * 136;
    float* psum = (float*)(KB + 64 * 136);
    float* lbs = psum + 512;
    const int tid = opaque_tid();
    bf16_t* xtra = (l == 0) ? (bf16_t*)p.out : p.vf;
    __syncthreads();
    for (int e = tid; e < DM; e += 512) { float lb = 0.f; if (l == 1) { const float l0 = p.lb_logits[e], l1 = p.lb_logits[DM + e]; lb = __builtin_amdgcn_rcpf(1.0f + __expf(l0 - l1)); } lbs[e] = lb; }
    __syncthreads();
    const int t = tid >> 3, c0 = (tid & 7) * 16;
    const int cc = tid & 127, tq = tid >> 7;
    for (int item = blockIdx.x; item < NB * 64 * 8; item += gridDim.x) {
        const int h = item & 7, ch = (item >> 3) & 63, b = item >> 9;
        const size_t r0 = (size_t)b * SEQ + ch * 64;
        bf16_t* hr = p.H + (r0 + t) * LDC_H + h * 128 + c0;
        float qv[16], kv[16];
        {
            const u32x4 q0 = *(const u32x4*)hr, q1 = *(const u32x4*)(hr + 8), f0 = *(const u32x4*)(hr + 1024), f1 = *(const u32x4*)(hr + 1032), i0 = *(const u32x4*)(hr + 2048), i1 = *(const u32x4*)(hr + 2056);
            const unsigned qa[8] = {q0.x, q0.y, q0.z, q0.w, q1.x, q1.y, q1.z, q1.w}, fa[8] = {f0.x, f0.y, f0.z, f0.w, f1.x, f1.y, f1.z, f1.w};
            *(u32x4*)(IB + t * 136 + c0) = i0; *(u32x4*)(IB + t * 136 + c0 + 8) = i1;
            float lf[16];
#pragma unroll
            for (int e = 0; e < 8; ++e) {
                const float lb0 = lbs[h * 128 + c0 + 2 * e], lb1 = lbs[h * 128 + c0 + 2 * e + 1];
                qv[2 * e] = siluf_(bflo(qa[e])); qv[2 * e + 1] = siluf_(bfhi(qa[e]));
                const float g0 = lb0 + (1.0f - lb0) * sigmoidf_(bflo(fa[e])), g1 = lb1 + (1.0f - lb1) * sigmoidf_(bfhi(fa[e]));
                kv[2 * e] = 1.0f - g0; kv[2 * e + 1] = 1.0f - g1; lf[2 * e] = __logf(g0); lf[2 * e + 1] = __logf(g1); }
#pragma unroll
            for (int e = 0; e < 4; ++e) *(f32x4*)(LF + t * 132 + c0 + e * 4) = (f32x4){lf[e * 4], lf[e * 4 + 1], lf[e * 4 + 2], lf[e * 4 + 3]};
        }
        __syncthreads();
        { float run = 0.f;
#pragma unroll
          for (int e = 0; e < 16; ++e) { run += LF[(tq * 16 + e) * 132 + cc]; LF[(tq * 16 + e) * 132 + cc] = run; }
          psum[tq * 128 + cc] = run; }
        __syncthreads();
        {
            const int tqt = t >> 4;
            unsigned qo[8], ko[8];
#pragma unroll
            for (int e4 = 0; e4 < 4; ++e4) {
                const f32x4 p0 = *(const f32x4*)(psum + c0 + e4 * 4), p1 = *(const f32x4*)(psum + 128 + c0 + e4 * 4), p2 = *(const f32x4*)(psum + 256 + c0 + e4 * 4), p3 = *(const f32x4*)(psum + 384 + c0 + e4 * 4);
                const f32x4 bl = *(const f32x4*)(LF + t * 132 + c0 + e4 * 4);
                float q2[4], k2[4];
#pragma unroll
                for (int j = 0; j < 4; ++j) {
                    const float off = (tqt > 0 ? p0[j] : 0.f) + (tqt > 1 ? p1[j] : 0.f) + (tqt > 2 ? p2[j] : 0.f);
                    const float bmid = p0[j] + p1[j], bb = bl[j] + off;
                    q2[j] = qv[e4 * 4 + j] * __expf(bb - bmid); k2[j] = kv[e4 * 4 + j] * __expf(bmid - bb); }
                qo[e4 * 2] = cvt_pk_bf16(q2[0], q2[1]); qo[e4 * 2 + 1] = cvt_pk_bf16(q2[2], q2[3]); ko[e4 * 2] = cvt_pk_bf16(k2[0], k2[1]); ko[e4 * 2 + 1] = cvt_pk_bf16(k2[2], k2[3]);
                if (t == 0) { f32x4 e1, e3;
#pragma unroll
                    for (int j = 0; j < 4; ++j) { e1[j] = __expf(p0[j] + p1[j]); e3[j] = __expf(p2[j] + p3[j]); }
                    float* gs = p.rkbuf + (size_t)(((b * 64 + ch) * 8 + h)) * 256 + c0 + e4 * 4; *(f32x4*)gs = e1; *(f32x4*)(gs + 128) = e3; }
            }
            const u32x4 qw0 = {qo[0], qo[1], qo[2], qo[3]}, qw1 = {qo[4], qo[5], qo[6], qo[7]}, kw0 = {ko[0], ko[1], ko[2], ko[3]}, kw1 = {ko[4], ko[5], ko[6], ko[7]};
            if (!dry) { *(u32x4*)hr = qw0; *(u32x4*)(hr + 8) = qw1; *(u32x4*)(hr + 1024) = kw0; *(u32x4*)(hr + 1032) = kw1; }
            *(u32x4*)(KB + t * 136 + c0) = kw0; *(u32x4*)(KB + t * 136 + c0 + 8) = kw1;
        }
        __syncthreads();
        {
            unsigned iw[8], kw[8];
#pragma unroll
            for (int e = 0; e < 8; ++e) {
                iw[e] = (unsigned)IB[(tq * 16 + 2 * e) * 136 + cc] | ((unsigned)IB[(tq * 16 + 2 * e + 1) * 136 + cc] << 16);
                kw[e] = (unsigned)KB[(tq * 16 + 2 * e) * 136 + cc] | ((unsigned)KB[(tq * 16 + 2 * e + 1) * 136 + cc] << 16); }
            bf16_t* ir = p.H + (r0 + (cc >> 1)) * LDC_H + 2048 + h * 128 + (cc & 1) * 64 + tq * 16;
            if (!dry) { *(u32x4*)ir = (u32x4){iw[0], iw[1], iw[2], iw[3]}; *(u32x4*)(ir + 8) = (u32x4){iw[4], iw[5], iw[6], iw[7]}; }
            bf16_t* kr = xtra + (r0 + (cc >> 1)) * DM + h * 128 + (cc & 1) * 64 + tq * 16;
            *(u32x4*)kr = (u32x4){kw[0], kw[1], kw[2], kw[3]}; *(u32x4*)(kr + 8) = (u32x4){kw[4], kw[5], kw[6], kw[7]};
        }
        __syncthreads();
    }
}

struct HgRaw { u32x4 qm[4], km[2][4], it[2][2], kt[2]; f32x4 e1, e3; };
__device__ __forceinline__ void hg_load(HgRaw& R, const bf16_t* H, const bf16_t* xtra, const float* gsc, size_t r0, int b, int ch, int h, int vs, int w, int fr, int fq) {
    const int tt_ = w >> 1, sp = w & 1;
#pragma unroll
    for (int ks = 0; ks < 4; ++ks) R.qm[ks] = *(const u32x4*)(H + (r0 + tt_ * 16 + fr) * LDC_H + h * 128 + ks * 32 + fq * 8);
#pragma unroll
    for (int q = 0; q < 2; ++q)
#pragma unroll
        for (int ks = 0; ks < 4; ++ks) R.km[q][ks] = *(const u32x4*)(H + (r0 + (sp * 2 + q) * 16 + fr) * LDC_H + 1024 + h * 128 + ks * 32 + fq * 8);
#pragma unroll
    for (int vt = 0; vt < 2; ++vt) { const int v = vs * 32 + vt * 16 + fr;
#pragma unroll
        for (int ks = 0; ks < 2; ++ks) R.it[vt][ks] = *(const u32x4*)(H + (r0 + (v >> 1)) * LDC_H + 2048 + h * 128 + (v & 1) * 64 + ks * 32 + fq * 8); }
    { const int k = w * 16 + fr;
#pragma unroll
      for (int ks = 0; ks < 2; ++ks) R.kt[ks] = *(const u32x4*)(xtra + (r0 + (k >> 1)) * DM + h * 128 + (k & 1) * 64 + ks * 32 + fq * 8); }
    const float* gs = gsc + (size_t)(((b * 64 + ch) * 8 + h)) * 256 + w * 16 + fq * 4;
    R.e1 = *(const f32x4*)gs; R.e3 = *(const f32x4*)(gs + 128);
}

__device__ void phase_hgrn_seq(int l, unsigned char* smem, bool dry) {
    const Params p = load_params();
    bf16_t* att = (bf16_t*)smem;
    bf16_t* STs = att + 64 * 72;
    const int tid = opaque_tid(), w = __builtin_amdgcn_readfirstlane(tid >> 6), lane = tid & 63, fr = lane & 15, fq = lane >> 4;
    const bf16_t* xtra = (l == 0) ? (const bf16_t*)p.out : p.vf;
    const int tt_ = w >> 1, sp = w & 1;
    for (int item = blockIdx.x; item < NB * 32; item += gridDim.x) {
        const int xc_ = item & 7, sl_ = item >> 3, vs = sl_ & 3, gi_ = (sl_ >> 2) * 8 + xc_, h = gi_ & 7, b = gi_ >> 3;
        __syncthreads();
        for (int e = tid; e < 32 * 136 / 2; e += 512) ((unsigned*)STs)[e] = 0u;
        f32x4 S[2] = {{0.f, 0.f, 0.f, 0.f}, {0.f, 0.f, 0.f, 0.f}};
        u32x2 o0 = {0u, 0u};
        HgRaw raw; hg_load(raw, p.H, xtra, p.rkbuf, (size_t)b * SEQ, b, 0, h, vs, w, fr, fq);
        __syncthreads();
        for (int ch = 0; ch < 64; ++ch) {
            const size_t r0 = (size_t)b * SEQ + ch * 64;
            const HgRaw cr = raw;
            if (ch + 1 < 64) hg_load(raw, p.H, xtra, p.rkbuf, r0 + 64, b, ch + 1, h, vs, w, fr, fq);
#pragma unroll
            for (int q = 0; q < 2; ++q) { const int stile = sp * 2 + q; f32x4 a = {0.f, 0.f, 0.f, 0.f};
                if (stile <= tt_) {
#pragma unroll
                    for (int ks = 0; ks < 4; ++ks) a = __builtin_amdgcn_mfma_f32_16x16x32_bf16(__builtin_bit_cast(bf16x8, cr.qm[ks]), __builtin_bit_cast(bf16x8, cr.km[q][ks]), a, 0, 0, 0); }
#pragma unroll
                for (int j = 0; j < 4; ++j) { const int t = tt_ * 16 + fq * 4 + j, s = stile * 16 + fr; att[t * 72 + s] = f2bf(s <= t ? a[j] : 0.f); } }
            __syncthreads();
            f32x4 o = {0.f, 0.f, 0.f, 0.f};
#pragma unroll
            for (int ks = 0; ks < 2; ++ks) { const bf16x8 af = *(const bf16x8*)(att + (tt_ * 16 + fr) * 72 + ks * 32 + fq * 8);
                o = __builtin_amdgcn_mfma_f32_16x16x32_bf16(__builtin_bit_cast(bf16x8, sp ? cr.it[1][ks] : cr.it[0][ks]), af, o, 0, 0, 0); }
#pragma unroll
            for (int ks = 0; ks < 4; ++ks) { const bf16x8 sf = *(const bf16x8*)(STs + (sp * 16 + fr) * 136 + ks * 32 + fq * 8);
                o = __builtin_amdgcn_mfma_f32_16x16x32_bf16(sf, __builtin_bit_cast(bf16x8, cr.qm[ks]), o, 0, 0, 0); }
            { u32x2 ow; ow.x = cvt_pk_bf16(o[0], o[1]); ow.y = cvt_pk_bf16(o[2], o[3]);
              if (ch == 0) o0 = ow;
              else if (!dry) { const int t = tt_ * 16 + fr; *(u32x2*)(p.H + (r0 - 64 + vs * 16 + (t >> 2)) * LDC_H + 2048 + h * 128 + (t & 3) * 32 + sp * 16 + fq * 4) = ow; } }
#pragma unroll
            for (int vt = 0; vt < 2; ++vt) { f32x4 u = {0.f, 0.f, 0.f, 0.f};
#pragma unroll
                for (int ks = 0; ks < 2; ++ks) u = __builtin_amdgcn_mfma_f32_16x16x32_bf16(__builtin_bit_cast(bf16x8, cr.kt[ks]), __builtin_bit_cast(bf16x8, cr.it[vt][ks]), u, 0, 0, 0);
#pragma unroll
                for (int j = 0; j < 4; ++j) S[vt][j] = cr.e3[j] * (cr.e1[j] * S[vt][j] + u[j]); }
            __syncthreads();
            if (ch + 1 < 64) {
#pragma unroll
                for (int vt = 0; vt < 2; ++vt) { u32x2 sw; sw.x = cvt_pk_bf16(S[vt][0] * raw.e1[0], S[vt][1] * raw.e1[1]); sw.y = cvt_pk_bf16(S[vt][2] * raw.e1[2], S[vt][3] * raw.e1[3]);
                    *(u32x2*)(STs + (vt * 16 + fr) * 136 + w * 16 + fq * 4) = sw; } }
        }
        if (!dry) { const int t = tt_ * 16 + fr; *(u32x2*)(p.H + ((size_t)b * SEQ + 63 * 64 + vs * 16 + (t >> 2)) * LDC_H + 2048 + h * 128 + (t & 3) * 32 + sp * 16 + fq * 4) = o0; }
    }
    __syncthreads();
}

__device__ void phase_hgrn_post(int l) {
    const Params p = load_params();
    const int tid = opaque_tid(), l8 = tid & 7;
    const int ngrp = T_TOK * 8;
    for (int g = blockIdx.x * 64 + (tid >> 3); g < ngrp; g += gridDim.x * 64) {
        const int tok = g >> 3, h = g & 7, b = tok / SEQ, tin = tok % SEQ, ch = tin >> 6, t = tin & 63, slot = (ch + 63) & 63, vs = l8 >> 1, vv0 = (l8 & 1) * 16;
        const bf16_t* op = p.H + ((size_t)b * SEQ + slot * 64 + vs * 16 + (t >> 2)) * LDC_H + 2048 + h * 128 + (t & 3) * 32 + vv0;
        bf16_t* zp = p.H + (size_t)tok * LDC_H + 3072 + h * 128 + l8 * 16;
        const u32x4 a0 = *(const u32x4*)op, a1 = *(const u32x4*)(op + 8), z0 = *(const u32x4*)zp, z1 = *(const u32x4*)(zp + 8);
        const float ov[16] = {bflo(a0.x), bfhi(a0.x), bflo(a0.y), bfhi(a0.y), bflo(a0.z), bfhi(a0.z), bflo(a0.w), bfhi(a0.w), bflo(a1.x), bfhi(a1.x), bflo(a1.y), bfhi(a1.y), bflo(a1.z), bfhi(a1.z), bflo(a1.w), bfhi(a1.w)};
        const float zf[16] = {bflo(z0.x), bfhi(z0.x), bflo(z0.y), bfhi(z0.y), bflo(z0.z), bfhi(z0.z), bflo(z0.w), bfhi(z0.w), bflo(z1.x), bfhi(z1.x), bflo(z1.y), bfhi(z1.y), bflo(z1.z), bfhi(z1.z), bflo(z1.w), bfhi(z1.w)};
        float ss = 0.f;
#pragma unroll
        for (int e = 0; e < 16; ++e) ss += ov[e] * ov[e];
        ss = red8(ss); const float rinv = rsqrtf(ss * (1.0f / 128.f) + EPS);
        const float* gn = p.hgrn_g + (size_t)l * DM + h * 128 + l8 * 16;
        float r[16];
#pragma unroll
        for (int e = 0; e < 16; ++e) r[e] = ov[e] * rinv * gn[e] * siluf_(zf[e]);
        u32x4 w0, w1; w0.x = cvt_pk_bf16(r[0], r[1]); w0.y = cvt_pk_bf16(r[2], r[3]); w0.z = cvt_pk_bf16(r[4], r[5]); w0.w = cvt_pk_bf16(r[6], r[7]);
        w1.x = cvt_pk_bf16(r[8], r[9]); w1.y = cvt_pk_bf16(r[10], r[11]); w1.z = cvt_pk_bf16(r[12], r[13]); w1.w = cvt_pk_bf16(r[14], r[15]);
        *(u32x4*)zp = w0; *(u32x4*)(zp + 8) = w1;
    }
}


#define XB_TMO      128
#define XB_XCNT(j)  (256  + 64 * (j))
#define XB_XSUB(j)  (1280 + 64 * (j))
#define XB_XGEN(j)  (2304 + 64 * (j))
#define XB_TOP      3328
#define XB_TOPGEN   3392
#define XCD_BAR_WORDS 3456
#define XB_SPIN_CAP (1u << 18)
__device__ __forceinline__ unsigned xb_ld(unsigned* p)              { return __hip_atomic_load(p, __ATOMIC_RELAXED, __HIP_MEMORY_SCOPE_AGENT); }
__device__ __forceinline__ unsigned xb_add(unsigned* p, unsigned v) { return __hip_atomic_fetch_add(p, v, __ATOMIC_RELAXED, __HIP_MEMORY_SCOPE_AGENT); }
__device__ __forceinline__ unsigned xb_xcc_id() { return (unsigned)__builtin_amdgcn_s_getreg((3 << 11) | 20) & 0xFu; }
#define XB_SPIN(cond, bar) do { unsigned _sp = 0; while (cond) { __builtin_amdgcn_s_sleep(1); \
    if ((++_sp & 255u) == 0u) { if (xb_ld(&(bar)[XB_TMO])) break; if (_sp > XB_SPIN_CAP) { atomicAdd(&(bar)[XB_TMO], 1u); break; } } } } while (0)
struct XcdBarrier { unsigned* bar; unsigned x; volatile LAS unsigned* st; };
__device__ __forceinline__ XcdBarrier xcd_barrier_post(unsigned* bar, volatile LAS unsigned* st) {
    XcdBarrier b; b.bar = bar; b.x = xb_xcc_id(); b.st = st;
    if (threadIdx.x == 0) (void)xb_add(&bar[XB_XCNT(b.x)], 1u);
    return b;
}
__device__ __forceinline__ void xcd_barrier_complete(unsigned* bar, unsigned x, unsigned& nloc, unsigned& nx) {
    const unsigned G = gridDim.x * gridDim.y * gridDim.z;
    unsigned sum, cnt, mine, sp = 0u;
    for (;;) {
        sum = 0u; cnt = 0u; mine = 0u;
#pragma unroll
        for (unsigned j = 0; j < 16; ++j) { const unsigned c = xb_ld(&bar[XB_XCNT(j)]); sum += c; cnt += (c > 0u) ? 1u : 0u; mine = (j == x) ? c : mine; }
        if (sum == G) break;
        __builtin_amdgcn_s_sleep(1);
        if ((++sp & 255u) == 0u) { if (xb_ld(&bar[XB_TMO])) break; if (sp > XB_SPIN_CAP) { atomicAdd(&bar[XB_TMO], 1u); break; } }
    }
    nloc = mine > 0u ? mine : 1u; nx = cnt > 0u ? cnt : 1u;
}
__device__ __forceinline__ void xcd_barrier(const XcdBarrier& b) {
    asm volatile("s_waitcnt vmcnt(0)" ::: "memory");
    __syncthreads();
    if (threadIdx.x == 0) {
        unsigned* bar = b.bar;
        __builtin_amdgcn_s_waitcnt(0);
        unsigned nloc = b.st[0], nx = b.st[1];
        if (nloc == 0u) { xcd_barrier_complete(bar, b.x, nloc, nx); b.st[0] = nloc; b.st[1] = nx; }
        const unsigned old = xb_add(&bar[XB_XSUB(b.x)], 1u);
        const unsigned gen = old / nloc;
        if (old + 1u == (gen + 1u) * nloc) {
            __builtin_amdgcn_fence(__ATOMIC_RELEASE, "agent");
            asm volatile("s_waitcnt vmcnt(0)" ::: "memory");
            const unsigned og = xb_add(&bar[XB_TOP], 1u);
            const unsigned tg = og / nx;
            if (og + 1u == (tg + 1u) * nx) xb_add(&bar[XB_TOPGEN], 1u);
            else XB_SPIN(xb_ld(&bar[XB_TOPGEN]) == tg, bar);
            __builtin_amdgcn_fence(__ATOMIC_ACQUIRE, "agent");
            xb_add(&bar[XB_XGEN(b.x)], 1u);
            asm volatile("s_waitcnt vmcnt(0)" ::: "memory");
        } else {
            XB_SPIN(xb_ld(&bar[XB_XGEN(b.x)]) == gen, bar);
            __builtin_amdgcn_fence(__ATOMIC_ACQUIRE, "agent");
            asm volatile("s_waitcnt vmcnt(0)" ::: "memory");
        }
    }
    __syncthreads();
}

constexpr int PH_PER_LAYER = 14, N_PHASES = 2 * PH_PER_LAYER + 1;

__global__ void __launch_bounds__(512, 2) fwd_megakernel(Params pk) {
    extern __shared__ __attribute__((aligned(16))) unsigned char shm[];
    LAS unsigned char* lds = (LAS unsigned char*)shm;
    cg::grid_group grid = cg::this_grid();
    const int phase_lo = pk.phase_lo, phase_hi = pk.phase_hi;
    volatile LAS unsigned* xst = (volatile LAS unsigned*)(lds + LDS_BYTES - 16);
    XcdBarrier xb; xb.bar = pk.bar; xb.x = 0; xb.st = xst;
    if (phase_hi - phase_lo > 1) { if (threadIdx.x == 0) { xst[0] = 0u; xst[1] = 0u; } __syncthreads(); xb = xcd_barrier_post(pk.bar, xst); }
    for (int ph = phase_lo; ph < phase_hi; ++ph) {
        const int l = ph / PH_PER_LAYER, q = ph % PH_PER_LAYER;
        if (ph == N_PHASES - 1) {
            const Params p = load_params();
            phase_rmsnorm(p.out, p.final_g, nullptr, p.out);
        } else if (q == 0) {
            { const int nrep = (PROBE_Q == 0 && l == 0) ? 2 : 1; for (int rep = 0; rep < nrep; ++rep) {
            phase_convert(l, shm);
            const Params p = load_params();
            phase_rmsnorm(l == 0 ? p.x : p.out, p.norm_g + (size_t)l * DM, p.xn, nullptr); } }
        } else if (q == 1 || q == 5 || q == 8) {
            const Params p = load_params(); const int G = gridDim.x, cidx = opaque_bid();
            const int N = (q == 1) ? LDA_H : (q == 5) ? LDB_H : LDC_H; const int r0 = (q == 1) ? 0 : (q == 5) ? LDA_H : (LDA_H + LDB_H);
            pg8::GemmDesc g; g.A = p.xn; g.Bt = p.Wt + (size_t)r0 * DM; g.lda = DM;
            pg8::Sched S; S.init(T_TOK, N, G, cidx, 1);
            pg8::EpiStore E; E.O = p.H; E.ldc = N;
{ const int nrep = (PROBE_Q == 1 && l == 0 && q == 1) ? 2 : 1; for (int rep = 0; rep < nrep; ++rep) pg8::gemm_phase(lds, g, g, S, E); }
        } else if (q == 2) {
{ const int nrep = (PROBE_Q == 2 && l == 0) ? 2 : 1; for (int rep = 0; rep < nrep; ++rep) phase_rwkv(l, shm, nullptr); }
        } else if (q == 3) {
            phase_rwkv_post(l, nullptr);
        } else if (q == 6) {
{ const int nrep = (PROBE_Q == 6 && l == 0) ? 2 : 1; for (int rep = 0; rep < nrep; ++rep) { const Params p = load_params(); phase_sgu(l, shm, rep + 1 < nrep ? (bf16_t*)p.out : nullptr); } }
        } else if (q == 9) {
            { const int nrep = (PROBE_Q == 9 && l == 0) ? 2 : 1; for (int rep = 0; rep < nrep; ++rep) phase_hgrn_pre(l, shm, rep + 1 < nrep); }
        } else if (q == 10) {
            { const int nrep = (PROBE_Q == 10 && l == 0) ? 2 : 1; for (int rep = 0; rep < nrep; ++rep) phase_hgrn_seq(l, shm, rep + 1 < nrep); }
        } else if (q == 11) {
            phase_hgrn_post(l);
        } else if (q == 4 || q == 7 || q == 12) {
            const Params p = load_params(); const int G = gridDim.x, cidx = opaque_bid();
            bf16_t* WtBr = p.Wt + (size_t)WT_ROWS * DM;
            const int n = (q == 4) ? 0 : (q == 7) ? 1 : 2; const int ldh = (n == 0) ? LDA_H : (n == 1) ? LDB_H : LDC_H; const int ocol = (n == 0) ? 3200 : (n == 1) ? 2048 : 3072;
            pg8::GemmDesc g0, g1; g0.A = p.xn; g0.Bt = p.Wt + (size_t)(LDA_H + LDB_H + LDC_H + n * DM) * DM; g0.lda = DM;
            g1.A = p.H + ocol; g1.Bt = WtBr + (size_t)n * DM * DM; g1.lda = ldh;
            pg8::Sched S; S.init(T_TOK, DM, G, cidx, 2);
            pg8::EpiMerge E; E.G = p.H; E.ldg = ldh; E.bias = p.b_merge + ((size_t)l * 3 + n) * DM; E.Y = p.y; E.accum = (n > 0);
            { const int nrep = (PROBE_Q == 4 && l == 0 && q == 4) ? 2 : 1; for (int rep = 0; rep < nrep; ++rep) pg8::gemm_phase(lds, g0, g1, S, E); }
        } else {
            const Params p = load_params(); const int G = gridDim.x, cidx = opaque_bid();
            bf16_t* WtOut = p.Wt + (size_t)WT_ROWS * DM + (size_t)3 * DM * DM;
            pg8::GemmDesc g; g.A = p.y; g.Bt = WtOut; g.lda = DM;
            pg8::Sched S; S.init(T_TOK, DM, G, cidx, 1);
            pg8::EpiResid E; E.Xin = (l == 0) ? p.x : p.out; E.Xout = p.out;
            { const int nrep = (PROBE_Q == 13 && l == 0) ? 2 : 1; for (int rep = 0; rep < nrep; ++rep) pg8::gemm_phase(lds, g, g, S, E); }
        }
        if (ph + 1 < phase_hi) { if (ph == phase_lo) grid.sync(); else xcd_barrier(xb); }
    }
}

extern "C" void kernel_launch(void* const* d_in, const int* in_sizes, int n_in, void* d_out, int out_size, void* d_ws, size_t ws_size, hipStream_t stream) {
    static int grid_blocks = 0;
    if (!grid_blocks) {
        int dev = 0, cus = 0, per_cu = 0;
        hipGetDevice(&dev);
        hipDeviceGetAttribute(&cus, hipDeviceAttributeMultiprocessorCount, dev);
        if (hipFuncSetAttribute((const void*)fwd_megakernel, hipFuncAttributeMaxDynamicSharedMemorySize, LDS_BYTES) != hipSuccess) { fprintf(stderr, "hipFuncSetAttribute failed\n"); return; }
        hipOccupancyMaxActiveBlocksPerMultiprocessor(&per_cu, (const void*)fwd_megakernel, 512, LDS_BYTES);
        if (per_cu < 1) { fprintf(stderr, "occupancy query says 0 blocks per CU\n"); return; }
        grid_blocks = cus * 1;
    }
    Params p{};
    const float** fp = (const float**)&p;
    for (int i = 0; i < 26; ++i) fp[i] = (const float*)d_in[i];
    p.out = (float*)d_out;
    unsigned char* ws = (unsigned char*)d_ws; size_t off = 0;
    auto take = [&](size_t bytes) { unsigned char* r = ws + off; off += (bytes + 255) & ~(size_t)255; return r; };
    p.Wt = (bf16_t*)take(((size_t)WT_ROWS * DM + 4 * (size_t)DM * DM) * 2);
    p.xn = (bf16_t*)take((size_t)T_TOK * DM * 2);
    p.vf = (bf16_t*)take((size_t)T_TOK * DM * 2);
    p.y = (bf16_t*)take((size_t)T_TOK * DM * 2);
    p.H = (bf16_t*)take((size_t)T_TOK * LDA_H * 2);
    p.rkbuf = (float*)take((size_t)T_TOK * 16 * 2 * 4);
    p.bar = (unsigned*)take((size_t)XCD_BAR_WORDS * 4);
    if (off > ws_size) { fprintf(stderr, "workspace too small: need %zu have %zu\n", off, ws_size); return; }
#if SINGLE_LAUNCH
    p.phase_lo = 0; p.phase_hi = N_PHASES;
    void* args[] = {&p};
    if (hipMemsetAsync(p.bar, 0, (size_t)XCD_BAR_WORDS * 4, stream) != hipSuccess) { fprintf(stderr, "memset failed\n"); return; }
    hipError_t e = hipLaunchCooperativeKernel((const void*)fwd_megakernel, dim3(grid_blocks), dim3(512), args, LDS_BYTES, stream);
    if (e != hipSuccess) fprintf(stderr, "cooperative launch failed: %s (grid %d)\n", hipGetErrorString(e), grid_blocks);
#else
    for (int ph = 0; ph < N_PHASES; ++ph) {
        p.phase_lo = ph; p.phase_hi = ph + 1;
        hipLaunchKernelGGL(fwd_megakernel, dim3(grid_blocks), dim3(512), LDS_BYTES, stream, p);
    }
#endif
}
```

```cpp
#include <hip/hip_runtime.h>
#include <hip/hip_cooperative_groups.h>
#include <cstdio>
namespace cg = cooperative_groups;

#ifndef PROBE_Q
#define PROBE_Q -1
#endif
#ifndef SINGLE_LAUNCH
#define SINGLE_LAUNCH 1
#endif

typedef unsigned short bf16_t;
typedef short bf16x8 __attribute__((ext_vector_type(8)));
typedef float f32x4 __attribute__((ext_vector_type(4)));
typedef float f32x2 __attribute__((ext_vector_type(2)));
typedef unsigned u32x4 __attribute__((ext_vector_type(4)));
typedef unsigned u32x2 __attribute__((ext_vector_type(2)));
#define LAS __attribute__((address_space(3)))

constexpr int T_TOK = 32768, DM = 1024, SEQ = 4096, NB = 8;
constexpr int N_IN = 14464;
constexpr int LDA_H = 4352, LDB_H = 3072, LDC_H = 4096;
constexpr int WT_ROWS = 14592;
constexpr int LDS_BYTES = 163840;
constexpr float EPS = 1e-6f, GN_EPS = 64e-5f;

struct Params {
    const float *x, *norm_g, *w_in, *b_merge, *mu, *w0, *w_w2, *a0, *a_w2, *v0, *v_w1, *v_w2, *k_k, *k_a, *r_k, *lnx_g, *lnx_b,
        *sgu_ln_g, *sgu_ln_b, *sgu_w, *sgu_b, *lb_logits, *hgrn_g, *w_branch, *w_out, *final_g;
    float* out;
    bf16_t *Wt, *xn, *vf, *y, *H;
    float* rkbuf;
    unsigned* bar;
    int phase_lo, phase_hi;
};

__device__ __forceinline__ float bf2f(bf16_t h) { return __uint_as_float(((unsigned)h) << 16); }
__device__ __forceinline__ float bflo(unsigned u) { return __uint_as_float(u << 16); }
__device__ __forceinline__ float bfhi(unsigned u) { return __uint_as_float(u & 0xffff0000u); }
typedef __bf16 bf16x2_t __attribute__((ext_vector_type(2)));
__device__ __forceinline__ unsigned cvt_pk_bf16(float lo, float hi) { const f32x2 v = {lo, hi}; const bf16x2_t r = __builtin_convertvector(v, bf16x2_t); return __builtin_bit_cast(unsigned, r); }
__device__ __forceinline__ bf16_t f2bf(float f) { return (bf16_t)(cvt_pk_bf16(f, 0.f) & 0xffffu); }
__device__ __forceinline__ float sigmoidf_(float x) { return __builtin_amdgcn_rcpf(1.0f + __expf(-x)); }
__device__ __forceinline__ float siluf_(float x) { return x * __builtin_amdgcn_rcpf(1.0f + __expf(-x)); }
__device__ __forceinline__ float tanh_fast(float x) { return 1.0f - 2.0f * __builtin_amdgcn_rcpf(1.0f + __expf(2.0f * x)); }

__device__ __forceinline__ Params load_params() {
#if defined(__HIP_DEVICE_COMPILE__)
    typedef const Params __attribute__((address_space(4)))* KP;
    KP kp = (KP)__builtin_amdgcn_kernarg_segment_ptr(); asm volatile("" : "+s"(kp)); return *kp;
#else
    return Params{};
#endif
}
__device__ __forceinline__ int opaque_tid() { int t = threadIdx.x; asm volatile("" : "+v"(t)); return t; }
__device__ __forceinline__ int opaque_bid() { int t = blockIdx.x; asm volatile("" : "+s"(t)); return t; }

namespace pg8 {
constexpr int BM = 256, BK = 64, HALF = 128, HTB = HALF * BK * 2, STAGE_BYTES = 8 * HTB, NXCD = 8, WGM = 8, KD = 1024;
__device__ __forceinline__ int lds_byte(int r, int c) { const int st = (r >> 4) * 2 + (c >> 5), rr = r & 15, cc = c & 31, ob = rr * 64 + cc * 2; return st * 1024 + (ob ^ (((ob >> 9) & 1) << 5)); }
__device__ __forceinline__ void stage_rc(int b, int& R, int& C) { const int st = b / 1024, sb = b % 1024, swz = sb ^ (((sb >> 9) & 1) << 5); R = (st >> 1) * 16 + swz / 64; C = (st & 1) * 32 + (swz % 64) / 2; }
__device__ __forceinline__ int perm32(int rho) { const int n = rho >> 4, i = rho & 15; return 8 * (i >> 2) + 4 * n + (i & 3); }

struct Unit { int pm, pn, sel; };
struct GemmDesc { const bf16_t* A; const bf16_t* Bt; int lda; };
struct Sched {
    int nM, nN, nwg, G, c, nsel;
    __device__ void init(int M, int N, int G_, int c_, int nsel_) { nM = M / BM; nN = N / BM; nwg = nM * nN; G = G_; c = c_; nsel = nsel_; }
    __device__ bool next(int i, Unit& u) const {
        const int ti = (nsel == 2) ? (i >> 1) : i; u.sel = (nsel == 2) ? (i & 1) : 0;
        const long L = (long)ti * G + c; if (L >= nwg) return false;
        int wgid = (int)L; { const int q = nwg / NXCD, r = nwg % NXCD, xcd = wgid % NXCD, off = wgid / NXCD; wgid = (xcd < r ? xcd * (q + 1) : r * (q + 1) + (xcd - r) * q) + off; }
        const int nig = WGM * nN, gid = wgid / nig, fm = gid * WGM, gsz = (nM - fm) < WGM ? (nM - fm) : WGM;
        u.pm = fm + ((wgid % nig) % gsz); u.pn = (wgid % nig) / gsz; return true;
    }
};

template <class Epi>
__device__ __forceinline__ void gemm_phase(LAS unsigned char* lds, const GemmDesc g0, const GemmDesc g1, const Sched& S, const Epi& E) {
    const int tid = opaque_tid(), wid = __builtin_amdgcn_readfirstlane(tid >> 6), lane = tid & 63, wr = wid >> 2, wc = wid & 3, fr = lane & 15, fq = lane >> 4;
    constexpr int K = KD, nt = K / BK;
    unsigned voffA0[2], voffA1[2], voffB[2];
#pragma unroll
    for (int i = 0; i < 2; ++i) { int R, C; stage_rc(tid * 16 + i * 8192, R, C); const int Rb = Epi::PERM ? ((R & ~31) + perm32(R & 31)) : R;
        voffA0[i] = (unsigned)(R * g0.lda + C) * 2u; voffA1[i] = (unsigned)(R * g1.lda + C) * 2u; voffB[i] = (unsigned)(Rb * K + C) * 2u; }
    const size_t kstep = (size_t)(BK * 2);
    const size_t hstepB = (size_t)HALF * K * 2;
    const unsigned ldsw = (unsigned)wid * 1024u;
    const int aoff = lds_byte(wr * 64 + fr, fq * 8), boff = lds_byte(wc * 32 + fr, fq * 8);
#define PG8_SA(b, h) (((b) * 2 + (h)) * HTB)
#define PG8_SB(b, h) ((4 + (b) * 2 + (h)) * HTB)
#define PG8_STAGE(bufoff, gbase, v0, v1) do { \
        __builtin_amdgcn_global_load_lds((const unsigned*)((const char*)(gbase) + (v0)), (LAS unsigned*)(lds + (bufoff) + ldsw), 16, 0, 0); \
        __builtin_amdgcn_global_load_lds((const unsigned*)((const char*)(gbase) + (v1)), (LAS unsigned*)(lds + (bufoff) + ldsw + 8192), 16, 0, 0); } while (0)
#define PG8_STAGEB(bufoff, gbase) PG8_STAGE(bufoff, gbase, voffB[0], voffB[1])
#define PG8_LDA(dst, b, h) do { _Pragma("unroll") for (int m = 0; m < 4; ++m) _Pragma("unroll") for (int k = 0; k < 2; ++k) dst[m][k] = *(const LAS bf16x8*)(lds + PG8_SA(b, h) + aoff + m * 2048 + k * 1024); } while (0)
#define PG8_LDB(dst, b, h) do { _Pragma("unroll") for (int n = 0; n < 2; ++n) _Pragma("unroll") for (int k = 0; k < 2; ++k) dst[n][k] = *(const LAS bf16x8*)(lds + PG8_SB(b, h) + boff + n * 2048 + k * 1024); } while (0)
#define PG8_MMA(ai, bj, At, Bt) do { __builtin_amdgcn_s_setprio(1); _Pragma("unroll") for (int m = 0; m < 4; ++m) _Pragma("unroll") for (int n = 0; n < 2; ++n) _Pragma("unroll") for (int k = 0; k < 2; ++k) \
        acc[ai][bj][m][n] = __builtin_amdgcn_mfma_f32_16x16x32_bf16(Bt[n][k], At[m][k], acc[ai][bj][m][n], 0, 0, 0); __builtin_amdgcn_s_setprio(0); } while (0)
#define PG8_WAIT_V(n) asm volatile("s_waitcnt vmcnt(" #n ")" ::: "memory")
#define PG8_WAIT_L(n) asm volatile("s_waitcnt lgkmcnt(" #n ")" ::: "memory")
#define PG8_BAR __builtin_amdgcn_s_barrier()
#define PG8_SCHED __builtin_amdgcn_sched_barrier(0)
    Unit cur, nxt; int ui = 0;
    if (!S.next(0, cur)) return;
    f32x4 acc[2][2][4][2];
#pragma unroll
    for (int a = 0; a < 2; ++a)
#pragma unroll
        for (int b = 0; b < 2; ++b)
#pragma unroll
            for (int m = 0; m < 4; ++m)
#pragma unroll
                for (int n = 0; n < 2; ++n) acc[a][b][m][n] = (f32x4){0.f, 0.f, 0.f, 0.f};
    bf16x8 At[4][2], B0[2][2], B1[2][2];
    const char* cA = (const char*)(cur.sel ? g1.A : g0.A) + (size_t)cur.pm * 256 * (size_t)(cur.sel ? g1.lda : g0.lda) * 2;
    const char* cB = (const char*)(cur.sel ? g1.Bt : g0.Bt) + (size_t)cur.pn * 256 * K * 2;
    size_t chA = (size_t)HALF * (cur.sel ? g1.lda : g0.lda) * 2;
    unsigned cv0 = cur.sel ? voffA1[0] : voffA0[0], cv1 = cur.sel ? voffA1[1] : voffA0[1];
    PG8_STAGEB(PG8_SB(0, 0), cB); PG8_STAGE(PG8_SA(0, 0), cA, cv0, cv1); PG8_STAGEB(PG8_SB(0, 1), cB + hstepB); PG8_STAGE(PG8_SA(0, 1), cA + chA, cv0, cv1);
    if (wr == 1) PG8_BAR;
    PG8_WAIT_V(4); PG8_BAR;
    PG8_STAGEB(PG8_SB(1, 0), cB + kstep); PG8_STAGE(PG8_SA(1, 0), cA + kstep, cv0, cv1); PG8_STAGEB(PG8_SB(1, 1), cB + hstepB + kstep);
    PG8_WAIT_V(6); PG8_BAR;
    for (;;) {
        const bool has_next = S.next(ui + 1, nxt);
        const int nsel = has_next ? nxt.sel : cur.sel;
        const char* nA = has_next ? (const char*)(nsel ? g1.A : g0.A) + (size_t)nxt.pm * 256 * (size_t)(nsel ? g1.lda : g0.lda) * 2 : cA;
        const char* nB = has_next ? (const char*)(nsel ? g1.Bt : g0.Bt) + (size_t)nxt.pn * 256 * K * 2 : cB;
        const size_t nhA = (size_t)HALF * (nsel ? g1.lda : g0.lda) * 2;
        const unsigned nv0 = nsel ? voffA1[0] : voffA0[0], nv1 = nsel ? voffA1[1] : voffA0[1];
        for (int t = 0; t < nt; t += 2) {
            const bool last = (t == nt - 2);
            const char* a1 = cA + (size_t)(t + 1) * kstep;
            const char* a2 = last ? nA : cA + (size_t)(t + 2) * kstep; const char* b2 = last ? nB : cB + (size_t)(t + 2) * kstep;
            const char* a3 = a2 + kstep; const char* b3 = b2 + kstep;
            const size_t h2 = last ? nhA : chA; const unsigned w0 = last ? nv0 : cv0, w1 = last ? nv1 : cv1;
            PG8_LDB(B0, 0, 0); PG8_SCHED; PG8_LDA(At, 0, 0); PG8_STAGE(PG8_SA(1, 1), a1 + chA, cv0, cv1);
            PG8_WAIT_L(8); PG8_BAR; PG8_WAIT_L(0); PG8_MMA(0, 0, At, B0); PG8_BAR; PG8_SCHED;
            PG8_LDB(B1, 0, 1); PG8_STAGEB(PG8_SB(0, 0), b2);
            PG8_BAR; PG8_WAIT_L(0); PG8_MMA(0, 1, At, B1); PG8_BAR;
            PG8_LDA(At, 0, 1); PG8_STAGE(PG8_SA(0, 0), a2, w0, w1);
            PG8_BAR; PG8_WAIT_L(0); PG8_MMA(1, 0, At, B0); PG8_BAR; PG8_SCHED;
            PG8_STAGEB(PG8_SB(0, 1), b2 + hstepB);
            PG8_WAIT_V(6); PG8_BAR; PG8_MMA(1, 1, At, B1); PG8_BAR;
            PG8_LDB(B0, 1, 0); PG8_SCHED; PG8_LDA(At, 1, 0); PG8_STAGE(PG8_SA(0, 1), a2 + h2, w0, w1);
            PG8_WAIT_L(8); PG8_BAR; PG8_WAIT_L(0); PG8_MMA(0, 0, At, B0); PG8_BAR; PG8_SCHED;
            PG8_LDB(B1, 1, 1); PG8_STAGEB(PG8_SB(1, 0), b3);
            PG8_BAR; PG8_WAIT_L(0); PG8_MMA(0, 1, At, B1); PG8_BAR;
            PG8_LDA(At, 1, 1); PG8_STAGE(PG8_SA(1, 0), a3, w0, w1);
            PG8_BAR; PG8_WAIT_L(0); PG8_MMA(1, 0, At, B0); PG8_BAR; PG8_SCHED;
            PG8_STAGEB(PG8_SB(1, 1), b3 + hstepB);
            PG8_WAIT_V(6); PG8_BAR; PG8_MMA(1, 1, At, B1); PG8_BAR;
        }
        E(acc, cur, wr, wc, fr, fq);
        if (!has_next) break;
#pragma unroll
        for (int a = 0; a < 2; ++a)
#pragma unroll
            for (int b = 0; b < 2; ++b)
#pragma unroll
                for (int m = 0; m < 4; ++m)
#pragma unroll
                    for (int n = 0; n < 2; ++n) acc[a][b][m][n] = (f32x4){0.f, 0.f, 0.f, 0.f};
        cur = nxt; cA = nA; cB = nB; chA = nhA; cv0 = nv0; cv1 = nv1; ++ui;
    }
    PG8_WAIT_V(0);
    if (wr == 0) PG8_BAR;
    PG8_BAR;
#undef PG8_SA
#undef PG8_SB
#undef PG8_STAGE
#undef PG8_STAGEB
#undef PG8_LDA
#undef PG8_LDB
#undef PG8_MMA
#undef PG8_WAIT_V
#undef PG8_WAIT_L
#undef PG8_BAR
#undef PG8_SCHED
}

struct EpiStore {
    static constexpr bool PERM = true;
    bf16_t* O; int ldc;
    __device__ __forceinline__ void operator()(const f32x4 (&acc)[2][2][4][2], const Unit& u, int wr, int wc, int fr, int fq) const {
        const int row0 = u.pm * BM + wr * 64 + fr, col0 = u.pn * BM + wc * 32 + 8 * fq;
#pragma unroll
        for (int ai = 0; ai < 2; ++ai)
#pragma unroll
            for (int m = 0; m < 4; ++m) { bf16_t* rowp = O + (size_t)(row0 + ai * HALF + m * 16) * ldc + col0;
#pragma unroll
                for (int bj = 0; bj < 2; ++bj) { const f32x4 v0 = acc[ai][bj][m][0], v1 = acc[ai][bj][m][1];
                    u32x4 w; w.x = cvt_pk_bf16(v0[0], v0[1]); w.y = cvt_pk_bf16(v0[2], v0[3]); w.z = cvt_pk_bf16(v1[0], v1[1]); w.w = cvt_pk_bf16(v1[2], v1[3]);
                    *(u32x4*)(rowp + bj * HALF) = w; } }
    }
};
struct EpiMerge {
    static constexpr bool PERM = true;
    bf16_t* G; int ldg; const float* bias; bf16_t* Y; int accum;
    __device__ __forceinline__ void operator()(const f32x4 (&acc)[2][2][4][2], const Unit& u, int wr, int wc, int fr, int fq) const {
        const int row0 = u.pm * BM + wr * 64 + fr, col0 = u.pn * BM + wc * 32 + 8 * fq;
        if (u.sel == 0) {
            f32x4 bv[2][2];
#pragma unroll
            for (int bj = 0; bj < 2; ++bj)
#pragma unroll
                for (int n = 0; n < 2; ++n) bv[bj][n] = *(const f32x4*)(bias + col0 + bj * HALF + 4 * n);
#pragma unroll
            for (int ai = 0; ai < 2; ++ai)
#pragma unroll
                for (int m = 0; m < 4; ++m) { bf16_t* rowp = G + (size_t)(row0 + ai * HALF + m * 16) * ldg + col0;
#pragma unroll
                    for (int bj = 0; bj < 2; ++bj) { f32x4 v0 = acc[ai][bj][m][0] + bv[bj][0], v1 = acc[ai][bj][m][1] + bv[bj][1];
#pragma unroll
                        for (int j = 0; j < 4; ++j) { v0[j] = sigmoidf_(v0[j]); v1[j] = sigmoidf_(v1[j]); }
                        u32x4 w; w.x = cvt_pk_bf16(v0[0], v0[1]); w.y = cvt_pk_bf16(v0[2], v0[3]); w.z = cvt_pk_bf16(v1[0], v1[1]); w.w = cvt_pk_bf16(v1[2], v1[3]);
                        *(u32x4*)(rowp + bj * HALF) = w; } }
        } else {
#pragma unroll
            for (int ai = 0; ai < 2; ++ai)
#pragma unroll
                for (int m = 0; m < 4; ++m) { const size_t r = (size_t)(row0 + ai * HALF + m * 16);
                    const unsigned long long* gp = (const unsigned long long*)(G + r * ldg + col0); bf16_t* yp = Y + r * DM + col0;
#pragma unroll
                    for (int bj = 0; bj < 2; ++bj) {
                        const unsigned long long g0 = __hip_atomic_load(gp + bj * (HALF / 4), __ATOMIC_RELAXED, __HIP_MEMORY_SCOPE_AGENT);
                        const unsigned long long g1 = __hip_atomic_load(gp + bj * (HALF / 4) + 1, __ATOMIC_RELAXED, __HIP_MEMORY_SCOPE_AGENT);
                        const unsigned gw[4] = {(unsigned)g0, (unsigned)(g0 >> 32), (unsigned)g1, (unsigned)(g1 >> 32)};
                        u32x4 yo = {0u, 0u, 0u, 0u}; if (accum) yo = *(const u32x4*)(yp + bj * HALF);
                        const f32x4 v0 = acc[ai][bj][m][0], v1 = acc[ai][bj][m][1];
                        u32x4 w;
                        w.x = cvt_pk_bf16(bflo(yo.x) + bflo(gw[0]) * v0[0], bfhi(yo.x) + bfhi(gw[0]) * v0[1]);
                        w.y = cvt_pk_bf16(bflo(yo.y) + bflo(gw[1]) * v0[2], bfhi(yo.y) + bfhi(gw[1]) * v0[3]);
                        w.z = cvt_pk_bf16(bflo(yo.z) + bflo(gw[2]) * v1[0], bfhi(yo.z) + bfhi(gw[2]) * v1[1]);
                        w.w = cvt_pk_bf16(bflo(yo.w) + bflo(gw[3]) * v1[2], bfhi(yo.w) + bfhi(gw[3]) * v1[3]);
                        *(u32x4*)(yp + bj * HALF) = w; } }
        }
    }
};
struct EpiResid {
    static constexpr bool PERM = false;
    const float* Xin; float* Xout;
    __device__ __forceinline__ void operator()(const f32x4 (&acc)[2][2][4][2], const Unit& u, int wr, int wc, int fr, int fq) const {
        const int row0 = u.pm * BM + wr * 64 + fr, col0 = u.pn * BM + wc * 32 + 4 * fq;
#pragma unroll
        for (int ai = 0; ai < 2; ++ai)
#pragma unroll
            for (int m = 0; m < 4; ++m) { const size_t ro = (size_t)(row0 + ai * HALF + m * 16) * DM + col0;
#pragma unroll
                for (int bj = 0; bj < 2; ++bj)
#pragma unroll
                    for (int n = 0; n < 2; ++n) { const f32x4 xi = *(const f32x4*)(Xin + ro + bj * HALF + n * 16); *(f32x4*)(Xout + ro + bj * HALF + n * 16) = xi + acc[ai][bj][m][n]; } }
    }
};
}

__device__ void phase_convert(int l, unsigned char* smem) {
    const Params p = load_params();
    float* tile = (float*)smem;
    const int tid = opaque_tid();
    const float* win = p.w_in + (size_t)l * DM * N_IN;
    bf16_t* WtIn = p.Wt; bf16_t* WtBr = p.Wt + (size_t)WT_ROWS * DM; bf16_t* WtOut = WtBr + (size_t)3 * DM * DM;
    const int NT_IN = WT_ROWS / 64;
    const int total = (NT_IN + 48 + 16) * 16;
    for (int it = blockIdx.x; it < total; it += gridDim.x) {
        const int ntile = it >> 4, kt = it & 15, k0 = kt * 64;
        const float* src = nullptr; int ld = 0, c0 = 0, valid = 64; bf16_t* dst;
        if (ntile < NT_IN) {
            const int n0 = ntile * 64; dst = WtIn + (size_t)n0 * DM;
            if (n0 < 4224) { src = win; ld = N_IN; c0 = n0; }
            else if (n0 < 4352) { if (n0 == 4224 && l > 0) { src = p.v_w1 + (size_t)(l - 1) * DM * 32; ld = 32; c0 = 0; valid = 32; } else { valid = 0; } }
            else { src = win; ld = N_IN; c0 = n0 - 128; }
        } else if (ntile < NT_IN + 48) {
            const int q = ntile - NT_IN, n = q >> 4, n0 = (q & 15) * 64;
            src = p.w_branch + ((size_t)l * 3 + n) * DM * DM; ld = DM; c0 = n0; dst = WtBr + ((size_t)n * DM + n0) * DM;
        } else {
            const int n0 = (ntile - NT_IN - 48) * 64; src = p.w_out + (size_t)l * DM * DM; ld = DM; c0 = n0; dst = WtOut + (size_t)n0 * DM;
        }
        __syncthreads();
        if (valid == 64) {
            const int kr = tid >> 4, nc = (tid & 15) * 4;
#pragma unroll
            for (int ps = 0; ps < 2; ++ps) { const int k = kr + ps * 32; const f32x4 v = *(const f32x4*)(src + (size_t)(k0 + k) * ld + c0 + nc);
                tile[k * 65 + nc] = v[0]; tile[k * 65 + nc + 1] = v[1]; tile[k * 65 + nc + 2] = v[2]; tile[k * 65 + nc + 3] = v[3]; }
        } else {
            for (int e = tid; e < 4096; e += 512) { const int k = e >> 6, n = e & 63; tile[k * 65 + n] = (n < valid) ? src[(size_t)(k0 + k) * ld + c0 + n] : 0.f; }
        }
        __syncthreads();
        { const int nr = tid >> 3, kc = (tid & 7) * 8; u32x4 w;
          w.x = cvt_pk_bf16(tile[(kc + 0) * 65 + nr], tile[(kc + 1) * 65 + nr]); w.y = cvt_pk_bf16(tile[(kc + 2) * 65 + nr], tile[(kc + 3) * 65 + nr]);
          w.z = cvt_pk_bf16(tile[(kc + 4) * 65 + nr], tile[(kc + 5) * 65 + nr]); w.w = cvt_pk_bf16(tile[(kc + 6) * 65 + nr], tile[(kc + 7) * 65 + nr]);
          *(u32x4*)(dst + (size_t)nr * DM + k0 + kc) = w; }
    }
    __syncthreads();
}

__device__ void phase_rmsnorm(const float* x, const float* g, bf16_t* xn, float* outf) {
    const int tid_ = opaque_tid(); const int lane = tid_ & 63, wv = tid_ >> 6;
    f32x4 gv[4];
#pragma unroll
    for (int q = 0; q < 4; ++q) gv[q] = *(const f32x4*)(g + q * 256 + lane * 4);
    for (int row = blockIdx.x * 8 + wv; row < T_TOK; row += gridDim.x * 8) {
        const float* xr = x + (size_t)row * DM; f32x4 v[4]; float ss = 0.f;
#pragma unroll
        for (int q = 0; q < 4; ++q) { v[q] = *(const f32x4*)(xr + q * 256 + lane * 4); ss += v[q][0] * v[q][0] + v[q][1] * v[q][1] + v[q][2] * v[q][2] + v[q][3] * v[q][3]; }
#pragma unroll
        for (int o = 32; o > 0; o >>= 1) ss += __shfl_xor(ss, o);
        const float rinv = rsqrtf(ss * (1.0f / DM) + EPS);
#pragma unroll
        for (int q = 0; q < 4; ++q) { const f32x4 o = v[q] * rinv * gv[q];
            if (xn) { u32x2 w; w.x = cvt_pk_bf16(o[0], o[1]); w.y = cvt_pk_bf16(o[2], o[3]); *(u32x2*)(xn + (size_t)row * DM + q * 256 + lane * 4) = w; }
            else *(f32x4*)(outf + (size_t)row * DM + q * 256 + lane * 4) = o; }
    }
}

template <int CTRL> __device__ __forceinline__ float dpp_f(float v) { return __int_as_float(__builtin_amdgcn_update_dpp(0, __float_as_int(v), CTRL, 0xf, 0xf, false)); }
__device__ __forceinline__ float red8(float v) { v += dpp_f<0xB1>(v); v += dpp_f<0x4E>(v); v += dpp_f<0x141>(v); return v; }
__device__ __forceinline__ float red16(float v) { v = red8(v); v += dpp_f<0x140>(v); return v; }

struct RwRaw { u32x4 cw[2], pw[2], ca[2], pa[2], vl; u32x2 cr[2], pr[2], ck[2], pk[2], cv, pv, vf; };
__device__ __forceinline__ void rw_load(RwRaw& R, const bf16_t* H, const bf16_t* vfp, int l, size_t tok, bool hasp, int h, int chh, int vnt, int fq) {
    const bf16_t* cur = H + tok * LDA_H; const bf16_t* prev = cur - LDA_H;
    const u32x4 z4 = {0u, 0u, 0u, 0u}; const u32x2 z2 = {0u, 0u};
#pragma unroll
    for (int ks = 0; ks < 2; ++ks) { const int m0 = ks * 32 + fq * 8;
        R.cw[ks] = *(const u32x4*)(cur + 3072 + m0); R.ca[ks] = *(const u32x4*)(cur + 3136 + m0);
        R.pw[ks] = hasp ? *(const u32x4*)(prev + 3072 + m0) : z4; R.pa[ks] = hasp ? *(const u32x4*)(prev + 3136 + m0) : z4; }
#pragma unroll
    for (int q = 0; q < 2; ++q) { const int cb = h * 64 + (chh * 2 + q) * 16 + fq * 4;
        R.cr[q] = *(const u32x2*)(cur + cb); R.ck[q] = *(const u32x2*)(cur + 1024 + cb);
        R.pr[q] = hasp ? *(const u32x2*)(prev + cb) : z2; R.pk[q] = hasp ? *(const u32x2*)(prev + 1024 + cb) : z2; }
    const int cbv = h * 64 + vnt * 16 + fq * 4;
    R.cv = *(const u32x2*)(cur + 2048 + cbv); R.pv = hasp ? *(const u32x2*)(prev + 2048 + cbv) : z2;
    R.vf = z2; R.vl = z4;
    if (l > 0) { R.vf = *(const u32x2*)(vfp + tok * DM + cbv); R.vl = *(const u32x4*)(cur + 4224 + fq * 8); }
}

__device__ void phase_rwkv(int l, unsigned char* smem, bf16_t* oalt) {
    const Params p = load_params();
    constexpr int TC = 32, NCH = SEQ / TC, RS = 68  , BUFSZ = 5 * TC * RS + TC * 32 + TC * 2;
    bf16_t* w2T = (bf16_t*)smem;
    bf16_t* a2T = w2T + 64 * 72;
    bf16_t* v2T = a2T + 64 * 72;
    float* cst = (float*)(v2T + 64 * 40);
    float* buf0 = cst + 11 * 64;
    float* ybuf = buf0 + 2 * BUFSZ;
    const int tid = opaque_tid(), wid = __builtin_amdgcn_readfirstlane(tid >> 6), lane = tid & 63, fr = lane & 15, fq = lane >> 4;
    for (int item = blockIdx.x; item < NB * 32; item += gridDim.x) {
        const int xc_ = item & 7, sl_ = item >> 3, half = sl_ & 1, pi_ = (sl_ >> 1) * 8 + xc_, b = pi_ >> 4, h = pi_ & 15;
        __syncthreads();
        for (int e = tid; e < 4096; e += 512) { const int m = e >> 6, j = e & 63; w2T[j * 72 + m] = f2bf(p.w_w2[((size_t)l * 64 + m) * DM + h * 64 + j]); a2T[j * 72 + m] = f2bf(p.a_w2[((size_t)l * 64 + m) * DM + h * 64 + j]); }
        if (l > 0) for (int e = tid; e < 2048; e += 512) { const int m = e >> 6, j = e & 63; v2T[j * 40 + m] = f2bf(p.v_w2[((size_t)(l - 1) * 32 + m) * DM + h * 64 + j]); }
        if (tid < 64) { const float* mu = p.mu + (size_t)l * 3200; const int cc = h * 64 + tid;
            cst[tid] = mu[cc]; cst[64 + tid] = mu[1024 + cc]; cst[128 + tid] = mu[2048 + cc]; cst[192 + tid] = p.w0[l * DM + cc]; cst[256 + tid] = p.a0[l * DM + cc];
            cst[320 + tid] = (l > 0) ? p.v0[(l - 1) * DM + cc] : 0.f; cst[384 + tid] = p.k_k[l * DM + cc]; cst[448 + tid] = p.k_a[l * DM + cc]; cst[512 + tid] = p.r_k[l * DM + cc];
            cst[576 + tid] = mu[3072 + tid]; cst[640 + tid] = mu[3136 + tid]; }
        __syncthreads();
        f32x2 st[4];
#pragma unroll
        for (int j = 0; j < 4; ++j) st[j] = (f32x2){0.f, 0.f};
        const int si = tid >> 3, seg = tid & 7;
        const int pwv = wid - 4, tti = pwv & 1, chh = (pwv >> 1) & 1, vnt = half * 2 + chh, tt = tti * 16 + fr;
        RwRaw raw;
        if (wid >= 4) rw_load(raw, p.H, p.vf, l, (size_t)b * SEQ + tt, tt > 0, h, chh, vnt, fq);
        for (int c = -1; c < NCH; ++c) {
            if (wid >= 4 && c + 1 < NCH) {
                float* B_ = buf0 + ((c + 1) & 1) * BUFSZ;
                float* sR = B_; float* sW = sR + TC * RS; float* sK = sW + TC * RS; float* sA = sK + TC * RS; float* sB = sA + TC * RS; float* sV = sB + TC * RS; float* sS = sV + TC * 32;
                const size_t tok = (size_t)b * SEQ + (c + 1) * TC + tt;
                const RwRaw cr_ = raw;
                if (c + 2 < NCH) rw_load(raw, p.H, p.vf, l, tok + TC, true, h, chh, vnt, fq);
                bf16x8 AfW[2], AfA[2];
#pragma unroll
                for (int ks = 0; ks < 2; ++ks) { const int m0 = ks * 32 + fq * 8;
                    const f32x4 mw0 = *(const f32x4*)(cst + 576 + m0), mw1 = *(const f32x4*)(cst + 576 + m0 + 4), ma0 = *(const f32x4*)(cst + 640 + m0), ma1 = *(const f32x4*)(cst + 640 + m0 + 4);
                    const float muw[8] = {mw0[0], mw0[1], mw0[2], mw0[3], mw1[0], mw1[1], mw1[2], mw1[3]}, mua[8] = {ma0[0], ma0[1], ma0[2], ma0[3], ma1[0], ma1[1], ma1[2], ma1[3]};
                    const unsigned cwv[4] = {cr_.cw[ks].x, cr_.cw[ks].y, cr_.cw[ks].z, cr_.cw[ks].w}, pwq[4] = {cr_.pw[ks].x, cr_.pw[ks].y, cr_.pw[ks].z, cr_.pw[ks].w};
                    const unsigned cav[4] = {cr_.ca[ks].x, cr_.ca[ks].y, cr_.ca[ks].z, cr_.ca[ks].w}, pav[4] = {cr_.pa[ks].x, cr_.pa[ks].y, cr_.pa[ks].z, cr_.pa[ks].w};
                    unsigned ow[4], oa[4];
#pragma unroll
                    for (int e = 0; e < 4; ++e) {
                        const float c0 = bflo(cwv[e]), c1 = bfhi(cwv[e]), q0 = bflo(pwq[e]), q1 = bfhi(pwq[e]);
                        ow[e] = cvt_pk_bf16(tanh_fast(c0 + muw[2 * e] * (q0 - c0)), tanh_fast(c1 + muw[2 * e + 1] * (q1 - c1)));
                        const float d0 = bflo(cav[e]), d1 = bfhi(cav[e]), r0 = bflo(pav[e]), r1 = bfhi(pav[e]);
                        oa[e] = cvt_pk_bf16(d0 + mua[2 * e] * (r0 - d0), d1 + mua[2 * e + 1] * (r1 - d1)); }
                    AfW[ks] = __builtin_bit_cast(bf16x8, ((u32x4){ow[0], ow[1], ow[2], ow[3]})); AfA[ks] = __builtin_bit_cast(bf16x8, ((u32x4){oa[0], oa[1], oa[2], oa[3]})); }
                f32x4 accW[2], accA[2], accV = (f32x4){0.f, 0.f, 0.f, 0.f};
#pragma unroll
                for (int q = 0; q < 2; ++q) { const int nt = chh * 2 + q; accW[q] = (f32x4){0.f, 0.f, 0.f, 0.f}; accA[q] = (f32x4){0.f, 0.f, 0.f, 0.f};
#pragma unroll
                    for (int ks = 0; ks < 2; ++ks) { const bf16x8 bw = *(const bf16x8*)(w2T + (nt * 16 + fr) * 72 + ks * 32 + fq * 8), ba = *(const bf16x8*)(a2T + (nt * 16 + fr) * 72 + ks * 32 + fq * 8);
                        accW[q] = __builtin_amdgcn_mfma_f32_16x16x32_bf16(bw, AfW[ks], accW[q], 0, 0, 0); accA[q] = __builtin_amdgcn_mfma_f32_16x16x32_bf16(ba, AfA[ks], accA[q], 0, 0, 0); } }
                if (l > 0) { const bf16x8 bv = *(const bf16x8*)(v2T + (vnt * 16 + fr) * 40 + fq * 8); accV = __builtin_amdgcn_mfma_f32_16x16x32_bf16(bv, __builtin_bit_cast(bf16x8, cr_.vl), accV, 0, 0, 0); }
                float ss = 0.f, rk = 0.f;
#pragma unroll
                for (int q = 0; q < 2; ++q) { const int ch0 = (chh * 2 + q) * 16 + fq * 4;
                    const float fr_[4] = {bflo(cr_.cr[q].x), bfhi(cr_.cr[q].x), bflo(cr_.cr[q].y), bfhi(cr_.cr[q].y)}, fpr[4] = {bflo(cr_.pr[q].x), bfhi(cr_.pr[q].x), bflo(cr_.pr[q].y), bfhi(cr_.pr[q].y)};
                    const float fk_[4] = {bflo(cr_.ck[q].x), bfhi(cr_.ck[q].x), bflo(cr_.ck[q].y), bfhi(cr_.ck[q].y)}, fpk[4] = {bflo(cr_.pk[q].x), bfhi(cr_.pk[q].x), bflo(cr_.pk[q].y), bfhi(cr_.pk[q].y)};
                    const f32x4 mur = *(const f32x4*)(cst + ch0), muk = *(const f32x4*)(cst + 64 + ch0), w0v = *(const f32x4*)(cst + 192 + ch0), a0v = *(const f32x4*)(cst + 256 + ch0),
                        kkv = *(const f32x4*)(cst + 384 + ch0), kav = *(const f32x4*)(cst + 448 + ch0), rkv = *(const f32x4*)(cst + 512 + ch0);
                    f32x4 ro, wo, ko, ao, bo;
#pragma unroll
                    for (int e = 0; e < 4; ++e) {
                        const float r = fr_[e] + mur[e] * (fpr[e] - fr_[e]), k = fk_[e] + muk[e] * (fpk[e] - fk_[e]);
                        const float xw = -(w0v[e] + accW[q][e]); const float sp = fmaxf(xw, 0.f) + __logf(1.0f + __expf(-fabsf(xw)));
                        wo[e] = __expf(-__expf(-sp - 0.5f));
                        const float a = sigmoidf_(a0v[e] + accA[q][e]);
                        const float kq = k * kkv[e]; ss += kq * kq; ao[e] = -kq; bo[e] = kq * a;
                        const float km = k * (1.0f + (a - 1.0f) * kav[e]); rk += r * km * rkv[e]; ro[e] = r; ko[e] = km; }
                    *(f32x4*)(sR + tt * RS + ch0) = ro; *(f32x4*)(sW + tt * RS + ch0) = wo; *(f32x4*)(sK + tt * RS + ch0) = ko; *(f32x4*)(sA + tt * RS + ch0) = ao; *(f32x4*)(sB + tt * RS + ch0) = bo; }
                ss += __shfl_xor(ss, 16); ss += __shfl_xor(ss, 32); rk += __shfl_xor(rk, 16); rk += __shfl_xor(rk, 32);
                if (fq == 0) { sS[tt * 2 + chh] = ss; if (half == 0) p.rkbuf[(size_t)((b * 16 + h) * 2 + chh) * SEQ + (c + 1) * TC + tt] = rk; }
                { const int ch0 = vnt * 16 + fq * 4, cb = h * 64 + ch0;
                  const float fv_[4] = {bflo(cr_.cv.x), bfhi(cr_.cv.x), bflo(cr_.cv.y), bfhi(cr_.cv.y)}, fpv[4] = {bflo(cr_.pv.x), bfhi(cr_.pv.x), bflo(cr_.pv.y), bfhi(cr_.pv.y)};
                  const f32x4 muv = *(const f32x4*)(cst + 128 + ch0), v0v = *(const f32x4*)(cst + 320 + ch0);
                  f32x4 vo;
#pragma unroll
                  for (int e = 0; e < 4; ++e) vo[e] = fv_[e] + muv[e] * (fpv[e] - fv_[e]);
                  if (l > 0) { const float vfv[4] = {bflo(cr_.vf.x), bfhi(cr_.vf.x), bflo(cr_.vf.y), bfhi(cr_.vf.y)};
#pragma unroll
                      for (int e = 0; e < 4; ++e) vo[e] = vo[e] + (vfv[e] - vo[e]) * sigmoidf_(v0v[e] + accV[e]); }
                  u32x2 w; w.x = cvt_pk_bf16(vo[0], vo[1]); w.y = cvt_pk_bf16(vo[2], vo[3]); *(u32x2*)(p.vf + tok * DM + cb) = w;
                  *(f32x4*)(sV + tt * 32 + chh * 16 + fq * 4) = vo; }
            }
            if (wid < 4 && c >= 0) {
                const float* B_ = buf0 + (c & 1) * BUFSZ;
                const float* sR = B_; const float* sW = sR + TC * RS; const float* sK = sW + TC * RS; const float* sA = sK + TC * RS; const float* sB = sA + TC * RS; const float* sV = sB + TC * RS; const float* sS = sV + TC * 32;
                f32x4 A0, A1, W0, W1, B0, B1, K0, K1, R0, R1; float VI; f32x2 PS;
#define SC_LOAD(s_) do { const int o_ = (s_) * RS + seg * 8; \
                    A0 = *(const f32x4*)(sA + o_); A1 = *(const f32x4*)(sA + o_ + 4); W0 = *(const f32x4*)(sW + o_); W1 = *(const f32x4*)(sW + o_ + 4); \
                    B0 = *(const f32x4*)(sB + o_); B1 = *(const f32x4*)(sB + o_ + 4); K0 = *(const f32x4*)(sK + o_); K1 = *(const f32x4*)(sK + o_ + 4); \
                    R0 = *(const f32x4*)(sR + o_); R1 = *(const f32x4*)(sR + o_ + 4); VI = sV[(s_) * 32 + si]; PS = *(const f32x2*)(sS + (s_) * 2); } while (0)
                SC_LOAD(0);
#pragma unroll 4
                for (int s = 0; s < TC; ++s) {
                    const f32x4 a0 = A0, a1 = A1, w0 = W0, w1 = W1, b0 = B0, b1 = B1, k0 = K0, k1 = K1, r0 = R0, r1 = R1; const float vi = VI; const f32x2 ps = PS;
                    if (s + 1 < TC) SC_LOAD(s + 1);
                    __builtin_amdgcn_sched_barrier(0);
                    const float inv2 = __builtin_amdgcn_rcpf(fmaxf(ps.x + ps.y, 1e-24f));
                    const f32x2 av[4] = {{a0[0], a0[1]}, {a0[2], a0[3]}, {a1[0], a1[1]}, {a1[2], a1[3]}}, wv[4] = {{w0[0], w0[1]}, {w0[2], w0[3]}, {w1[0], w1[1]}, {w1[2], w1[3]}};
                    const f32x2 bv[4] = {{b0[0], b0[1]}, {b0[2], b0[3]}, {b1[0], b1[1]}, {b1[2], b1[3]}}, kv[4] = {{k0[0], k0[1]}, {k0[2], k0[3]}, {k1[0], k1[1]}, {k1[2], k1[3]}};
                    const f32x2 rv[4] = {{r0[0], r0[1]}, {r0[2], r0[3]}, {r1[0], r1[1]}, {r1[2], r1[3]}};
                    const f32x2 vi2 = {vi, vi};
                    f32x2 vk[4];
#pragma unroll
                    for (int j = 0; j < 4; ++j) vk[j] = vi2 * kv[j];
                    const f32x2 pa = st[0] * av[0] + st[1] * av[1], pb = st[2] * av[2] + st[3] * av[3]; const f32x2 pc = pa + pb;
                    const float sa = red8(pc.x + pc.y) * inv2;
                    const f32x2 sa2 = {sa, sa};
#pragma unroll
                    for (int j = 0; j < 4; ++j) st[j] = st[j] * wv[j] + (sa2 * bv[j] + vk[j]);
                    const f32x2 qa = st[0] * rv[0] + st[1] * rv[1], qb = st[2] * rv[2] + st[3] * rv[3]; const f32x2 qc = qa + qb;
                    const float yy = red8(qc.x + qc.y);
                    if (seg == 0) ybuf[s * 32 + si] = yy;
                }
#undef SC_LOAD
                { const int tk = lane >> 1, rq = (lane & 1) * 4; const f32x4 yv = *(const f32x4*)(ybuf + tk * 32 + wid * 8 + rq);
                  u32x2 w; w.x = cvt_pk_bf16(yv[0], yv[1]); w.y = cvt_pk_bf16(yv[2], yv[3]);
                  *(u32x2*)(p.y + ((size_t)b * SEQ + c * TC + tk) * DM + h * 64 + half * 32 + wid * 8 + rq) = w; }
            }
            __syncthreads();
        }
    }
    __syncthreads();
}

__device__ void phase_rwkv_post(int l, bf16_t* oalt) {
    const Params p = load_params();
    const int tid = opaque_tid(), l8 = tid & 7;
    const int ngrp = T_TOK * 16;
    for (int g = blockIdx.x * 64 + (tid >> 3); g < ngrp; g += gridDim.x * 64) {
        const int tok = g >> 4, h = g & 15, cb = h * 64 + l8 * 8;
        const u32x4 y4 = *(const u32x4*)(p.y + (size_t)tok * DM + cb), b4 = *(const u32x4*)(p.vf + (size_t)tok * DM + cb);
        const int bb = tok / SEQ, tq = tok % SEQ; const float rk = p.rkbuf[(size_t)((bb * 16 + h) * 2) * SEQ + tq] + p.rkbuf[(size_t)((bb * 16 + h) * 2 + 1) * SEQ + tq];
        bf16_t* zp = p.H + (size_t)tok * LDA_H + 3200 + cb; const u32x4 z4 = *(const u32x4*)zp;
        const float yv[8] = {bflo(y4.x), bfhi(y4.x), bflo(y4.y), bfhi(y4.y), bflo(y4.z), bfhi(y4.z), bflo(y4.w), bfhi(y4.w)};
        const float bv[8] = {bflo(b4.x), bfhi(b4.x), bflo(b4.y), bfhi(b4.y), bflo(b4.z), bfhi(b4.z), bflo(b4.w), bfhi(b4.w)};
        const float zv[8] = {bflo(z4.x), bfhi(z4.x), bflo(z4.y), bfhi(z4.y), bflo(z4.z), bfhi(z4.z), bflo(z4.w), bfhi(z4.w)};
        float sm = 0.f;
#pragma unroll
        for (int e = 0; e < 8; ++e) sm += yv[e];
        sm = red8(sm); const float mean = sm * (1.0f / 64.f); float d[8], vs = 0.f;
#pragma unroll
        for (int e = 0; e < 8; ++e) { d[e] = yv[e] - mean; vs += d[e] * d[e]; }
        vs = red8(vs); const float rstd = rsqrtf(vs * (1.0f / 64.f) + GN_EPS);
        const f32x4 g0 = *(const f32x4*)(p.lnx_g + l * DM + cb), g1 = *(const f32x4*)(p.lnx_g + l * DM + cb + 4), c0 = *(const f32x4*)(p.lnx_b + l * DM + cb), c1 = *(const f32x4*)(p.lnx_b + l * DM + cb + 4);
        const float gg[8] = {g0[0], g0[1], g0[2], g0[3], g1[0], g1[1], g1[2], g1[3]}, cc[8] = {c0[0], c0[1], c0[2], c0[3], c1[0], c1[1], c1[2], c1[3]};
        float o[8];
#pragma unroll
        for (int e = 0; e < 8; ++e) o[e] = (d[e] * rstd * gg[e] + cc[e] + rk * bv[e]) * siluf_(zv[e]);
        u32x4 w; w.x = cvt_pk_bf16(o[0], o[1]); w.y = cvt_pk_bf16(o[2], o[3]); w.z = cvt_pk_bf16(o[4], o[5]); w.w = cvt_pk_bf16(o[6], o[7]);
        *(u32x4*)(oalt ? oalt + (size_t)tok * DM + cb : zp) = w;
    }
}

__device__ void phase_sgu(int l, unsigned char* smem, bf16_t* oalt) {
    const Params p = load_params();
    bf16_t* vnT = (bf16_t*)smem;
    float* stat = (float*)(smem + 128 * 136 * 2);
    const int tid = opaque_tid(), wid = tid >> 6, lane = tid & 63, fr = lane & 15, fq = lane >> 4;
    const float* lng = p.sgu_ln_g + (size_t)l * DM; const float* lnb = p.sgu_ln_b + (size_t)l * DM;
    for (int item = blockIdx.x; item < T_TOK / 128; item += gridDim.x) {
        bf16_t* Hb = p.H + (size_t)item * 128 * LDB_H;
        __syncthreads();
        for (int q = 0; q < 16; ++q) { const int s = wid * 16 + q; const bf16_t* vr = Hb + (size_t)s * LDB_H + 1024 + lane * 16;
            const u32x4 a = *(const u32x4*)vr, bq = *(const u32x4*)(vr + 8);
            const float f[16] = {bflo(a.x), bfhi(a.x), bflo(a.y), bfhi(a.y), bflo(a.z), bfhi(a.z), bflo(a.w), bfhi(a.w), bflo(bq.x), bfhi(bq.x), bflo(bq.y), bfhi(bq.y), bflo(bq.z), bfhi(bq.z), bflo(bq.w), bfhi(bq.w)};
            float sm = 0.f;
#pragma unroll
            for (int e = 0; e < 16; ++e) sm += f[e];
#pragma unroll
            for (int o = 32; o > 0; o >>= 1) sm += __shfl_xor(sm, o);
            const float mean = sm * (1.0f / DM); float vs = 0.f;
#pragma unroll
            for (int e = 0; e < 16; ++e) { const float d = f[e] - mean; vs += d * d; }
#pragma unroll
            for (int o = 32; o > 0; o >>= 1) vs += __shfl_xor(vs, o);
            if (lane == 0) { stat[s * 2] = mean; stat[s * 2 + 1] = rsqrtf(vs * (1.0f / DM) + EPS); } }
        __syncthreads();
        for (int g = 0; g < 8; ++g) {
            { const int s = tid >> 2, c0 = (tid & 3) * 32; const float mean = stat[s * 2], rstd = stat[s * 2 + 1];
              const bf16_t* vr = Hb + (size_t)s * LDB_H + 1024 + g * 128 + c0;
#pragma unroll
              for (int q = 0; q < 4; ++q) { const u32x4 a = *(const u32x4*)(vr + q * 8); const float f[8] = {bflo(a.x), bfhi(a.x), bflo(a.y), bfhi(a.y), bflo(a.z), bfhi(a.z), bflo(a.w), bfhi(a.w)};
#pragma unroll
                  for (int e = 0; e < 8; ++e) { const int c = c0 + q * 8 + e; const float vn = (f[e] - mean) * rstd * lng[g * 128 + c] + lnb[g * 128 + c]; vnT[c * 136 + s] = f2bf(vn); } } }
            __syncthreads();
            f32x4 acc[8];
#pragma unroll
            for (int i = 0; i < 8; ++i) acc[i] = (f32x4){0.f, 0.f, 0.f, 0.f};
            const int trow = wid * 16 + fr;
            const float* Wg = p.sgu_w + (((size_t)l * 8 + g) * 128 + trow) * 128;
            const int nks = (wid < 4) ? 2 : 4;
            for (int ks = 0; ks < nks; ++ks) {
                const f32x4 wa = *(const f32x4*)(Wg + ks * 32 + fq * 8), wb = *(const f32x4*)(Wg + ks * 32 + fq * 8 + 4);
                u32x4 wp; wp.x = cvt_pk_bf16(wa[0], wa[1]); wp.y = cvt_pk_bf16(wa[2], wa[3]); wp.z = cvt_pk_bf16(wb[0], wb[1]); wp.w = cvt_pk_bf16(wb[2], wb[3]);
                const bf16x8 wfrag = __builtin_bit_cast(bf16x8, wp);
#pragma unroll
                for (int ct = 0; ct < 8; ++ct) { const bf16x8 vfrag = *(const bf16x8*)(vnT + (ct * 16 + fr) * 136 + ks * 32 + fq * 8);
                    acc[ct] = __builtin_amdgcn_mfma_f32_16x16x32_bf16(vfrag, wfrag, acc[ct], 0, 0, 0); }
            }
            { const float bs = p.sgu_b[((size_t)l * 8 + g) * 128 + trow]; bf16_t* hr = Hb + (size_t)trow * LDB_H;
#pragma unroll
              for (int ct = 0; ct < 8; ++ct) { const int c = g * 128 + ct * 16 + fq * 4;
                  const u32x2 u2 = *(const u32x2*)(hr + c), z2 = *(const u32x2*)(hr + 2048 + c);
                  const float uf[4] = {bflo(u2.x), bfhi(u2.x), bflo(u2.y), bfhi(u2.y)}, zf[4] = {bflo(z2.x), bfhi(z2.x), bflo(z2.y), bfhi(z2.y)};
                  float o[4];
#pragma unroll
                  for (int j = 0; j < 4; ++j) o[j] = uf[j] * (acc[ct][j] + bs) * siluf_(zf[j]);
                  u32x2 w; w.x = cvt_pk_bf16(o[0], o[1]); w.y = cvt_pk_bf16(o[2], o[3]); *(u32x2*)(oalt ? oalt + ((size_t)item * 128 + trow) * DM + c : hr + 2048 + c) = w; } }
            __syncthreads();
        }
    }
    __syncthreads();
}

__device__ void phase_hgrn_pre(int l, unsigned char* smem, bool dry) {
    const Params p = load_params();
    float* LF = (float*)smem;
    bf16_t* IB = (bf16_t*)(LF + 64 * 132);
    bf16_t* KB = IB + 64 * 136;
    float* psum = (float*)(KB + 64 * 136);
    float* lbs = psum + 512;
    const int tid = opaque_tid();
    bf16_t* xtra = (l == 0) ? (bf16_t*)p.out : p.vf;
    __syncthreads();
    for (int e = tid; e < DM; e += 512) { float lb = 0.f; if (l == 1) { const float l0 = p.lb_logits[e], l1 = p.lb_logits[DM + e]; lb = __builtin_amdgcn_rcpf(1.0f + __expf(l0 - l1)); } lbs[e] = lb; }
    __syncthreads();
    const int t = tid >> 3, c0 = (tid & 7) * 16;
    const int cc = tid & 127, tq = tid >> 7;
    for (int item = blockIdx.x; item < NB * 64 * 8; item += gridDim.x) {
        const int h = item & 7, ch = (item >> 3) & 63, b = item >> 9;
        const size_t r0 = (size_t)b * SEQ + ch * 64;
        bf16_t* hr = p.H + (r0 + t) * LDC_H + h * 128 + c0;
        float qv[16], kv[16];
        {
            const u32x4 q0 = *(const u32x4*)hr, q1 = *(const u32x4*)(hr + 8), f0 = *(const u32x4*)(hr + 1024), f1 = *(const u32x4*)(hr + 1032), i0 = *(const u32x4*)(hr + 2048), i1 = *(const u32x4*)(hr + 2056);
            const unsigned qa[8] = {q0.x, q0.y, q0.z, q0.w, q1.x, q1.y, q1.z, q1.w}, fa[8] = {f0.x, f0.y, f0.z, f0.w, f1.x, f1.y, f1.z, f1.w};
            *(u32x4*)(IB + t * 136 + c0) = i0; *(u32x4*)(IB + t * 136 + c0 + 8) = i1;
            float lf[16];
#pragma unroll
            for (int e = 0; e < 8; ++e) {
                const float lb0 = lbs[h * 128 + c0 + 2 * e], lb1 = lbs[h * 128 + c0 + 2 * e + 1];
                qv[2 * e] = siluf_(bflo(qa[e])); qv[2 * e + 1] = siluf_(bfhi(qa[e]));
                const float g0 = lb0 + (1.0f - lb0) * sigmoidf_(bflo(fa[e])), g1 = lb1 + (1.0f - lb1) * sigmoidf_(bfhi(fa[e]));
                kv[2 * e] = 1.0f - g0; kv[2 * e + 1] = 1.0f - g1; lf[2 * e] = __logf(g0); lf[2 * e + 1] = __logf(g1); }
#pragma unroll
            for (int e = 0; e < 4; ++e) *(f32x4*)(LF + t * 132 + c0 + e * 4) = (f32x4){lf[e * 4], lf[e * 4 + 1], lf[e * 4 + 2], lf[e * 4 + 3]};
        }
        __syncthreads();
        { float run = 0.f;
#pragma unroll
          for (int e = 0; e < 16; ++e) { run += LF[(tq * 16 + e) * 132 + cc]; LF[(tq * 16 + e) * 132 + cc] = run; }
          psum[tq * 128 + cc] = run; }
        __syncthreads();
        {
            const int tqt = t >> 4;
            unsigned qo[8], ko[8];
#pragma unroll
            for (int e4 = 0; e4 < 4; ++e4) {
                const f32x4 p0 = *(const f32x4*)(psum + c0 + e4 * 4), p1 = *(const f32x4*)(psum + 128 + c0 + e4 * 4), p2 = *(const f32x4*)(psum + 256 + c0 + e4 * 4), p3 = *(const f32x4*)(psum + 384 + c0 + e4 * 4);
                const f32x4 bl = *(const f32x4*)(LF + t * 132 + c0 + e4 * 4);
                float q2[4], k2[4];
#pragma unroll
                for (int j = 0; j < 4; ++j) {
                    const float off = (tqt > 0 ? p0[j] : 0.f) + (tqt > 1 ? p1[j] : 0.f) + (tqt > 2 ? p2[j] : 0.f);
                    const float bmid = p0[j] + p1[j], bb = bl[j] + off;
                    q2[j] = qv[e4 * 4 + j] * __expf(bb - bmid); k2[j] = kv[e4 * 4 + j] * __expf(bmid - bb); }
                qo[e4 * 2] = cvt_pk_bf16(q2[0], q2[1]); qo[e4 * 2 + 1] = cvt_pk_bf16(q2[2], q2[3]); ko[e4 * 2] = cvt_pk_bf16(k2[0], k2[1]); ko[e4 * 2 + 1] = cvt_pk_bf16(k2[2], k2[3]);
                if (t == 0) { f32x4 e1, e3;
#pragma unroll
                    for (int j = 0; j < 4; ++j) { e1[j] = __expf(p0[j] + p1[j]); e3[j] = __expf(p2[j] + p3[j]); }
                    float* gs = p.rkbuf + (size_t)(((b * 64 + ch) * 8 + h)) * 256 + c0 + e4 * 4; *(f32x4*)gs = e1; *(f32x4*)(gs + 128) = e3; }
            }
            const u32x4 qw0 = {qo[0], qo[1], qo[2], qo[3]}, qw1 = {qo[4], qo[5], qo[6], qo[7]}, kw0 = {ko[0], ko[1], ko[2], ko[3]}, kw1 = {ko[4], ko[5], ko[6], ko[7]};
            if (!dry) { *(u32x4*)hr = qw0; *(u32x4*)(hr + 8) = qw1; *(u32x4*)(hr + 1024) = kw0; *(u32x4*)(hr + 1032) = kw1; }
            *(u32x4*)(KB + t * 136 + c0) = kw0; *(u32x4*)(KB + t * 136 + c0 + 8) = kw1;
        }
        __syncthreads();
        {
            unsigned iw[8], kw[8];
#pragma unroll
            for (int e = 0; e < 8; ++e) {
                iw[e] = (unsigned)IB[(tq * 16 + 2 * e) * 136 + cc] | ((unsigned)IB[(tq * 16 + 2 * e + 1) * 136 + cc] << 16);
                kw[e] = (unsigned)KB[(tq * 16 + 2 * e) * 136 + cc] | ((unsigned)KB[(tq * 16 + 2 * e + 1) * 136 + cc] << 16); }
            bf16_t* ir = p.H + (r0 + (cc >> 1)) * LDC_H + 2048 + h * 128 + (cc & 1) * 64 + tq * 16;
            if (!dry) { *(u32x4*)ir = (u32x4){iw[0], iw[1], iw[2], iw[3]}; *(u32x4*)(ir + 8) = (u32x4){iw[4], iw[5], iw[6], iw[7]}; }
            bf16_t* kr = xtra + (r0 + (cc >> 1)) * DM + h * 128 + (cc & 1) * 64 + tq * 16;
            *(u32x4*)kr = (u32x4){kw[0], kw[1], kw[2], kw[3]}; *(u32x4*)(kr + 8) = (u32x4){kw[4], kw[5], kw[6], kw[7]};
        }
        __syncthreads();
    }
}

struct HgRaw { u32x4 qm[4], km[2][4], it[2][2], kt[2]; f32x4 e1, e3; };
__device__ __forceinline__ void hg_load(HgRaw& R, const bf16_t* H, const bf16_t* xtra, const float* gsc, size_t r0, int b, int ch, int h, int vs, int w, int fr, int fq) {
    const int tt_ = w >> 1, sp = w & 1;
#pragma unroll
    for (int ks = 0; ks < 4; ++ks) R.qm[ks] = *(const u32x4*)(H + (r0 + tt_ * 16 + fr) * LDC_H + h * 128 + ks * 32 + fq * 8);
#pragma unroll
    for (int q = 0; q < 2; ++q)
#pragma unroll
        for (int ks = 0; ks < 4; ++ks) R.km[q][ks] = *(const u32x4*)(H + (r0 + (sp * 2 + q) * 16 + fr) * LDC_H + 1024 + h * 128 + ks * 32 + fq * 8);
#pragma unroll
    for (int vt = 0; vt < 2; ++vt) { const int v = vs * 32 + vt * 16 + fr;
#pragma unroll
        for (int ks = 0; ks < 2; ++ks) R.it[vt][ks] = *(const u32x4*)(H + (r0 + (v >> 1)) * LDC_H + 2048 + h * 128 + (v & 1) * 64 + ks * 32 + fq * 8); }
    { const int k = w * 16 + fr;
#pragma unroll
      for (int ks = 0; ks < 2; ++ks) R.kt[ks] = *(const u32x4*)(xtra + (r0 + (k >> 1)) * DM + h * 128 + (k & 1) * 64 + ks * 32 + fq * 8); }
    const float* gs = gsc + (size_t)(((b * 64 + ch) * 8 + h)) * 256 + w * 16 + fq * 4;
    R.e1 = *(const f32x4*)gs; R.e3 = *(const f32x4*)(gs + 128);
}

__device__ void phase_hgrn_seq(int l, unsigned char* smem, bool dry) {
    const Params p = load_params();
    bf16_t* att = (bf16_t*)smem;
    bf16_t* STs = att + 64 * 72;
    const int tid = opaque_tid(), w = __builtin_amdgcn_readfirstlane(tid >> 6), lane = tid & 63, fr = lane & 15, fq = lane >> 4;
    const bf16_t* xtra = (l == 0) ? (const bf16_t*)p.out : p.vf;
    const int tt_ = w >> 1, sp = w & 1;
    for (int item = blockIdx.x; item < NB * 32; item += gridDim.x) {
        const int xc_ = item & 7, sl_ = item >> 3, vs = sl_ & 3, gi_ = (sl_ >> 2) * 8 + xc_, h = gi_ & 7, b = gi_ >> 3;
        __syncthreads();
        for (int e = tid; e < 32 * 136 / 2; e += 512) ((unsigned*)STs)[e] = 0u;
        f32x4 S[2] = {{0.f, 0.f, 0.f, 0.f}, {0.f, 0.f, 0.f, 0.f}};
        u32x2 o0 = {0u, 0u};
        HgRaw raw; hg_load(raw, p.H, xtra, p.rkbuf, (size_t)b * SEQ, b, 0, h, vs, w, fr, fq);
        __syncthreads();
        for (int ch = 0; ch < 64; ++ch) {
            const size_t r0 = (size_t)b * SEQ + ch * 64;
            const HgRaw cr = raw;
            if (ch + 1 < 64) hg_load(raw, p.H, xtra, p.rkbuf, r0 + 64, b, ch + 1, h, vs, w, fr, fq);
#pragma unroll
            for (int q = 0; q < 2; ++q) { const int stile = sp * 2 + q; f32x4 a = {0.f, 0.f, 0.f, 0.f};
                if (stile <= tt_) {
#pragma unroll
                    for (int ks = 0; ks < 4; ++ks) a = __builtin_amdgcn_mfma_f32_16x16x32_bf16(__builtin_bit_cast(bf16x8, cr.qm[ks]), __builtin_bit_cast(bf16x8, cr.km[q][ks]), a, 0, 0, 0); }
#pragma unroll
                for (int j = 0; j < 4; ++j) { const int t = tt_ * 16 + fq * 4 + j, s = stile * 16 + fr; att[t * 72 + s] = f2bf(s <= t ? a[j] : 0.f); } }
            __syncthreads();
            f32x4 o = {0.f, 0.f, 0.f, 0.f};
#pragma unroll
            for (int ks = 0; ks < 2; ++ks) { const bf16x8 af = *(const bf16x8*)(att + (tt_ * 16 + fr) * 72 + ks * 32 + fq * 8);
                o = __builtin_amdgcn_mfma_f32_16x16x32_bf16(__builtin_bit_cast(bf16x8, sp ? cr.it[1][ks] : cr.it[0][ks]), af, o, 0, 0, 0); }
#pragma unroll
            for (int ks = 0; ks < 4; ++ks) { const bf16x8 sf = *(const bf16x8*)(STs + (sp * 16 + fr) * 136 + ks * 32 + fq * 8);
                o = __builtin_amdgcn_mfma_f32_16x16x32_bf16(sf, __builtin_bit_cast(bf16x8, cr.qm[ks]), o, 0, 0, 0); }
            { u32x2 ow; ow.x = cvt_pk_bf16(o[0], o[1]); ow.y = cvt_pk_bf16(o[2], o[3]);
              if (ch == 0) o0 = ow;
              else if (!dry) { const int t = tt_ * 16 + fr; *(u32x2*)(p.H + (r0 - 64 + vs * 16 + (t >> 2)) * LDC_H + 2048 + h * 128 + (t & 3) * 32 + sp * 16 + fq * 4) = ow; } }
#pragma unroll
            for (int vt = 0; vt < 2; ++vt) { f32x4 u = {0.f, 0.f, 0.f, 0.f};
#pragma unroll
                for (int ks = 0; ks < 2; ++ks) u = __builtin_amdgcn_mfma_f32_16x16x32_bf16(__builtin_bit_cast(bf16x8, cr.kt[ks]), __builtin_bit_cast(bf16x8, cr.it[vt][ks]), u, 0, 0, 0);
#pragma unroll
                for (int j = 0; j < 4; ++j) S[vt][j] = cr.e3[j] * (cr.e1[j] * S[vt][j] + u[j]); }
            __syncthreads();
            if (ch + 1 < 64) {
#pragma unroll
                for (int vt = 0; vt < 2; ++vt) { u32x2 sw; sw.x = cvt_pk_bf16(S[vt][0] * raw.e1[0], S[vt][1] * raw.e1[1]); sw.y = cvt_pk_bf16(S[vt][2] * raw.e1[2], S[vt][3] * raw.e1[3]);
                    *(u32x2*)(STs + (vt * 16 + fr) * 136 + w * 16 + fq * 4) = sw; } }
        }
        if (!dry) { const int t = tt_ * 16 + fr; *(u32x2*)(p.H + ((size_t)b * SEQ + 63 * 64 + vs * 16 + (t >> 2)) * LDC_H + 2048 + h * 128 + (t & 3) * 32 + sp * 16 + fq * 4) = o0; }
    }
    __syncthreads();
}

__device__ void phase_hgrn_post(int l) {
    const Params p = load_params();
    const int tid = opaque_tid(), l8 = tid & 7;
    const int ngrp = T_TOK * 8;
    for (int g = blockIdx.x * 64 + (tid >> 3); g < ngrp; g += gridDim.x * 64) {
        const int tok = g >> 3, h = g & 7, b = tok / SEQ, tin = tok % SEQ, ch = tin >> 6, t = tin & 63, slot = (ch + 63) & 63, vs = l8 >> 1, vv0 = (l8 & 1) * 16;
        const bf16_t* op = p.H + ((size_t)b * SEQ + slot * 64 + vs * 16 + (t >> 2)) * LDC_H + 2048 + h * 128 + (t & 3) * 32 + vv0;
        bf16_t* zp = p.H + (size_t)tok * LDC_H + 3072 + h * 128 + l8 * 16;
        const u32x4 a0 = *(const u32x4*)op, a1 = *(const u32x4*)(op + 8), z0 = *(const u32x4*)zp, z1 = *(const u32x4*)(zp + 8);
        const float ov[16] = {bflo(a0.x), bfhi(a0.x), bflo(a0.y), bfhi(a0.y), bflo(a0.z), bfhi(a0.z), bflo(a0.w), bfhi(a0.w), bflo(a1.x), bfhi(a1.x), bflo(a1.y), bfhi(a1.y), bflo(a1.z), bfhi(a1.z), bflo(a1.w), bfhi(a1.w)};
        const float zf[16] = {bflo(z0.x), bfhi(z0.x), bflo(z0.y), bfhi(z0.y), bflo(z0.z), bfhi(z0.z), bflo(z0.w), bfhi(z0.w), bflo(z1.x), bfhi(z1.x), bflo(z1.y), bfhi(z1.y), bflo(z1.z), bfhi(z1.z), bflo(z1.w), bfhi(z1.w)};
        float ss = 0.f;
#pragma unroll
        for (int e = 0; e < 16; ++e) ss += ov[e] * ov[e];
        ss = red8(ss); const float rinv = rsqrtf(ss * (1.0f / 128.f) + EPS);
        const float* gn = p.hgrn_g + (size_t)l * DM + h * 128 + l8 * 16;
        float r[16];
#pragma unroll
        for (int e = 0; e < 16; ++e) r[e] = ov[e] * rinv * gn[e] * siluf_(zf[e]);
        u32x4 w0, w1; w0.x = cvt_pk_bf16(r[0], r[1]); w0.y = cvt_pk_bf16(r[2], r[3]); w0.z = cvt_pk_bf16(r[4], r[5]); w0.w = cvt_pk_bf16(r[6], r[7]);
        w1.x = cvt_pk_bf16(r[8], r[9]); w1.y = cvt_pk_bf16(r[10], r[11]); w1.z = cvt_pk_bf16(r[12], r[13]); w1.w = cvt_pk_bf16(r[14], r[15]);
        *(u32x4*)zp = w0; *(u32x4*)(zp + 8) = w1;
    }
}


#define XB_TMO      128
#define XB_XCNT(j)  (256  + 64 * (j))
#define XB_XSUB(j)  (1280 + 64 * (j))
#define XB_XGEN(j)  (2304 + 64 * (j))
#define XB_TOP      3328
#define XB_TOPGEN   3392
#define XCD_BAR_WORDS 3456
#define XB_SPIN_CAP (1u << 18)
__device__ __forceinline__ unsigned xb_ld(unsigned* p)              { return __hip_atomic_load(p, __ATOMIC_RELAXED, __HIP_MEMORY_SCOPE_AGENT); }
__device__ __forceinline__ unsigned xb_add(unsigned* p, unsigned v) { return __hip_atomic_fetch_add(p, v, __ATOMIC_RELAXED, __HIP_MEMORY_SCOPE_AGENT); }
__device__ __forceinline__ unsigned xb_xcc_id() { return (unsigned)__builtin_amdgcn_s_getreg((3 << 11) | 20) & 0xFu; }
#define XB_SPIN(cond, bar) do { unsigned _sp = 0; while (cond) { __builtin_amdgcn_s_sleep(1); \
    if ((++_sp & 255u) == 0u) { if (xb_ld(&(bar)[XB_TMO])) break; if (_sp > XB_SPIN_CAP) { atomicAdd(&(bar)[XB_TMO], 1u); break; } } } } while (0)
struct XcdBarrier { unsigned* bar; unsigned x; volatile LAS unsigned* st; };
__device__ __forceinline__ XcdBarrier xcd_barrier_post(unsigned* bar, volatile LAS unsigned* st) {
    XcdBarrier b; b.bar = bar; b.x = xb_xcc_id(); b.st = st;
    if (threadIdx.x == 0) (void)xb_add(&bar[XB_XCNT(b.x)], 1u);
    return b;
}
__device__ __forceinline__ void xcd_barrier_complete(unsigned* bar, unsigned x, unsigned& nloc, unsigned& nx) {
    const unsigned G = gridDim.x * gridDim.y * gridDim.z;
    unsigned sum, cnt, mine, sp = 0u;
    for (;;) {
        sum = 0u; cnt = 0u; mine = 0u;
#pragma unroll
        for (unsigned j = 0; j < 16; ++j) { const unsigned c = xb_ld(&bar[XB_XCNT(j)]); sum += c; cnt += (c > 0u) ? 1u : 0u; mine = (j == x) ? c : mine; }
        if (sum == G) break;
        __builtin_amdgcn_s_sleep(1);
        if ((++sp & 255u) == 0u) { if (xb_ld(&bar[XB_TMO])) break; if (sp > XB_SPIN_CAP) { atomicAdd(&bar[XB_TMO], 1u); break; } }
    }
    nloc = mine > 0u ? mine : 1u; nx = cnt > 0u ? cnt : 1u;
}
__device__ __forceinline__ void xcd_barrier(const XcdBarrier& b) {
    asm volatile("s_waitcnt vmcnt(0)" ::: "memory");
    __syncthreads();
    if (threadIdx.x == 0) {
        unsigned* bar = b.bar;
        __builtin_amdgcn_s_waitcnt(0);
        unsigned nloc = b.st[0], nx = b.st[1];
        if (nloc == 0u) { xcd_barrier_complete(bar, b.x, nloc, nx); b.st[0] = nloc; b.st[1] = nx; }
        const unsigned old = xb_add(&bar[XB_XSUB(b.x)], 1u);
        const unsigned gen = old / nloc;
        if (old + 1u == (gen + 1u) * nloc) {
            __builtin_amdgcn_fence(__ATOMIC_RELEASE, "agent");
            asm volatile("s_waitcnt vmcnt(0)" ::: "memory");
            const unsigned og = xb_add(&bar[XB_TOP], 1u);
            const unsigned tg = og / nx;
            if (og + 1u == (tg + 1u) * nx) xb_add(&bar[XB_TOPGEN], 1u);
            else XB_SPIN(xb_ld(&bar[XB_TOPGEN]) == tg, bar);
            __builtin_amdgcn_fence(__ATOMIC_ACQUIRE, "agent");
            xb_add(&bar[XB_XGEN(b.x)], 1u);
            asm volatile("s_waitcnt vmcnt(0)" ::: "memory");
        } else {
            XB_SPIN(xb_ld(&bar[XB_XGEN(b.x)]) == gen, bar);
            __builtin_amdgcn_fence(__ATOMIC_ACQUIRE, "agent");
            asm volatile("s_waitcnt vmcnt(0)" ::: "memory");
        }
    }
    __syncthreads();
}

constexpr int PH_PER_LAYER = 14, N_PHASES = 2 * PH_PER_LAYER + 1;

__global__ void __launch_bounds__(512, 2) fwd_megakernel(Params pk) {
    extern __shared__ __attribute__((aligned(16))) unsigned char shm[];
    LAS unsigned char* lds = (LAS unsigned char*)shm;
    cg::grid_group grid = cg::this_grid();
    const int phase_lo = pk.phase_lo, phase_hi = pk.phase_hi;
    volatile LAS unsigned* xst = (volatile LAS unsigned*)(lds + LDS_BYTES - 16);
    XcdBarrier xb; xb.bar = pk.bar; xb.x = 0; xb.st = xst;
    if (phase_hi - phase_lo > 1) { if (threadIdx.x == 0) { xst[0] = 0u; xst[1] = 0u; } __syncthreads(); xb = xcd_barrier_post(pk.bar, xst); }
    for (int ph = phase_lo; ph < phase_hi; ++ph) {
        const int l = ph / PH_PER_LAYER, q = ph % PH_PER_LAYER;
        if (ph == N_PHASES - 1) {
            const Params p = load_params();
            phase_rmsnorm(p.out, p.final_g, nullptr, p.out);
        } else if (q == 0) {
            { const int nrep = (PROBE_Q == 0 && l == 0) ? 2 : 1; for (int rep = 0; rep < nrep; ++rep) {
            phase_convert(l, shm);
            const Params p = load_params();
            phase_rmsnorm(l == 0 ? p.x : p.out, p.norm_g + (size_t)l * DM, p.xn, nullptr); } }
        } else if (q == 1 || q == 5 || q == 8) {
            const Params p = load_params(); const int G = gridDim.x, cidx = opaque_bid();
            const int N = (q == 1) ? LDA_H : (q == 5) ? LDB_H : LDC_H; const int r0 = (q == 1) ? 0 : (q == 5) ? LDA_H : (LDA_H + LDB_H);
            pg8::GemmDesc g; g.A = p.xn; g.Bt = p.Wt + (size_t)r0 * DM; g.lda = DM;
            pg8::Sched S; S.init(T_TOK, N, G, cidx, 1);
            pg8::EpiStore E; E.O = p.H; E.ldc = N;
{ const int nrep = (PROBE_Q == 1 && l == 0 && q == 1) ? 2 : 1; for (int rep = 0; rep < nrep; ++rep) pg8::gemm_phase(lds, g, g, S, E); }
        } else if (q == 2) {
{ const int nrep = (PROBE_Q == 2 && l == 0) ? 2 : 1; for (int rep = 0; rep < nrep; ++rep) phase_rwkv(l, shm, nullptr); }
        } else if (q == 3) {
            phase_rwkv_post(l, nullptr);
        } else if (q == 6) {
{ const int nrep = (PROBE_Q == 6 && l == 0) ? 2 : 1; for (int rep = 0; rep < nrep; ++rep) { const Params p = load_params(); phase_sgu(l, shm, rep + 1 < nrep ? (bf16_t*)p.out : nullptr); } }
        } else if (q == 9) {
            { const int nrep = (PROBE_Q == 9 && l == 0) ? 2 : 1; for (int rep = 0; rep < nrep; ++rep) phase_hgrn_pre(l, shm, rep + 1 < nrep); }
        } else if (q == 10) {
            { const int nrep = (PROBE_Q == 10 && l == 0) ? 2 : 1; for (int rep = 0; rep < nrep; ++rep) phase_hgrn_seq(l, shm, rep + 1 < nrep); }
        } else if (q == 11) {
            phase_hgrn_post(l);
        } else if (q == 4 || q == 7 || q == 12) {
            const Params p = load_params(); const int G = gridDim.x, cidx = opaque_bid();
            bf16_t* WtBr = p.Wt + (size_t)WT_ROWS * DM;
            const int n = (q == 4) ? 0 : (q == 7) ? 1 : 2; const int ldh = (n == 0) ? LDA_H : (n == 1) ? LDB_H : LDC_H; const int ocol = (n == 0) ? 3200 : (n == 1) ? 2048 : 3072;
            pg8::GemmDesc g0, g1; g0.A = p.xn; g0.Bt = p.Wt + (size_t)(LDA_H + LDB_H + LDC_H + n * DM) * DM; g0.lda = DM;
            g1.A = p.H + ocol; g1.Bt = WtBr + (size_t)n * DM * DM; g1.lda = ldh;
            pg8::Sched S; S.init(T_TOK, DM, G, cidx, 2);
            pg8::EpiMerge E; E.G = p.H; E.ldg = ldh; E.bias = p.b_merge + ((size_t)l * 3 + n) * DM; E.Y = p.y; E.accum = (n > 0);
            { const int nrep = (PROBE_Q == 4 && l == 0 && q == 4) ? 2 : 1; for (int rep = 0; rep < nrep; ++rep) pg8::gemm_phase(lds, g0, g1, S, E); }
        } else {
            const Params p = load_params(); const int G = gridDim.x, cidx = opaque_bid();
            bf16_t* WtOut = p.Wt + (size_t)WT_ROWS * DM + (size_t)3 * DM * DM;
            pg8::GemmDesc g; g.A = p.y; g.Bt = WtOut; g.lda = DM;
            pg8::Sched S; S.init(T_TOK, DM, G, cidx, 1);
            pg8::EpiResid E; E.Xin = (l == 0) ? p.x : p.out; E.Xout = p.out;
            { const int nrep = (PROBE_Q == 13 && l == 0) ? 2 : 1; for (int rep = 0; rep < nrep; ++rep) pg8::gemm_phase(lds, g, g, S, E); }
        }
        if (ph + 1 < phase_hi) { if (ph == phase_lo) grid.sync(); else xcd_barrier(xb); }
    }
}

extern "C" void kernel_launch(void* const* d_in, const int* in_sizes, int n_in, void* d_out, int out_size, void* d_ws, size_t ws_size, hipStream_t stream) {
    static int grid_blocks = 0;
    if (!grid_blocks) {
        int dev = 0, cus = 0, per_cu = 0;
        hipGetDevice(&dev);
        hipDeviceGetAttribute(&cus, hipDeviceAttributeMultiprocessorCount, dev);
        if (hipFuncSetAttribute((const void*)fwd_megakernel, hipFuncAttributeMaxDynamicSharedMemorySize, LDS_BYTES) != hipSuccess) { fprintf(stderr, "hipFuncSetAttribute failed\n"); return; }
        hipOccupancyMaxActiveBlocksPerMultiprocessor(&per_cu, (const void*)fwd_megakernel, 512, LDS_BYTES);
        if (per_cu < 1) { fprintf(stderr, "occupancy query says 0 blocks per CU\n"); return; }
        grid_blocks = cus * 1;
    }
    Params p{};
    const float** fp = (const float**)&p;
    for (int i = 0; i < 26; ++i) fp[i] = (const float*)d_in[i];
    p.out = (float*)d_out;
    unsigned char* ws = (unsigned char*)d_ws; size_t off = 0;
    auto take = [&](size_t bytes) { unsigned char* r = ws + off; off += (bytes + 255) & ~(size_t)255; return r; };
    p.Wt = (bf16_t*)take(((size_t)WT_ROWS * DM + 4 * (size_t)DM * DM) * 2);
    p.xn = (bf16_t*)take((size_t)T_TOK * DM * 2);
    p.vf = (bf16_t*)take((size_t)T_TOK * DM * 2);
    p.y = (bf16_t*)take((size_t)T_TOK * DM * 2);
    p.H = (bf16_t*)take((size_t)T_TOK * LDA_H * 2);
    p.rkbuf = (float*)take((size_t)T_TOK * 16 * 2 * 4);
    p.bar = (unsigned*)take((size_t)XCD_BAR_WORDS * 4);
    if (off > ws_size) { fprintf(stderr, "workspace too small: need %zu have %zu\n", off, ws_size); return; }
#if SINGLE_LAUNCH
    p.phase_lo = 0; p.phase_hi = N_PHASES;
    void* args[] = {&p};
    if (hipMemsetAsync(p.bar, 0, (size_t)XCD_BAR_WORDS * 4, stream) != hipSuccess) { fprintf(stderr, "memset failed\n"); return; }
    hipError_t e = hipLaunchCooperativeKernel((const void*)fwd_megakernel, dim3(grid_blocks), dim3(512), args, LDS_BYTES, stream);
    if (e != hipSuccess) fprintf(stderr, "cooperative launch failed: %s (grid %d)\n", hipGetErrorString(e), grid_blocks);
#else
    for (int ph = 0; ph < N_PHASES; ++ph) {
        p.phase_lo = ph; p.phase_hi = ph + 1;
        hipLaunchKernelGGL(fwd_megakernel, dim3(grid_blocks), dim3(512), LDS_BYTES, stream, p);
    }
#endif
}
```

```cpp
#include <hip/hip_runtime.h>
#include <hip/hip_cooperative_groups.h>
#include <cstdio>
namespace cg = cooperative_groups;

#ifndef PROBE_MODE
#define PROBE_MODE 0
#endif
#ifndef PROBE_Q
#define PROBE_Q -1
#endif
#ifndef SINGLE_LAUNCH
#define SINGLE_LAUNCH 1
#endif

typedef unsigned short bf16_t;
typedef short bf16x8 __attribute__((ext_vector_type(8)));
typedef float f32x4 __attribute__((ext_vector_type(4)));
typedef float f32x2 __attribute__((ext_vector_type(2)));
typedef unsigned u32x4 __attribute__((ext_vector_type(4)));
typedef unsigned u32x2 __attribute__((ext_vector_type(2)));
#define LAS __attribute__((address_space(3)))

constexpr int T_TOK = 32768, DM = 1024, SEQ = 4096, NB = 8;
constexpr int N_IN = 14464;
constexpr int LDA_H = 4352, LDB_H = 3072, LDC_H = 4096;
constexpr int WT_ROWS = 14592;
constexpr int LDS_BYTES = 163840;
constexpr float EPS = 1e-6f, GN_EPS = 64e-5f;

struct Params {
    const float *x, *norm_g, *w_in, *b_merge, *mu, *w0, *w_w2, *a0, *a_w2, *v0, *v_w1, *v_w2, *k_k, *k_a, *r_k, *lnx_g, *lnx_b,
        *sgu_ln_g, *sgu_ln_b, *sgu_w, *sgu_b, *lb_logits, *hgrn_g, *w_branch, *w_out, *final_g;
    float* out;
    bf16_t *Wt, *xn, *vf, *y, *H;
    float* rkbuf;
    unsigned* bar;
    int phase_lo, phase_hi;
};

__device__ __forceinline__ float bf2f(bf16_t h) { return __uint_as_float(((unsigned)h) << 16); }
__device__ __forceinline__ float bflo(unsigned u) { return __uint_as_float(u << 16); }
__device__ __forceinline__ float bfhi(unsigned u) { return __uint_as_float(u & 0xffff0000u); }
typedef __bf16 bf16x2_t __attribute__((ext_vector_type(2)));
__device__ __forceinline__ unsigned cvt_pk_bf16(float lo, float hi) { const f32x2 v = {lo, hi}; const bf16x2_t r = __builtin_convertvector(v, bf16x2_t); return __builtin_bit_cast(unsigned, r); }
__device__ __forceinline__ bf16_t f2bf(float f) { return (bf16_t)(cvt_pk_bf16(f, 0.f) & 0xffffu); }
__device__ __forceinline__ float sigmoidf_(float x) { return __builtin_amdgcn_rcpf(1.0f + __expf(-x)); }
__device__ __forceinline__ float siluf_(float x) { return x * __builtin_amdgcn_rcpf(1.0f + __expf(-x)); }
__device__ __forceinline__ float tanh_fast(float x) { return 1.0f - 2.0f * __builtin_amdgcn_rcpf(1.0f + __expf(2.0f * x)); }

__device__ __forceinline__ Params load_params() {
#if defined(__HIP_DEVICE_COMPILE__)
    typedef const Params __attribute__((address_space(4)))* KP;
    KP kp = (KP)__builtin_amdgcn_kernarg_segment_ptr(); asm volatile("" : "+s"(kp)); return *kp;
#else
    return Params{};
#endif
}
__device__ __forceinline__ int opaque_tid() { int t = threadIdx.x; asm volatile("" : "+v"(t)); return t; }
__device__ __forceinline__ int opaque_bid() { int t = blockIdx.x; asm volatile("" : "+s"(t)); return t; }

namespace pg8 {
constexpr int BM = 256, BK = 64, HALF = 128, HTB = HALF * BK * 2, STAGE_BYTES = 8 * HTB, NXCD = 8, WGM = 8, KD = 1024;
__device__ __forceinline__ int lds_byte(int r, int c) { const int st = (r >> 4) * 2 + (c >> 5), rr = r & 15, cc = c & 31, ob = rr * 64 + cc * 2; return st * 1024 + (ob ^ (((ob >> 9) & 1) << 5)); }
__device__ __forceinline__ void stage_rc(int b, int& R, int& C) { const int st = b / 1024, sb = b % 1024, swz = sb ^ (((sb >> 9) & 1) << 5); R = (st >> 1) * 16 + swz / 64; C = (st & 1) * 32 + (swz % 64) / 2; }
__device__ __forceinline__ int perm32(int rho) { const int n = rho >> 4, i = rho & 15; return 8 * (i >> 2) + 4 * n + (i & 3); }

struct Unit { int pm, pn, sel; };
struct GemmDesc { const bf16_t* A; const bf16_t* Bt; int lda; };
struct Sched {
    int nM, nN, nwg, G, c, nsel;
    __device__ void init(int M, int N, int G_, int c_, int nsel_) { nM = M / BM; nN = N / BM; nwg = nM * nN; G = G_; c = c_; nsel = nsel_; }
    __device__ bool next(int i, Unit& u) const {
        const int ti = (nsel == 2) ? (i >> 1) : i; u.sel = (nsel == 2) ? (i & 1) : 0;
        const long L = (long)ti * G + c; if (L >= nwg) return false;
        int wgid = (int)L; { const int q = nwg / NXCD, r = nwg % NXCD, xcd = wgid % NXCD, off = wgid / NXCD; wgid = (xcd < r ? xcd * (q + 1) : r * (q + 1) + (xcd - r) * q) + off; }
        const int nig = WGM * nN, gid = wgid / nig, fm = gid * WGM, gsz = (nM - fm) < WGM ? (nM - fm) : WGM;
        u.pm = fm + ((wgid % nig) % gsz); u.pn = (wgid % nig) / gsz; return true;
    }
};

template <class Epi>
__device__ __forceinline__ void gemm_phase(LAS unsigned char* lds, const GemmDesc g0, const GemmDesc g1, const Sched& S, const Epi& E) {
    const int tid = opaque_tid(), wid = __builtin_amdgcn_readfirstlane(tid >> 6), lane = tid & 63, wr = wid >> 2, wc = wid & 3, fr = lane & 15, fq = lane >> 4;
    constexpr int K = KD, nt = K / BK;
    unsigned voffA0[2], voffA1[2], voffB[2];
#pragma unroll
    for (int i = 0; i < 2; ++i) { int R, C; stage_rc(tid * 16 + i * 8192, R, C); const int Rb = Epi::PERM ? ((R & ~31) + perm32(R & 31)) : R;
        voffA0[i] = (unsigned)(R * g0.lda + C) * 2u; voffA1[i] = (unsigned)(R * g1.lda + C) * 2u; voffB[i] = (unsigned)(Rb * K + C) * 2u; }
    const size_t kstep = (size_t)(BK * 2);
    const size_t hstepB = (size_t)HALF * K * 2;
    const unsigned ldsw = (unsigned)wid * 1024u;
    const int aoff = lds_byte(wr * 64 + fr, fq * 8), boff = lds_byte(wc * 32 + fr, fq * 8);
#define PG8_SA(b, h) (((b) * 2 + (h)) * HTB)
#define PG8_SB(b, h) ((4 + (b) * 2 + (h)) * HTB)
#define PG8_STAGE(bufoff, gbase, v0, v1) do { \
        __builtin_amdgcn_global_load_lds((const unsigned*)((const char*)(gbase) + (v0)), (LAS unsigned*)(lds + (bufoff) + ldsw), 16, 0, 0); \
        __builtin_amdgcn_global_load_lds((const unsigned*)((const char*)(gbase) + (v1)), (LAS unsigned*)(lds + (bufoff) + ldsw + 8192), 16, 0, 0); } while (0)
#define PG8_STAGEB(bufoff, gbase) PG8_STAGE(bufoff, gbase, voffB[0], voffB[1])
#define PG8_LDA(dst, b, h) do { _Pragma("unroll") for (int m = 0; m < 4; ++m) _Pragma("unroll") for (int k = 0; k < 2; ++k) dst[m][k] = *(const LAS bf16x8*)(lds + PG8_SA(b, h) + aoff + m * 2048 + k * 1024); } while (0)
#define PG8_LDB(dst, b, h) do { _Pragma("unroll") for (int n = 0; n < 2; ++n) _Pragma("unroll") for (int k = 0; k < 2; ++k) dst[n][k] = *(const LAS bf16x8*)(lds + PG8_SB(b, h) + boff + n * 2048 + k * 1024); } while (0)
#define PG8_MMA(ai, bj, At, Bt) do { __builtin_amdgcn_s_setprio(1); _Pragma("unroll") for (int m = 0; m < 4; ++m) _Pragma("unroll") for (int n = 0; n < 2; ++n) _Pragma("unroll") for (int k = 0; k < 2; ++k) \
        acc[ai][bj][m][n] = __builtin_amdgcn_mfma_f32_16x16x32_bf16(Bt[n][k], At[m][k], acc[ai][bj][m][n], 0, 0, 0); __builtin_amdgcn_s_setprio(0); } while (0)
#define PG8_WAIT_V(n) asm volatile("s_waitcnt vmcnt(" #n ")" ::: "memory")
#define PG8_WAIT_L(n) asm volatile("s_waitcnt lgkmcnt(" #n ")" ::: "memory")
#define PG8_BAR __builtin_amdgcn_s_barrier()
#define PG8_SCHED __builtin_amdgcn_sched_barrier(0)
    Unit cur, nxt; int ui = 0;
    if (!S.next(0, cur)) return;
    f32x4 acc[2][2][4][2];
#pragma unroll
    for (int a = 0; a < 2; ++a)
#pragma unroll
        for (int b = 0; b < 2; ++b)
#pragma unroll
            for (int m = 0; m < 4; ++m)
#pragma unroll
                for (int n = 0; n < 2; ++n) acc[a][b][m][n] = (f32x4){0.f, 0.f, 0.f, 0.f};
    bf16x8 At[4][2], B0[2][2], B1[2][2];
    const char* cA = (const char*)(cur.sel ? g1.A : g0.A) + (size_t)cur.pm * 256 * (size_t)(cur.sel ? g1.lda : g0.lda) * 2;
    const char* cB = (const char*)(cur.sel ? g1.Bt : g0.Bt) + (size_t)cur.pn * 256 * K * 2;
    size_t chA = (size_t)HALF * (cur.sel ? g1.lda : g0.lda) * 2;
    unsigned cv0 = cur.sel ? voffA1[0] : voffA0[0], cv1 = cur.sel ? voffA1[1] : voffA0[1];
    PG8_STAGEB(PG8_SB(0, 0), cB); PG8_STAGE(PG8_SA(0, 0), cA, cv0, cv1); PG8_STAGEB(PG8_SB(0, 1), cB + hstepB); PG8_STAGE(PG8_SA(0, 1), cA + chA, cv0, cv1);
    if (wr == 1) PG8_BAR;
    PG8_WAIT_V(4); PG8_BAR;
    PG8_STAGEB(PG8_SB(1, 0), cB + kstep); PG8_STAGE(PG8_SA(1, 0), cA + kstep, cv0, cv1); PG8_STAGEB(PG8_SB(1, 1), cB + hstepB + kstep);
    PG8_WAIT_V(6); PG8_BAR;
    for (;;) {
        const bool has_next = S.next(ui + 1, nxt);
        const int nsel = has_next ? nxt.sel : cur.sel;
        const char* nA = has_next ? (const char*)(nsel ? g1.A : g0.A) + (size_t)nxt.pm * 256 * (size_t)(nsel ? g1.lda : g0.lda) * 2 : cA;
        const char* nB = has_next ? (const char*)(nsel ? g1.Bt : g0.Bt) + (size_t)nxt.pn * 256 * K * 2 : cB;
        const size_t nhA = (size_t)HALF * (nsel ? g1.lda : g0.lda) * 2;
        const unsigned nv0 = nsel ? voffA1[0] : voffA0[0], nv1 = nsel ? voffA1[1] : voffA0[1];
        for (int t = 0; t < nt; t += 2) {
            const bool last = (t == nt - 2);
            const char* a1 = cA + (size_t)(t + 1) * kstep;
            const char* a2 = last ? nA : cA + (size_t)(t + 2) * kstep; const char* b2 = last ? nB : cB + (size_t)(t + 2) * kstep;
            const char* a3 = a2 + kstep; const char* b3 = b2 + kstep;
            const size_t h2 = last ? nhA : chA; const unsigned w0 = last ? nv0 : cv0, w1 = last ? nv1 : cv1;
            PG8_LDB(B0, 0, 0); PG8_SCHED; PG8_LDA(At, 0, 0); PG8_STAGE(PG8_SA(1, 1), a1 + chA, cv0, cv1);
            PG8_WAIT_L(8); PG8_BAR; PG8_WAIT_L(0); PG8_MMA(0, 0, At, B0); PG8_BAR; PG8_SCHED;
            PG8_LDB(B1, 0, 1); PG8_STAGEB(PG8_SB(0, 0), b2);
            PG8_BAR; PG8_WAIT_L(0); PG8_MMA(0, 1, At, B1); PG8_BAR;
            PG8_LDA(At, 0, 1); PG8_STAGE(PG8_SA(0, 0), a2, w0, w1);
            PG8_BAR; PG8_WAIT_L(0); PG8_MMA(1, 0, At, B0); PG8_BAR; PG8_SCHED;
            PG8_STAGEB(PG8_SB(0, 1), b2 + hstepB);
            PG8_WAIT_V(6); PG8_BAR; PG8_MMA(1, 1, At, B1); PG8_BAR;
            PG8_LDB(B0, 1, 0); PG8_SCHED; PG8_LDA(At, 1, 0); PG8_STAGE(PG8_SA(0, 1), a2 + h2, w0, w1);
            PG8_WAIT_L(8); PG8_BAR; PG8_WAIT_L(0); PG8_MMA(0, 0, At, B0); PG8_BAR; PG8_SCHED;
            PG8_LDB(B1, 1, 1); PG8_STAGEB(PG8_SB(1, 0), b3);
            PG8_BAR; PG8_WAIT_L(0); PG8_MMA(0, 1, At, B1); PG8_BAR;
            PG8_LDA(At, 1, 1); PG8_STAGE(PG8_SA(1, 0), a3, w0, w1);
            PG8_BAR; PG8_WAIT_L(0); PG8_MMA(1, 0, At, B0); PG8_BAR; PG8_SCHED;
            PG8_STAGEB(PG8_SB(1, 1), b3 + hstepB);
            PG8_WAIT_V(6); PG8_BAR; PG8_MMA(1, 1, At, B1); PG8_BAR;
        }
        E(acc, cur, wr, wc, fr, fq);
        if (!has_next) break;
#pragma unroll
        for (int a = 0; a < 2; ++a)
#pragma unroll
            for (int b = 0; b < 2; ++b)
#pragma unroll
                for (int m = 0; m < 4; ++m)
#pragma unroll
                    for (int n = 0; n < 2; ++n) acc[a][b][m][n] = (f32x4){0.f, 0.f, 0.f, 0.f};
        cur = nxt; cA = nA; cB = nB; chA = nhA; cv0 = nv0; cv1 = nv1; ++ui;
    }
    PG8_WAIT_V(0);
    if (wr == 0) PG8_BAR;
    PG8_BAR;
#undef PG8_SA
#undef PG8_SB
#undef PG8_STAGE
#undef PG8_STAGEB
#undef PG8_LDA
#undef PG8_LDB
#undef PG8_MMA
#undef PG8_WAIT_V
#undef PG8_WAIT_L
#undef PG8_BAR
#undef PG8_SCHED
}

struct EpiStore {
    static constexpr bool PERM = true;
    bf16_t* O; int ldc;
    __device__ __forceinline__ void operator()(const f32x4 (&acc)[2][2][4][2], const Unit& u, int wr, int wc, int fr, int fq) const {
        const int row0 = u.pm * BM + wr * 64 + fr, col0 = u.pn * BM + wc * 32 + 8 * fq;
#pragma unroll
        for (int ai = 0; ai < 2; ++ai)
#pragma unroll
            for (int m = 0; m < 4; ++m) { bf16_t* rowp = O + (size_t)(row0 + ai * HALF + m * 16) * ldc + col0;
#pragma unroll
                for (int bj = 0; bj < 2; ++bj) { const f32x4 v0 = acc[ai][bj][m][0], v1 = acc[ai][bj][m][1];
                    u32x4 w; w.x = cvt_pk_bf16(v0[0], v0[1]); w.y = cvt_pk_bf16(v0[2], v0[3]); w.z = cvt_pk_bf16(v1[0], v1[1]); w.w = cvt_pk_bf16(v1[2], v1[3]);
                    *(u32x4*)(rowp + bj * HALF) = w; } }
    }
};
struct EpiMerge {
    static constexpr bool PERM = true;
    bf16_t* G; int ldg; const float* bias; bf16_t* Y; int accum;
    __device__ __forceinline__ void operator()(const f32x4 (&acc)[2][2][4][2], const Unit& u, int wr, int wc, int fr, int fq) const {
        const int row0 = u.pm * BM + wr * 64 + fr, col0 = u.pn * BM + wc * 32 + 8 * fq;
        if (u.sel == 0) {
            f32x4 bv[2][2];
#pragma unroll
            for (int bj = 0; bj < 2; ++bj)
#pragma unroll
                for (int n = 0; n < 2; ++n) bv[bj][n] = *(const f32x4*)(bias + col0 + bj * HALF + 4 * n);
#pragma unroll
            for (int ai = 0; ai < 2; ++ai)
#pragma unroll
                for (int m = 0; m < 4; ++m) { bf16_t* rowp = G + (size_t)(row0 + ai * HALF + m * 16) * ldg + col0;
#pragma unroll
                    for (int bj = 0; bj < 2; ++bj) { f32x4 v0 = acc[ai][bj][m][0] + bv[bj][0], v1 = acc[ai][bj][m][1] + bv[bj][1];
#pragma unroll
                        for (int j = 0; j < 4; ++j) { v0[j] = sigmoidf_(v0[j]); v1[j] = sigmoidf_(v1[j]); }
                        u32x4 w; w.x = cvt_pk_bf16(v0[0], v0[1]); w.y = cvt_pk_bf16(v0[2], v0[3]); w.z = cvt_pk_bf16(v1[0], v1[1]); w.w = cvt_pk_bf16(v1[2], v1[3]);
                        *(u32x4*)(rowp + bj * HALF) = w; } }
        } else {
#pragma unroll
            for (int ai = 0; ai < 2; ++ai)
#pragma unroll
                for (int m = 0; m < 4; ++m) { const size_t r = (size_t)(row0 + ai * HALF + m * 16);
                    const unsigned long long* gp = (const unsigned long long*)(G + r * ldg + col0); bf16_t* yp = Y + r * DM + col0;
#pragma unroll
                    for (int bj = 0; bj < 2; ++bj) {
                        const unsigned long long g0 = __hip_atomic_load(gp + bj * (HALF / 4), __ATOMIC_RELAXED, __HIP_MEMORY_SCOPE_AGENT);
                        const unsigned long long g1 = __hip_atomic_load(gp + bj * (HALF / 4) + 1, __ATOMIC_RELAXED, __HIP_MEMORY_SCOPE_AGENT);
                        const unsigned gw[4] = {(unsigned)g0, (unsigned)(g0 >> 32), (unsigned)g1, (unsigned)(g1 >> 32)};
                        u32x4 yo = {0u, 0u, 0u, 0u}; if (accum) yo = *(const u32x4*)(yp + bj * HALF);
                        const f32x4 v0 = acc[ai][bj][m][0], v1 = acc[ai][bj][m][1];
                        u32x4 w;
                        w.x = cvt_pk_bf16(bflo(yo.x) + bflo(gw[0]) * v0[0], bfhi(yo.x) + bfhi(gw[0]) * v0[1]);
                        w.y = cvt_pk_bf16(bflo(yo.y) + bflo(gw[1]) * v0[2], bfhi(yo.y) + bfhi(gw[1]) * v0[3]);
                        w.z = cvt_pk_bf16(bflo(yo.z) + bflo(gw[2]) * v1[0], bfhi(yo.z) + bfhi(gw[2]) * v1[1]);
                        w.w = cvt_pk_bf16(bflo(yo.w) + bflo(gw[3]) * v1[2], bfhi(yo.w) + bfhi(gw[3]) * v1[3]);
                        *(u32x4*)(yp + bj * HALF) = w; } }
        }
    }
};
struct EpiResid {
    static constexpr bool PERM = false;
    const float* Xin; float* Xout;
    __device__ __forceinline__ void operator()(const f32x4 (&acc)[2][2][4][2], const Unit& u, int wr, int wc, int fr, int fq) const {
        const int row0 = u.pm * BM + wr * 64 + fr, col0 = u.pn * BM + wc * 32 + 4 * fq;
#pragma unroll
        for (int ai = 0; ai < 2; ++ai)
#pragma unroll
            for (int m = 0; m < 4; ++m) { const size_t ro = (size_t)(row0 + ai * HALF + m * 16) * DM + col0;
#pragma unroll
                for (int bj = 0; bj < 2; ++bj)
#pragma unroll
                    for (int n = 0; n < 2; ++n) { const f32x4 xi = *(const f32x4*)(Xin + ro + bj * HALF + n * 16); *(f32x4*)(Xout + ro + bj * HALF + n * 16) = xi + acc[ai][bj][m][n]; } }
    }
};
}

__device__ void phase_convert(int l, unsigned char* smem) {
    const Params p = load_params();
    float* tile = (float*)smem;
    const int tid = opaque_tid();
    const float* win = p.w_in + (size_t)l * DM * N_IN;
    bf16_t* WtIn = p.Wt; bf16_t* WtBr = p.Wt + (size_t)WT_ROWS * DM; bf16_t* WtOut = WtBr + (size_t)3 * DM * DM;
    const int NT_IN = WT_ROWS / 64;
    const int total = (NT_IN + 48 + 16) * 16;
    for (int it = blockIdx.x; it < total; it += gridDim.x) {
        const int ntile = it >> 4, kt = it & 15, k0 = kt * 64;
        const float* src = nullptr; int ld = 0, c0 = 0, valid = 64; bf16_t* dst;
        if (ntile < NT_IN) {
            const int n0 = ntile * 64; dst = WtIn + (size_t)n0 * DM;
            if (n0 < 4224) { src = win; ld = N_IN; c0 = n0; }
            else if (n0 < 4352) { if (n0 == 4224 && l > 0) { src = p.v_w1 + (size_t)(l - 1) * DM * 32; ld = 32; c0 = 0; valid = 32; } else { valid = 0; } }
            else { src = win; ld = N_IN; c0 = n0 - 128; }
        } else if (ntile < NT_IN + 48) {
            const int q = ntile - NT_IN, n = q >> 4, n0 = (q & 15) * 64;
            src = p.w_branch + ((size_t)l * 3 + n) * DM * DM; ld = DM; c0 = n0; dst = WtBr + ((size_t)n * DM + n0) * DM;
        } else {
            const int n0 = (ntile - NT_IN - 48) * 64; src = p.w_out + (size_t)l * DM * DM; ld = DM; c0 = n0; dst = WtOut + (size_t)n0 * DM;
        }
        __syncthreads();
        if (valid == 64) {
            const int kr = tid >> 4, nc = (tid & 15) * 4;
#pragma unroll
            for (int ps = 0; ps < 2; ++ps) { const int k = kr + ps * 32; const f32x4 v = *(const f32x4*)(src + (size_t)(k0 + k) * ld + c0 + nc);
                tile[k * 65 + nc] = v[0]; tile[k * 65 + nc + 1] = v[1]; tile[k * 65 + nc + 2] = v[2]; tile[k * 65 + nc + 3] = v[3]; }
        } else {
            for (int e = tid; e < 4096; e += 512) { const int k = e >> 6, n = e & 63; tile[k * 65 + n] = (n < valid) ? src[(size_t)(k0 + k) * ld + c0 + n] : 0.f; }
        }
        __syncthreads();
        { const int nr = tid >> 3, kc = (tid & 7) * 8; u32x4 w;
          w.x = cvt_pk_bf16(tile[(kc + 0) * 65 + nr], tile[(kc + 1) * 65 + nr]); w.y = cvt_pk_bf16(tile[(kc + 2) * 65 + nr], tile[(kc + 3) * 65 + nr]);
          w.z = cvt_pk_bf16(tile[(kc + 4) * 65 + nr], tile[(kc + 5) * 65 + nr]); w.w = cvt_pk_bf16(tile[(kc + 6) * 65 + nr], tile[(kc + 7) * 65 + nr]);
          *(u32x4*)(dst + (size_t)nr * DM + k0 + kc) = w; }
    }
    __syncthreads();
}

__device__ void phase_rmsnorm(const float* x, const float* g, bf16_t* xn, float* outf) {
    const int tid_ = opaque_tid(); const int lane = tid_ & 63, wv = tid_ >> 6;
    f32x4 gv[4];
#pragma unroll
    for (int q = 0; q < 4; ++q) gv[q] = *(const f32x4*)(g + q * 256 + lane * 4);
    for (int row = blockIdx.x * 8 + wv; row < T_TOK; row += gridDim.x * 8) {
        const float* xr = x + (size_t)row * DM; f32x4 v[4]; float ss = 0.f;
#pragma unroll
        for (int q = 0; q < 4; ++q) { v[q] = *(const f32x4*)(xr + q * 256 + lane * 4); ss += v[q][0] * v[q][0] + v[q][1] * v[q][1] + v[q][2] * v[q][2] + v[q][3] * v[q][3]; }
#pragma unroll
        for (int o = 32; o > 0; o >>= 1) ss += __shfl_xor(ss, o);
        const float rinv = rsqrtf(ss * (1.0f / DM) + EPS);
#pragma unroll
        for (int q = 0; q < 4; ++q) { const f32x4 o = v[q] * rinv * gv[q];
            if (xn) { u32x2 w; w.x = cvt_pk_bf16(o[0], o[1]); w.y = cvt_pk_bf16(o[2], o[3]); *(u32x2*)(xn + (size_t)row * DM + q * 256 + lane * 4) = w; }
            else *(f32x4*)(outf + (size_t)row * DM + q * 256 + lane * 4) = o; }
    }
}

template <int CTRL> __device__ __forceinline__ float dpp_f(float v) { return __int_as_float(__builtin_amdgcn_update_dpp(0, __float_as_int(v), CTRL, 0xf, 0xf, false)); }
__device__ __forceinline__ float red8(float v) { v += dpp_f<0xB1>(v); v += dpp_f<0x4E>(v); v += dpp_f<0x141>(v); return v; }
__device__ __forceinline__ float red16(float v) { v = red8(v); v += dpp_f<0x140>(v); return v; }

struct RwRaw { u32x4 cw[2], pw[2], ca[2], pa[2], vl; u32x2 cr[2], pr[2], ck[2], pk[2], cv, pv, vf; };
__device__ __forceinline__ void rw_load(RwRaw& R, const bf16_t* H, const bf16_t* vfp, int l, size_t tok, bool hasp, int h, int chh, int vnt, int fq) {
    const bf16_t* cur = H + tok * LDA_H; const bf16_t* prev = cur - LDA_H;
    const u32x4 z4 = {0u, 0u, 0u, 0u}; const u32x2 z2 = {0u, 0u};
#pragma unroll
    for (int ks = 0; ks < 2; ++ks) { const int m0 = ks * 32 + fq * 8;
        R.cw[ks] = *(const u32x4*)(cur + 3072 + m0); R.ca[ks] = *(const u32x4*)(cur + 3136 + m0);
        R.pw[ks] = hasp ? *(const u32x4*)(prev + 3072 + m0) : z4; R.pa[ks] = hasp ? *(const u32x4*)(prev + 3136 + m0) : z4; }
#pragma unroll
    for (int q = 0; q < 2; ++q) { const int cb = h * 64 + (chh * 2 + q) * 16 + fq * 4;
        R.cr[q] = *(const u32x2*)(cur + cb); R.ck[q] = *(const u32x2*)(cur + 1024 + cb);
        R.pr[q] = hasp ? *(const u32x2*)(prev + cb) : z2; R.pk[q] = hasp ? *(const u32x2*)(prev + 1024 + cb) : z2; }
    const int cbv = h * 64 + vnt * 16 + fq * 4;
    R.cv = *(const u32x2*)(cur + 2048 + cbv); R.pv = hasp ? *(const u32x2*)(prev + 2048 + cbv) : z2;
    R.vf = z2; R.vl = z4;
    if (l > 0) { R.vf = *(const u32x2*)(vfp + tok * DM + cbv); R.vl = *(const u32x4*)(cur + 4224 + fq * 8); }
}

__device__ void phase_rwkv(int l, unsigned char* smem, int mode) {
    const Params p = load_params();
    constexpr int TC = 32, NCH = SEQ / TC, RS = 68  , BUFSZ = 5 * TC * RS + TC * 32 + TC * 2;
    bf16_t* w2T = (bf16_t*)smem;
    bf16_t* a2T = w2T + 64 * 72;
    bf16_t* v2T = a2T + 64 * 72;
    float* cst = (float*)(v2T + 64 * 40);
    float* buf0 = cst + 11 * 64;
    float* ypart = buf0 + 2 * BUFSZ;
    float* sI = ypart + 4 * TC * 64;
    const int tid = opaque_tid(), wid = __builtin_amdgcn_readfirstlane(tid >> 6), lane = tid & 63, fr = lane & 15, fq = lane >> 4;
    for (int item = blockIdx.x; item < NB * 32; item += gridDim.x) {
        const int xc_ = item & 7, sl_ = item >> 3, half = sl_ & 1, pi_ = (sl_ >> 1) * 8 + xc_, b = pi_ >> 4, h = pi_ & 15;
        __syncthreads();
        for (int e = tid; e < 4096; e += 512) { const int m = e >> 6, j = e & 63; w2T[j * 72 + m] = f2bf(p.w_w2[((size_t)l * 64 + m) * DM + h * 64 + j]); a2T[j * 72 + m] = f2bf(p.a_w2[((size_t)l * 64 + m) * DM + h * 64 + j]); }
        if (l > 0) for (int e = tid; e < 2048; e += 512) { const int m = e >> 6, j = e & 63; v2T[j * 40 + m] = f2bf(p.v_w2[((size_t)(l - 1) * 32 + m) * DM + h * 64 + j]); }
        if (tid < 64) { const float* mu = p.mu + (size_t)l * 3200; const int cc = h * 64 + tid;
            cst[tid] = mu[cc]; cst[64 + tid] = mu[1024 + cc]; cst[128 + tid] = mu[2048 + cc]; cst[192 + tid] = p.w0[l * DM + cc]; cst[256 + tid] = p.a0[l * DM + cc];
            cst[320 + tid] = (l > 0) ? p.v0[(l - 1) * DM + cc] : 0.f; cst[384 + tid] = p.k_k[l * DM + cc]; cst[448 + tid] = p.k_a[l * DM + cc]; cst[512 + tid] = p.r_k[l * DM + cc];
            cst[576 + tid] = mu[3072 + tid]; cst[640 + tid] = mu[3136 + tid]; }
        __syncthreads();
        f32x2 st[4];
#pragma unroll
        for (int j = 0; j < 4; ++j) st[j] = (f32x2){0.f, 0.f};
        const int si = tid >> 3, seg = tid & 7;
        const int pwv = wid - 4, tti = pwv & 1, chh = (pwv >> 1) & 1, vnt = half * 2 + chh, tt = tti * 16 + fr;
        RwRaw raw;
        if (wid >= 4) rw_load(raw, p.H, p.vf, l, (size_t)b * SEQ + tt, tt > 0, h, chh, vnt, fq);
        for (int c = -1; c < NCH; ++c) {
            if (wid >= 4 && c + 1 < NCH && !(mode & 2)) {
                float* B_ = buf0 + ((c + 1) & 1) * BUFSZ;
                float* sR = B_; float* sW = sR + TC * RS; float* sK = sW + TC * RS; float* sA = sK + TC * RS; float* sB = sA + TC * RS; float* sV = sB + TC * RS; float* sS = sV + TC * 32;
                const size_t tok = (size_t)b * SEQ + (c + 1) * TC + tt;
                const RwRaw cr_ = raw;
                if (c + 2 < NCH) rw_load(raw, p.H, p.vf, l, tok + TC, true, h, chh, vnt, fq);
                bf16x8 AfW[2], AfA[2];
#pragma unroll
                for (int ks = 0; ks < 2; ++ks) { const int m0 = ks * 32 + fq * 8;
                    const f32x4 mw0 = *(const f32x4*)(cst + 576 + m0), mw1 = *(const f32x4*)(cst + 576 + m0 + 4), ma0 = *(const f32x4*)(cst + 640 + m0), ma1 = *(const f32x4*)(cst + 640 + m0 + 4);
                    const float muw[8] = {mw0[0], mw0[1], mw0[2], mw0[3], mw1[0], mw1[1], mw1[2], mw1[3]}, mua[8] = {ma0[0], ma0[1], ma0[2], ma0[3], ma1[0], ma1[1], ma1[2], ma1[3]};
                    const unsigned cwv[4] = {cr_.cw[ks].x, cr_.cw[ks].y, cr_.cw[ks].z, cr_.cw[ks].w}, pwq[4] = {cr_.pw[ks].x, cr_.pw[ks].y, cr_.pw[ks].z, cr_.pw[ks].w};
                    const unsigned cav[4] = {cr_.ca[ks].x, cr_.ca[ks].y, cr_.ca[ks].z, cr_.ca[ks].w}, pav[4] = {cr_.pa[ks].x, cr_.pa[ks].y, cr_.pa[ks].z, cr_.pa[ks].w};
                    unsigned ow[4], oa[4];
#pragma unroll
                    for (int e = 0; e < 4; ++e) {
                        const float c0 = bflo(cwv[e]), c1 = bfhi(cwv[e]), q0 = bflo(pwq[e]), q1 = bfhi(pwq[e]);
                        ow[e] = cvt_pk_bf16(tanh_fast(c0 + muw[2 * e] * (q0 - c0)), tanh_fast(c1 + muw[2 * e + 1] * (q1 - c1)));
                        const float d0 = bflo(cav[e]), d1 = bfhi(cav[e]), r0 = bflo(pav[e]), r1 = bfhi(pav[e]);
                        oa[e] = cvt_pk_bf16(d0 + mua[2 * e] * (r0 - d0), d1 + mua[2 * e + 1] * (r1 - d1)); }
                    AfW[ks] = __builtin_bit_cast(bf16x8, ((u32x4){ow[0], ow[1], ow[2], ow[3]})); AfA[ks] = __builtin_bit_cast(bf16x8, ((u32x4){oa[0], oa[1], oa[2], oa[3]})); }
                f32x4 accW[2], accA[2], accV = (f32x4){0.f, 0.f, 0.f, 0.f};
#pragma unroll
                for (int q = 0; q < 2; ++q) { const int nt = chh * 2 + q; accW[q] = (f32x4){0.f, 0.f, 0.f, 0.f}; accA[q] = (f32x4){0.f, 0.f, 0.f, 0.f};
#pragma unroll
                    for (int ks = 0; ks < 2; ++ks) { const bf16x8 bw = *(const bf16x8*)(w2T + (nt * 16 + fr) * 72 + ks * 32 + fq * 8), ba = *(const bf16x8*)(a2T + (nt * 16 + fr) * 72 + ks * 32 + fq * 8);
                        accW[q] = __builtin_amdgcn_mfma_f32_16x16x32_bf16(bw, AfW[ks], accW[q], 0, 0, 0); accA[q] = __builtin_amdgcn_mfma_f32_16x16x32_bf16(ba, AfA[ks], accA[q], 0, 0, 0); } }
                if (l > 0) { const bf16x8 bv = *(const bf16x8*)(v2T + (vnt * 16 + fr) * 40 + fq * 8); accV = __builtin_amdgcn_mfma_f32_16x16x32_bf16(bv, __builtin_bit_cast(bf16x8, cr_.vl), accV, 0, 0, 0); }
                float ss = 0.f, rk = 0.f;
#pragma unroll
                for (int q = 0; q < 2; ++q) { const int ch0 = (chh * 2 + q) * 16 + fq * 4;
                    const float fr_[4] = {bflo(cr_.cr[q].x), bfhi(cr_.cr[q].x), bflo(cr_.cr[q].y), bfhi(cr_.cr[q].y)}, fpr[4] = {bflo(cr_.pr[q].x), bfhi(cr_.pr[q].x), bflo(cr_.pr[q].y), bfhi(cr_.pr[q].y)};
                    const float fk_[4] = {bflo(cr_.ck[q].x), bfhi(cr_.ck[q].x), bflo(cr_.ck[q].y), bfhi(cr_.ck[q].y)}, fpk[4] = {bflo(cr_.pk[q].x), bfhi(cr_.pk[q].x), bflo(cr_.pk[q].y), bfhi(cr_.pk[q].y)};
                    const f32x4 mur = *(const f32x4*)(cst + ch0), muk = *(const f32x4*)(cst + 64 + ch0), w0v = *(const f32x4*)(cst + 192 + ch0), a0v = *(const f32x4*)(cst + 256 + ch0),
                        kkv = *(const f32x4*)(cst + 384 + ch0), kav = *(const f32x4*)(cst + 448 + ch0), rkv = *(const f32x4*)(cst + 512 + ch0);
                    f32x4 ro, wo, ko, ao, bo;
#pragma unroll
                    for (int e = 0; e < 4; ++e) {
                        const float r = fr_[e] + mur[e] * (fpr[e] - fr_[e]), k = fk_[e] + muk[e] * (fpk[e] - fk_[e]);
                        wo[e] = __expf(-0.60653065971f * sigmoidf_(w0v[e] + accW[q][e]));
                        const float a = sigmoidf_(a0v[e] + accA[q][e]);
                        const float kq = k * kkv[e]; ss += kq * kq; ao[e] = -kq; bo[e] = kq * a;
                        const float km = k * (1.0f + (a - 1.0f) * kav[e]); rk += r * km * rkv[e]; ro[e] = r; ko[e] = km; }
                    *(f32x4*)(sR + tt * RS + ch0) = ro; *(f32x4*)(sW + tt * RS + ch0) = wo; *(f32x4*)(sK + tt * RS + ch0) = ko; *(f32x4*)(sA + tt * RS + ch0) = ao; *(f32x4*)(sB + tt * RS + ch0) = bo; }
                ss += __shfl_xor(ss, 16); ss += __shfl_xor(ss, 32); rk += __shfl_xor(rk, 16); rk += __shfl_xor(rk, 32);
                if (fq == 0) { sS[tt * 2 + chh] = ss; if (half == 0) p.rkbuf[(size_t)((b * 16 + h) * 2 + chh) * SEQ + (c + 1) * TC + tt] = rk; }
                { const int ch0 = vnt * 16 + fq * 4, cb = h * 64 + ch0;
                  const float fv_[4] = {bflo(cr_.cv.x), bfhi(cr_.cv.x), bflo(cr_.cv.y), bfhi(cr_.cv.y)}, fpv[4] = {bflo(cr_.pv.x), bfhi(cr_.pv.x), bflo(cr_.pv.y), bfhi(cr_.pv.y)};
                  const f32x4 muv = *(const f32x4*)(cst + 128 + ch0), v0v = *(const f32x4*)(cst + 320 + ch0);
                  f32x4 vo;
#pragma unroll
                  for (int e = 0; e < 4; ++e) vo[e] = fv_[e] + muv[e] * (fpv[e] - fv_[e]);
                  if (l > 0) { const float vfv[4] = {bflo(cr_.vf.x), bfhi(cr_.vf.x), bflo(cr_.vf.y), bfhi(cr_.vf.y)};
#pragma unroll
                      for (int e = 0; e < 4; ++e) vo[e] = vo[e] + (vfv[e] - vo[e]) * sigmoidf_(v0v[e] + accV[e]); }
                  u32x2 w; w.x = cvt_pk_bf16(vo[0], vo[1]); w.y = cvt_pk_bf16(vo[2], vo[3]); *(u32x2*)(p.vf + tok * DM + cb) = w;
                  *(f32x4*)(sV + tt * 32 + chh * 16 + fq * 4) = vo; }
            }
            if (wid < 4 && c >= 0 && !(mode & 1)) {
                const float* B_ = buf0 + (c & 1) * BUFSZ;
                const float* sR = B_; const float* sW = sR + TC * RS; const float* sK = sW + TC * RS; const float* sA = sK + TC * RS; const float* sB = sA + TC * RS; const float* sV = sB + TC * RS; const float* sS = sV + TC * 32;
                float* yp = ypart + wid * (TC * 64) + lane; float* sIw = sI + wid * TC;
                if (lane < TC) { const f32x2 ps = *(const f32x2*)(sS + lane * 2); sIw[lane] = __builtin_amdgcn_rcpf(fmaxf(ps.x + ps.y, 1e-24f)); }
                f32x4 A0, A1, W0, W1, B0, B1, K0, K1, R0, R1; float VI, IV;
#define SC_LOAD(s_) do { const int o_ = (s_) * RS + seg * 8; \
                    A0 = *(const f32x4*)(sA + o_); A1 = *(const f32x4*)(sA + o_ + 4); W0 = *(const f32x4*)(sW + o_); W1 = *(const f32x4*)(sW + o_ + 4); \
                    B0 = *(const f32x4*)(sB + o_); B1 = *(const f32x4*)(sB + o_ + 4); K0 = *(const f32x4*)(sK + o_); K1 = *(const f32x4*)(sK + o_ + 4); \
                    R0 = *(const f32x4*)(sR + o_); R1 = *(const f32x4*)(sR + o_ + 4); VI = sV[(s_) * 32 + si]; IV = sIw[(s_)]; } while (0)
                SC_LOAD(0);
#pragma unroll 4
                for (int s = 0; s < TC; ++s) {
                    const f32x4 a0 = A0, a1 = A1, w0 = W0, w1 = W1, b0 = B0, b1 = B1, k0 = K0, k1 = K1, r0 = R0, r1 = R1; const float vi = VI, inv2 = IV;
                    if (s + 1 < TC) SC_LOAD(s + 1);
                    __builtin_amdgcn_sched_barrier(0);
                    const f32x2 av[4] = {{a0[0], a0[1]}, {a0[2], a0[3]}, {a1[0], a1[1]}, {a1[2], a1[3]}}, wv[4] = {{w0[0], w0[1]}, {w0[2], w0[3]}, {w1[0], w1[1]}, {w1[2], w1[3]}};
                    const f32x2 bv[4] = {{b0[0], b0[1]}, {b0[2], b0[3]}, {b1[0], b1[1]}, {b1[2], b1[3]}}, kv[4] = {{k0[0], k0[1]}, {k0[2], k0[3]}, {k1[0], k1[1]}, {k1[2], k1[3]}};
                    const f32x2 rv[4] = {{r0[0], r0[1]}, {r0[2], r0[3]}, {r1[0], r1[1]}, {r1[2], r1[3]}};
                    const f32x2 vi2 = {vi, vi};
                    f32x2 vk[4];
#pragma unroll
                    for (int j = 0; j < 4; ++j) vk[j] = vi2 * kv[j];
                    const f32x2 pa = st[0] * av[0] + st[1] * av[1], pb = st[2] * av[2] + st[3] * av[3]; const f32x2 pc = pa + pb;
                    const float sa = red8(pc.x + pc.y) * inv2;
                    const f32x2 sa2 = {sa, sa};
#pragma unroll
                    for (int j = 0; j < 4; ++j) st[j] = st[j] * wv[j] + (sa2 * bv[j] + vk[j]);
                    const f32x2 qa = st[0] * rv[0] + st[1] * rv[1], qb = st[2] * rv[2] + st[3] * rv[3]; const f32x2 qc = qa + qb;
                    yp[s * 64] = qc.x + qc.y;
                }
#undef SC_LOAD
                { const int tk = lane >> 1, rq = (lane & 1) * 4; const float* yr = ypart + wid * (TC * 64) + tk * 64 + rq * 8; float yv[4];
#pragma unroll
                  for (int r_ = 0; r_ < 4; ++r_) { const f32x4 u0 = *(const f32x4*)(yr + r_ * 8), u1 = *(const f32x4*)(yr + r_ * 8 + 4); yv[r_] = ((u0[0] + u0[1]) + (u0[2] + u0[3])) + ((u1[0] + u1[1]) + (u1[2] + u1[3])); }
                  u32x2 w; w.x = cvt_pk_bf16(yv[0], yv[1]); w.y = cvt_pk_bf16(yv[2], yv[3]);
                  *(u32x2*)(p.y + ((size_t)b * SEQ + c * TC + tk) * DM + h * 64 + half * 32 + wid * 8 + rq) = w; }
            }
            __syncthreads();
        }
    }
    __syncthreads();
}

__device__ void phase_rwkv_post(int l, bf16_t* oalt) {
    const Params p = load_params();
    const int tid = opaque_tid(), l8 = tid & 7;
    const int ngrp = T_TOK * 16;
    for (int g = blockIdx.x * 64 + (tid >> 3); g < ngrp; g += gridDim.x * 64) {
        const int tok = g >> 4, h = g & 15, cb = h * 64 + l8 * 8;
        const u32x4 y4 = *(const u32x4*)(p.y + (size_t)tok * DM + cb), b4 = *(const u32x4*)(p.vf + (size_t)tok * DM + cb);
        const int bb = tok / SEQ, tq = tok % SEQ; const float rk = p.rkbuf[(size_t)((bb * 16 + h) * 2) * SEQ + tq] + p.rkbuf[(size_t)((bb * 16 + h) * 2 + 1) * SEQ + tq];
        bf16_t* zp = p.H + (size_t)tok * LDA_H + 3200 + cb; const u32x4 z4 = *(const u32x4*)zp;
        const float yv[8] = {bflo(y4.x), bfhi(y4.x), bflo(y4.y), bfhi(y4.y), bflo(y4.z), bfhi(y4.z), bflo(y4.w), bfhi(y4.w)};
        const float bv[8] = {bflo(b4.x), bfhi(b4.x), bflo(b4.y), bfhi(b4.y), bflo(b4.z), bfhi(b4.z), bflo(b4.w), bfhi(b4.w)};
        const float zv[8] = {bflo(z4.x), bfhi(z4.x), bflo(z4.y), bfhi(z4.y), bflo(z4.z), bfhi(z4.z), bflo(z4.w), bfhi(z4.w)};
        float sm = 0.f;
#pragma unroll
        for (int e = 0; e < 8; ++e) sm += yv[e];
        sm = red8(sm); const float mean = sm * (1.0f / 64.f); float d[8], vs = 0.f;
#pragma unroll
        for (int e = 0; e < 8; ++e) { d[e] = yv[e] - mean; vs += d[e] * d[e]; }
        vs = red8(vs); const float rstd = rsqrtf(vs * (1.0f / 64.f) + GN_EPS);
        const f32x4 g0 = *(const f32x4*)(p.lnx_g + l * DM + cb), g1 = *(const f32x4*)(p.lnx_g + l * DM + cb + 4), c0 = *(const f32x4*)(p.lnx_b + l * DM + cb), c1 = *(const f32x4*)(p.lnx_b + l * DM + cb + 4);
        const float gg[8] = {g0[0], g0[1], g0[2], g0[3], g1[0], g1[1], g1[2], g1[3]}, cc[8] = {c0[0], c0[1], c0[2], c0[3], c1[0], c1[1], c1[2], c1[3]};
        float o[8];
#pragma unroll
        for (int e = 0; e < 8; ++e) o[e] = (d[e] * rstd * gg[e] + cc[e] + rk * bv[e]) * siluf_(zv[e]);
        u32x4 w; w.x = cvt_pk_bf16(o[0], o[1]); w.y = cvt_pk_bf16(o[2], o[3]); w.z = cvt_pk_bf16(o[4], o[5]); w.w = cvt_pk_bf16(o[6], o[7]);
        *(u32x4*)(oalt ? oalt + (size_t)tok * DM + cb : zp) = w;
    }
}

__device__ void phase_sgu(int l, unsigned char* smem, bf16_t* oalt) {
    const Params p = load_params();
    bf16_t* vnT = (bf16_t*)smem;
    float* stat = (float*)(smem + 128 * 136 * 2);
    const int tid = opaque_tid(), wid = tid >> 6, lane = tid & 63, fr = lane & 15, fq = lane >> 4;
    const float* lng = p.sgu_ln_g + (size_t)l * DM; const float* lnb = p.sgu_ln_b + (size_t)l * DM;
    for (int item = blockIdx.x; item < T_TOK / 128; item += gridDim.x) {
        bf16_t* Hb = p.H + (size_t)item * 128 * LDB_H;
        __syncthreads();
        for (int q = 0; q < 16; ++q) { const int s = wid * 16 + q; const bf16_t* vr = Hb + (size_t)s * LDB_H + 1024 + lane * 16;
            const u32x4 a = *(const u32x4*)vr, bq = *(const u32x4*)(vr + 8);
            const float f[16] = {bflo(a.x), bfhi(a.x), bflo(a.y), bfhi(a.y), bflo(a.z), bfhi(a.z), bflo(a.w), bfhi(a.w), bflo(bq.x), bfhi(bq.x), bflo(bq.y), bfhi(bq.y), bflo(bq.z), bfhi(bq.z), bflo(bq.w), bfhi(bq.w)};
            float sm = 0.f;
#pragma unroll
            for (int e = 0; e < 16; ++e) sm += f[e];
#pragma unroll
            for (int o = 32; o > 0; o >>= 1) sm += __shfl_xor(sm, o);
            const float mean = sm * (1.0f / DM); float vs = 0.f;
#pragma unroll
            for (int e = 0; e < 16; ++e) { const float d = f[e] - mean; vs += d * d; }
#pragma unroll
            for (int o = 32; o > 0; o >>= 1) vs += __shfl_xor(vs, o);
            if (lane == 0) { stat[s * 2] = mean; stat[s * 2 + 1] = rsqrtf(vs * (1.0f / DM) + EPS); } }
        __syncthreads();
        for (int g = 0; g < 8; ++g) {
            { const int s = tid >> 2, c0 = (tid & 3) * 32; const float mean = stat[s * 2], rstd = stat[s * 2 + 1];
              const bf16_t* vr = Hb + (size_t)s * LDB_H + 1024 + g * 128 + c0;
#pragma unroll
              for (int q = 0; q < 4; ++q) { const u32x4 a = *(const u32x4*)(vr + q * 8); const float f[8] = {bflo(a.x), bfhi(a.x), bflo(a.y), bfhi(a.y), bflo(a.z), bfhi(a.z), bflo(a.w), bfhi(a.w)};
#pragma unroll
                  for (int e = 0; e < 8; ++e) { const int c = c0 + q * 8 + e; const float vn = (f[e] - mean) * rstd * lng[g * 128 + c] + lnb[g * 128 + c]; vnT[c * 136 + s] = f2bf(vn); } } }
            __syncthreads();
            f32x4 acc[8];
#pragma unroll
            for (int i = 0; i < 8; ++i) acc[i] = (f32x4){0.f, 0.f, 0.f, 0.f};
            const int trow = wid * 16 + fr;
            const float* Wg = p.sgu_w + (((size_t)l * 8 + g) * 128 + trow) * 128;
            const int nks = (wid < 4) ? 2 : 4;
            for (int ks = 0; ks < nks; ++ks) {
                const f32x4 wa = *(const f32x4*)(Wg + ks * 32 + fq * 8), wb = *(const f32x4*)(Wg + ks * 32 + fq * 8 + 4);
                u32x4 wp; wp.x = cvt_pk_bf16(wa[0], wa[1]); wp.y = cvt_pk_bf16(wa[2], wa[3]); wp.z = cvt_pk_bf16(wb[0], wb[1]); wp.w = cvt_pk_bf16(wb[2], wb[3]);
                const bf16x8 wfrag = __builtin_bit_cast(bf16x8, wp);
#pragma unroll
                for (int ct = 0; ct < 8; ++ct) { const bf16x8 vfrag = *(const bf16x8*)(vnT + (ct * 16 + fr) * 136 + ks * 32 + fq * 8);
                    acc[ct] = __builtin_amdgcn_mfma_f32_16x16x32_bf16(vfrag, wfrag, acc[ct], 0, 0, 0); }
            }
            { const float bs = p.sgu_b[((size_t)l * 8 + g) * 128 + trow]; bf16_t* hr = Hb + (size_t)trow * LDB_H;
#pragma unroll
              for (int ct = 0; ct < 8; ++ct) { const int c = g * 128 + ct * 16 + fq * 4;
                  const u32x2 u2 = *(const u32x2*)(hr + c), z2 = *(const u32x2*)(hr + 2048 + c);
                  const float uf[4] = {bflo(u2.x), bfhi(u2.x), bflo(u2.y), bfhi(u2.y)}, zf[4] = {bflo(z2.x), bfhi(z2.x), bflo(z2.y), bfhi(z2.y)};
                  float o[4];
#pragma unroll
                  for (int j = 0; j < 4; ++j) o[j] = uf[j] * (acc[ct][j] + bs) * siluf_(zf[j]);
                  u32x2 w; w.x = cvt_pk_bf16(o[0], o[1]); w.y = cvt_pk_bf16(o[2], o[3]); *(u32x2*)(oalt ? oalt + ((size_t)item * 128 + trow) * DM + c : hr + 2048 + c) = w; } }
            __syncthreads();
        }
    }
    __syncthreads();
}

__device__ void phase_hgrn_pre(int l, unsigned char* smem, bool dry) {
    const Params p = load_params();
    float* LF = (float*)smem;
    bf16_t* IB = (bf16_t*)(LF + 64 * 132);
    bf16_t* KB = IB + 64 * 136;
    float* psum = (float*)(KB + 64 * 136);
    float* lbs = psum + 512;
    const int tid = opaque_tid();
    bf16_t* xtra = (l == 0) ? (bf16_t*)p.out : p.vf;
    __syncthreads();
    for (int e = tid; e < DM; e += 512) { float lb = 0.f; if (l == 1) { const float l0 = p.lb_logits[e], l1 = p.lb_logits[DM + e]; lb = __builtin_amdgcn_rcpf(1.0f + __expf(l0 - l1)); } lbs[e] = lb; }
    __syncthreads();
    const int t = tid >> 3, c0 = (tid & 7) * 16;
    const int cc = tid & 127, tq = tid >> 7;
    for (int item = blockIdx.x; item < NB * 64 * 8; item += gridDim.x) {
        const int h = item & 7, ch = (item >> 3) & 63, b = item >> 9;
        const size_t r0 = (size_t)b * SEQ + ch * 64;
        bf16_t* hr = p.H + (r0 + t) * LDC_H + h * 128 + c0;
        float qv[16], kv[16];
        {
            const u32x4 q0 = *(const u32x4*)hr, q1 = *(const u32x4*)(hr + 8), f0 = *(const u32x4*)(hr + 1024), f1 = *(const u32x4*)(hr + 1032), i0 = *(const u32x4*)(hr + 2048), i1 = *(const u32x4*)(hr + 2056);
            const unsigned qa[8] = {q0.x, q0.y, q0.z, q0.w, q1.x, q1.y, q1.z, q1.w}, fa[8] = {f0.x, f0.y, f0.z, f0.w, f1.x, f1.y, f1.z, f1.w};
            *(u32x4*)(IB + t * 136 + c0) = i0; *(u32x4*)(IB + t * 136 + c0 + 8) = i1;
            float lf[16];
#pragma unroll
            for (int e = 0; e < 8; ++e) {
                const float lb0 = lbs[h * 128 + c0 + 2 * e], lb1 = lbs[h * 128 + c0 + 2 * e + 1];
                qv[2 * e] = siluf_(bflo(qa[e])); qv[2 * e + 1] = siluf_(bfhi(qa[e]));
                const float g0 = lb0 + (1.0f - lb0) * sigmoidf_(bflo(fa[e])), g1 = lb1 + (1.0f - lb1) * sigmoidf_(bfhi(fa[e]));
                kv[2 * e] = 1.0f - g0; kv[2 * e + 1] = 1.0f - g1; lf[2 * e] = __logf(g0); lf[2 * e + 1] = __logf(g1); }
#pragma unroll
            for (int e = 0; e < 4; ++e) *(f32x4*)(LF + t * 132 + c0 + e * 4) = (f32x4){lf[e * 4], lf[e * 4 + 1], lf[e * 4 + 2], lf[e * 4 + 3]};
        }
        __syncthreads();
        { float run = 0.f;
#pragma unroll
          for (int e = 0; e < 16; ++e) { run += LF[(tq * 16 + e) * 132 + cc]; LF[(tq * 16 + e) * 132 + cc] = run; }
          psum[tq * 128 + cc] = run; }
        __syncthreads();
        {
            const int tqt = t >> 4;
            unsigned qo[8], ko[8];
#pragma unroll
            for (int e4 = 0; e4 < 4; ++e4) {
                const f32x4 p0 = *(const f32x4*)(psum + c0 + e4 * 4), p1 = *(const f32x4*)(psum + 128 + c0 + e4 * 4), p2 = *(const f32x4*)(psum + 256 + c0 + e4 * 4), p3 = *(const f32x4*)(psum + 384 + c0 + e4 * 4);
                const f32x4 bl = *(const f32x4*)(LF + t * 132 + c0 + e4 * 4);
                float q2[4], k2[4];
#pragma unroll
                for (int j = 0; j < 4; ++j) {
                    const float off = (tqt > 0 ? p0[j] : 0.f) + (tqt > 1 ? p1[j] : 0.f) + (tqt > 2 ? p2[j] : 0.f);
                    const float bmid = p0[j] + p1[j], bb = bl[j] + off;
                    q2[j] = qv[e4 * 4 + j] * __expf(bb - bmid); k2[j] = kv[e4 * 4 + j] * __expf(bmid - bb); }
                qo[e4 * 2] = cvt_pk_bf16(q2[0], q2[1]); qo[e4 * 2 + 1] = cvt_pk_bf16(q2[2], q2[3]); ko[e4 * 2] = cvt_pk_bf16(k2[0], k2[1]); ko[e4 * 2 + 1] = cvt_pk_bf16(k2[2], k2[3]);
                if (t == 0) { f32x4 e1, e3;
#pragma unroll
                    for (int j = 0; j < 4; ++j) { e1[j] = __expf(p0[j] + p1[j]); e3[j] = __expf(p2[j] + p3[j]); }
                    float* gs = p.rkbuf + (size_t)(((b * 64 + ch) * 8 + h)) * 256 + c0 + e4 * 4; *(f32x4*)gs = e1; *(f32x4*)(gs + 128) = e3; }
            }
            const u32x4 qw0 = {qo[0], qo[1], qo[2], qo[3]}, qw1 = {qo[4], qo[5], qo[6], qo[7]}, kw0 = {ko[0], ko[1], ko[2], ko[3]}, kw1 = {ko[4], ko[5], ko[6], ko[7]};
            if (!dry) { *(u32x4*)hr = qw0; *(u32x4*)(hr + 8) = qw1; *(u32x4*)(hr + 1024) = kw0; *(u32x4*)(hr + 1032) = kw1; }
            *(u32x4*)(KB + t * 136 + c0) = kw0; *(u32x4*)(KB + t * 136 + c0 + 8) = kw1;
        }
        __syncthreads();
        {
            unsigned iw[8], kw[8];
#pragma unroll
            for (int e = 0; e < 8; ++e) {
                iw[e] = (unsigned)IB[(tq * 16 + 2 * e) * 136 + cc] | ((unsigned)IB[(tq * 16 + 2 * e + 1) * 136 + cc] << 16);
                kw[e] = (unsigned)KB[(tq * 16 + 2 * e) * 136 + cc] | ((unsigned)KB[(tq * 16 + 2 * e + 1) * 136 + cc] << 16); }
            bf16_t* ir = p.H + (r0 + (cc >> 1)) * LDC_H + 2048 + h * 128 + (cc & 1) * 64 + tq * 16;
            if (!dry) { *(u32x4*)ir = (u32x4){iw[0], iw[1], iw[2], iw[3]}; *(u32x4*)(ir + 8) = (u32x4){iw[4], iw[5], iw[6], iw[7]}; }
            bf16_t* kr = xtra + (r0 + (cc >> 1)) * DM + h * 128 + (cc & 1) * 64 + tq * 16;
            *(u32x4*)kr = (u32x4){kw[0], kw[1], kw[2], kw[3]}; *(u32x4*)(kr + 8) = (u32x4){kw[4], kw[5], kw[6], kw[7]};
        }
        __syncthreads();
    }
}

struct HgRaw { u32x4 qm[4], km[2][4], it[2][2], kt[2]; f32x4 e1, e3; };
__device__ __forceinline__ void hg_load(HgRaw& R, const bf16_t* H, const bf16_t* xtra, const float* gsc, size_t r0, int b, int ch, int h, int vs, int w, int fr, int fq) {
    const int tt_ = w >> 1, sp = w & 1;
#pragma unroll
    for (int ks = 0; ks < 4; ++ks) R.qm[ks] = *(const u32x4*)(H + (r0 + tt_ * 16 + fr) * LDC_H + h * 128 + ks * 32 + fq * 8);
#pragma unroll
    for (int q = 0; q < 2; ++q)
#pragma unroll
        for (int ks = 0; ks < 4; ++ks) R.km[q][ks] = *(const u32x4*)(H + (r0 + (sp * 2 + q) * 16 + fr) * LDC_H + 1024 + h * 128 + ks * 32 + fq * 8);
#pragma unroll
    for (int vt = 0; vt < 2; ++vt) { const int v = vs * 32 + vt * 16 + fr;
#pragma unroll
        for (int ks = 0; ks < 2; ++ks) R.it[vt][ks] = *(const u32x4*)(H + (r0 + (v >> 1)) * LDC_H + 2048 + h * 128 + (v & 1) * 64 + ks * 32 + fq * 8); }
    { const int k = w * 16 + fr;
#pragma unroll
      for (int ks = 0; ks < 2; ++ks) R.kt[ks] = *(const u32x4*)(xtra + (r0 + (k >> 1)) * DM + h * 128 + (k & 1) * 64 + ks * 32 + fq * 8); }
    const float* gs = gsc + (size_t)(((b * 64 + ch) * 8 + h)) * 256 + w * 16 + fq * 4;
    R.e1 = *(const f32x4*)gs; R.e3 = *(const f32x4*)(gs + 128);
}

__device__ void phase_hgrn_seq(int l, unsigned char* smem, bool dry) {
    const Params p = load_params();
    bf16_t* att = (bf16_t*)smem;
    bf16_t* STs = att + 64 * 72;
    const int tid = opaque_tid(), w = __builtin_amdgcn_readfirstlane(tid >> 6), lane = tid & 63, fr = lane & 15, fq = lane >> 4;
    const bf16_t* xtra = (l == 0) ? (const bf16_t*)p.out : p.vf;
    const int tt_ = w >> 1, sp = w & 1;
    for (int item = blockIdx.x; item < NB * 32; item += gridDim.x) {
        const int xc_ = item & 7, sl_ = item >> 3, vs = sl_ & 3, gi_ = (sl_ >> 2) * 8 + xc_, h = gi_ & 7, b = gi_ >> 3;
        __syncthreads();
        for (int e = tid; e < 32 * 136 / 2; e += 512) ((unsigned*)STs)[e] = 0u;
        f32x4 S[2] = {{0.f, 0.f, 0.f, 0.f}, {0.f, 0.f, 0.f, 0.f}};
        u32x2 o0 = {0u, 0u};
        HgRaw raw; hg_load(raw, p.H, xtra, p.rkbuf, (size_t)b * SEQ, b, 0, h, vs, w, fr, fq);
        __syncthreads();
        for (int ch = 0; ch < 64; ++ch) {
            const size_t r0 = (size_t)b * SEQ + ch * 64;
            const HgRaw cr = raw;
            if (ch + 1 < 64) hg_load(raw, p.H, xtra, p.rkbuf, r0 + 64, b, ch + 1, h, vs, w, fr, fq);
#pragma unroll
            for (int q = 0; q < 2; ++q) { const int stile = sp * 2 + q; f32x4 a = {0.f, 0.f, 0.f, 0.f};
                if (stile <= tt_) {
#pragma unroll
                    for (int ks = 0; ks < 4; ++ks) a = __builtin_amdgcn_mfma_f32_16x16x32_bf16(__builtin_bit_cast(bf16x8, cr.qm[ks]), __builtin_bit_cast(bf16x8, cr.km[q][ks]), a, 0, 0, 0); }
#pragma unroll
                for (int j = 0; j < 4; ++j) { const int t = tt_ * 16 + fq * 4 + j, s = stile * 16 + fr; att[t * 72 + s] = f2bf(s <= t ? a[j] : 0.f); } }
            __syncthreads();
            f32x4 o = {0.f, 0.f, 0.f, 0.f};
#pragma unroll
            for (int ks = 0; ks < 2; ++ks) { const bf16x8 af = *(const bf16x8*)(att + (tt_ * 16 + fr) * 72 + ks * 32 + fq * 8);
                o = __builtin_amdgcn_mfma_f32_16x16x32_bf16(__builtin_bit_cast(bf16x8, sp ? cr.it[1][ks] : cr.it[0][ks]), af, o, 0, 0, 0); }
#pragma unroll
            for (int ks = 0; ks < 4; ++ks) { const bf16x8 sf = *(const bf16x8*)(STs + (sp * 16 + fr) * 136 + ks * 32 + fq * 8);
                o = __builtin_amdgcn_mfma_f32_16x16x32_bf16(sf, __builtin_bit_cast(bf16x8, cr.qm[ks]), o, 0, 0, 0); }
            { u32x2 ow; ow.x = cvt_pk_bf16(o[0], o[1]); ow.y = cvt_pk_bf16(o[2], o[3]);
              if (ch == 0) o0 = ow;
              else if (!dry) { const int t = tt_ * 16 + fr; *(u32x2*)(p.H + (r0 - 64 + vs * 16 + (t >> 2)) * LDC_H + 2048 + h * 128 + (t & 3) * 32 + sp * 16 + fq * 4) = ow; } }
#pragma unroll
            for (int vt = 0; vt < 2; ++vt) { f32x4 u = {0.f, 0.f, 0.f, 0.f};
#pragma unroll
                for (int ks = 0; ks < 2; ++ks) u = __builtin_amdgcn_mfma_f32_16x16x32_bf16(__builtin_bit_cast(bf16x8, cr.kt[ks]), __builtin_bit_cast(bf16x8, cr.it[vt][ks]), u, 0, 0, 0);
#pragma unroll
                for (int j = 0; j < 4; ++j) S[vt][j] = cr.e3[j] * (cr.e1[j] * S[vt][j] + u[j]); }
            __syncthreads();
            if (ch + 1 < 64) {
#pragma unroll
                for (int vt = 0; vt < 2; ++vt) { u32x2 sw; sw.x = cvt_pk_bf16(S[vt][0] * raw.e1[0], S[vt][1] * raw.e1[1]); sw.y = cvt_pk_bf16(S[vt][2] * raw.e1[2], S[vt][3] * raw.e1[3]);
                    *(u32x2*)(STs + (vt * 16 + fr) * 136 + w * 16 + fq * 4) = sw; } }
        }
        if (!dry) { const int t = tt_ * 16 + fr; *(u32x2*)(p.H + ((size_t)b * SEQ + 63 * 64 + vs * 16 + (t >> 2)) * LDC_H + 2048 + h * 128 + (t & 3) * 32 + sp * 16 + fq * 4) = o0; }
    }
    __syncthreads();
}

__device__ void phase_hgrn_post(int l) {
    const Params p = load_params();
    const int tid = opaque_tid(), l8 = tid & 7;
    const int ngrp = T_TOK * 8;
    for (int g = blockIdx.x * 64 + (tid >> 3); g < ngrp; g += gridDim.x * 64) {
        const int tok = g >> 3, h = g & 7, b = tok / SEQ, tin = tok % SEQ, ch = tin >> 6, t = tin & 63, slot = (ch + 63) & 63, vs = l8 >> 1, vv0 = (l8 & 1) * 16;
        const bf16_t* op = p.H + ((size_t)b * SEQ + slot * 64 + vs * 16 + (t >> 2)) * LDC_H + 2048 + h * 128 + (t & 3) * 32 + vv0;
        bf16_t* zp = p.H + (size_t)tok * LDC_H + 3072 + h * 128 + l8 * 16;
        const u32x4 a0 = *(const u32x4*)op, a1 = *(const u32x4*)(op + 8), z0 = *(const u32x4*)zp, z1 = *(const u32x4*)(zp + 8);
        const float ov[16] = {bflo(a0.x), bfhi(a0.x), bflo(a0.y), bfhi(a0.y), bflo(a0.z), bfhi(a0.z), bflo(a0.w), bfhi(a0.w), bflo(a1.x), bfhi(a1.x), bflo(a1.y), bfhi(a1.y), bflo(a1.z), bfhi(a1.z), bflo(a1.w), bfhi(a1.w)};
        const float zf[16] = {bflo(z0.x), bfhi(z0.x), bflo(z0.y), bfhi(z0.y), bflo(z0.z), bfhi(z0.z), bflo(z0.w), bfhi(z0.w), bflo(z1.x), bfhi(z1.x), bflo(z1.y), bfhi(z1.y), bflo(z1.z), bfhi(z1.z), bflo(z1.w), bfhi(z1.w)};
        float ss = 0.f;
#pragma unroll
        for (int e = 0; e < 16; ++e) ss += ov[e] * ov[e];
        ss = red8(ss); const float rinv = rsqrtf(ss * (1.0f / 128.f) + EPS);
        const float* gn = p.hgrn_g + (size_t)l * DM + h * 128 + l8 * 16;
        float r[16];
#pragma unroll
        for (int e = 0; e < 16; ++e) r[e] = ov[e] * rinv * gn[e] * siluf_(zf[e]);
        u32x4 w0, w1; w0.x = cvt_pk_bf16(r[0], r[1]); w0.y = cvt_pk_bf16(r[2], r[3]); w0.z = cvt_pk_bf16(r[4], r[5]); w0.w = cvt_pk_bf16(r[6], r[7]);
        w1.x = cvt_pk_bf16(r[8], r[9]); w1.y = cvt_pk_bf16(r[10], r[11]); w1.z = cvt_pk_bf16(r[12], r[13]); w1.w = cvt_pk_bf16(r[14], r[15]);
        *(u32x4*)zp = w0; *(u32x4*)(zp + 8) = w1;
    }
}


#define XB_TMO      128
#define XB_XCNT(j)  (256  + 64 * (j))
#define XB_XSUB(j)  (1280 + 64 * (j))
#define XB_XGEN(j)  (2304 + 64 * (j))
#define XB_TOP      3328
#define XB_TOPGEN   3392
#define XCD_BAR_WORDS 3456
#define XB_SPIN_CAP (1u << 18)
__device__ __forceinline__ unsigned xb_ld(unsigned* p)              { return __hip_atomic_load(p, __ATOMIC_RELAXED, __HIP_MEMORY_SCOPE_AGENT); }
__device__ __forceinline__ unsigned xb_add(unsigned* p, unsigned v) { return __hip_atomic_fetch_add(p, v, __ATOMIC_RELAXED, __HIP_MEMORY_SCOPE_AGENT); }
__device__ __forceinline__ unsigned xb_xcc_id() { return (unsigned)__builtin_amdgcn_s_getreg((3 << 11) | 20) & 0xFu; }
#define XB_SPIN(cond, bar) do { unsigned _sp = 0; while (cond) { __builtin_amdgcn_s_sleep(1); \
    if ((++_sp & 255u) == 0u) { if (xb_ld(&(bar)[XB_TMO])) break; if (_sp > XB_SPIN_CAP) { atomicAdd(&(bar)[XB_TMO], 1u); break; } } } } while (0)
struct XcdBarrier { unsigned* bar; unsigned x; volatile LAS unsigned* st; };
__device__ __forceinline__ XcdBarrier xcd_barrier_post(unsigned* bar, volatile LAS unsigned* st) {
    XcdBarrier b; b.bar = bar; b.x = xb_xcc_id(); b.st = st;
    if (threadIdx.x == 0) (void)xb_add(&bar[XB_XCNT(b.x)], 1u);
    return b;
}
__device__ __forceinline__ void xcd_barrier_complete(unsigned* bar, unsigned x, unsigned& nloc, unsigned& nx) {
    const unsigned G = gridDim.x * gridDim.y * gridDim.z;
    unsigned sum, cnt, mine, sp = 0u;
    for (;;) {
        sum = 0u; cnt = 0u; mine = 0u;
#pragma unroll
        for (unsigned j = 0; j < 16; ++j) { const unsigned c = xb_ld(&bar[XB_XCNT(j)]); sum += c; cnt += (c > 0u) ? 1u : 0u; mine = (j == x) ? c : mine; }
        if (sum == G) break;
        __builtin_amdgcn_s_sleep(1);
        if ((++sp & 255u) == 0u) { if (xb_ld(&bar[XB_TMO])) break; if (sp > XB_SPIN_CAP) { atomicAdd(&bar[XB_TMO], 1u); break; } }
    }
    nloc = mine > 0u ? mine : 1u; nx = cnt > 0u ? cnt : 1u;
}
__device__ __forceinline__ void xcd_barrier(const XcdBarrier& b) {
    asm volatile("s_waitcnt vmcnt(0)" ::: "memory");
    __syncthreads();
    if (threadIdx.x == 0) {
        unsigned* bar = b.bar;
        __builtin_amdgcn_s_waitcnt(0);
        unsigned nloc = b.st[0], nx = b.st[1];
        if (nloc == 0u) { xcd_barrier_complete(bar, b.x, nloc, nx); b.st[0] = nloc; b.st[1] = nx; }
        const unsigned old = xb_add(&bar[XB_XSUB(b.x)], 1u);
        const unsigned gen = old / nloc;
        if (old + 1u == (gen + 1u) * nloc) {
            __builtin_amdgcn_fence(__ATOMIC_RELEASE, "agent");
            asm volatile("s_waitcnt vmcnt(0)" ::: "memory");
            const unsigned og = xb_add(&bar[XB_TOP], 1u);
            const unsigned tg = og / nx;
            if (og + 1u == (tg + 1u) * nx) xb_add(&bar[XB_TOPGEN], 1u);
            else XB_SPIN(xb_ld(&bar[XB_TOPGEN]) == tg, bar);
            __builtin_amdgcn_fence(__ATOMIC_ACQUIRE, "agent");
            xb_add(&bar[XB_XGEN(b.x)], 1u);
            asm volatile("s_waitcnt vmcnt(0)" ::: "memory");
        } else {
            XB_SPIN(xb_ld(&bar[XB_XGEN(b.x)]) == gen, bar);
            __builtin_amdgcn_fence(__ATOMIC_ACQUIRE, "agent");
            asm volatile("s_waitcnt vmcnt(0)" ::: "memory");
        }
    }
    __syncthreads();
}

constexpr int PH_PER_LAYER = 14, N_PHASES = 2 * PH_PER_LAYER + 1;

__global__ void __launch_bounds__(512, 2) fwd_megakernel(Params pk) {
    extern __shared__ __attribute__((aligned(16))) unsigned char shm[];
    LAS unsigned char* lds = (LAS unsigned char*)shm;
    cg::grid_group grid = cg::this_grid();
    const int phase_lo = pk.phase_lo, phase_hi = pk.phase_hi;
    volatile LAS unsigned* xst = (volatile LAS unsigned*)(lds + LDS_BYTES - 16);
    XcdBarrier xb; xb.bar = pk.bar; xb.x = 0; xb.st = xst;
    if (phase_hi - phase_lo > 1) { if (threadIdx.x == 0) { xst[0] = 0u; xst[1] = 0u; } __syncthreads(); xb = xcd_barrier_post(pk.bar, xst); }
    for (int ph = phase_lo; ph < phase_hi; ++ph) {
        const int l = ph / PH_PER_LAYER, q = ph % PH_PER_LAYER;
        if (ph == N_PHASES - 1) {
            const Params p = load_params();
            phase_rmsnorm(p.out, p.final_g, nullptr, p.out);
        } else if (q == 0) {
            { const int nrep = (PROBE_Q == 0 && l == 0) ? 2 : 1; for (int rep = 0; rep < nrep; ++rep) {
            phase_convert(l, shm);
            const Params p = load_params();
            phase_rmsnorm(l == 0 ? p.x : p.out, p.norm_g + (size_t)l * DM, p.xn, nullptr); } }
        } else if (q == 1 || q == 5 || q == 8) {
            const Params p = load_params(); const int G = gridDim.x, cidx = opaque_bid();
            const int N = (q == 1) ? LDA_H : (q == 5) ? LDB_H : LDC_H; const int r0 = (q == 1) ? 0 : (q == 5) ? LDA_H : (LDA_H + LDB_H);
            pg8::GemmDesc g; g.A = p.xn; g.Bt = p.Wt + (size_t)r0 * DM; g.lda = DM;
            pg8::Sched S; S.init(T_TOK, N, G, cidx, 1);
            pg8::EpiStore E; E.O = p.H; E.ldc = N;
{ const int nrep = ((PROBE_Q == 1 && l == 0 && q == 1) || (PROBE_Q == 50 && l == 0 && q == 5) || (PROBE_Q == 80 && l == 0 && q == 8)) ? 2 : 1; for (int rep = 0; rep < nrep; ++rep) pg8::gemm_phase(lds, g, g, S, E); }
        } else if (q == 2) {
{ const int nrep = (PROBE_Q == 2 && l == 0) ? 2 : 1; for (int rep = 0; rep < nrep; ++rep) phase_rwkv(l, shm, rep + 1 < nrep ? PROBE_MODE : 0); }
        } else if (q == 3) {
            phase_rwkv_post(l, nullptr);
        } else if (q == 6) {
{ const int nrep = (PROBE_Q == 6 && l == 0) ? 2 : 1; for (int rep = 0; rep < nrep; ++rep) { const Params p = load_params(); phase_sgu(l, shm, rep + 1 < nrep ? (bf16_t*)p.out : nullptr); } }
        } else if (q == 9) {
            { const int nrep = (PROBE_Q == 9 && l == 0) ? 2 : 1; for (int rep = 0; rep < nrep; ++rep) phase_hgrn_pre(l, shm, rep + 1 < nrep); }
        } else if (q == 10) {
            { const int nrep = (PROBE_Q == 10 && l == 0) ? 2 : 1; for (int rep = 0; rep < nrep; ++rep) phase_hgrn_seq(l, shm, rep + 1 < nrep); }
        } else if (q == 11) {
            phase_hgrn_post(l);
        } else if (q == 4 || q == 7 || q == 12) {
            const Params p = load_params(); const int G = gridDim.x, cidx = opaque_bid();
            bf16_t* WtBr = p.Wt + (size_t)WT_ROWS * DM;
            const int n = (q == 4) ? 0 : (q == 7) ? 1 : 2; const int ldh = (n == 0) ? LDA_H : (n == 1) ? LDB_H : LDC_H; const int ocol = (n == 0) ? 3200 : (n == 1) ? 2048 : 3072;
            pg8::GemmDesc g0, g1; g0.A = p.xn; g0.Bt = p.Wt + (size_t)(LDA_H + LDB_H + LDC_H + n * DM) * DM; g0.lda = DM;
            g1.A = p.H + ocol; g1.Bt = WtBr + (size_t)n * DM * DM; g1.lda = ldh;
            pg8::Sched S; S.init(T_TOK, DM, G, cidx, 2);
            pg8::EpiMerge E; E.G = p.H; E.ldg = ldh; E.bias = p.b_merge + ((size_t)l * 3 + n) * DM; E.Y = p.y; E.accum = (n > 0);
            { const int nrep = (PROBE_Q == 4 && l == 0 && q == 4) ? 2 : 1; for (int rep = 0; rep < nrep; ++rep) pg8::gemm_phase(lds, g0, g1, S, E); }
        } else {
            const Params p = load_params(); const int G = gridDim.x, cidx = opaque_bid();
            bf16_t* WtOut = p.Wt + (size_t)WT_ROWS * DM + (size_t)3 * DM * DM;
            pg8::GemmDesc g; g.A = p.y; g.Bt = WtOut; g.lda = DM;
            pg8::Sched S; S.init(T_TOK, DM, G, cidx, 1);
            pg8::EpiResid E; E.Xin = (l == 0) ? p.x : p.out; E.Xout = p.out;
            { const int nrep = (PROBE_Q == 13 && l == 0) ? 2 : 1; for (int rep = 0; rep < nrep; ++rep) pg8::gemm_phase(lds, g, g, S, E); }
        }
        if (ph + 1 < phase_hi) { if (ph == phase_lo) grid.sync(); else xcd_barrier(xb); }
    }
}

extern "C" void kernel_launch(void* const* d_in, const int* in_sizes, int n_in, void* d_out, int out_size, void* d_ws, size_t ws_size, hipStream_t stream) {
    static int grid_blocks = 0;
    if (!grid_blocks) {
        int dev = 0, cus = 0, per_cu = 0;
        hipGetDevice(&dev);
        hipDeviceGetAttribute(&cus, hipDeviceAttributeMultiprocessorCount, dev);
        if (hipFuncSetAttribute((const void*)fwd_megakernel, hipFuncAttributeMaxDynamicSharedMemorySize, LDS_BYTES) != hipSuccess) { fprintf(stderr, "hipFuncSetAttribute failed\n"); return; }
        hipOccupancyMaxActiveBlocksPerMultiprocessor(&per_cu, (const void*)fwd_megakernel, 512, LDS_BYTES);
        if (per_cu < 1) { fprintf(stderr, "occupancy query says 0 blocks per CU\n"); return; }
        grid_blocks = cus * 1;
    }
    Params p{};
    const float** fp = (const float**)&p;
    for (int i = 0; i < 26; ++i) fp[i] = (const float*)d_in[i];
    p.out = (float*)d_out;
    unsigned char* ws = (unsigned char*)d_ws; size_t off = 0;
    auto take = [&](size_t bytes) { unsigned char* r = ws + off; off += (bytes + 255) & ~(size_t)255; return r; };
    p.Wt = (bf16_t*)take(((size_t)WT_ROWS * DM + 4 * (size_t)DM * DM) * 2);
    p.xn = (bf16_t*)take((size_t)T_TOK * DM * 2);
    p.vf = (bf16_t*)take((size_t)T_TOK * DM * 2);
    p.y = (bf16_t*)take((size_t)T_TOK * DM * 2);
    p.H = (bf16_t*)take((size_t)T_TOK * LDA_H * 2);
    p.rkbuf = (float*)take((size_t)T_TOK * 16 * 2 * 4);
    p.bar = (unsigned*)take((size_t)XCD_BAR_WORDS * 4);
    if (off > ws_size) { fprintf(stderr, "workspace too small: need %zu have %zu\n", off, ws_size); return; }
#if SINGLE_LAUNCH
    p.phase_lo = 0; p.phase_hi = N_PHASES;
    void* args[] = {&p};
    if (hipMemsetAsync(p.bar, 0, (size_t)XCD_BAR_WORDS * 4, stream) != hipSuccess) { fprintf(stderr, "memset failed\n"); return; }
    hipError_t e = hipLaunchCooperativeKernel((const void*)fwd_megakernel, dim3(grid_blocks), dim3(512), args, LDS_BYTES, stream);
    if (e != hipSuccess) fprintf(stderr, "cooperative launch failed: %s (grid %d)\n", hipGetErrorString(e), grid_blocks);
#else
    for (int ph = 0; ph < N_PHASES; ++ph) {
        p.phase_lo = ph; p.phase_hi = ph + 1;
        hipLaunchKernelGGL(fwd_megakernel, dim3(grid_blocks), dim3(512), LDS_BYTES, stream, p);
    }
#endif
}
```

```cpp
#include <hip/hip_runtime.h>
#include <hip/hip_cooperative_groups.h>
#include <cstdio>
namespace cg = cooperative_groups;

#ifndef PROBE_MODE
#define PROBE_MODE 0
#endif
#ifndef PROBE_Q
#define PROBE_Q -1
#endif
#ifndef SINGLE_LAUNCH
#define SINGLE_LAUNCH 1
#endif

typedef unsigned short bf16_t;
typedef short bf16x8 __attribute__((ext_vector_type(8)));
typedef float f32x4 __attribute__((ext_vector_type(4)));
typedef float f32x2 __attribute__((ext_vector_type(2)));
typedef unsigned u32x4 __attribute__((ext_vector_type(4)));
typedef unsigned u32x2 __attribute__((ext_vector_type(2)));
#define LAS __attribute__((address_space(3)))

constexpr int T_TOK = 32768, DM = 1024, SEQ = 4096, NB = 8;
constexpr int N_IN = 14464;
constexpr int LDA_H = 4352, LDB_H = 3072, LDC_H = 4096;
constexpr int WT_ROWS = 14592;
constexpr int LDS_BYTES = 163840;
constexpr float EPS = 1e-6f, GN_EPS = 64e-5f;

struct Params {
    const float *x, *norm_g, *w_in, *b_merge, *mu, *w0, *w_w2, *a0, *a_w2, *v0, *v_w1, *v_w2, *k_k, *k_a, *r_k, *lnx_g, *lnx_b,
        *sgu_ln_g, *sgu_ln_b, *sgu_w, *sgu_b, *lb_logits, *hgrn_g, *w_branch, *w_out, *final_g;
    float* out;
    bf16_t *Wt, *xn, *vf, *y, *H;
    float* rkbuf;
    unsigned* bar;
    int phase_lo, phase_hi;
};

__device__ __forceinline__ float bf2f(bf16_t h) { return __uint_as_float(((unsigned)h) << 16); }
__device__ __forceinline__ float bflo(unsigned u) { return __uint_as_float(u << 16); }
__device__ __forceinline__ float bfhi(unsigned u) { return __uint_as_float(u & 0xffff0000u); }
typedef __bf16 bf16x2_t __attribute__((ext_vector_type(2)));
__device__ __forceinline__ unsigned cvt_pk_bf16(float lo, float hi) { const f32x2 v = {lo, hi}; const bf16x2_t r = __builtin_convertvector(v, bf16x2_t); return __builtin_bit_cast(unsigned, r); }
__device__ __forceinline__ bf16_t f2bf(float f) { return (bf16_t)(cvt_pk_bf16(f, 0.f) & 0xffffu); }
__device__ __forceinline__ float sigmoidf_(float x) { return __builtin_amdgcn_rcpf(1.0f + __expf(-x)); }
__device__ __forceinline__ float siluf_(float x) { return x * __builtin_amdgcn_rcpf(1.0f + __expf(-x)); }
__device__ __forceinline__ float tanh_fast(float x) { return 1.0f - 2.0f * __builtin_amdgcn_rcpf(1.0f + __expf(2.0f * x)); }

__device__ __forceinline__ Params load_params() {
#if defined(__HIP_DEVICE_COMPILE__)
    typedef const Params __attribute__((address_space(4)))* KP;
    KP kp = (KP)__builtin_amdgcn_kernarg_segment_ptr(); asm volatile("" : "+s"(kp)); return *kp;
#else
    return Params{};
#endif
}
__device__ __forceinline__ int opaque_tid() { int t = threadIdx.x; asm volatile("" : "+v"(t)); return t; }
__device__ __forceinline__ int opaque_bid() { int t = blockIdx.x; asm volatile("" : "+s"(t)); return t; }

namespace pg8 {
constexpr int BM = 256, BK = 64, HALF = 128, HTB = HALF * BK * 2, STAGE_BYTES = 8 * HTB, NXCD = 8, WGM = 8, KD = 1024;
__device__ __forceinline__ int lds_byte(int r, int c) { const int st = (r >> 4) * 2 + (c >> 5), rr = r & 15, cc = c & 31, ob = rr * 64 + cc * 2; return st * 1024 + (ob ^ (((ob >> 9) & 1) << 5)); }
__device__ __forceinline__ void stage_rc(int b, int& R, int& C) { const int st = b / 1024, sb = b % 1024, swz = sb ^ (((sb >> 9) & 1) << 5); R = (st >> 1) * 16 + swz / 64; C = (st & 1) * 32 + (swz % 64) / 2; }
__device__ __forceinline__ int perm32(int rho) { const int n = rho >> 4, i = rho & 15; return 8 * (i >> 2) + 4 * n + (i & 3); }

struct Unit { int pm, pn, sel; };
struct GemmDesc { const bf16_t* A; const bf16_t* Bt; int lda; };
struct Sched {
    int nM, nN, nwg, G, c, nsel;
    __device__ void init(int M, int N, int G_, int c_, int nsel_) { nM = M / BM; nN = N / BM; nwg = nM * nN; G = G_; c = c_; nsel = nsel_; }
    __device__ bool next(int i, Unit& u) const {
        const int ti = (nsel == 2) ? (i >> 1) : i; u.sel = (nsel == 2) ? (i & 1) : 0;
        const long L = (long)ti * G + c; if (L >= nwg) return false;
        int wgid = (int)L; { const int q = nwg / NXCD, r = nwg % NXCD, xcd = wgid % NXCD, off = wgid / NXCD; wgid = (xcd < r ? xcd * (q + 1) : r * (q + 1) + (xcd - r) * q) + off; }
        const int nig = WGM * nN, gid = wgid / nig, fm = gid * WGM, gsz = (nM - fm) < WGM ? (nM - fm) : WGM;
        u.pm = fm + ((wgid % nig) % gsz); u.pn = (wgid % nig) / gsz; return true;
    }
};

template <class Epi>
__device__ __forceinline__ void gemm_phase(LAS unsigned char* lds, const GemmDesc g0, const GemmDesc g1, const Sched& S, const Epi& E) {
    const int tid = opaque_tid(), wid = __builtin_amdgcn_readfirstlane(tid >> 6), lane = tid & 63, wr = wid >> 2, wc = wid & 3, fr = lane & 15, fq = lane >> 4;
    constexpr int K = KD, nt = K / BK;
    unsigned voffA0[2], voffA1[2], voffB[2];
#pragma unroll
    for (int i = 0; i < 2; ++i) { int R, C; stage_rc(tid * 16 + i * 8192, R, C); const int Rb = Epi::PERM ? ((R & ~31) + perm32(R & 31)) : R;
        voffA0[i] = (unsigned)(R * g0.lda + C) * 2u; voffA1[i] = (unsigned)(R * g1.lda + C) * 2u; voffB[i] = (unsigned)(Rb * K + C) * 2u; }
    const size_t kstep = (size_t)(BK * 2);
    const size_t hstepB = (size_t)HALF * K * 2;
    const unsigned ldsw = (unsigned)wid * 1024u;
    const int aoff = lds_byte(wr * 64 + fr, fq * 8), boff = lds_byte(wc * 32 + fr, fq * 8);
#define PG8_SA(b, h) (((b) * 2 + (h)) * HTB)
#define PG8_SB(b, h) ((4 + (b) * 2 + (h)) * HTB)
#define PG8_STAGE(bufoff, gbase, v0, v1) do { \
        __builtin_amdgcn_global_load_lds((const unsigned*)((const char*)(gbase) + (v0)), (LAS unsigned*)(lds + (bufoff) + ldsw), 16, 0, 0); \
        __builtin_amdgcn_global_load_lds((const unsigned*)((const char*)(gbase) + (v1)), (LAS unsigned*)(lds + (bufoff) + ldsw + 8192), 16, 0, 0); } while (0)
#define PG8_STAGEB(bufoff, gbase) PG8_STAGE(bufoff, gbase, voffB[0], voffB[1])
#define PG8_LDA(dst, b, h) do { _Pragma("unroll") for (int m = 0; m < 4; ++m) _Pragma("unroll") for (int k = 0; k < 2; ++k) dst[m][k] = *(const LAS bf16x8*)(lds + PG8_SA(b, h) + aoff + m * 2048 + k * 1024); } while (0)
#define PG8_LDB(dst, b, h) do { _Pragma("unroll") for (int n = 0; n < 2; ++n) _Pragma("unroll") for (int k = 0; k < 2; ++k) dst[n][k] = *(const LAS bf16x8*)(lds + PG8_SB(b, h) + boff + n * 2048 + k * 1024); } while (0)
#define PG8_MMA(ai, bj, At, Bt) do { __builtin_amdgcn_s_setprio(1); _Pragma("unroll") for (int m = 0; m < 4; ++m) _Pragma("unroll") for (int n = 0; n < 2; ++n) _Pragma("unroll") for (int k = 0; k < 2; ++k) \
        acc[ai][bj][m][n] = __builtin_amdgcn_mfma_f32_16x16x32_bf16(Bt[n][k], At[m][k], acc[ai][bj][m][n], 0, 0, 0); __builtin_amdgcn_s_setprio(0); } while (0)
#define PG8_WAIT_V(n) asm volatile("s_waitcnt vmcnt(" #n ")" ::: "memory")
#define PG8_WAIT_L(n) asm volatile("s_waitcnt lgkmcnt(" #n ")" ::: "memory")
#define PG8_BAR __builtin_amdgcn_s_barrier()
#define PG8_SCHED __builtin_amdgcn_sched_barrier(0)
    Unit cur, nxt; int ui = 0;
    if (!S.next(0, cur)) return;
    f32x4 acc[2][2][4][2];
#pragma unroll
    for (int a = 0; a < 2; ++a)
#pragma unroll
        for (int b = 0; b < 2; ++b)
#pragma unroll
            for (int m = 0; m < 4; ++m)
#pragma unroll
                for (int n = 0; n < 2; ++n) acc[a][b][m][n] = (f32x4){0.f, 0.f, 0.f, 0.f};
    bf16x8 At[4][2], B0[2][2], B1[2][2];
    const char* cA = (const char*)(cur.sel ? g1.A : g0.A) + (size_t)cur.pm * 256 * (size_t)(cur.sel ? g1.lda : g0.lda) * 2;
    const char* cB = (const char*)(cur.sel ? g1.Bt : g0.Bt) + (size_t)cur.pn * 256 * K * 2;
    size_t chA = (size_t)HALF * (cur.sel ? g1.lda : g0.lda) * 2;
    unsigned cv0 = cur.sel ? voffA1[0] : voffA0[0], cv1 = cur.sel ? voffA1[1] : voffA0[1];
    PG8_STAGEB(PG8_SB(0, 0), cB); PG8_STAGE(PG8_SA(0, 0), cA, cv0, cv1); PG8_STAGEB(PG8_SB(0, 1), cB + hstepB); PG8_STAGE(PG8_SA(0, 1), cA + chA, cv0, cv1);
    if (wr == 1) PG8_BAR;
    PG8_WAIT_V(4); PG8_BAR;
    PG8_STAGEB(PG8_SB(1, 0), cB + kstep); PG8_STAGE(PG8_SA(1, 0), cA + kstep, cv0, cv1); PG8_STAGEB(PG8_SB(1, 1), cB + hstepB + kstep);
    PG8_WAIT_V(6); PG8_BAR;
    for (;;) {
        const bool has_next = S.next(ui + 1, nxt);
        const int nsel = has_next ? nxt.sel : cur.sel;
        const char* nA = has_next ? (const char*)(nsel ? g1.A : g0.A) + (size_t)nxt.pm * 256 * (size_t)(nsel ? g1.lda : g0.lda) * 2 : cA;
        const char* nB = has_next ? (const char*)(nsel ? g1.Bt : g0.Bt) + (size_t)nxt.pn * 256 * K * 2 : cB;
        const size_t nhA = (size_t)HALF * (nsel ? g1.lda : g0.lda) * 2;
        const unsigned nv0 = nsel ? voffA1[0] : voffA0[0], nv1 = nsel ? voffA1[1] : voffA0[1];
        for (int t = 0; t < nt; t += 2) {
            const bool last = (t == nt - 2);
            const char* a1 = cA + (size_t)(t + 1) * kstep;
            const char* a2 = last ? nA : cA + (size_t)(t + 2) * kstep; const char* b2 = last ? nB : cB + (size_t)(t + 2) * kstep;
            const char* a3 = a2 + kstep; const char* b3 = b2 + kstep;
            const size_t h2 = last ? nhA : chA; const unsigned w0 = last ? nv0 : cv0, w1 = last ? nv1 : cv1;
            PG8_LDB(B0, 0, 0); PG8_SCHED; PG8_LDA(At, 0, 0); PG8_STAGE(PG8_SA(1, 1), a1 + chA, cv0, cv1);
            PG8_WAIT_L(8); PG8_BAR; PG8_WAIT_L(0); PG8_MMA(0, 0, At, B0); PG8_BAR; PG8_SCHED;
            PG8_LDB(B1, 0, 1); PG8_STAGEB(PG8_SB(0, 0), b2);
            PG8_BAR; PG8_WAIT_L(0); PG8_MMA(0, 1, At, B1); PG8_BAR;
            PG8_LDA(At, 0, 1); PG8_STAGE(PG8_SA(0, 0), a2, w0, w1);
            PG8_BAR; PG8_WAIT_L(0); PG8_MMA(1, 0, At, B0); PG8_BAR; PG8_SCHED;
            PG8_STAGEB(PG8_SB(0, 1), b2 + hstepB);
            PG8_WAIT_V(6); PG8_BAR; PG8_MMA(1, 1, At, B1); PG8_BAR;
            PG8_LDB(B0, 1, 0); PG8_SCHED; PG8_LDA(At, 1, 0); PG8_STAGE(PG8_SA(0, 1), a2 + h2, w0, w1);
            PG8_WAIT_L(8); PG8_BAR; PG8_WAIT_L(0); PG8_MMA(0, 0, At, B0); PG8_BAR; PG8_SCHED;
            PG8_LDB(B1, 1, 1); PG8_STAGEB(PG8_SB(1, 0), b3);
            PG8_BAR; PG8_WAIT_L(0); PG8_MMA(0, 1, At, B1); PG8_BAR;
            PG8_LDA(At, 1, 1); PG8_STAGE(PG8_SA(1, 0), a3, w0, w1);
            PG8_BAR; PG8_WAIT_L(0); PG8_MMA(1, 0, At, B0); PG8_BAR; PG8_SCHED;
            PG8_STAGEB(PG8_SB(1, 1), b3 + hstepB);
            PG8_WAIT_V(6); PG8_BAR; PG8_MMA(1, 1, At, B1); PG8_BAR;
        }
        E(acc, cur, wr, wc, fr, fq);
        if (!has_next) break;
#pragma unroll
        for (int a = 0; a < 2; ++a)
#pragma unroll
            for (int b = 0; b < 2; ++b)
#pragma unroll
                for (int m = 0; m < 4; ++m)
#pragma unroll
                    for (int n = 0; n < 2; ++n) acc[a][b][m][n] = (f32x4){0.f, 0.f, 0.f, 0.f};
        cur = nxt; cA = nA; cB = nB; chA = nhA; cv0 = nv0; cv1 = nv1; ++ui;
    }
    PG8_WAIT_V(0);
    if (wr == 0) PG8_BAR;
    PG8_BAR;
#undef PG8_SA
#undef PG8_SB
#undef PG8_STAGE
#undef PG8_STAGEB
#undef PG8_LDA
#undef PG8_LDB
#undef PG8_MMA
#undef PG8_WAIT_V
#undef PG8_WAIT_L
#undef PG8_BAR
#undef PG8_SCHED
}

struct EpiStore {
    static constexpr bool PERM = true;
    bf16_t* O; int ldc;
    __device__ __forceinline__ void operator()(const f32x4 (&acc)[2][2][4][2], const Unit& u, int wr, int wc, int fr, int fq) const {
        const int row0 = u.pm * BM + wr * 64 + fr, col0 = u.pn * BM + wc * 32 + 8 * fq;
#pragma unroll
        for (int ai = 0; ai < 2; ++ai)
#pragma unroll
            for (int m = 0; m < 4; ++m) { bf16_t* rowp = O + (size_t)(row0 + ai * HALF + m * 16) * ldc + col0;
#pragma unroll
                for (int bj = 0; bj < 2; ++bj) { const f32x4 v0 = acc[ai][bj][m][0], v1 = acc[ai][bj][m][1];
                    u32x4 w; w.x = cvt_pk_bf16(v0[0], v0[1]); w.y = cvt_pk_bf16(v0[2], v0[3]); w.z = cvt_pk_bf16(v1[0], v1[1]); w.w = cvt_pk_bf16(v1[2], v1[3]);
                    *(u32x4*)(rowp + bj * HALF) = w; } }
    }
};
struct EpiMerge {
    static constexpr bool PERM = true;
    bf16_t* G; int ldg; const float* bias; bf16_t* Y; int accum;
    __device__ __forceinline__ void operator()(const f32x4 (&acc)[2][2][4][2], const Unit& u, int wr, int wc, int fr, int fq) const {
        const int row0 = u.pm * BM + wr * 64 + fr, col0 = u.pn * BM + wc * 32 + 8 * fq;
        if (u.sel == 0) {
            f32x4 bv[2][2];
#pragma unroll
            for (int bj = 0; bj < 2; ++bj)
#pragma unroll
                for (int n = 0; n < 2; ++n) bv[bj][n] = *(const f32x4*)(bias + col0 + bj * HALF + 4 * n);
#pragma unroll
            for (int ai = 0; ai < 2; ++ai)
#pragma unroll
                for (int m = 0; m < 4; ++m) { bf16_t* rowp = G + (size_t)(row0 + ai * HALF + m * 16) * ldg + col0;
#pragma unroll
                    for (int bj = 0; bj < 2; ++bj) { f32x4 v0 = acc[ai][bj][m][0] + bv[bj][0], v1 = acc[ai][bj][m][1] + bv[bj][1];
#pragma unroll
                        for (int j = 0; j < 4; ++j) { v0[j] = sigmoidf_(v0[j]); v1[j] = sigmoidf_(v1[j]); }
                        u32x4 w; w.x = cvt_pk_bf16(v0[0], v0[1]); w.y = cvt_pk_bf16(v0[2], v0[3]); w.z = cvt_pk_bf16(v1[0], v1[1]); w.w = cvt_pk_bf16(v1[2], v1[3]);
                        *(u32x4*)(rowp + bj * HALF) = w; } }
        } else {
#pragma unroll
            for (int ai = 0; ai < 2; ++ai)
#pragma unroll
                for (int m = 0; m < 4; ++m) { const size_t r = (size_t)(row0 + ai * HALF + m * 16);
                    const unsigned long long* gp = (const unsigned long long*)(G + r * ldg + col0); bf16_t* yp = Y + r * DM + col0;
#pragma unroll
                    for (int bj = 0; bj < 2; ++bj) {
                        const unsigned long long g0 = __hip_atomic_load(gp + bj * (HALF / 4), __ATOMIC_RELAXED, __HIP_MEMORY_SCOPE_AGENT);
                        const unsigned long long g1 = __hip_atomic_load(gp + bj * (HALF / 4) + 1, __ATOMIC_RELAXED, __HIP_MEMORY_SCOPE_AGENT);
                        const unsigned gw[4] = {(unsigned)g0, (unsigned)(g0 >> 32), (unsigned)g1, (unsigned)(g1 >> 32)};
                        u32x4 yo = {0u, 0u, 0u, 0u}; if (accum) yo = *(const u32x4*)(yp + bj * HALF);
                        const f32x4 v0 = acc[ai][bj][m][0], v1 = acc[ai][bj][m][1];
                        u32x4 w;
                        w.x = cvt_pk_bf16(bflo(yo.x) + bflo(gw[0]) * v0[0], bfhi(yo.x) + bfhi(gw[0]) * v0[1]);
                        w.y = cvt_pk_bf16(bflo(yo.y) + bflo(gw[1]) * v0[2], bfhi(yo.y) + bfhi(gw[1]) * v0[3]);
                        w.z = cvt_pk_bf16(bflo(yo.z) + bflo(gw[2]) * v1[0], bfhi(yo.z) + bfhi(gw[2]) * v1[1]);
                        w.w = cvt_pk_bf16(bflo(yo.w) + bflo(gw[3]) * v1[2], bfhi(yo.w) + bfhi(gw[3]) * v1[3]);
                        *(u32x4*)(yp + bj * HALF) = w; } }
        }
    }
};
struct EpiResid {
    static constexpr bool PERM = false;
    const float* Xin; float* Xout;
    __device__ __forceinline__ void operator()(const f32x4 (&acc)[2][2][4][2], const Unit& u, int wr, int wc, int fr, int fq) const {
        const int row0 = u.pm * BM + wr * 64 + fr, col0 = u.pn * BM + wc * 32 + 4 * fq;
#pragma unroll
        for (int ai = 0; ai < 2; ++ai)
#pragma unroll
            for (int m = 0; m < 4; ++m) { const size_t ro = (size_t)(row0 + ai * HALF + m * 16) * DM + col0;
#pragma unroll
                for (int bj = 0; bj < 2; ++bj)
#pragma unroll
                    for (int n = 0; n < 2; ++n) { const f32x4 xi = *(const f32x4*)(Xin + ro + bj * HALF + n * 16); *(f32x4*)(Xout + ro + bj * HALF + n * 16) = xi + acc[ai][bj][m][n]; } }
    }
};
}

__device__ void phase_convert(int l, unsigned char* smem) {
    const Params p = load_params();
    float* tile = (float*)smem;
    const int tid = opaque_tid();
    const float* win = p.w_in + (size_t)l * DM * N_IN;
    bf16_t* WtIn = p.Wt; bf16_t* WtBr = p.Wt + (size_t)WT_ROWS * DM; bf16_t* WtOut = WtBr + (size_t)3 * DM * DM;
    const int NT_IN = WT_ROWS / 64;
    const int total = (NT_IN + 48 + 16) * 16;
    for (int it = blockIdx.x; it < total; it += gridDim.x) {
        const int ntile = it >> 4, kt = it & 15, k0 = kt * 64;
        const float* src = nullptr; int ld = 0, c0 = 0, valid = 64; bf16_t* dst;
        if (ntile < NT_IN) {
            const int n0 = ntile * 64; dst = WtIn + (size_t)n0 * DM;
            if (n0 < 4224) { src = win; ld = N_IN; c0 = n0; }
            else if (n0 < 4352) { if (n0 == 4224 && l > 0) { src = p.v_w1 + (size_t)(l - 1) * DM * 32; ld = 32; c0 = 0; valid = 32; } else { valid = 0; } }
            else { src = win; ld = N_IN; c0 = n0 - 128; }
        } else if (ntile < NT_IN + 48) {
            const int q = ntile - NT_IN, n = q >> 4, n0 = (q & 15) * 64;
            src = p.w_branch + ((size_t)l * 3 + n) * DM * DM; ld = DM; c0 = n0; dst = WtBr + ((size_t)n * DM + n0) * DM;
        } else {
            const int n0 = (ntile - NT_IN - 48) * 64; src = p.w_out + (size_t)l * DM * DM; ld = DM; c0 = n0; dst = WtOut + (size_t)n0 * DM;
        }
        __syncthreads();
        if (valid == 64) {
            const int kr = tid >> 4, nc = (tid & 15) * 4;
#pragma unroll
            for (int ps = 0; ps < 2; ++ps) { const int k = kr + ps * 32; const f32x4 v = *(const f32x4*)(src + (size_t)(k0 + k) * ld + c0 + nc);
                tile[k * 65 + nc] = v[0]; tile[k * 65 + nc + 1] = v[1]; tile[k * 65 + nc + 2] = v[2]; tile[k * 65 + nc + 3] = v[3]; }
        } else {
            for (int e = tid; e < 4096; e += 512) { const int k = e >> 6, n = e & 63; tile[k * 65 + n] = (n < valid) ? src[(size_t)(k0 + k) * ld + c0 + n] : 0.f; }
        }
        __syncthreads();
        { const int nr = tid >> 3, kc = (tid & 7) * 8; u32x4 w;
          w.x = cvt_pk_bf16(tile[(kc + 0) * 65 + nr], tile[(kc + 1) * 65 + nr]); w.y = cvt_pk_bf16(tile[(kc + 2) * 65 + nr], tile[(kc + 3) * 65 + nr]);
          w.z = cvt_pk_bf16(tile[(kc + 4) * 65 + nr], tile[(kc + 5) * 65 + nr]); w.w = cvt_pk_bf16(tile[(kc + 6) * 65 + nr], tile[(kc + 7) * 65 + nr]);
          *(u32x4*)(dst + (size_t)nr * DM + k0 + kc) = w; }
    }
    __syncthreads();
}

__device__ void phase_rmsnorm(const float* x, const float* g, bf16_t* xn, float* outf) {
    const int tid_ = opaque_tid(); const int lane = tid_ & 63, wv = tid_ >> 6;
    f32x4 gv[4];
#pragma unroll
    for (int q = 0; q < 4; ++q) gv[q] = *(const f32x4*)(g + q * 256 + lane * 4);
    for (int row = blockIdx.x * 8 + wv; row < T_TOK; row += gridDim.x * 8) {
        const float* xr = x + (size_t)row * DM; f32x4 v[4]; float ss = 0.f;
#pragma unroll
        for (int q = 0; q < 4; ++q) { v[q] = *(const f32x4*)(xr + q * 256 + lane * 4); ss += v[q][0] * v[q][0] + v[q][1] * v[q][1] + v[q][2] * v[q][2] + v[q][3] * v[q][3]; }
#pragma unroll
        for (int o = 32; o > 0; o >>= 1) ss += __shfl_xor(ss, o);
        const float rinv = rsqrtf(ss * (1.0f / DM) + EPS);
#pragma unroll
        for (int q = 0; q < 4; ++q) { const f32x4 o = v[q] * rinv * gv[q];
            if (xn) { u32x2 w; w.x = cvt_pk_bf16(o[0], o[1]); w.y = cvt_pk_bf16(o[2], o[3]); *(u32x2*)(xn + (size_t)row * DM + q * 256 + lane * 4) = w; }
            else *(f32x4*)(outf + (size_t)row * DM + q * 256 + lane * 4) = o; }
    }
}

template <int CTRL> __device__ __forceinline__ float dpp_f(float v) { return __int_as_float(__builtin_amdgcn_update_dpp(0, __float_as_int(v), CTRL, 0xf, 0xf, false)); }
__device__ __forceinline__ float red8(float v) { v += dpp_f<0xB1>(v); v += dpp_f<0x4E>(v); v += dpp_f<0x141>(v); return v; }
__device__ __forceinline__ float red16(float v) { v = red8(v); v += dpp_f<0x140>(v); return v; }

struct RwRaw { u32x4 cw[2], pw[2], ca[2], pa[2], vl; u32x2 cr[2], pr[2], ck[2], pk[2], cv, pv, vf; };
__device__ __forceinline__ void rw_load(RwRaw& R, const bf16_t* H, const bf16_t* vfp, int l, size_t tok, bool hasp, int h, int chh, int vnt, int fq) {
    const bf16_t* cur = H + tok * LDA_H; const bf16_t* prev = cur - LDA_H;
    const u32x4 z4 = {0u, 0u, 0u, 0u}; const u32x2 z2 = {0u, 0u};
#pragma unroll
    for (int ks = 0; ks < 2; ++ks) { const int m0 = ks * 32 + fq * 8;
        R.cw[ks] = *(const u32x4*)(cur + 3072 + m0); R.ca[ks] = *(const u32x4*)(cur + 3136 + m0);
        R.pw[ks] = hasp ? *(const u32x4*)(prev + 3072 + m0) : z4; R.pa[ks] = hasp ? *(const u32x4*)(prev + 3136 + m0) : z4; }
#pragma unroll
    for (int q = 0; q < 2; ++q) { const int cb = h * 64 + (chh * 2 + q) * 16 + fq * 4;
        R.cr[q] = *(const u32x2*)(cur + cb); R.ck[q] = *(const u32x2*)(cur + 1024 + cb);
        R.pr[q] = hasp ? *(const u32x2*)(prev + cb) : z2; R.pk[q] = hasp ? *(const u32x2*)(prev + 1024 + cb) : z2; }
    const int cbv = h * 64 + vnt * 16 + fq * 4;
    R.cv = *(const u32x2*)(cur + 2048 + cbv); R.pv = hasp ? *(const u32x2*)(prev + 2048 + cbv) : z2;
    R.vf = z2; R.vl = z4;
    if (l > 0) { R.vf = *(const u32x2*)(vfp + tok * DM + cbv); R.vl = *(const u32x4*)(cur + 4224 + fq * 8); }
}

__device__ void phase_rwkv(int l, unsigned char* smem, int mode) {
    const Params p = load_params();
    constexpr int TC = 32, NCH = SEQ / TC, RS = 68  , BUFSZ = 5 * TC * RS + TC * 32 + TC * 2;
    bf16_t* w2T = (bf16_t*)smem;
    bf16_t* a2T = w2T + 64 * 72;
    bf16_t* v2T = a2T + 64 * 72;
    float* cst = (float*)(v2T + 64 * 40);
    float* buf0 = cst + 11 * 64;
    float* ypart = buf0 + 2 * BUFSZ;
    float* sI = ypart + 4 * TC * 64;
    const int tid = opaque_tid(), wid = __builtin_amdgcn_readfirstlane(tid >> 6), lane = tid & 63, fr = lane & 15, fq = lane >> 4;
    for (int item = blockIdx.x; item < NB * 32; item += gridDim.x) {
        const int xc_ = item & 7, sl_ = item >> 3, half = sl_ & 1, pi_ = (sl_ >> 1) * 8 + xc_, b = pi_ >> 4, h = pi_ & 15;
        __syncthreads();
        for (int e = tid; e < 4096; e += 512) { const int m = e >> 6, j = e & 63; w2T[j * 72 + m] = f2bf(p.w_w2[((size_t)l * 64 + m) * DM + h * 64 + j]); a2T[j * 72 + m] = f2bf(p.a_w2[((size_t)l * 64 + m) * DM + h * 64 + j]); }
        if (l > 0) for (int e = tid; e < 2048; e += 512) { const int m = e >> 6, j = e & 63; v2T[j * 40 + m] = f2bf(p.v_w2[((size_t)(l - 1) * 32 + m) * DM + h * 64 + j]); }
        if (tid < 64) { const float* mu = p.mu + (size_t)l * 3200; const int cc = h * 64 + tid;
            cst[tid] = mu[cc]; cst[64 + tid] = mu[1024 + cc]; cst[128 + tid] = mu[2048 + cc]; cst[192 + tid] = p.w0[l * DM + cc]; cst[256 + tid] = p.a0[l * DM + cc];
            cst[320 + tid] = (l > 0) ? p.v0[(l - 1) * DM + cc] : 0.f; cst[384 + tid] = p.k_k[l * DM + cc]; cst[448 + tid] = p.k_a[l * DM + cc]; cst[512 + tid] = p.r_k[l * DM + cc];
            cst[576 + tid] = mu[3072 + tid]; cst[640 + tid] = mu[3136 + tid]; }
        __syncthreads();
        f32x2 st[4];
#pragma unroll
        for (int j = 0; j < 4; ++j) st[j] = (f32x2){0.f, 0.f};
        const int si = tid >> 3, seg = tid & 7;
        const int pwv = wid - 4, tti = pwv & 1, chh = (pwv >> 1) & 1, vnt = half * 2 + chh, tt = tti * 16 + fr;
        RwRaw raw;
        if (wid >= 4) rw_load(raw, p.H, p.vf, l, (size_t)b * SEQ + tt, tt > 0, h, chh, vnt, fq);
        for (int c = -1; c < NCH; ++c) {
            if (wid >= 4 && c + 1 < NCH && !(mode & 2)) {
                float* B_ = buf0 + ((c + 1) & 1) * BUFSZ;
                float* sR = B_; float* sW = sR + TC * RS; float* sK = sW + TC * RS; float* sA = sK + TC * RS; float* sB = sA + TC * RS; float* sV = sB + TC * RS; float* sS = sV + TC * 32;
                const size_t tok = (size_t)b * SEQ + (c + 1) * TC + tt;
                const RwRaw cr_ = raw;
                if (c + 2 < NCH) rw_load(raw, p.H, p.vf, l, tok + TC, true, h, chh, vnt, fq);
                bf16x8 AfW[2], AfA[2];
#pragma unroll
                for (int ks = 0; ks < 2; ++ks) { const int m0 = ks * 32 + fq * 8;
                    const f32x4 mw0 = *(const f32x4*)(cst + 576 + m0), mw1 = *(const f32x4*)(cst + 576 + m0 + 4), ma0 = *(const f32x4*)(cst + 640 + m0), ma1 = *(const f32x4*)(cst + 640 + m0 + 4);
                    const float muw[8] = {mw0[0], mw0[1], mw0[2], mw0[3], mw1[0], mw1[1], mw1[2], mw1[3]}, mua[8] = {ma0[0], ma0[1], ma0[2], ma0[3], ma1[0], ma1[1], ma1[2], ma1[3]};
                    const unsigned cwv[4] = {cr_.cw[ks].x, cr_.cw[ks].y, cr_.cw[ks].z, cr_.cw[ks].w}, pwq[4] = {cr_.pw[ks].x, cr_.pw[ks].y, cr_.pw[ks].z, cr_.pw[ks].w};
                    const unsigned cav[4] = {cr_.ca[ks].x, cr_.ca[ks].y, cr_.ca[ks].z, cr_.ca[ks].w}, pav[4] = {cr_.pa[ks].x, cr_.pa[ks].y, cr_.pa[ks].z, cr_.pa[ks].w};
                    unsigned ow[4], oa[4];
#pragma unroll
                    for (int e = 0; e < 4; ++e) {
                        const float c0 = bflo(cwv[e]), c1 = bfhi(cwv[e]), q0 = bflo(pwq[e]), q1 = bfhi(pwq[e]);
                        ow[e] = cvt_pk_bf16(tanh_fast(c0 + muw[2 * e] * (q0 - c0)), tanh_fast(c1 + muw[2 * e + 1] * (q1 - c1)));
                        const float d0 = bflo(cav[e]), d1 = bfhi(cav[e]), r0 = bflo(pav[e]), r1 = bfhi(pav[e]);
                        oa[e] = cvt_pk_bf16(d0 + mua[2 * e] * (r0 - d0), d1 + mua[2 * e + 1] * (r1 - d1)); }
                    AfW[ks] = __builtin_bit_cast(bf16x8, ((u32x4){ow[0], ow[1], ow[2], ow[3]})); AfA[ks] = __builtin_bit_cast(bf16x8, ((u32x4){oa[0], oa[1], oa[2], oa[3]})); }
                f32x4 accW[2], accA[2], accV = (f32x4){0.f, 0.f, 0.f, 0.f};
#pragma unroll
                for (int q = 0; q < 2; ++q) { const int nt = chh * 2 + q; accW[q] = (f32x4){0.f, 0.f, 0.f, 0.f}; accA[q] = (f32x4){0.f, 0.f, 0.f, 0.f};
#pragma unroll
                    for (int ks = 0; ks < 2; ++ks) { const bf16x8 bw = *(const bf16x8*)(w2T + (nt * 16 + fr) * 72 + ks * 32 + fq * 8), ba = *(const bf16x8*)(a2T + (nt * 16 + fr) * 72 + ks * 32 + fq * 8);
                        accW[q] = __builtin_amdgcn_mfma_f32_16x16x32_bf16(bw, AfW[ks], accW[q], 0, 0, 0); accA[q] = __builtin_amdgcn_mfma_f32_16x16x32_bf16(ba, AfA[ks], accA[q], 0, 0, 0); } }
                if (l > 0) { const bf16x8 bv = *(const bf16x8*)(v2T + (vnt * 16 + fr) * 40 + fq * 8); accV = __builtin_amdgcn_mfma_f32_16x16x32_bf16(bv, __builtin_bit_cast(bf16x8, cr_.vl), accV, 0, 0, 0); }
                float ss = 0.f, rk = 0.f;
#pragma unroll
                for (int q = 0; q < 2; ++q) { const int ch0 = (chh * 2 + q) * 16 + fq * 4;
                    const float fr_[4] = {bflo(cr_.cr[q].x), bfhi(cr_.cr[q].x), bflo(cr_.cr[q].y), bfhi(cr_.cr[q].y)}, fpr[4] = {bflo(cr_.pr[q].x), bfhi(cr_.pr[q].x), bflo(cr_.pr[q].y), bfhi(cr_.pr[q].y)};
                    const float fk_[4] = {bflo(cr_.ck[q].x), bfhi(cr_.ck[q].x), bflo(cr_.ck[q].y), bfhi(cr_.ck[q].y)}, fpk[4] = {bflo(cr_.pk[q].x), bfhi(cr_.pk[q].x), bflo(cr_.pk[q].y), bfhi(cr_.pk[q].y)};
                    const f32x4 mur = *(const f32x4*)(cst + ch0), muk = *(const f32x4*)(cst + 64 + ch0), w0v = *(const f32x4*)(cst + 192 + ch0), a0v = *(const f32x4*)(cst + 256 + ch0),
                        kkv = *(const f32x4*)(cst + 384 + ch0), kav = *(const f32x4*)(cst + 448 + ch0), rkv = *(const f32x4*)(cst + 512 + ch0);
                    f32x4 ro, wo, ko, ao, bo;
#pragma unroll
                    for (int e = 0; e < 4; ++e) {
                        const float r = fr_[e] + mur[e] * (fpr[e] - fr_[e]), k = fk_[e] + muk[e] * (fpk[e] - fk_[e]);
                        wo[e] = __expf(-0.60653065971f * sigmoidf_(w0v[e] + accW[q][e]));
                        const float a = sigmoidf_(a0v[e] + accA[q][e]);
                        const float kq = k * kkv[e]; ss += kq * kq; ao[e] = -kq; bo[e] = kq * a;
                        const float km = k * (1.0f + (a - 1.0f) * kav[e]); rk += r * km * rkv[e]; ro[e] = r; ko[e] = km; }
                    *(f32x4*)(sR + tt * RS + ch0) = ro; *(f32x4*)(sW + tt * RS + ch0) = wo; *(f32x4*)(sK + tt * RS + ch0) = ko; *(f32x4*)(sA + tt * RS + ch0) = ao; *(f32x4*)(sB + tt * RS + ch0) = bo; }
                ss += __shfl_xor(ss, 16); ss += __shfl_xor(ss, 32); rk += __shfl_xor(rk, 16); rk += __shfl_xor(rk, 32);
                if (fq == 0) { sS[tt * 2 + chh] = ss; if (half == 0) p.rkbuf[(size_t)((b * 16 + h) * 2 + chh) * SEQ + (c + 1) * TC + tt] = rk; }
                { const int ch0 = vnt * 16 + fq * 4, cb = h * 64 + ch0;
                  const float fv_[4] = {bflo(cr_.cv.x), bfhi(cr_.cv.x), bflo(cr_.cv.y), bfhi(cr_.cv.y)}, fpv[4] = {bflo(cr_.pv.x), bfhi(cr_.pv.x), bflo(cr_.pv.y), bfhi(cr_.pv.y)};
                  const f32x4 muv = *(const f32x4*)(cst + 128 + ch0), v0v = *(const f32x4*)(cst + 320 + ch0);
                  f32x4 vo;
#pragma unroll
                  for (int e = 0; e < 4; ++e) vo[e] = fv_[e] + muv[e] * (fpv[e] - fv_[e]);
                  if (l > 0) { const float vfv[4] = {bflo(cr_.vf.x), bfhi(cr_.vf.x), bflo(cr_.vf.y), bfhi(cr_.vf.y)};
#pragma unroll
                      for (int e = 0; e < 4; ++e) vo[e] = vo[e] + (vfv[e] - vo[e]) * sigmoidf_(v0v[e] + accV[e]); }
                  u32x2 w; w.x = cvt_pk_bf16(vo[0], vo[1]); w.y = cvt_pk_bf16(vo[2], vo[3]); *(u32x2*)(p.vf + tok * DM + cb) = w;
                  *(f32x4*)(sV + tt * 32 + chh * 16 + fq * 4) = vo; }
            }
            if (wid < 4 && c >= 0 && !(mode & 1)) {
                const float* B_ = buf0 + (c & 1) * BUFSZ;
                const float* sR = B_; const float* sW = sR + TC * RS; const float* sK = sW + TC * RS; const float* sA = sK + TC * RS; const float* sB = sA + TC * RS; const float* sV = sB + TC * RS; const float* sS = sV + TC * 32;
                float* yp = ypart + wid * (TC * 64) + lane; float* sIw = sI + wid * TC;
                if (lane < TC) { const f32x2 ps = *(const f32x2*)(sS + lane * 2); sIw[lane] = __builtin_amdgcn_rcpf(fmaxf(ps.x + ps.y, 1e-24f)); }
                f32x4 A0, A1, W0, W1, B0, B1, K0, K1, R0, R1; float VI, IV;
#define SC_LOAD(s_) do { const int o_ = (s_) * RS + seg * 8; \
                    A0 = *(const f32x4*)(sA + o_); A1 = *(const f32x4*)(sA + o_ + 4); W0 = *(const f32x4*)(sW + o_); W1 = *(const f32x4*)(sW + o_ + 4); \
                    B0 = *(const f32x4*)(sB + o_); B1 = *(const f32x4*)(sB + o_ + 4); K0 = *(const f32x4*)(sK + o_); K1 = *(const f32x4*)(sK + o_ + 4); \
                    R0 = *(const f32x4*)(sR + o_); R1 = *(const f32x4*)(sR + o_ + 4); VI = sV[(s_) * 32 + si]; IV = sIw[(s_)]; } while (0)
                SC_LOAD(0);
#pragma unroll 4
                for (int s = 0; s < TC; ++s) {
                    const f32x4 a0 = A0, a1 = A1, w0 = W0, w1 = W1, b0 = B0, b1 = B1, k0 = K0, k1 = K1, r0 = R0, r1 = R1; const float vi = VI, inv2 = IV;
                    if (s + 1 < TC) SC_LOAD(s + 1);
                    __builtin_amdgcn_sched_barrier(0);
                    const f32x2 av[4] = {{a0[0], a0[1]}, {a0[2], a0[3]}, {a1[0], a1[1]}, {a1[2], a1[3]}}, wv[4] = {{w0[0], w0[1]}, {w0[2], w0[3]}, {w1[0], w1[1]}, {w1[2], w1[3]}};
                    const f32x2 bv[4] = {{b0[0], b0[1]}, {b0[2], b0[3]}, {b1[0], b1[1]}, {b1[2], b1[3]}}, kv[4] = {{k0[0], k0[1]}, {k0[2], k0[3]}, {k1[0], k1[1]}, {k1[2], k1[3]}};
                    const f32x2 rv[4] = {{r0[0], r0[1]}, {r0[2], r0[3]}, {r1[0], r1[1]}, {r1[2], r1[3]}};
                    const f32x2 vi2 = {vi, vi};
                    f32x2 vk[4];
#pragma unroll
                    for (int j = 0; j < 4; ++j) vk[j] = vi2 * kv[j];
                    const f32x2 pa = st[0] * av[0] + st[1] * av[1], pb = st[2] * av[2] + st[3] * av[3]; const f32x2 pc = pa + pb;
                    const float sa = red8(pc.x + pc.y) * inv2;
                    const f32x2 sa2 = {sa, sa};
#pragma unroll
                    for (int j = 0; j < 4; ++j) st[j] = st[j] * wv[j] + (sa2 * bv[j] + vk[j]);
                    const f32x2 qa = st[0] * rv[0] + st[1] * rv[1], qb = st[2] * rv[2] + st[3] * rv[3]; const f32x2 qc = qa + qb;
                    yp[s * 64] = qc.x + qc.y;
                }
#undef SC_LOAD
                { const int tk = lane >> 1, rq = (lane & 1) * 4; const float* yr = ypart + wid * (TC * 64) + tk * 64 + rq * 8; float yv[4];
#pragma unroll
                  for (int r_ = 0; r_ < 4; ++r_) { const f32x4 u0 = *(const f32x4*)(yr + r_ * 8), u1 = *(const f32x4*)(yr + r_ * 8 + 4); yv[r_] = ((u0[0] + u0[1]) + (u0[2] + u0[3])) + ((u1[0] + u1[1]) + (u1[2] + u1[3])); }
                  u32x2 w; w.x = cvt_pk_bf16(yv[0], yv[1]); w.y = cvt_pk_bf16(yv[2], yv[3]);
                  *(u32x2*)(p.y + ((size_t)b * SEQ + c * TC + tk) * DM + h * 64 + half * 32 + wid * 8 + rq) = w; }
            }
            __syncthreads();
        }
    }
    __syncthreads();
}

__device__ void phase_rwkv_post(int l, bf16_t* oalt) {
    const Params p = load_params();
    const int tid = opaque_tid(), l8 = tid & 7;
    const int ngrp = T_TOK * 16;
    for (int g = blockIdx.x * 64 + (tid >> 3); g < ngrp; g += gridDim.x * 64) {
        const int tok = g >> 4, h = g & 15, cb = h * 64 + l8 * 8;
        const u32x4 y4 = *(const u32x4*)(p.y + (size_t)tok * DM + cb), b4 = *(const u32x4*)(p.vf + (size_t)tok * DM + cb);
        const int bb = tok / SEQ, tq = tok % SEQ; const float rk = p.rkbuf[(size_t)((bb * 16 + h) * 2) * SEQ + tq] + p.rkbuf[(size_t)((bb * 16 + h) * 2 + 1) * SEQ + tq];
        bf16_t* zp = p.H + (size_t)tok * LDA_H + 3200 + cb; const u32x4 z4 = *(const u32x4*)zp;
        const float yv[8] = {bflo(y4.x), bfhi(y4.x), bflo(y4.y), bfhi(y4.y), bflo(y4.z), bfhi(y4.z), bflo(y4.w), bfhi(y4.w)};
        const float bv[8] = {bflo(b4.x), bfhi(b4.x), bflo(b4.y), bfhi(b4.y), bflo(b4.z), bfhi(b4.z), bflo(b4.w), bfhi(b4.w)};
        const float zv[8] = {bflo(z4.x), bfhi(z4.x), bflo(z4.y), bfhi(z4.y), bflo(z4.z), bfhi(z4.z), bflo(z4.w), bfhi(z4.w)};
        float sm = 0.f;
#pragma unroll
        for (int e = 0; e < 8; ++e) sm += yv[e];
        sm = red8(sm); const float mean = sm * (1.0f / 64.f); float d[8], vs = 0.f;
#pragma unroll
        for (int e = 0; e < 8; ++e) { d[e] = yv[e] - mean; vs += d[e] * d[e]; }
        vs = red8(vs); const float rstd = rsqrtf(vs * (1.0f / 64.f) + GN_EPS);
        const f32x4 g0 = *(const f32x4*)(p.lnx_g + l * DM + cb), g1 = *(const f32x4*)(p.lnx_g + l * DM + cb + 4), c0 = *(const f32x4*)(p.lnx_b + l * DM + cb), c1 = *(const f32x4*)(p.lnx_b + l * DM + cb + 4);
        const float gg[8] = {g0[0], g0[1], g0[2], g0[3], g1[0], g1[1], g1[2], g1[3]}, cc[8] = {c0[0], c0[1], c0[2], c0[3], c1[0], c1[1], c1[2], c1[3]};
        float o[8];
#pragma unroll
        for (int e = 0; e < 8; ++e) o[e] = (d[e] * rstd * gg[e] + cc[e] + rk * bv[e]) * siluf_(zv[e]);
        u32x4 w; w.x = cvt_pk_bf16(o[0], o[1]); w.y = cvt_pk_bf16(o[2], o[3]); w.z = cvt_pk_bf16(o[4], o[5]); w.w = cvt_pk_bf16(o[6], o[7]);
        *(u32x4*)(oalt ? oalt + (size_t)tok * DM + cb : zp) = w;
    }
}

__device__ __forceinline__ float wave_sum64(float v) {
    v = red16(v);
    const float a = __int_as_float(__builtin_amdgcn_readlane(__float_as_int(v), 0)), b = __int_as_float(__builtin_amdgcn_readlane(__float_as_int(v), 16));
    const float c = __int_as_float(__builtin_amdgcn_readlane(__float_as_int(v), 32)), d = __int_as_float(__builtin_amdgcn_readlane(__float_as_int(v), 48));
    return (a + b) + (c + d);
}
__device__ void phase_sgu(int l, unsigned char* smem, bf16_t* oalt) {
    const Params p = load_params();
    bf16_t* vnTb = (bf16_t*)smem;
    float* stat = (float*)(smem + 2 * 128 * 136 * 2);
    float* lnG = stat + 256; float* lnB = lnG + DM;
    const int tid = opaque_tid(), wid = tid >> 6, lane = tid & 63, fr = lane & 15, fq = lane >> 4;
    __syncthreads();
    for (int e = tid; e < DM; e += 512) { lnG[e] = p.sgu_ln_g[(size_t)l * DM + e]; lnB[e] = p.sgu_ln_b[(size_t)l * DM + e]; }
    for (int item = blockIdx.x; item < T_TOK / 128; item += gridDim.x) {
        bf16_t* Hb = p.H + (size_t)item * 128 * LDB_H;
        __syncthreads();
#pragma unroll
        for (int hb = 0; hb < 2; ++hb) {
            u32x4 va[8], vb[8];
#pragma unroll
            for (int q = 0; q < 8; ++q) { const bf16_t* vr = Hb + (size_t)(wid * 16 + hb * 8 + q) * LDB_H + 1024 + lane * 16; va[q] = *(const u32x4*)vr; vb[q] = *(const u32x4*)(vr + 8); }
#pragma unroll
            for (int q = 0; q < 8; ++q) {
                const float f[16] = {bflo(va[q].x), bfhi(va[q].x), bflo(va[q].y), bfhi(va[q].y), bflo(va[q].z), bfhi(va[q].z), bflo(va[q].w), bfhi(va[q].w), bflo(vb[q].x), bfhi(vb[q].x), bflo(vb[q].y), bfhi(vb[q].y), bflo(vb[q].z), bfhi(vb[q].z), bflo(vb[q].w), bfhi(vb[q].w)};
                float sm = 0.f, sq = 0.f;
#pragma unroll
                for (int e = 0; e < 16; ++e) { sm += f[e]; sq += f[e] * f[e]; }
                sm = wave_sum64(sm); sq = wave_sum64(sq);
                const float mean = sm * (1.0f / DM), var = fmaxf(sq * (1.0f / DM) - mean * mean, 0.f);
                if (lane == 0) { const int s = wid * 16 + hb * 8 + q; stat[s * 2] = mean; stat[s * 2 + 1] = rsqrtf(var + EPS); } }
        }
        __syncthreads();
        const int trow = wid * 16 + fr; bf16_t* hr = Hb + (size_t)trow * LDB_H;
        const int nks = (wid < 4) ? 2 : 4;
        for (int g = 0; g < 8; ++g) {
            bf16_t* vnT = vnTb + (g & 1) * (128 * 136);
            const int s = tid >> 2, c0 = (tid & 3) * 32;
            const bf16_t* vr = Hb + (size_t)s * LDB_H + 1024 + g * 128 + c0;
            u32x4 vv[4];
#pragma unroll
            for (int q = 0; q < 4; ++q) vv[q] = *(const u32x4*)(vr + q * 8);
            const float* Wg = p.sgu_w + (((size_t)l * 8 + g) * 128 + trow) * 128;
            f32x4 wa[4], wb[4];
#pragma unroll
            for (int ks = 0; ks < 4; ++ks) if (ks < nks) { wa[ks] = *(const f32x4*)(Wg + ks * 32 + fq * 8); wb[ks] = *(const f32x4*)(Wg + ks * 32 + fq * 8 + 4); }
            u32x2 u2[8], z2[8];
#pragma unroll
            for (int ct = 0; ct < 8; ++ct) { const int c = g * 128 + ct * 16 + fq * 4; u2[ct] = *(const u32x2*)(hr + c); z2[ct] = *(const u32x2*)(hr + 2048 + c); }
            const float bs = p.sgu_b[((size_t)l * 8 + g) * 128 + trow];
            { const float mean = stat[s * 2], rstd = stat[s * 2 + 1];
#pragma unroll
              for (int q = 0; q < 4; ++q) { const float f[8] = {bflo(vv[q].x), bfhi(vv[q].x), bflo(vv[q].y), bfhi(vv[q].y), bflo(vv[q].z), bfhi(vv[q].z), bflo(vv[q].w), bfhi(vv[q].w)};
                  const f32x4 g0 = *(const f32x4*)(lnG + g * 128 + c0 + q * 8), g1 = *(const f32x4*)(lnG + g * 128 + c0 + q * 8 + 4), b0 = *(const f32x4*)(lnB + g * 128 + c0 + q * 8), b1 = *(const f32x4*)(lnB + g * 128 + c0 + q * 8 + 4);
                  const float gg[8] = {g0[0], g0[1], g0[2], g0[3], g1[0], g1[1], g1[2], g1[3]}, bb[8] = {b0[0], b0[1], b0[2], b0[3], b1[0], b1[1], b1[2], b1[3]};
#pragma unroll
                  for (int e = 0; e < 8; ++e) { const int c = c0 + q * 8 + e; const float a_ = rstd * gg[e]; vnT[c * 136 + s] = f2bf(f[e] * a_ + (bb[e] - mean * a_)); } } }
            __syncthreads();
            f32x4 acc[8];
#pragma unroll
            for (int i = 0; i < 8; ++i) acc[i] = (f32x4){0.f, 0.f, 0.f, 0.f};
#pragma unroll
            for (int ks = 0; ks < 4; ++ks) if (ks < nks) {
                u32x4 wp; wp.x = cvt_pk_bf16(wa[ks][0], wa[ks][1]); wp.y = cvt_pk_bf16(wa[ks][2], wa[ks][3]); wp.z = cvt_pk_bf16(wb[ks][0], wb[ks][1]); wp.w = cvt_pk_bf16(wb[ks][2], wb[ks][3]);
                const bf16x8 wfrag = __builtin_bit_cast(bf16x8, wp);
#pragma unroll
                for (int ct = 0; ct < 8; ++ct) { const bf16x8 vfrag = *(const bf16x8*)(vnT + (ct * 16 + fr) * 136 + ks * 32 + fq * 8);
                    acc[ct] = __builtin_amdgcn_mfma_f32_16x16x32_bf16(vfrag, wfrag, acc[ct], 0, 0, 0); }
            }
#pragma unroll
            for (int ct = 0; ct < 8; ++ct) { const int c = g * 128 + ct * 16 + fq * 4;
                const float uf[4] = {bflo(u2[ct].x), bfhi(u2[ct].x), bflo(u2[ct].y), bfhi(u2[ct].y)}, zf[4] = {bflo(z2[ct].x), bfhi(z2[ct].x), bflo(z2[ct].y), bfhi(z2[ct].y)};
                float o[4];
#pragma unroll
                for (int j = 0; j < 4; ++j) o[j] = uf[j] * (acc[ct][j] + bs) * siluf_(zf[j]);
                u32x2 w; w.x = cvt_pk_bf16(o[0], o[1]); w.y = cvt_pk_bf16(o[2], o[3]); *(u32x2*)(oalt ? oalt + ((size_t)item * 128 + trow) * DM + c : hr + 2048 + c) = w; }
        }
    }
    __syncthreads();
}

__device__ void phase_hgrn_pre(int l, unsigned char* smem, bool dry) {
    const Params p = load_params();
    float* LF = (float*)smem;
    bf16_t* IB = (bf16_t*)(LF + 64 * 132);
    bf16_t* KB = IB + 64 * 136;
    float* psum = (float*)(KB + 64 * 136);
    float* lbs = psum + 512;
    const int tid = opaque_tid();
    bf16_t* xtra = (l == 0) ? (bf16_t*)p.out : p.vf;
    __syncthreads();
    for (int e = tid; e < DM; e += 512) { float lb = 0.f; if (l == 1) { const float l0 = p.lb_logits[e], l1 = p.lb_logits[DM + e]; lb = __builtin_amdgcn_rcpf(1.0f + __expf(l0 - l1)); } lbs[e] = lb; }
    __syncthreads();
    const int t = tid >> 3, c0 = (tid & 7) * 16;
    const int cc = tid & 127, tq = tid >> 7;
    for (int item = blockIdx.x; item < NB * 64 * 8; item += gridDim.x) {
        const int h = item & 7, ch = (item >> 3) & 63, b = item >> 9;
        const size_t r0 = (size_t)b * SEQ + ch * 64;
        bf16_t* hr = p.H + (r0 + t) * LDC_H + h * 128 + c0;
        float qv[16], kv[16];
        {
            const u32x4 q0 = *(const u32x4*)hr, q1 = *(const u32x4*)(hr + 8), f0 = *(const u32x4*)(hr + 1024), f1 = *(const u32x4*)(hr + 1032), i0 = *(const u32x4*)(hr + 2048), i1 = *(const u32x4*)(hr + 2056);
            const unsigned qa[8] = {q0.x, q0.y, q0.z, q0.w, q1.x, q1.y, q1.z, q1.w}, fa[8] = {f0.x, f0.y, f0.z, f0.w, f1.x, f1.y, f1.z, f1.w};
            *(u32x4*)(IB + t * 136 + c0) = i0; *(u32x4*)(IB + t * 136 + c0 + 8) = i1;
            float lf[16];
#pragma unroll
            for (int e = 0; e < 8; ++e) {
                const float lb0 = lbs[h * 128 + c0 + 2 * e], lb1 = lbs[h * 128 + c0 + 2 * e + 1];
                qv[2 * e] = siluf_(bflo(qa[e])); qv[2 * e + 1] = siluf_(bfhi(qa[e]));
                const float g0 = lb0 + (1.0f - lb0) * sigmoidf_(bflo(fa[e])), g1 = lb1 + (1.0f - lb1) * sigmoidf_(bfhi(fa[e]));
                kv[2 * e] = 1.0f - g0; kv[2 * e + 1] = 1.0f - g1; lf[2 * e] = __logf(g0); lf[2 * e + 1] = __logf(g1); }
#pragma unroll
            for (int e = 0; e < 4; ++e) *(f32x4*)(LF + t * 132 + c0 + e * 4) = (f32x4){lf[e * 4], lf[e * 4 + 1], lf[e * 4 + 2], lf[e * 4 + 3]};
        }
        __syncthreads();
        { float run = 0.f;
#pragma unroll
          for (int e = 0; e < 16; ++e) { run += LF[(tq * 16 + e) * 132 + cc]; LF[(tq * 16 + e) * 132 + cc] = run; }
          psum[tq * 128 + cc] = run; }
        __syncthreads();
        {
            const int tqt = t >> 4;
            unsigned qo[8], ko[8];
#pragma unroll
            for (int e4 = 0; e4 < 4; ++e4) {
                const f32x4 p0 = *(const f32x4*)(psum + c0 + e4 * 4), p1 = *(const f32x4*)(psum + 128 + c0 + e4 * 4), p2 = *(const f32x4*)(psum + 256 + c0 + e4 * 4), p3 = *(const f32x4*)(psum + 384 + c0 + e4 * 4);
                const f32x4 bl = *(const f32x4*)(LF + t * 132 + c0 + e4 * 4);
                float q2[4], k2[4];
#pragma unroll
                for (int j = 0; j < 4; ++j) {
                    const float off = (tqt > 0 ? p0[j] : 0.f) + (tqt > 1 ? p1[j] : 0.f) + (tqt > 2 ? p2[j] : 0.f);
                    const float bmid = p0[j] + p1[j], bb = bl[j] + off;
                    q2[j] = qv[e4 * 4 + j] * __expf(bb - bmid); k2[j] = kv[e4 * 4 + j] * __expf(bmid - bb); }
                qo[e4 * 2] = cvt_pk_bf16(q2[0], q2[1]); qo[e4 * 2 + 1] = cvt_pk_bf16(q2[2], q2[3]); ko[e4 * 2] = cvt_pk_bf16(k2[0], k2[1]); ko[e4 * 2 + 1] = cvt_pk_bf16(k2[2], k2[3]);
                if (t == 0) { f32x4 e1, e3;
#pragma unroll
                    for (int j = 0; j < 4; ++j) { e1[j] = __expf(p0[j] + p1[j]); e3[j] = __expf(p2[j] + p3[j]); }
                    float* gs = p.rkbuf + (size_t)(((b * 64 + ch) * 8 + h)) * 256 + c0 + e4 * 4; *(f32x4*)gs = e1; *(f32x4*)(gs + 128) = e3; }
            }
            const u32x4 qw0 = {qo[0], qo[1], qo[2], qo[3]}, qw1 = {qo[4], qo[5], qo[6], qo[7]}, kw0 = {ko[0], ko[1], ko[2], ko[3]}, kw1 = {ko[4], ko[5], ko[6], ko[7]};
            if (!dry) { *(u32x4*)hr = qw0; *(u32x4*)(hr + 8) = qw1; *(u32x4*)(hr + 1024) = kw0; *(u32x4*)(hr + 1032) = kw1; }
            *(u32x4*)(KB + t * 136 + c0) = kw0; *(u32x4*)(KB + t * 136 + c0 + 8) = kw1;
        }
        __syncthreads();
        {
            unsigned iw[8], kw[8];
#pragma unroll
            for (int e = 0; e < 8; ++e) {
                iw[e] = (unsigned)IB[(tq * 16 + 2 * e) * 136 + cc] | ((unsigned)IB[(tq * 16 + 2 * e + 1) * 136 + cc] << 16);
                kw[e] = (unsigned)KB[(tq * 16 + 2 * e) * 136 + cc] | ((unsigned)KB[(tq * 16 + 2 * e + 1) * 136 + cc] << 16); }
            bf16_t* ir = p.H + (r0 + (cc >> 1)) * LDC_H + 2048 + h * 128 + (cc & 1) * 64 + tq * 16;
            if (!dry) { *(u32x4*)ir = (u32x4){iw[0], iw[1], iw[2], iw[3]}; *(u32x4*)(ir + 8) = (u32x4){iw[4], iw[5], iw[6], iw[7]}; }
            bf16_t* kr = xtra + (r0 + (cc >> 1)) * DM + h * 128 + (cc & 1) * 64 + tq * 16;
            *(u32x4*)kr = (u32x4){kw[0], kw[1], kw[2], kw[3]}; *(u32x4*)(kr + 8) = (u32x4){kw[4], kw[5], kw[6], kw[7]};
        }
        __syncthreads();
    }
}

struct HgSet { u32x4 r[7]; };
__device__ __forceinline__ void hg_issue(HgSet& R, const bf16_t* H, const bf16_t* xtra, const float* gsc, int b, int ch, int h, int vs, int tid) {
    const size_t r0 = (size_t)b * SEQ + (size_t)ch * 64;
    const int row = tid >> 4, wi = tid & 15;
#pragma unroll
    for (int j = 0; j < 2; ++j) { const int t = j * 32 + row; R.r[j] = *(const u32x4*)(H + (r0 + t) * LDC_H + h * 128 + wi * 8); R.r[2 + j] = *(const u32x4*)(H + (r0 + t) * LDC_H + 1024 + h * 128 + wi * 8); }
#pragma unroll
    for (int j = 0; j < 2; ++j) { const int kp = j * 32 + row; R.r[4 + j] = *(const u32x4*)(xtra + (r0 + kp) * DM + h * 128 + wi * 8); }
    const u32x4 z4 = {0u, 0u, 0u, 0u}; R.r[6] = z4;
    if (tid < 256) R.r[6] = *(const u32x4*)(H + (r0 + vs * 16 + row) * LDC_H + 2048 + h * 128 + wi * 8);
    else if (tid < 320) R.r[6] = *(const u32x4*)(gsc + (size_t)(((b * 64 + ch) * 8 + h)) * 256 + (tid - 256) * 4);
}
constexpr int HG_QM = 0, HG_KM = 16 * 65 * 16, HG_KT = 2 * 16 * 65 * 16, HG_IT = HG_KT + 8 * 129 * 16, HG_E = HG_IT + 8 * 33 * 16, HG_BUF = HG_E + 1024;
__device__ __forceinline__ void hg_stage(const HgSet& R, unsigned char* B, int tid) {
    const int row = tid >> 4, wi = tid & 15;
#pragma unroll
    for (int j = 0; j < 2; ++j) { const int t = j * 32 + row; *(u32x4*)(B + HG_QM + (wi * 65 + t) * 16) = R.r[j]; *(u32x4*)(B + HG_KM + (wi * 65 + t) * 16) = R.r[2 + j]; }
#pragma unroll
    for (int j = 0; j < 2; ++j) { const int k = (j * 32 + row) * 2 + (wi >> 3), sc = wi & 7; *(u32x4*)(B + HG_KT + (sc * 129 + k) * 16) = R.r[4 + j]; }
    if (tid < 256) { const int vv = row * 2 + (wi >> 3), sc = wi & 7; *(u32x4*)(B + HG_IT + (sc * 33 + vv) * 16) = R.r[6]; }
    else if (tid < 320) *(u32x4*)(B + HG_E + (tid - 256) * 16) = R.r[6];
}

__device__ void phase_hgrn_seq(int l, unsigned char* smem, bool dry) {
    const Params p = load_params();
    unsigned char* img = smem;
    bf16_t* att = (bf16_t*)(smem + 2 * HG_BUF);
    bf16_t* STs = att + 64 * 72;
    const int tid = opaque_tid(), w = __builtin_amdgcn_readfirstlane(tid >> 6), lane = tid & 63, fr = lane & 15, fq = lane >> 4;
    const bf16_t* xtra = (l == 0) ? (const bf16_t*)p.out : p.vf;
    const int tt_ = w >> 1, sp = w & 1;
    for (int item = blockIdx.x; item < NB * 32; item += gridDim.x) {
        const int xc_ = item & 7, sl_ = item >> 3, vs = sl_ & 3, gi_ = (sl_ >> 2) * 8 + xc_, h = gi_ & 7, b = gi_ >> 3;
        __syncthreads();
        for (int e = tid; e < 32 * 136 / 2; e += 512) ((unsigned*)STs)[e] = 0u;
        f32x4 S[2] = {{0.f, 0.f, 0.f, 0.f}, {0.f, 0.f, 0.f, 0.f}};
        u32x2 o0 = {0u, 0u};
        HgSet R0, R1;
        hg_issue(R0, p.H, xtra, p.rkbuf, b, 0, h, vs, tid); hg_stage(R0, img, tid);
        hg_issue(R1, p.H, xtra, p.rkbuf, b, 1, h, vs, tid); hg_issue(R0, p.H, xtra, p.rkbuf, b, 2, h, vs, tid);
        __syncthreads();
        auto iter = [&](const int ch, HgSet& RS) {
            const size_t r0 = (size_t)b * SEQ + (size_t)ch * 64;
            const unsigned char* B = img + (ch & 1) * HG_BUF; unsigned char* Bn = img + ((ch + 1) & 1) * HG_BUF;
            bf16x8 qf[4];
#pragma unroll
            for (int ks = 0; ks < 4; ++ks) qf[ks] = *(const bf16x8*)(B + HG_QM + ((ks * 4 + fq) * 65 + tt_ * 16 + fr) * 16);
#pragma unroll
            for (int q = 0; q < 2; ++q) { const int stile = sp * 2 + q; f32x4 a = {0.f, 0.f, 0.f, 0.f};
                if (stile <= tt_) {
#pragma unroll
                    for (int ks = 0; ks < 4; ++ks) { const bf16x8 kf = *(const bf16x8*)(B + HG_KM + ((ks * 4 + fq) * 65 + stile * 16 + fr) * 16); a = __builtin_amdgcn_mfma_f32_16x16x32_bf16(qf[ks], kf, a, 0, 0, 0); } }
#pragma unroll
                for (int j = 0; j < 4; ++j) { const int t = tt_ * 16 + fq * 4 + j, s = stile * 16 + fr; att[t * 72 + s] = f2bf(s <= t ? a[j] : 0.f); } }
            if (ch + 1 < 64) hg_stage(RS, Bn, tid);
            if (ch + 3 < 64) hg_issue(RS, p.H, xtra, p.rkbuf, b, ch + 3, h, vs, tid);
            __syncthreads();
            f32x4 o = {0.f, 0.f, 0.f, 0.f};
#pragma unroll
            for (int ks = 0; ks < 2; ++ks) { const bf16x8 af = *(const bf16x8*)(att + (tt_ * 16 + fr) * 72 + ks * 32 + fq * 8); const bf16x8 itf = *(const bf16x8*)(B + HG_IT + ((ks * 4 + fq) * 33 + sp * 16 + fr) * 16);
                o = __builtin_amdgcn_mfma_f32_16x16x32_bf16(itf, af, o, 0, 0, 0); }
#pragma unroll
            for (int ks = 0; ks < 4; ++ks) { const bf16x8 sf = *(const bf16x8*)(STs + (sp * 16 + fr) * 136 + ks * 32 + fq * 8);
                o = __builtin_amdgcn_mfma_f32_16x16x32_bf16(sf, qf[ks], o, 0, 0, 0); }
            { u32x2 ow; ow.x = cvt_pk_bf16(o[0], o[1]); ow.y = cvt_pk_bf16(o[2], o[3]);
              if (ch == 0) o0 = ow;
              else if (!dry) { const int t = tt_ * 16 + fr; *(u32x2*)(p.H + (r0 - 64 + vs * 16 + (t >> 2)) * LDC_H + 2048 + h * 128 + (t & 3) * 32 + sp * 16 + fq * 4) = ow; } }
            const f32x4 e1 = *(const f32x4*)(B + HG_E + (w * 16 + fq * 4) * 4), e3 = *(const f32x4*)(B + HG_E + 512 + (w * 16 + fq * 4) * 4);
            bf16x8 ktf[2];
#pragma unroll
            for (int ks = 0; ks < 2; ++ks) ktf[ks] = *(const bf16x8*)(B + HG_KT + ((ks * 4 + fq) * 129 + w * 16 + fr) * 16);
#pragma unroll
            for (int vt = 0; vt < 2; ++vt) { f32x4 u = {0.f, 0.f, 0.f, 0.f};
#pragma unroll
                for (int ks = 0; ks < 2; ++ks) { const bf16x8 itf = *(const bf16x8*)(B + HG_IT + ((ks * 4 + fq) * 33 + vt * 16 + fr) * 16); u = __builtin_amdgcn_mfma_f32_16x16x32_bf16(ktf[ks], itf, u, 0, 0, 0); }
#pragma unroll
                for (int j = 0; j < 4; ++j) S[vt][j] = e3[j] * (e1[j] * S[vt][j] + u[j]); }
            __syncthreads();
            if (ch + 1 < 64) { const f32x4 e1n = *(const f32x4*)(Bn + HG_E + (w * 16 + fq * 4) * 4);
#pragma unroll
                for (int vt = 0; vt < 2; ++vt) { u32x2 sw; sw.x = cvt_pk_bf16(S[vt][0] * e1n[0], S[vt][1] * e1n[1]); sw.y = cvt_pk_bf16(S[vt][2] * e1n[2], S[vt][3] * e1n[3]);
                    *(u32x2*)(STs + (vt * 16 + fr) * 136 + w * 16 + fq * 4) = sw; } }
        };
        for (int ch = 0; ch < 64; ch += 2) { iter(ch, R1); iter(ch + 1, R0); }
        if (!dry) { const int t = tt_ * 16 + fr; *(u32x2*)(p.H + ((size_t)b * SEQ + 63 * 64 + vs * 16 + (t >> 2)) * LDC_H + 2048 + h * 128 + (t & 3) * 32 + sp * 16 + fq * 4) = o0; }
    }
    __syncthreads();
}

__device__ void phase_hgrn_post(int l) {
    const Params p = load_params();
    const int tid = opaque_tid(), l8 = tid & 7;
    const int ngrp = T_TOK * 8;
    for (int g = blockIdx.x * 64 + (tid >> 3); g < ngrp; g += gridDim.x * 64) {
        const int tok = g >> 3, h = g & 7, b = tok / SEQ, tin = tok % SEQ, ch = tin >> 6, t = tin & 63, slot = (ch + 63) & 63, vs = l8 >> 1, vv0 = (l8 & 1) * 16;
        const bf16_t* op = p.H + ((size_t)b * SEQ + slot * 64 + vs * 16 + (t >> 2)) * LDC_H + 2048 + h * 128 + (t & 3) * 32 + vv0;
        bf16_t* zp = p.H + (size_t)tok * LDC_H + 3072 + h * 128 + l8 * 16;
        const u32x4 a0 = *(const u32x4*)op, a1 = *(const u32x4*)(op + 8), z0 = *(const u32x4*)zp, z1 = *(const u32x4*)(zp + 8);
        const float ov[16] = {bflo(a0.x), bfhi(a0.x), bflo(a0.y), bfhi(a0.y), bflo(a0.z), bfhi(a0.z), bflo(a0.w), bfhi(a0.w), bflo(a1.x), bfhi(a1.x), bflo(a1.y), bfhi(a1.y), bflo(a1.z), bfhi(a1.z), bflo(a1.w), bfhi(a1.w)};
        const float zf[16] = {bflo(z0.x), bfhi(z0.x), bflo(z0.y), bfhi(z0.y), bflo(z0.z), bfhi(z0.z), bflo(z0.w), bfhi(z0.w), bflo(z1.x), bfhi(z1.x), bflo(z1.y), bfhi(z1.y), bflo(z1.z), bfhi(z1.z), bflo(z1.w), bfhi(z1.w)};
        float ss = 0.f;
#pragma unroll
        for (int e = 0; e < 16; ++e) ss += ov[e] * ov[e];
        ss = red8(ss); const float rinv = rsqrtf(ss * (1.0f / 128.f) + EPS);
        const float* gn = p.hgrn_g + (size_t)l * DM + h * 128 + l8 * 16;
        float r[16];
#pragma unroll
        for (int e = 0; e < 16; ++e) r[e] = ov[e] * rinv * gn[e] * siluf_(zf[e]);
        u32x4 w0, w1; w0.x = cvt_pk_bf16(r[0], r[1]); w0.y = cvt_pk_bf16(r[2], r[3]); w0.z = cvt_pk_bf16(r[4], r[5]); w0.w = cvt_pk_bf16(r[6], r[7]);
        w1.x = cvt_pk_bf16(r[8], r[9]); w1.y = cvt_pk_bf16(r[10], r[11]); w1.z = cvt_pk_bf16(r[12], r[13]); w1.w = cvt_pk_bf16(r[14], r[15]);
        *(u32x4*)zp = w0; *(u32x4*)(zp + 8) = w1;
    }
}


#define XB_TMO      128
#define XB_XCNT(j)  (256  + 64 * (j))
#define XB_XSUB(j)  (1280 + 64 * (j))
#define XB_XGEN(j)  (2304 + 64 * (j))
#define XB_TOP      3328
#define XB_TOPGEN   3392
#define XCD_BAR_WORDS 3456
#define XB_SPIN_CAP (1u << 18)
__device__ __forceinline__ unsigned xb_ld(unsigned* p)              { return __hip_atomic_load(p, __ATOMIC_RELAXED, __HIP_MEMORY_SCOPE_AGENT); }
__device__ __forceinline__ unsigned xb_add(unsigned* p, unsigned v) { return __hip_atomic_fetch_add(p, v, __ATOMIC_RELAXED, __HIP_MEMORY_SCOPE_AGENT); }
__device__ __forceinline__ unsigned xb_xcc_id() { return (unsigned)__builtin_amdgcn_s_getreg((3 << 11) | 20) & 0xFu; }
#define XB_SPIN(cond, bar) do { unsigned _sp = 0; while (cond) { __builtin_amdgcn_s_sleep(1); \
    if ((++_sp & 255u) == 0u) { if (xb_ld(&(bar)[XB_TMO])) break; if (_sp > XB_SPIN_CAP) { atomicAdd(&(bar)[XB_TMO], 1u); break; } } } } while (0)
struct XcdBarrier { unsigned* bar; unsigned x; volatile LAS unsigned* st; };
__device__ __forceinline__ XcdBarrier xcd_barrier_post(unsigned* bar, volatile LAS unsigned* st) {
    XcdBarrier b; b.bar = bar; b.x = xb_xcc_id(); b.st = st;
    if (threadIdx.x == 0) (void)xb_add(&bar[XB_XCNT(b.x)], 1u);
    return b;
}
__device__ __forceinline__ void xcd_barrier_complete(unsigned* bar, unsigned x, unsigned& nloc, unsigned& nx) {
    const unsigned G = gridDim.x * gridDim.y * gridDim.z;
    unsigned sum, cnt, mine, sp = 0u;
    for (;;) {
        sum = 0u; cnt = 0u; mine = 0u;
#pragma unroll
        for (unsigned j = 0; j < 16; ++j) { const unsigned c = xb_ld(&bar[XB_XCNT(j)]); sum += c; cnt += (c > 0u) ? 1u : 0u; mine = (j == x) ? c : mine; }
        if (sum == G) break;
        __builtin_amdgcn_s_sleep(1);
        if ((++sp & 255u) == 0u) { if (xb_ld(&bar[XB_TMO])) break; if (sp > XB_SPIN_CAP) { atomicAdd(&bar[XB_TMO], 1u); break; } }
    }
    nloc = mine > 0u ? mine : 1u; nx = cnt > 0u ? cnt : 1u;
}
__device__ __forceinline__ void xcd_barrier(const XcdBarrier& b) {
    asm volatile("s_waitcnt vmcnt(0)" ::: "memory");
    __syncthreads();
    if (threadIdx.x == 0) {
        unsigned* bar = b.bar;
        __builtin_amdgcn_s_waitcnt(0);
        unsigned nloc = b.st[0], nx = b.st[1];
        if (nloc == 0u) { xcd_barrier_complete(bar, b.x, nloc, nx); b.st[0] = nloc; b.st[1] = nx; }
        const unsigned old = xb_add(&bar[XB_XSUB(b.x)], 1u);
        const unsigned gen = old / nloc;
        if (old + 1u == (gen + 1u) * nloc) {
            __builtin_amdgcn_fence(__ATOMIC_RELEASE, "agent");
            asm volatile("s_waitcnt vmcnt(0)" ::: "memory");
            const unsigned og = xb_add(&bar[XB_TOP], 1u);
            const unsigned tg = og / nx;
            if (og + 1u == (tg + 1u) * nx) xb_add(&bar[XB_TOPGEN], 1u);
            else XB_SPIN(xb_ld(&bar[XB_TOPGEN]) == tg, bar);
            __builtin_amdgcn_fence(__ATOMIC_ACQUIRE, "agent");
            xb_add(&bar[XB_XGEN(b.x)], 1u);
            asm volatile("s_waitcnt vmcnt(0)" ::: "memory");
        } else {
            XB_SPIN(xb_ld(&bar[XB_XGEN(b.x)]) == gen, bar);
            __builtin_amdgcn_fence(__ATOMIC_ACQUIRE, "agent");
            asm volatile("s_waitcnt vmcnt(0)" ::: "memory");
        }
    }
    __syncthreads();
}

constexpr int PH_PER_LAYER = 14, N_PHASES = 2 * PH_PER_LAYER + 1;

__global__ void __launch_bounds__(512, 2) fwd_megakernel(Params pk) {
    extern __shared__ __attribute__((aligned(16))) unsigned char shm[];
    LAS unsigned char* lds = (LAS unsigned char*)shm;
    cg::grid_group grid = cg::this_grid();
    const int phase_lo = pk.phase_lo, phase_hi = pk.phase_hi;
    volatile LAS unsigned* xst = (volatile LAS unsigned*)(lds + LDS_BYTES - 16);
    XcdBarrier xb; xb.bar = pk.bar; xb.x = 0; xb.st = xst;
    if (phase_hi - phase_lo > 1) { if (threadIdx.x == 0) { xst[0] = 0u; xst[1] = 0u; } __syncthreads(); xb = xcd_barrier_post(pk.bar, xst); }
    for (int ph = phase_lo; ph < phase_hi; ++ph) {
        const int l = ph / PH_PER_LAYER, q = ph % PH_PER_LAYER;
        if (ph == N_PHASES - 1) {
            const Params p = load_params();
            phase_rmsnorm(p.out, p.final_g, nullptr, p.out);
        } else if (q == 0) {
            { const int nrep = (PROBE_Q == 0 && l == 0) ? 2 : 1; for (int rep = 0; rep < nrep; ++rep) {
            phase_convert(l, shm);
            const Params p = load_params();
            phase_rmsnorm(l == 0 ? p.x : p.out, p.norm_g + (size_t)l * DM, p.xn, nullptr); } }
        } else if (q == 1 || q == 5 || q == 8) {
            const Params p = load_params(); const int G = gridDim.x, cidx = opaque_bid();
            const int N = (q == 1) ? LDA_H : (q == 5) ? LDB_H : LDC_H; const int r0 = (q == 1) ? 0 : (q == 5) ? LDA_H : (LDA_H + LDB_H);
            pg8::GemmDesc g; g.A = p.xn; g.Bt = p.Wt + (size_t)r0 * DM; g.lda = DM;
            pg8::Sched S; S.init(T_TOK, N, G, cidx, 1);
            pg8::EpiStore E; E.O = p.H; E.ldc = N;
{ const int nrep = ((PROBE_Q == 1 && l == 0 && q == 1) || (PROBE_Q == 50 && l == 0 && q == 5) || (PROBE_Q == 80 && l == 0 && q == 8)) ? 2 : 1; for (int rep = 0; rep < nrep; ++rep) pg8::gemm_phase(lds, g, g, S, E); }
        } else if (q == 2) {
{ const int nrep = (PROBE_Q == 2 && l == 0) ? 2 : 1; for (int rep = 0; rep < nrep; ++rep) phase_rwkv(l, shm, rep + 1 < nrep ? PROBE_MODE : 0); }
        } else if (q == 3) {
            phase_rwkv_post(l, nullptr);
        } else if (q == 6) {
{ const int nrep = (PROBE_Q == 6 && l == 0) ? 2 : 1; for (int rep = 0; rep < nrep; ++rep) { const Params p = load_params(); phase_sgu(l, shm, rep + 1 < nrep ? (bf16_t*)p.out : nullptr); } }
        } else if (q == 9) {
            { const int nrep = (PROBE_Q == 9 && l == 0) ? 2 : 1; for (int rep = 0; rep < nrep; ++rep) phase_hgrn_pre(l, shm, rep + 1 < nrep); }
        } else if (q == 10) {
            { const int nrep = (PROBE_Q == 10 && l == 0) ? 2 : 1; for (int rep = 0; rep < nrep; ++rep) phase_hgrn_seq(l, shm, rep + 1 < nrep); }
        } else if (q == 11) {
            phase_hgrn_post(l);
        } else if (q == 4 || q == 7 || q == 12) {
            const Params p = load_params(); const int G = gridDim.x, cidx = opaque_bid();
            bf16_t* WtBr = p.Wt + (size_t)WT_ROWS * DM;
            const int n = (q == 4) ? 0 : (q == 7) ? 1 : 2; const int ldh = (n == 0) ? LDA_H : (n == 1) ? LDB_H : LDC_H; const int ocol = (n == 0) ? 3200 : (n == 1) ? 2048 : 3072;
            pg8::GemmDesc g0, g1; g0.A = p.xn; g0.Bt = p.Wt + (size_t)(LDA_H + LDB_H + LDC_H + n * DM) * DM; g0.lda = DM;
            g1.A = p.H + ocol; g1.Bt = WtBr + (size_t)n * DM * DM; g1.lda = ldh;
            pg8::Sched S; S.init(T_TOK, DM, G, cidx, 2);
            pg8::EpiMerge E; E.G = p.H; E.ldg = ldh; E.bias = p.b_merge + ((size_t)l * 3 + n) * DM; E.Y = p.y; E.accum = (n > 0);
            { const int nrep = (PROBE_Q == 4 && l == 0 && q == 4) ? 2 : 1; for (int rep = 0; rep < nrep; ++rep) pg8::gemm_phase(lds, g0, g1, S, E); }
        } else {
            const Params p = load_params(); const int G = gridDim.x, cidx = opaque_bid();
            bf16_t* WtOut = p.Wt + (size_t)WT_ROWS * DM + (size_t)3 * DM * DM;
            pg8::GemmDesc g; g.A = p.y; g.Bt = WtOut; g.lda = DM;
            pg8::Sched S; S.init(T_TOK, DM, G, cidx, 1);
            pg8::EpiResid E; E.Xin = (l == 0) ? p.x : p.out; E.Xout = p.out;
            { const int nrep = (PROBE_Q == 13 && l == 0) ? 2 : 1; for (int rep = 0; rep < nrep; ++rep) pg8::gemm_phase(lds, g, g, S, E); }
        }
        if (ph + 1 < phase_hi) { if (ph == phase_lo) grid.sync(); else xcd_barrier(xb); }
    }
}

extern "C" void kernel_launch(void* const* d_in, const int* in_sizes, int n_in, void* d_out, int out_size, void* d_ws, size_t ws_size, hipStream_t stream) {
    static int grid_blocks = 0;
    if (!grid_blocks) {
        int dev = 0, cus = 0, per_cu = 0;
        hipGetDevice(&dev);
        hipDeviceGetAttribute(&cus, hipDeviceAttributeMultiprocessorCount, dev);
        if (hipFuncSetAttribute((const void*)fwd_megakernel, hipFuncAttributeMaxDynamicSharedMemorySize, LDS_BYTES) != hipSuccess) { fprintf(stderr, "hipFuncSetAttribute failed\n"); return; }
        hipOccupancyMaxActiveBlocksPerMultiprocessor(&per_cu, (const void*)fwd_megakernel, 512, LDS_BYTES);
        if (per_cu < 1) { fprintf(stderr, "occupancy query says 0 blocks per CU\n"); return; }
        grid_blocks = cus * 1;
    }
    Params p{};
    const float** fp = (const float**)&p;
    for (int i = 0; i < 26; ++i) fp[i] = (const float*)d_in[i];
    p.out = (float*)d_out;
    unsigned char* ws = (unsigned char*)d_ws; size_t off = 0;
    auto take = [&](size_t bytes) { unsigned char* r = ws + off; off += (bytes + 255) & ~(size_t)255; return r; };
    p.Wt = (bf16_t*)take(((size_t)WT_ROWS * DM + 4 * (size_t)DM * DM) * 2);
    p.xn = (bf16_t*)take((size_t)T_TOK * DM * 2);
    p.vf = (bf16_t*)take((size_t)T_TOK * DM * 2);
    p.y = (bf16_t*)take((size_t)T_TOK * DM * 2);
    p.H = (bf16_t*)take((size_t)T_TOK * LDA_H * 2);
    p.rkbuf = (float*)take((size_t)T_TOK * 16 * 2 * 4);
    p.bar = (unsigned*)take((size_t)XCD_BAR_WORDS * 4);
    if (off > ws_size) { fprintf(stderr, "workspace too small: need %zu have %zu\n", off, ws_size); return; }
#if SINGLE_LAUNCH
    p.phase_lo = 0; p.phase_hi = N_PHASES;
    void* args[] = {&p};
    if (hipMemsetAsync(p.bar, 0, (size_t)XCD_BAR_WORDS * 4, stream) != hipSuccess) { fprintf(stderr, "memset failed\n"); return; }
    hipError_t e = hipLaunchCooperativeKernel((const void*)fwd_megakernel, dim3(grid_blocks), dim3(512), args, LDS_BYTES, stream);
    if (e != hipSuccess) fprintf(stderr, "cooperative launch failed: %s (grid %d)\n", hipGetErrorString(e), grid_blocks);
#else
    for (int ph = 0; ph < N_PHASES; ++ph) {
        p.phase_lo = ph; p.phase_hi = ph + 1;
        hipLaunchKernelGGL(fwd_megakernel, dim3(grid_blocks), dim3(512), LDS_BYTES, stream, p);
    }
#endif
}
```

```cpp
#include <hip/hip_runtime.h>
#include <hip/hip_cooperative_groups.h>
#include <cstdio>
namespace cg = cooperative_groups;

#ifndef PROBE_MODE
#define PROBE_MODE 0
#endif
#ifndef PROBE_Q
#define PROBE_Q -1
#endif
#ifndef SINGLE_LAUNCH
#define SINGLE_LAUNCH 1
#endif

typedef unsigned short bf16_t;
typedef short bf16x8 __attribute__((ext_vector_type(8)));
typedef float f32x4 __attribute__((ext_vector_type(4)));
typedef float f32x2 __attribute__((ext_vector_type(2)));
typedef unsigned u32x4 __attribute__((ext_vector_type(4)));
typedef unsigned u32x2 __attribute__((ext_vector_type(2)));
#define LAS __attribute__((address_space(3)))

constexpr int T_TOK = 32768, DM = 1024, SEQ = 4096, NB = 8;
constexpr int N_IN = 14464;
constexpr int LDA_H = 4352, LDB_H = 3072, LDC_H = 4096;
constexpr int WT_ROWS = 14592;
constexpr int LDS_BYTES = 163840;
constexpr float EPS = 1e-6f, GN_EPS = 64e-5f;

struct Params {
    const float *x, *norm_g, *w_in, *b_merge, *mu, *w0, *w_w2, *a0, *a_w2, *v0, *v_w1, *v_w2, *k_k, *k_a, *r_k, *lnx_g, *lnx_b,
        *sgu_ln_g, *sgu_ln_b, *sgu_w, *sgu_b, *lb_logits, *hgrn_g, *w_branch, *w_out, *final_g;
    float* out;
    bf16_t *Wt, *xn, *vf, *y, *H;
    float* rkbuf;
    unsigned* bar;
    int phase_lo, phase_hi;
};

__device__ __forceinline__ float bf2f(bf16_t h) { return __uint_as_float(((unsigned)h) << 16); }
__device__ __forceinline__ float bflo(unsigned u) { return __uint_as_float(u << 16); }
__device__ __forceinline__ float bfhi(unsigned u) { return __uint_as_float(u & 0xffff0000u); }
typedef __bf16 bf16x2_t __attribute__((ext_vector_type(2)));
__device__ __forceinline__ unsigned cvt_pk_bf16(float lo, float hi) { const f32x2 v = {lo, hi}; const bf16x2_t r = __builtin_convertvector(v, bf16x2_t); return __builtin_bit_cast(unsigned, r); }
__device__ __forceinline__ bf16_t f2bf(float f) { return (bf16_t)(cvt_pk_bf16(f, 0.f) & 0xffffu); }
__device__ __forceinline__ float sigmoidf_(float x) { return __builtin_amdgcn_rcpf(1.0f + __expf(-x)); }
__device__ __forceinline__ float siluf_(float x) { return x * __builtin_amdgcn_rcpf(1.0f + __expf(-x)); }
__device__ __forceinline__ float tanh_fast(float x) { return 1.0f - 2.0f * __builtin_amdgcn_rcpf(1.0f + __expf(2.0f * x)); }

__device__ __forceinline__ Params load_params() {
#if defined(__HIP_DEVICE_COMPILE__)
    typedef const Params __attribute__((address_space(4)))* KP;
    KP kp = (KP)__builtin_amdgcn_kernarg_segment_ptr(); asm volatile("" : "+s"(kp)); return *kp;
#else
    return Params{};
#endif
}
__device__ __forceinline__ int opaque_tid() { int t = threadIdx.x; asm volatile("" : "+v"(t)); return t; }
__device__ __forceinline__ int opaque_bid() { int t = blockIdx.x; asm volatile("" : "+s"(t)); return t; }

namespace pg8 {
constexpr int BM = 256, BK = 64, HALF = 128, HTB = HALF * BK * 2, STAGE_BYTES = 8 * HTB, NXCD = 8, WGM = 8, KD = 1024;
__device__ __forceinline__ int lds_byte(int r, int c) { const int st = (r >> 4) * 2 + (c >> 5), rr = r & 15, cc = c & 31, ob = rr * 64 + cc * 2; return st * 1024 + (ob ^ (((ob >> 9) & 1) << 5)); }
__device__ __forceinline__ void stage_rc(int b, int& R, int& C) { const int st = b / 1024, sb = b % 1024, swz = sb ^ (((sb >> 9) & 1) << 5); R = (st >> 1) * 16 + swz / 64; C = (st & 1) * 32 + (swz % 64) / 2; }
__device__ __forceinline__ int perm32(int rho) { const int n = rho >> 4, i = rho & 15; return 8 * (i >> 2) + 4 * n + (i & 3); }

struct Unit { int pm, pn, sel; };
struct GemmDesc { const bf16_t* A; const bf16_t* Bt; int lda; };
struct Sched {
    int nM, nN, nwg, G, c, nsel;
    __device__ void init(int M, int N, int G_, int c_, int nsel_) { nM = M / BM; nN = N / BM; nwg = nM * nN; G = G_; c = c_; nsel = nsel_; }
    __device__ bool next(int i, Unit& u) const {
        const int ti = (nsel == 2) ? (i >> 1) : i; u.sel = (nsel == 2) ? (i & 1) : 0;
        const long L = (long)ti * G + c; if (L >= nwg) return false;
        int wgid = (int)L; { const int q = nwg / NXCD, r = nwg % NXCD, xcd = wgid % NXCD, off = wgid / NXCD; wgid = (xcd < r ? xcd * (q + 1) : r * (q + 1) + (xcd - r) * q) + off; }
        const int nig = WGM * nN, gid = wgid / nig, fm = gid * WGM, gsz = (nM - fm) < WGM ? (nM - fm) : WGM;
        u.pm = fm + ((wgid % nig) % gsz); u.pn = (wgid % nig) / gsz; return true;
    }
};

template <class Epi>
__device__ __forceinline__ void gemm_phase(LAS unsigned char* lds, const GemmDesc g0, const GemmDesc g1, const Sched& S, const Epi& E) {
    const int tid = opaque_tid(), wid = __builtin_amdgcn_readfirstlane(tid >> 6), lane = tid & 63, wr = wid >> 2, wc = wid & 3, fr = lane & 15, fq = lane >> 4;
    constexpr int K = KD, nt = K / BK;
    unsigned voffA0[2], voffA1[2], voffB[2];
#pragma unroll
    for (int i = 0; i < 2; ++i) { int R, C; stage_rc(tid * 16 + i * 8192, R, C); const int Rb = Epi::PERM ? ((R & ~31) + perm32(R & 31)) : R;
        voffA0[i] = (unsigned)(R * g0.lda + C) * 2u; voffA1[i] = (unsigned)(R * g1.lda + C) * 2u; voffB[i] = (unsigned)(Rb * K + C) * 2u; }
    const size_t kstep = (size_t)(BK * 2);
    const size_t hstepB = (size_t)HALF * K * 2;
    const unsigned ldsw = (unsigned)wid * 1024u;
    const int aoff = lds_byte(wr * 64 + fr, fq * 8), boff = lds_byte(wc * 32 + fr, fq * 8);
#define PG8_SA(b, h) (((b) * 2 + (h)) * HTB)
#define PG8_SB(b, h) ((4 + (b) * 2 + (h)) * HTB)
#define PG8_STAGE(bufoff, gbase, v0, v1) do { \
        __builtin_amdgcn_global_load_lds((const unsigned*)((const char*)(gbase) + (v0)), (LAS unsigned*)(lds + (bufoff) + ldsw), 16, 0, 0); \
        __builtin_amdgcn_global_load_lds((const unsigned*)((const char*)(gbase) + (v1)), (LAS unsigned*)(lds + (bufoff) + ldsw + 8192), 16, 0, 0); } while (0)
#define PG8_STAGEB(bufoff, gbase) PG8_STAGE(bufoff, gbase, voffB[0], voffB[1])
#define PG8_LDA(dst, b, h) do { _Pragma("unroll") for (int m = 0; m < 4; ++m) _Pragma("unroll") for (int k = 0; k < 2; ++k) dst[m][k] = *(const LAS bf16x8*)(lds + PG8_SA(b, h) + aoff + m * 2048 + k * 1024); } while (0)
#define PG8_LDB(dst, b, h) do { _Pragma("unroll") for (int n = 0; n < 2; ++n) _Pragma("unroll") for (int k = 0; k < 2; ++k) dst[n][k] = *(const LAS bf16x8*)(lds + PG8_SB(b, h) + boff + n * 2048 + k * 1024); } while (0)
#define PG8_MMA(ai, bj, At, Bt) do { __builtin_amdgcn_s_setprio(1); _Pragma("unroll") for (int m = 0; m < 4; ++m) _Pragma("unroll") for (int n = 0; n < 2; ++n) _Pragma("unroll") for (int k = 0; k < 2; ++k) \
        acc[ai][bj][m][n] = __builtin_amdgcn_mfma_f32_16x16x32_bf16(Bt[n][k], At[m][k], acc[ai][bj][m][n], 0, 0, 0); __builtin_amdgcn_s_setprio(0); } while (0)
#define PG8_WAIT_V(n) asm volatile("s_waitcnt vmcnt(" #n ")" ::: "memory")
#define PG8_WAIT_L(n) asm volatile("s_waitcnt lgkmcnt(" #n ")" ::: "memory")
#define PG8_BAR __builtin_amdgcn_s_barrier()
#define PG8_SCHED __builtin_amdgcn_sched_barrier(0)
    Unit cur, nxt; int ui = 0;
    if (!S.next(0, cur)) return;
    f32x4 acc[2][2][4][2];
#pragma unroll
    for (int a = 0; a < 2; ++a)
#pragma unroll
        for (int b = 0; b < 2; ++b)
#pragma unroll
            for (int m = 0; m < 4; ++m)
#pragma unroll
                for (int n = 0; n < 2; ++n) acc[a][b][m][n] = (f32x4){0.f, 0.f, 0.f, 0.f};
    bf16x8 At[4][2], B0[2][2], B1[2][2];
    const char* cA = (const char*)(cur.sel ? g1.A : g0.A) + (size_t)cur.pm * 256 * (size_t)(cur.sel ? g1.lda : g0.lda) * 2;
    const char* cB = (const char*)(cur.sel ? g1.Bt : g0.Bt) + (size_t)cur.pn * 256 * K * 2;
    size_t chA = (size_t)HALF * (cur.sel ? g1.lda : g0.lda) * 2;
    unsigned cv0 = cur.sel ? voffA1[0] : voffA0[0], cv1 = cur.sel ? voffA1[1] : voffA0[1];
    PG8_STAGEB(PG8_SB(0, 0), cB); PG8_STAGE(PG8_SA(0, 0), cA, cv0, cv1); PG8_STAGEB(PG8_SB(0, 1), cB + hstepB); PG8_STAGE(PG8_SA(0, 1), cA + chA, cv0, cv1);
    if (wr == 1) PG8_BAR;
    PG8_WAIT_V(4); PG8_BAR;
    PG8_STAGEB(PG8_SB(1, 0), cB + kstep); PG8_STAGE(PG8_SA(1, 0), cA + kstep, cv0, cv1); PG8_STAGEB(PG8_SB(1, 1), cB + hstepB + kstep);
    PG8_WAIT_V(6); PG8_BAR;
    for (;;) {
        const bool has_next = S.next(ui + 1, nxt);
        const int nsel = has_next ? nxt.sel : cur.sel;
        const char* nA = has_next ? (const char*)(nsel ? g1.A : g0.A) + (size_t)nxt.pm * 256 * (size_t)(nsel ? g1.lda : g0.lda) * 2 : cA;
        const char* nB = has_next ? (const char*)(nsel ? g1.Bt : g0.Bt) + (size_t)nxt.pn * 256 * K * 2 : cB;
        const size_t nhA = (size_t)HALF * (nsel ? g1.lda : g0.lda) * 2;
        const unsigned nv0 = nsel ? voffA1[0] : voffA0[0], nv1 = nsel ? voffA1[1] : voffA0[1];
        for (int t = 0; t < nt; t += 2) {
            const bool last = (t == nt - 2);
            const char* a1 = cA + (size_t)(t + 1) * kstep;
            const char* a2 = last ? nA : cA + (size_t)(t + 2) * kstep; const char* b2 = last ? nB : cB + (size_t)(t + 2) * kstep;
            const char* a3 = a2 + kstep; const char* b3 = b2 + kstep;
            const size_t h2 = last ? nhA : chA; const unsigned w0 = last ? nv0 : cv0, w1 = last ? nv1 : cv1;
            PG8_LDB(B0, 0, 0); PG8_SCHED; PG8_LDA(At, 0, 0); PG8_STAGE(PG8_SA(1, 1), a1 + chA, cv0, cv1);
            PG8_WAIT_L(8); PG8_BAR; PG8_WAIT_L(0); PG8_MMA(0, 0, At, B0); PG8_BAR; PG8_SCHED;
            PG8_LDB(B1, 0, 1); PG8_STAGEB(PG8_SB(0, 0), b2);
            PG8_BAR; PG8_WAIT_L(0); PG8_MMA(0, 1, At, B1); PG8_BAR;
            PG8_LDA(At, 0, 1); PG8_STAGE(PG8_SA(0, 0), a2, w0, w1);
            PG8_BAR; PG8_WAIT_L(0); PG8_MMA(1, 0, At, B0); PG8_BAR; PG8_SCHED;
            PG8_STAGEB(PG8_SB(0, 1), b2 + hstepB);
            PG8_WAIT_V(6); PG8_BAR; PG8_MMA(1, 1, At, B1); PG8_BAR;
            PG8_LDB(B0, 1, 0); PG8_SCHED; PG8_LDA(At, 1, 0); PG8_STAGE(PG8_SA(0, 1), a2 + h2, w0, w1);
            PG8_WAIT_L(8); PG8_BAR; PG8_WAIT_L(0); PG8_MMA(0, 0, At, B0); PG8_BAR; PG8_SCHED;
            PG8_LDB(B1, 1, 1); PG8_STAGEB(PG8_SB(1, 0), b3);
            PG8_BAR; PG8_WAIT_L(0); PG8_MMA(0, 1, At, B1); PG8_BAR;
            PG8_LDA(At, 1, 1); PG8_STAGE(PG8_SA(1, 0), a3, w0, w1);
            PG8_BAR; PG8_WAIT_L(0); PG8_MMA(1, 0, At, B0); PG8_BAR; PG8_SCHED;
            PG8_STAGEB(PG8_SB(1, 1), b3 + hstepB);
            PG8_WAIT_V(6); PG8_BAR; PG8_MMA(1, 1, At, B1); PG8_BAR;
        }
        E(acc, cur, wr, wc, fr, fq);
        if (!has_next) break;
#pragma unroll
        for (int a = 0; a < 2; ++a)
#pragma unroll
            for (int b = 0; b < 2; ++b)
#pragma unroll
                for (int m = 0; m < 4; ++m)
#pragma unroll
                    for (int n = 0; n < 2; ++n) acc[a][b][m][n] = (f32x4){0.f, 0.f, 0.f, 0.f};
        cur = nxt; cA = nA; cB = nB; chA = nhA; cv0 = nv0; cv1 = nv1; ++ui;
    }
    PG8_WAIT_V(0);
    if (wr == 0) PG8_BAR;
    PG8_BAR;
#undef PG8_SA
#undef PG8_SB
#undef PG8_STAGE
#undef PG8_STAGEB
#undef PG8_LDA
#undef PG8_LDB
#undef PG8_MMA
#undef PG8_WAIT_V
#undef PG8_WAIT_L
#undef PG8_BAR
#undef PG8_SCHED
}

struct EpiStore {
    static constexpr bool PERM = true;
    bf16_t* O; int ldc;
    __device__ __forceinline__ void operator()(const f32x4 (&acc)[2][2][4][2], const Unit& u, int wr, int wc, int fr, int fq) const {
        const int row0 = u.pm * BM + wr * 64 + fr, col0 = u.pn * BM + wc * 32 + 8 * fq;
#pragma unroll
        for (int ai = 0; ai < 2; ++ai)
#pragma unroll
            for (int m = 0; m < 4; ++m) { bf16_t* rowp = O + (size_t)(row0 + ai * HALF + m * 16) * ldc + col0;
#pragma unroll
                for (int bj = 0; bj < 2; ++bj) { const f32x4 v0 = acc[ai][bj][m][0], v1 = acc[ai][bj][m][1];
                    u32x4 w; w.x = cvt_pk_bf16(v0[0], v0[1]); w.y = cvt_pk_bf16(v0[2], v0[3]); w.z = cvt_pk_bf16(v1[0], v1[1]); w.w = cvt_pk_bf16(v1[2], v1[3]);
                    *(u32x4*)(rowp + bj * HALF) = w; } }
    }
};
struct EpiMerge {
    static constexpr bool PERM = true;
    bf16_t* G; int ldg; const float* bias; bf16_t* Y; int accum;
    __device__ __forceinline__ void operator()(const f32x4 (&acc)[2][2][4][2], const Unit& u, int wr, int wc, int fr, int fq) const {
        const int row0 = u.pm * BM + wr * 64 + fr, col0 = u.pn * BM + wc * 32 + 8 * fq;
        if (u.sel == 0) {
            f32x4 bv[2][2];
#pragma unroll
            for (int bj = 0; bj < 2; ++bj)
#pragma unroll
                for (int n = 0; n < 2; ++n) bv[bj][n] = *(const f32x4*)(bias + col0 + bj * HALF + 4 * n);
#pragma unroll
            for (int ai = 0; ai < 2; ++ai)
#pragma unroll
                for (int m = 0; m < 4; ++m) { bf16_t* rowp = G + (size_t)(row0 + ai * HALF + m * 16) * ldg + col0;
#pragma unroll
                    for (int bj = 0; bj < 2; ++bj) { f32x4 v0 = acc[ai][bj][m][0] + bv[bj][0], v1 = acc[ai][bj][m][1] + bv[bj][1];
#pragma unroll
                        for (int j = 0; j < 4; ++j) { v0[j] = sigmoidf_(v0[j]); v1[j] = sigmoidf_(v1[j]); }
                        u32x4 w; w.x = cvt_pk_bf16(v0[0], v0[1]); w.y = cvt_pk_bf16(v0[2], v0[3]); w.z = cvt_pk_bf16(v1[0], v1[1]); w.w = cvt_pk_bf16(v1[2], v1[3]);
                        *(u32x4*)(rowp + bj * HALF) = w; } }
        } else {
#pragma unroll
            for (int ai = 0; ai < 2; ++ai)
#pragma unroll
                for (int m = 0; m < 4; ++m) { const size_t r = (size_t)(row0 + ai * HALF + m * 16);
                    const unsigned long long* gp = (const unsigned long long*)(G + r * ldg + col0); bf16_t* yp = Y + r * DM + col0;
#pragma unroll
                    for (int bj = 0; bj < 2; ++bj) {
                        const unsigned long long g0 = __hip_atomic_load(gp + bj * (HALF / 4), __ATOMIC_RELAXED, __HIP_MEMORY_SCOPE_AGENT);
                        const unsigned long long g1 = __hip_atomic_load(gp + bj * (HALF / 4) + 1, __ATOMIC_RELAXED, __HIP_MEMORY_SCOPE_AGENT);
                        const unsigned gw[4] = {(unsigned)g0, (unsigned)(g0 >> 32), (unsigned)g1, (unsigned)(g1 >> 32)};
                        u32x4 yo = {0u, 0u, 0u, 0u}; if (accum) yo = *(const u32x4*)(yp + bj * HALF);
                        const f32x4 v0 = acc[ai][bj][m][0], v1 = acc[ai][bj][m][1];
                        u32x4 w;
                        w.x = cvt_pk_bf16(bflo(yo.x) + bflo(gw[0]) * v0[0], bfhi(yo.x) + bfhi(gw[0]) * v0[1]);
                        w.y = cvt_pk_bf16(bflo(yo.y) + bflo(gw[1]) * v0[2], bfhi(yo.y) + bfhi(gw[1]) * v0[3]);
                        w.z = cvt_pk_bf16(bflo(yo.z) + bflo(gw[2]) * v1[0], bfhi(yo.z) + bfhi(gw[2]) * v1[1]);
                        w.w = cvt_pk_bf16(bflo(yo.w) + bflo(gw[3]) * v1[2], bfhi(yo.w) + bfhi(gw[3]) * v1[3]);
                        *(u32x4*)(yp + bj * HALF) = w; } }
        }
    }
};
struct EpiResid {
    static constexpr bool PERM = false;
    const float* Xin; float* Xout;
    __device__ __forceinline__ void operator()(const f32x4 (&acc)[2][2][4][2], const Unit& u, int wr, int wc, int fr, int fq) const {
        const int row0 = u.pm * BM + wr * 64 + fr, col0 = u.pn * BM + wc * 32 + 4 * fq;
#pragma unroll
        for (int ai = 0; ai < 2; ++ai)
#pragma unroll
            for (int m = 0; m < 4; ++m) { const size_t ro = (size_t)(row0 + ai * HALF + m * 16) * DM + col0;
#pragma unroll
                for (int bj = 0; bj < 2; ++bj)
#pragma unroll
                    for (int n = 0; n < 2; ++n) { const f32x4 xi = *(const f32x4*)(Xin + ro + bj * HALF + n * 16); *(f32x4*)(Xout + ro + bj * HALF + n * 16) = xi + acc[ai][bj][m][n]; } }
    }
};
}

__device__ void phase_convert(int l, unsigned char* smem) {
    const Params p = load_params();
    float* tile = (float*)smem;
    const int tid = opaque_tid();
    const float* win = p.w_in + (size_t)l * DM * N_IN;
    bf16_t* WtIn = p.Wt; bf16_t* WtBr = p.Wt + (size_t)WT_ROWS * DM; bf16_t* WtOut = WtBr + (size_t)3 * DM * DM;
    const int NT_IN = WT_ROWS / 64;
    const int total = (NT_IN + 48 + 16) * 16;
    for (int it = blockIdx.x; it < total; it += gridDim.x) {
        const int ntile = it >> 4, kt = it & 15, k0 = kt * 64;
        const float* src = nullptr; int ld = 0, c0 = 0, valid = 64; bf16_t* dst;
        if (ntile < NT_IN) {
            const int n0 = ntile * 64; dst = WtIn + (size_t)n0 * DM;
            if (n0 < 4224) { src = win; ld = N_IN; c0 = n0; }
            else if (n0 < 4352) { if (n0 == 4224 && l > 0) { src = p.v_w1 + (size_t)(l - 1) * DM * 32; ld = 32; c0 = 0; valid = 32; } else { valid = 0; } }
            else { src = win; ld = N_IN; c0 = n0 - 128; }
        } else if (ntile < NT_IN + 48) {
            const int q = ntile - NT_IN, n = q >> 4, n0 = (q & 15) * 64;
            src = p.w_branch + ((size_t)l * 3 + n) * DM * DM; ld = DM; c0 = n0; dst = WtBr + ((size_t)n * DM + n0) * DM;
        } else {
            const int n0 = (ntile - NT_IN - 48) * 64; src = p.w_out + (size_t)l * DM * DM; ld = DM; c0 = n0; dst = WtOut + (size_t)n0 * DM;
        }
        __syncthreads();
        if (valid == 64) {
            const int kr = tid >> 4, nc = (tid & 15) * 4;
#pragma unroll
            for (int ps = 0; ps < 2; ++ps) { const int k = kr + ps * 32; const f32x4 v = *(const f32x4*)(src + (size_t)(k0 + k) * ld + c0 + nc);
                tile[k * 65 + nc] = v[0]; tile[k * 65 + nc + 1] = v[1]; tile[k * 65 + nc + 2] = v[2]; tile[k * 65 + nc + 3] = v[3]; }
        } else {
            for (int e = tid; e < 4096; e += 512) { const int k = e >> 6, n = e & 63; tile[k * 65 + n] = (n < valid) ? src[(size_t)(k0 + k) * ld + c0 + n] : 0.f; }
        }
        __syncthreads();
        { const int nr = tid >> 3, kc = (tid & 7) * 8; u32x4 w;
          w.x = cvt_pk_bf16(tile[(kc + 0) * 65 + nr], tile[(kc + 1) * 65 + nr]); w.y = cvt_pk_bf16(tile[(kc + 2) * 65 + nr], tile[(kc + 3) * 65 + nr]);
          w.z = cvt_pk_bf16(tile[(kc + 4) * 65 + nr], tile[(kc + 5) * 65 + nr]); w.w = cvt_pk_bf16(tile[(kc + 6) * 65 + nr], tile[(kc + 7) * 65 + nr]);
          *(u32x4*)(dst + (size_t)nr * DM + k0 + kc) = w; }
    }
    __syncthreads();
}

__device__ void phase_rmsnorm(const float* x, const float* g, bf16_t* xn, float* outf) {
    const int tid_ = opaque_tid(); const int lane = tid_ & 63, wv = tid_ >> 6;
    f32x4 gv[4];
#pragma unroll
    for (int q = 0; q < 4; ++q) gv[q] = *(const f32x4*)(g + q * 256 + lane * 4);
    for (int row = blockIdx.x * 8 + wv; row < T_TOK; row += gridDim.x * 8) {
        const float* xr = x + (size_t)row * DM; f32x4 v[4]; float ss = 0.f;
#pragma unroll
        for (int q = 0; q < 4; ++q) { v[q] = *(const f32x4*)(xr + q * 256 + lane * 4); ss += v[q][0] * v[q][0] + v[q][1] * v[q][1] + v[q][2] * v[q][2] + v[q][3] * v[q][3]; }
#pragma unroll
        for (int o = 32; o > 0; o >>= 1) ss += __shfl_xor(ss, o);
        const float rinv = rsqrtf(ss * (1.0f / DM) + EPS);
#pragma unroll
        for (int q = 0; q < 4; ++q) { const f32x4 o = v[q] * rinv * gv[q];
            if (xn) { u32x2 w; w.x = cvt_pk_bf16(o[0], o[1]); w.y = cvt_pk_bf16(o[2], o[3]); *(u32x2*)(xn + (size_t)row * DM + q * 256 + lane * 4) = w; }
            else *(f32x4*)(outf + (size_t)row * DM + q * 256 + lane * 4) = o; }
    }
}

template <int CTRL> __device__ __forceinline__ float dpp_f(float v) { return __int_as_float(__builtin_amdgcn_update_dpp(0, __float_as_int(v), CTRL, 0xf, 0xf, false)); }
__device__ __forceinline__ float red8(float v) { v += dpp_f<0xB1>(v); v += dpp_f<0x4E>(v); v += dpp_f<0x141>(v); return v; }
__device__ __forceinline__ float red16(float v) { v = red8(v); v += dpp_f<0x140>(v); return v; }

struct RwRaw { u32x4 cw[2], pw[2], ca[2], pa[2], vl; u32x2 cr[2], pr[2], ck[2], pk[2], cv, pv, vf; };
__device__ __forceinline__ void rw_load(RwRaw& R, const bf16_t* H, const bf16_t* vfp, int l, size_t tok, bool hasp, int h, int chh, int vnt, int fq) {
    const bf16_t* cur = H + tok * LDA_H; const bf16_t* prev = cur - LDA_H;
    const u32x4 z4 = {0u, 0u, 0u, 0u}; const u32x2 z2 = {0u, 0u};
#pragma unroll
    for (int ks = 0; ks < 2; ++ks) { const int m0 = ks * 32 + fq * 8;
        R.cw[ks] = *(const u32x4*)(cur + 3072 + m0); R.ca[ks] = *(const u32x4*)(cur + 3136 + m0);
        R.pw[ks] = hasp ? *(const u32x4*)(prev + 3072 + m0) : z4; R.pa[ks] = hasp ? *(const u32x4*)(prev + 3136 + m0) : z4; }
#pragma unroll
    for (int q = 0; q < 2; ++q) { const int cb = h * 64 + (chh * 2 + q) * 16 + fq * 4;
        R.cr[q] = *(const u32x2*)(cur + cb); R.ck[q] = *(const u32x2*)(cur + 1024 + cb);
        R.pr[q] = hasp ? *(const u32x2*)(prev + cb) : z2; R.pk[q] = hasp ? *(const u32x2*)(prev + 1024 + cb) : z2; }
    const int cbv = h * 64 + vnt * 16 + fq * 4;
    R.cv = *(const u32x2*)(cur + 2048 + cbv); R.pv = hasp ? *(const u32x2*)(prev + 2048 + cbv) : z2;
    R.vf = z2; R.vl = z4;
    if (l > 0) { R.vf = *(const u32x2*)(vfp + tok * DM + cbv); R.vl = *(const u32x4*)(cur + 4224 + fq * 8); }
}

__device__ void phase_rwkv(int l, unsigned char* smem, int mode) {
    const Params p = load_params();
    constexpr int TC = 32, NCH = SEQ / TC, RS = 68  , BUFSZ = 5 * TC * RS + TC * 32 + TC * 2;
    bf16_t* w2T = (bf16_t*)smem;
    bf16_t* a2T = w2T + 64 * 72;
    bf16_t* v2T = a2T + 64 * 72;
    float* cst = (float*)(v2T + 64 * 40);
    float* buf0 = cst + 11 * 64;
    float* ypart = buf0 + 2 * BUFSZ;
    float* sI = ypart + 4 * TC * 64;
    const int tid = opaque_tid(), wid = __builtin_amdgcn_readfirstlane(tid >> 6), lane = tid & 63, fr = lane & 15, fq = lane >> 4;
    for (int item = blockIdx.x; item < NB * 32; item += gridDim.x) {
        const int xc_ = item & 7, sl_ = item >> 3, half = sl_ & 1, pi_ = (sl_ >> 1) * 8 + xc_, b = pi_ >> 4, h = pi_ & 15;
        __syncthreads();
        for (int e = tid; e < 4096; e += 512) { const int m = e >> 6, j = e & 63; w2T[j * 72 + m] = f2bf(p.w_w2[((size_t)l * 64 + m) * DM + h * 64 + j]); a2T[j * 72 + m] = f2bf(p.a_w2[((size_t)l * 64 + m) * DM + h * 64 + j]); }
        if (l > 0) for (int e = tid; e < 2048; e += 512) { const int m = e >> 6, j = e & 63; v2T[j * 40 + m] = f2bf(p.v_w2[((size_t)(l - 1) * 32 + m) * DM + h * 64 + j]); }
        if (tid < 64) { const float* mu = p.mu + (size_t)l * 3200; const int cc = h * 64 + tid;
            cst[tid] = mu[cc]; cst[64 + tid] = mu[1024 + cc]; cst[128 + tid] = mu[2048 + cc]; cst[192 + tid] = p.w0[l * DM + cc]; cst[256 + tid] = p.a0[l * DM + cc];
            cst[320 + tid] = (l > 0) ? p.v0[(l - 1) * DM + cc] : 0.f; cst[384 + tid] = p.k_k[l * DM + cc]; cst[448 + tid] = p.k_a[l * DM + cc]; cst[512 + tid] = p.r_k[l * DM + cc];
            cst[576 + tid] = mu[3072 + tid]; cst[640 + tid] = mu[3136 + tid]; }
        __syncthreads();
        f32x2 st[4];
#pragma unroll
        for (int j = 0; j < 4; ++j) st[j] = (f32x2){0.f, 0.f};
        const int si = tid >> 3, seg = tid & 7;
        const int pwv = wid - 4, tti = pwv & 1, chh = (pwv >> 1) & 1, vnt = half * 2 + chh, tt = tti * 16 + fr;
        RwRaw raw;
        if (wid >= 4) rw_load(raw, p.H, p.vf, l, (size_t)b * SEQ + tt, tt > 0, h, chh, vnt, fq);
        for (int c = -1; c < NCH; ++c) {
            if (wid >= 4 && c + 1 < NCH && !(mode & 2)) {
                float* B_ = buf0 + ((c + 1) & 1) * BUFSZ;
                float* sR = B_; float* sW = sR + TC * RS; float* sK = sW + TC * RS; float* sA = sK + TC * RS; float* sB = sA + TC * RS; float* sV = sB + TC * RS; float* sS = sV + TC * 32;
                const size_t tok = (size_t)b * SEQ + (c + 1) * TC + tt;
                const RwRaw cr_ = raw;
                if (c + 2 < NCH) rw_load(raw, p.H, p.vf, l, tok + TC, true, h, chh, vnt, fq);
                bf16x8 AfW[2], AfA[2];
#pragma unroll
                for (int ks = 0; ks < 2; ++ks) { const int m0 = ks * 32 + fq * 8;
                    const f32x4 mw0 = *(const f32x4*)(cst + 576 + m0), mw1 = *(const f32x4*)(cst + 576 + m0 + 4), ma0 = *(const f32x4*)(cst + 640 + m0), ma1 = *(const f32x4*)(cst + 640 + m0 + 4);
                    const float muw[8] = {mw0[0], mw0[1], mw0[2], mw0[3], mw1[0], mw1[1], mw1[2], mw1[3]}, mua[8] = {ma0[0], ma0[1], ma0[2], ma0[3], ma1[0], ma1[1], ma1[2], ma1[3]};
                    const unsigned cwv[4] = {cr_.cw[ks].x, cr_.cw[ks].y, cr_.cw[ks].z, cr_.cw[ks].w}, pwq[4] = {cr_.pw[ks].x, cr_.pw[ks].y, cr_.pw[ks].z, cr_.pw[ks].w};
                    const unsigned cav[4] = {cr_.ca[ks].x, cr_.ca[ks].y, cr_.ca[ks].z, cr_.ca[ks].w}, pav[4] = {cr_.pa[ks].x, cr_.pa[ks].y, cr_.pa[ks].z, cr_.pa[ks].w};
                    unsigned ow[4], oa[4];
#pragma unroll
                    for (int e = 0; e < 4; ++e) {
                        const float c0 = bflo(cwv[e]), c1 = bfhi(cwv[e]), q0 = bflo(pwq[e]), q1 = bfhi(pwq[e]);
                        ow[e] = cvt_pk_bf16(tanh_fast(c0 + muw[2 * e] * (q0 - c0)), tanh_fast(c1 + muw[2 * e + 1] * (q1 - c1)));
                        const float d0 = bflo(cav[e]), d1 = bfhi(cav[e]), r0 = bflo(pav[e]), r1 = bfhi(pav[e]);
                        oa[e] = cvt_pk_bf16(d0 + mua[2 * e] * (r0 - d0), d1 + mua[2 * e + 1] * (r1 - d1)); }
                    AfW[ks] = __builtin_bit_cast(bf16x8, ((u32x4){ow[0], ow[1], ow[2], ow[3]})); AfA[ks] = __builtin_bit_cast(bf16x8, ((u32x4){oa[0], oa[1], oa[2], oa[3]})); }
                f32x4 accW[2], accA[2], accV = (f32x4){0.f, 0.f, 0.f, 0.f};
#pragma unroll
                for (int q = 0; q < 2; ++q) { const int nt = chh * 2 + q; accW[q] = (f32x4){0.f, 0.f, 0.f, 0.f}; accA[q] = (f32x4){0.f, 0.f, 0.f, 0.f};
#pragma unroll
                    for (int ks = 0; ks < 2; ++ks) { const bf16x8 bw = *(const bf16x8*)(w2T + (nt * 16 + fr) * 72 + ks * 32 + fq * 8), ba = *(const bf16x8*)(a2T + (nt * 16 + fr) * 72 + ks * 32 + fq * 8);
                        accW[q] = __builtin_amdgcn_mfma_f32_16x16x32_bf16(bw, AfW[ks], accW[q], 0, 0, 0); accA[q] = __builtin_amdgcn_mfma_f32_16x16x32_bf16(ba, AfA[ks], accA[q], 0, 0, 0); } }
                if (l > 0) { const bf16x8 bv = *(const bf16x8*)(v2T + (vnt * 16 + fr) * 40 + fq * 8); accV = __builtin_amdgcn_mfma_f32_16x16x32_bf16(bv, __builtin_bit_cast(bf16x8, cr_.vl), accV, 0, 0, 0); }
                float ss = 0.f, rk = 0.f;
#pragma unroll
                for (int q = 0; q < 2; ++q) { const int ch0 = (chh * 2 + q) * 16 + fq * 4;
                    const float fr_[4] = {bflo(cr_.cr[q].x), bfhi(cr_.cr[q].x), bflo(cr_.cr[q].y), bfhi(cr_.cr[q].y)}, fpr[4] = {bflo(cr_.pr[q].x), bfhi(cr_.pr[q].x), bflo(cr_.pr[q].y), bfhi(cr_.pr[q].y)};
                    const float fk_[4] = {bflo(cr_.ck[q].x), bfhi(cr_.ck[q].x), bflo(cr_.ck[q].y), bfhi(cr_.ck[q].y)}, fpk[4] = {bflo(cr_.pk[q].x), bfhi(cr_.pk[q].x), bflo(cr_.pk[q].y), bfhi(cr_.pk[q].y)};
                    const f32x4 mur = *(const f32x4*)(cst + ch0), muk = *(const f32x4*)(cst + 64 + ch0), w0v = *(const f32x4*)(cst + 192 + ch0), a0v = *(const f32x4*)(cst + 256 + ch0),
                        kkv = *(const f32x4*)(cst + 384 + ch0), kav = *(const f32x4*)(cst + 448 + ch0), rkv = *(const f32x4*)(cst + 512 + ch0);
                    f32x4 ro, wo, ko, ao, bo;
#pragma unroll
                    for (int e = 0; e < 4; ++e) {
                        const float r = fr_[e] + mur[e] * (fpr[e] - fr_[e]), k = fk_[e] + muk[e] * (fpk[e] - fk_[e]);
                        wo[e] = __expf(-0.60653065971f * sigmoidf_(w0v[e] + accW[q][e]));
                        const float a = sigmoidf_(a0v[e] + accA[q][e]);
                        const float kq = k * kkv[e]; ss += kq * kq; ao[e] = -kq; bo[e] = kq * a;
                        const float km = k * (1.0f + (a - 1.0f) * kav[e]); rk += r * km * rkv[e]; ro[e] = r; ko[e] = km; }
                    *(f32x4*)(sR + tt * RS + ch0) = ro; *(f32x4*)(sW + tt * RS + ch0) = wo; *(f32x4*)(sK + tt * RS + ch0) = ko; *(f32x4*)(sA + tt * RS + ch0) = ao; *(f32x4*)(sB + tt * RS + ch0) = bo; }
                ss += __shfl_xor(ss, 16); ss += __shfl_xor(ss, 32); rk += __shfl_xor(rk, 16); rk += __shfl_xor(rk, 32);
                if (fq == 0) { sS[tt * 2 + chh] = ss; if (half == 0) p.rkbuf[(size_t)((b * 16 + h) * 2 + chh) * SEQ + (c + 1) * TC + tt] = rk; }
                { const int ch0 = vnt * 16 + fq * 4, cb = h * 64 + ch0;
                  const float fv_[4] = {bflo(cr_.cv.x), bfhi(cr_.cv.x), bflo(cr_.cv.y), bfhi(cr_.cv.y)}, fpv[4] = {bflo(cr_.pv.x), bfhi(cr_.pv.x), bflo(cr_.pv.y), bfhi(cr_.pv.y)};
                  const f32x4 muv = *(const f32x4*)(cst + 128 + ch0), v0v = *(const f32x4*)(cst + 320 + ch0);
                  f32x4 vo;
#pragma unroll
                  for (int e = 0; e < 4; ++e) vo[e] = fv_[e] + muv[e] * (fpv[e] - fv_[e]);
                  if (l > 0) { const float vfv[4] = {bflo(cr_.vf.x), bfhi(cr_.vf.x), bflo(cr_.vf.y), bfhi(cr_.vf.y)};
#pragma unroll
                      for (int e = 0; e < 4; ++e) vo[e] = vo[e] + (vfv[e] - vo[e]) * sigmoidf_(v0v[e] + accV[e]); }
                  u32x2 w; w.x = cvt_pk_bf16(vo[0], vo[1]); w.y = cvt_pk_bf16(vo[2], vo[3]); *(u32x2*)(p.vf + tok * DM + cb) = w;
                  *(f32x4*)(sV + tt * 32 + chh * 16 + fq * 4) = vo; }
            }
            if (wid < 4 && c >= 0 && !(mode & 1)) {
                const float* B_ = buf0 + (c & 1) * BUFSZ;
                const float* sR = B_; const float* sW = sR + TC * RS; const float* sK = sW + TC * RS; const float* sA = sK + TC * RS; const float* sB = sA + TC * RS; const float* sV = sB + TC * RS; const float* sS = sV + TC * 32;
                float* yp = ypart + wid * (TC * 64) + lane; float* sIw = sI + wid * TC;
                if (lane < TC) { const f32x2 ps = *(const f32x2*)(sS + lane * 2); sIw[lane] = __builtin_amdgcn_rcpf(fmaxf(ps.x + ps.y, 1e-24f)); }
                f32x4 A0, A1, W0, W1, B0, B1, K0, K1, R0, R1; float VI, IV;
#define SC_LOAD(s_) do { const int o_ = (s_) * RS + seg * 8; \
                    A0 = *(const f32x4*)(sA + o_); A1 = *(const f32x4*)(sA + o_ + 4); W0 = *(const f32x4*)(sW + o_); W1 = *(const f32x4*)(sW + o_ + 4); \
                    B0 = *(const f32x4*)(sB + o_); B1 = *(const f32x4*)(sB + o_ + 4); K0 = *(const f32x4*)(sK + o_); K1 = *(const f32x4*)(sK + o_ + 4); \
                    R0 = *(const f32x4*)(sR + o_); R1 = *(const f32x4*)(sR + o_ + 4); VI = sV[(s_) * 32 + si]; IV = sIw[(s_)]; } while (0)
                SC_LOAD(0);
#pragma unroll 4
                for (int s = 0; s < TC; ++s) {
                    const f32x4 a0 = A0, a1 = A1, w0 = W0, w1 = W1, b0 = B0, b1 = B1, k0 = K0, k1 = K1, r0 = R0, r1 = R1; const float vi = VI, inv2 = IV;
                    if (s + 1 < TC) SC_LOAD(s + 1);
                    __builtin_amdgcn_sched_barrier(0);
                    const f32x2 av[4] = {{a0[0], a0[1]}, {a0[2], a0[3]}, {a1[0], a1[1]}, {a1[2], a1[3]}}, wv[4] = {{w0[0], w0[1]}, {w0[2], w0[3]}, {w1[0], w1[1]}, {w1[2], w1[3]}};
                    const f32x2 bv[4] = {{b0[0], b0[1]}, {b0[2], b0[3]}, {b1[0], b1[1]}, {b1[2], b1[3]}}, kv[4] = {{k0[0], k0[1]}, {k0[2], k0[3]}, {k1[0], k1[1]}, {k1[2], k1[3]}};
                    const f32x2 rv[4] = {{r0[0], r0[1]}, {r0[2], r0[3]}, {r1[0], r1[1]}, {r1[2], r1[3]}};
                    const f32x2 vi2 = {vi, vi};
                    f32x2 vk[4];
#pragma unroll
                    for (int j = 0; j < 4; ++j) vk[j] = vi2 * kv[j];
                    const f32x2 pa = st[0] * av[0] + st[1] * av[1], pb = st[2] * av[2] + st[3] * av[3]; const f32x2 pc = pa + pb;
                    const float sa = red8(pc.x + pc.y) * inv2;
                    const f32x2 sa2 = {sa, sa};
#pragma unroll
                    for (int j = 0; j < 4; ++j) st[j] = st[j] * wv[j] + (sa2 * bv[j] + vk[j]);
                    const f32x2 qa = st[0] * rv[0] + st[1] * rv[1], qb = st[2] * rv[2] + st[3] * rv[3]; const f32x2 qc = qa + qb;
                    yp[s * 64] = qc.x + qc.y;
                }
#undef SC_LOAD
                { const int tk = lane >> 1, rq = (lane & 1) * 4; const float* yr = ypart + wid * (TC * 64) + tk * 64 + rq * 8; float yv[4];
#pragma unroll
                  for (int r_ = 0; r_ < 4; ++r_) { const f32x4 u0 = *(const f32x4*)(yr + r_ * 8), u1 = *(const f32x4*)(yr + r_ * 8 + 4); yv[r_] = ((u0[0] + u0[1]) + (u0[2] + u0[3])) + ((u1[0] + u1[1]) + (u1[2] + u1[3])); }
                  u32x2 w; w.x = cvt_pk_bf16(yv[0], yv[1]); w.y = cvt_pk_bf16(yv[2], yv[3]);
                  *(u32x2*)(p.y + ((size_t)b * SEQ + c * TC + tk) * DM + h * 64 + half * 32 + wid * 8 + rq) = w; }
            }
            __syncthreads();
        }
    }
    __syncthreads();
}

__device__ void phase_rwkv_post(int l, bf16_t* oalt) {
    const Params p = load_params();
    const int tid = opaque_tid(), l8 = tid & 7;
    const int ngrp = T_TOK * 16;
    for (int g = blockIdx.x * 64 + (tid >> 3); g < ngrp; g += gridDim.x * 64) {
        const int tok = g >> 4, h = g & 15, cb = h * 64 + l8 * 8;
        const u32x4 y4 = *(const u32x4*)(p.y + (size_t)tok * DM + cb), b4 = *(const u32x4*)(p.vf + (size_t)tok * DM + cb);
        const int bb = tok / SEQ, tq = tok % SEQ; const float rk = p.rkbuf[(size_t)((bb * 16 + h) * 2) * SEQ + tq] + p.rkbuf[(size_t)((bb * 16 + h) * 2 + 1) * SEQ + tq];
        bf16_t* zp = p.H + (size_t)tok * LDA_H + 3200 + cb; const u32x4 z4 = *(const u32x4*)zp;
        const float yv[8] = {bflo(y4.x), bfhi(y4.x), bflo(y4.y), bfhi(y4.y), bflo(y4.z), bfhi(y4.z), bflo(y4.w), bfhi(y4.w)};
        const float bv[8] = {bflo(b4.x), bfhi(b4.x), bflo(b4.y), bfhi(b4.y), bflo(b4.z), bfhi(b4.z), bflo(b4.w), bfhi(b4.w)};
        const float zv[8] = {bflo(z4.x), bfhi(z4.x), bflo(z4.y), bfhi(z4.y), bflo(z4.z), bfhi(z4.z), bflo(z4.w), bfhi(z4.w)};
        float sm = 0.f;
#pragma unroll
        for (int e = 0; e < 8; ++e) sm += yv[e];
        sm = red8(sm); const float mean = sm * (1.0f / 64.f); float d[8], vs = 0.f;
#pragma unroll
        for (int e = 0; e < 8; ++e) { d[e] = yv[e] - mean; vs += d[e] * d[e]; }
        vs = red8(vs); const float rstd = rsqrtf(vs * (1.0f / 64.f) + GN_EPS);
        const f32x4 g0 = *(const f32x4*)(p.lnx_g + l * DM + cb), g1 = *(const f32x4*)(p.lnx_g + l * DM + cb + 4), c0 = *(const f32x4*)(p.lnx_b + l * DM + cb), c1 = *(const f32x4*)(p.lnx_b + l * DM + cb + 4);
        const float gg[8] = {g0[0], g0[1], g0[2], g0[3], g1[0], g1[1], g1[2], g1[3]}, cc[8] = {c0[0], c0[1], c0[2], c0[3], c1[0], c1[1], c1[2], c1[3]};
        float o[8];
#pragma unroll
        for (int e = 0; e < 8; ++e) o[e] = (d[e] * rstd * gg[e] + cc[e] + rk * bv[e]) * siluf_(zv[e]);
        u32x4 w; w.x = cvt_pk_bf16(o[0], o[1]); w.y = cvt_pk_bf16(o[2], o[3]); w.z = cvt_pk_bf16(o[4], o[5]); w.w = cvt_pk_bf16(o[6], o[7]);
        *(u32x4*)(oalt ? oalt + (size_t)tok * DM + cb : zp) = w;
    }
}

__device__ __forceinline__ float wave_sum64(float v) {
    v = red16(v);
    const float a = __int_as_float(__builtin_amdgcn_readlane(__float_as_int(v), 0)), b = __int_as_float(__builtin_amdgcn_readlane(__float_as_int(v), 16));
    const float c = __int_as_float(__builtin_amdgcn_readlane(__float_as_int(v), 32)), d = __int_as_float(__builtin_amdgcn_readlane(__float_as_int(v), 48));
    return (a + b) + (c + d);
}
__device__ void phase_sgu(int l, unsigned char* smem, bf16_t* oalt) {
    const Params p = load_params();
    bf16_t* vnTb = (bf16_t*)smem;
    float* stat = (float*)(smem + 2 * 128 * 136 * 2);
    float* lnG = stat + 256; float* lnB = lnG + DM;
    const int tid = opaque_tid(), wid = tid >> 6, lane = tid & 63, fr = lane & 15, fq = lane >> 4;
    __syncthreads();
    for (int e = tid; e < DM; e += 512) { lnG[e] = p.sgu_ln_g[(size_t)l * DM + e]; lnB[e] = p.sgu_ln_b[(size_t)l * DM + e]; }
    for (int item = blockIdx.x; item < T_TOK / 128; item += gridDim.x) {
        bf16_t* Hb = p.H + (size_t)item * 128 * LDB_H;
        __syncthreads();
#pragma unroll
        for (int hb = 0; hb < 2; ++hb) {
            u32x4 va[8], vb[8];
#pragma unroll
            for (int q = 0; q < 8; ++q) { const bf16_t* vr = Hb + (size_t)(wid * 16 + hb * 8 + q) * LDB_H + 1024 + lane * 16; va[q] = *(const u32x4*)vr; vb[q] = *(const u32x4*)(vr + 8); }
#pragma unroll
            for (int q = 0; q < 8; ++q) {
                const float f[16] = {bflo(va[q].x), bfhi(va[q].x), bflo(va[q].y), bfhi(va[q].y), bflo(va[q].z), bfhi(va[q].z), bflo(va[q].w), bfhi(va[q].w), bflo(vb[q].x), bfhi(vb[q].x), bflo(vb[q].y), bfhi(vb[q].y), bflo(vb[q].z), bfhi(vb[q].z), bflo(vb[q].w), bfhi(vb[q].w)};
                float sm = 0.f, sq = 0.f;
#pragma unroll
                for (int e = 0; e < 16; ++e) { sm += f[e]; sq += f[e] * f[e]; }
                sm = wave_sum64(sm); sq = wave_sum64(sq);
                const float mean = sm * (1.0f / DM), var = fmaxf(sq * (1.0f / DM) - mean * mean, 0.f);
                if (lane == 0) { const int s = wid * 16 + hb * 8 + q; stat[s * 2] = mean; stat[s * 2 + 1] = rsqrtf(var + EPS); } }
        }
        __syncthreads();
        const int trow = wid * 16 + fr; bf16_t* hr = Hb + (size_t)trow * LDB_H;
        const int nks = (wid < 4) ? 2 : 4;
        for (int g = 0; g < 8; ++g) {
            bf16_t* vnT = vnTb + (g & 1) * (128 * 136);
            const int s = tid >> 2, c0 = (tid & 3) * 32;
            const bf16_t* vr = Hb + (size_t)s * LDB_H + 1024 + g * 128 + c0;
            u32x4 vv[4];
#pragma unroll
            for (int q = 0; q < 4; ++q) vv[q] = *(const u32x4*)(vr + q * 8);
            const float* Wg = p.sgu_w + (((size_t)l * 8 + g) * 128 + trow) * 128;
            f32x4 wa[4], wb[4];
#pragma unroll
            for (int ks = 0; ks < 4; ++ks) if (ks < nks) { wa[ks] = *(const f32x4*)(Wg + ks * 32 + fq * 8); wb[ks] = *(const f32x4*)(Wg + ks * 32 + fq * 8 + 4); }
            u32x2 u2[8], z2[8];
#pragma unroll
            for (int ct = 0; ct < 8; ++ct) { const int c = g * 128 + ct * 16 + fq * 4; u2[ct] = *(const u32x2*)(hr + c); z2[ct] = *(const u32x2*)(hr + 2048 + c); }
            const float bs = p.sgu_b[((size_t)l * 8 + g) * 128 + trow];
            { const float mean = stat[s * 2], rstd = stat[s * 2 + 1];
#pragma unroll
              for (int q = 0; q < 4; ++q) { const float f[8] = {bflo(vv[q].x), bfhi(vv[q].x), bflo(vv[q].y), bfhi(vv[q].y), bflo(vv[q].z), bfhi(vv[q].z), bflo(vv[q].w), bfhi(vv[q].w)};
                  const f32x4 g0 = *(const f32x4*)(lnG + g * 128 + c0 + q * 8), g1 = *(const f32x4*)(lnG + g * 128 + c0 + q * 8 + 4), b0 = *(const f32x4*)(lnB + g * 128 + c0 + q * 8), b1 = *(const f32x4*)(lnB + g * 128 + c0 + q * 8 + 4);
                  const float gg[8] = {g0[0], g0[1], g0[2], g0[3], g1[0], g1[1], g1[2], g1[3]}, bb[8] = {b0[0], b0[1], b0[2], b0[3], b1[0], b1[1], b1[2], b1[3]};
#pragma unroll
                  for (int e = 0; e < 8; ++e) { const int c = c0 + q * 8 + e; const float a_ = rstd * gg[e]; vnT[c * 136 + s] = f2bf(f[e] * a_ + (bb[e] - mean * a_)); } } }
            __syncthreads();
            f32x4 acc[8];
#pragma unroll
            for (int i = 0; i < 8; ++i) acc[i] = (f32x4){0.f, 0.f, 0.f, 0.f};
#pragma unroll
            for (int ks = 0; ks < 4; ++ks) if (ks < nks) {
                u32x4 wp; wp.x = cvt_pk_bf16(wa[ks][0], wa[ks][1]); wp.y = cvt_pk_bf16(wa[ks][2], wa[ks][3]); wp.z = cvt_pk_bf16(wb[ks][0], wb[ks][1]); wp.w = cvt_pk_bf16(wb[ks][2], wb[ks][3]);
                const bf16x8 wfrag = __builtin_bit_cast(bf16x8, wp);
#pragma unroll
                for (int ct = 0; ct < 8; ++ct) { const bf16x8 vfrag = *(const bf16x8*)(vnT + (ct * 16 + fr) * 136 + ks * 32 + fq * 8);
                    acc[ct] = __builtin_amdgcn_mfma_f32_16x16x32_bf16(vfrag, wfrag, acc[ct], 0, 0, 0); }
            }
#pragma unroll
            for (int ct = 0; ct < 8; ++ct) { const int c = g * 128 + ct * 16 + fq * 4;
                const float uf[4] = {bflo(u2[ct].x), bfhi(u2[ct].x), bflo(u2[ct].y), bfhi(u2[ct].y)}, zf[4] = {bflo(z2[ct].x), bfhi(z2[ct].x), bflo(z2[ct].y), bfhi(z2[ct].y)};
                float o[4];
#pragma unroll
                for (int j = 0; j < 4; ++j) o[j] = uf[j] * (acc[ct][j] + bs) * siluf_(zf[j]);
                u32x2 w; w.x = cvt_pk_bf16(o[0], o[1]); w.y = cvt_pk_bf16(o[2], o[3]); *(u32x2*)(oalt ? oalt + ((size_t)item * 128 + trow) * DM + c : hr + 2048 + c) = w; }
        }
    }
    __syncthreads();
}

__device__ void phase_hgrn_pre(int l, unsigned char* smem, bool dry) {
    const Params p = load_params();
    float* LF = (float*)smem;
    bf16_t* IB = (bf16_t*)(LF + 64 * 132);
    bf16_t* KB = IB + 64 * 136;
    float* psum = (float*)(KB + 64 * 136);
    float* lbs = psum + 512;
    const int tid = opaque_tid();
    bf16_t* xtra = (l == 0) ? (bf16_t*)p.out : p.vf;
    __syncthreads();
    for (int e = tid; e < DM; e += 512) { float lb = 0.f; if (l == 1) { const float l0 = p.lb_logits[e], l1 = p.lb_logits[DM + e]; lb = __builtin_amdgcn_rcpf(1.0f + __expf(l0 - l1)); } lbs[e] = lb; }
    __syncthreads();
    const int t = tid >> 3, c0 = (tid & 7) * 16;
    const int cc = tid & 127, tq = tid >> 7;
    u32x4 nq0, nq1, nf0, nf1, ni0, ni1;
#define HP_ISSUE(it_) do { const int h_ = (it_) & 7, ch_ = ((it_) >> 3) & 63, b_ = (it_) >> 9; const bf16_t* hr_ = p.H + ((size_t)b_ * SEQ + ch_ * 64 + t) * LDC_H + h_ * 128 + c0; \
        nq0 = *(const u32x4*)hr_; nq1 = *(const u32x4*)(hr_ + 8); nf0 = *(const u32x4*)(hr_ + 1024); nf1 = *(const u32x4*)(hr_ + 1032); ni0 = *(const u32x4*)(hr_ + 2048); ni1 = *(const u32x4*)(hr_ + 2056); } while (0)
    if ((int)blockIdx.x < NB * 64 * 8) HP_ISSUE((int)blockIdx.x);
    for (int item = blockIdx.x; item < NB * 64 * 8; item += gridDim.x) {
        const int h = item & 7, ch = (item >> 3) & 63, b = item >> 9;
        const size_t r0 = (size_t)b * SEQ + ch * 64;
        bf16_t* hr = p.H + (r0 + t) * LDC_H + h * 128 + c0;
        float qv[16], kv[16];
        {
            const u32x4 q0 = nq0, q1 = nq1, f0 = nf0, f1 = nf1, i0 = ni0, i1 = ni1;
            if (item + (int)gridDim.x < NB * 64 * 8) HP_ISSUE(item + (int)gridDim.x);
            const unsigned qa[8] = {q0.x, q0.y, q0.z, q0.w, q1.x, q1.y, q1.z, q1.w}, fa[8] = {f0.x, f0.y, f0.z, f0.w, f1.x, f1.y, f1.z, f1.w};
            *(u32x4*)(IB + t * 136 + c0) = i0; *(u32x4*)(IB + t * 136 + c0 + 8) = i1;
            float lf[16];
#pragma unroll
            for (int e = 0; e < 8; ++e) {
                const float lb0 = lbs[h * 128 + c0 + 2 * e], lb1 = lbs[h * 128 + c0 + 2 * e + 1];
                qv[2 * e] = siluf_(bflo(qa[e])); qv[2 * e + 1] = siluf_(bfhi(qa[e]));
                const float g0 = lb0 + (1.0f - lb0) * sigmoidf_(bflo(fa[e])), g1 = lb1 + (1.0f - lb1) * sigmoidf_(bfhi(fa[e]));
                kv[2 * e] = 1.0f - g0; kv[2 * e + 1] = 1.0f - g1; lf[2 * e] = __logf(g0); lf[2 * e + 1] = __logf(g1); }
#pragma unroll
            for (int e = 0; e < 4; ++e) *(f32x4*)(LF + t * 132 + c0 + e * 4) = (f32x4){lf[e * 4], lf[e * 4 + 1], lf[e * 4 + 2], lf[e * 4 + 3]};
        }
        __syncthreads();
        { float run = 0.f;
#pragma unroll
          for (int e = 0; e < 16; ++e) { run += LF[(tq * 16 + e) * 132 + cc]; LF[(tq * 16 + e) * 132 + cc] = run; }
          psum[tq * 128 + cc] = run; }
        __syncthreads();
        {
            const int tqt = t >> 4;
            unsigned qo[8], ko[8];
#pragma unroll
            for (int e4 = 0; e4 < 4; ++e4) {
                const f32x4 p0 = *(const f32x4*)(psum + c0 + e4 * 4), p1 = *(const f32x4*)(psum + 128 + c0 + e4 * 4), p2 = *(const f32x4*)(psum + 256 + c0 + e4 * 4), p3 = *(const f32x4*)(psum + 384 + c0 + e4 * 4);
                const f32x4 bl = *(const f32x4*)(LF + t * 132 + c0 + e4 * 4);
                float q2[4], k2[4];
#pragma unroll
                for (int j = 0; j < 4; ++j) {
                    const float off = (tqt > 0 ? p0[j] : 0.f) + (tqt > 1 ? p1[j] : 0.f) + (tqt > 2 ? p2[j] : 0.f);
                    const float bmid = p0[j] + p1[j], bb = bl[j] + off;
                    q2[j] = qv[e4 * 4 + j] * __expf(bb - bmid); k2[j] = kv[e4 * 4 + j] * __expf(bmid - bb); }
                qo[e4 * 2] = cvt_pk_bf16(q2[0], q2[1]); qo[e4 * 2 + 1] = cvt_pk_bf16(q2[2], q2[3]); ko[e4 * 2] = cvt_pk_bf16(k2[0], k2[1]); ko[e4 * 2 + 1] = cvt_pk_bf16(k2[2], k2[3]);
                if (t == 0) { f32x4 e1, e3;
#pragma unroll
                    for (int j = 0; j < 4; ++j) { e1[j] = __expf(p0[j] + p1[j]); e3[j] = __expf(p2[j] + p3[j]); }
                    float* gs = p.rkbuf + (size_t)(((b * 64 + ch) * 8 + h)) * 256 + c0 + e4 * 4; *(f32x4*)gs = e1; *(f32x4*)(gs + 128) = e3; }
            }
            const u32x4 qw0 = {qo[0], qo[1], qo[2], qo[3]}, qw1 = {qo[4], qo[5], qo[6], qo[7]}, kw0 = {ko[0], ko[1], ko[2], ko[3]}, kw1 = {ko[4], ko[5], ko[6], ko[7]};
            if (!dry) { *(u32x4*)hr = qw0; *(u32x4*)(hr + 8) = qw1; *(u32x4*)(hr + 1024) = kw0; *(u32x4*)(hr + 1032) = kw1; }
            *(u32x4*)(KB + t * 136 + c0) = kw0; *(u32x4*)(KB + t * 136 + c0 + 8) = kw1;
        }
        __syncthreads();
        {
            unsigned iw[8], kw[8];
#pragma unroll
            for (int e = 0; e < 8; ++e) {
                iw[e] = (unsigned)IB[(tq * 16 + 2 * e) * 136 + cc] | ((unsigned)IB[(tq * 16 + 2 * e + 1) * 136 + cc] << 16);
                kw[e] = (unsigned)KB[(tq * 16 + 2 * e) * 136 + cc] | ((unsigned)KB[(tq * 16 + 2 * e + 1) * 136 + cc] << 16); }
            bf16_t* ir = p.H + (r0 + (cc >> 1)) * LDC_H + 2048 + h * 128 + (cc & 1) * 64 + tq * 16;
            if (!dry) { *(u32x4*)ir = (u32x4){iw[0], iw[1], iw[2], iw[3]}; *(u32x4*)(ir + 8) = (u32x4){iw[4], iw[5], iw[6], iw[7]}; }
            bf16_t* kr = xtra + (r0 + (cc >> 1)) * DM + h * 128 + (cc & 1) * 64 + tq * 16;
            *(u32x4*)kr = (u32x4){kw[0], kw[1], kw[2], kw[3]}; *(u32x4*)(kr + 8) = (u32x4){kw[4], kw[5], kw[6], kw[7]};
        }
        __syncthreads();
    }
}

struct HgSet { u32x4 r[7]; };
__device__ __forceinline__ void hg_issue(HgSet& R, const bf16_t* H, const bf16_t* xtra, const float* gsc, int b, int ch, int h, int vs, int tid) {
    const size_t r0 = (size_t)b * SEQ + (size_t)ch * 64;
    const int row = tid >> 4, wi = tid & 15;
#pragma unroll
    for (int j = 0; j < 2; ++j) { const int t = j * 32 + row; R.r[j] = *(const u32x4*)(H + (r0 + t) * LDC_H + h * 128 + wi * 8); R.r[2 + j] = *(const u32x4*)(H + (r0 + t) * LDC_H + 1024 + h * 128 + wi * 8); }
#pragma unroll
    for (int j = 0; j < 2; ++j) { const int kp = j * 32 + row; R.r[4 + j] = *(const u32x4*)(xtra + (r0 + kp) * DM + h * 128 + wi * 8); }
    const u32x4 z4 = {0u, 0u, 0u, 0u}; R.r[6] = z4;
    if (tid < 256) R.r[6] = *(const u32x4*)(H + (r0 + vs * 16 + row) * LDC_H + 2048 + h * 128 + wi * 8);
    else if (tid < 320) R.r[6] = *(const u32x4*)(gsc + (size_t)(((b * 64 + ch) * 8 + h)) * 256 + (tid - 256) * 4);
}
constexpr int HG_QM = 0, HG_KM = 16 * 65 * 16, HG_KT = 2 * 16 * 65 * 16, HG_IT = HG_KT + 8 * 129 * 16, HG_E = HG_IT + 8 * 33 * 16, HG_BUF = HG_E + 1024;
__device__ __forceinline__ void hg_stage(const HgSet& R, unsigned char* B, int tid) {
    const int row = tid >> 4, wi = tid & 15;
#pragma unroll
    for (int j = 0; j < 2; ++j) { const int t = j * 32 + row; *(u32x4*)(B + HG_QM + (wi * 65 + t) * 16) = R.r[j]; *(u32x4*)(B + HG_KM + (wi * 65 + t) * 16) = R.r[2 + j]; }
#pragma unroll
    for (int j = 0; j < 2; ++j) { const int k = (j * 32 + row) * 2 + (wi >> 3), sc = wi & 7; *(u32x4*)(B + HG_KT + (sc * 129 + k) * 16) = R.r[4 + j]; }
    if (tid < 256) { const int vv = row * 2 + (wi >> 3), sc = wi & 7; *(u32x4*)(B + HG_IT + (sc * 33 + vv) * 16) = R.r[6]; }
    else if (tid < 320) *(u32x4*)(B + HG_E + (tid - 256) * 16) = R.r[6];
}

__device__ void phase_hgrn_seq(int l, unsigned char* smem, bool dry) {
    const Params p = load_params();
    unsigned char* img = smem;
    bf16_t* att = (bf16_t*)(smem + 2 * HG_BUF);
    bf16_t* STs = att + 64 * 72;
    const int tid = opaque_tid(), w = __builtin_amdgcn_readfirstlane(tid >> 6), lane = tid & 63, fr = lane & 15, fq = lane >> 4;
    const bf16_t* xtra = (l == 0) ? (const bf16_t*)p.out : p.vf;
    const int tt_ = w >> 1, sp = w & 1;
    for (int item = blockIdx.x; item < NB * 32; item += gridDim.x) {
        const int xc_ = item & 7, sl_ = item >> 3, vs = sl_ & 3, gi_ = (sl_ >> 2) * 8 + xc_, h = gi_ & 7, b = gi_ >> 3;
        __syncthreads();
        for (int e = tid; e < 32 * 136 / 2; e += 512) ((unsigned*)STs)[e] = 0u;
        f32x4 S[2] = {{0.f, 0.f, 0.f, 0.f}, {0.f, 0.f, 0.f, 0.f}};
        u32x2 o0 = {0u, 0u};
        HgSet R0, R1;
        hg_issue(R0, p.H, xtra, p.rkbuf, b, 0, h, vs, tid); hg_stage(R0, img, tid);
        hg_issue(R1, p.H, xtra, p.rkbuf, b, 1, h, vs, tid); hg_issue(R0, p.H, xtra, p.rkbuf, b, 2, h, vs, tid);
        __syncthreads();
        auto iter = [&](const int ch, HgSet& RS) {
            const size_t r0 = (size_t)b * SEQ + (size_t)ch * 64;
            const unsigned char* B = img + (ch & 1) * HG_BUF; unsigned char* Bn = img + ((ch + 1) & 1) * HG_BUF;
            bf16x8 qf[4];
#pragma unroll
            for (int ks = 0; ks < 4; ++ks) qf[ks] = *(const bf16x8*)(B + HG_QM + ((ks * 4 + fq) * 65 + tt_ * 16 + fr) * 16);
#pragma unroll
            for (int q = 0; q < 2; ++q) { const int stile = sp * 2 + q; f32x4 a = {0.f, 0.f, 0.f, 0.f};
                if (stile <= tt_) {
#pragma unroll
                    for (int ks = 0; ks < 4; ++ks) { const bf16x8 kf = *(const bf16x8*)(B + HG_KM + ((ks * 4 + fq) * 65 + stile * 16 + fr) * 16); a = __builtin_amdgcn_mfma_f32_16x16x32_bf16(qf[ks], kf, a, 0, 0, 0); } }
#pragma unroll
                for (int j = 0; j < 4; ++j) { const int t = tt_ * 16 + fq * 4 + j, s = stile * 16 + fr; att[t * 72 + s] = f2bf(s <= t ? a[j] : 0.f); } }
            if (ch + 1 < 64) hg_stage(RS, Bn, tid);
            if (ch + 3 < 64) hg_issue(RS, p.H, xtra, p.rkbuf, b, ch + 3, h, vs, tid);
            __syncthreads();
            f32x4 o = {0.f, 0.f, 0.f, 0.f};
#pragma unroll
            for (int ks = 0; ks < 2; ++ks) { const bf16x8 af = *(const bf16x8*)(att + (tt_ * 16 + fr) * 72 + ks * 32 + fq * 8); const bf16x8 itf = *(const bf16x8*)(B + HG_IT + ((ks * 4 + fq) * 33 + sp * 16 + fr) * 16);
                o = __builtin_amdgcn_mfma_f32_16x16x32_bf16(itf, af, o, 0, 0, 0); }
#pragma unroll
            for (int ks = 0; ks < 4; ++ks) { const bf16x8 sf = *(const bf16x8*)(STs + (sp * 16 + fr) * 136 + ks * 32 + fq * 8);
                o = __builtin_amdgcn_mfma_f32_16x16x32_bf16(sf, qf[ks], o, 0, 0, 0); }
            { u32x2 ow; ow.x = cvt_pk_bf16(o[0], o[1]); ow.y = cvt_pk_bf16(o[2], o[3]);
              if (ch == 0) o0 = ow;
              else if (!dry) { const int t = tt_ * 16 + fr; *(u32x2*)(p.H + (r0 - 64 + vs * 16 + (t >> 2)) * LDC_H + 2048 + h * 128 + (t & 3) * 32 + sp * 16 + fq * 4) = ow; } }
            const f32x4 e1 = *(const f32x4*)(B + HG_E + (w * 16 + fq * 4) * 4), e3 = *(const f32x4*)(B + HG_E + 512 + (w * 16 + fq * 4) * 4);
            bf16x8 ktf[2];
#pragma unroll
            for (int ks = 0; ks < 2; ++ks) ktf[ks] = *(const bf16x8*)(B + HG_KT + ((ks * 4 + fq) * 129 + w * 16 + fr) * 16);
#pragma unroll
            for (int vt = 0; vt < 2; ++vt) { f32x4 u = {0.f, 0.f, 0.f, 0.f};
#pragma unroll
                for (int ks = 0; ks < 2; ++ks) { const bf16x8 itf = *(const bf16x8*)(B + HG_IT + ((ks * 4 + fq) * 33 + vt * 16 + fr) * 16); u = __builtin_amdgcn_mfma_f32_16x16x32_bf16(ktf[ks], itf, u, 0, 0, 0); }
#pragma unroll
                for (int j = 0; j < 4; ++j) S[vt][j] = e3[j] * (e1[j] * S[vt][j] + u[j]); }
            __syncthreads();
            if (ch + 1 < 64) { const f32x4 e1n = *(const f32x4*)(Bn + HG_E + (w * 16 + fq * 4) * 4);
#pragma unroll
                for (int vt = 0; vt < 2; ++vt) { u32x2 sw; sw.x = cvt_pk_bf16(S[vt][0] * e1n[0], S[vt][1] * e1n[1]); sw.y = cvt_pk_bf16(S[vt][2] * e1n[2], S[vt][3] * e1n[3]);
                    *(u32x2*)(STs + (vt * 16 + fr) * 136 + w * 16 + fq * 4) = sw; } }
        };
        for (int ch = 0; ch < 64; ch += 2) { iter(ch, R1); iter(ch + 1, R0); }
        if (!dry) { const int t = tt_ * 16 + fr; *(u32x2*)(p.H + ((size_t)b * SEQ + 63 * 64 + vs * 16 + (t >> 2)) * LDC_H + 2048 + h * 128 + (t & 3) * 32 + sp * 16 + fq * 4) = o0; }
    }
    __syncthreads();
}

__device__ void phase_hgrn_post(int l) {
    const Params p = load_params();
    const int tid = opaque_tid(), l8 = tid & 7;
    const int ngrp = T_TOK * 8;
    for (int g = blockIdx.x * 64 + (tid >> 3); g < ngrp; g += gridDim.x * 64) {
        const int tok = g >> 3, h = g & 7, b = tok / SEQ, tin = tok % SEQ, ch = tin >> 6, t = tin & 63, slot = (ch + 63) & 63, vs = l8 >> 1, vv0 = (l8 & 1) * 16;
        const bf16_t* op = p.H + ((size_t)b * SEQ + slot * 64 + vs * 16 + (t >> 2)) * LDC_H + 2048 + h * 128 + (t & 3) * 32 + vv0;
        bf16_t* zp = p.H + (size_t)tok * LDC_H + 3072 + h * 128 + l8 * 16;
        const u32x4 a0 = *(const u32x4*)op, a1 = *(const u32x4*)(op + 8), z0 = *(const u32x4*)zp, z1 = *(const u32x4*)(zp + 8);
        const float ov[16] = {bflo(a0.x), bfhi(a0.x), bflo(a0.y), bfhi(a0.y), bflo(a0.z), bfhi(a0.z), bflo(a0.w), bfhi(a0.w), bflo(a1.x), bfhi(a1.x), bflo(a1.y), bfhi(a1.y), bflo(a1.z), bfhi(a1.z), bflo(a1.w), bfhi(a1.w)};
        const float zf[16] = {bflo(z0.x), bfhi(z0.x), bflo(z0.y), bfhi(z0.y), bflo(z0.z), bfhi(z0.z), bflo(z0.w), bfhi(z0.w), bflo(z1.x), bfhi(z1.x), bflo(z1.y), bfhi(z1.y), bflo(z1.z), bfhi(z1.z), bflo(z1.w), bfhi(z1.w)};
        float ss = 0.f;
#pragma unroll
        for (int e = 0; e < 16; ++e) ss += ov[e] * ov[e];
        ss = red8(ss); const float rinv = rsqrtf(ss * (1.0f / 128.f) + EPS);
        const float* gn = p.hgrn_g + (size_t)l * DM + h * 128 + l8 * 16;
        float r[16];
#pragma unroll
        for (int e = 0; e < 16; ++e) r[e] = ov[e] * rinv * gn[e] * siluf_(zf[e]);
        u32x4 w0, w1; w0.x = cvt_pk_bf16(r[0], r[1]); w0.y = cvt_pk_bf16(r[2], r[3]); w0.z = cvt_pk_bf16(r[4], r[5]); w0.w = cvt_pk_bf16(r[6], r[7]);
        w1.x = cvt_pk_bf16(r[8], r[9]); w1.y = cvt_pk_bf16(r[10], r[11]); w1.z = cvt_pk_bf16(r[12], r[13]); w1.w = cvt_pk_bf16(r[14], r[15]);
        *(u32x4*)zp = w0; *(u32x4*)(zp + 8) = w1;
    }
}


#define XB_TMO      128
#define XB_XCNT(j)  (256  + 64 * (j))
#define XB_XSUB(j)  (1280 + 64 * (j))
#define XB_XGEN(j)  (2304 + 64 * (j))
#define XB_TOP      3328
#define XB_TOPGEN   3392
#define XCD_BAR_WORDS 3456
#define XB_SPIN_CAP (1u << 18)
__device__ __forceinline__ unsigned xb_ld(unsigned* p)              { return __hip_atomic_load(p, __ATOMIC_RELAXED, __HIP_MEMORY_SCOPE_AGENT); }
__device__ __forceinline__ unsigned xb_add(unsigned* p, unsigned v) { return __hip_atomic_fetch_add(p, v, __ATOMIC_RELAXED, __HIP_MEMORY_SCOPE_AGENT); }
__device__ __forceinline__ unsigned xb_xcc_id() { return (unsigned)__builtin_amdgcn_s_getreg((3 << 11) | 20) & 0xFu; }
#define XB_SPIN(cond, bar) do { unsigned _sp = 0; while (cond) { __builtin_amdgcn_s_sleep(1); \
    if ((++_sp & 255u) == 0u) { if (xb_ld(&(bar)[XB_TMO])) break; if (_sp > XB_SPIN_CAP) { atomicAdd(&(bar)[XB_TMO], 1u); break; } } } } while (0)
struct XcdBarrier { unsigned* bar; unsigned x; volatile LAS unsigned* st; };
__device__ __forceinline__ XcdBarrier xcd_barrier_post(unsigned* bar, volatile LAS unsigned* st) {
    XcdBarrier b; b.bar = bar; b.x = xb_xcc_id(); b.st = st;
    if (threadIdx.x == 0) (void)xb_add(&bar[XB_XCNT(b.x)], 1u);
    return b;
}
__device__ __forceinline__ void xcd_barrier_complete(unsigned* bar, unsigned x, unsigned& nloc, unsigned& nx) {
    const unsigned G = gridDim.x * gridDim.y * gridDim.z;
    unsigned sum, cnt, mine, sp = 0u;
    for (;;) {
        sum = 0u; cnt = 0u; mine = 0u;
#pragma unroll
        for (unsigned j = 0; j < 16; ++j) { const unsigned c = xb_ld(&bar[XB_XCNT(j)]); sum += c; cnt += (c > 0u) ? 1u : 0u; mine = (j == x) ? c : mine; }
        if (sum == G) break;
        __builtin_amdgcn_s_sleep(1);
        if ((++sp & 255u) == 0u) { if (xb_ld(&bar[XB_TMO])) break; if (sp > XB_SPIN_CAP) { atomicAdd(&bar[XB_TMO], 1u); break; } }
    }
    nloc = mine > 0u ? mine : 1u; nx = cnt > 0u ? cnt : 1u;
}
__device__ __forceinline__ void xcd_barrier(const XcdBarrier& b) {
    asm volatile("s_waitcnt vmcnt(0)" ::: "memory");
    __syncthreads();
    if (threadIdx.x == 0) {
        unsigned* bar = b.bar;
        __builtin_amdgcn_s_waitcnt(0);
        unsigned nloc = b.st[0], nx = b.st[1];
        if (nloc == 0u) { xcd_barrier_complete(bar, b.x, nloc, nx); b.st[0] = nloc; b.st[1] = nx; }
        const unsigned old = xb_add(&bar[XB_XSUB(b.x)], 1u);
        const unsigned gen = old / nloc;
        if (old + 1u == (gen + 1u) * nloc) {
            __builtin_amdgcn_fence(__ATOMIC_RELEASE, "agent");
            asm volatile("s_waitcnt vmcnt(0)" ::: "memory");
            const unsigned og = xb_add(&bar[XB_TOP], 1u);
            const unsigned tg = og / nx;
            if (og + 1u == (tg + 1u) * nx) xb_add(&bar[XB_TOPGEN], 1u);
            else XB_SPIN(xb_ld(&bar[XB_TOPGEN]) == tg, bar);
            __builtin_amdgcn_fence(__ATOMIC_ACQUIRE, "agent");
            xb_add(&bar[XB_XGEN(b.x)], 1u);
            asm volatile("s_waitcnt vmcnt(0)" ::: "memory");
        } else {
            XB_SPIN(xb_ld(&bar[XB_XGEN(b.x)]) == gen, bar);
            __builtin_amdgcn_fence(__ATOMIC_ACQUIRE, "agent");
            asm volatile("s_waitcnt vmcnt(0)" ::: "memory");
        }
    }
    __syncthreads();
}

constexpr int PH_PER_LAYER = 14, N_PHASES = 2 * PH_PER_LAYER + 1;

__global__ void __launch_bounds__(512, 2) fwd_megakernel(Params pk) {
    extern __shared__ __attribute__((aligned(16))) unsigned char shm[];
    LAS unsigned char* lds = (LAS unsigned char*)shm;
    cg::grid_group grid = cg::this_grid();
    const int phase_lo = pk.phase_lo, phase_hi = pk.phase_hi;
    volatile LAS unsigned* xst = (volatile LAS unsigned*)(lds + LDS_BYTES - 16);
    XcdBarrier xb; xb.bar = pk.bar; xb.x = 0; xb.st = xst;
    if (phase_hi - phase_lo > 1) { if (threadIdx.x == 0) { xst[0] = 0u; xst[1] = 0u; } __syncthreads(); xb = xcd_barrier_post(pk.bar, xst); }
    for (int ph = phase_lo; ph < phase_hi; ++ph) {
        const int l = ph / PH_PER_LAYER, q = ph % PH_PER_LAYER;
        if (ph == N_PHASES - 1) {
            const Params p = load_params();
            phase_rmsnorm(p.out, p.final_g, nullptr, p.out);
        } else if (q == 0) {
            { const int nrep = (PROBE_Q == 0 && l == 0) ? 2 : 1; for (int rep = 0; rep < nrep; ++rep) {
            phase_convert(l, shm);
            const Params p = load_params();
            phase_rmsnorm(l == 0 ? p.x : p.out, p.norm_g + (size_t)l * DM, p.xn, nullptr); } }
        } else if (q == 1 || q == 5 || q == 8) {
            const Params p = load_params(); const int G = gridDim.x, cidx = opaque_bid();
            const int N = (q == 1) ? LDA_H : (q == 5) ? LDB_H : LDC_H; const int r0 = (q == 1) ? 0 : (q == 5) ? LDA_H : (LDA_H + LDB_H);
            pg8::GemmDesc g; g.A = p.xn; g.Bt = p.Wt + (size_t)r0 * DM; g.lda = DM;
            pg8::Sched S; S.init(T_TOK, N, G, cidx, 1);
            pg8::EpiStore E; E.O = p.H; E.ldc = N;
{ const int nrep = ((PROBE_Q == 1 && l == 0 && q == 1) || (PROBE_Q == 50 && l == 0 && q == 5) || (PROBE_Q == 80 && l == 0 && q == 8)) ? 2 : 1; for (int rep = 0; rep < nrep; ++rep) pg8::gemm_phase(lds, g, g, S, E); }
        } else if (q == 2) {
{ const int nrep = (PROBE_Q == 2 && l == 0) ? 2 : 1; for (int rep = 0; rep < nrep; ++rep) phase_rwkv(l, shm, rep + 1 < nrep ? PROBE_MODE : 0); }
        } else if (q == 3) {
            phase_rwkv_post(l, nullptr);
        } else if (q == 6) {
{ const int nrep = (PROBE_Q == 6 && l == 0) ? 2 : 1; for (int rep = 0; rep < nrep; ++rep) { const Params p = load_params(); phase_sgu(l, shm, rep + 1 < nrep ? (bf16_t*)p.out : nullptr); } }
        } else if (q == 9) {
            { const int nrep = (PROBE_Q == 9 && l == 0) ? 2 : 1; for (int rep = 0; rep < nrep; ++rep) phase_hgrn_pre(l, shm, rep + 1 < nrep); }
        } else if (q == 10) {
            { const int nrep = (PROBE_Q == 10 && l == 0) ? 2 : 1; for (int rep = 0; rep < nrep; ++rep) phase_hgrn_seq(l, shm, rep + 1 < nrep); }
        } else if (q == 11) {
            phase_hgrn_post(l);
        } else if (q == 4 || q == 7 || q == 12) {
            const Params p = load_params(); const int G = gridDim.x, cidx = opaque_bid();
            bf16_t* WtBr = p.Wt + (size_t)WT_ROWS * DM;
            const int n = (q == 4) ? 0 : (q == 7) ? 1 : 2; const int ldh = (n == 0) ? LDA_H : (n == 1) ? LDB_H : LDC_H; const int ocol = (n == 0) ? 3200 : (n == 1) ? 2048 : 3072;
            pg8::GemmDesc g0, g1; g0.A = p.xn; g0.Bt = p.Wt + (size_t)(LDA_H + LDB_H + LDC_H + n * DM) * DM; g0.lda = DM;
            g1.A = p.H + ocol; g1.Bt = WtBr + (size_t)n * DM * DM; g1.lda = ldh;
            pg8::Sched S; S.init(T_TOK, DM, G, cidx, 2);
            pg8::EpiMerge E; E.G = p.H; E.ldg = ldh; E.bias = p.b_merge + ((size_t)l * 3 + n) * DM; E.Y = p.y; E.accum = (n > 0);
            { const int nrep = (PROBE_Q == 4 && l == 0 && q == 4) ? 2 : 1; for (int rep = 0; rep < nrep; ++rep) pg8::gemm_phase(lds, g0, g1, S, E); }
        } else {
            const Params p = load_params(); const int G = gridDim.x, cidx = opaque_bid();
            bf16_t* WtOut = p.Wt + (size_t)WT_ROWS * DM + (size_t)3 * DM * DM;
            pg8::GemmDesc g; g.A = p.y; g.Bt = WtOut; g.lda = DM;
            pg8::Sched S; S.init(T_TOK, DM, G, cidx, 1);
            pg8::EpiResid E; E.Xin = (l == 0) ? p.x : p.out; E.Xout = p.out;
            { const int nrep = (PROBE_Q == 13 && l == 0) ? 2 : 1; for (int rep = 0; rep < nrep; ++rep) pg8::gemm_phase(lds, g, g, S, E); }
        }
        if (ph + 1 < phase_hi) { if (ph == phase_lo) grid.sync(); else xcd_barrier(xb); }
    }
}

extern "C" void kernel_launch(void* const* d_in, const int* in_sizes, int n_in, void* d_out, int out_size, void* d_ws, size_t ws_size, hipStream_t stream) {
    static int grid_blocks = 0;
    if (!grid_blocks) {
        int dev = 0, cus = 0, per_cu = 0;
        hipGetDevice(&dev);
        hipDeviceGetAttribute(&cus, hipDeviceAttributeMultiprocessorCount, dev);
        if (hipFuncSetAttribute((const void*)fwd_megakernel, hipFuncAttributeMaxDynamicSharedMemorySize, LDS_BYTES) != hipSuccess) { fprintf(stderr, "hipFuncSetAttribute failed\n"); return; }
        hipOccupancyMaxActiveBlocksPerMultiprocessor(&per_cu, (const void*)fwd_megakernel, 512, LDS_BYTES);
        if (per_cu < 1) { fprintf(stderr, "occupancy query says 0 blocks per CU\n"); return; }
        grid_blocks = cus * 1;
    }
    Params p{};
    const float** fp = (const float**)&p;
    for (int i = 0; i < 26; ++i) fp[i] = (const float*)d_in[i];
    p.out = (float*)d_out;
    unsigned char* ws = (unsigned char*)d_ws; size_t off = 0;
    auto take = [&](size_t bytes) { unsigned char* r = ws + off; off += (bytes + 255) & ~(size_t)255; return r; };
    p.Wt = (bf16_t*)take(((size_t)WT_ROWS * DM + 4 * (size_t)DM * DM) * 2);
    p.xn = (bf16_t*)take((size_t)T_TOK * DM * 2);
    p.vf = (bf16_t*)take((size_t)T_TOK * DM * 2);
    p.y = (bf16_t*)take((size_t)T_TOK * DM * 2);
    p.H = (bf16_t*)take((size_t)T_TOK * LDA_H * 2);
    p.rkbuf = (float*)take((size_t)T_TOK * 16 * 2 * 4);
    p.bar = (unsigned*)take((size_t)XCD_BAR_WORDS * 4);
    if (off > ws_size) { fprintf(stderr, "workspace too small: need %zu have %zu\n", off, ws_size); return; }
#if SINGLE_LAUNCH
    p.phase_lo = 0; p.phase_hi = N_PHASES;
    void* args[] = {&p};
    if (hipMemsetAsync(p.bar, 0, (size_t)XCD_BAR_WORDS * 4, stream) != hipSuccess) { fprintf(stderr, "memset failed\n"); return; }
    hipError_t e = hipLaunchCooperativeKernel((const void*)fwd_megakernel, dim3(grid_blocks), dim3(512), args, LDS_BYTES, stream);
    if (e != hipSuccess) fprintf(stderr, "cooperative launch failed: %s (grid %d)\n", hipGetErrorString(e), grid_blocks);
#else
    for (int ph = 0; ph < N_PHASES; ++ph) {
        p.phase_lo = ph; p.phase_hi = ph + 1;
        hipLaunchKernelGGL(fwd_megakernel, dim3(grid_blocks), dim3(512), LDS_BYTES, stream, p);
    }
#endif
}
```

```cpp
#include <hip/hip_runtime.h>
#include <hip/hip_cooperative_groups.h>
#include <cstdio>
namespace cg = cooperative_groups;

#ifndef PROBE_MODE
#define PROBE_MODE 0
#endif
#ifndef PROBE_Q
#define PROBE_Q -1
#endif
#ifndef SINGLE_LAUNCH
#define SINGLE_LAUNCH 1
#endif

typedef unsigned short bf16_t;
typedef short bf16x8 __attribute__((ext_vector_type(8)));
typedef float f32x4 __attribute__((ext_vector_type(4)));
typedef float f32x2 __attribute__((ext_vector_type(2)));
typedef unsigned u32x4 __attribute__((ext_vector_type(4)));
typedef unsigned u32x2 __attribute__((ext_vector_type(2)));
#define LAS __attribute__((address_space(3)))

constexpr int T_TOK = 32768, DM = 1024, SEQ = 4096, NB = 8;
constexpr int N_IN = 14464;
constexpr int LDA_H = 4352, LDB_H = 3072, LDC_H = 4096;
constexpr int WT_ROWS = 14592;
constexpr int LDS_BYTES = 163840;
constexpr float EPS = 1e-6f, GN_EPS = 64e-5f;

struct Params {
    const float *x, *norm_g, *w_in, *b_merge, *mu, *w0, *w_w2, *a0, *a_w2, *v0, *v_w1, *v_w2, *k_k, *k_a, *r_k, *lnx_g, *lnx_b,
        *sgu_ln_g, *sgu_ln_b, *sgu_w, *sgu_b, *lb_logits, *hgrn_g, *w_branch, *w_out, *final_g;
    float* out;
    bf16_t *Wt, *xn, *vf, *y, *H;
    float* rkbuf;
    unsigned* bar;
    int phase_lo, phase_hi;
};

__device__ __forceinline__ float bf2f(bf16_t h) { return __uint_as_float(((unsigned)h) << 16); }
__device__ __forceinline__ float bflo(unsigned u) { return __uint_as_float(u << 16); }
__device__ __forceinline__ float bfhi(unsigned u) { return __uint_as_float(u & 0xffff0000u); }
typedef __bf16 bf16x2_t __attribute__((ext_vector_type(2)));
__device__ __forceinline__ unsigned cvt_pk_bf16(float lo, float hi) { const f32x2 v = {lo, hi}; const bf16x2_t r = __builtin_convertvector(v, bf16x2_t); return __builtin_bit_cast(unsigned, r); }
__device__ __forceinline__ bf16_t f2bf(float f) { return (bf16_t)(cvt_pk_bf16(f, 0.f) & 0xffffu); }
__device__ __forceinline__ float sigmoidf_(float x) { return __builtin_amdgcn_rcpf(1.0f + __expf(-x)); }
__device__ __forceinline__ float siluf_(float x) { return x * __builtin_amdgcn_rcpf(1.0f + __expf(-x)); }
__device__ __forceinline__ float tanh_fast(float x) { return 1.0f - 2.0f * __builtin_amdgcn_rcpf(1.0f + __expf(2.0f * x)); }

__device__ __forceinline__ Params load_params() {
#if defined(__HIP_DEVICE_COMPILE__)
    typedef const Params __attribute__((address_space(4)))* KP;
    KP kp = (KP)__builtin_amdgcn_kernarg_segment_ptr(); asm volatile("" : "+s"(kp)); return *kp;
#else
    return Params{};
#endif
}
__device__ __forceinline__ int opaque_tid() { int t = threadIdx.x; asm volatile("" : "+v"(t)); return t; }
__device__ __forceinline__ int opaque_bid() { int t = blockIdx.x; asm volatile("" : "+s"(t)); return t; }

namespace pg8 {
constexpr int BM = 256, BK = 64, HALF = 128, HTB = HALF * BK * 2, STAGE_BYTES = 8 * HTB, NXCD = 8, WGM = 8, KD = 1024;
__device__ __forceinline__ int lds_byte(int r, int c) { const int st = (r >> 4) * 2 + (c >> 5), rr = r & 15, cc = c & 31, ob = rr * 64 + cc * 2; return st * 1024 + (ob ^ (((ob >> 9) & 1) << 5)); }
__device__ __forceinline__ void stage_rc(int b, int& R, int& C) { const int st = b / 1024, sb = b % 1024, swz = sb ^ (((sb >> 9) & 1) << 5); R = (st >> 1) * 16 + swz / 64; C = (st & 1) * 32 + (swz % 64) / 2; }
__device__ __forceinline__ int perm32(int rho) { const int n = rho >> 4, i = rho & 15; return 8 * (i >> 2) + 4 * n + (i & 3); }

struct Unit { int pm, pn, sel; };
struct GemmDesc { const bf16_t* A; const bf16_t* Bt; int lda; };
struct Sched {
    int nM, nN, nwg, G, c, nsel;
    __device__ void init(int M, int N, int G_, int c_, int nsel_) { nM = M / BM; nN = N / BM; nwg = nM * nN; G = G_; c = c_; nsel = nsel_; }
    __device__ bool next(int i, Unit& u) const {
        const int ti = (nsel == 2) ? (i >> 1) : i; u.sel = (nsel == 2) ? (i & 1) : 0;
        const long L = (long)ti * G + c; if (L >= nwg) return false;
        int wgid = (int)L; { const int q = nwg / NXCD, r = nwg % NXCD, xcd = wgid % NXCD, off = wgid / NXCD; wgid = (xcd < r ? xcd * (q + 1) : r * (q + 1) + (xcd - r) * q) + off; }
        const int nig = WGM * nN, gid = wgid / nig, fm = gid * WGM, gsz = (nM - fm) < WGM ? (nM - fm) : WGM;
        u.pm = fm + ((wgid % nig) % gsz); u.pn = (wgid % nig) / gsz; return true;
    }
};

template <class Epi>
__device__ __forceinline__ void gemm_phase(LAS unsigned char* lds, const GemmDesc g0, const GemmDesc g1, const Sched& S, const Epi& E) {
    const int tid = opaque_tid(), wid = __builtin_amdgcn_readfirstlane(tid >> 6), lane = tid & 63, wr = wid >> 2, wc = wid & 3, fr = lane & 15, fq = lane >> 4;
    constexpr int K = KD, nt = K / BK;
    unsigned voffA0[2], voffA1[2], voffB[2];
#pragma unroll
    for (int i = 0; i < 2; ++i) { int R, C; stage_rc(tid * 16 + i * 8192, R, C); const int Rb = Epi::PERM ? ((R & ~31) + perm32(R & 31)) : R;
        voffA0[i] = (unsigned)(R * g0.lda + C) * 2u; voffA1[i] = (unsigned)(R * g1.lda + C) * 2u; voffB[i] = (unsigned)(Rb * K + C) * 2u; }
    const size_t kstep = (size_t)(BK * 2);
    const size_t hstepB = (size_t)HALF * K * 2;
    const unsigned ldsw = (unsigned)wid * 1024u;
    const int aoff = lds_byte(wr * 64 + fr, fq * 8), boff = lds_byte(wc * 32 + fr, fq * 8);
#define PG8_SA(b, h) (((b) * 2 + (h)) * HTB)
#define PG8_SB(b, h) ((4 + (b) * 2 + (h)) * HTB)
#define PG8_STAGE(bufoff, gbase, v0, v1) do { \
        __builtin_amdgcn_global_load_lds((const unsigned*)((const char*)(gbase) + (v0)), (LAS unsigned*)(lds + (bufoff) + ldsw), 16, 0, 0); \
        __builtin_amdgcn_global_load_lds((const unsigned*)((const char*)(gbase) + (v1)), (LAS unsigned*)(lds + (bufoff) + ldsw + 8192), 16, 0, 0); } while (0)
#define PG8_STAGEB(bufoff, gbase) PG8_STAGE(bufoff, gbase, voffB[0], voffB[1])
#define PG8_LDA(dst, b, h) do { _Pragma("unroll") for (int m = 0; m < 4; ++m) _Pragma("unroll") for (int k = 0; k < 2; ++k) dst[m][k] = *(const LAS bf16x8*)(lds + PG8_SA(b, h) + aoff + m * 2048 + k * 1024); } while (0)
#define PG8_LDB(dst, b, h) do { _Pragma("unroll") for (int n = 0; n < 2; ++n) _Pragma("unroll") for (int k = 0; k < 2; ++k) dst[n][k] = *(const LAS bf16x8*)(lds + PG8_SB(b, h) + boff + n * 2048 + k * 1024); } while (0)
#define PG8_MMA(ai, bj, At, Bt) do { __builtin_amdgcn_s_setprio(1); _Pragma("unroll") for (int m = 0; m < 4; ++m) _Pragma("unroll") for (int n = 0; n < 2; ++n) _Pragma("unroll") for (int k = 0; k < 2; ++k) \
        acc[ai][bj][m][n] = __builtin_amdgcn_mfma_f32_16x16x32_bf16(Bt[n][k], At[m][k], acc[ai][bj][m][n], 0, 0, 0); __builtin_amdgcn_s_setprio(0); } while (0)
#define PG8_WAIT_V(n) asm volatile("s_waitcnt vmcnt(" #n ")" ::: "memory")
#define PG8_WAIT_L(n) asm volatile("s_waitcnt lgkmcnt(" #n ")" ::: "memory")
#define PG8_BAR __builtin_amdgcn_s_barrier()
#define PG8_SCHED __builtin_amdgcn_sched_barrier(0)
    Unit cur, nxt; int ui = 0;
    if (!S.next(0, cur)) return;
    f32x4 acc[2][2][4][2];
#pragma unroll
    for (int a = 0; a < 2; ++a)
#pragma unroll
        for (int b = 0; b < 2; ++b)
#pragma unroll
            for (int m = 0; m < 4; ++m)
#pragma unroll
                for (int n = 0; n < 2; ++n) acc[a][b][m][n] = (f32x4){0.f, 0.f, 0.f, 0.f};
    bf16x8 At[4][2], B0[2][2], B1[2][2];
    const char* cA = (const char*)(cur.sel ? g1.A : g0.A) + (size_t)cur.pm * 256 * (size_t)(cur.sel ? g1.lda : g0.lda) * 2;
    const char* cB = (const char*)(cur.sel ? g1.Bt : g0.Bt) + (size_t)cur.pn * 256 * K * 2;
    size_t chA = (size_t)HALF * (cur.sel ? g1.lda : g0.lda) * 2;
    unsigned cv0 = cur.sel ? voffA1[0] : voffA0[0], cv1 = cur.sel ? voffA1[1] : voffA0[1];
    PG8_STAGEB(PG8_SB(0, 0), cB); PG8_STAGE(PG8_SA(0, 0), cA, cv0, cv1); PG8_STAGEB(PG8_SB(0, 1), cB + hstepB); PG8_STAGE(PG8_SA(0, 1), cA + chA, cv0, cv1);
    if (wr == 1) PG8_BAR;
    PG8_WAIT_V(4); PG8_BAR;
    PG8_STAGEB(PG8_SB(1, 0), cB + kstep); PG8_STAGE(PG8_SA(1, 0), cA + kstep, cv0, cv1); PG8_STAGEB(PG8_SB(1, 1), cB + hstepB + kstep);
    PG8_WAIT_V(6); PG8_BAR;
    for (;;) {
        const bool has_next = S.next(ui + 1, nxt);
        const int nsel = has_next ? nxt.sel : cur.sel;
        const char* nA = has_next ? (const char*)(nsel ? g1.A : g0.A) + (size_t)nxt.pm * 256 * (size_t)(nsel ? g1.lda : g0.lda) * 2 : cA;
        const char* nB = has_next ? (const char*)(nsel ? g1.Bt : g0.Bt) + (size_t)nxt.pn * 256 * K * 2 : cB;
        const size_t nhA = (size_t)HALF * (nsel ? g1.lda : g0.lda) * 2;
        const unsigned nv0 = nsel ? voffA1[0] : voffA0[0], nv1 = nsel ? voffA1[1] : voffA0[1];
        for (int t = 0; t < nt; t += 2) {
            const bool last = (t == nt - 2);
            const char* a1 = cA + (size_t)(t + 1) * kstep;
            const char* a2 = last ? nA : cA + (size_t)(t + 2) * kstep; const char* b2 = last ? nB : cB + (size_t)(t + 2) * kstep;
            const char* a3 = a2 + kstep; const char* b3 = b2 + kstep;
            const size_t h2 = last ? nhA : chA; const unsigned w0 = last ? nv0 : cv0, w1 = last ? nv1 : cv1;
            PG8_LDB(B0, 0, 0); PG8_SCHED; PG8_LDA(At, 0, 0); PG8_STAGE(PG8_SA(1, 1), a1 + chA, cv0, cv1);
            PG8_WAIT_L(8); PG8_BAR; PG8_WAIT_L(0); PG8_MMA(0, 0, At, B0); PG8_BAR; PG8_SCHED;
            PG8_LDB(B1, 0, 1); PG8_STAGEB(PG8_SB(0, 0), b2);
            PG8_BAR; PG8_WAIT_L(0); PG8_MMA(0, 1, At, B1); PG8_BAR;
            PG8_LDA(At, 0, 1); PG8_STAGE(PG8_SA(0, 0), a2, w0, w1);
            PG8_BAR; PG8_WAIT_L(0); PG8_MMA(1, 0, At, B0); PG8_BAR; PG8_SCHED;
            PG8_STAGEB(PG8_SB(0, 1), b2 + hstepB);
            PG8_WAIT_V(6); PG8_BAR; PG8_MMA(1, 1, At, B1); PG8_BAR;
            PG8_LDB(B0, 1, 0); PG8_SCHED; PG8_LDA(At, 1, 0); PG8_STAGE(PG8_SA(0, 1), a2 + h2, w0, w1);
            PG8_WAIT_L(8); PG8_BAR; PG8_WAIT_L(0); PG8_MMA(0, 0, At, B0); PG8_BAR; PG8_SCHED;
            PG8_LDB(B1, 1, 1); PG8_STAGEB(PG8_SB(1, 0), b3);
            PG8_BAR; PG8_WAIT_L(0); PG8_MMA(0, 1, At, B1); PG8_BAR;
            PG8_LDA(At, 1, 1); PG8_STAGE(PG8_SA(1, 0), a3, w0, w1);
            PG8_BAR; PG8_WAIT_L(0); PG8_MMA(1, 0, At, B0); PG8_BAR; PG8_SCHED;
            PG8_STAGEB(PG8_SB(1, 1), b3 + hstepB);
            PG8_WAIT_V(6); PG8_BAR; PG8_MMA(1, 1, At, B1); PG8_BAR;
        }
        E(acc, cur, wr, wc, fr, fq);
        if (!has_next) break;
#pragma unroll
        for (int a = 0; a < 2; ++a)
#pragma unroll
            for (int b = 0; b < 2; ++b)
#pragma unroll
                for (int m = 0; m < 4; ++m)
#pragma unroll
                    for (int n = 0; n < 2; ++n) acc[a][b][m][n] = (f32x4){0.f, 0.f, 0.f, 0.f};
        cur = nxt; cA = nA; cB = nB; chA = nhA; cv0 = nv0; cv1 = nv1; ++ui;
    }
    PG8_WAIT_V(0);
    if (wr == 0) PG8_BAR;
    PG8_BAR;
#undef PG8_SA
#undef PG8_SB
#undef PG8_STAGE
#undef PG8_STAGEB
#undef PG8_LDA
#undef PG8_LDB
#undef PG8_MMA
#undef PG8_WAIT_V
#undef PG8_WAIT_L
#undef PG8_BAR
#undef PG8_SCHED
}

struct EpiStore {
    static constexpr bool PERM = true;
    bf16_t* O; int ldc;
    __device__ __forceinline__ void operator()(const f32x4 (&acc)[2][2][4][2], const Unit& u, int wr, int wc, int fr, int fq) const {
        const int row0 = u.pm * BM + wr * 64 + fr, col0 = u.pn * BM + wc * 32 + 8 * fq;
#pragma unroll
        for (int ai = 0; ai < 2; ++ai)
#pragma unroll
            for (int m = 0; m < 4; ++m) { bf16_t* rowp = O + (size_t)(row0 + ai * HALF + m * 16) * ldc + col0;
#pragma unroll
                for (int bj = 0; bj < 2; ++bj) { const f32x4 v0 = acc[ai][bj][m][0], v1 = acc[ai][bj][m][1];
                    u32x4 w; w.x = cvt_pk_bf16(v0[0], v0[1]); w.y = cvt_pk_bf16(v0[2], v0[3]); w.z = cvt_pk_bf16(v1[0], v1[1]); w.w = cvt_pk_bf16(v1[2], v1[3]);
                    *(u32x4*)(rowp + bj * HALF) = w; } }
    }
};
struct EpiMerge {
    static constexpr bool PERM = true;
    bf16_t* G; int ldg; const float* bias; bf16_t* Y; int accum;
    __device__ __forceinline__ void operator()(const f32x4 (&acc)[2][2][4][2], const Unit& u, int wr, int wc, int fr, int fq) const {
        const int row0 = u.pm * BM + wr * 64 + fr, col0 = u.pn * BM + wc * 32 + 8 * fq;
        if (u.sel == 0) {
            f32x4 bv[2][2];
#pragma unroll
            for (int bj = 0; bj < 2; ++bj)
#pragma unroll
                for (int n = 0; n < 2; ++n) bv[bj][n] = *(const f32x4*)(bias + col0 + bj * HALF + 4 * n);
#pragma unroll
            for (int ai = 0; ai < 2; ++ai)
#pragma unroll
                for (int m = 0; m < 4; ++m) { bf16_t* rowp = G + (size_t)(row0 + ai * HALF + m * 16) * ldg + col0;
#pragma unroll
                    for (int bj = 0; bj < 2; ++bj) { f32x4 v0 = acc[ai][bj][m][0] + bv[bj][0], v1 = acc[ai][bj][m][1] + bv[bj][1];
#pragma unroll
                        for (int j = 0; j < 4; ++j) { v0[j] = sigmoidf_(v0[j]); v1[j] = sigmoidf_(v1[j]); }
                        u32x4 w; w.x = cvt_pk_bf16(v0[0], v0[1]); w.y = cvt_pk_bf16(v0[2], v0[3]); w.z = cvt_pk_bf16(v1[0], v1[1]); w.w = cvt_pk_bf16(v1[2], v1[3]);
                        *(u32x4*)(rowp + bj * HALF) = w; } }
        } else {
#pragma unroll
            for (int ai = 0; ai < 2; ++ai)
#pragma unroll
                for (int m = 0; m < 4; ++m) { const size_t r = (size_t)(row0 + ai * HALF + m * 16);
                    const unsigned long long* gp = (const unsigned long long*)(G + r * ldg + col0); bf16_t* yp = Y + r * DM + col0;
#pragma unroll
                    for (int bj = 0; bj < 2; ++bj) {
                        const unsigned long long g0 = __hip_atomic_load(gp + bj * (HALF / 4), __ATOMIC_RELAXED, __HIP_MEMORY_SCOPE_AGENT);
                        const unsigned long long g1 = __hip_atomic_load(gp + bj * (HALF / 4) + 1, __ATOMIC_RELAXED, __HIP_MEMORY_SCOPE_AGENT);
                        const unsigned gw[4] = {(unsigned)g0, (unsigned)(g0 >> 32), (unsigned)g1, (unsigned)(g1 >> 32)};
                        u32x4 yo = {0u, 0u, 0u, 0u}; if (accum) yo = *(const u32x4*)(yp + bj * HALF);
                        const f32x4 v0 = acc[ai][bj][m][0], v1 = acc[ai][bj][m][1];
                        u32x4 w;
                        w.x = cvt_pk_bf16(bflo(yo.x) + bflo(gw[0]) * v0[0], bfhi(yo.x) + bfhi(gw[0]) * v0[1]);
                        w.y = cvt_pk_bf16(bflo(yo.y) + bflo(gw[1]) * v0[2], bfhi(yo.y) + bfhi(gw[1]) * v0[3]);
                        w.z = cvt_pk_bf16(bflo(yo.z) + bflo(gw[2]) * v1[0], bfhi(yo.z) + bfhi(gw[2]) * v1[1]);
                        w.w = cvt_pk_bf16(bflo(yo.w) + bflo(gw[3]) * v1[2], bfhi(yo.w) + bfhi(gw[3]) * v1[3]);
                        *(u32x4*)(yp + bj * HALF) = w; } }
        }
    }
};
struct EpiResid {
    static constexpr bool PERM = false;
    const float* Xin; float* Xout;
    __device__ __forceinline__ void operator()(const f32x4 (&acc)[2][2][4][2], const Unit& u, int wr, int wc, int fr, int fq) const {
        const int row0 = u.pm * BM + wr * 64 + fr, col0 = u.pn * BM + wc * 32 + 4 * fq;
#pragma unroll
        for (int ai = 0; ai < 2; ++ai)
#pragma unroll
            for (int m = 0; m < 4; ++m) { const size_t ro = (size_t)(row0 + ai * HALF + m * 16) * DM + col0;
#pragma unroll
                for (int bj = 0; bj < 2; ++bj)
#pragma unroll
                    for (int n = 0; n < 2; ++n) { const f32x4 xi = *(const f32x4*)(Xin + ro + bj * HALF + n * 16); *(f32x4*)(Xout + ro + bj * HALF + n * 16) = xi + acc[ai][bj][m][n]; } }
    }
};
}

__device__ void phase_convert(int l, unsigned char* smem) {
    const Params p = load_params();
    float* tile = (float*)smem;
    const int tid = opaque_tid();
    const float* win = p.w_in + (size_t)l * DM * N_IN;
    bf16_t* WtIn = p.Wt; bf16_t* WtBr = p.Wt + (size_t)WT_ROWS * DM; bf16_t* WtOut = WtBr + (size_t)3 * DM * DM;
    const int NT_IN = WT_ROWS / 64;
    const int total = (NT_IN + 48 + 16) * 16;
    for (int it = blockIdx.x; it < total; it += gridDim.x) {
        const int ntile = it >> 4, kt = it & 15, k0 = kt * 64;
        const float* src = nullptr; int ld = 0, c0 = 0, valid = 64; bf16_t* dst;
        if (ntile < NT_IN) {
            const int n0 = ntile * 64; dst = WtIn + (size_t)n0 * DM;
            if (n0 < 4224) { src = win; ld = N_IN; c0 = n0; }
            else if (n0 < 4352) { if (n0 == 4224 && l > 0) { src = p.v_w1 + (size_t)(l - 1) * DM * 32; ld = 32; c0 = 0; valid = 32; } else { valid = 0; } }
            else { src = win; ld = N_IN; c0 = n0 - 128; }
        } else if (ntile < NT_IN + 48) {
            const int q = ntile - NT_IN, n = q >> 4, n0 = (q & 15) * 64;
            src = p.w_branch + ((size_t)l * 3 + n) * DM * DM; ld = DM; c0 = n0; dst = WtBr + ((size_t)n * DM + n0) * DM;
        } else {
            const int n0 = (ntile - NT_IN - 48) * 64; src = p.w_out + (size_t)l * DM * DM; ld = DM; c0 = n0; dst = WtOut + (size_t)n0 * DM;
        }
        __syncthreads();
        if (valid == 64) {
            const int kr = tid >> 4, nc = (tid & 15) * 4;
#pragma unroll
            for (int ps = 0; ps < 2; ++ps) { const int k = kr + ps * 32; const f32x4 v = *(const f32x4*)(src + (size_t)(k0 + k) * ld + c0 + nc);
                tile[k * 65 + nc] = v[0]; tile[k * 65 + nc + 1] = v[1]; tile[k * 65 + nc + 2] = v[2]; tile[k * 65 + nc + 3] = v[3]; }
        } else {
            for (int e = tid; e < 4096; e += 512) { const int k = e >> 6, n = e & 63; tile[k * 65 + n] = (n < valid) ? src[(size_t)(k0 + k) * ld + c0 + n] : 0.f; }
        }
        __syncthreads();
        { const int nr = tid >> 3, kc = (tid & 7) * 8; u32x4 w;
          w.x = cvt_pk_bf16(tile[(kc + 0) * 65 + nr], tile[(kc + 1) * 65 + nr]); w.y = cvt_pk_bf16(tile[(kc + 2) * 65 + nr], tile[(kc + 3) * 65 + nr]);
          w.z = cvt_pk_bf16(tile[(kc + 4) * 65 + nr], tile[(kc + 5) * 65 + nr]); w.w = cvt_pk_bf16(tile[(kc + 6) * 65 + nr], tile[(kc + 7) * 65 + nr]);
          *(u32x4*)(dst + (size_t)nr * DM + k0 + kc) = w; }
    }
    __syncthreads();
}

__device__ void phase_rmsnorm(const float* x, const float* g, bf16_t* xn, float* outf) {
    const int tid_ = opaque_tid(); const int lane = tid_ & 63, wv = tid_ >> 6;
    f32x4 gv[4];
#pragma unroll
    for (int q = 0; q < 4; ++q) gv[q] = *(const f32x4*)(g + q * 256 + lane * 4);
    for (int row = blockIdx.x * 8 + wv; row < T_TOK; row += gridDim.x * 8) {
        const float* xr = x + (size_t)row * DM; f32x4 v[4]; float ss = 0.f;
#pragma unroll
        for (int q = 0; q < 4; ++q) { v[q] = *(const f32x4*)(xr + q * 256 + lane * 4); ss += v[q][0] * v[q][0] + v[q][1] * v[q][1] + v[q][2] * v[q][2] + v[q][3] * v[q][3]; }
#pragma unroll
        for (int o = 32; o > 0; o >>= 1) ss += __shfl_xor(ss, o);
        const float rinv = rsqrtf(ss * (1.0f / DM) + EPS);
#pragma unroll
        for (int q = 0; q < 4; ++q) { const f32x4 o = v[q] * rinv * gv[q];
            if (xn) { u32x2 w; w.x = cvt_pk_bf16(o[0], o[1]); w.y = cvt_pk_bf16(o[2], o[3]); *(u32x2*)(xn + (size_t)row * DM + q * 256 + lane * 4) = w; }
            else *(f32x4*)(outf + (size_t)row * DM + q * 256 + lane * 4) = o; }
    }
}

template <int CTRL> __device__ __forceinline__ float dpp_f(float v) { return __int_as_float(__builtin_amdgcn_update_dpp(0, __float_as_int(v), CTRL, 0xf, 0xf, false)); }
__device__ __forceinline__ float red8(float v) { v += dpp_f<0xB1>(v); v += dpp_f<0x4E>(v); v += dpp_f<0x141>(v); return v; }
__device__ __forceinline__ float red16(float v) { v = red8(v); v += dpp_f<0x140>(v); return v; }

struct RwRaw { u32x4 cw[2], pw[2], ca[2], pa[2], vl; u32x2 cr[2], pr[2], ck[2], pk[2], cv, pv, vf; };
__device__ __forceinline__ void rw_load(RwRaw& R, const bf16_t* H, const bf16_t* vfp, int l, size_t tok, bool hasp, int h, int chh, int vnt, int fq) {
    const bf16_t* cur = H + tok * LDA_H; const bf16_t* prev = cur - LDA_H;
    const u32x4 z4 = {0u, 0u, 0u, 0u}; const u32x2 z2 = {0u, 0u};
#pragma unroll
    for (int ks = 0; ks < 2; ++ks) { const int m0 = ks * 32 + fq * 8;
        R.cw[ks] = *(const u32x4*)(cur + 3072 + m0); R.ca[ks] = *(const u32x4*)(cur + 3136 + m0);
        R.pw[ks] = hasp ? *(const u32x4*)(prev + 3072 + m0) : z4; R.pa[ks] = hasp ? *(const u32x4*)(prev + 3136 + m0) : z4; }
#pragma unroll
    for (int q = 0; q < 2; ++q) { const int cb = h * 64 + (chh * 2 + q) * 16 + fq * 4;
        R.cr[q] = *(const u32x2*)(cur + cb); R.ck[q] = *(const u32x2*)(cur + 1024 + cb);
        R.pr[q] = hasp ? *(const u32x2*)(prev + cb) : z2; R.pk[q] = hasp ? *(const u32x2*)(prev + 1024 + cb) : z2; }
    const int cbv = h * 64 + vnt * 16 + fq * 4;
    R.cv = *(const u32x2*)(cur + 2048 + cbv); R.pv = hasp ? *(const u32x2*)(prev + 2048 + cbv) : z2;
    R.vf = z2; R.vl = z4;
    if (l > 0) { R.vf = *(const u32x2*)(vfp + tok * DM + cbv); R.vl = *(const u32x4*)(cur + 4224 + fq * 8); }
}

__device__ void phase_rwkv(int l, unsigned char* smem, int mode) {
    const Params p = load_params();
    constexpr int TC = 32, NCH = SEQ / TC, RS = 68  , BUFSZ = 5 * TC * RS + TC * 32 + TC * 2;
    bf16_t* w2T = (bf16_t*)smem;
    bf16_t* a2T = w2T + 64 * 72;
    bf16_t* v2T = a2T + 64 * 72;
    float* cst = (float*)(v2T + 64 * 40);
    float* buf0 = cst + 11 * 64;
    float* ypart = buf0 + 2 * BUFSZ;
    float* sI = ypart + 4 * TC * 64;
    const int tid = opaque_tid(), wid = __builtin_amdgcn_readfirstlane(tid >> 6), lane = tid & 63, fr = lane & 15, fq = lane >> 4;
    for (int item = blockIdx.x; item < NB * 32; item += gridDim.x) {
        const int xc_ = item & 7, sl_ = item >> 3, half = sl_ & 1, pi_ = (sl_ >> 1) * 8 + xc_, b = pi_ >> 4, h = pi_ & 15;
        __syncthreads();
        for (int e = tid; e < 4096; e += 512) { const int m = e >> 6, j = e & 63; w2T[j * 72 + m] = f2bf(p.w_w2[((size_t)l * 64 + m) * DM + h * 64 + j]); a2T[j * 72 + m] = f2bf(p.a_w2[((size_t)l * 64 + m) * DM + h * 64 + j]); }
        if (l > 0) for (int e = tid; e < 2048; e += 512) { const int m = e >> 6, j = e & 63; v2T[j * 40 + m] = f2bf(p.v_w2[((size_t)(l - 1) * 32 + m) * DM + h * 64 + j]); }
        if (tid < 64) { const float* mu = p.mu + (size_t)l * 3200; const int cc = h * 64 + tid;
            cst[tid] = mu[cc]; cst[64 + tid] = mu[1024 + cc]; cst[128 + tid] = mu[2048 + cc]; cst[192 + tid] = p.w0[l * DM + cc]; cst[256 + tid] = p.a0[l * DM + cc];
            cst[320 + tid] = (l > 0) ? p.v0[(l - 1) * DM + cc] : 0.f; cst[384 + tid] = p.k_k[l * DM + cc]; cst[448 + tid] = p.k_a[l * DM + cc]; cst[512 + tid] = p.r_k[l * DM + cc];
            cst[576 + tid] = mu[3072 + tid]; cst[640 + tid] = mu[3136 + tid]; }
        __syncthreads();
        f32x2 st[4];
#pragma unroll
        for (int j = 0; j < 4; ++j) st[j] = (f32x2){0.f, 0.f};
        const int si = tid >> 3, seg = tid & 7;
        const int pwv = wid - 4, tti = pwv & 1, chh = (pwv >> 1) & 1, vnt = half * 2 + chh, tt = tti * 16 + fr;
        RwRaw raw;
        if (wid >= 4) rw_load(raw, p.H, p.vf, l, (size_t)b * SEQ + tt, tt > 0, h, chh, vnt, fq);
        for (int c = -1; c < NCH; ++c) {
            if (wid >= 4 && c + 1 < NCH && !(mode & 2)) {
                float* B_ = buf0 + ((c + 1) & 1) * BUFSZ;
                float* sR = B_; float* sW = sR + TC * RS; float* sK = sW + TC * RS; float* sA = sK + TC * RS; float* sB = sA + TC * RS; float* sV = sB + TC * RS; float* sS = sV + TC * 32;
                const size_t tok = (size_t)b * SEQ + (c + 1) * TC + tt;
                const RwRaw& cr_ = raw;
                bf16x8 AfW[2], AfA[2];
#pragma unroll
                for (int ks = 0; ks < 2; ++ks) { const int m0 = ks * 32 + fq * 8;
                    const f32x4 mw0 = *(const f32x4*)(cst + 576 + m0), mw1 = *(const f32x4*)(cst + 576 + m0 + 4), ma0 = *(const f32x4*)(cst + 640 + m0), ma1 = *(const f32x4*)(cst + 640 + m0 + 4);
                    const float muw[8] = {mw0[0], mw0[1], mw0[2], mw0[3], mw1[0], mw1[1], mw1[2], mw1[3]}, mua[8] = {ma0[0], ma0[1], ma0[2], ma0[3], ma1[0], ma1[1], ma1[2], ma1[3]};
                    const unsigned cwv[4] = {cr_.cw[ks].x, cr_.cw[ks].y, cr_.cw[ks].z, cr_.cw[ks].w}, pwq[4] = {cr_.pw[ks].x, cr_.pw[ks].y, cr_.pw[ks].z, cr_.pw[ks].w};
                    const unsigned cav[4] = {cr_.ca[ks].x, cr_.ca[ks].y, cr_.ca[ks].z, cr_.ca[ks].w}, pav[4] = {cr_.pa[ks].x, cr_.pa[ks].y, cr_.pa[ks].z, cr_.pa[ks].w};
                    unsigned ow[4], oa[4];
#pragma unroll
                    for (int e = 0; e < 4; ++e) {
                        const float c0 = bflo(cwv[e]), c1 = bfhi(cwv[e]), q0 = bflo(pwq[e]), q1 = bfhi(pwq[e]);
                        ow[e] = cvt_pk_bf16(tanh_fast(c0 + muw[2 * e] * (q0 - c0)), tanh_fast(c1 + muw[2 * e + 1] * (q1 - c1)));
                        const float d0 = bflo(cav[e]), d1 = bfhi(cav[e]), r0 = bflo(pav[e]), r1 = bfhi(pav[e]);
                        oa[e] = cvt_pk_bf16(d0 + mua[2 * e] * (r0 - d0), d1 + mua[2 * e + 1] * (r1 - d1)); }
                    AfW[ks] = __builtin_bit_cast(bf16x8, ((u32x4){ow[0], ow[1], ow[2], ow[3]})); AfA[ks] = __builtin_bit_cast(bf16x8, ((u32x4){oa[0], oa[1], oa[2], oa[3]})); }
                f32x4 accW[2], accA[2], accV = (f32x4){0.f, 0.f, 0.f, 0.f};
#pragma unroll
                for (int q = 0; q < 2; ++q) { const int nt = chh * 2 + q; accW[q] = (f32x4){0.f, 0.f, 0.f, 0.f}; accA[q] = (f32x4){0.f, 0.f, 0.f, 0.f};
#pragma unroll
                    for (int ks = 0; ks < 2; ++ks) { const bf16x8 bw = *(const bf16x8*)(w2T + (nt * 16 + fr) * 72 + ks * 32 + fq * 8), ba = *(const bf16x8*)(a2T + (nt * 16 + fr) * 72 + ks * 32 + fq * 8);
                        accW[q] = __builtin_amdgcn_mfma_f32_16x16x32_bf16(bw, AfW[ks], accW[q], 0, 0, 0); accA[q] = __builtin_amdgcn_mfma_f32_16x16x32_bf16(ba, AfA[ks], accA[q], 0, 0, 0); } }
                if (l > 0) { const bf16x8 bv = *(const bf16x8*)(v2T + (vnt * 16 + fr) * 40 + fq * 8); accV = __builtin_amdgcn_mfma_f32_16x16x32_bf16(bv, __builtin_bit_cast(bf16x8, cr_.vl), accV, 0, 0, 0); }
                float ss = 0.f, rk = 0.f;
#pragma unroll
                for (int q = 0; q < 2; ++q) { const int ch0 = (chh * 2 + q) * 16 + fq * 4;
                    const float fr_[4] = {bflo(cr_.cr[q].x), bfhi(cr_.cr[q].x), bflo(cr_.cr[q].y), bfhi(cr_.cr[q].y)}, fpr[4] = {bflo(cr_.pr[q].x), bfhi(cr_.pr[q].x), bflo(cr_.pr[q].y), bfhi(cr_.pr[q].y)};
                    const float fk_[4] = {bflo(cr_.ck[q].x), bfhi(cr_.ck[q].x), bflo(cr_.ck[q].y), bfhi(cr_.ck[q].y)}, fpk[4] = {bflo(cr_.pk[q].x), bfhi(cr_.pk[q].x), bflo(cr_.pk[q].y), bfhi(cr_.pk[q].y)};
                    const f32x4 mur = *(const f32x4*)(cst + ch0), muk = *(const f32x4*)(cst + 64 + ch0), w0v = *(const f32x4*)(cst + 192 + ch0), a0v = *(const f32x4*)(cst + 256 + ch0),
                        kkv = *(const f32x4*)(cst + 384 + ch0), kav = *(const f32x4*)(cst + 448 + ch0), rkv = *(const f32x4*)(cst + 512 + ch0);
                    f32x4 ro, wo, ko, ao, bo;
#pragma unroll
                    for (int e = 0; e < 4; ++e) {
                        const float r = fr_[e] + mur[e] * (fpr[e] - fr_[e]), k = fk_[e] + muk[e] * (fpk[e] - fk_[e]);
                        wo[e] = __expf(-0.60653065971f * sigmoidf_(w0v[e] + accW[q][e]));
                        const float a = sigmoidf_(a0v[e] + accA[q][e]);
                        const float kq = k * kkv[e]; ss += kq * kq; ao[e] = -kq; bo[e] = kq * a;
                        const float km = k * (1.0f + (a - 1.0f) * kav[e]); rk += r * km * rkv[e]; ro[e] = r; ko[e] = km; }
                    *(f32x4*)(sR + tt * RS + ch0) = ro; *(f32x4*)(sW + tt * RS + ch0) = wo; *(f32x4*)(sK + tt * RS + ch0) = ko; *(f32x4*)(sA + tt * RS + ch0) = ao; *(f32x4*)(sB + tt * RS + ch0) = bo; }
                ss += __shfl_xor(ss, 16); ss += __shfl_xor(ss, 32); rk += __shfl_xor(rk, 16); rk += __shfl_xor(rk, 32);
                if (fq == 0) { sS[tt * 2 + chh] = ss; if (half == 0) p.rkbuf[(size_t)((b * 16 + h) * 2 + chh) * SEQ + (c + 1) * TC + tt] = rk; }
                { const int ch0 = vnt * 16 + fq * 4, cb = h * 64 + ch0;
                  const float fv_[4] = {bflo(cr_.cv.x), bfhi(cr_.cv.x), bflo(cr_.cv.y), bfhi(cr_.cv.y)}, fpv[4] = {bflo(cr_.pv.x), bfhi(cr_.pv.x), bflo(cr_.pv.y), bfhi(cr_.pv.y)};
                  const f32x4 muv = *(const f32x4*)(cst + 128 + ch0), v0v = *(const f32x4*)(cst + 320 + ch0);
                  f32x4 vo;
#pragma unroll
                  for (int e = 0; e < 4; ++e) vo[e] = fv_[e] + muv[e] * (fpv[e] - fv_[e]);
                  if (l > 0) { const float vfv[4] = {bflo(cr_.vf.x), bfhi(cr_.vf.x), bflo(cr_.vf.y), bfhi(cr_.vf.y)};
#pragma unroll
                      for (int e = 0; e < 4; ++e) vo[e] = vo[e] + (vfv[e] - vo[e]) * sigmoidf_(v0v[e] + accV[e]); }
                  u32x2 w; w.x = cvt_pk_bf16(vo[0], vo[1]); w.y = cvt_pk_bf16(vo[2], vo[3]); *(u32x2*)(p.vf + tok * DM + cb) = w;
                  *(f32x4*)(sV + tt * 32 + chh * 16 + fq * 4) = vo; }
            }
            if (wid >= 4 && c + 2 < NCH && !(mode & 2)) rw_load(raw, p.H, p.vf, l, (size_t)b * SEQ + (size_t)(c + 2) * TC + tt, true, h, chh, vnt, fq);
            if (wid < 4 && c >= 0 && !(mode & 1)) {
                const float* B_ = buf0 + (c & 1) * BUFSZ;
                const float* sR = B_; const float* sW = sR + TC * RS; const float* sK = sW + TC * RS; const float* sA = sK + TC * RS; const float* sB = sA + TC * RS; const float* sV = sB + TC * RS; const float* sS = sV + TC * 32;
                float* yp = ypart + wid * (TC * 64) + lane; float* sIw = sI + wid * TC;
                if (lane < TC) { const f32x2 ps = *(const f32x2*)(sS + lane * 2); sIw[lane] = __builtin_amdgcn_rcpf(fmaxf(ps.x + ps.y, 1e-24f)); }
                f32x4 A0, A1, W0, W1, B0, B1, K0, K1, R0, R1; float VI, IV;
#define SC_LOAD(s_) do { const int o_ = (s_) * RS + seg * 8; \
                    A0 = *(const f32x4*)(sA + o_); A1 = *(const f32x4*)(sA + o_ + 4); W0 = *(const f32x4*)(sW + o_); W1 = *(const f32x4*)(sW + o_ + 4); \
                    B0 = *(const f32x4*)(sB + o_); B1 = *(const f32x4*)(sB + o_ + 4); K0 = *(const f32x4*)(sK + o_); K1 = *(const f32x4*)(sK + o_ + 4); \
                    R0 = *(const f32x4*)(sR + o_); R1 = *(const f32x4*)(sR + o_ + 4); VI = sV[(s_) * 32 + si]; IV = sIw[(s_)]; } while (0)
                SC_LOAD(0);
#pragma unroll 4
                for (int s = 0; s < TC; ++s) {
                    const f32x4 a0 = A0, a1 = A1, w0 = W0, w1 = W1, b0 = B0, b1 = B1, k0 = K0, k1 = K1, r0 = R0, r1 = R1; const float vi = VI, inv2 = IV;
                    if (s + 1 < TC) SC_LOAD(s + 1);
                    __builtin_amdgcn_sched_barrier(0);
                    const f32x2 av[4] = {{a0[0], a0[1]}, {a0[2], a0[3]}, {a1[0], a1[1]}, {a1[2], a1[3]}}, wv[4] = {{w0[0], w0[1]}, {w0[2], w0[3]}, {w1[0], w1[1]}, {w1[2], w1[3]}};
                    const f32x2 bv[4] = {{b0[0], b0[1]}, {b0[2], b0[3]}, {b1[0], b1[1]}, {b1[2], b1[3]}}, kv[4] = {{k0[0], k0[1]}, {k0[2], k0[3]}, {k1[0], k1[1]}, {k1[2], k1[3]}};
                    const f32x2 rv[4] = {{r0[0], r0[1]}, {r0[2], r0[3]}, {r1[0], r1[1]}, {r1[2], r1[3]}};
                    const f32x2 vi2 = {vi, vi};
                    f32x2 vk[4];
#pragma unroll
                    for (int j = 0; j < 4; ++j) vk[j] = vi2 * kv[j];
                    const f32x2 pa = st[0] * av[0] + st[1] * av[1], pb = st[2] * av[2] + st[3] * av[3]; const f32x2 pc = pa + pb;
                    const float sa = red8(pc.x + pc.y) * inv2;
                    const f32x2 sa2 = {sa, sa};
#pragma unroll
                    for (int j = 0; j < 4; ++j) st[j] = st[j] * wv[j] + (sa2 * bv[j] + vk[j]);
                    const f32x2 qa = st[0] * rv[0] + st[1] * rv[1], qb = st[2] * rv[2] + st[3] * rv[3]; const f32x2 qc = qa + qb;
                    yp[s * 64] = qc.x + qc.y;
                }
#undef SC_LOAD
                { const int tk = lane >> 1, rq = (lane & 1) * 4; const float* yr = ypart + wid * (TC * 64) + tk * 64 + rq * 8; float yv[4];
#pragma unroll
                  for (int r_ = 0; r_ < 4; ++r_) { const f32x4 u0 = *(const f32x4*)(yr + r_ * 8), u1 = *(const f32x4*)(yr + r_ * 8 + 4); yv[r_] = ((u0[0] + u0[1]) + (u0[2] + u0[3])) + ((u1[0] + u1[1]) + (u1[2] + u1[3])); }
                  u32x2 w; w.x = cvt_pk_bf16(yv[0], yv[1]); w.y = cvt_pk_bf16(yv[2], yv[3]);
                  *(u32x2*)(p.y + ((size_t)b * SEQ + c * TC + tk) * DM + h * 64 + half * 32 + wid * 8 + rq) = w; }
            }
            __syncthreads();
        }
    }
    __syncthreads();
}

__device__ void phase_rwkv_post(int l, bf16_t* oalt) {
    const Params p = load_params();
    const int tid = opaque_tid(), l8 = tid & 7;
    const int ngrp = T_TOK * 16;
    for (int g = blockIdx.x * 64 + (tid >> 3); g < ngrp; g += gridDim.x * 64) {
        const int tok = g >> 4, h = g & 15, cb = h * 64 + l8 * 8;
        const u32x4 y4 = *(const u32x4*)(p.y + (size_t)tok * DM + cb), b4 = *(const u32x4*)(p.vf + (size_t)tok * DM + cb);
        const int bb = tok / SEQ, tq = tok % SEQ; const float rk = p.rkbuf[(size_t)((bb * 16 + h) * 2) * SEQ + tq] + p.rkbuf[(size_t)((bb * 16 + h) * 2 + 1) * SEQ + tq];
        bf16_t* zp = p.H + (size_t)tok * LDA_H + 3200 + cb; const u32x4 z4 = *(const u32x4*)zp;
        const float yv[8] = {bflo(y4.x), bfhi(y4.x), bflo(y4.y), bfhi(y4.y), bflo(y4.z), bfhi(y4.z), bflo(y4.w), bfhi(y4.w)};
        const float bv[8] = {bflo(b4.x), bfhi(b4.x), bflo(b4.y), bfhi(b4.y), bflo(b4.z), bfhi(b4.z), bflo(b4.w), bfhi(b4.w)};
        const float zv[8] = {bflo(z4.x), bfhi(z4.x), bflo(z4.y), bfhi(z4.y), bflo(z4.z), bfhi(z4.z), bflo(z4.w), bfhi(z4.w)};
        float sm = 0.f;
#pragma unroll
        for (int e = 0; e < 8; ++e) sm += yv[e];
        sm = red8(sm); const float mean = sm * (1.0f / 64.f); float d[8], vs = 0.f;
#pragma unroll
        for (int e = 0; e < 8; ++e) { d[e] = yv[e] - mean; vs += d[e] * d[e]; }
        vs = red8(vs); const float rstd = rsqrtf(vs * (1.0f / 64.f) + GN_EPS);
        const f32x4 g0 = *(const f32x4*)(p.lnx_g + l * DM + cb), g1 = *(const f32x4*)(p.lnx_g + l * DM + cb + 4), c0 = *(const f32x4*)(p.lnx_b + l * DM + cb), c1 = *(const f32x4*)(p.lnx_b + l * DM + cb + 4);
        const float gg[8] = {g0[0], g0[1], g0[2], g0[3], g1[0], g1[1], g1[2], g1[3]}, cc[8] = {c0[0], c0[1], c0[2], c0[3], c1[0], c1[1], c1[2], c1[3]};
        float o[8];
#pragma unroll
        for (int e = 0; e < 8; ++e) o[e] = (d[e] * rstd * gg[e] + cc[e] + rk * bv[e]) * siluf_(zv[e]);
        u32x4 w; w.x = cvt_pk_bf16(o[0], o[1]); w.y = cvt_pk_bf16(o[2], o[3]); w.z = cvt_pk_bf16(o[4], o[5]); w.w = cvt_pk_bf16(o[6], o[7]);
        *(u32x4*)(oalt ? oalt + (size_t)tok * DM + cb : zp) = w;
    }
}

__device__ __forceinline__ float wave_sum64(float v) {
    v = red16(v);
    const float a = __int_as_float(__builtin_amdgcn_readlane(__float_as_int(v), 0)), b = __int_as_float(__builtin_amdgcn_readlane(__float_as_int(v), 16));
    const float c = __int_as_float(__builtin_amdgcn_readlane(__float_as_int(v), 32)), d = __int_as_float(__builtin_amdgcn_readlane(__float_as_int(v), 48));
    return (a + b) + (c + d);
}
__device__ void phase_sgu(int l, unsigned char* smem, bf16_t* oalt) {
    const Params p = load_params();
    bf16_t* vnTb = (bf16_t*)smem;
    float* stat = (float*)(smem + 2 * 128 * 136 * 2);
    float* lnG = stat + 256; float* lnB = lnG + DM;
    const int tid = opaque_tid(), wid = tid >> 6, lane = tid & 63, fr = lane & 15, fq = lane >> 4;
    __syncthreads();
    for (int e = tid; e < DM; e += 512) { lnG[e] = p.sgu_ln_g[(size_t)l * DM + e]; lnB[e] = p.sgu_ln_b[(size_t)l * DM + e]; }
    for (int item = blockIdx.x; item < T_TOK / 128; item += gridDim.x) {
        bf16_t* Hb = p.H + (size_t)item * 128 * LDB_H;
        __syncthreads();
#pragma unroll
        for (int hb = 0; hb < 2; ++hb) {
            u32x4 va[8], vb[8];
#pragma unroll
            for (int q = 0; q < 8; ++q) { const bf16_t* vr = Hb + (size_t)(wid * 16 + hb * 8 + q) * LDB_H + 1024 + lane * 16; va[q] = *(const u32x4*)vr; vb[q] = *(const u32x4*)(vr + 8); }
#pragma unroll
            for (int q = 0; q < 8; ++q) {
                const float f[16] = {bflo(va[q].x), bfhi(va[q].x), bflo(va[q].y), bfhi(va[q].y), bflo(va[q].z), bfhi(va[q].z), bflo(va[q].w), bfhi(va[q].w), bflo(vb[q].x), bfhi(vb[q].x), bflo(vb[q].y), bfhi(vb[q].y), bflo(vb[q].z), bfhi(vb[q].z), bflo(vb[q].w), bfhi(vb[q].w)};
                float sm = 0.f, sq = 0.f;
#pragma unroll
                for (int e = 0; e < 16; ++e) { sm += f[e]; sq += f[e] * f[e]; }
                sm = wave_sum64(sm); sq = wave_sum64(sq);
                const float mean = sm * (1.0f / DM), var = fmaxf(sq * (1.0f / DM) - mean * mean, 0.f);
                if (lane == 0) { const int s = wid * 16 + hb * 8 + q; stat[s * 2] = mean; stat[s * 2 + 1] = rsqrtf(var + EPS); } }
        }
        __syncthreads();
        const int trow = wid * 16 + fr; bf16_t* hr = Hb + (size_t)trow * LDB_H;
        const int nks = (wid < 4) ? 2 : 4;
        for (int g = 0; g < 8; ++g) {
            bf16_t* vnT = vnTb + (g & 1) * (128 * 136);
            const int s = tid >> 2, c0 = (tid & 3) * 32;
            const bf16_t* vr = Hb + (size_t)s * LDB_H + 1024 + g * 128 + c0;
            u32x4 vv[4];
#pragma unroll
            for (int q = 0; q < 4; ++q) vv[q] = *(const u32x4*)(vr + q * 8);
            const float* Wg = p.sgu_w + (((size_t)l * 8 + g) * 128 + trow) * 128;
            f32x4 wa[4], wb[4];
#pragma unroll
            for (int ks = 0; ks < 4; ++ks) if (ks < nks) { wa[ks] = *(const f32x4*)(Wg + ks * 32 + fq * 8); wb[ks] = *(const f32x4*)(Wg + ks * 32 + fq * 8 + 4); }
            u32x2 u2[8], z2[8];
#pragma unroll
            for (int ct = 0; ct < 8; ++ct) { const int c = g * 128 + ct * 16 + fq * 4; u2[ct] = *(const u32x2*)(hr + c); z2[ct] = *(const u32x2*)(hr + 2048 + c); }
            const float bs = p.sgu_b[((size_t)l * 8 + g) * 128 + trow];
            { const float mean = stat[s * 2], rstd = stat[s * 2 + 1];
#pragma unroll
              for (int q = 0; q < 4; ++q) { const float f[8] = {bflo(vv[q].x), bfhi(vv[q].x), bflo(vv[q].y), bfhi(vv[q].y), bflo(vv[q].z), bfhi(vv[q].z), bflo(vv[q].w), bfhi(vv[q].w)};
                  const f32x4 g0 = *(const f32x4*)(lnG + g * 128 + c0 + q * 8), g1 = *(const f32x4*)(lnG + g * 128 + c0 + q * 8 + 4), b0 = *(const f32x4*)(lnB + g * 128 + c0 + q * 8), b1 = *(const f32x4*)(lnB + g * 128 + c0 + q * 8 + 4);
                  const float gg[8] = {g0[0], g0[1], g0[2], g0[3], g1[0], g1[1], g1[2], g1[3]}, bb[8] = {b0[0], b0[1], b0[2], b0[3], b1[0], b1[1], b1[2], b1[3]};
#pragma unroll
                  for (int e = 0; e < 8; ++e) { const int c = c0 + q * 8 + e; const float a_ = rstd * gg[e]; vnT[c * 136 + s] = f2bf(f[e] * a_ + (bb[e] - mean * a_)); } } }
            __syncthreads();
            f32x4 acc[8];
#pragma unroll
            for (int i = 0; i < 8; ++i) acc[i] = (f32x4){0.f, 0.f, 0.f, 0.f};
#pragma unroll
            for (int ks = 0; ks < 4; ++ks) if (ks < nks) {
                u32x4 wp; wp.x = cvt_pk_bf16(wa[ks][0], wa[ks][1]); wp.y = cvt_pk_bf16(wa[ks][2], wa[ks][3]); wp.z = cvt_pk_bf16(wb[ks][0], wb[ks][1]); wp.w = cvt_pk_bf16(wb[ks][2], wb[ks][3]);
                const bf16x8 wfrag = __builtin_bit_cast(bf16x8, wp);
#pragma unroll
                for (int ct = 0; ct < 8; ++ct) { const bf16x8 vfrag = *(const bf16x8*)(vnT + (ct * 16 + fr) * 136 + ks * 32 + fq * 8);
                    acc[ct] = __builtin_amdgcn_mfma_f32_16x16x32_bf16(vfrag, wfrag, acc[ct], 0, 0, 0); }
            }
#pragma unroll
            for (int ct = 0; ct < 8; ++ct) { const int c = g * 128 + ct * 16 + fq * 4;
                const float uf[4] = {bflo(u2[ct].x), bfhi(u2[ct].x), bflo(u2[ct].y), bfhi(u2[ct].y)}, zf[4] = {bflo(z2[ct].x), bfhi(z2[ct].x), bflo(z2[ct].y), bfhi(z2[ct].y)};
                float o[4];
#pragma unroll
                for (int j = 0; j < 4; ++j) o[j] = uf[j] * (acc[ct][j] + bs) * siluf_(zf[j]);
                u32x2 w; w.x = cvt_pk_bf16(o[0], o[1]); w.y = cvt_pk_bf16(o[2], o[3]); *(u32x2*)(oalt ? oalt + ((size_t)item * 128 + trow) * DM + c : hr + 2048 + c) = w; }
        }
    }
    __syncthreads();
}

__device__ void phase_hgrn_pre(int l, unsigned char* smem, bool dry) {
    const Params p = load_params();
    float* LF = (float*)smem;
    bf16_t* IB = (bf16_t*)(LF + 64 * 132);
    bf16_t* KB = IB + 64 * 136;
    float* psum = (float*)(KB + 64 * 136);
    float* lbs = psum + 512;
    const int tid = opaque_tid();
    bf16_t* xtra = (l == 0) ? (bf16_t*)p.out : p.vf;
    __syncthreads();
    for (int e = tid; e < DM; e += 512) { float lb = 0.f; if (l == 1) { const float l0 = p.lb_logits[e], l1 = p.lb_logits[DM + e]; lb = __builtin_amdgcn_rcpf(1.0f + __expf(l0 - l1)); } lbs[e] = lb; }
    __syncthreads();
    const int t = tid >> 3, c0 = (tid & 7) * 16;
    const int cc = tid & 127, tq = tid >> 7;
    u32x4 nq0, nq1, nf0, nf1, ni0, ni1;
#define HP_ISSUE(it_) do { const int h_ = (it_) & 7, ch_ = ((it_) >> 3) & 63, b_ = (it_) >> 9; const bf16_t* hr_ = p.H + ((size_t)b_ * SEQ + ch_ * 64 + t) * LDC_H + h_ * 128 + c0; \
        nq0 = *(const u32x4*)hr_; nq1 = *(const u32x4*)(hr_ + 8); nf0 = *(const u32x4*)(hr_ + 1024); nf1 = *(const u32x4*)(hr_ + 1032); ni0 = *(const u32x4*)(hr_ + 2048); ni1 = *(const u32x4*)(hr_ + 2056); } while (0)
    if ((int)blockIdx.x < NB * 64 * 8) HP_ISSUE((int)blockIdx.x);
    for (int item = blockIdx.x; item < NB * 64 * 8; item += gridDim.x) {
        const int h = item & 7, ch = (item >> 3) & 63, b = item >> 9;
        const size_t r0 = (size_t)b * SEQ + ch * 64;
        bf16_t* hr = p.H + (r0 + t) * LDC_H + h * 128 + c0;
        float qv[16], kv[16];
        {
            const u32x4 q0 = nq0, q1 = nq1, f0 = nf0, f1 = nf1, i0 = ni0, i1 = ni1;
            if (item + (int)gridDim.x < NB * 64 * 8) HP_ISSUE(item + (int)gridDim.x);
            const unsigned qa[8] = {q0.x, q0.y, q0.z, q0.w, q1.x, q1.y, q1.z, q1.w}, fa[8] = {f0.x, f0.y, f0.z, f0.w, f1.x, f1.y, f1.z, f1.w};
            *(u32x4*)(IB + t * 136 + c0) = i0; *(u32x4*)(IB + t * 136 + c0 + 8) = i1;
            float lf[16];
#pragma unroll
            for (int e = 0; e < 8; ++e) {
                const float lb0 = lbs[h * 128 + c0 + 2 * e], lb1 = lbs[h * 128 + c0 + 2 * e + 1];
                qv[2 * e] = siluf_(bflo(qa[e])); qv[2 * e + 1] = siluf_(bfhi(qa[e]));
                const float g0 = lb0 + (1.0f - lb0) * sigmoidf_(bflo(fa[e])), g1 = lb1 + (1.0f - lb1) * sigmoidf_(bfhi(fa[e]));
                kv[2 * e] = 1.0f - g0; kv[2 * e + 1] = 1.0f - g1; lf[2 * e] = __logf(g0); lf[2 * e + 1] = __logf(g1); }
#pragma unroll
            for (int e = 0; e < 4; ++e) *(f32x4*)(LF + t * 132 + c0 + e * 4) = (f32x4){lf[e * 4], lf[e * 4 + 1], lf[e * 4 + 2], lf[e * 4 + 3]};
        }
        __syncthreads();
        { float run = 0.f;
#pragma unroll
          for (int e = 0; e < 16; ++e) { run += LF[(tq * 16 + e) * 132 + cc]; LF[(tq * 16 + e) * 132 + cc] = run; }
          psum[tq * 128 + cc] = run; }
        __syncthreads();
        {
            const int tqt = t >> 4;
            unsigned qo[8], ko[8];
#pragma unroll
            for (int e4 = 0; e4 < 4; ++e4) {
                const f32x4 p0 = *(const f32x4*)(psum + c0 + e4 * 4), p1 = *(const f32x4*)(psum + 128 + c0 + e4 * 4), p2 = *(const f32x4*)(psum + 256 + c0 + e4 * 4), p3 = *(const f32x4*)(psum + 384 + c0 + e4 * 4);
                const f32x4 bl = *(const f32x4*)(LF + t * 132 + c0 + e4 * 4);
                float q2[4], k2[4];
#pragma unroll
                for (int j = 0; j < 4; ++j) {
                    const float off = (tqt > 0 ? p0[j] : 0.f) + (tqt > 1 ? p1[j] : 0.f) + (tqt > 2 ? p2[j] : 0.f);
                    const float bmid = p0[j] + p1[j], bb = bl[j] + off;
                    q2[j] = qv[e4 * 4 + j] * __expf(bb - bmid); k2[j] = kv[e4 * 4 + j] * __expf(bmid - bb); }
                qo[e4 * 2] = cvt_pk_bf16(q2[0], q2[1]); qo[e4 * 2 + 1] = cvt_pk_bf16(q2[2], q2[3]); ko[e4 * 2] = cvt_pk_bf16(k2[0], k2[1]); ko[e4 * 2 + 1] = cvt_pk_bf16(k2[2], k2[3]);
                if (t == 0) { f32x4 e1, e3;
#pragma unroll
                    for (int j = 0; j < 4; ++j) { e1[j] = __expf(p0[j] + p1[j]); e3[j] = __expf(p2[j] + p3[j]); }
                    float* gs = p.rkbuf + (size_t)(((b * 64 + ch) * 8 + h)) * 256 + c0 + e4 * 4; *(f32x4*)gs = e1; *(f32x4*)(gs + 128) = e3; }
            }
            const u32x4 qw0 = {qo[0], qo[1], qo[2], qo[3]}, qw1 = {qo[4], qo[5], qo[6], qo[7]}, kw0 = {ko[0], ko[1], ko[2], ko[3]}, kw1 = {ko[4], ko[5], ko[6], ko[7]};
            if (!dry) { *(u32x4*)hr = qw0; *(u32x4*)(hr + 8) = qw1; *(u32x4*)(hr + 1024) = kw0; *(u32x4*)(hr + 1032) = kw1; }
            *(u32x4*)(KB + t * 136 + c0) = kw0; *(u32x4*)(KB + t * 136 + c0 + 8) = kw1;
        }
        __syncthreads();
        {
            unsigned iw[8], kw[8];
#pragma unroll
            for (int e = 0; e < 8; ++e) {
                iw[e] = (unsigned)IB[(tq * 16 + 2 * e) * 136 + cc] | ((unsigned)IB[(tq * 16 + 2 * e + 1) * 136 + cc] << 16);
                kw[e] = (unsigned)KB[(tq * 16 + 2 * e) * 136 + cc] | ((unsigned)KB[(tq * 16 + 2 * e + 1) * 136 + cc] << 16); }
            bf16_t* ir = p.H + (r0 + (cc >> 1)) * LDC_H + 2048 + h * 128 + (cc & 1) * 64 + tq * 16;
            if (!dry) { *(u32x4*)ir = (u32x4){iw[0], iw[1], iw[2], iw[3]}; *(u32x4*)(ir + 8) = (u32x4){iw[4], iw[5], iw[6], iw[7]}; }
            bf16_t* kr = xtra + (r0 + (cc >> 1)) * DM + h * 128 + (cc & 1) * 64 + tq * 16;
            *(u32x4*)kr = (u32x4){kw[0], kw[1], kw[2], kw[3]}; *(u32x4*)(kr + 8) = (u32x4){kw[4], kw[5], kw[6], kw[7]};
        }
        __syncthreads();
    }
}

struct HgSet { u32x4 r[7]; };
__device__ __forceinline__ void hg_issue(HgSet& R, const bf16_t* H, const bf16_t* xtra, const float* gsc, int b, int ch, int h, int vs, int tid) {
    const size_t r0 = (size_t)b * SEQ + (size_t)ch * 64;
    const int row = tid >> 4, wi = tid & 15;
#pragma unroll
    for (int j = 0; j < 2; ++j) { const int t = j * 32 + row; R.r[j] = *(const u32x4*)(H + (r0 + t) * LDC_H + h * 128 + wi * 8); R.r[2 + j] = *(const u32x4*)(H + (r0 + t) * LDC_H + 1024 + h * 128 + wi * 8); }
#pragma unroll
    for (int j = 0; j < 2; ++j) { const int kp = j * 32 + row; R.r[4 + j] = *(const u32x4*)(xtra + (r0 + kp) * DM + h * 128 + wi * 8); }
    const u32x4 z4 = {0u, 0u, 0u, 0u}; R.r[6] = z4;
    if (tid < 256) R.r[6] = *(const u32x4*)(H + (r0 + vs * 16 + row) * LDC_H + 2048 + h * 128 + wi * 8);
    else if (tid < 320) R.r[6] = *(const u32x4*)(gsc + (size_t)(((b * 64 + ch) * 8 + h)) * 256 + (tid - 256) * 4);
}
constexpr int HG_QM = 0, HG_KM = 16 * 65 * 16, HG_KT = 2 * 16 * 65 * 16, HG_IT = HG_KT + 8 * 129 * 16, HG_E = HG_IT + 8 * 33 * 16, HG_BUF = HG_E + 1024;
__device__ __forceinline__ void hg_stage(const HgSet& R, unsigned char* B, int tid) {
    const int row = tid >> 4, wi = tid & 15;
#pragma unroll
    for (int j = 0; j < 2; ++j) { const int t = j * 32 + row; *(u32x4*)(B + HG_QM + (wi * 65 + t) * 16) = R.r[j]; *(u32x4*)(B + HG_KM + (wi * 65 + t) * 16) = R.r[2 + j]; }
#pragma unroll
    for (int j = 0; j < 2; ++j) { const int k = (j * 32 + row) * 2 + (wi >> 3), sc = wi & 7; *(u32x4*)(B + HG_KT + (sc * 129 + k) * 16) = R.r[4 + j]; }
    if (tid < 256) { const int vv = row * 2 + (wi >> 3), sc = wi & 7; *(u32x4*)(B + HG_IT + (sc * 33 + vv) * 16) = R.r[6]; }
    else if (tid < 320) *(u32x4*)(B + HG_E + (tid - 256) * 16) = R.r[6];
}

__device__ void phase_hgrn_seq(int l, unsigned char* smem, bool dry) {
    const Params p = load_params();
    unsigned char* img = smem;
    bf16_t* att = (bf16_t*)(smem + 2 * HG_BUF);
    bf16_t* STs = att + 64 * 72;
    const int tid = opaque_tid(), w = __builtin_amdgcn_readfirstlane(tid >> 6), lane = tid & 63, fr = lane & 15, fq = lane >> 4;
    const bf16_t* xtra = (l == 0) ? (const bf16_t*)p.out : p.vf;
    const int tt_ = w >> 1, sp = w & 1;
    for (int item = blockIdx.x; item < NB * 32; item += gridDim.x) {
        const int xc_ = item & 7, sl_ = item >> 3, vs = sl_ & 3, gi_ = (sl_ >> 2) * 8 + xc_, h = gi_ & 7, b = gi_ >> 3;
        __syncthreads();
        for (int e = tid; e < 32 * 136 / 2; e += 512) ((unsigned*)STs)[e] = 0u;
        f32x4 S[2] = {{0.f, 0.f, 0.f, 0.f}, {0.f, 0.f, 0.f, 0.f}};
        u32x2 o0 = {0u, 0u};
        HgSet R0, R1;
        hg_issue(R0, p.H, xtra, p.rkbuf, b, 0, h, vs, tid); hg_stage(R0, img, tid);
        hg_issue(R1, p.H, xtra, p.rkbuf, b, 1, h, vs, tid); hg_issue(R0, p.H, xtra, p.rkbuf, b, 2, h, vs, tid);
        __syncthreads();
        auto iter = [&](const int ch, HgSet& RS) {
            const size_t r0 = (size_t)b * SEQ + (size_t)ch * 64;
            const unsigned char* B = img + (ch & 1) * HG_BUF; unsigned char* Bn = img + ((ch + 1) & 1) * HG_BUF;
            bf16x8 qf[4];
#pragma unroll
            for (int ks = 0; ks < 4; ++ks) qf[ks] = *(const bf16x8*)(B + HG_QM + ((ks * 4 + fq) * 65 + tt_ * 16 + fr) * 16);
#pragma unroll
            for (int q = 0; q < 2; ++q) { const int stile = sp * 2 + q; f32x4 a = {0.f, 0.f, 0.f, 0.f};
                if (stile <= tt_) {
#pragma unroll
                    for (int ks = 0; ks < 4; ++ks) { const bf16x8 kf = *(const bf16x8*)(B + HG_KM + ((ks * 4 + fq) * 65 + stile * 16 + fr) * 16); a = __builtin_amdgcn_mfma_f32_16x16x32_bf16(qf[ks], kf, a, 0, 0, 0); } }
#pragma unroll
                for (int j = 0; j < 4; ++j) { const int t = tt_ * 16 + fq * 4 + j, s = stile * 16 + fr; att[t * 72 + s] = f2bf(s <= t ? a[j] : 0.f); } }
            if (ch + 1 < 64) hg_stage(RS, Bn, tid);
            if (ch + 3 < 64) hg_issue(RS, p.H, xtra, p.rkbuf, b, ch + 3, h, vs, tid);
            __syncthreads();
            f32x4 o = {0.f, 0.f, 0.f, 0.f};
#pragma unroll
            for (int ks = 0; ks < 2; ++ks) { const bf16x8 af = *(const bf16x8*)(att + (tt_ * 16 + fr) * 72 + ks * 32 + fq * 8); const bf16x8 itf = *(const bf16x8*)(B + HG_IT + ((ks * 4 + fq) * 33 + sp * 16 + fr) * 16);
                o = __builtin_amdgcn_mfma_f32_16x16x32_bf16(itf, af, o, 0, 0, 0); }
#pragma unroll
            for (int ks = 0; ks < 4; ++ks) { const bf16x8 sf = *(const bf16x8*)(STs + (sp * 16 + fr) * 136 + ks * 32 + fq * 8);
                o = __builtin_amdgcn_mfma_f32_16x16x32_bf16(sf, qf[ks], o, 0, 0, 0); }
            { u32x2 ow; ow.x = cvt_pk_bf16(o[0], o[1]); ow.y = cvt_pk_bf16(o[2], o[3]);
              if (ch == 0) o0 = ow;
              else if (!dry) { const int t = tt_ * 16 + fr; *(u32x2*)(p.H + (r0 - 64 + vs * 16 + (t >> 2)) * LDC_H + 2048 + h * 128 + (t & 3) * 32 + sp * 16 + fq * 4) = ow; } }
            const f32x4 e1 = *(const f32x4*)(B + HG_E + (w * 16 + fq * 4) * 4), e3 = *(const f32x4*)(B + HG_E + 512 + (w * 16 + fq * 4) * 4);
            bf16x8 ktf[2];
#pragma unroll
            for (int ks = 0; ks < 2; ++ks) ktf[ks] = *(const bf16x8*)(B + HG_KT + ((ks * 4 + fq) * 129 + w * 16 + fr) * 16);
#pragma unroll
            for (int vt = 0; vt < 2; ++vt) { f32x4 u = {0.f, 0.f, 0.f, 0.f};
#pragma unroll
                for (int ks = 0; ks < 2; ++ks) { const bf16x8 itf = *(const bf16x8*)(B + HG_IT + ((ks * 4 + fq) * 33 + vt * 16 + fr) * 16); u = __builtin_amdgcn_mfma_f32_16x16x32_bf16(ktf[ks], itf, u, 0, 0, 0); }
#pragma unroll
                for (int j = 0; j < 4; ++j) S[vt][j] = e3[j] * (e1[j] * S[vt][j] + u[j]); }
            __syncthreads();
            if (ch + 1 < 64) { const f32x4 e1n = *(const f32x4*)(Bn + HG_E + (w * 16 + fq * 4) * 4);
#pragma unroll
                for (int vt = 0; vt < 2; ++vt) { u32x2 sw; sw.x = cvt_pk_bf16(S[vt][0] * e1n[0], S[vt][1] * e1n[1]); sw.y = cvt_pk_bf16(S[vt][2] * e1n[2], S[vt][3] * e1n[3]);
                    *(u32x2*)(STs + (vt * 16 + fr) * 136 + w * 16 + fq * 4) = sw; } }
        };
        for (int ch = 0; ch < 64; ch += 2) { iter(ch, R1); iter(ch + 1, R0); }
        if (!dry) { const int t = tt_ * 16 + fr; *(u32x2*)(p.H + ((size_t)b * SEQ + 63 * 64 + vs * 16 + (t >> 2)) * LDC_H + 2048 + h * 128 + (t & 3) * 32 + sp * 16 + fq * 4) = o0; }
    }
    __syncthreads();
}

__device__ void phase_hgrn_post(int l) {
    const Params p = load_params();
    const int tid = opaque_tid(), l8 = tid & 7;
    const int ngrp = T_TOK * 8;
    for (int g = blockIdx.x * 64 + (tid >> 3); g < ngrp; g += gridDim.x * 64) {
        const int tok = g >> 3, h = g & 7, b = tok / SEQ, tin = tok % SEQ, ch = tin >> 6, t = tin & 63, slot = (ch + 63) & 63, vs = l8 >> 1, vv0 = (l8 & 1) * 16;
        const bf16_t* op = p.H + ((size_t)b * SEQ + slot * 64 + vs * 16 + (t >> 2)) * LDC_H + 2048 + h * 128 + (t & 3) * 32 + vv0;
        bf16_t* zp = p.H + (size_t)tok * LDC_H + 3072 + h * 128 + l8 * 16;
        const u32x4 a0 = *(const u32x4*)op, a1 = *(const u32x4*)(op + 8), z0 = *(const u32x4*)zp, z1 = *(const u32x4*)(zp + 8);
        const float ov[16] = {bflo(a0.x), bfhi(a0.x), bflo(a0.y), bfhi(a0.y), bflo(a0.z), bfhi(a0.z), bflo(a0.w), bfhi(a0.w), bflo(a1.x), bfhi(a1.x), bflo(a1.y), bfhi(a1.y), bflo(a1.z), bfhi(a1.z), bflo(a1.w), bfhi(a1.w)};
        const float zf[16] = {bflo(z0.x), bfhi(z0.x), bflo(z0.y), bfhi(z0.y), bflo(z0.z), bfhi(z0.z), bflo(z0.w), bfhi(z0.w), bflo(z1.x), bfhi(z1.x), bflo(z1.y), bfhi(z1.y), bflo(z1.z), bfhi(z1.z), bflo(z1.w), bfhi(z1.w)};
        float ss = 0.f;
#pragma unroll
        for (int e = 0; e < 16; ++e) ss += ov[e] * ov[e];
        ss = red8(ss); const float rinv = rsqrtf(ss * (1.0f / 128.f) + EPS);
        const float* gn = p.hgrn_g + (size_t)l * DM + h * 128 + l8 * 16;
        float r[16];
#pragma unroll
        for (int e = 0; e < 16; ++e) r[e] = ov[e] * rinv * gn[e] * siluf_(zf[e]);
        u32x4 w0, w1; w0.x = cvt_pk_bf16(r[0], r[1]); w0.y = cvt_pk_bf16(r[2], r[3]); w0.z = cvt_pk_bf16(r[4], r[5]); w0.w = cvt_pk_bf16(r[6], r[7]);
        w1.x = cvt_pk_bf16(r[8], r[9]); w1.y = cvt_pk_bf16(r[10], r[11]); w1.z = cvt_pk_bf16(r[12], r[13]); w1.w = cvt_pk_bf16(r[14], r[15]);
        *(u32x4*)zp = w0; *(u32x4*)(zp + 8) = w1;
    }
}


#define XB_TMO      128
#define XB_XCNT(j)  (256  + 64 * (j))
#define XB_XSUB(j)  (1280 + 64 * (j))
#define XB_XGEN(j)  (2304 + 64 * (j))
#define XB_TOP      3328
#define XB_TOPGEN   3392
#define XCD_BAR_WORDS 3456
#define XB_SPIN_CAP (1u << 18)
__device__ __forceinline__ unsigned xb_ld(unsigned* p)              { return __hip_atomic_load(p, __ATOMIC_RELAXED, __HIP_MEMORY_SCOPE_AGENT); }
__device__ __forceinline__ unsigned xb_add(unsigned* p, unsigned v) { return __hip_atomic_fetch_add(p, v, __ATOMIC_RELAXED, __HIP_MEMORY_SCOPE_AGENT); }
__device__ __forceinline__ unsigned xb_xcc_id() { return (unsigned)__builtin_amdgcn_s_getreg((3 << 11) | 20) & 0xFu; }
#define XB_SPIN(cond, bar) do { unsigned _sp = 0; while (cond) { __builtin_amdgcn_s_sleep(1); \
    if ((++_sp & 255u) == 0u) { if (xb_ld(&(bar)[XB_TMO])) break; if (_sp > XB_SPIN_CAP) { atomicAdd(&(bar)[XB_TMO], 1u); break; } } } } while (0)
struct XcdBarrier { unsigned* bar; unsigned x; volatile LAS unsigned* st; };
__device__ __forceinline__ XcdBarrier xcd_barrier_post(unsigned* bar, volatile LAS unsigned* st) {
    XcdBarrier b; b.bar = bar; b.x = xb_xcc_id(); b.st = st;
    if (threadIdx.x == 0) (void)xb_add(&bar[XB_XCNT(b.x)], 1u);
    return b;
}
__device__ __forceinline__ void xcd_barrier_complete(unsigned* bar, unsigned x, unsigned& nloc, unsigned& nx) {
    const unsigned G = gridDim.x * gridDim.y * gridDim.z;
    unsigned sum, cnt, mine, sp = 0u;
    for (;;) {
        sum = 0u; cnt = 0u; mine = 0u;
#pragma unroll
        for (unsigned j = 0; j < 16; ++j) { const unsigned c = xb_ld(&bar[XB_XCNT(j)]); sum += c; cnt += (c > 0u) ? 1u : 0u; mine = (j == x) ? c : mine; }
        if (sum == G) break;
        __builtin_amdgcn_s_sleep(1);
        if ((++sp & 255u) == 0u) { if (xb_ld(&bar[XB_TMO])) break; if (sp > XB_SPIN_CAP) { atomicAdd(&bar[XB_TMO], 1u); break; } }
    }
    nloc = mine > 0u ? mine : 1u; nx = cnt > 0u ? cnt : 1u;
}
__device__ __forceinline__ void xcd_barrier(const XcdBarrier& b) {
    asm volatile("s_waitcnt vmcnt(0)" ::: "memory");
    __syncthreads();
    if (threadIdx.x == 0) {
        unsigned* bar = b.bar;
        __builtin_amdgcn_s_waitcnt(0);
        unsigned nloc = b.st[0], nx = b.st[1];
        if (nloc == 0u) { xcd_barrier_complete(bar, b.x, nloc, nx); b.st[0] = nloc; b.st[1] = nx; }
        const unsigned old = xb_add(&bar[XB_XSUB(b.x)], 1u);
        const unsigned gen = old / nloc;
        if (old + 1u == (gen + 1u) * nloc) {
            __builtin_amdgcn_fence(__ATOMIC_RELEASE, "agent");
            asm volatile("s_waitcnt vmcnt(0)" ::: "memory");
            const unsigned og = xb_add(&bar[XB_TOP], 1u);
            const unsigned tg = og / nx;
            if (og + 1u == (tg + 1u) * nx) xb_add(&bar[XB_TOPGEN], 1u);
            else XB_SPIN(xb_ld(&bar[XB_TOPGEN]) == tg, bar);
            __builtin_amdgcn_fence(__ATOMIC_ACQUIRE, "agent");
            xb_add(&bar[XB_XGEN(b.x)], 1u);
            asm volatile("s_waitcnt vmcnt(0)" ::: "memory");
        } else {
            XB_SPIN(xb_ld(&bar[XB_XGEN(b.x)]) == gen, bar);
            __builtin_amdgcn_fence(__ATOMIC_ACQUIRE, "agent");
            asm volatile("s_waitcnt vmcnt(0)" ::: "memory");
        }
    }
    __syncthreads();
}

constexpr int PH_PER_LAYER = 14, N_PHASES = 2 * PH_PER_LAYER + 1;

__global__ void __launch_bounds__(512, 2) fwd_megakernel(Params pk) {
    extern __shared__ __attribute__((aligned(16))) unsigned char shm[];
    LAS unsigned char* lds = (LAS unsigned char*)shm;
    cg::grid_group grid = cg::this_grid();
    const int phase_lo = pk.phase_lo, phase_hi = pk.phase_hi;
    volatile LAS unsigned* xst = (volatile LAS unsigned*)(lds + LDS_BYTES - 16);
    XcdBarrier xb; xb.bar = pk.bar; xb.x = 0; xb.st = xst;
    if (phase_hi - phase_lo > 1) { if (threadIdx.x == 0) { xst[0] = 0u; xst[1] = 0u; } __syncthreads(); xb = xcd_barrier_post(pk.bar, xst); }
    for (int ph = phase_lo; ph < phase_hi; ++ph) {
        const int l = ph / PH_PER_LAYER, q = ph % PH_PER_LAYER;
        if (ph == N_PHASES - 1) {
            const Params p = load_params();
            phase_rmsnorm(p.out, p.final_g, nullptr, p.out);
        } else if (q == 0) {
            { const int nrep = (PROBE_Q == 0 && l == 0) ? 2 : 1; for (int rep = 0; rep < nrep; ++rep) {
            phase_convert(l, shm);
            const Params p = load_params();
            phase_rmsnorm(l == 0 ? p.x : p.out, p.norm_g + (size_t)l * DM, p.xn, nullptr); } }
        } else if (q == 1 || q == 5 || q == 8) {
            const Params p = load_params(); const int G = gridDim.x, cidx = opaque_bid();
            const int N = (q == 1) ? LDA_H : (q == 5) ? LDB_H : LDC_H; const int r0 = (q == 1) ? 0 : (q == 5) ? LDA_H : (LDA_H + LDB_H);
            pg8::GemmDesc g; g.A = p.xn; g.Bt = p.Wt + (size_t)r0 * DM; g.lda = DM;
            pg8::Sched S; S.init(T_TOK, N, G, cidx, 1);
            pg8::EpiStore E; E.O = p.H; E.ldc = N;
{ const int nrep = ((PROBE_Q == 1 && l == 0 && q == 1) || (PROBE_Q == 50 && l == 0 && q == 5) || (PROBE_Q == 80 && l == 0 && q == 8)) ? 2 : 1; for (int rep = 0; rep < nrep; ++rep) pg8::gemm_phase(lds, g, g, S, E); }
        } else if (q == 2) {
{ const int nrep = (PROBE_Q == 2 && l == 0) ? 2 : 1; for (int rep = 0; rep < nrep; ++rep) phase_rwkv(l, shm, rep + 1 < nrep ? PROBE_MODE : 0); }
        } else if (q == 3) {
            phase_rwkv_post(l, nullptr);
        } else if (q == 6) {
{ const int nrep = (PROBE_Q == 6 && l == 0) ? 2 : 1; for (int rep = 0; rep < nrep; ++rep) { const Params p = load_params(); phase_sgu(l, shm, rep + 1 < nrep ? (bf16_t*)p.out : nullptr); } }
        } else if (q == 9) {
            { const int nrep = (PROBE_Q == 9 && l == 0) ? 2 : 1; for (int rep = 0; rep < nrep; ++rep) phase_hgrn_pre(l, shm, rep + 1 < nrep); }
        } else if (q == 10) {
            { const int nrep = (PROBE_Q == 10 && l == 0) ? 2 : 1; for (int rep = 0; rep < nrep; ++rep) phase_hgrn_seq(l, shm, rep + 1 < nrep); }
        } else if (q == 11) {
            phase_hgrn_post(l);
        } else if (q == 4 || q == 7 || q == 12) {
            const Params p = load_params(); const int G = gridDim.x, cidx = opaque_bid();
            bf16_t* WtBr = p.Wt + (size_t)WT_ROWS * DM;
            const int n = (q == 4) ? 0 : (q == 7) ? 1 : 2; const int ldh = (n == 0) ? LDA_H : (n == 1) ? LDB_H : LDC_H; const int ocol = (n == 0) ? 3200 : (n == 1) ? 2048 : 3072;
            pg8::GemmDesc g0, g1; g0.A = p.xn; g0.Bt = p.Wt + (size_t)(LDA_H + LDB_H + LDC_H + n * DM) * DM; g0.lda = DM;
            g1.A = p.H + ocol; g1.Bt = WtBr + (size_t)n * DM * DM; g1.lda = ldh;
            pg8::Sched S; S.init(T_TOK, DM, G, cidx, 2);
            pg8::EpiMerge E; E.G = p.H; E.ldg = ldh; E.bias = p.b_merge + ((size_t)l * 3 + n) * DM; E.Y = p.y; E.accum = (n > 0);
            { const int nrep = (PROBE_Q == 4 && l == 0 && q == 4) ? 2 : 1; for (int rep = 0; rep < nrep; ++rep) pg8::gemm_phase(lds, g0, g1, S, E); }
        } else {
            const Params p = load_params(); const int G = gridDim.x, cidx = opaque_bid();
            bf16_t* WtOut = p.Wt + (size_t)WT_ROWS * DM + (size_t)3 * DM * DM;
            pg8::GemmDesc g; g.A = p.y; g.Bt = WtOut; g.lda = DM;
            pg8::Sched S; S.init(T_TOK, DM, G, cidx, 1);
            pg8::EpiResid E; E.Xin = (l == 0) ? p.x : p.out; E.Xout = p.out;
            { const int nrep = (PROBE_Q == 13 && l == 0) ? 2 : 1; for (int rep = 0; rep < nrep; ++rep) pg8::gemm_phase(lds, g, g, S, E); }
        }
        if (ph + 1 < phase_hi) { if (ph == phase_lo) grid.sync(); else xcd_barrier(xb); }
    }
}

extern "C" void kernel_launch(void* const* d_in, const int* in_sizes, int n_in, void* d_out, int out_size, void* d_ws, size_t ws_size, hipStream_t stream) {
    static int grid_blocks = 0;
    if (!grid_blocks) {
        int dev = 0, cus = 0, per_cu = 0;
        hipGetDevice(&dev);
        hipDeviceGetAttribute(&cus, hipDeviceAttributeMultiprocessorCount, dev);
        if (hipFuncSetAttribute((const void*)fwd_megakernel, hipFuncAttributeMaxDynamicSharedMemorySize, LDS_BYTES) != hipSuccess) { fprintf(stderr, "hipFuncSetAttribute failed\n"); return; }
        hipOccupancyMaxActiveBlocksPerMultiprocessor(&per_cu, (const void*)fwd_megakernel, 512, LDS_BYTES);
        if (per_cu < 1) { fprintf(stderr, "occupancy query says 0 blocks per CU\n"); return; }
        grid_blocks = cus * 1;
    }
    Params p{};
    const float** fp = (const float**)&p;
    for (int i = 0; i < 26; ++i) fp[i] = (const float*)d_in[i];
    p.out = (float*)d_out;
    unsigned char* ws = (unsigned char*)d_ws; size_t off = 0;
    auto take = [&](size_t bytes) { unsigned char* r = ws + off; off += (bytes + 255) & ~(size_t)255; return r; };
    p.Wt = (bf16_t*)take(((size_t)WT_ROWS * DM + 4 * (size_t)DM * DM) * 2);
    p.xn = (bf16_t*)take((size_t)T_TOK * DM * 2);
    p.vf = (bf16_t*)take((size_t)T_TOK * DM * 2);
    p.y = (bf16_t*)take((size_t)T_TOK * DM * 2);
    p.H = (bf16_t*)take((size_t)T_TOK * LDA_H * 2);
    p.rkbuf = (float*)take((size_t)T_TOK * 16 * 2 * 4);
    p.bar = (unsigned*)take((size_t)XCD_BAR_WORDS * 4);
    if (off > ws_size) { fprintf(stderr, "workspace too small: need %zu have %zu\n", off, ws_size); return; }
#if SINGLE_LAUNCH
    p.phase_lo = 0; p.phase_hi = N_PHASES;
    void* args[] = {&p};
    if (hipMemsetAsync(p.bar, 0, (size_t)XCD_BAR_WORDS * 4, stream) != hipSuccess) { fprintf(stderr, "memset failed\n"); return; }
    hipError_t e = hipLaunchCooperativeKernel((const void*)fwd_megakernel, dim3(grid_blocks), dim3(512), args, LDS_BYTES, stream);
    if (e != hipSuccess) fprintf(stderr, "cooperative launch failed: %s (grid %d)\n", hipGetErrorString(e), grid_blocks);
#else
    for (int ph = 0; ph < N_PHASES; ++ph) {
        p.phase_lo = ph; p.phase_hi = ph + 1;
        hipLaunchKernelGGL(fwd_megakernel, dim3(grid_blocks), dim3(512), LDS_BYTES, stream, p);
    }
#endif
}
```

```cpp
#include <hip/hip_runtime.h>
#include <hip/hip_cooperative_groups.h>
#include <cstdio>
namespace cg = cooperative_groups;

#ifndef PROBE_MODE
#define PROBE_MODE 0
#endif
#ifndef PROBE_Q
#define PROBE_Q -1
#endif
#ifndef SINGLE_LAUNCH
#define SINGLE_LAUNCH 1
#endif

typedef unsigned short bf16_t;
typedef short bf16x8 __attribute__((ext_vector_type(8)));
typedef float f32x4 __attribute__((ext_vector_type(4)));
typedef float f32x2 __attribute__((ext_vector_type(2)));
typedef unsigned u32x4 __attribute__((ext_vector_type(4)));
typedef unsigned u32x2 __attribute__((ext_vector_type(2)));
#define LAS __attribute__((address_space(3)))

constexpr int T_TOK = 32768, DM = 1024, SEQ = 4096, NB = 8;
constexpr int N_IN = 14464;
constexpr int LDA_H = 4352, LDB_H = 3072, LDC_H = 4096;
constexpr int WT_ROWS = 14592;
constexpr int LDS_BYTES = 163840;
constexpr float EPS = 1e-6f, GN_EPS = 64e-5f;

struct Params {
    const float *x, *norm_g, *w_in, *b_merge, *mu, *w0, *w_w2, *a0, *a_w2, *v0, *v_w1, *v_w2, *k_k, *k_a, *r_k, *lnx_g, *lnx_b,
        *sgu_ln_g, *sgu_ln_b, *sgu_w, *sgu_b, *lb_logits, *hgrn_g, *w_branch, *w_out, *final_g;
    float* out;
    bf16_t *Wt, *xn, *vf, *y, *H;
    float* rkbuf;
    unsigned* bar;
    int phase_lo, phase_hi;
};

__device__ __forceinline__ float bf2f(bf16_t h) { return __uint_as_float(((unsigned)h) << 16); }
__device__ __forceinline__ float bflo(unsigned u) { return __uint_as_float(u << 16); }
__device__ __forceinline__ float bfhi(unsigned u) { return __uint_as_float(u & 0xffff0000u); }
typedef __bf16 bf16x2_t __attribute__((ext_vector_type(2)));
__device__ __forceinline__ unsigned cvt_pk_bf16(float lo, float hi) { const f32x2 v = {lo, hi}; const bf16x2_t r = __builtin_convertvector(v, bf16x2_t); return __builtin_bit_cast(unsigned, r); }
__device__ __forceinline__ bf16_t f2bf(float f) { return (bf16_t)(cvt_pk_bf16(f, 0.f) & 0xffffu); }
__device__ __forceinline__ float sigmoidf_(float x) { return __builtin_amdgcn_rcpf(1.0f + __expf(-x)); }
__device__ __forceinline__ float siluf_(float x) { return x * __builtin_amdgcn_rcpf(1.0f + __expf(-x)); }
__device__ __forceinline__ float tanh_fast(float x) { return 1.0f - 2.0f * __builtin_amdgcn_rcpf(1.0f + __expf(2.0f * x)); }

__device__ __forceinline__ Params load_params() {
#if defined(__HIP_DEVICE_COMPILE__)
    typedef const Params __attribute__((address_space(4)))* KP;
    KP kp = (KP)__builtin_amdgcn_kernarg_segment_ptr(); asm volatile("" : "+s"(kp)); return *kp;
#else
    return Params{};
#endif
}
__device__ __forceinline__ int opaque_tid() { int t = threadIdx.x; asm volatile("" : "+v"(t)); return t; }
__device__ __forceinline__ int opaque_bid() { int t = blockIdx.x; asm volatile("" : "+s"(t)); return t; }

namespace pg8 {
constexpr int BM = 256, BK = 64, HALF = 128, HTB = HALF * BK * 2, STAGE_BYTES = 8 * HTB, NXCD = 8, WGM = 8, KD = 1024;
__device__ __forceinline__ int lds_byte(int r, int c) { const int st = (r >> 4) * 2 + (c >> 5), rr = r & 15, cc = c & 31, ob = rr * 64 + cc * 2; return st * 1024 + (ob ^ (((ob >> 9) & 1) << 5)); }
__device__ __forceinline__ void stage_rc(int b, int& R, int& C) { const int st = b / 1024, sb = b % 1024, swz = sb ^ (((sb >> 9) & 1) << 5); R = (st >> 1) * 16 + swz / 64; C = (st & 1) * 32 + (swz % 64) / 2; }
__device__ __forceinline__ int perm32(int rho) { const int n = rho >> 4, i = rho & 15; return 8 * (i >> 2) + 4 * n + (i & 3); }

struct Unit { int pm, pn, sel; };
struct GemmDesc { const bf16_t* A; const bf16_t* Bt; int lda; };
struct Sched {
    int nM, nN, nwg, G, c, nsel;
    __device__ void init(int M, int N, int G_, int c_, int nsel_) { nM = M / BM; nN = N / BM; nwg = nM * nN; G = G_; c = c_; nsel = nsel_; }
    __device__ bool next(int i, Unit& u) const {
        const int ti = (nsel == 2) ? (i >> 1) : i; u.sel = (nsel == 2) ? (i & 1) : 0;
        const long L = (long)ti * G + c; if (L >= nwg) return false;
        int wgid = (int)L; { const int q = nwg / NXCD, r = nwg % NXCD, xcd = wgid % NXCD, off = wgid / NXCD; wgid = (xcd < r ? xcd * (q + 1) : r * (q + 1) + (xcd - r) * q) + off; }
        const int nig = WGM * nN, gid = wgid / nig, fm = gid * WGM, gsz = (nM - fm) < WGM ? (nM - fm) : WGM;
        u.pm = fm + ((wgid % nig) % gsz); u.pn = (wgid % nig) / gsz; return true;
    }
};

template <class Epi>
__device__ __forceinline__ void gemm_phase(LAS unsigned char* lds, const GemmDesc g0, const GemmDesc g1, const Sched& S, const Epi& E) {
    const int tid = opaque_tid(), wid = __builtin_amdgcn_readfirstlane(tid >> 6), lane = tid & 63, wr = wid >> 2, wc = wid & 3, fr = lane & 15, fq = lane >> 4;
    constexpr int K = KD, nt = K / BK;
    unsigned voffA0[2], voffA1[2], voffB[2];
#pragma unroll
    for (int i = 0; i < 2; ++i) { int R, C; stage_rc(tid * 16 + i * 8192, R, C); const int Rb = Epi::PERM ? ((R & ~31) + perm32(R & 31)) : R;
        voffA0[i] = (unsigned)(R * g0.lda + C) * 2u; voffA1[i] = (unsigned)(R * g1.lda + C) * 2u; voffB[i] = (unsigned)(Rb * K + C) * 2u; }
    const size_t kstep = (size_t)(BK * 2);
    const size_t hstepB = (size_t)HALF * K * 2;
    const unsigned ldsw = (unsigned)wid * 1024u;
    const int aoff = lds_byte(wr * 64 + fr, fq * 8), boff = lds_byte(wc * 32 + fr, fq * 8);
#define PG8_SA(b, h) (((b) * 2 + (h)) * HTB)
#define PG8_SB(b, h) ((4 + (b) * 2 + (h)) * HTB)
#define PG8_STAGE(bufoff, gbase, v0, v1) do { \
        __builtin_amdgcn_global_load_lds((const unsigned*)((const char*)(gbase) + (v0)), (LAS unsigned*)(lds + (bufoff) + ldsw), 16, 0, 0); \
        __builtin_amdgcn_global_load_lds((const unsigned*)((const char*)(gbase) + (v1)), (LAS unsigned*)(lds + (bufoff) + ldsw + 8192), 16, 0, 0); } while (0)
#define PG8_STAGEB(bufoff, gbase) PG8_STAGE(bufoff, gbase, voffB[0], voffB[1])
#define PG8_LDA(dst, b, h) do { _Pragma("unroll") for (int m = 0; m < 4; ++m) _Pragma("unroll") for (int k = 0; k < 2; ++k) dst[m][k] = *(const LAS bf16x8*)(lds + PG8_SA(b, h) + aoff + m * 2048 + k * 1024); } while (0)
#define PG8_LDB(dst, b, h) do { _Pragma("unroll") for (int n = 0; n < 2; ++n) _Pragma("unroll") for (int k = 0; k < 2; ++k) dst[n][k] = *(const LAS bf16x8*)(lds + PG8_SB(b, h) + boff + n * 2048 + k * 1024); } while (0)
#define PG8_MMA(ai, bj, At, Bt) do { __builtin_amdgcn_s_setprio(1); _Pragma("unroll") for (int m = 0; m < 4; ++m) _Pragma("unroll") for (int n = 0; n < 2; ++n) _Pragma("unroll") for (int k = 0; k < 2; ++k) \
        acc[ai][bj][m][n] = __builtin_amdgcn_mfma_f32_16x16x32_bf16(Bt[n][k], At[m][k], acc[ai][bj][m][n], 0, 0, 0); __builtin_amdgcn_s_setprio(0); } while (0)
#define PG8_WAIT_V(n) asm volatile("s_waitcnt vmcnt(" #n ")" ::: "memory")
#define PG8_WAIT_L(n) asm volatile("s_waitcnt lgkmcnt(" #n ")" ::: "memory")
#define PG8_BAR __builtin_amdgcn_s_barrier()
#define PG8_SCHED __builtin_amdgcn_sched_barrier(0)
    Unit cur, nxt; int ui = 0;
    if (!S.next(0, cur)) return;
    f32x4 acc[2][2][4][2];
#pragma unroll
    for (int a = 0; a < 2; ++a)
#pragma unroll
        for (int b = 0; b < 2; ++b)
#pragma unroll
            for (int m = 0; m < 4; ++m)
#pragma unroll
                for (int n = 0; n < 2; ++n) acc[a][b][m][n] = (f32x4){0.f, 0.f, 0.f, 0.f};
    bf16x8 At[4][2], B0[2][2], B1[2][2];
    const char* cA = (const char*)(cur.sel ? g1.A : g0.A) + (size_t)cur.pm * 256 * (size_t)(cur.sel ? g1.lda : g0.lda) * 2;
    const char* cB = (const char*)(cur.sel ? g1.Bt : g0.Bt) + (size_t)cur.pn * 256 * K * 2;
    size_t chA = (size_t)HALF * (cur.sel ? g1.lda : g0.lda) * 2;
    unsigned cv0 = cur.sel ? voffA1[0] : voffA0[0], cv1 = cur.sel ? voffA1[1] : voffA0[1];
    PG8_STAGEB(PG8_SB(0, 0), cB); PG8_STAGEB(PG8_SB(0, 1), cB + hstepB); PG8_STAGE(PG8_SA(0, 0), cA, cv0, cv1); PG8_STAGE(PG8_SA(0, 1), cA + chA, cv0, cv1);
    if (wr == 1) PG8_BAR;
    PG8_WAIT_V(2); PG8_BAR;
    PG8_STAGEB(PG8_SB(1, 0), cB + kstep); PG8_STAGE(PG8_SA(1, 0), cA + kstep, cv0, cv1); PG8_STAGEB(PG8_SB(1, 1), cB + hstepB + kstep);
    PG8_WAIT_V(6); PG8_BAR;
    for (;;) {
        const bool has_next = S.next(ui + 1, nxt);
        const int nsel = has_next ? nxt.sel : cur.sel;
        const char* nA = has_next ? (const char*)(nsel ? g1.A : g0.A) + (size_t)nxt.pm * 256 * (size_t)(nsel ? g1.lda : g0.lda) * 2 : cA;
        const char* nB = has_next ? (const char*)(nsel ? g1.Bt : g0.Bt) + (size_t)nxt.pn * 256 * K * 2 : cB;
        const size_t nhA = (size_t)HALF * (nsel ? g1.lda : g0.lda) * 2;
        const unsigned nv0 = nsel ? voffA1[0] : voffA0[0], nv1 = nsel ? voffA1[1] : voffA0[1];
        for (int t = 0; t < nt; t += 2) {
            const bool last = (t == nt - 2);
            const char* a1 = cA + (size_t)(t + 1) * kstep;
            const char* a2 = last ? nA : cA + (size_t)(t + 2) * kstep; const char* b2 = last ? nB : cB + (size_t)(t + 2) * kstep;
            const char* a3 = a2 + kstep; const char* b3 = b2 + kstep;
            const size_t h2 = last ? nhA : chA; const unsigned w0 = last ? nv0 : cv0, w1 = last ? nv1 : cv1;
            PG8_LDB(B0, 0, 0); PG8_LDB(B1, 0, 1); PG8_SCHED; PG8_LDA(At, 0, 0); PG8_STAGE(PG8_SA(1, 1), a1 + chA, cv0, cv1);
            PG8_WAIT_V(8); PG8_WAIT_L(0); PG8_BAR; PG8_MMA(0, 0, At, B0); PG8_MMA(0, 1, At, B1); PG8_BAR; PG8_SCHED;
            PG8_LDA(At, 0, 1); PG8_STAGEB(PG8_SB(0, 0), b2); PG8_STAGEB(PG8_SB(0, 1), b2 + hstepB); PG8_STAGE(PG8_SA(0, 0), a2, w0, w1);
            PG8_WAIT_V(8); PG8_WAIT_L(0); PG8_BAR; PG8_MMA(1, 0, At, B0); PG8_MMA(1, 1, At, B1); PG8_BAR; PG8_SCHED;
            PG8_LDB(B0, 1, 0); PG8_LDB(B1, 1, 1); PG8_SCHED; PG8_LDA(At, 1, 0); PG8_STAGE(PG8_SA(0, 1), a2 + h2, w0, w1);
            PG8_WAIT_V(8); PG8_WAIT_L(0); PG8_BAR; PG8_MMA(0, 0, At, B0); PG8_MMA(0, 1, At, B1); PG8_BAR; PG8_SCHED;
            PG8_LDA(At, 1, 1); PG8_STAGEB(PG8_SB(1, 0), b3); PG8_STAGEB(PG8_SB(1, 1), b3 + hstepB); PG8_STAGE(PG8_SA(1, 0), a3, w0, w1);
            PG8_WAIT_V(8); PG8_WAIT_L(0); PG8_BAR; PG8_MMA(1, 0, At, B0); PG8_MMA(1, 1, At, B1); PG8_BAR; PG8_SCHED;
        }
        if (wr == 0) PG8_BAR;
        E(acc, cur, wr, wc, fr, fq);
        if (!has_next) break;
#pragma unroll
        for (int a = 0; a < 2; ++a)
#pragma unroll
            for (int b = 0; b < 2; ++b)
#pragma unroll
                for (int m = 0; m < 4; ++m)
#pragma unroll
                    for (int n = 0; n < 2; ++n) acc[a][b][m][n] = (f32x4){0.f, 0.f, 0.f, 0.f};
        cur = nxt; cA = nA; cB = nB; chA = nhA; cv0 = nv0; cv1 = nv1; ++ui;
        if (wr == 1) PG8_BAR;
    }
    PG8_WAIT_V(0);
    PG8_BAR;
#undef PG8_SA
#undef PG8_SB
#undef PG8_STAGE
#undef PG8_STAGEB
#undef PG8_LDA
#undef PG8_LDB
#undef PG8_MMA
#undef PG8_WAIT_V
#undef PG8_WAIT_L
#undef PG8_BAR
#undef PG8_SCHED
}

struct EpiStore {
    static constexpr bool PERM = true;
    bf16_t* O; int ldc;
    __device__ __forceinline__ void operator()(const f32x4 (&acc)[2][2][4][2], const Unit& u, int wr, int wc, int fr, int fq) const {
        const int row0 = u.pm * BM + wr * 64 + fr, col0 = u.pn * BM + wc * 32 + 8 * fq;
#pragma unroll
        for (int ai = 0; ai < 2; ++ai)
#pragma unroll
            for (int m = 0; m < 4; ++m) { bf16_t* rowp = O + (size_t)(row0 + ai * HALF + m * 16) * ldc + col0;
#pragma unroll
                for (int bj = 0; bj < 2; ++bj) { const f32x4 v0 = acc[ai][bj][m][0], v1 = acc[ai][bj][m][1];
                    u32x4 w; w.x = cvt_pk_bf16(v0[0], v0[1]); w.y = cvt_pk_bf16(v0[2], v0[3]); w.z = cvt_pk_bf16(v1[0], v1[1]); w.w = cvt_pk_bf16(v1[2], v1[3]);
                    *(u32x4*)(rowp + bj * HALF) = w; } }
    }
};
struct EpiMerge {
    static constexpr bool PERM = true;
    bf16_t* G; int ldg; const float* bias; bf16_t* Y; int accum;
    __device__ __forceinline__ void operator()(const f32x4 (&acc)[2][2][4][2], const Unit& u, int wr, int wc, int fr, int fq) const {
        const int row0 = u.pm * BM + wr * 64 + fr, col0 = u.pn * BM + wc * 32 + 8 * fq;
        if (u.sel == 0) {
            f32x4 bv[2][2];
#pragma unroll
            for (int bj = 0; bj < 2; ++bj)
#pragma unroll
                for (int n = 0; n < 2; ++n) bv[bj][n] = *(const f32x4*)(bias + col0 + bj * HALF + 4 * n);
#pragma unroll
            for (int ai = 0; ai < 2; ++ai)
#pragma unroll
                for (int m = 0; m < 4; ++m) { bf16_t* rowp = G + (size_t)(row0 + ai * HALF + m * 16) * ldg + col0;
#pragma unroll
                    for (int bj = 0; bj < 2; ++bj) { f32x4 v0 = acc[ai][bj][m][0] + bv[bj][0], v1 = acc[ai][bj][m][1] + bv[bj][1];
#pragma unroll
                        for (int j = 0; j < 4; ++j) { v0[j] = sigmoidf_(v0[j]); v1[j] = sigmoidf_(v1[j]); }
                        u32x4 w; w.x = cvt_pk_bf16(v0[0], v0[1]); w.y = cvt_pk_bf16(v0[2], v0[3]); w.z = cvt_pk_bf16(v1[0], v1[1]); w.w = cvt_pk_bf16(v1[2], v1[3]);
                        *(u32x4*)(rowp + bj * HALF) = w; } }
        } else {
#pragma unroll
            for (int ai = 0; ai < 2; ++ai)
#pragma unroll
                for (int m = 0; m < 4; ++m) { const size_t r = (size_t)(row0 + ai * HALF + m * 16);
                    const unsigned long long* gp = (const unsigned long long*)(G + r * ldg + col0); bf16_t* yp = Y + r * DM + col0;
#pragma unroll
                    for (int bj = 0; bj < 2; ++bj) {
                        const unsigned long long g0 = __hip_atomic_load(gp + bj * (HALF / 4), __ATOMIC_RELAXED, __HIP_MEMORY_SCOPE_AGENT);
                        const unsigned long long g1 = __hip_atomic_load(gp + bj * (HALF / 4) + 1, __ATOMIC_RELAXED, __HIP_MEMORY_SCOPE_AGENT);
                        const unsigned gw[4] = {(unsigned)g0, (unsigned)(g0 >> 32), (unsigned)g1, (unsigned)(g1 >> 32)};
                        u32x4 yo = {0u, 0u, 0u, 0u}; if (accum) yo = *(const u32x4*)(yp + bj * HALF);
                        const f32x4 v0 = acc[ai][bj][m][0], v1 = acc[ai][bj][m][1];
                        u32x4 w;
                        w.x = cvt_pk_bf16(bflo(yo.x) + bflo(gw[0]) * v0[0], bfhi(yo.x) + bfhi(gw[0]) * v0[1]);
                        w.y = cvt_pk_bf16(bflo(yo.y) + bflo(gw[1]) * v0[2], bfhi(yo.y) + bfhi(gw[1]) * v0[3]);
                        w.z = cvt_pk_bf16(bflo(yo.z) + bflo(gw[2]) * v1[0], bfhi(yo.z) + bfhi(gw[2]) * v1[1]);
                        w.w = cvt_pk_bf16(bflo(yo.w) + bflo(gw[3]) * v1[2], bfhi(yo.w) + bfhi(gw[3]) * v1[3]);
                        *(u32x4*)(yp + bj * HALF) = w; } }
        }
    }
};
struct EpiResid {
    static constexpr bool PERM = false;
    const float* Xin; float* Xout;
    __device__ __forceinline__ void operator()(const f32x4 (&acc)[2][2][4][2], const Unit& u, int wr, int wc, int fr, int fq) const {
        const int row0 = u.pm * BM + wr * 64 + fr, col0 = u.pn * BM + wc * 32 + 4 * fq;
#pragma unroll
        for (int ai = 0; ai < 2; ++ai)
#pragma unroll
            for (int m = 0; m < 4; ++m) { const size_t ro = (size_t)(row0 + ai * HALF + m * 16) * DM + col0;
#pragma unroll
                for (int bj = 0; bj < 2; ++bj)
#pragma unroll
                    for (int n = 0; n < 2; ++n) { const f32x4 xi = *(const f32x4*)(Xin + ro + bj * HALF + n * 16); *(f32x4*)(Xout + ro + bj * HALF + n * 16) = xi + acc[ai][bj][m][n]; } }
    }
};
}

__device__ void phase_convert(int l, unsigned char* smem) {
    const Params p = load_params();
    float* tile = (float*)smem;
    const int tid = opaque_tid();
    const float* win = p.w_in + (size_t)l * DM * N_IN;
    bf16_t* WtIn = p.Wt; bf16_t* WtBr = p.Wt + (size_t)WT_ROWS * DM; bf16_t* WtOut = WtBr + (size_t)3 * DM * DM;
    const int NT_IN = WT_ROWS / 64;
    const int total = (NT_IN + 48 + 16) * 16;
    for (int it = blockIdx.x; it < total; it += gridDim.x) {
        const int ntile = it >> 4, kt = it & 15, k0 = kt * 64;
        const float* src = nullptr; int ld = 0, c0 = 0, valid = 64; bf16_t* dst;
        if (ntile < NT_IN) {
            const int n0 = ntile * 64; dst = WtIn + (size_t)n0 * DM;
            if (n0 < 4224) { src = win; ld = N_IN; c0 = n0; }
            else if (n0 < 4352) { if (n0 == 4224 && l > 0) { src = p.v_w1 + (size_t)(l - 1) * DM * 32; ld = 32; c0 = 0; valid = 32; } else { valid = 0; } }
            else { src = win; ld = N_IN; c0 = n0 - 128; }
        } else if (ntile < NT_IN + 48) {
            const int q = ntile - NT_IN, n = q >> 4, n0 = (q & 15) * 64;
            src = p.w_branch + ((size_t)l * 3 + n) * DM * DM; ld = DM; c0 = n0; dst = WtBr + ((size_t)n * DM + n0) * DM;
        } else {
            const int n0 = (ntile - NT_IN - 48) * 64; src = p.w_out + (size_t)l * DM * DM; ld = DM; c0 = n0; dst = WtOut + (size_t)n0 * DM;
        }
        __syncthreads();
        if (valid == 64) {
            const int kr = tid >> 4, nc = (tid & 15) * 4;
#pragma unroll
            for (int ps = 0; ps < 2; ++ps) { const int k = kr + ps * 32; const f32x4 v = *(const f32x4*)(src + (size_t)(k0 + k) * ld + c0 + nc);
                tile[k * 65 + nc] = v[0]; tile[k * 65 + nc + 1] = v[1]; tile[k * 65 + nc + 2] = v[2]; tile[k * 65 + nc + 3] = v[3]; }
        } else {
            for (int e = tid; e < 4096; e += 512) { const int k = e >> 6, n = e & 63; tile[k * 65 + n] = (n < valid) ? src[(size_t)(k0 + k) * ld + c0 + n] : 0.f; }
        }
        __syncthreads();
        { const int nr = tid >> 3, kc = (tid & 7) * 8; u32x4 w;
          w.x = cvt_pk_bf16(tile[(kc + 0) * 65 + nr], tile[(kc + 1) * 65 + nr]); w.y = cvt_pk_bf16(tile[(kc + 2) * 65 + nr], tile[(kc + 3) * 65 + nr]);
          w.z = cvt_pk_bf16(tile[(kc + 4) * 65 + nr], tile[(kc + 5) * 65 + nr]); w.w = cvt_pk_bf16(tile[(kc + 6) * 65 + nr], tile[(kc + 7) * 65 + nr]);
          *(u32x4*)(dst + (size_t)nr * DM + k0 + kc) = w; }
    }
    __syncthreads();
}

__device__ void phase_rmsnorm(const float* x, const float* g, bf16_t* xn, float* outf) {
    const int tid_ = opaque_tid(); const int lane = tid_ & 63, wv = tid_ >> 6;
    f32x4 gv[4];
#pragma unroll
    for (int q = 0; q < 4; ++q) gv[q] = *(const f32x4*)(g + q * 256 + lane * 4);
    for (int row = blockIdx.x * 8 + wv; row < T_TOK; row += gridDim.x * 8) {
        const float* xr = x + (size_t)row * DM; f32x4 v[4]; float ss = 0.f;
#pragma unroll
        for (int q = 0; q < 4; ++q) { v[q] = *(const f32x4*)(xr + q * 256 + lane * 4); ss += v[q][0] * v[q][0] + v[q][1] * v[q][1] + v[q][2] * v[q][2] + v[q][3] * v[q][3]; }
#pragma unroll
        for (int o = 32; o > 0; o >>= 1) ss += __shfl_xor(ss, o);
        const float rinv = rsqrtf(ss * (1.0f / DM) + EPS);
#pragma unroll
        for (int q = 0; q < 4; ++q) { const f32x4 o = v[q] * rinv * gv[q];
            if (xn) { u32x2 w; w.x = cvt_pk_bf16(o[0], o[1]); w.y = cvt_pk_bf16(o[2], o[3]); *(u32x2*)(xn + (size_t)row * DM + q * 256 + lane * 4) = w; }
            else *(f32x4*)(outf + (size_t)row * DM + q * 256 + lane * 4) = o; }
    }
}

template <int CTRL> __device__ __forceinline__ float dpp_f(float v) { return __int_as_float(__builtin_amdgcn_update_dpp(0, __float_as_int(v), CTRL, 0xf, 0xf, false)); }
__device__ __forceinline__ float red8(float v) { v += dpp_f<0xB1>(v); v += dpp_f<0x4E>(v); v += dpp_f<0x141>(v); return v; }
__device__ __forceinline__ float red16(float v) { v = red8(v); v += dpp_f<0x140>(v); return v; }

struct RwRaw { u32x4 cw[2], pw[2], ca[2], pa[2], vl; u32x2 cr[2], pr[2], ck[2], pk[2], cv, pv, vf; };
__device__ __forceinline__ void rw_load(RwRaw& R, const bf16_t* H, const bf16_t* vfp, int l, size_t tok, bool hasp, int h, int chh, int vnt, int fq) {
    const bf16_t* cur = H + tok * LDA_H; const bf16_t* prev = cur - LDA_H;
    const u32x4 z4 = {0u, 0u, 0u, 0u}; const u32x2 z2 = {0u, 0u};
#pragma unroll
    for (int ks = 0; ks < 2; ++ks) { const int m0 = ks * 32 + fq * 8;
        R.cw[ks] = *(const u32x4*)(cur + 3072 + m0); R.ca[ks] = *(const u32x4*)(cur + 3136 + m0);
        R.pw[ks] = hasp ? *(const u32x4*)(prev + 3072 + m0) : z4; R.pa[ks] = hasp ? *(const u32x4*)(prev + 3136 + m0) : z4; }
#pragma unroll
    for (int q = 0; q < 2; ++q) { const int cb = h * 64 + (chh * 2 + q) * 16 + fq * 4;
        R.cr[q] = *(const u32x2*)(cur + cb); R.ck[q] = *(const u32x2*)(cur + 1024 + cb);
        R.pr[q] = hasp ? *(const u32x2*)(prev + cb) : z2; R.pk[q] = hasp ? *(const u32x2*)(prev + 1024 + cb) : z2; }
    const int cbv = h * 64 + vnt * 16 + fq * 4;
    R.cv = *(const u32x2*)(cur + 2048 + cbv); R.pv = hasp ? *(const u32x2*)(prev + 2048 + cbv) : z2;
    R.vf = z2; R.vl = z4;
    if (l > 0) { R.vf = *(const u32x2*)(vfp + tok * DM + cbv); R.vl = *(const u32x4*)(cur + 4224 + fq * 8); }
}

__device__ void phase_rwkv(int l, unsigned char* smem, int mode) {
    const Params p = load_params();
    constexpr int TC = 32, NCH = SEQ / TC, RS = 68  , BUFSZ = 5 * TC * RS + TC * 32 + TC * 2;
    bf16_t* w2T = (bf16_t*)smem;
    bf16_t* a2T = w2T + 64 * 72;
    bf16_t* v2T = a2T + 64 * 72;
    float* cst = (float*)(v2T + 64 * 40);
    float* buf0 = cst + 11 * 64;
    float* ypart = buf0 + 2 * BUFSZ;
    float* sI = ypart + 4 * TC * 64;
    const int tid = opaque_tid(), wid = __builtin_amdgcn_readfirstlane(tid >> 6), lane = tid & 63, fr = lane & 15, fq = lane >> 4;
    for (int item = blockIdx.x; item < NB * 32; item += gridDim.x) {
        const int xc_ = item & 7, sl_ = item >> 3, half = sl_ & 1, pi_ = (sl_ >> 1) * 8 + xc_, b = pi_ >> 4, h = pi_ & 15;
        __syncthreads();
        for (int e = tid; e < 4096; e += 512) { const int m = e >> 6, j = e & 63; w2T[j * 72 + m] = f2bf(p.w_w2[((size_t)l * 64 + m) * DM + h * 64 + j]); a2T[j * 72 + m] = f2bf(p.a_w2[((size_t)l * 64 + m) * DM + h * 64 + j]); }
        if (l > 0) for (int e = tid; e < 2048; e += 512) { const int m = e >> 6, j = e & 63; v2T[j * 40 + m] = f2bf(p.v_w2[((size_t)(l - 1) * 32 + m) * DM + h * 64 + j]); }
        if (tid < 64) { const float* mu = p.mu + (size_t)l * 3200; const int cc = h * 64 + tid;
            cst[tid] = mu[cc]; cst[64 + tid] = mu[1024 + cc]; cst[128 + tid] = mu[2048 + cc]; cst[192 + tid] = p.w0[l * DM + cc]; cst[256 + tid] = p.a0[l * DM + cc];
            cst[320 + tid] = (l > 0) ? p.v0[(l - 1) * DM + cc] : 0.f; cst[384 + tid] = p.k_k[l * DM + cc]; cst[448 + tid] = p.k_a[l * DM + cc]; cst[512 + tid] = p.r_k[l * DM + cc];
            cst[576 + tid] = mu[3072 + tid]; cst[640 + tid] = mu[3136 + tid]; }
        __syncthreads();
        f32x2 st[4];
#pragma unroll
        for (int j = 0; j < 4; ++j) st[j] = (f32x2){0.f, 0.f};
        const int si = tid >> 3, seg = tid & 7;
        const int pwv = wid - 4, tti = pwv & 1, chh = (pwv >> 1) & 1, vnt = half * 2 + chh, tt = tti * 16 + fr;
        RwRaw raw;
        if (wid >= 4) rw_load(raw, p.H, p.vf, l, (size_t)b * SEQ + tt, tt > 0, h, chh, vnt, fq);
        for (int c = -1; c < NCH; ++c) {
            if (wid >= 4 && c + 1 < NCH && !(mode & 2)) {
                float* B_ = buf0 + ((c + 1) & 1) * BUFSZ;
                float* sR = B_; float* sW = sR + TC * RS; float* sK = sW + TC * RS; float* sA = sK + TC * RS; float* sB = sA + TC * RS; float* sV = sB + TC * RS; float* sS = sV + TC * 32;
                const size_t tok = (size_t)b * SEQ + (c + 1) * TC + tt;
                const RwRaw& cr_ = raw;
                bf16x8 AfW[2], AfA[2];
#pragma unroll
                for (int ks = 0; ks < 2; ++ks) { const int m0 = ks * 32 + fq * 8;
                    const f32x4 mw0 = *(const f32x4*)(cst + 576 + m0), mw1 = *(const f32x4*)(cst + 576 + m0 + 4), ma0 = *(const f32x4*)(cst + 640 + m0), ma1 = *(const f32x4*)(cst + 640 + m0 + 4);
                    const float muw[8] = {mw0[0], mw0[1], mw0[2], mw0[3], mw1[0], mw1[1], mw1[2], mw1[3]}, mua[8] = {ma0[0], ma0[1], ma0[2], ma0[3], ma1[0], ma1[1], ma1[2], ma1[3]};
                    const unsigned cwv[4] = {cr_.cw[ks].x, cr_.cw[ks].y, cr_.cw[ks].z, cr_.cw[ks].w}, pwq[4] = {cr_.pw[ks].x, cr_.pw[ks].y, cr_.pw[ks].z, cr_.pw[ks].w};
                    const unsigned cav[4] = {cr_.ca[ks].x, cr_.ca[ks].y, cr_.ca[ks].z, cr_.ca[ks].w}, pav[4] = {cr_.pa[ks].x, cr_.pa[ks].y, cr_.pa[ks].z, cr_.pa[ks].w};
                    unsigned ow[4], oa[4];
#pragma unroll
                    for (int e = 0; e < 4; ++e) {
                        const float c0 = bflo(cwv[e]), c1 = bfhi(cwv[e]), q0 = bflo(pwq[e]), q1 = bfhi(pwq[e]);
                        ow[e] = cvt_pk_bf16(tanh_fast(c0 + muw[2 * e] * (q0 - c0)), tanh_fast(c1 + muw[2 * e + 1] * (q1 - c1)));
                        const float d0 = bflo(cav[e]), d1 = bfhi(cav[e]), r0 = bflo(pav[e]), r1 = bfhi(pav[e]);
                        oa[e] = cvt_pk_bf16(d0 + mua[2 * e] * (r0 - d0), d1 + mua[2 * e + 1] * (r1 - d1)); }
                    AfW[ks] = __builtin_bit_cast(bf16x8, ((u32x4){ow[0], ow[1], ow[2], ow[3]})); AfA[ks] = __builtin_bit_cast(bf16x8, ((u32x4){oa[0], oa[1], oa[2], oa[3]})); }
                f32x4 accW[2], accA[2], accV = (f32x4){0.f, 0.f, 0.f, 0.f};
#pragma unroll
                for (int q = 0; q < 2; ++q) { const int nt = chh * 2 + q; accW[q] = (f32x4){0.f, 0.f, 0.f, 0.f}; accA[q] = (f32x4){0.f, 0.f, 0.f, 0.f};
#pragma unroll
                    for (int ks = 0; ks < 2; ++ks) { const bf16x8 bw = *(const bf16x8*)(w2T + (nt * 16 + fr) * 72 + ks * 32 + fq * 8), ba = *(const bf16x8*)(a2T + (nt * 16 + fr) * 72 + ks * 32 + fq * 8);
                        accW[q] = __builtin_amdgcn_mfma_f32_16x16x32_bf16(bw, AfW[ks], accW[q], 0, 0, 0); accA[q] = __builtin_amdgcn_mfma_f32_16x16x32_bf16(ba, AfA[ks], accA[q], 0, 0, 0); } }
                if (l > 0) { const bf16x8 bv = *(const bf16x8*)(v2T + (vnt * 16 + fr) * 40 + fq * 8); accV = __builtin_amdgcn_mfma_f32_16x16x32_bf16(bv, __builtin_bit_cast(bf16x8, cr_.vl), accV, 0, 0, 0); }
                float ss = 0.f, rk = 0.f;
#pragma unroll
                for (int q = 0; q < 2; ++q) { const int ch0 = (chh * 2 + q) * 16 + fq * 4;
                    const float fr_[4] = {bflo(cr_.cr[q].x), bfhi(cr_.cr[q].x), bflo(cr_.cr[q].y), bfhi(cr_.cr[q].y)}, fpr[4] = {bflo(cr_.pr[q].x), bfhi(cr_.pr[q].x), bflo(cr_.pr[q].y), bfhi(cr_.pr[q].y)};
                    const float fk_[4] = {bflo(cr_.ck[q].x), bfhi(cr_.ck[q].x), bflo(cr_.ck[q].y), bfhi(cr_.ck[q].y)}, fpk[4] = {bflo(cr_.pk[q].x), bfhi(cr_.pk[q].x), bflo(cr_.pk[q].y), bfhi(cr_.pk[q].y)};
                    const f32x4 mur = *(const f32x4*)(cst + ch0), muk = *(const f32x4*)(cst + 64 + ch0), w0v = *(const f32x4*)(cst + 192 + ch0), a0v = *(const f32x4*)(cst + 256 + ch0),
                        kkv = *(const f32x4*)(cst + 384 + ch0), kav = *(const f32x4*)(cst + 448 + ch0), rkv = *(const f32x4*)(cst + 512 + ch0);
                    f32x4 ro, wo, ko, ao, bo;
#pragma unroll
                    for (int e = 0; e < 4; ++e) {
                        const float r = fr_[e] + mur[e] * (fpr[e] - fr_[e]), k = fk_[e] + muk[e] * (fpk[e] - fk_[e]);
                        wo[e] = __expf(-0.60653065971f * sigmoidf_(w0v[e] + accW[q][e]));
                        const float a = sigmoidf_(a0v[e] + accA[q][e]);
                        const float kq = k * kkv[e]; ss += kq * kq; ao[e] = -kq; bo[e] = kq * a;
                        const float km = k * (1.0f + (a - 1.0f) * kav[e]); rk += r * km * rkv[e]; ro[e] = r; ko[e] = km; }
                    *(f32x4*)(sR + tt * RS + ch0) = ro; *(f32x4*)(sW + tt * RS + ch0) = wo; *(f32x4*)(sK + tt * RS + ch0) = ko; *(f32x4*)(sA + tt * RS + ch0) = ao; *(f32x4*)(sB + tt * RS + ch0) = bo; }
                ss += __shfl_xor(ss, 16); ss += __shfl_xor(ss, 32); rk += __shfl_xor(rk, 16); rk += __shfl_xor(rk, 32);
                if (fq == 0) { sS[tt * 2 + chh] = ss; if (half == 0) p.rkbuf[(size_t)((b * 16 + h) * 2 + chh) * SEQ + (c + 1) * TC + tt] = rk; }
                { const int ch0 = vnt * 16 + fq * 4, cb = h * 64 + ch0;
                  const float fv_[4] = {bflo(cr_.cv.x), bfhi(cr_.cv.x), bflo(cr_.cv.y), bfhi(cr_.cv.y)}, fpv[4] = {bflo(cr_.pv.x), bfhi(cr_.pv.x), bflo(cr_.pv.y), bfhi(cr_.pv.y)};
                  const f32x4 muv = *(const f32x4*)(cst + 128 + ch0), v0v = *(const f32x4*)(cst + 320 + ch0);
                  f32x4 vo;
#pragma unroll
                  for (int e = 0; e < 4; ++e) vo[e] = fv_[e] + muv[e] * (fpv[e] - fv_[e]);
                  if (l > 0) { const float vfv[4] = {bflo(cr_.vf.x), bfhi(cr_.vf.x), bflo(cr_.vf.y), bfhi(cr_.vf.y)};
#pragma unroll
                      for (int e = 0; e < 4; ++e) vo[e] = vo[e] + (vfv[e] - vo[e]) * sigmoidf_(v0v[e] + accV[e]); }
                  u32x2 w; w.x = cvt_pk_bf16(vo[0], vo[1]); w.y = cvt_pk_bf16(vo[2], vo[3]); *(u32x2*)(p.vf + tok * DM + cb) = w;
                  *(f32x4*)(sV + tt * 32 + chh * 16 + fq * 4) = vo; }
            }
            if (wid >= 4 && c + 2 < NCH && !(mode & 2)) rw_load(raw, p.H, p.vf, l, (size_t)b * SEQ + (size_t)(c + 2) * TC + tt, true, h, chh, vnt, fq);
            if (wid < 4 && c >= 0 && !(mode & 1)) {
                const float* B_ = buf0 + (c & 1) * BUFSZ;
                const float* sR = B_; const float* sW = sR + TC * RS; const float* sK = sW + TC * RS; const float* sA = sK + TC * RS; const float* sB = sA + TC * RS; const float* sV = sB + TC * RS; const float* sS = sV + TC * 32;
                float* yp = ypart + wid * (TC * 64) + lane; float* sIw = sI + wid * TC;
                if (lane < TC) { const f32x2 ps = *(const f32x2*)(sS + lane * 2); sIw[lane] = __builtin_amdgcn_rcpf(fmaxf(ps.x + ps.y, 1e-24f)); }
                f32x4 A0, A1, W0, W1, B0, B1, K0, K1, R0, R1; float VI, IV;
#define SC_LOAD(s_) do { const int o_ = (s_) * RS + seg * 8; \
                    A0 = *(const f32x4*)(sA + o_); A1 = *(const f32x4*)(sA + o_ + 4); W0 = *(const f32x4*)(sW + o_); W1 = *(const f32x4*)(sW + o_ + 4); \
                    B0 = *(const f32x4*)(sB + o_); B1 = *(const f32x4*)(sB + o_ + 4); K0 = *(const f32x4*)(sK + o_); K1 = *(const f32x4*)(sK + o_ + 4); \
                    R0 = *(const f32x4*)(sR + o_); R1 = *(const f32x4*)(sR + o_ + 4); VI = sV[(s_) * 32 + si]; IV = sIw[(s_)]; } while (0)
                SC_LOAD(0);
#pragma unroll 4
                for (int s = 0; s < TC; ++s) {
                    const f32x4 a0 = A0, a1 = A1, w0 = W0, w1 = W1, b0 = B0, b1 = B1, k0 = K0, k1 = K1, r0 = R0, r1 = R1; const float vi = VI, inv2 = IV;
                    if (s + 1 < TC) SC_LOAD(s + 1);
                    __builtin_amdgcn_sched_barrier(0);
                    const f32x2 av[4] = {{a0[0], a0[1]}, {a0[2], a0[3]}, {a1[0], a1[1]}, {a1[2], a1[3]}}, wv[4] = {{w0[0], w0[1]}, {w0[2], w0[3]}, {w1[0], w1[1]}, {w1[2], w1[3]}};
                    const f32x2 bv[4] = {{b0[0], b0[1]}, {b0[2], b0[3]}, {b1[0], b1[1]}, {b1[2], b1[3]}}, kv[4] = {{k0[0], k0[1]}, {k0[2], k0[3]}, {k1[0], k1[1]}, {k1[2], k1[3]}};
                    const f32x2 rv[4] = {{r0[0], r0[1]}, {r0[2], r0[3]}, {r1[0], r1[1]}, {r1[2], r1[3]}};
                    const f32x2 vi2 = {vi, vi};
                    f32x2 vk[4];
#pragma unroll
                    for (int j = 0; j < 4; ++j) vk[j] = vi2 * kv[j];
                    const f32x2 pa = st[0] * av[0] + st[1] * av[1], pb = st[2] * av[2] + st[3] * av[3]; const f32x2 pc = pa + pb;
                    const float sa = red8(pc.x + pc.y) * inv2;
                    const f32x2 sa2 = {sa, sa};
#pragma unroll
                    for (int j = 0; j < 4; ++j) st[j] = st[j] * wv[j] + (sa2 * bv[j] + vk[j]);
                    const f32x2 qa = st[0] * rv[0] + st[1] * rv[1], qb = st[2] * rv[2] + st[3] * rv[3]; const f32x2 qc = qa + qb;
                    yp[s * 64] = qc.x + qc.y;
                }
#undef SC_LOAD
                { const int tk = lane >> 1, rq = (lane & 1) * 4; const float* yr = ypart + wid * (TC * 64) + tk * 64 + rq * 8; float yv[4];
#pragma unroll
                  for (int r_ = 0; r_ < 4; ++r_) { const f32x4 u0 = *(const f32x4*)(yr + r_ * 8), u1 = *(const f32x4*)(yr + r_ * 8 + 4); yv[r_] = ((u0[0] + u0[1]) + (u0[2] + u0[3])) + ((u1[0] + u1[1]) + (u1[2] + u1[3])); }
                  u32x2 w; w.x = cvt_pk_bf16(yv[0], yv[1]); w.y = cvt_pk_bf16(yv[2], yv[3]);
                  *(u32x2*)(p.y + ((size_t)b * SEQ + c * TC + tk) * DM + h * 64 + half * 32 + wid * 8 + rq) = w; }
            }
            __syncthreads();
        }
    }
    __syncthreads();
}

__device__ void phase_rwkv_post(int l, bf16_t* oalt) {
    const Params p = load_params();
    const int tid = opaque_tid(), l8 = tid & 7;
    const int ngrp = T_TOK * 16;
    for (int g = blockIdx.x * 64 + (tid >> 3); g < ngrp; g += gridDim.x * 64) {
        const int tok = g >> 4, h = g & 15, cb = h * 64 + l8 * 8;
        const u32x4 y4 = *(const u32x4*)(p.y + (size_t)tok * DM + cb), b4 = *(const u32x4*)(p.vf + (size_t)tok * DM + cb);
        const int bb = tok / SEQ, tq = tok % SEQ; const float rk = p.rkbuf[(size_t)((bb * 16 + h) * 2) * SEQ + tq] + p.rkbuf[(size_t)((bb * 16 + h) * 2 + 1) * SEQ + tq];
        bf16_t* zp = p.H + (size_t)tok * LDA_H + 3200 + cb; const u32x4 z4 = *(const u32x4*)zp;
        const float yv[8] = {bflo(y4.x), bfhi(y4.x), bflo(y4.y), bfhi(y4.y), bflo(y4.z), bfhi(y4.z), bflo(y4.w), bfhi(y4.w)};
        const float bv[8] = {bflo(b4.x), bfhi(b4.x), bflo(b4.y), bfhi(b4.y), bflo(b4.z), bfhi(b4.z), bflo(b4.w), bfhi(b4.w)};
        const float zv[8] = {bflo(z4.x), bfhi(z4.x), bflo(z4.y), bfhi(z4.y), bflo(z4.z), bfhi(z4.z), bflo(z4.w), bfhi(z4.w)};
        float sm = 0.f;
#pragma unroll
        for (int e = 0; e < 8; ++e) sm += yv[e];
        sm = red8(sm); const float mean = sm * (1.0f / 64.f); float d[8], vs = 0.f;
#pragma unroll
        for (int e = 0; e < 8; ++e) { d[e] = yv[e] - mean; vs += d[e] * d[e]; }
        vs = red8(vs); const float rstd = rsqrtf(vs * (1.0f / 64.f) + GN_EPS);
        const f32x4 g0 = *(const f32x4*)(p.lnx_g + l * DM + cb), g1 = *(const f32x4*)(p.lnx_g + l * DM + cb + 4), c0 = *(const f32x4*)(p.lnx_b + l * DM + cb), c1 = *(const f32x4*)(p.lnx_b + l * DM + cb + 4);
        const float gg[8] = {g0[0], g0[1], g0[2], g0[3], g1[0], g1[1], g1[2], g1[3]}, cc[8] = {c0[0], c0[1], c0[2], c0[3], c1[0], c1[1], c1[2], c1[3]};
        float o[8];
#pragma unroll
        for (int e = 0; e < 8; ++e) o[e] = (d[e] * rstd * gg[e] + cc[e] + rk * bv[e]) * siluf_(zv[e]);
        u32x4 w; w.x = cvt_pk_bf16(o[0], o[1]); w.y = cvt_pk_bf16(o[2], o[3]); w.z = cvt_pk_bf16(o[4], o[5]); w.w = cvt_pk_bf16(o[6], o[7]);
        *(u32x4*)(oalt ? oalt + (size_t)tok * DM + cb : zp) = w;
    }
}

__device__ __forceinline__ float wave_sum64(float v) {
    v = red16(v);
    const float a = __int_as_float(__builtin_amdgcn_readlane(__float_as_int(v), 0)), b = __int_as_float(__builtin_amdgcn_readlane(__float_as_int(v), 16));
    const float c = __int_as_float(__builtin_amdgcn_readlane(__float_as_int(v), 32)), d = __int_as_float(__builtin_amdgcn_readlane(__float_as_int(v), 48));
    return (a + b) + (c + d);
}
__device__ void phase_sgu(int l, unsigned char* smem, bf16_t* oalt) {
    const Params p = load_params();
    bf16_t* vnTb = (bf16_t*)smem;
    float* stat = (float*)(smem + 2 * 128 * 136 * 2);
    float* lnG = stat + 256; float* lnB = lnG + DM;
    const int tid = opaque_tid(), wid = tid >> 6, lane = tid & 63, fr = lane & 15, fq = lane >> 4;
    __syncthreads();
    for (int e = tid; e < DM; e += 512) { lnG[e] = p.sgu_ln_g[(size_t)l * DM + e]; lnB[e] = p.sgu_ln_b[(size_t)l * DM + e]; }
    for (int item = blockIdx.x; item < T_TOK / 128; item += gridDim.x) {
        bf16_t* Hb = p.H + (size_t)item * 128 * LDB_H;
        __syncthreads();
#pragma unroll
        for (int hb = 0; hb < 2; ++hb) {
            u32x4 va[8], vb[8];
#pragma unroll
            for (int q = 0; q < 8; ++q) { const bf16_t* vr = Hb + (size_t)(wid * 16 + hb * 8 + q) * LDB_H + 1024 + lane * 16; va[q] = *(const u32x4*)vr; vb[q] = *(const u32x4*)(vr + 8); }
#pragma unroll
            for (int q = 0; q < 8; ++q) {
                const float f[16] = {bflo(va[q].x), bfhi(va[q].x), bflo(va[q].y), bfhi(va[q].y), bflo(va[q].z), bfhi(va[q].z), bflo(va[q].w), bfhi(va[q].w), bflo(vb[q].x), bfhi(vb[q].x), bflo(vb[q].y), bfhi(vb[q].y), bflo(vb[q].z), bfhi(vb[q].z), bflo(vb[q].w), bfhi(vb[q].w)};
                float sm = 0.f, sq = 0.f;
#pragma unroll
                for (int e = 0; e < 16; ++e) { sm += f[e]; sq += f[e] * f[e]; }
                sm = wave_sum64(sm); sq = wave_sum64(sq);
                const float mean = sm * (1.0f / DM), var = fmaxf(sq * (1.0f / DM) - mean * mean, 0.f);
                if (lane == 0) { const int s = wid * 16 + hb * 8 + q; stat[s * 2] = mean; stat[s * 2 + 1] = rsqrtf(var + EPS); } }
        }
        __syncthreads();
        const int trow = wid * 16 + fr; bf16_t* hr = Hb + (size_t)trow * LDB_H;
        const int nks = (wid < 4) ? 2 : 4;
        for (int g = 0; g < 8; ++g) {
            bf16_t* vnT = vnTb + (g & 1) * (128 * 136);
            const int s = tid >> 2, c0 = (tid & 3) * 32;
            const bf16_t* vr = Hb + (size_t)s * LDB_H + 1024 + g * 128 + c0;
            u32x4 vv[4];
#pragma unroll
            for (int q = 0; q < 4; ++q) vv[q] = *(const u32x4*)(vr + q * 8);
            const float* Wg = p.sgu_w + (((size_t)l * 8 + g) * 128 + trow) * 128;
            f32x4 wa[4], wb[4];
#pragma unroll
            for (int ks = 0; ks < 4; ++ks) if (ks < nks) { wa[ks] = *(const f32x4*)(Wg + ks * 32 + fq * 8); wb[ks] = *(const f32x4*)(Wg + ks * 32 + fq * 8 + 4); }
            u32x2 u2[8], z2[8];
#pragma unroll
            for (int ct = 0; ct < 8; ++ct) { const int c = g * 128 + ct * 16 + fq * 4; u2[ct] = *(const u32x2*)(hr + c); z2[ct] = *(const u32x2*)(hr + 2048 + c); }
            const float bs = p.sgu_b[((size_t)l * 8 + g) * 128 + trow];
            { const float mean = stat[s * 2], rstd = stat[s * 2 + 1];
#pragma unroll
              for (int q = 0; q < 4; ++q) { const float f[8] = {bflo(vv[q].x), bfhi(vv[q].x), bflo(vv[q].y), bfhi(vv[q].y), bflo(vv[q].z), bfhi(vv[q].z), bflo(vv[q].w), bfhi(vv[q].w)};
                  const f32x4 g0 = *(const f32x4*)(lnG + g * 128 + c0 + q * 8), g1 = *(const f32x4*)(lnG + g * 128 + c0 + q * 8 + 4), b0 = *(const f32x4*)(lnB + g * 128 + c0 + q * 8), b1 = *(const f32x4*)(lnB + g * 128 + c0 + q * 8 + 4);
                  const float gg[8] = {g0[0], g0[1], g0[2], g0[3], g1[0], g1[1], g1[2], g1[3]}, bb[8] = {b0[0], b0[1], b0[2], b0[3], b1[0], b1[1], b1[2], b1[3]};
#pragma unroll
                  for (int e = 0; e < 8; ++e) { const int c = c0 + q * 8 + e; const float a_ = rstd * gg[e]; vnT[c * 136 + s] = f2bf(f[e] * a_ + (bb[e] - mean * a_)); } } }
            __syncthreads();
            f32x4 acc[8];
#pragma unroll
            for (int i = 0; i < 8; ++i) acc[i] = (f32x4){0.f, 0.f, 0.f, 0.f};
#pragma unroll
            for (int ks = 0; ks < 4; ++ks) if (ks < nks) {
                u32x4 wp; wp.x = cvt_pk_bf16(wa[ks][0], wa[ks][1]); wp.y = cvt_pk_bf16(wa[ks][2], wa[ks][3]); wp.z = cvt_pk_bf16(wb[ks][0], wb[ks][1]); wp.w = cvt_pk_bf16(wb[ks][2], wb[ks][3]);
                const bf16x8 wfrag = __builtin_bit_cast(bf16x8, wp);
#pragma unroll
                for (int ct = 0; ct < 8; ++ct) { const bf16x8 vfrag = *(const bf16x8*)(vnT + (ct * 16 + fr) * 136 + ks * 32 + fq * 8);
                    acc[ct] = __builtin_amdgcn_mfma_f32_16x16x32_bf16(vfrag, wfrag, acc[ct], 0, 0, 0); }
            }
#pragma unroll
            for (int ct = 0; ct < 8; ++ct) { const int c = g * 128 + ct * 16 + fq * 4;
                const float uf[4] = {bflo(u2[ct].x), bfhi(u2[ct].x), bflo(u2[ct].y), bfhi(u2[ct].y)}, zf[4] = {bflo(z2[ct].x), bfhi(z2[ct].x), bflo(z2[ct].y), bfhi(z2[ct].y)};
                float o[4];
#pragma unroll
                for (int j = 0; j < 4; ++j) o[j] = uf[j] * (acc[ct][j] + bs) * siluf_(zf[j]);
                u32x2 w; w.x = cvt_pk_bf16(o[0], o[1]); w.y = cvt_pk_bf16(o[2], o[3]); *(u32x2*)(oalt ? oalt + ((size_t)item * 128 + trow) * DM + c : hr + 2048 + c) = w; }
        }
    }
    __syncthreads();
}

__device__ void phase_hgrn_pre(int l, unsigned char* smem, bool dry) {
    const Params p = load_params();
    float* LF = (float*)smem;
    bf16_t* IB = (bf16_t*)(LF + 64 * 132);
    bf16_t* KB = IB + 64 * 136;
    float* psum = (float*)(KB + 64 * 136);
    float* lbs = psum + 512;
    const int tid = opaque_tid();
    bf16_t* xtra = (l == 0) ? (bf16_t*)p.out : p.vf;
    __syncthreads();
    for (int e = tid; e < DM; e += 512) { float lb = 0.f; if (l == 1) { const float l0 = p.lb_logits[e], l1 = p.lb_logits[DM + e]; lb = __builtin_amdgcn_rcpf(1.0f + __expf(l0 - l1)); } lbs[e] = lb; }
    __syncthreads();
    const int t = tid >> 3, c0 = (tid & 7) * 16;
    const int cc = tid & 127, tq = tid >> 7;
    u32x4 nq0, nq1, nf0, nf1, ni0, ni1;
#define HP_ISSUE(it_) do { const int h_ = (it_) & 7, ch_ = ((it_) >> 3) & 63, b_ = (it_) >> 9; const bf16_t* hr_ = p.H + ((size_t)b_ * SEQ + ch_ * 64 + t) * LDC_H + h_ * 128 + c0; \
        nq0 = *(const u32x4*)hr_; nq1 = *(const u32x4*)(hr_ + 8); nf0 = *(const u32x4*)(hr_ + 1024); nf1 = *(const u32x4*)(hr_ + 1032); ni0 = *(const u32x4*)(hr_ + 2048); ni1 = *(const u32x4*)(hr_ + 2056); } while (0)
    if ((int)blockIdx.x < NB * 64 * 8) HP_ISSUE((int)blockIdx.x);
    for (int item = blockIdx.x; item < NB * 64 * 8; item += gridDim.x) {
        const int h = item & 7, ch = (item >> 3) & 63, b = item >> 9;
        const size_t r0 = (size_t)b * SEQ + ch * 64;
        bf16_t* hr = p.H + (r0 + t) * LDC_H + h * 128 + c0;
        float qv[16], kv[16];
        {
            const u32x4 q0 = nq0, q1 = nq1, f0 = nf0, f1 = nf1, i0 = ni0, i1 = ni1;
            if (item + (int)gridDim.x < NB * 64 * 8) HP_ISSUE(item + (int)gridDim.x);
            const unsigned qa[8] = {q0.x, q0.y, q0.z, q0.w, q1.x, q1.y, q1.z, q1.w}, fa[8] = {f0.x, f0.y, f0.z, f0.w, f1.x, f1.y, f1.z, f1.w};
            *(u32x4*)(IB + t * 136 + c0) = i0; *(u32x4*)(IB + t * 136 + c0 + 8) = i1;
            float lf[16];
#pragma unroll
            for (int e = 0; e < 8; ++e) {
                const float lb0 = lbs[h * 128 + c0 + 2 * e], lb1 = lbs[h * 128 + c0 + 2 * e + 1];
                qv[2 * e] = siluf_(bflo(qa[e])); qv[2 * e + 1] = siluf_(bfhi(qa[e]));
                const float g0 = lb0 + (1.0f - lb0) * sigmoidf_(bflo(fa[e])), g1 = lb1 + (1.0f - lb1) * sigmoidf_(bfhi(fa[e]));
                kv[2 * e] = 1.0f - g0; kv[2 * e + 1] = 1.0f - g1; lf[2 * e] = __logf(g0); lf[2 * e + 1] = __logf(g1); }
#pragma unroll
            for (int e = 0; e < 4; ++e) *(f32x4*)(LF + t * 132 + c0 + e * 4) = (f32x4){lf[e * 4], lf[e * 4 + 1], lf[e * 4 + 2], lf[e * 4 + 3]};
        }
        __syncthreads();
        { float run = 0.f;
#pragma unroll
          for (int e = 0; e < 16; ++e) { run += LF[(tq * 16 + e) * 132 + cc]; LF[(tq * 16 + e) * 132 + cc] = run; }
          psum[tq * 128 + cc] = run; }
        __syncthreads();
        {
            const int tqt = t >> 4;
            unsigned qo[8], ko[8];
#pragma unroll
            for (int e4 = 0; e4 < 4; ++e4) {
                const f32x4 p0 = *(const f32x4*)(psum + c0 + e4 * 4), p1 = *(const f32x4*)(psum + 128 + c0 + e4 * 4), p2 = *(const f32x4*)(psum + 256 + c0 + e4 * 4), p3 = *(const f32x4*)(psum + 384 + c0 + e4 * 4);
                const f32x4 bl = *(const f32x4*)(LF + t * 132 + c0 + e4 * 4);
                float q2[4], k2[4];
#pragma unroll
                for (int j = 0; j < 4; ++j) {
                    const float off = (tqt > 0 ? p0[j] : 0.f) + (tqt > 1 ? p1[j] : 0.f) + (tqt > 2 ? p2[j] : 0.f);
                    const float bmid = p0[j] + p1[j], bb = bl[j] + off;
                    q2[j] = qv[e4 * 4 + j] * __expf(bb - bmid); k2[j] = kv[e4 * 4 + j] * __expf(bmid - bb); }
                qo[e4 * 2] = cvt_pk_bf16(q2[0], q2[1]); qo[e4 * 2 + 1] = cvt_pk_bf16(q2[2], q2[3]); ko[e4 * 2] = cvt_pk_bf16(k2[0], k2[1]); ko[e4 * 2 + 1] = cvt_pk_bf16(k2[2], k2[3]);
                if (t == 0) { f32x4 e1, e3;
#pragma unroll
                    for (int j = 0; j < 4; ++j) { e1[j] = __expf(p0[j] + p1[j]); e3[j] = __expf(p2[j] + p3[j]); }
                    float* gs = p.rkbuf + (size_t)(((b * 64 + ch) * 8 + h)) * 256 + c0 + e4 * 4; *(f32x4*)gs = e1; *(f32x4*)(gs + 128) = e3; }
            }
            const u32x4 qw0 = {qo[0], qo[1], qo[2], qo[3]}, qw1 = {qo[4], qo[5], qo[6], qo[7]}, kw0 = {ko[0], ko[1], ko[2], ko[3]}, kw1 = {ko[4], ko[5], ko[6], ko[7]};
            if (!dry) { *(u32x4*)hr = qw0; *(u32x4*)(hr + 8) = qw1; *(u32x4*)(hr + 1024) = kw0; *(u32x4*)(hr + 1032) = kw1; }
            *(u32x4*)(KB + t * 136 + c0) = kw0; *(u32x4*)(KB + t * 136 + c0 + 8) = kw1;
        }
        __syncthreads();
        {
            unsigned iw[8], kw[8];
#pragma unroll
            for (int e = 0; e < 8; ++e) {
                iw[e] = (unsigned)IB[(tq * 16 + 2 * e) * 136 + cc] | ((unsigned)IB[(tq * 16 + 2 * e + 1) * 136 + cc] << 16);
                kw[e] = (unsigned)KB[(tq * 16 + 2 * e) * 136 + cc] | ((unsigned)KB[(tq * 16 + 2 * e + 1) * 136 + cc] << 16); }
            bf16_t* ir = p.H + (r0 + (cc >> 1)) * LDC_H + 2048 + h * 128 + (cc & 1) * 64 + tq * 16;
            if (!dry) { *(u32x4*)ir = (u32x4){iw[0], iw[1], iw[2], iw[3]}; *(u32x4*)(ir + 8) = (u32x4){iw[4], iw[5], iw[6], iw[7]}; }
            bf16_t* kr = xtra + (r0 + (cc >> 1)) * DM + h * 128 + (cc & 1) * 64 + tq * 16;
            *(u32x4*)kr = (u32x4){kw[0], kw[1], kw[2], kw[3]}; *(u32x4*)(kr + 8) = (u32x4){kw[4], kw[5], kw[6], kw[7]};
        }
        __syncthreads();
    }
}

struct HgSet { u32x4 r[7]; };
__device__ __forceinline__ void hg_issue(HgSet& R, const bf16_t* H, const bf16_t* xtra, const float* gsc, int b, int ch, int h, int vs, int tid) {
    const size_t r0 = (size_t)b * SEQ + (size_t)ch * 64;
    const int row = tid >> 4, wi = tid & 15;
#pragma unroll
    for (int j = 0; j < 2; ++j) { const int t = j * 32 + row; R.r[j] = *(const u32x4*)(H + (r0 + t) * LDC_H + h * 128 + wi * 8); R.r[2 + j] = *(const u32x4*)(H + (r0 + t) * LDC_H + 1024 + h * 128 + wi * 8); }
#pragma unroll
    for (int j = 0; j < 2; ++j) { const int kp = j * 32 + row; R.r[4 + j] = *(const u32x4*)(xtra + (r0 + kp) * DM + h * 128 + wi * 8); }
    const u32x4 z4 = {0u, 0u, 0u, 0u}; R.r[6] = z4;
    if (tid < 256) R.r[6] = *(const u32x4*)(H + (r0 + vs * 16 + row) * LDC_H + 2048 + h * 128 + wi * 8);
    else if (tid < 320) R.r[6] = *(const u32x4*)(gsc + (size_t)(((b * 64 + ch) * 8 + h)) * 256 + (tid - 256) * 4);
}
constexpr int HG_QM = 0, HG_KM = 16 * 65 * 16, HG_KT = 2 * 16 * 65 * 16, HG_IT = HG_KT + 8 * 129 * 16, HG_E = HG_IT + 8 * 33 * 16, HG_BUF = HG_E + 1024;
__device__ __forceinline__ void hg_stage(const HgSet& R, unsigned char* B, int tid) {
    const int row = tid >> 4, wi = tid & 15;
#pragma unroll
    for (int j = 0; j < 2; ++j) { const int t = j * 32 + row; *(u32x4*)(B + HG_QM + (wi * 65 + t) * 16) = R.r[j]; *(u32x4*)(B + HG_KM + (wi * 65 + t) * 16) = R.r[2 + j]; }
#pragma unroll
    for (int j = 0; j < 2; ++j) { const int k = (j * 32 + row) * 2 + (wi >> 3), sc = wi & 7; *(u32x4*)(B + HG_KT + (sc * 129 + k) * 16) = R.r[4 + j]; }
    if (tid < 256) { const int vv = row * 2 + (wi >> 3), sc = wi & 7; *(u32x4*)(B + HG_IT + (sc * 33 + vv) * 16) = R.r[6]; }
    else if (tid < 320) *(u32x4*)(B + HG_E + (tid - 256) * 16) = R.r[6];
}

__device__ void phase_hgrn_seq(int l, unsigned char* smem, bool dry) {
    const Params p = load_params();
    unsigned char* img = smem;
    bf16_t* att = (bf16_t*)(smem + 2 * HG_BUF);
    bf16_t* STs = att + 64 * 72;
    const int tid = opaque_tid(), w = __builtin_amdgcn_readfirstlane(tid >> 6), lane = tid & 63, fr = lane & 15, fq = lane >> 4;
    const bf16_t* xtra = (l == 0) ? (const bf16_t*)p.out : p.vf;
    const int tt_ = w >> 1, sp = w & 1;
    for (int item = blockIdx.x; item < NB * 32; item += gridDim.x) {
        const int xc_ = item & 7, sl_ = item >> 3, vs = sl_ & 3, gi_ = (sl_ >> 2) * 8 + xc_, h = gi_ & 7, b = gi_ >> 3;
        __syncthreads();
        for (int e = tid; e < 32 * 136 / 2; e += 512) ((unsigned*)STs)[e] = 0u;
        f32x4 S[2] = {{0.f, 0.f, 0.f, 0.f}, {0.f, 0.f, 0.f, 0.f}};
        u32x2 o0 = {0u, 0u};
        HgSet R0, R1;
        hg_issue(R0, p.H, xtra, p.rkbuf, b, 0, h, vs, tid); hg_stage(R0, img, tid);
        hg_issue(R1, p.H, xtra, p.rkbuf, b, 1, h, vs, tid); hg_issue(R0, p.H, xtra, p.rkbuf, b, 2, h, vs, tid);
        __syncthreads();
        auto iter = [&](const int ch, HgSet& RS) {
            const size_t r0 = (size_t)b * SEQ + (size_t)ch * 64;
            const unsigned char* B = img + (ch & 1) * HG_BUF; unsigned char* Bn = img + ((ch + 1) & 1) * HG_BUF;
            bf16x8 qf[4];
#pragma unroll
            for (int ks = 0; ks < 4; ++ks) qf[ks] = *(const bf16x8*)(B + HG_QM + ((ks * 4 + fq) * 65 + tt_ * 16 + fr) * 16);
#pragma unroll
            for (int q = 0; q < 2; ++q) { const int stile = sp * 2 + q; f32x4 a = {0.f, 0.f, 0.f, 0.f};
                if (stile <= tt_) {
#pragma unroll
                    for (int ks = 0; ks < 4; ++ks) { const bf16x8 kf = *(const bf16x8*)(B + HG_KM + ((ks * 4 + fq) * 65 + stile * 16 + fr) * 16); a = __builtin_amdgcn_mfma_f32_16x16x32_bf16(qf[ks], kf, a, 0, 0, 0); } }
#pragma unroll
                for (int j = 0; j < 4; ++j) { const int t = tt_ * 16 + fq * 4 + j, s = stile * 16 + fr; att[t * 72 + s] = f2bf(s <= t ? a[j] : 0.f); } }
            if (ch + 1 < 64) hg_stage(RS, Bn, tid);
            if (ch + 3 < 64) hg_issue(RS, p.H, xtra, p.rkbuf, b, ch + 3, h, vs, tid);
            __syncthreads();
            f32x4 o = {0.f, 0.f, 0.f, 0.f};
#pragma unroll
            for (int ks = 0; ks < 2; ++ks) { const bf16x8 af = *(const bf16x8*)(att + (tt_ * 16 + fr) * 72 + ks * 32 + fq * 8); const bf16x8 itf = *(const bf16x8*)(B + HG_IT + ((ks * 4 + fq) * 33 + sp * 16 + fr) * 16);
                o = __builtin_amdgcn_mfma_f32_16x16x32_bf16(itf, af, o, 0, 0, 0); }
#pragma unroll
            for (int ks = 0; ks < 4; ++ks) { const bf16x8 sf = *(const bf16x8*)(STs + (sp * 16 + fr) * 136 + ks * 32 + fq * 8);
                o = __builtin_amdgcn_mfma_f32_16x16x32_bf16(sf, qf[ks], o, 0, 0, 0); }
            { u32x2 ow; ow.x = cvt_pk_bf16(o[0], o[1]); ow.y = cvt_pk_bf16(o[2], o[3]);
              if (ch == 0) o0 = ow;
              else if (!dry) { const int t = tt_ * 16 + fr; *(u32x2*)(p.H + (r0 - 64 + vs * 16 + (t >> 2)) * LDC_H + 2048 + h * 128 + (t & 3) * 32 + sp * 16 + fq * 4) = ow; } }
            const f32x4 e1 = *(const f32x4*)(B + HG_E + (w * 16 + fq * 4) * 4), e3 = *(const f32x4*)(B + HG_E + 512 + (w * 16 + fq * 4) * 4);
            bf16x8 ktf[2];
#pragma unroll
            for (int ks = 0; ks < 2; ++ks) ktf[ks] = *(const bf16x8*)(B + HG_KT + ((ks * 4 + fq) * 129 + w * 16 + fr) * 16);
#pragma unroll
            for (int vt = 0; vt < 2; ++vt) { f32x4 u = {0.f, 0.f, 0.f, 0.f};
#pragma unroll
                for (int ks = 0; ks < 2; ++ks) { const bf16x8 itf = *(const bf16x8*)(B + HG_IT + ((ks * 4 + fq) * 33 + vt * 16 + fr) * 16); u = __builtin_amdgcn_mfma_f32_16x16x32_bf16(ktf[ks], itf, u, 0, 0, 0); }
#pragma unroll
                for (int j = 0; j < 4; ++j) S[vt][j] = e3[j] * (e1[j] * S[vt][j] + u[j]); }
            __syncthreads();
            if (ch + 1 < 64) { const f32x4 e1n = *(const f32x4*)(Bn + HG_E + (w * 16 + fq * 4) * 4);
#pragma unroll
                for (int vt = 0; vt < 2; ++vt) { u32x2 sw; sw.x = cvt_pk_bf16(S[vt][0] * e1n[0], S[vt][1] * e1n[1]); sw.y = cvt_pk_bf16(S[vt][2] * e1n[2], S[vt][3] * e1n[3]);
                    *(u32x2*)(STs + (vt * 16 + fr) * 136 + w * 16 + fq * 4) = sw; } }
        };
        for (int ch = 0; ch < 64; ch += 2) { iter(ch, R1); iter(ch + 1, R0); }
        if (!dry) { const int t = tt_ * 16 + fr; *(u32x2*)(p.H + ((size_t)b * SEQ + 63 * 64 + vs * 16 + (t >> 2)) * LDC_H + 2048 + h * 128 + (t & 3) * 32 + sp * 16 + fq * 4) = o0; }
    }
    __syncthreads();
}

__device__ void phase_hgrn_post(int l) {
    const Params p = load_params();
    const int tid = opaque_tid(), l8 = tid & 7;
    const int ngrp = T_TOK * 8;
    for (int g = blockIdx.x * 64 + (tid >> 3); g < ngrp; g += gridDim.x * 64) {
        const int tok = g >> 3, h = g & 7, b = tok / SEQ, tin = tok % SEQ, ch = tin >> 6, t = tin & 63, slot = (ch + 63) & 63, vs = l8 >> 1, vv0 = (l8 & 1) * 16;
        const bf16_t* op = p.H + ((size_t)b * SEQ + slot * 64 + vs * 16 + (t >> 2)) * LDC_H + 2048 + h * 128 + (t & 3) * 32 + vv0;
        bf16_t* zp = p.H + (size_t)tok * LDC_H + 3072 + h * 128 + l8 * 16;
        const u32x4 a0 = *(const u32x4*)op, a1 = *(const u32x4*)(op + 8), z0 = *(const u32x4*)zp, z1 = *(const u32x4*)(zp + 8);
        const float ov[16] = {bflo(a0.x), bfhi(a0.x), bflo(a0.y), bfhi(a0.y), bflo(a0.z), bfhi(a0.z), bflo(a0.w), bfhi(a0.w), bflo(a1.x), bfhi(a1.x), bflo(a1.y), bfhi(a1.y), bflo(a1.z), bfhi(a1.z), bflo(a1.w), bfhi(a1.w)};
        const float zf[16] = {bflo(z0.x), bfhi(z0.x), bflo(z0.y), bfhi(z0.y), bflo(z0.z), bfhi(z0.z), bflo(z0.w), bfhi(z0.w), bflo(z1.x), bfhi(z1.x), bflo(z1.y), bfhi(z1.y), bflo(z1.z), bfhi(z1.z), bflo(z1.w), bfhi(z1.w)};
        float ss = 0.f;
#pragma unroll
        for (int e = 0; e < 16; ++e) ss += ov[e] * ov[e];
        ss = red8(ss); const float rinv = rsqrtf(ss * (1.0f / 128.f) + EPS);
        const float* gn = p.hgrn_g + (size_t)l * DM + h * 128 + l8 * 16;
        float r[16];
#pragma unroll
        for (int e = 0; e < 16; ++e) r[e] = ov[e] * rinv * gn[e] * siluf_(zf[e]);
        u32x4 w0, w1; w0.x = cvt_pk_bf16(r[0], r[1]); w0.y = cvt_pk_bf16(r[2], r[3]); w0.z = cvt_pk_bf16(r[4], r[5]); w0.w = cvt_pk_bf16(r[6], r[7]);
        w1.x = cvt_pk_bf16(r[8], r[9]); w1.y = cvt_pk_bf16(r[10], r[11]); w1.z = cvt_pk_bf16(r[12], r[13]); w1.w = cvt_pk_bf16(r[14], r[15]);
        *(u32x4*)zp = w0; *(u32x4*)(zp + 8) = w1;
    }
}


#define XB_TMO      128
#define XB_XCNT(j)  (256  + 64 * (j))
#define XB_XSUB(j)  (1280 + 64 * (j))
#define XB_XGEN(j)  (2304 + 64 * (j))
#define XB_TOP      3328
#define XB_TOPGEN   3392
#define XCD_BAR_WORDS 3456
#define XB_SPIN_CAP (1u << 18)
__device__ __forceinline__ unsigned xb_ld(unsigned* p)              { return __hip_atomic_load(p, __ATOMIC_RELAXED, __HIP_MEMORY_SCOPE_AGENT); }
__device__ __forceinline__ unsigned xb_add(unsigned* p, unsigned v) { return __hip_atomic_fetch_add(p, v, __ATOMIC_RELAXED, __HIP_MEMORY_SCOPE_AGENT); }
__device__ __forceinline__ unsigned xb_xcc_id() { return (unsigned)__builtin_amdgcn_s_getreg((3 << 11) | 20) & 0xFu; }
#define XB_SPIN(cond, bar) do { unsigned _sp = 0; while (cond) { __builtin_amdgcn_s_sleep(1); \
    if ((++_sp & 255u) == 0u) { if (xb_ld(&(bar)[XB_TMO])) break; if (_sp > XB_SPIN_CAP) { atomicAdd(&(bar)[XB_TMO], 1u); break; } } } } while (0)
struct XcdBarrier { unsigned* bar; unsigned x; volatile LAS unsigned* st; };
__device__ __forceinline__ XcdBarrier xcd_barrier_post(unsigned* bar, volatile LAS unsigned* st) {
    XcdBarrier b; b.bar = bar; b.x = xb_xcc_id(); b.st = st;
    if (threadIdx.x == 0) (void)xb_add(&bar[XB_XCNT(b.x)], 1u);
    return b;
}
__device__ __forceinline__ void xcd_barrier_complete(unsigned* bar, unsigned x, unsigned& nloc, unsigned& nx) {
    const unsigned G = gridDim.x * gridDim.y * gridDim.z;
    unsigned sum, cnt, mine, sp = 0u;
    for (;;) {
        sum = 0u; cnt = 0u; mine = 0u;
#pragma unroll
        for (unsigned j = 0; j < 16; ++j) { const unsigned c = xb_ld(&bar[XB_XCNT(j)]); sum += c; cnt += (c > 0u) ? 1u : 0u; mine = (j == x) ? c : mine; }
        if (sum == G) break;
        __builtin_amdgcn_s_sleep(1);
        if ((++sp & 255u) == 0u) { if (xb_ld(&bar[XB_TMO])) break; if (sp > XB_SPIN_CAP) { atomicAdd(&bar[XB_TMO], 1u); break; } }
    }
    nloc = mine > 0u ? mine : 1u; nx = cnt > 0u ? cnt : 1u;
}
__device__ __forceinline__ void xcd_barrier(const XcdBarrier& b) {
    asm volatile("s_waitcnt vmcnt(0)" ::: "memory");
    __syncthreads();
    if (threadIdx.x == 0) {
        unsigned* bar = b.bar;
        __builtin_amdgcn_s_waitcnt(0);
        unsigned nloc = b.st[0], nx = b.st[1];
        if (nloc == 0u) { xcd_barrier_complete(bar, b.x, nloc, nx); b.st[0] = nloc; b.st[1] = nx; }
        const unsigned old = xb_add(&bar[XB_XSUB(b.x)], 1u);
        const unsigned gen = old / nloc;
        if (old + 1u == (gen + 1u) * nloc) {
            __builtin_amdgcn_fence(__ATOMIC_RELEASE, "agent");
            asm volatile("s_waitcnt vmcnt(0)" ::: "memory");
            const unsigned og = xb_add(&bar[XB_TOP], 1u);
            const unsigned tg = og / nx;
            if (og + 1u == (tg + 1u) * nx) xb_add(&bar[XB_TOPGEN], 1u);
            else XB_SPIN(xb_ld(&bar[XB_TOPGEN]) == tg, bar);
            __builtin_amdgcn_fence(__ATOMIC_ACQUIRE, "agent");
            xb_add(&bar[XB_XGEN(b.x)], 1u);
            asm volatile("s_waitcnt vmcnt(0)" ::: "memory");
        } else {
            XB_SPIN(xb_ld(&bar[XB_XGEN(b.x)]) == gen, bar);
            __builtin_amdgcn_fence(__ATOMIC_ACQUIRE, "agent");
            asm volatile("s_waitcnt vmcnt(0)" ::: "memory");
        }
    }
    __syncthreads();
}

constexpr int PH_PER_LAYER = 14, N_PHASES = 2 * PH_PER_LAYER + 1;

__global__ void __launch_bounds__(512, 2) fwd_megakernel(Params pk) {
    extern __shared__ __attribute__((aligned(16))) unsigned char shm[];
    LAS unsigned char* lds = (LAS unsigned char*)shm;
    cg::grid_group grid = cg::this_grid();
    const int phase_lo = pk.phase_lo, phase_hi = pk.phase_hi;
    volatile LAS unsigned* xst = (volatile LAS unsigned*)(lds + LDS_BYTES - 16);
    XcdBarrier xb; xb.bar = pk.bar; xb.x = 0; xb.st = xst;
    if (phase_hi - phase_lo > 1) { if (threadIdx.x == 0) { xst[0] = 0u; xst[1] = 0u; } __syncthreads(); xb = xcd_barrier_post(pk.bar, xst); }
    for (int ph = phase_lo; ph < phase_hi; ++ph) {
        const int l = ph / PH_PER_LAYER, q = ph % PH_PER_LAYER;
        if (ph == N_PHASES - 1) {
            const Params p = load_params();
            phase_rmsnorm(p.out, p.final_g, nullptr, p.out);
        } else if (q == 0) {
            { const int nrep = (PROBE_Q == 0 && l == 0) ? 2 : 1; for (int rep = 0; rep < nrep; ++rep) {
            phase_convert(l, shm);
            const Params p = load_params();
            phase_rmsnorm(l == 0 ? p.x : p.out, p.norm_g + (size_t)l * DM, p.xn, nullptr); } }
        } else if (q == 1 || q == 5 || q == 8) {
            const Params p = load_params(); const int G = gridDim.x, cidx = opaque_bid();
            const int N = (q == 1) ? LDA_H : (q == 5) ? LDB_H : LDC_H; const int r0 = (q == 1) ? 0 : (q == 5) ? LDA_H : (LDA_H + LDB_H);
            pg8::GemmDesc g; g.A = p.xn; g.Bt = p.Wt + (size_t)r0 * DM; g.lda = DM;
            pg8::Sched S; S.init(T_TOK, N, G, cidx, 1);
            pg8::EpiStore E; E.O = p.H; E.ldc = N;
{ const int nrep = ((PROBE_Q == 1 && l == 0 && q == 1) || (PROBE_Q == 50 && l == 0 && q == 5) || (PROBE_Q == 80 && l == 0 && q == 8)) ? 2 : 1; for (int rep = 0; rep < nrep; ++rep) pg8::gemm_phase(lds, g, g, S, E); }
        } else if (q == 2) {
{ const int nrep = (PROBE_Q == 2 && l == 0) ? 2 : 1; for (int rep = 0; rep < nrep; ++rep) phase_rwkv(l, shm, rep + 1 < nrep ? PROBE_MODE : 0); }
        } else if (q == 3) {
            phase_rwkv_post(l, nullptr);
        } else if (q == 6) {
{ const int nrep = (PROBE_Q == 6 && l == 0) ? 2 : 1; for (int rep = 0; rep < nrep; ++rep) { const Params p = load_params(); phase_sgu(l, shm, rep + 1 < nrep ? (bf16_t*)p.out : nullptr); } }
        } else if (q == 9) {
            { const int nrep = (PROBE_Q == 9 && l == 0) ? 2 : 1; for (int rep = 0; rep < nrep; ++rep) phase_hgrn_pre(l, shm, rep + 1 < nrep); }
        } else if (q == 10) {
            { const int nrep = (PROBE_Q == 10 && l == 0) ? 2 : 1; for (int rep = 0; rep < nrep; ++rep) phase_hgrn_seq(l, shm, rep + 1 < nrep); }
        } else if (q == 11) {
            phase_hgrn_post(l);
        } else if (q == 4 || q == 7 || q == 12) {
            const Params p = load_params(); const int G = gridDim.x, cidx = opaque_bid();
            bf16_t* WtBr = p.Wt + (size_t)WT_ROWS * DM;
            const int n = (q == 4) ? 0 : (q == 7) ? 1 : 2; const int ldh = (n == 0) ? LDA_H : (n == 1) ? LDB_H : LDC_H; const int ocol = (n == 0) ? 3200 : (n == 1) ? 2048 : 3072;
            pg8::GemmDesc g0, g1; g0.A = p.xn; g0.Bt = p.Wt + (size_t)(LDA_H + LDB_H + LDC_H + n * DM) * DM; g0.lda = DM;
            g1.A = p.H + ocol; g1.Bt = WtBr + (size_t)n * DM * DM; g1.lda = ldh;
            pg8::Sched S; S.init(T_TOK, DM, G, cidx, 2);
            pg8::EpiMerge E; E.G = p.H; E.ldg = ldh; E.bias = p.b_merge + ((size_t)l * 3 + n) * DM; E.Y = p.y; E.accum = (n > 0);
            { const int nrep = (PROBE_Q == 4 && l == 0 && q == 4) ? 2 : 1; for (int rep = 0; rep < nrep; ++rep) pg8::gemm_phase(lds, g0, g1, S, E); }
        } else {
            const Params p = load_params(); const int G = gridDim.x, cidx = opaque_bid();
            bf16_t* WtOut = p.Wt + (size_t)WT_ROWS * DM + (size_t)3 * DM * DM;
            pg8::GemmDesc g; g.A = p.y; g.Bt = WtOut; g.lda = DM;
            pg8::Sched S; S.init(T_TOK, DM, G, cidx, 1);
            pg8::EpiResid E; E.Xin = (l == 0) ? p.x : p.out; E.Xout = p.out;
            { const int nrep = (PROBE_Q == 13 && l == 0) ? 2 : 1; for (int rep = 0; rep < nrep; ++rep) pg8::gemm_phase(lds, g, g, S, E); }
        }
        if (ph + 1 < phase_hi) { if (ph == phase_lo) grid.sync(); else xcd_barrier(xb); }
    }
}

extern "C" void kernel_launch(void* const* d_in, const int* in_sizes, int n_in, void* d_out, int out_size, void* d_ws, size_t ws_size, hipStream_t stream) {
    static int grid_blocks = 0;
    if (!grid_blocks) {
        int dev = 0, cus = 0, per_cu = 0;
        hipGetDevice(&dev);
        hipDeviceGetAttribute(&cus, hipDeviceAttributeMultiprocessorCount, dev);
        if (hipFuncSetAttribute((const void*)fwd_megakernel, hipFuncAttributeMaxDynamicSharedMemorySize, LDS_BYTES) != hipSuccess) { fprintf(stderr, "hipFuncSetAttribute failed\n"); return; }
        hipOccupancyMaxActiveBlocksPerMultiprocessor(&per_cu, (const void*)fwd_megakernel, 512, LDS_BYTES);
        if (per_cu < 1) { fprintf(stderr, "occupancy query says 0 blocks per CU\n"); return; }
        grid_blocks = cus * 1;
    }
    Params p{};
    const float** fp = (const float**)&p;
    for (int i = 0; i < 26; ++i) fp[i] = (const float*)d_in[i];
    p.out = (float*)d_out;
    unsigned char* ws = (unsigned char*)d_ws; size_t off = 0;
    auto take = [&](size_t bytes) { unsigned char* r = ws + off; off += (bytes + 255) & ~(size_t)255; return r; };
    p.Wt = (bf16_t*)take(((size_t)WT_ROWS * DM + 4 * (size_t)DM * DM) * 2);
    p.xn = (bf16_t*)take((size_t)T_TOK * DM * 2);
    p.vf = (bf16_t*)take((size_t)T_TOK * DM * 2);
    p.y = (bf16_t*)take((size_t)T_TOK * DM * 2);
    p.H = (bf16_t*)take((size_t)T_TOK * LDA_H * 2);
    p.rkbuf = (float*)take((size_t)T_TOK * 16 * 2 * 4);
    p.bar = (unsigned*)take((size_t)XCD_BAR_WORDS * 4);
    if (off > ws_size) { fprintf(stderr, "workspace too small: need %zu have %zu\n", off, ws_size); return; }
#if SINGLE_LAUNCH
    p.phase_lo = 0; p.phase_hi = N_PHASES;
    void* args[] = {&p};
    if (hipMemsetAsync(p.bar, 0, (size_t)XCD_BAR_WORDS * 4, stream) != hipSuccess) { fprintf(stderr, "memset failed\n"); return; }
    hipError_t e = hipLaunchCooperativeKernel((const void*)fwd_megakernel, dim3(grid_blocks), dim3(512), args, LDS_BYTES, stream);
    if (e != hipSuccess) fprintf(stderr, "cooperative launch failed: %s (grid %d)\n", hipGetErrorString(e), grid_blocks);
#else
    for (int ph = 0; ph < N_PHASES; ++ph) {
        p.phase_lo = ph; p.phase_hi = ph + 1;
        hipLaunchKernelGGL(fwd_megakernel, dim3(grid_blocks), dim3(512), LDS_BYTES, stream, p);
    }
#endif
}
```

```cpp
#include <hip/hip_runtime.h>
#include <hip/hip_cooperative_groups.h>
#include <cstdio>
namespace cg = cooperative_groups;

#ifndef PROBE_MODE
#define PROBE_MODE 0
#endif
#ifndef PROBE_Q
#define PROBE_Q -1
#endif
#ifndef SINGLE_LAUNCH
#define SINGLE_LAUNCH 1
#endif

typedef unsigned short bf16_t;
typedef short bf16x8 __attribute__((ext_vector_type(8)));
typedef float f32x4 __attribute__((ext_vector_type(4)));
typedef float f32x2 __attribute__((ext_vector_type(2)));
typedef unsigned u32x4 __attribute__((ext_vector_type(4)));
typedef unsigned u32x2 __attribute__((ext_vector_type(2)));
#define LAS __attribute__((address_space(3)))

constexpr int T_TOK = 32768, DM = 1024, SEQ = 4096, NB = 8;
constexpr int N_IN = 14464;
constexpr int LDA_H = 4352, LDB_H = 3072, LDC_H = 4096;
constexpr int WT_ROWS = 14592;
constexpr int LDS_BYTES = 163840;
constexpr float EPS = 1e-6f, GN_EPS = 64e-5f;

struct Params {
    const float *x, *norm_g, *w_in, *b_merge, *mu, *w0, *w_w2, *a0, *a_w2, *v0, *v_w1, *v_w2, *k_k, *k_a, *r_k, *lnx_g, *lnx_b,
        *sgu_ln_g, *sgu_ln_b, *sgu_w, *sgu_b, *lb_logits, *hgrn_g, *w_branch, *w_out, *final_g;
    float* out;
    bf16_t *Wt, *xn, *vf, *y, *H;
    float* rkbuf;
    unsigned* bar;
    int phase_lo, phase_hi;
};

__device__ __forceinline__ float bf2f(bf16_t h) { return __uint_as_float(((unsigned)h) << 16); }
__device__ __forceinline__ float bflo(unsigned u) { return __uint_as_float(u << 16); }
__device__ __forceinline__ float bfhi(unsigned u) { return __uint_as_float(u & 0xffff0000u); }
typedef __bf16 bf16x2_t __attribute__((ext_vector_type(2)));
__device__ __forceinline__ unsigned cvt_pk_bf16(float lo, float hi) { const f32x2 v = {lo, hi}; const bf16x2_t r = __builtin_convertvector(v, bf16x2_t); return __builtin_bit_cast(unsigned, r); }
__device__ __forceinline__ bf16_t f2bf(float f) { return (bf16_t)(cvt_pk_bf16(f, 0.f) & 0xffffu); }
__device__ __forceinline__ float sigmoidf_(float x) { return __builtin_amdgcn_rcpf(1.0f + __expf(-x)); }
__device__ __forceinline__ float siluf_(float x) { return x * __builtin_amdgcn_rcpf(1.0f + __expf(-x)); }
__device__ __forceinline__ float tanh_fast(float x) { return 1.0f - 2.0f * __builtin_amdgcn_rcpf(1.0f + __expf(2.0f * x)); }

__device__ __forceinline__ Params load_params() {
#if defined(__HIP_DEVICE_COMPILE__)
    typedef const Params __attribute__((address_space(4)))* KP;
    KP kp = (KP)__builtin_amdgcn_kernarg_segment_ptr(); asm volatile("" : "+s"(kp)); return *kp;
#else
    return Params{};
#endif
}
__device__ __forceinline__ int opaque_tid() { int t = threadIdx.x; asm volatile("" : "+v"(t)); return t; }
__device__ __forceinline__ int opaque_bid() { int t = blockIdx.x; asm volatile("" : "+s"(t)); return t; }

namespace pg8 {
constexpr int BM = 256, BK = 64, HALF = 128, HTB = HALF * BK * 2, STAGE_BYTES = 8 * HTB, NXCD = 8, WGM = 8, KD = 1024;
__device__ __forceinline__ int lds_byte(int r, int c) { const int st = (r >> 4) * 2 + (c >> 5), rr = r & 15, cc = c & 31, ob = rr * 64 + cc * 2; return st * 1024 + (ob ^ (((ob >> 9) & 1) << 5)); }
__device__ __forceinline__ void stage_rc(int b, int& R, int& C) { const int st = b / 1024, sb = b % 1024, swz = sb ^ (((sb >> 9) & 1) << 5); R = (st >> 1) * 16 + swz / 64; C = (st & 1) * 32 + (swz % 64) / 2; }
__device__ __forceinline__ int perm32(int rho) { const int n = rho >> 4, i = rho & 15; return 8 * (i >> 2) + 4 * n + (i & 3); }

struct Unit { int pm, pn, sel; };
struct GemmDesc { const bf16_t* A; const bf16_t* Bt; int lda; };
struct Sched {
    int nM, nN, nwg, G, c, nsel;
    __device__ void init(int M, int N, int G_, int c_, int nsel_) { nM = M / BM; nN = N / BM; nwg = nM * nN; G = G_; c = c_; nsel = nsel_; }
    __device__ bool next(int i, Unit& u) const {
        const int ti = (nsel == 2) ? (i >> 1) : i; u.sel = (nsel == 2) ? (i & 1) : 0;
        const long L = (long)ti * G + c; if (L >= nwg) return false;
        int wgid = (int)L; { const int q = nwg / NXCD, r = nwg % NXCD, xcd = wgid % NXCD, off = wgid / NXCD; wgid = (xcd < r ? xcd * (q + 1) : r * (q + 1) + (xcd - r) * q) + off; }
        const int nig = WGM * nN, gid = wgid / nig, fm = gid * WGM, gsz = (nM - fm) < WGM ? (nM - fm) : WGM;
        u.pm = fm + ((wgid % nig) % gsz); u.pn = (wgid % nig) / gsz; return true;
    }
};

template <class Epi>
__device__ __forceinline__ void gemm_phase(LAS unsigned char* lds, const GemmDesc g0, const GemmDesc g1, const Sched& S, const Epi& E) {
    const int tid = opaque_tid(), wid = __builtin_amdgcn_readfirstlane(tid >> 6), lane = tid & 63, wr = wid >> 2, wc = wid & 3, fr = lane & 15, fq = lane >> 4;
    constexpr int K = KD, nt = K / BK;
    unsigned voffA0[2], voffA1[2], voffB[2];
#pragma unroll
    for (int i = 0; i < 2; ++i) { int R, C; stage_rc(tid * 16 + i * 8192, R, C); const int Rb = Epi::PERM ? ((R & ~31) + perm32(R & 31)) : R;
        voffA0[i] = (unsigned)(R * g0.lda + C) * 2u; voffA1[i] = (unsigned)(R * g1.lda + C) * 2u; voffB[i] = (unsigned)(Rb * K + C) * 2u; }
    const size_t kstep = (size_t)(BK * 2);
    const size_t hstepB = (size_t)HALF * K * 2;
    const unsigned ldsw = (unsigned)wid * 1024u;
    const int aoff = lds_byte(wr * 64 + fr, fq * 8), boff = lds_byte(wc * 32 + fr, fq * 8);
#define PG8_SA(b, h) (((b) * 2 + (h)) * HTB)
#define PG8_SB(b, h) ((4 + (b) * 2 + (h)) * HTB)
#define PG8_STAGE(bufoff, gbase, v0, v1) do { \
        __builtin_amdgcn_global_load_lds((const unsigned*)((const char*)(gbase) + (v0)), (LAS unsigned*)(lds + (bufoff) + ldsw), 16, 0, 0); \
        __builtin_amdgcn_global_load_lds((const unsigned*)((const char*)(gbase) + (v1)), (LAS unsigned*)(lds + (bufoff) + ldsw + 8192), 16, 0, 0); } while (0)
#define PG8_STAGEB(bufoff, gbase) PG8_STAGE(bufoff, gbase, voffB[0], voffB[1])
#define PG8_LDA(dst, b, h) do { _Pragma("unroll") for (int m = 0; m < 4; ++m) _Pragma("unroll") for (int k = 0; k < 2; ++k) dst[m][k] = *(const LAS bf16x8*)(lds + PG8_SA(b, h) + aoff + m * 2048 + k * 1024); } while (0)
#define PG8_LDB(dst, b, h) do { _Pragma("unroll") for (int n = 0; n < 2; ++n) _Pragma("unroll") for (int k = 0; k < 2; ++k) dst[n][k] = *(const LAS bf16x8*)(lds + PG8_SB(b, h) + boff + n * 2048 + k * 1024); } while (0)
#define PG8_MMA(ai, bj, At, Bt) do { __builtin_amdgcn_s_setprio(1); _Pragma("unroll") for (int m = 0; m < 4; ++m) _Pragma("unroll") for (int n = 0; n < 2; ++n) _Pragma("unroll") for (int k = 0; k < 2; ++k) \
        acc[ai][bj][m][n] = __builtin_amdgcn_mfma_f32_16x16x32_bf16(Bt[n][k], At[m][k], acc[ai][bj][m][n], 0, 0, 0); __builtin_amdgcn_s_setprio(0); } while (0)
#define PG8_WAIT_V(n) asm volatile("s_waitcnt vmcnt(" #n ")" ::: "memory")
#define PG8_WAIT_L(n) asm volatile("s_waitcnt lgkmcnt(" #n ")" ::: "memory")
#define PG8_BAR __builtin_amdgcn_s_barrier()
#define PG8_SCHED __builtin_amdgcn_sched_barrier(0)
    Unit cur, nxt; int ui = 0;
    if (!S.next(0, cur)) return;
    f32x4 acc[2][2][4][2];
#pragma unroll
    for (int a = 0; a < 2; ++a)
#pragma unroll
        for (int b = 0; b < 2; ++b)
#pragma unroll
            for (int m = 0; m < 4; ++m)
#pragma unroll
                for (int n = 0; n < 2; ++n) acc[a][b][m][n] = (f32x4){0.f, 0.f, 0.f, 0.f};
    bf16x8 At[4][2], B0[2][2], B1[2][2];
    const char* cA = (const char*)(cur.sel ? g1.A : g0.A) + (size_t)cur.pm * 256 * (size_t)(cur.sel ? g1.lda : g0.lda) * 2;
    const char* cB = (const char*)(cur.sel ? g1.Bt : g0.Bt) + (size_t)cur.pn * 256 * K * 2;
    size_t chA = (size_t)HALF * (cur.sel ? g1.lda : g0.lda) * 2;
    unsigned cv0 = cur.sel ? voffA1[0] : voffA0[0], cv1 = cur.sel ? voffA1[1] : voffA0[1];
    PG8_STAGEB(PG8_SB(0, 0), cB); PG8_STAGEB(PG8_SB(0, 1), cB + hstepB); PG8_STAGE(PG8_SA(0, 0), cA, cv0, cv1); PG8_STAGE(PG8_SA(0, 1), cA + chA, cv0, cv1);
    if (wr == 1) PG8_BAR;
    PG8_WAIT_V(2); PG8_BAR;
    PG8_STAGEB(PG8_SB(1, 0), cB + kstep); PG8_STAGE(PG8_SA(1, 0), cA + kstep, cv0, cv1); PG8_STAGEB(PG8_SB(1, 1), cB + hstepB + kstep);
    PG8_WAIT_V(6); PG8_BAR;
    for (;;) {
        const bool has_next = S.next(ui + 1, nxt);
        const int nsel = has_next ? nxt.sel : cur.sel;
        const char* nA = has_next ? (const char*)(nsel ? g1.A : g0.A) + (size_t)nxt.pm * 256 * (size_t)(nsel ? g1.lda : g0.lda) * 2 : cA;
        const char* nB = has_next ? (const char*)(nsel ? g1.Bt : g0.Bt) + (size_t)nxt.pn * 256 * K * 2 : cB;
        const size_t nhA = (size_t)HALF * (nsel ? g1.lda : g0.lda) * 2;
        const unsigned nv0 = nsel ? voffA1[0] : voffA0[0], nv1 = nsel ? voffA1[1] : voffA0[1];
        for (int t = 0; t < nt; t += 2) {
            const bool last = (t == nt - 2);
            const char* a1 = cA + (size_t)(t + 1) * kstep;
            const char* a2 = last ? nA : cA + (size_t)(t + 2) * kstep; const char* b2 = last ? nB : cB + (size_t)(t + 2) * kstep;
            const char* a3 = a2 + kstep; const char* b3 = b2 + kstep;
            const size_t h2 = last ? nhA : chA; const unsigned w0 = last ? nv0 : cv0, w1 = last ? nv1 : cv1;
            PG8_LDB(B0, 0, 0); PG8_LDB(B1, 0, 1); PG8_SCHED; PG8_LDA(At, 0, 0); PG8_STAGE(PG8_SA(1, 1), a1 + chA, cv0, cv1);
            PG8_WAIT_V(8); PG8_WAIT_L(0); PG8_BAR; PG8_MMA(0, 0, At, B0); PG8_MMA(0, 1, At, B1); PG8_BAR; PG8_SCHED;
            PG8_LDA(At, 0, 1); PG8_STAGEB(PG8_SB(0, 0), b2); PG8_STAGEB(PG8_SB(0, 1), b2 + hstepB); PG8_STAGE(PG8_SA(0, 0), a2, w0, w1);
            PG8_WAIT_V(8); PG8_WAIT_L(0); PG8_BAR; PG8_MMA(1, 0, At, B0); PG8_MMA(1, 1, At, B1); PG8_BAR; PG8_SCHED;
            PG8_LDB(B0, 1, 0); PG8_LDB(B1, 1, 1); PG8_SCHED; PG8_LDA(At, 1, 0); PG8_STAGE(PG8_SA(0, 1), a2 + h2, w0, w1);
            PG8_WAIT_V(8); PG8_WAIT_L(0); PG8_BAR; PG8_MMA(0, 0, At, B0); PG8_MMA(0, 1, At, B1); PG8_BAR; PG8_SCHED;
            PG8_LDA(At, 1, 1); PG8_STAGEB(PG8_SB(1, 0), b3); PG8_STAGEB(PG8_SB(1, 1), b3 + hstepB); PG8_STAGE(PG8_SA(1, 0), a3, w0, w1);
            PG8_WAIT_V(8); PG8_WAIT_L(0); PG8_BAR; PG8_MMA(1, 0, At, B0); PG8_MMA(1, 1, At, B1); PG8_BAR; PG8_SCHED;
        }
        if (wr == 0) PG8_BAR;
        E(acc, cur, wr, wc, fr, fq);
        if (!has_next) break;
#pragma unroll
        for (int a = 0; a < 2; ++a)
#pragma unroll
            for (int b = 0; b < 2; ++b)
#pragma unroll
                for (int m = 0; m < 4; ++m)
#pragma unroll
                    for (int n = 0; n < 2; ++n) acc[a][b][m][n] = (f32x4){0.f, 0.f, 0.f, 0.f};
        cur = nxt; cA = nA; cB = nB; chA = nhA; cv0 = nv0; cv1 = nv1; ++ui;
        if (wr == 1) PG8_BAR;
    }
    PG8_WAIT_V(0);
    PG8_BAR;
#undef PG8_SA
#undef PG8_SB
#undef PG8_STAGE
#undef PG8_STAGEB
#undef PG8_LDA
#undef PG8_LDB
#undef PG8_MMA
#undef PG8_WAIT_V
#undef PG8_WAIT_L
#undef PG8_BAR
#undef PG8_SCHED
}

struct EpiStore {
    static constexpr bool PERM = true;
    bf16_t* O; int ldc;
    __device__ __forceinline__ void operator()(const f32x4 (&acc)[2][2][4][2], const Unit& u, int wr, int wc, int fr, int fq) const {
        const int row0 = u.pm * BM + wr * 64 + fr, col0 = u.pn * BM + wc * 32 + 8 * fq;
#pragma unroll
        for (int ai = 0; ai < 2; ++ai)
#pragma unroll
            for (int m = 0; m < 4; ++m) { bf16_t* rowp = O + (size_t)(row0 + ai * HALF + m * 16) * ldc + col0;
#pragma unroll
                for (int bj = 0; bj < 2; ++bj) { const f32x4 v0 = acc[ai][bj][m][0], v1 = acc[ai][bj][m][1];
                    u32x4 w; w.x = cvt_pk_bf16(v0[0], v0[1]); w.y = cvt_pk_bf16(v0[2], v0[3]); w.z = cvt_pk_bf16(v1[0], v1[1]); w.w = cvt_pk_bf16(v1[2], v1[3]);
                    *(u32x4*)(rowp + bj * HALF) = w; } }
    }
};
struct EpiMerge {
    static constexpr bool PERM = true;
    bf16_t* G; int ldg; const float* bias; bf16_t* Y; int accum;
    __device__ __forceinline__ void operator()(const f32x4 (&acc)[2][2][4][2], const Unit& u, int wr, int wc, int fr, int fq) const {
        const int row0 = u.pm * BM + wr * 64 + fr, col0 = u.pn * BM + wc * 32 + 8 * fq;
        if (u.sel == 0) {
            f32x4 bv[2][2];
#pragma unroll
            for (int bj = 0; bj < 2; ++bj)
#pragma unroll
                for (int n = 0; n < 2; ++n) bv[bj][n] = *(const f32x4*)(bias + col0 + bj * HALF + 4 * n);
#pragma unroll
            for (int ai = 0; ai < 2; ++ai)
#pragma unroll
                for (int m = 0; m < 4; ++m) { bf16_t* rowp = G + (size_t)(row0 + ai * HALF + m * 16) * ldg + col0;
#pragma unroll
                    for (int bj = 0; bj < 2; ++bj) { f32x4 v0 = acc[ai][bj][m][0] + bv[bj][0], v1 = acc[ai][bj][m][1] + bv[bj][1];
#pragma unroll
                        for (int j = 0; j < 4; ++j) { v0[j] = sigmoidf_(v0[j]); v1[j] = sigmoidf_(v1[j]); }
                        u32x4 w; w.x = cvt_pk_bf16(v0[0], v0[1]); w.y = cvt_pk_bf16(v0[2], v0[3]); w.z = cvt_pk_bf16(v1[0], v1[1]); w.w = cvt_pk_bf16(v1[2], v1[3]);
                        *(u32x4*)(rowp + bj * HALF) = w; } }
        } else {
#pragma unroll
            for (int ai = 0; ai < 2; ++ai)
#pragma unroll
                for (int m = 0; m < 4; ++m) { const size_t r = (size_t)(row0 + ai * HALF + m * 16);
                    const unsigned long long* gp = (const unsigned long long*)(G + r * ldg + col0); bf16_t* yp = Y + r * DM + col0;
#pragma unroll
                    for (int bj = 0; bj < 2; ++bj) {
                        const unsigned long long g0 = __hip_atomic_load(gp + bj * (HALF / 4), __ATOMIC_RELAXED, __HIP_MEMORY_SCOPE_AGENT);
                        const unsigned long long g1 = __hip_atomic_load(gp + bj * (HALF / 4) + 1, __ATOMIC_RELAXED, __HIP_MEMORY_SCOPE_AGENT);
                        const unsigned gw[4] = {(unsigned)g0, (unsigned)(g0 >> 32), (unsigned)g1, (unsigned)(g1 >> 32)};
                        u32x4 yo = {0u, 0u, 0u, 0u}; if (accum) yo = *(const u32x4*)(yp + bj * HALF);
                        const f32x4 v0 = acc[ai][bj][m][0], v1 = acc[ai][bj][m][1];
                        u32x4 w;
                        w.x = cvt_pk_bf16(bflo(yo.x) + bflo(gw[0]) * v0[0], bfhi(yo.x) + bfhi(gw[0]) * v0[1]);
                        w.y = cvt_pk_bf16(bflo(yo.y) + bflo(gw[1]) * v0[2], bfhi(yo.y) + bfhi(gw[1]) * v0[3]);
                        w.z = cvt_pk_bf16(bflo(yo.z) + bflo(gw[2]) * v1[0], bfhi(yo.z) + bfhi(gw[2]) * v1[1]);
                        w.w = cvt_pk_bf16(bflo(yo.w) + bflo(gw[3]) * v1[2], bfhi(yo.w) + bfhi(gw[3]) * v1[3]);
                        *(u32x4*)(yp + bj * HALF) = w; } }
        }
    }
};
struct EpiResid {
    static constexpr bool PERM = false;
    const float* Xin; float* Xout;
    __device__ __forceinline__ void operator()(const f32x4 (&acc)[2][2][4][2], const Unit& u, int wr, int wc, int fr, int fq) const {
        const int row0 = u.pm * BM + wr * 64 + fr, col0 = u.pn * BM + wc * 32 + 4 * fq;
#pragma unroll
        for (int ai = 0; ai < 2; ++ai)
#pragma unroll
            for (int m = 0; m < 4; ++m) { const size_t ro = (size_t)(row0 + ai * HALF + m * 16) * DM + col0;
#pragma unroll
                for (int bj = 0; bj < 2; ++bj)
#pragma unroll
                    for (int n = 0; n < 2; ++n) { const f32x4 xi = *(const f32x4*)(Xin + ro + bj * HALF + n * 16); *(f32x4*)(Xout + ro + bj * HALF + n * 16) = xi + acc[ai][bj][m][n]; } }
    }
};
}

__device__ void phase_convert(int l, unsigned char* smem) {
    const Params p = load_params();
    float* tile = (float*)smem;
    const int tid = opaque_tid();
    const float* win = p.w_in + (size_t)l * DM * N_IN;
    bf16_t* WtIn = p.Wt; bf16_t* WtBr = p.Wt + (size_t)WT_ROWS * DM; bf16_t* WtOut = WtBr + (size_t)3 * DM * DM;
    const int NT_IN = WT_ROWS / 64;
    const int total = (NT_IN + 48 + 16) * 16;
    for (int it = blockIdx.x; it < total; it += gridDim.x) {
        const int ntile = it >> 4, kt = it & 15, k0 = kt * 64;
        const float* src = nullptr; int ld = 0, c0 = 0, valid = 64; bf16_t* dst;
        if (ntile < NT_IN) {
            const int n0 = ntile * 64; dst = WtIn + (size_t)n0 * DM;
            if (n0 < 4224) { src = win; ld = N_IN; c0 = n0; }
            else if (n0 < 4352) { if (n0 == 4224 && l > 0) { src = p.v_w1 + (size_t)(l - 1) * DM * 32; ld = 32; c0 = 0; valid = 32; } else { valid = 0; } }
            else { src = win; ld = N_IN; c0 = n0 - 128; }
        } else if (ntile < NT_IN + 48) {
            const int q = ntile - NT_IN, n = q >> 4, n0 = (q & 15) * 64;
            src = p.w_branch + ((size_t)l * 3 + n) * DM * DM; ld = DM; c0 = n0; dst = WtBr + ((size_t)n * DM + n0) * DM;
        } else {
            const int n0 = (ntile - NT_IN - 48) * 64; src = p.w_out + (size_t)l * DM * DM; ld = DM; c0 = n0; dst = WtOut + (size_t)n0 * DM;
        }
        __syncthreads();
        if (valid == 64) {
            const int kr = tid >> 4, nc = (tid & 15) * 4;
#pragma unroll
            for (int ps = 0; ps < 2; ++ps) { const int k = kr + ps * 32; const f32x4 v = *(const f32x4*)(src + (size_t)(k0 + k) * ld + c0 + nc);
                tile[k * 65 + nc] = v[0]; tile[k * 65 + nc + 1] = v[1]; tile[k * 65 + nc + 2] = v[2]; tile[k * 65 + nc + 3] = v[3]; }
        } else {
            for (int e = tid; e < 4096; e += 512) { const int k = e >> 6, n = e & 63; tile[k * 65 + n] = (n < valid) ? src[(size_t)(k0 + k) * ld + c0 + n] : 0.f; }
        }
        __syncthreads();
        { const int nr = tid >> 3, kc = (tid & 7) * 8; u32x4 w;
          w.x = cvt_pk_bf16(tile[(kc + 0) * 65 + nr], tile[(kc + 1) * 65 + nr]); w.y = cvt_pk_bf16(tile[(kc + 2) * 65 + nr], tile[(kc + 3) * 65 + nr]);
          w.z = cvt_pk_bf16(tile[(kc + 4) * 65 + nr], tile[(kc + 5) * 65 + nr]); w.w = cvt_pk_bf16(tile[(kc + 6) * 65 + nr], tile[(kc + 7) * 65 + nr]);
          *(u32x4*)(dst + (size_t)nr * DM + k0 + kc) = w; }
    }
    __syncthreads();
}

__device__ void phase_rmsnorm(const float* x, const float* g, bf16_t* xn, float* outf) {
    const int tid_ = opaque_tid(); const int lane = tid_ & 63, wv = tid_ >> 6;
    f32x4 gv[4];
#pragma unroll
    for (int q = 0; q < 4; ++q) gv[q] = *(const f32x4*)(g + q * 256 + lane * 4);
    for (int row = blockIdx.x * 8 + wv; row < T_TOK; row += gridDim.x * 8) {
        const float* xr = x + (size_t)row * DM; f32x4 v[4]; float ss = 0.f;
#pragma unroll
        for (int q = 0; q < 4; ++q) { v[q] = *(const f32x4*)(xr + q * 256 + lane * 4); ss += v[q][0] * v[q][0] + v[q][1] * v[q][1] + v[q][2] * v[q][2] + v[q][3] * v[q][3]; }
#pragma unroll
        for (int o = 32; o > 0; o >>= 1) ss += __shfl_xor(ss, o);
        const float rinv = rsqrtf(ss * (1.0f / DM) + EPS);
#pragma unroll
        for (int q = 0; q < 4; ++q) { const f32x4 o = v[q] * rinv * gv[q];
            if (xn) { u32x2 w; w.x = cvt_pk_bf16(o[0], o[1]); w.y = cvt_pk_bf16(o[2], o[3]); *(u32x2*)(xn + (size_t)row * DM + q * 256 + lane * 4) = w; }
            else *(f32x4*)(outf + (size_t)row * DM + q * 256 + lane * 4) = o; }
    }
}

template <int CTRL> __device__ __forceinline__ float dpp_f(float v) { return __int_as_float(__builtin_amdgcn_update_dpp(0, __float_as_int(v), CTRL, 0xf, 0xf, false)); }
__device__ __forceinline__ float red8(float v) { v += dpp_f<0xB1>(v); v += dpp_f<0x4E>(v); v += dpp_f<0x141>(v); return v; }
__device__ __forceinline__ float red16(float v) { v = red8(v); v += dpp_f<0x140>(v); return v; }

struct RwRaw { u32x4 cw[2], pw[2], ca[2], pa[2], vl; u32x2 cr[2], pr[2], ck[2], pk[2], cv, pv, vf; };
__device__ __forceinline__ void rw_load(RwRaw& R, const bf16_t* H, const bf16_t* vfp, int l, size_t tok, bool hasp, int h, int chh, int vnt, int fq) {
    const bf16_t* cur = H + tok * LDA_H; const bf16_t* prev = cur - LDA_H;
    const u32x4 z4 = {0u, 0u, 0u, 0u}; const u32x2 z2 = {0u, 0u};
#pragma unroll
    for (int ks = 0; ks < 2; ++ks) { const int m0 = ks * 32 + fq * 8;
        R.cw[ks] = *(const u32x4*)(cur + 3072 + m0); R.ca[ks] = *(const u32x4*)(cur + 3136 + m0);
        R.pw[ks] = hasp ? *(const u32x4*)(prev + 3072 + m0) : z4; R.pa[ks] = hasp ? *(const u32x4*)(prev + 3136 + m0) : z4; }
#pragma unroll
    for (int q = 0; q < 2; ++q) { const int cb = h * 64 + (chh * 2 + q) * 16 + fq * 4;
        R.cr[q] = *(const u32x2*)(cur + cb); R.ck[q] = *(const u32x2*)(cur + 1024 + cb);
        R.pr[q] = hasp ? *(const u32x2*)(prev + cb) : z2; R.pk[q] = hasp ? *(const u32x2*)(prev + 1024 + cb) : z2; }
    const int cbv = h * 64 + vnt * 16 + fq * 4;
    R.cv = *(const u32x2*)(cur + 2048 + cbv); R.pv = hasp ? *(const u32x2*)(prev + 2048 + cbv) : z2;
    R.vf = z2; R.vl = z4;
    if (l > 0) { R.vf = *(const u32x2*)(vfp + tok * DM + cbv); R.vl = *(const u32x4*)(cur + 4224 + fq * 8); }
}

__device__ void phase_rwkv(int l, unsigned char* smem, int mode) {
    const Params p = load_params();
    constexpr int TC = 32, NCH = SEQ / TC, RS = 68  , BUFSZ = 5 * TC * RS + TC * 32 + TC * 2;
    bf16_t* w2T = (bf16_t*)smem;
    bf16_t* a2T = w2T + 64 * 72;
    bf16_t* v2T = a2T + 64 * 72;
    float* cst = (float*)(v2T + 64 * 40);
    float* buf0 = cst + 11 * 64;
    float* ypart = buf0 + 2 * BUFSZ;
    float* sI = ypart + 4 * TC * 64;
    const int tid = opaque_tid(), wid = __builtin_amdgcn_readfirstlane(tid >> 6), lane = tid & 63, fr = lane & 15, fq = lane >> 4;
    for (int item = blockIdx.x; item < NB * 32; item += gridDim.x) {
        const int xc_ = item & 7, sl_ = item >> 3, half = sl_ & 1, pi_ = (sl_ >> 1) * 8 + xc_, b = pi_ >> 4, h = pi_ & 15;
        __syncthreads();
        for (int e = tid; e < 4096; e += 512) { const int m = e >> 6, j = e & 63; w2T[j * 72 + m] = f2bf(p.w_w2[((size_t)l * 64 + m) * DM + h * 64 + j]); a2T[j * 72 + m] = f2bf(p.a_w2[((size_t)l * 64 + m) * DM + h * 64 + j]); }
        if (l > 0) for (int e = tid; e < 2048; e += 512) { const int m = e >> 6, j = e & 63; v2T[j * 40 + m] = f2bf(p.v_w2[((size_t)(l - 1) * 32 + m) * DM + h * 64 + j]); }
        if (tid < 64) { const float* mu = p.mu + (size_t)l * 3200; const int cc = h * 64 + tid;
            cst[tid] = mu[cc]; cst[64 + tid] = mu[1024 + cc]; cst[128 + tid] = mu[2048 + cc]; cst[192 + tid] = p.w0[l * DM + cc]; cst[256 + tid] = p.a0[l * DM + cc];
            cst[320 + tid] = (l > 0) ? p.v0[(l - 1) * DM + cc] : 0.f; cst[384 + tid] = p.k_k[l * DM + cc]; cst[448 + tid] = p.k_a[l * DM + cc]; cst[512 + tid] = p.r_k[l * DM + cc];
            cst[576 + tid] = mu[3072 + tid]; cst[640 + tid] = mu[3136 + tid]; }
        __syncthreads();
        f32x2 st[4];
#pragma unroll
        for (int j = 0; j < 4; ++j) st[j] = (f32x2){0.f, 0.f};
        const int si = tid >> 3, seg = tid & 7;
        const int pwv = wid - 4, tti = pwv & 1, chh = (pwv >> 1) & 1, vnt = half * 2 + chh, tt = tti * 16 + fr;
        RwRaw raw;
        if (wid >= 4) rw_load(raw, p.H, p.vf, l, (size_t)b * SEQ + tt, tt > 0, h, chh, vnt, fq);
        for (int c = -1; c < NCH; ++c) {
            if (wid >= 4 && c + 1 < NCH && !(mode & 2)) {
                float* B_ = buf0 + ((c + 1) & 1) * BUFSZ;
                float* sR = B_; float* sW = sR + TC * RS; float* sK = sW + TC * RS; float* sA = sK + TC * RS; float* sB = sA + TC * RS; float* sV = sB + TC * RS; float* sS = sV + TC * 32;
                const size_t tok = (size_t)b * SEQ + (c + 1) * TC + tt;
                const RwRaw& cr_ = raw;
                bf16x8 AfW[2], AfA[2];
#pragma unroll
                for (int ks = 0; ks < 2; ++ks) { const int m0 = ks * 32 + fq * 8;
                    const f32x4 mw0 = *(const f32x4*)(cst + 576 + m0), mw1 = *(const f32x4*)(cst + 576 + m0 + 4), ma0 = *(const f32x4*)(cst + 640 + m0), ma1 = *(const f32x4*)(cst + 640 + m0 + 4);
                    const float muw[8] = {mw0[0], mw0[1], mw0[2], mw0[3], mw1[0], mw1[1], mw1[2], mw1[3]}, mua[8] = {ma0[0], ma0[1], ma0[2], ma0[3], ma1[0], ma1[1], ma1[2], ma1[3]};
                    const unsigned cwv[4] = {cr_.cw[ks].x, cr_.cw[ks].y, cr_.cw[ks].z, cr_.cw[ks].w}, pwq[4] = {cr_.pw[ks].x, cr_.pw[ks].y, cr_.pw[ks].z, cr_.pw[ks].w};
                    const unsigned cav[4] = {cr_.ca[ks].x, cr_.ca[ks].y, cr_.ca[ks].z, cr_.ca[ks].w}, pav[4] = {cr_.pa[ks].x, cr_.pa[ks].y, cr_.pa[ks].z, cr_.pa[ks].w};
                    unsigned ow[4], oa[4];
#pragma unroll
                    for (int e = 0; e < 4; ++e) {
                        const float c0 = bflo(cwv[e]), c1 = bfhi(cwv[e]), q0 = bflo(pwq[e]), q1 = bfhi(pwq[e]);
                        ow[e] = cvt_pk_bf16(tanh_fast(c0 + muw[2 * e] * (q0 - c0)), tanh_fast(c1 + muw[2 * e + 1] * (q1 - c1)));
                        const float d0 = bflo(cav[e]), d1 = bfhi(cav[e]), r0 = bflo(pav[e]), r1 = bfhi(pav[e]);
                        oa[e] = cvt_pk_bf16(d0 + mua[2 * e] * (r0 - d0), d1 + mua[2 * e + 1] * (r1 - d1)); }
                    AfW[ks] = __builtin_bit_cast(bf16x8, ((u32x4){ow[0], ow[1], ow[2], ow[3]})); AfA[ks] = __builtin_bit_cast(bf16x8, ((u32x4){oa[0], oa[1], oa[2], oa[3]})); }
                f32x4 accW[2], accA[2], accV = (f32x4){0.f, 0.f, 0.f, 0.f};
#pragma unroll
                for (int q = 0; q < 2; ++q) { const int nt = chh * 2 + q; accW[q] = (f32x4){0.f, 0.f, 0.f, 0.f}; accA[q] = (f32x4){0.f, 0.f, 0.f, 0.f};
#pragma unroll
                    for (int ks = 0; ks < 2; ++ks) { const bf16x8 bw = *(const bf16x8*)(w2T + (nt * 16 + fr) * 72 + ks * 32 + fq * 8), ba = *(const bf16x8*)(a2T + (nt * 16 + fr) * 72 + ks * 32 + fq * 8);
                        accW[q] = __builtin_amdgcn_mfma_f32_16x16x32_bf16(bw, AfW[ks], accW[q], 0, 0, 0); accA[q] = __builtin_amdgcn_mfma_f32_16x16x32_bf16(ba, AfA[ks], accA[q], 0, 0, 0); } }
                if (l > 0) { const bf16x8 bv = *(const bf16x8*)(v2T + (vnt * 16 + fr) * 40 + fq * 8); accV = __builtin_amdgcn_mfma_f32_16x16x32_bf16(bv, __builtin_bit_cast(bf16x8, cr_.vl), accV, 0, 0, 0); }
                float ss = 0.f, rk = 0.f;
#pragma unroll
                for (int q = 0; q < 2; ++q) { const int ch0 = (chh * 2 + q) * 16 + fq * 4;
                    const float fr_[4] = {bflo(cr_.cr[q].x), bfhi(cr_.cr[q].x), bflo(cr_.cr[q].y), bfhi(cr_.cr[q].y)}, fpr[4] = {bflo(cr_.pr[q].x), bfhi(cr_.pr[q].x), bflo(cr_.pr[q].y), bfhi(cr_.pr[q].y)};
                    const float fk_[4] = {bflo(cr_.ck[q].x), bfhi(cr_.ck[q].x), bflo(cr_.ck[q].y), bfhi(cr_.ck[q].y)}, fpk[4] = {bflo(cr_.pk[q].x), bfhi(cr_.pk[q].x), bflo(cr_.pk[q].y), bfhi(cr_.pk[q].y)};
                    const f32x4 mur = *(const f32x4*)(cst + ch0), muk = *(const f32x4*)(cst + 64 + ch0), w0v = *(const f32x4*)(cst + 192 + ch0), a0v = *(const f32x4*)(cst + 256 + ch0),
                        kkv = *(const f32x4*)(cst + 384 + ch0), kav = *(const f32x4*)(cst + 448 + ch0), rkv = *(const f32x4*)(cst + 512 + ch0);
                    f32x4 ro, wo, ko, ao, bo;
#pragma unroll
                    for (int e = 0; e < 4; ++e) {
                        const float r = fr_[e] + mur[e] * (fpr[e] - fr_[e]), k = fk_[e] + muk[e] * (fpk[e] - fk_[e]);
                        wo[e] = __expf(-0.60653065971f * sigmoidf_(w0v[e] + accW[q][e]));
                        const float a = sigmoidf_(a0v[e] + accA[q][e]);
                        const float kq = k * kkv[e]; ss += kq * kq; ao[e] = -kq; bo[e] = kq * a;
                        const float km = k * (1.0f + (a - 1.0f) * kav[e]); rk += r * km * rkv[e]; ro[e] = r; ko[e] = km; }
                    *(f32x4*)(sR + tt * RS + ch0) = ro; *(f32x4*)(sW + tt * RS + ch0) = wo; *(f32x4*)(sK + tt * RS + ch0) = ko; *(f32x4*)(sA + tt * RS + ch0) = ao; *(f32x4*)(sB + tt * RS + ch0) = bo; }
                ss += __shfl_xor(ss, 16); ss += __shfl_xor(ss, 32); rk += __shfl_xor(rk, 16); rk += __shfl_xor(rk, 32);
                if (fq == 0) { sS[tt * 2 + chh] = ss; if (half == 0) p.rkbuf[(size_t)((b * 16 + h) * 2 + chh) * SEQ + (c + 1) * TC + tt] = rk; }
                { const int ch0 = vnt * 16 + fq * 4, cb = h * 64 + ch0;
                  const float fv_[4] = {bflo(cr_.cv.x), bfhi(cr_.cv.x), bflo(cr_.cv.y), bfhi(cr_.cv.y)}, fpv[4] = {bflo(cr_.pv.x), bfhi(cr_.pv.x), bflo(cr_.pv.y), bfhi(cr_.pv.y)};
                  const f32x4 muv = *(const f32x4*)(cst + 128 + ch0), v0v = *(const f32x4*)(cst + 320 + ch0);
                  f32x4 vo;
#pragma unroll
                  for (int e = 0; e < 4; ++e) vo[e] = fv_[e] + muv[e] * (fpv[e] - fv_[e]);
                  if (l > 0) { const float vfv[4] = {bflo(cr_.vf.x), bfhi(cr_.vf.x), bflo(cr_.vf.y), bfhi(cr_.vf.y)};
#pragma unroll
                      for (int e = 0; e < 4; ++e) vo[e] = vo[e] + (vfv[e] - vo[e]) * sigmoidf_(v0v[e] + accV[e]); }
                  u32x2 w; w.x = cvt_pk_bf16(vo[0], vo[1]); w.y = cvt_pk_bf16(vo[2], vo[3]); *(u32x2*)(p.vf + tok * DM + cb) = w;
                  *(f32x4*)(sV + tt * 32 + chh * 16 + fq * 4) = vo; }
            }
            if (wid >= 4 && c + 2 < NCH && !(mode & 2)) rw_load(raw, p.H, p.vf, l, (size_t)b * SEQ + (size_t)(c + 2) * TC + tt, true, h, chh, vnt, fq);
            if (wid < 4 && c >= 0 && !(mode & 1)) {
                const float* B_ = buf0 + (c & 1) * BUFSZ;
                const float* sR = B_; const float* sW = sR + TC * RS; const float* sK = sW + TC * RS; const float* sA = sK + TC * RS; const float* sB = sA + TC * RS; const float* sV = sB + TC * RS; const float* sS = sV + TC * 32;
                float* yp = ypart + wid * (TC * 64) + lane; float* sIw = sI + wid * TC;
                if (lane < TC) { const f32x2 ps = *(const f32x2*)(sS + lane * 2); sIw[lane] = __builtin_amdgcn_rcpf(fmaxf(ps.x + ps.y, 1e-24f)); }
                f32x4 A0, A1, W0, W1, B0, B1, K0, K1, R0, R1; float VI, IV;
#define SC_LOAD(s_) do { const int o_ = (s_) * RS + seg * 8; \
                    A0 = *(const f32x4*)(sA + o_); A1 = *(const f32x4*)(sA + o_ + 4); W0 = *(const f32x4*)(sW + o_); W1 = *(const f32x4*)(sW + o_ + 4); \
                    B0 = *(const f32x4*)(sB + o_); B1 = *(const f32x4*)(sB + o_ + 4); K0 = *(const f32x4*)(sK + o_); K1 = *(const f32x4*)(sK + o_ + 4); \
                    R0 = *(const f32x4*)(sR + o_); R1 = *(const f32x4*)(sR + o_ + 4); VI = sV[(s_) * 32 + si]; IV = sIw[(s_)]; } while (0)
                SC_LOAD(0);
#pragma unroll 8
                for (int s = 0; s < TC; ++s) {
                    const f32x4 a0 = A0, a1 = A1, w0 = W0, w1 = W1, b0 = B0, b1 = B1, k0 = K0, k1 = K1, r0 = R0, r1 = R1; const float vi = VI, inv2 = IV;
                    if (s + 1 < TC) SC_LOAD(s + 1);
                    __builtin_amdgcn_sched_barrier(0);
                    const f32x2 av[4] = {{a0[0], a0[1]}, {a0[2], a0[3]}, {a1[0], a1[1]}, {a1[2], a1[3]}}, wv[4] = {{w0[0], w0[1]}, {w0[2], w0[3]}, {w1[0], w1[1]}, {w1[2], w1[3]}};
                    const f32x2 bv[4] = {{b0[0], b0[1]}, {b0[2], b0[3]}, {b1[0], b1[1]}, {b1[2], b1[3]}}, kv[4] = {{k0[0], k0[1]}, {k0[2], k0[3]}, {k1[0], k1[1]}, {k1[2], k1[3]}};
                    const f32x2 rv[4] = {{r0[0], r0[1]}, {r0[2], r0[3]}, {r1[0], r1[1]}, {r1[2], r1[3]}};
                    const f32x2 vi2 = {vi, vi};
                    f32x2 vk[4];
#pragma unroll
                    for (int j = 0; j < 4; ++j) vk[j] = vi2 * kv[j];
                    f32x2 pc = st[0] * av[0]; pc += st[1] * av[1]; pc += st[2] * av[2]; pc += st[3] * av[3];
                    const float sa = red8(pc.x + pc.y) * inv2;
                    const f32x2 sa2 = {sa, sa};
#pragma unroll
                    for (int j = 0; j < 4; ++j) st[j] = st[j] * wv[j] + (sa2 * bv[j] + vk[j]);
                    f32x2 qc = st[0] * rv[0]; qc += st[1] * rv[1]; qc += st[2] * rv[2]; qc += st[3] * rv[3];
                    yp[s * 64] = qc.x + qc.y;
                }
#undef SC_LOAD
                { const int tk = lane >> 1, rq = (lane & 1) * 4; const float* yr = ypart + wid * (TC * 64) + tk * 64 + rq * 8; float yv[4];
#pragma unroll
                  for (int r_ = 0; r_ < 4; ++r_) { const f32x4 u0 = *(const f32x4*)(yr + r_ * 8), u1 = *(const f32x4*)(yr + r_ * 8 + 4); yv[r_] = ((u0[0] + u0[1]) + (u0[2] + u0[3])) + ((u1[0] + u1[1]) + (u1[2] + u1[3])); }
                  u32x2 w; w.x = cvt_pk_bf16(yv[0], yv[1]); w.y = cvt_pk_bf16(yv[2], yv[3]);
                  *(u32x2*)(p.y + ((size_t)b * SEQ + c * TC + tk) * DM + h * 64 + half * 32 + wid * 8 + rq) = w; }
            }
            __syncthreads();
        }
    }
    __syncthreads();
}

__device__ void phase_rwkv_post(int l, bf16_t* oalt) {
    const Params p = load_params();
    const int tid = opaque_tid(), l8 = tid & 7;
    const int ngrp = T_TOK * 16;
    for (int g = blockIdx.x * 64 + (tid >> 3); g < ngrp; g += gridDim.x * 64) {
        const int tok = g >> 4, h = g & 15, cb = h * 64 + l8 * 8;
        const u32x4 y4 = *(const u32x4*)(p.y + (size_t)tok * DM + cb), b4 = *(const u32x4*)(p.vf + (size_t)tok * DM + cb);
        const int bb = tok / SEQ, tq = tok % SEQ; const float rk = p.rkbuf[(size_t)((bb * 16 + h) * 2) * SEQ + tq] + p.rkbuf[(size_t)((bb * 16 + h) * 2 + 1) * SEQ + tq];
        bf16_t* zp = p.H + (size_t)tok * LDA_H + 3200 + cb; const u32x4 z4 = *(const u32x4*)zp;
        const float yv[8] = {bflo(y4.x), bfhi(y4.x), bflo(y4.y), bfhi(y4.y), bflo(y4.z), bfhi(y4.z), bflo(y4.w), bfhi(y4.w)};
        const float bv[8] = {bflo(b4.x), bfhi(b4.x), bflo(b4.y), bfhi(b4.y), bflo(b4.z), bfhi(b4.z), bflo(b4.w), bfhi(b4.w)};
        const float zv[8] = {bflo(z4.x), bfhi(z4.x), bflo(z4.y), bfhi(z4.y), bflo(z4.z), bfhi(z4.z), bflo(z4.w), bfhi(z4.w)};
        float sm = 0.f;
#pragma unroll
        for (int e = 0; e < 8; ++e) sm += yv[e];
        sm = red8(sm); const float mean = sm * (1.0f / 64.f); float d[8], vs = 0.f;
#pragma unroll
        for (int e = 0; e < 8; ++e) { d[e] = yv[e] - mean; vs += d[e] * d[e]; }
        vs = red8(vs); const float rstd = rsqrtf(vs * (1.0f / 64.f) + GN_EPS);
        const f32x4 g0 = *(const f32x4*)(p.lnx_g + l * DM + cb), g1 = *(const f32x4*)(p.lnx_g + l * DM + cb + 4), c0 = *(const f32x4*)(p.lnx_b + l * DM + cb), c1 = *(const f32x4*)(p.lnx_b + l * DM + cb + 4);
        const float gg[8] = {g0[0], g0[1], g0[2], g0[3], g1[0], g1[1], g1[2], g1[3]}, cc[8] = {c0[0], c0[1], c0[2], c0[3], c1[0], c1[1], c1[2], c1[3]};
        float o[8];
#pragma unroll
        for (int e = 0; e < 8; ++e) o[e] = (d[e] * rstd * gg[e] + cc[e] + rk * bv[e]) * siluf_(zv[e]);
        u32x4 w; w.x = cvt_pk_bf16(o[0], o[1]); w.y = cvt_pk_bf16(o[2], o[3]); w.z = cvt_pk_bf16(o[4], o[5]); w.w = cvt_pk_bf16(o[6], o[7]);
        *(u32x4*)(oalt ? oalt + (size_t)tok * DM + cb : zp) = w;
    }
}

__device__ __forceinline__ float wave_sum64(float v) {
    v = red16(v);
    const float a = __int_as_float(__builtin_amdgcn_readlane(__float_as_int(v), 0)), b = __int_as_float(__builtin_amdgcn_readlane(__float_as_int(v), 16));
    const float c = __int_as_float(__builtin_amdgcn_readlane(__float_as_int(v), 32)), d = __int_as_float(__builtin_amdgcn_readlane(__float_as_int(v), 48));
    return (a + b) + (c + d);
}
__device__ void phase_sgu(int l, unsigned char* smem, bf16_t* oalt) {
    const Params p = load_params();
    bf16_t* vnTb = (bf16_t*)smem;
    float* stat = (float*)(smem + 2 * 128 * 136 * 2);
    float* lnG = stat + 256; float* lnB = lnG + DM;
    const int tid = opaque_tid(), wid = tid >> 6, lane = tid & 63, fr = lane & 15, fq = lane >> 4;
    __syncthreads();
    for (int e = tid; e < DM; e += 512) { lnG[e] = p.sgu_ln_g[(size_t)l * DM + e]; lnB[e] = p.sgu_ln_b[(size_t)l * DM + e]; }
    for (int item = blockIdx.x; item < T_TOK / 128; item += gridDim.x) {
        bf16_t* Hb = p.H + (size_t)item * 128 * LDB_H;
        __syncthreads();
#pragma unroll
        for (int hb = 0; hb < 2; ++hb) {
            u32x4 va[8], vb[8];
#pragma unroll
            for (int q = 0; q < 8; ++q) { const bf16_t* vr = Hb + (size_t)(wid * 16 + hb * 8 + q) * LDB_H + 1024 + lane * 16; va[q] = *(const u32x4*)vr; vb[q] = *(const u32x4*)(vr + 8); }
#pragma unroll
            for (int q = 0; q < 8; ++q) {
                const float f[16] = {bflo(va[q].x), bfhi(va[q].x), bflo(va[q].y), bfhi(va[q].y), bflo(va[q].z), bfhi(va[q].z), bflo(va[q].w), bfhi(va[q].w), bflo(vb[q].x), bfhi(vb[q].x), bflo(vb[q].y), bfhi(vb[q].y), bflo(vb[q].z), bfhi(vb[q].z), bflo(vb[q].w), bfhi(vb[q].w)};
                float sm = 0.f, sq = 0.f;
#pragma unroll
                for (int e = 0; e < 16; ++e) { sm += f[e]; sq += f[e] * f[e]; }
                sm = wave_sum64(sm); sq = wave_sum64(sq);
                const float mean = sm * (1.0f / DM), var = fmaxf(sq * (1.0f / DM) - mean * mean, 0.f);
                if (lane == 0) { const int s = wid * 16 + hb * 8 + q; stat[s * 2] = mean; stat[s * 2 + 1] = rsqrtf(var + EPS); } }
        }
        __syncthreads();
        const int trow = wid * 16 + fr; bf16_t* hr = Hb + (size_t)trow * LDB_H;
        const int nks = (wid < 4) ? 2 : 4;
        for (int g = 0; g < 8; ++g) {
            bf16_t* vnT = vnTb + (g & 1) * (128 * 136);
            const int s = tid >> 2, c0 = (tid & 3) * 32;
            const bf16_t* vr = Hb + (size_t)s * LDB_H + 1024 + g * 128 + c0;
            u32x4 vv[4];
#pragma unroll
            for (int q = 0; q < 4; ++q) vv[q] = *(const u32x4*)(vr + q * 8);
            const float* Wg = p.sgu_w + (((size_t)l * 8 + g) * 128 + trow) * 128;
            f32x4 wa[4], wb[4];
#pragma unroll
            for (int ks = 0; ks < 4; ++ks) if (ks < nks) { wa[ks] = *(const f32x4*)(Wg + ks * 32 + fq * 8); wb[ks] = *(const f32x4*)(Wg + ks * 32 + fq * 8 + 4); }
            u32x2 u2[8], z2[8];
#pragma unroll
            for (int ct = 0; ct < 8; ++ct) { const int c = g * 128 + ct * 16 + fq * 4; u2[ct] = *(const u32x2*)(hr + c); z2[ct] = *(const u32x2*)(hr + 2048 + c); }
            const float bs = p.sgu_b[((size_t)l * 8 + g) * 128 + trow];
            { const float mean = stat[s * 2], rstd = stat[s * 2 + 1];
#pragma unroll
              for (int q = 0; q < 4; ++q) { const float f[8] = {bflo(vv[q].x), bfhi(vv[q].x), bflo(vv[q].y), bfhi(vv[q].y), bflo(vv[q].z), bfhi(vv[q].z), bflo(vv[q].w), bfhi(vv[q].w)};
                  const f32x4 g0 = *(const f32x4*)(lnG + g * 128 + c0 + q * 8), g1 = *(const f32x4*)(lnG + g * 128 + c0 + q * 8 + 4), b0 = *(const f32x4*)(lnB + g * 128 + c0 + q * 8), b1 = *(const f32x4*)(lnB + g * 128 + c0 + q * 8 + 4);
                  const float gg[8] = {g0[0], g0[1], g0[2], g0[3], g1[0], g1[1], g1[2], g1[3]}, bb[8] = {b0[0], b0[1], b0[2], b0[3], b1[0], b1[1], b1[2], b1[3]};
#pragma unroll
                  for (int e = 0; e < 8; ++e) { const int c = c0 + q * 8 + e; const float a_ = rstd * gg[e]; vnT[c * 136 + s] = f2bf(f[e] * a_ + (bb[e] - mean * a_)); } } }
            __syncthreads();
            f32x4 acc[8];
#pragma unroll
            for (int i = 0; i < 8; ++i) acc[i] = (f32x4){0.f, 0.f, 0.f, 0.f};
#pragma unroll
            for (int ks = 0; ks < 4; ++ks) if (ks < nks) {
                u32x4 wp; wp.x = cvt_pk_bf16(wa[ks][0], wa[ks][1]); wp.y = cvt_pk_bf16(wa[ks][2], wa[ks][3]); wp.z = cvt_pk_bf16(wb[ks][0], wb[ks][1]); wp.w = cvt_pk_bf16(wb[ks][2], wb[ks][3]);
                const bf16x8 wfrag = __builtin_bit_cast(bf16x8, wp);
#pragma unroll
                for (int ct = 0; ct < 8; ++ct) { const bf16x8 vfrag = *(const bf16x8*)(vnT + (ct * 16 + fr) * 136 + ks * 32 + fq * 8);
                    acc[ct] = __builtin_amdgcn_mfma_f32_16x16x32_bf16(vfrag, wfrag, acc[ct], 0, 0, 0); }
            }
#pragma unroll
            for (int ct = 0; ct < 8; ++ct) { const int c = g * 128 + ct * 16 + fq * 4;
                const float uf[4] = {bflo(u2[ct].x), bfhi(u2[ct].x), bflo(u2[ct].y), bfhi(u2[ct].y)}, zf[4] = {bflo(z2[ct].x), bfhi(z2[ct].x), bflo(z2[ct].y), bfhi(z2[ct].y)};
                float o[4];
#pragma unroll
                for (int j = 0; j < 4; ++j) o[j] = uf[j] * (acc[ct][j] + bs) * siluf_(zf[j]);
                u32x2 w; w.x = cvt_pk_bf16(o[0], o[1]); w.y = cvt_pk_bf16(o[2], o[3]); *(u32x2*)(oalt ? oalt + ((size_t)item * 128 + trow) * DM + c : hr + 2048 + c) = w; }
        }
    }
    __syncthreads();
}

__device__ void phase_hgrn_pre(int l, unsigned char* smem, bool dry) {
    const Params p = load_params();
    float* LF = (float*)smem;
    bf16_t* IB = (bf16_t*)(LF + 64 * 132);
    bf16_t* KB = IB + 64 * 136;
    float* psum = (float*)(KB + 64 * 136);
    float* lbs = psum + 512;
    const int tid = opaque_tid();
    bf16_t* xtra = (l == 0) ? (bf16_t*)p.out : p.vf;
    __syncthreads();
    for (int e = tid; e < DM; e += 512) { float lb = 0.f; if (l == 1) { const float l0 = p.lb_logits[e], l1 = p.lb_logits[DM + e]; lb = __builtin_amdgcn_rcpf(1.0f + __expf(l0 - l1)); } lbs[e] = lb; }
    __syncthreads();
    const int t = tid >> 3, c0 = (tid & 7) * 16;
    const int cc = tid & 127, tq = tid >> 7;
    u32x4 nq0, nq1, nf0, nf1, ni0, ni1;
#define HP_ISSUE(it_) do { const int h_ = (it_) & 7, ch_ = ((it_) >> 3) & 63, b_ = (it_) >> 9; const bf16_t* hr_ = p.H + ((size_t)b_ * SEQ + ch_ * 64 + t) * LDC_H + h_ * 128 + c0; \
        nq0 = *(const u32x4*)hr_; nq1 = *(const u32x4*)(hr_ + 8); nf0 = *(const u32x4*)(hr_ + 1024); nf1 = *(const u32x4*)(hr_ + 1032); ni0 = *(const u32x4*)(hr_ + 2048); ni1 = *(const u32x4*)(hr_ + 2056); } while (0)
    if ((int)blockIdx.x < NB * 64 * 8) HP_ISSUE((int)blockIdx.x);
    for (int item = blockIdx.x; item < NB * 64 * 8; item += gridDim.x) {
        const int h = item & 7, ch = (item >> 3) & 63, b = item >> 9;
        const size_t r0 = (size_t)b * SEQ + ch * 64;
        bf16_t* hr = p.H + (r0 + t) * LDC_H + h * 128 + c0;
        float qv[16], kv[16];
        {
            const u32x4 q0 = nq0, q1 = nq1, f0 = nf0, f1 = nf1, i0 = ni0, i1 = ni1;
            if (item + (int)gridDim.x < NB * 64 * 8) HP_ISSUE(item + (int)gridDim.x);
            const unsigned qa[8] = {q0.x, q0.y, q0.z, q0.w, q1.x, q1.y, q1.z, q1.w}, fa[8] = {f0.x, f0.y, f0.z, f0.w, f1.x, f1.y, f1.z, f1.w};
            *(u32x4*)(IB + t * 136 + c0) = i0; *(u32x4*)(IB + t * 136 + c0 + 8) = i1;
            float lf[16];
#pragma unroll
            for (int e = 0; e < 8; ++e) {
                const float lb0 = lbs[h * 128 + c0 + 2 * e], lb1 = lbs[h * 128 + c0 + 2 * e + 1];
                qv[2 * e] = siluf_(bflo(qa[e])); qv[2 * e + 1] = siluf_(bfhi(qa[e]));
                const float g0 = lb0 + (1.0f - lb0) * sigmoidf_(bflo(fa[e])), g1 = lb1 + (1.0f - lb1) * sigmoidf_(bfhi(fa[e]));
                kv[2 * e] = 1.0f - g0; kv[2 * e + 1] = 1.0f - g1; lf[2 * e] = __logf(g0); lf[2 * e + 1] = __logf(g1); }
#pragma unroll
            for (int e = 0; e < 4; ++e) *(f32x4*)(LF + t * 132 + c0 + e * 4) = (f32x4){lf[e * 4], lf[e * 4 + 1], lf[e * 4 + 2], lf[e * 4 + 3]};
        }
        __syncthreads();
        { float run = 0.f;
#pragma unroll
          for (int e = 0; e < 16; ++e) { run += LF[(tq * 16 + e) * 132 + cc]; LF[(tq * 16 + e) * 132 + cc] = run; }
          psum[tq * 128 + cc] = run; }
        __syncthreads();
        {
            const int tqt = t >> 4;
            unsigned qo[8], ko[8];
#pragma unroll
            for (int e4 = 0; e4 < 4; ++e4) {
                const f32x4 p0 = *(const f32x4*)(psum + c0 + e4 * 4), p1 = *(const f32x4*)(psum + 128 + c0 + e4 * 4), p2 = *(const f32x4*)(psum + 256 + c0 + e4 * 4), p3 = *(const f32x4*)(psum + 384 + c0 + e4 * 4);
                const f32x4 bl = *(const f32x4*)(LF + t * 132 + c0 + e4 * 4);
                float q2[4], k2[4];
#pragma unroll
                for (int j = 0; j < 4; ++j) {
                    const float off = (tqt > 0 ? p0[j] : 0.f) + (tqt > 1 ? p1[j] : 0.f) + (tqt > 2 ? p2[j] : 0.f);
                    const float bmid = p0[j] + p1[j], bb = bl[j] + off;
                    q2[j] = qv[e4 * 4 + j] * __expf(bb - bmid); k2[j] = kv[e4 * 4 + j] * __expf(bmid - bb); }
                qo[e4 * 2] = cvt_pk_bf16(q2[0], q2[1]); qo[e4 * 2 + 1] = cvt_pk_bf16(q2[2], q2[3]); ko[e4 * 2] = cvt_pk_bf16(k2[0], k2[1]); ko[e4 * 2 + 1] = cvt_pk_bf16(k2[2], k2[3]);
                if (t == 0) { f32x4 e1, e3;
#pragma unroll
                    for (int j = 0; j < 4; ++j) { e1[j] = __expf(p0[j] + p1[j]); e3[j] = __expf(p2[j] + p3[j]); }
                    float* gs = p.rkbuf + (size_t)(((b * 64 + ch) * 8 + h)) * 256 + c0 + e4 * 4; *(f32x4*)gs = e1; *(f32x4*)(gs + 128) = e3; }
            }
            const u32x4 qw0 = {qo[0], qo[1], qo[2], qo[3]}, qw1 = {qo[4], qo[5], qo[6], qo[7]}, kw0 = {ko[0], ko[1], ko[2], ko[3]}, kw1 = {ko[4], ko[5], ko[6], ko[7]};
            if (!dry) { *(u32x4*)hr = qw0; *(u32x4*)(hr + 8) = qw1; *(u32x4*)(hr + 1024) = kw0; *(u32x4*)(hr + 1032) = kw1; }
            *(u32x4*)(KB + t * 136 + c0) = kw0; *(u32x4*)(KB + t * 136 + c0 + 8) = kw1;
        }
        __syncthreads();
        {
            unsigned iw[8], kw[8];
#pragma unroll
            for (int e = 0; e < 8; ++e) {
                iw[e] = (unsigned)IB[(tq * 16 + 2 * e) * 136 + cc] | ((unsigned)IB[(tq * 16 + 2 * e + 1) * 136 + cc] << 16);
                kw[e] = (unsigned)KB[(tq * 16 + 2 * e) * 136 + cc] | ((unsigned)KB[(tq * 16 + 2 * e + 1) * 136 + cc] << 16); }
            bf16_t* ir = p.H + (r0 + (cc >> 1)) * LDC_H + 2048 + h * 128 + (cc & 1) * 64 + tq * 16;
            if (!dry) { *(u32x4*)ir = (u32x4){iw[0], iw[1], iw[2], iw[3]}; *(u32x4*)(ir + 8) = (u32x4){iw[4], iw[5], iw[6], iw[7]}; }
            bf16_t* kr = xtra + (r0 + (cc >> 1)) * DM + h * 128 + (cc & 1) * 64 + tq * 16;
            *(u32x4*)kr = (u32x4){kw[0], kw[1], kw[2], kw[3]}; *(u32x4*)(kr + 8) = (u32x4){kw[4], kw[5], kw[6], kw[7]};
        }
        __syncthreads();
    }
}

struct HgSet { u32x4 r[7]; };
__device__ __forceinline__ void hg_issue(HgSet& R, const bf16_t* H, const bf16_t* xtra, const float* gsc, int b, int ch, int h, int vs, int tid) {
    const size_t r0 = (size_t)b * SEQ + (size_t)ch * 64;
    const int row = tid >> 4, wi = tid & 15;
#pragma unroll
    for (int j = 0; j < 2; ++j) { const int t = j * 32 + row; R.r[j] = *(const u32x4*)(H + (r0 + t) * LDC_H + h * 128 + wi * 8); R.r[2 + j] = *(const u32x4*)(H + (r0 + t) * LDC_H + 1024 + h * 128 + wi * 8); }
#pragma unroll
    for (int j = 0; j < 2; ++j) { const int kp = j * 32 + row; R.r[4 + j] = *(const u32x4*)(xtra + (r0 + kp) * DM + h * 128 + wi * 8); }
    const u32x4 z4 = {0u, 0u, 0u, 0u}; R.r[6] = z4;
    if (tid < 256) R.r[6] = *(const u32x4*)(H + (r0 + vs * 16 + row) * LDC_H + 2048 + h * 128 + wi * 8);
    else if (tid < 320) R.r[6] = *(const u32x4*)(gsc + (size_t)(((b * 64 + ch) * 8 + h)) * 256 + (tid - 256) * 4);
}
constexpr int HG_QM = 0, HG_KM = 16 * 65 * 16, HG_KT = 2 * 16 * 65 * 16, HG_IT = HG_KT + 8 * 129 * 16, HG_E = HG_IT + 8 * 33 * 16, HG_BUF = HG_E + 1024;
__device__ __forceinline__ void hg_stage(const HgSet& R, unsigned char* B, int tid) {
    const int row = tid >> 4, wi = tid & 15;
#pragma unroll
    for (int j = 0; j < 2; ++j) { const int t = j * 32 + row; *(u32x4*)(B + HG_QM + (wi * 65 + t) * 16) = R.r[j]; *(u32x4*)(B + HG_KM + (wi * 65 + t) * 16) = R.r[2 + j]; }
#pragma unroll
    for (int j = 0; j < 2; ++j) { const int k = (j * 32 + row) * 2 + (wi >> 3), sc = wi & 7; *(u32x4*)(B + HG_KT + (sc * 129 + k) * 16) = R.r[4 + j]; }
    if (tid < 256) { const int vv = row * 2 + (wi >> 3), sc = wi & 7; *(u32x4*)(B + HG_IT + (sc * 33 + vv) * 16) = R.r[6]; }
    else if (tid < 320) *(u32x4*)(B + HG_E + (tid - 256) * 16) = R.r[6];
}

__device__ void phase_hgrn_seq(int l, unsigned char* smem, bool dry) {
    const Params p = load_params();
    unsigned char* img = smem;
    bf16_t* att = (bf16_t*)(smem + 2 * HG_BUF);
    bf16_t* STs = att + 64 * 72;
    const int tid = opaque_tid(), w = __builtin_amdgcn_readfirstlane(tid >> 6), lane = tid & 63, fr = lane & 15, fq = lane >> 4;
    const bf16_t* xtra = (l == 0) ? (const bf16_t*)p.out : p.vf;
    const int tt_ = w >> 1, sp = w & 1;
    for (int item = blockIdx.x; item < NB * 32; item += gridDim.x) {
        const int xc_ = item & 7, sl_ = item >> 3, vs = sl_ & 3, gi_ = (sl_ >> 2) * 8 + xc_, h = gi_ & 7, b = gi_ >> 3;
        __syncthreads();
        for (int e = tid; e < 32 * 136 / 2; e += 512) ((unsigned*)STs)[e] = 0u;
        f32x4 S[2] = {{0.f, 0.f, 0.f, 0.f}, {0.f, 0.f, 0.f, 0.f}};
        u32x2 o0 = {0u, 0u};
        HgSet R0, R1;
        hg_issue(R0, p.H, xtra, p.rkbuf, b, 0, h, vs, tid); hg_stage(R0, img, tid);
        hg_issue(R1, p.H, xtra, p.rkbuf, b, 1, h, vs, tid); hg_issue(R0, p.H, xtra, p.rkbuf, b, 2, h, vs, tid);
        __syncthreads();
        auto iter = [&](const int ch, HgSet& RS) {
            const size_t r0 = (size_t)b * SEQ + (size_t)ch * 64;
            const unsigned char* B = img + (ch & 1) * HG_BUF; unsigned char* Bn = img + ((ch + 1) & 1) * HG_BUF;
            bf16x8 qf[4];
#pragma unroll
            for (int ks = 0; ks < 4; ++ks) qf[ks] = *(const bf16x8*)(B + HG_QM + ((ks * 4 + fq) * 65 + tt_ * 16 + fr) * 16);
#pragma unroll
            for (int q = 0; q < 2; ++q) { const int stile = sp * 2 + q; f32x4 a = {0.f, 0.f, 0.f, 0.f};
                if (stile <= tt_) {
#pragma unroll
                    for (int ks = 0; ks < 4; ++ks) { const bf16x8 kf = *(const bf16x8*)(B + HG_KM + ((ks * 4 + fq) * 65 + stile * 16 + fr) * 16); a = __builtin_amdgcn_mfma_f32_16x16x32_bf16(qf[ks], kf, a, 0, 0, 0); } }
#pragma unroll
                for (int j = 0; j < 4; ++j) { const int t = tt_ * 16 + fq * 4 + j, s = stile * 16 + fr; att[t * 72 + s] = f2bf(s <= t ? a[j] : 0.f); } }
            if (ch + 1 < 64) hg_stage(RS, Bn, tid);
            if (ch + 3 < 64) hg_issue(RS, p.H, xtra, p.rkbuf, b, ch + 3, h, vs, tid);
            __syncthreads();
            f32x4 o = {0.f, 0.f, 0.f, 0.f};
#pragma unroll
            for (int ks = 0; ks < 2; ++ks) { const bf16x8 af = *(const bf16x8*)(att + (tt_ * 16 + fr) * 72 + ks * 32 + fq * 8); const bf16x8 itf = *(const bf16x8*)(B + HG_IT + ((ks * 4 + fq) * 33 + sp * 16 + fr) * 16);
                o = __builtin_amdgcn_mfma_f32_16x16x32_bf16(itf, af, o, 0, 0, 0); }
#pragma unroll
            for (int ks = 0; ks < 4; ++ks) { const bf16x8 sf = *(const bf16x8*)(STs + (sp * 16 + fr) * 136 + ks * 32 + fq * 8);
                o = __builtin_amdgcn_mfma_f32_16x16x32_bf16(sf, qf[ks], o, 0, 0, 0); }
            { u32x2 ow; ow.x = cvt_pk_bf16(o[0], o[1]); ow.y = cvt_pk_bf16(o[2], o[3]);
              if (ch == 0) o0 = ow;
              else if (!dry) { const int t = tt_ * 16 + fr; *(u32x2*)(p.H + (r0 - 64 + vs * 16 + (t >> 2)) * LDC_H + 2048 + h * 128 + (t & 3) * 32 + sp * 16 + fq * 4) = ow; } }
            const f32x4 e1 = *(const f32x4*)(B + HG_E + (w * 16 + fq * 4) * 4), e3 = *(const f32x4*)(B + HG_E + 512 + (w * 16 + fq * 4) * 4);
            bf16x8 ktf[2];
#pragma unroll
            for (int ks = 0; ks < 2; ++ks) ktf[ks] = *(const bf16x8*)(B + HG_KT + ((ks * 4 + fq) * 129 + w * 16 + fr) * 16);
#pragma unroll
            for (int vt = 0; vt < 2; ++vt) { f32x4 u = {0.f, 0.f, 0.f, 0.f};
#pragma unroll
                for (int ks = 0; ks < 2; ++ks) { const bf16x8 itf = *(const bf16x8*)(B + HG_IT + ((ks * 4 + fq) * 33 + vt * 16 + fr) * 16); u = __builtin_amdgcn_mfma_f32_16x16x32_bf16(ktf[ks], itf, u, 0, 0, 0); }
#pragma unroll
                for (int j = 0; j < 4; ++j) S[vt][j] = e3[j] * (e1[j] * S[vt][j] + u[j]); }
            __syncthreads();
            if (ch + 1 < 64) { const f32x4 e1n = *(const f32x4*)(Bn + HG_E + (w * 16 + fq * 4) * 4);
#pragma unroll
                for (int vt = 0; vt < 2; ++vt) { u32x2 sw; sw.x = cvt_pk_bf16(S[vt][0] * e1n[0], S[vt][1] * e1n[1]); sw.y = cvt_pk_bf16(S[vt][2] * e1n[2], S[vt][3] * e1n[3]);
                    *(u32x2*)(STs + (vt * 16 + fr) * 136 + w * 16 + fq * 4) = sw; } }
        };
        for (int ch = 0; ch < 64; ch += 2) { iter(ch, R1); iter(ch + 1, R0); }
        if (!dry) { const int t = tt_ * 16 + fr; *(u32x2*)(p.H + ((size_t)b * SEQ + 63 * 64 + vs * 16 + (t >> 2)) * LDC_H + 2048 + h * 128 + (t & 3) * 32 + sp * 16 + fq * 4) = o0; }
    }
    __syncthreads();
}

__device__ void phase_hgrn_post(int l) {
    const Params p = load_params();
    const int tid = opaque_tid(), l8 = tid & 7;
    const int ngrp = T_TOK * 8;
    for (int g = blockIdx.x * 64 + (tid >> 3); g < ngrp; g += gridDim.x * 64) {
        const int tok = g >> 3, h = g & 7, b = tok / SEQ, tin = tok % SEQ, ch = tin >> 6, t = tin & 63, slot = (ch + 63) & 63, vs = l8 >> 1, vv0 = (l8 & 1) * 16;
        const bf16_t* op = p.H + ((size_t)b * SEQ + slot * 64 + vs * 16 + (t >> 2)) * LDC_H + 2048 + h * 128 + (t & 3) * 32 + vv0;
        bf16_t* zp = p.H + (size_t)tok * LDC_H + 3072 + h * 128 + l8 * 16;
        const u32x4 a0 = *(const u32x4*)op, a1 = *(const u32x4*)(op + 8), z0 = *(const u32x4*)zp, z1 = *(const u32x4*)(zp + 8);
        const float ov[16] = {bflo(a0.x), bfhi(a0.x), bflo(a0.y), bfhi(a0.y), bflo(a0.z), bfhi(a0.z), bflo(a0.w), bfhi(a0.w), bflo(a1.x), bfhi(a1.x), bflo(a1.y), bfhi(a1.y), bflo(a1.z), bfhi(a1.z), bflo(a1.w), bfhi(a1.w)};
        const float zf[16] = {bflo(z0.x), bfhi(z0.x), bflo(z0.y), bfhi(z0.y), bflo(z0.z), bfhi(z0.z), bflo(z0.w), bfhi(z0.w), bflo(z1.x), bfhi(z1.x), bflo(z1.y), bfhi(z1.y), bflo(z1.z), bfhi(z1.z), bflo(z1.w), bfhi(z1.w)};
        float ss = 0.f;
#pragma unroll
        for (int e = 0; e < 16; ++e) ss += ov[e] * ov[e];
        ss = red8(ss); const float rinv = rsqrtf(ss * (1.0f / 128.f) + EPS);
        const float* gn = p.hgrn_g + (size_t)l * DM + h * 128 + l8 * 16;
        float r[16];
#pragma unroll
        for (int e = 0; e < 16; ++e) r[e] = ov[e] * rinv * gn[e] * siluf_(zf[e]);
        u32x4 w0, w1; w0.x = cvt_pk_bf16(r[0], r[1]); w0.y = cvt_pk_bf16(r[2], r[3]); w0.z = cvt_pk_bf16(r[4], r[5]); w0.w = cvt_pk_bf16(r[6], r[7]);
        w1.x = cvt_pk_bf16(r[8], r[9]); w1.y = cvt_pk_bf16(r[10], r[11]); w1.z = cvt_pk_bf16(r[12], r[13]); w1.w = cvt_pk_bf16(r[14], r[15]);
        *(u32x4*)zp = w0; *(u32x4*)(zp + 8) = w1;
    }
}


#define XB_TMO      128
#define XB_XCNT(j)  (256  + 64 * (j))
#define XB_XSUB(j)  (1280 + 64 * (j))
#define XB_XGEN(j)  (2304 + 64 * (j))
#define XB_TOP      3328
#define XB_TOPGEN   3392
#define XCD_BAR_WORDS 3456
#define XB_SPIN_CAP (1u << 18)
__device__ __forceinline__ unsigned xb_ld(unsigned* p)              { return __hip_atomic_load(p, __ATOMIC_RELAXED, __HIP_MEMORY_SCOPE_AGENT); }
__device__ __forceinline__ unsigned xb_add(unsigned* p, unsigned v) { return __hip_atomic_fetch_add(p, v, __ATOMIC_RELAXED, __HIP_MEMORY_SCOPE_AGENT); }
__device__ __forceinline__ unsigned xb_xcc_id() { return (unsigned)__builtin_amdgcn_s_getreg((3 << 11) | 20) & 0xFu; }
#define XB_SPIN(cond, bar) do { unsigned _sp = 0; while (cond) { __builtin_amdgcn_s_sleep(1); \
    if ((++_sp & 255u) == 0u) { if (xb_ld(&(bar)[XB_TMO])) break; if (_sp > XB_SPIN_CAP) { atomicAdd(&(bar)[XB_TMO], 1u); break; } } } } while (0)
struct XcdBarrier { unsigned* bar; unsigned x; volatile LAS unsigned* st; };
__device__ __forceinline__ XcdBarrier xcd_barrier_post(unsigned* bar, volatile LAS unsigned* st) {
    XcdBarrier b; b.bar = bar; b.x = xb_xcc_id(); b.st = st;
    if (threadIdx.x == 0) (void)xb_add(&bar[XB_XCNT(b.x)], 1u);
    return b;
}
__device__ __forceinline__ void xcd_barrier_complete(unsigned* bar, unsigned x, unsigned& nloc, unsigned& nx) {
    const unsigned G = gridDim.x * gridDim.y * gridDim.z;
    unsigned sum, cnt, mine, sp = 0u;
    for (;;) {
        sum = 0u; cnt = 0u; mine = 0u;
#pragma unroll
        for (unsigned j = 0; j < 16; ++j) { const unsigned c = xb_ld(&bar[XB_XCNT(j)]); sum += c; cnt += (c > 0u) ? 1u : 0u; mine = (j == x) ? c : mine; }
        if (sum == G) break;
        __builtin_amdgcn_s_sleep(1);
        if ((++sp & 255u) == 0u) { if (xb_ld(&bar[XB_TMO])) break; if (sp > XB_SPIN_CAP) { atomicAdd(&bar[XB_TMO], 1u); break; } }
    }
    nloc = mine > 0u ? mine : 1u; nx = cnt > 0u ? cnt : 1u;
}
__device__ __forceinline__ void xcd_barrier(const XcdBarrier& b) {
    asm volatile("s_waitcnt vmcnt(0)" ::: "memory");
    __syncthreads();
    if (threadIdx.x == 0) {
        unsigned* bar = b.bar;
        __builtin_amdgcn_s_waitcnt(0);
        unsigned nloc = b.st[0], nx = b.st[1];
        if (nloc == 0u) { xcd_barrier_complete(bar, b.x, nloc, nx); b.st[0] = nloc; b.st[1] = nx; }
        const unsigned old = xb_add(&bar[XB_XSUB(b.x)], 1u);
        const unsigned gen = old / nloc;
        if (old + 1u == (gen + 1u) * nloc) {
            __builtin_amdgcn_fence(__ATOMIC_RELEASE, "agent");
            asm volatile("s_waitcnt vmcnt(0)" ::: "memory");
            const unsigned og = xb_add(&bar[XB_TOP], 1u);
            const unsigned tg = og / nx;
            if (og + 1u == (tg + 1u) * nx) xb_add(&bar[XB_TOPGEN], 1u);
            else XB_SPIN(xb_ld(&bar[XB_TOPGEN]) == tg, bar);
            __builtin_amdgcn_fence(__ATOMIC_ACQUIRE, "agent");
            xb_add(&bar[XB_XGEN(b.x)], 1u);
            asm volatile("s_waitcnt vmcnt(0)" ::: "memory");
        } else {
            XB_SPIN(xb_ld(&bar[XB_XGEN(b.x)]) == gen, bar);
            __builtin_amdgcn_fence(__ATOMIC_ACQUIRE, "agent");
            asm volatile("s_waitcnt vmcnt(0)" ::: "memory");
        }
    }
    __syncthreads();
}

constexpr int PH_PER_LAYER = 14, N_PHASES = 2 * PH_PER_LAYER + 1;

__global__ void __launch_bounds__(512, 2) fwd_megakernel(Params pk) {
    extern __shared__ __attribute__((aligned(16))) unsigned char shm[];
    LAS unsigned char* lds = (LAS unsigned char*)shm;
    cg::grid_group grid = cg::this_grid();
    const int phase_lo = pk.phase_lo, phase_hi = pk.phase_hi;
    volatile LAS unsigned* xst = (volatile LAS unsigned*)(lds + LDS_BYTES - 16);
    XcdBarrier xb; xb.bar = pk.bar; xb.x = 0; xb.st = xst;
    if (phase_hi - phase_lo > 1) { if (threadIdx.x == 0) { xst[0] = 0u; xst[1] = 0u; } __syncthreads(); xb = xcd_barrier_post(pk.bar, xst); }
    for (int ph = phase_lo; ph < phase_hi; ++ph) {
        const int l = ph / PH_PER_LAYER, q = ph % PH_PER_LAYER;
        if (ph == N_PHASES - 1) {
            const Params p = load_params();
            phase_rmsnorm(p.out, p.final_g, nullptr, p.out);
        } else if (q == 0) {
            { const int nrep = (PROBE_Q == 0 && l == 0) ? 2 : 1; for (int rep = 0; rep < nrep; ++rep) {
            phase_convert(l, shm);
            const Params p = load_params();
            phase_rmsnorm(l == 0 ? p.x : p.out, p.norm_g + (size_t)l * DM, p.xn, nullptr); } }
        } else if (q == 1 || q == 5 || q == 8) {
            const Params p = load_params(); const int G = gridDim.x, cidx = opaque_bid();
            const int N = (q == 1) ? LDA_H : (q == 5) ? LDB_H : LDC_H; const int r0 = (q == 1) ? 0 : (q == 5) ? LDA_H : (LDA_H + LDB_H);
            pg8::GemmDesc g; g.A = p.xn; g.Bt = p.Wt + (size_t)r0 * DM; g.lda = DM;
            pg8::Sched S; S.init(T_TOK, N, G, cidx, 1);
            pg8::EpiStore E; E.O = p.H; E.ldc = N;
{ const int nrep = ((PROBE_Q == 1 && l == 0 && q == 1) || (PROBE_Q == 50 && l == 0 && q == 5) || (PROBE_Q == 80 && l == 0 && q == 8)) ? 2 : 1; for (int rep = 0; rep < nrep; ++rep) pg8::gemm_phase(lds, g, g, S, E); }
        } else if (q == 2) {
{ const int nrep = (PROBE_Q == 2 && l == 0) ? 2 : 1; for (int rep = 0; rep < nrep; ++rep) phase_rwkv(l, shm, rep + 1 < nrep ? PROBE_MODE : 0); }
        } else if (q == 3) {
            phase_rwkv_post(l, nullptr);
        } else if (q == 6) {
{ const int nrep = (PROBE_Q == 6 && l == 0) ? 2 : 1; for (int rep = 0; rep < nrep; ++rep) { const Params p = load_params(); phase_sgu(l, shm, rep + 1 < nrep ? (bf16_t*)p.out : nullptr); } }
        } else if (q == 9) {
            { const int nrep = (PROBE_Q == 9 && l == 0) ? 2 : 1; for (int rep = 0; rep < nrep; ++rep) phase_hgrn_pre(l, shm, rep + 1 < nrep); }
        } else if (q == 10) {
            { const int nrep = (PROBE_Q == 10 && l == 0) ? 2 : 1; for (int rep = 0; rep < nrep; ++rep) phase_hgrn_seq(l, shm, rep + 1 < nrep); }
        } else if (q == 11) {
            phase_hgrn_post(l);
        } else if (q == 4 || q == 7 || q == 12) {
            const Params p = load_params(); const int G = gridDim.x, cidx = opaque_bid();
            bf16_t* WtBr = p.Wt + (size_t)WT_ROWS * DM;
            const int n = (q == 4) ? 0 : (q == 7) ? 1 : 2; const int ldh = (n == 0) ? LDA_H : (n == 1) ? LDB_H : LDC_H; const int ocol = (n == 0) ? 3200 : (n == 1) ? 2048 : 3072;
            pg8::GemmDesc g0, g1; g0.A = p.xn; g0.Bt = p.Wt + (size_t)(LDA_H + LDB_H + LDC_H + n * DM) * DM; g0.lda = DM;
            g1.A = p.H + ocol; g1.Bt = WtBr + (size_t)n * DM * DM; g1.lda = ldh;
            pg8::Sched S; S.init(T_TOK, DM, G, cidx, 2);
            pg8::EpiMerge E; E.G = p.H; E.ldg = ldh; E.bias = p.b_merge + ((size_t)l * 3 + n) * DM; E.Y = p.y; E.accum = (n > 0);
            { const int nrep = (PROBE_Q == 4 && l == 0 && q == 4) ? 2 : 1; for (int rep = 0; rep < nrep; ++rep) pg8::gemm_phase(lds, g0, g1, S, E); }
        } else {
            const Params p = load_params(); const int G = gridDim.x, cidx = opaque_bid();
            bf16_t* WtOut = p.Wt + (size_t)WT_ROWS * DM + (size_t)3 * DM * DM;
            pg8::GemmDesc g; g.A = p.y; g.Bt = WtOut; g.lda = DM;
            pg8::Sched S; S.init(T_TOK, DM, G, cidx, 1);
            pg8::EpiResid E; E.Xin = (l == 0) ? p.x : p.out; E.Xout = p.out;
            { const int nrep = (PROBE_Q == 13 && l == 0) ? 2 : 1; for (int rep = 0; rep < nrep; ++rep) pg8::gemm_phase(lds, g, g, S, E); }
        }
        if (ph + 1 < phase_hi) { if (ph == phase_lo) grid.sync(); else xcd_barrier(xb); }
    }
}

extern "C" void kernel_launch(void* const* d_in, const int* in_sizes, int n_in, void* d_out, int out_size, void* d_ws, size_t ws_size, hipStream_t stream) {
    static int grid_blocks = 0;
    if (!grid_blocks) {
        int dev = 0, cus = 0, per_cu = 0;
        hipGetDevice(&dev);
        hipDeviceGetAttribute(&cus, hipDeviceAttributeMultiprocessorCount, dev);
        if (hipFuncSetAttribute((const void*)fwd_megakernel, hipFuncAttributeMaxDynamicSharedMemorySize, LDS_BYTES) != hipSuccess) { fprintf(stderr, "hipFuncSetAttribute failed\n"); return; }
        hipOccupancyMaxActiveBlocksPerMultiprocessor(&per_cu, (const void*)fwd_megakernel, 512, LDS_BYTES);
        if (per_cu < 1) { fprintf(stderr, "occupancy query says 0 blocks per CU\n"); return; }
        grid_blocks = cus * 1;
    }
    Params p{};
    const float** fp = (const float**)&p;
    for (int i = 0; i < 26; ++i) fp[i] = (const float*)d_in[i];
    p.out = (float*)d_out;
    unsigned char* ws = (unsigned char*)d_ws; size_t off = 0;
    auto take = [&](size_t bytes) { unsigned char* r = ws + off; off += (bytes + 255) & ~(size_t)255; return r; };
    p.Wt = (bf16_t*)take(((size_t)WT_ROWS * DM + 4 * (size_t)DM * DM) * 2);
    p.xn = (bf16_t*)take((size_t)T_TOK * DM * 2);
    p.vf = (bf16_t*)take((size_t)T_TOK * DM * 2);
    p.y = (bf16_t*)take((size_t)T_TOK * DM * 2);
    p.H = (bf16_t*)take((size_t)T_TOK * LDA_H * 2);
    p.rkbuf = (float*)take((size_t)T_TOK * 16 * 2 * 4);
    p.bar = (unsigned*)take((size_t)XCD_BAR_WORDS * 4);
    if (off > ws_size) { fprintf(stderr, "workspace too small: need %zu have %zu\n", off, ws_size); return; }
#if SINGLE_LAUNCH
    p.phase_lo = 0; p.phase_hi = N_PHASES;
    void* args[] = {&p};
    if (hipMemsetAsync(p.bar, 0, (size_t)XCD_BAR_WORDS * 4, stream) != hipSuccess) { fprintf(stderr, "memset failed\n"); return; }
    hipError_t e = hipLaunchCooperativeKernel((const void*)fwd_megakernel, dim3(grid_blocks), dim3(512), args, LDS_BYTES, stream);
    if (e != hipSuccess) fprintf(stderr, "cooperative launch failed: %s (grid %d)\n", hipGetErrorString(e), grid_blocks);
#else
    for (int ph = 0; ph < N_PHASES; ++ph) {
        p.phase_lo = ph; p.phase_hi = ph + 1;
        hipLaunchKernelGGL(fwd_megakernel, dim3(grid_blocks), dim3(512), LDS_BYTES, stream, p);
    }
#endif
}
```

```cpp
#include <hip/hip_runtime.h>
#include <hip/hip_cooperative_groups.h>
#include <cstdio>
namespace cg = cooperative_groups;

#ifndef PROBE_MODE
#define PROBE_MODE 0
#endif
#ifndef PROBE_Q
#define PROBE_Q -1
#endif
#ifndef SINGLE_LAUNCH
#define SINGLE_LAUNCH 1
#endif

typedef unsigned short bf16_t;
typedef short bf16x8 __attribute__((ext_vector_type(8)));
typedef float f32x4 __attribute__((ext_vector_type(4)));
typedef float f32x2 __attribute__((ext_vector_type(2)));
typedef unsigned u32x4 __attribute__((ext_vector_type(4)));
typedef unsigned u32x2 __attribute__((ext_vector_type(2)));
#define LAS __attribute__((address_space(3)))

constexpr int T_TOK = 32768, DM = 1024, SEQ = 4096, NB = 8;
constexpr int N_IN = 14464;
constexpr int LDA_H = 4352, LDB_H = 3072, LDC_H = 4096;
constexpr int WT_ROWS = 14592;
constexpr int LDS_BYTES = 163840;
constexpr float EPS = 1e-6f, GN_EPS = 64e-5f;

struct Params {
    const float *x, *norm_g, *w_in, *b_merge, *mu, *w0, *w_w2, *a0, *a_w2, *v0, *v_w1, *v_w2, *k_k, *k_a, *r_k, *lnx_g, *lnx_b,
        *sgu_ln_g, *sgu_ln_b, *sgu_w, *sgu_b, *lb_logits, *hgrn_g, *w_branch, *w_out, *final_g;
    float* out;
    bf16_t *Wt, *xn, *vf, *y, *H;
    float* rkbuf;
    unsigned* bar;
    int phase_lo, phase_hi;
};

__device__ __forceinline__ float bf2f(bf16_t h) { return __uint_as_float(((unsigned)h) << 16); }
__device__ __forceinline__ float bflo(unsigned u) { return __uint_as_float(u << 16); }
__device__ __forceinline__ float bfhi(unsigned u) { return __uint_as_float(u & 0xffff0000u); }
typedef __bf16 bf16x2_t __attribute__((ext_vector_type(2)));
__device__ __forceinline__ unsigned cvt_pk_bf16(float lo, float hi) { const f32x2 v = {lo, hi}; const bf16x2_t r = __builtin_convertvector(v, bf16x2_t); return __builtin_bit_cast(unsigned, r); }
__device__ __forceinline__ bf16_t f2bf(float f) { return (bf16_t)(cvt_pk_bf16(f, 0.f) & 0xffffu); }
__device__ __forceinline__ float sigmoidf_(float x) { return __builtin_amdgcn_rcpf(1.0f + __expf(-x)); }
__device__ __forceinline__ float siluf_(float x) { return x * __builtin_amdgcn_rcpf(1.0f + __expf(-x)); }
__device__ __forceinline__ float tanh_fast(float x) { return 1.0f - 2.0f * __builtin_amdgcn_rcpf(1.0f + __expf(2.0f * x)); }

__device__ __forceinline__ Params load_params() {
#if defined(__HIP_DEVICE_COMPILE__)
    typedef const Params __attribute__((address_space(4)))* KP;
    KP kp = (KP)__builtin_amdgcn_kernarg_segment_ptr(); asm volatile("" : "+s"(kp)); return *kp;
#else
    return Params{};
#endif
}
__device__ __forceinline__ int opaque_tid() { int t = threadIdx.x; asm volatile("" : "+v"(t)); return t; }
__device__ __forceinline__ int opaque_bid() { int t = blockIdx.x; asm volatile("" : "+s"(t)); return t; }

namespace pg8 {
constexpr int BM = 256, BK = 64, HALF = 128, HTB = HALF * BK * 2, STAGE_BYTES = 8 * HTB, NXCD = 8, WGM = 8, KD = 1024;
__device__ __forceinline__ int lds_byte(int r, int c) { const int st = (r >> 4) * 2 + (c >> 5), rr = r & 15, cc = c & 31, ob = rr * 64 + cc * 2; return st * 1024 + (ob ^ (((ob >> 9) & 1) << 5)); }
__device__ __forceinline__ void stage_rc(int b, int& R, int& C) { const int st = b / 1024, sb = b % 1024, swz = sb ^ (((sb >> 9) & 1) << 5); R = (st >> 1) * 16 + swz / 64; C = (st & 1) * 32 + (swz % 64) / 2; }
__device__ __forceinline__ int perm32(int rho) { const int n = rho >> 4, i = rho & 15; return 8 * (i >> 2) + 4 * n + (i & 3); }

struct Unit { int pm, pn, sel; };
struct GemmDesc { const bf16_t* A; const bf16_t* Bt; int lda; };
struct Sched {
    int nM, nN, nwg, G, c, nsel;
    __device__ void init(int M, int N, int G_, int c_, int nsel_) { nM = M / BM; nN = N / BM; nwg = nM * nN; G = G_; c = c_; nsel = nsel_; }
    __device__ bool next(int i, Unit& u) const {
        const int ti = (nsel == 2) ? (i >> 1) : i; u.sel = (nsel == 2) ? (i & 1) : 0;
        const long L = (long)ti * G + c; if (L >= nwg) return false;
        int wgid = (int)L; { const int q = nwg / NXCD, r = nwg % NXCD, xcd = wgid % NXCD, off = wgid / NXCD; wgid = (xcd < r ? xcd * (q + 1) : r * (q + 1) + (xcd - r) * q) + off; }
        const int nig = WGM * nN, gid = wgid / nig, fm = gid * WGM, gsz = (nM - fm) < WGM ? (nM - fm) : WGM;
        u.pm = fm + ((wgid % nig) % gsz); u.pn = (wgid % nig) / gsz; return true;
    }
};

template <class Epi>
__device__ __forceinline__ void gemm_phase(LAS unsigned char* lds, const GemmDesc g0, const GemmDesc g1, const Sched& S, const Epi& E) {
    const int tid = opaque_tid(), wid = __builtin_amdgcn_readfirstlane(tid >> 6), lane = tid & 63, wr = wid >> 2, wc = wid & 3, fr = lane & 15, fq = lane >> 4;
    constexpr int K = KD, nt = K / BK;
    unsigned voffA0[2], voffA1[2], voffB[2];
#pragma unroll
    for (int i = 0; i < 2; ++i) { int R, C; stage_rc(tid * 16 + i * 8192, R, C); const int Rb = Epi::PERM ? ((R & ~31) + perm32(R & 31)) : R;
        voffA0[i] = (unsigned)(R * g0.lda + C) * 2u; voffA1[i] = (unsigned)(R * g1.lda + C) * 2u; voffB[i] = (unsigned)(Rb * K + C) * 2u; }
    const size_t kstep = (size_t)(BK * 2);
    const size_t hstepB = (size_t)HALF * K * 2;
    const unsigned ldsw = (unsigned)wid * 1024u;
    const int aoff = lds_byte(wr * 64 + fr, fq * 8), boff = lds_byte(wc * 32 + fr, fq * 8);
#define PG8_SA(b, h) (((b) * 2 + (h)) * HTB)
#define PG8_SB(b, h) ((4 + (b) * 2 + (h)) * HTB)
#define PG8_STAGE(bufoff, gbase, v0, v1) do { \
        __builtin_amdgcn_global_load_lds((const unsigned*)((const char*)(gbase) + (v0)), (LAS unsigned*)(lds + (bufoff) + ldsw), 16, 0, 0); \
        __builtin_amdgcn_global_load_lds((const unsigned*)((const char*)(gbase) + (v1)), (LAS unsigned*)(lds + (bufoff) + ldsw + 8192), 16, 0, 0); } while (0)
#define PG8_STAGEB(bufoff, gbase) PG8_STAGE(bufoff, gbase, voffB[0], voffB[1])
#define PG8_LDA(dst, b, h) do { _Pragma("unroll") for (int m = 0; m < 4; ++m) _Pragma("unroll") for (int k = 0; k < 2; ++k) dst[m][k] = *(const LAS bf16x8*)(lds + PG8_SA(b, h) + aoff + m * 2048 + k * 1024); } while (0)
#define PG8_LDB(dst, b, h) do { _Pragma("unroll") for (int n = 0; n < 2; ++n) _Pragma("unroll") for (int k = 0; k < 2; ++k) dst[n][k] = *(const LAS bf16x8*)(lds + PG8_SB(b, h) + boff + n * 2048 + k * 1024); } while (0)
#define PG8_MMA(ai, bj, At, Bt) do { __builtin_amdgcn_s_setprio(1); _Pragma("unroll") for (int m = 0; m < 4; ++m) _Pragma("unroll") for (int n = 0; n < 2; ++n) _Pragma("unroll") for (int k = 0; k < 2; ++k) \
        acc[ai][bj][m][n] = __builtin_amdgcn_mfma_f32_16x16x32_bf16(Bt[n][k], At[m][k], acc[ai][bj][m][n], 0, 0, 0); __builtin_amdgcn_s_setprio(0); } while (0)
#define PG8_WAIT_V(n) asm volatile("s_waitcnt vmcnt(" #n ")" ::: "memory")
#define PG8_WAIT_L(n) asm volatile("s_waitcnt lgkmcnt(" #n ")" ::: "memory")
#define PG8_BAR __builtin_amdgcn_s_barrier()
#define PG8_SCHED __builtin_amdgcn_sched_barrier(0)
    Unit cur, nxt; int ui = 0;
    if (!S.next(0, cur)) return;
    f32x4 acc[2][2][4][2];
#pragma unroll
    for (int a = 0; a < 2; ++a)
#pragma unroll
        for (int b = 0; b < 2; ++b)
#pragma unroll
            for (int m = 0; m < 4; ++m)
#pragma unroll
                for (int n = 0; n < 2; ++n) acc[a][b][m][n] = (f32x4){0.f, 0.f, 0.f, 0.f};
    bf16x8 At[4][2], B0[2][2], B1[2][2];
    const char* cA = (const char*)(cur.sel ? g1.A : g0.A) + (size_t)cur.pm * 256 * (size_t)(cur.sel ? g1.lda : g0.lda) * 2;
    const char* cB = (const char*)(cur.sel ? g1.Bt : g0.Bt) + (size_t)cur.pn * 256 * K * 2;
    size_t chA = (size_t)HALF * (cur.sel ? g1.lda : g0.lda) * 2;
    unsigned cv0 = cur.sel ? voffA1[0] : voffA0[0], cv1 = cur.sel ? voffA1[1] : voffA0[1];
    PG8_STAGEB(PG8_SB(0, 0), cB); PG8_STAGEB(PG8_SB(0, 1), cB + hstepB); PG8_STAGE(PG8_SA(0, 0), cA, cv0, cv1); PG8_STAGE(PG8_SA(0, 1), cA + chA, cv0, cv1);
    if (wr == 1) PG8_BAR;
    PG8_WAIT_V(2); PG8_BAR;
    PG8_STAGEB(PG8_SB(1, 0), cB + kstep); PG8_STAGE(PG8_SA(1, 0), cA + kstep, cv0, cv1); PG8_STAGEB(PG8_SB(1, 1), cB + hstepB + kstep);
    PG8_WAIT_V(6); PG8_BAR;
    for (;;) {
        const bool has_next = S.next(ui + 1, nxt);
        const int nsel = has_next ? nxt.sel : cur.sel;
        const char* nA = has_next ? (const char*)(nsel ? g1.A : g0.A) + (size_t)nxt.pm * 256 * (size_t)(nsel ? g1.lda : g0.lda) * 2 : cA;
        const char* nB = has_next ? (const char*)(nsel ? g1.Bt : g0.Bt) + (size_t)nxt.pn * 256 * K * 2 : cB;
        const size_t nhA = (size_t)HALF * (nsel ? g1.lda : g0.lda) * 2;
        const unsigned nv0 = nsel ? voffA1[0] : voffA0[0], nv1 = nsel ? voffA1[1] : voffA0[1];
        for (int t = 0; t < nt; t += 2) {
            const bool last = (t == nt - 2);
            const char* a1 = cA + (size_t)(t + 1) * kstep;
            const char* a2 = last ? nA : cA + (size_t)(t + 2) * kstep; const char* b2 = last ? nB : cB + (size_t)(t + 2) * kstep;
            const char* a3 = a2 + kstep; const char* b3 = b2 + kstep;
            const size_t h2 = last ? nhA : chA; const unsigned w0 = last ? nv0 : cv0, w1 = last ? nv1 : cv1;
            PG8_LDB(B0, 0, 0); PG8_LDB(B1, 0, 1); PG8_SCHED; PG8_LDA(At, 0, 0); PG8_STAGE(PG8_SA(1, 1), a1 + chA, cv0, cv1);
            PG8_WAIT_V(8); PG8_WAIT_L(0); PG8_BAR; PG8_MMA(0, 0, At, B0); PG8_MMA(0, 1, At, B1); PG8_BAR; PG8_SCHED;
            PG8_LDA(At, 0, 1); PG8_STAGEB(PG8_SB(0, 0), b2); PG8_STAGEB(PG8_SB(0, 1), b2 + hstepB); PG8_STAGE(PG8_SA(0, 0), a2, w0, w1);
            PG8_WAIT_V(8); PG8_WAIT_L(0); PG8_BAR; PG8_MMA(1, 0, At, B0); PG8_MMA(1, 1, At, B1); PG8_BAR; PG8_SCHED;
            PG8_LDB(B0, 1, 0); PG8_LDB(B1, 1, 1); PG8_SCHED; PG8_LDA(At, 1, 0); PG8_STAGE(PG8_SA(0, 1), a2 + h2, w0, w1);
            PG8_WAIT_V(8); PG8_WAIT_L(0); PG8_BAR; PG8_MMA(0, 0, At, B0); PG8_MMA(0, 1, At, B1); PG8_BAR; PG8_SCHED;
            PG8_LDA(At, 1, 1); PG8_STAGEB(PG8_SB(1, 0), b3); PG8_STAGEB(PG8_SB(1, 1), b3 + hstepB); PG8_STAGE(PG8_SA(1, 0), a3, w0, w1);
            PG8_WAIT_V(8); PG8_WAIT_L(0); PG8_BAR; PG8_MMA(1, 0, At, B0); PG8_MMA(1, 1, At, B1); PG8_BAR; PG8_SCHED;
        }
        if (wr == 0) PG8_BAR;
        E(acc, cur, wr, wc, fr, fq);
        if (!has_next) break;
#pragma unroll
        for (int a = 0; a < 2; ++a)
#pragma unroll
            for (int b = 0; b < 2; ++b)
#pragma unroll
                for (int m = 0; m < 4; ++m)
#pragma unroll
                    for (int n = 0; n < 2; ++n) acc[a][b][m][n] = (f32x4){0.f, 0.f, 0.f, 0.f};
        cur = nxt; cA = nA; cB = nB; chA = nhA; cv0 = nv0; cv1 = nv1; ++ui;
        if (wr == 1) PG8_BAR;
    }
    PG8_WAIT_V(0);
    PG8_BAR;
#undef PG8_SA
#undef PG8_SB
#undef PG8_STAGE
#undef PG8_STAGEB
#undef PG8_LDA
#undef PG8_LDB
#undef PG8_MMA
#undef PG8_WAIT_V
#undef PG8_WAIT_L
#undef PG8_BAR
#undef PG8_SCHED
}

struct EpiStore {
    static constexpr bool PERM = true;
    bf16_t* O; int ldc;
    __device__ __forceinline__ void operator()(const f32x4 (&acc)[2][2][4][2], const Unit& u, int wr, int wc, int fr, int fq) const {
        const int row0 = u.pm * BM + wr * 64 + fr, col0 = u.pn * BM + wc * 32 + 8 * fq;
#pragma unroll
        for (int ai = 0; ai < 2; ++ai)
#pragma unroll
            for (int m = 0; m < 4; ++m) { bf16_t* rowp = O + (size_t)(row0 + ai * HALF + m * 16) * ldc + col0;
#pragma unroll
                for (int bj = 0; bj < 2; ++bj) { const f32x4 v0 = acc[ai][bj][m][0], v1 = acc[ai][bj][m][1];
                    u32x4 w; w.x = cvt_pk_bf16(v0[0], v0[1]); w.y = cvt_pk_bf16(v0[2], v0[3]); w.z = cvt_pk_bf16(v1[0], v1[1]); w.w = cvt_pk_bf16(v1[2], v1[3]);
                    *(u32x4*)(rowp + bj * HALF) = w; } }
    }
};
struct EpiMerge {
    static constexpr bool PERM = true;
    bf16_t* G; int ldg; const float* bias; bf16_t* Y; int accum;
    __device__ __forceinline__ void operator()(const f32x4 (&acc)[2][2][4][2], const Unit& u, int wr, int wc, int fr, int fq) const {
        const int row0 = u.pm * BM + wr * 64 + fr, col0 = u.pn * BM + wc * 32 + 8 * fq;
        if (u.sel == 0) {
            f32x4 bv[2][2];
#pragma unroll
            for (int bj = 0; bj < 2; ++bj)
#pragma unroll
                for (int n = 0; n < 2; ++n) bv[bj][n] = *(const f32x4*)(bias + col0 + bj * HALF + 4 * n);
#pragma unroll
            for (int ai = 0; ai < 2; ++ai)
#pragma unroll
                for (int m = 0; m < 4; ++m) { bf16_t* rowp = G + (size_t)(row0 + ai * HALF + m * 16) * ldg + col0;
#pragma unroll
                    for (int bj = 0; bj < 2; ++bj) { f32x4 v0 = acc[ai][bj][m][0] + bv[bj][0], v1 = acc[ai][bj][m][1] + bv[bj][1];
#pragma unroll
                        for (int j = 0; j < 4; ++j) { v0[j] = sigmoidf_(v0[j]); v1[j] = sigmoidf_(v1[j]); }
                        u32x4 w; w.x = cvt_pk_bf16(v0[0], v0[1]); w.y = cvt_pk_bf16(v0[2], v0[3]); w.z = cvt_pk_bf16(v1[0], v1[1]); w.w = cvt_pk_bf16(v1[2], v1[3]);
                        *(u32x4*)(rowp + bj * HALF) = w; } }
        } else {
#pragma unroll
            for (int ai = 0; ai < 2; ++ai)
#pragma unroll
                for (int m = 0; m < 4; ++m) { const size_t r = (size_t)(row0 + ai * HALF + m * 16);
                    const unsigned long long* gp = (const unsigned long long*)(G + r * ldg + col0); bf16_t* yp = Y + r * DM + col0;
#pragma unroll
                    for (int bj = 0; bj < 2; ++bj) {
                        const unsigned long long g0 = __hip_atomic_load(gp + bj * (HALF / 4), __ATOMIC_RELAXED, __HIP_MEMORY_SCOPE_AGENT);
                        const unsigned long long g1 = __hip_atomic_load(gp + bj * (HALF / 4) + 1, __ATOMIC_RELAXED, __HIP_MEMORY_SCOPE_AGENT);
                        const unsigned gw[4] = {(unsigned)g0, (unsigned)(g0 >> 32), (unsigned)g1, (unsigned)(g1 >> 32)};
                        u32x4 yo = {0u, 0u, 0u, 0u}; if (accum) yo = *(const u32x4*)(yp + bj * HALF);
                        const f32x4 v0 = acc[ai][bj][m][0], v1 = acc[ai][bj][m][1];
                        u32x4 w;
                        w.x = cvt_pk_bf16(bflo(yo.x) + bflo(gw[0]) * v0[0], bfhi(yo.x) + bfhi(gw[0]) * v0[1]);
                        w.y = cvt_pk_bf16(bflo(yo.y) + bflo(gw[1]) * v0[2], bfhi(yo.y) + bfhi(gw[1]) * v0[3]);
                        w.z = cvt_pk_bf16(bflo(yo.z) + bflo(gw[2]) * v1[0], bfhi(yo.z) + bfhi(gw[2]) * v1[1]);
                        w.w = cvt_pk_bf16(bflo(yo.w) + bflo(gw[3]) * v1[2], bfhi(yo.w) + bfhi(gw[3]) * v1[3]);
                        *(u32x4*)(yp + bj * HALF) = w; } }
        }
    }
};
struct EpiResid {
    static constexpr bool PERM = false;
    const float* Xin; float* Xout;
    __device__ __forceinline__ void operator()(const f32x4 (&acc)[2][2][4][2], const Unit& u, int wr, int wc, int fr, int fq) const {
        const int row0 = u.pm * BM + wr * 64 + fr, col0 = u.pn * BM + wc * 32 + 4 * fq;
#pragma unroll
        for (int ai = 0; ai < 2; ++ai)
#pragma unroll
            for (int m = 0; m < 4; ++m) { const size_t ro = (size_t)(row0 + ai * HALF + m * 16) * DM + col0;
#pragma unroll
                for (int bj = 0; bj < 2; ++bj)
#pragma unroll
                    for (int n = 0; n < 2; ++n) { const f32x4 xi = *(const f32x4*)(Xin + ro + bj * HALF + n * 16); *(f32x4*)(Xout + ro + bj * HALF + n * 16) = xi + acc[ai][bj][m][n]; } }
    }
};
}

__device__ void phase_convert(int l, unsigned char* smem) {
    const Params p = load_params();
    float* tile = (float*)smem;
    const int tid = opaque_tid();
    const float* win = p.w_in + (size_t)l * DM * N_IN;
    bf16_t* WtIn = p.Wt; bf16_t* WtBr = p.Wt + (size_t)WT_ROWS * DM; bf16_t* WtOut = WtBr + (size_t)3 * DM * DM;
    const int NT_IN = WT_ROWS / 64;
    const int total = (NT_IN + 48 + 16) * 16;
    for (int it = blockIdx.x; it < total; it += gridDim.x) {
        const int ntile = it >> 4, kt = it & 15, k0 = kt * 64;
        const float* src = nullptr; int ld = 0, c0 = 0, valid = 64; bf16_t* dst;
        if (ntile < NT_IN) {
            const int n0 = ntile * 64; dst = WtIn + (size_t)n0 * DM;
            if (n0 < 4224) { src = win; ld = N_IN; c0 = n0; }
            else if (n0 < 4352) { if (n0 == 4224 && l > 0) { src = p.v_w1 + (size_t)(l - 1) * DM * 32; ld = 32; c0 = 0; valid = 32; } else { valid = 0; } }
            else { src = win; ld = N_IN; c0 = n0 - 128; }
        } else if (ntile < NT_IN + 48) {
            const int q = ntile - NT_IN, n = q >> 4, n0 = (q & 15) * 64;
            src = p.w_branch + ((size_t)l * 3 + n) * DM * DM; ld = DM; c0 = n0; dst = WtBr + ((size_t)n * DM + n0) * DM;
        } else {
            const int n0 = (ntile - NT_IN - 48) * 64; src = p.w_out + (size_t)l * DM * DM; ld = DM; c0 = n0; dst = WtOut + (size_t)n0 * DM;
        }
        __syncthreads();
        if (valid == 64) {
            const int kr = tid >> 4, nc = (tid & 15) * 4;
#pragma unroll
            for (int ps = 0; ps < 2; ++ps) { const int k = kr + ps * 32; const f32x4 v = *(const f32x4*)(src + (size_t)(k0 + k) * ld + c0 + nc);
                tile[k * 65 + nc] = v[0]; tile[k * 65 + nc + 1] = v[1]; tile[k * 65 + nc + 2] = v[2]; tile[k * 65 + nc + 3] = v[3]; }
        } else {
            for (int e = tid; e < 4096; e += 512) { const int k = e >> 6, n = e & 63; tile[k * 65 + n] = (n < valid) ? src[(size_t)(k0 + k) * ld + c0 + n] : 0.f; }
        }
        __syncthreads();
        { const int nr = tid >> 3, kc = (tid & 7) * 8; u32x4 w;
          w.x = cvt_pk_bf16(tile[(kc + 0) * 65 + nr], tile[(kc + 1) * 65 + nr]); w.y = cvt_pk_bf16(tile[(kc + 2) * 65 + nr], tile[(kc + 3) * 65 + nr]);
          w.z = cvt_pk_bf16(tile[(kc + 4) * 65 + nr], tile[(kc + 5) * 65 + nr]); w.w = cvt_pk_bf16(tile[(kc + 6) * 65 + nr], tile[(kc + 7) * 65 + nr]);
          *(u32x4*)(dst + (size_t)nr * DM + k0 + kc) = w; }
    }
    __syncthreads();
}

__device__ void phase_rmsnorm(const float* x, const float* g, bf16_t* xn, float* outf) {
    const int tid_ = opaque_tid(); const int lane = tid_ & 63, wv = tid_ >> 6;
    f32x4 gv[4];
#pragma unroll
    for (int q = 0; q < 4; ++q) gv[q] = *(const f32x4*)(g + q * 256 + lane * 4);
    for (int row = blockIdx.x * 8 + wv; row < T_TOK; row += gridDim.x * 8) {
        const float* xr = x + (size_t)row * DM; f32x4 v[4]; float ss = 0.f;
#pragma unroll
        for (int q = 0; q < 4; ++q) { v[q] = *(const f32x4*)(xr + q * 256 + lane * 4); ss += v[q][0] * v[q][0] + v[q][1] * v[q][1] + v[q][2] * v[q][2] + v[q][3] * v[q][3]; }
#pragma unroll
        for (int o = 32; o > 0; o >>= 1) ss += __shfl_xor(ss, o);
        const float rinv = rsqrtf(ss * (1.0f / DM) + EPS);
#pragma unroll
        for (int q = 0; q < 4; ++q) { const f32x4 o = v[q] * rinv * gv[q];
            if (xn) { u32x2 w; w.x = cvt_pk_bf16(o[0], o[1]); w.y = cvt_pk_bf16(o[2], o[3]); *(u32x2*)(xn + (size_t)row * DM + q * 256 + lane * 4) = w; }
            else *(f32x4*)(outf + (size_t)row * DM + q * 256 + lane * 4) = o; }
    }
}

template <int CTRL> __device__ __forceinline__ float dpp_f(float v) { return __int_as_float(__builtin_amdgcn_update_dpp(0, __float_as_int(v), CTRL, 0xf, 0xf, false)); }
__device__ __forceinline__ float red8(float v) { v += dpp_f<0xB1>(v); v += dpp_f<0x4E>(v); v += dpp_f<0x141>(v); return v; }
__device__ __forceinline__ float red16(float v) { v = red8(v); v += dpp_f<0x140>(v); return v; }

struct RwRaw { u32x4 cw[2], pw[2], ca[2], pa[2], vl; u32x2 cr[2], pr[2], ck[2], pk[2], cv, pv, vf; };
__device__ __forceinline__ void rw_load(RwRaw& R, const bf16_t* H, const bf16_t* vfp, int l, size_t tok, bool hasp, int h, int chh, int vnt, int fq) {
    const bf16_t* cur = H + tok * LDA_H; const bf16_t* prev = cur - LDA_H;
    const u32x4 z4 = {0u, 0u, 0u, 0u}; const u32x2 z2 = {0u, 0u};
#pragma unroll
    for (int ks = 0; ks < 2; ++ks) { const int m0 = ks * 32 + fq * 8;
        R.cw[ks] = *(const u32x4*)(cur + 3072 + m0); R.ca[ks] = *(const u32x4*)(cur + 3136 + m0);
        R.pw[ks] = hasp ? *(const u32x4*)(prev + 3072 + m0) : z4; R.pa[ks] = hasp ? *(const u32x4*)(prev + 3136 + m0) : z4; }
#pragma unroll
    for (int q = 0; q < 2; ++q) { const int cb = h * 64 + (chh * 2 + q) * 16 + fq * 4;
        R.cr[q] = *(const u32x2*)(cur + cb); R.ck[q] = *(const u32x2*)(cur + 1024 + cb);
        R.pr[q] = hasp ? *(const u32x2*)(prev + cb) : z2; R.pk[q] = hasp ? *(const u32x2*)(prev + 1024 + cb) : z2; }
    const int cbv = h * 64 + vnt * 16 + fq * 4;
    R.cv = *(const u32x2*)(cur + 2048 + cbv); R.pv = hasp ? *(const u32x2*)(prev + 2048 + cbv) : z2;
    R.vf = z2; R.vl = z4;
    if (l > 0) { R.vf = *(const u32x2*)(vfp + tok * DM + cbv); R.vl = *(const u32x4*)(cur + 4224 + fq * 8); }
}

__device__ void phase_rwkv(int l, unsigned char* smem, int mode) {
    const Params p = load_params();
    constexpr int TC = 32, NCH = SEQ / TC, RS = 68  , BUFSZ = 5 * TC * RS + TC * 32 + TC * 2;
    bf16_t* w2T = (bf16_t*)smem;
    bf16_t* a2T = w2T + 64 * 72;
    bf16_t* v2T = a2T + 64 * 72;
    float* cst = (float*)(v2T + 64 * 40);
    float* buf0 = cst + 11 * 64;
    float* ypart = buf0 + 2 * BUFSZ;
    float* sI = ypart + 4 * TC * 64;
    const int tid = opaque_tid(), wid = __builtin_amdgcn_readfirstlane(tid >> 6), lane = tid & 63, fr = lane & 15, fq = lane >> 4;
    for (int item = blockIdx.x; item < NB * 32; item += gridDim.x) {
        const int xc_ = item & 7, sl_ = item >> 3, half = sl_ & 1, pi_ = (sl_ >> 1) * 8 + xc_, b = pi_ >> 4, h = pi_ & 15;
        __syncthreads();
        for (int e = tid; e < 4096; e += 512) { const int m = e >> 6, j = e & 63; w2T[j * 72 + m] = f2bf(p.w_w2[((size_t)l * 64 + m) * DM + h * 64 + j]); a2T[j * 72 + m] = f2bf(p.a_w2[((size_t)l * 64 + m) * DM + h * 64 + j]); }
        if (l > 0) for (int e = tid; e < 2048; e += 512) { const int m = e >> 6, j = e & 63; v2T[j * 40 + m] = f2bf(p.v_w2[((size_t)(l - 1) * 32 + m) * DM + h * 64 + j]); }
        if (tid < 64) { const float* mu = p.mu + (size_t)l * 3200; const int cc = h * 64 + tid;
            cst[tid] = mu[cc]; cst[64 + tid] = mu[1024 + cc]; cst[128 + tid] = mu[2048 + cc]; cst[192 + tid] = p.w0[l * DM + cc]; cst[256 + tid] = p.a0[l * DM + cc];
            cst[320 + tid] = (l > 0) ? p.v0[(l - 1) * DM + cc] : 0.f; cst[384 + tid] = p.k_k[l * DM + cc]; cst[448 + tid] = p.k_a[l * DM + cc]; cst[512 + tid] = p.r_k[l * DM + cc];
            cst[576 + tid] = mu[3072 + tid]; cst[640 + tid] = mu[3136 + tid]; }
        __syncthreads();
        f32x2 st[4];
#pragma unroll
        for (int j = 0; j < 4; ++j) st[j] = (f32x2){0.f, 0.f};
        const int si = tid >> 3, seg = tid & 7;
        const int pwv = wid - 4, tti = pwv & 1, chh = (pwv >> 1) & 1, vnt = half * 2 + chh, tt = tti * 16 + fr;
        RwRaw raw;
        if (wid >= 4) rw_load(raw, p.H, p.vf, l, (size_t)b * SEQ + tt, tt > 0, h, chh, vnt, fq);
        for (int c = -1; c < NCH; ++c) {
            if (wid >= 4 && c + 1 < NCH && !(mode & 2)) {
                float* B_ = buf0 + ((c + 1) & 1) * BUFSZ;
                float* sR = B_; float* sW = sR + TC * RS; float* sK = sW + TC * RS; float* sA = sK + TC * RS; float* sB = sA + TC * RS; float* sV = sB + TC * RS; float* sS = sV + TC * 32;
                const size_t tok = (size_t)b * SEQ + (c + 1) * TC + tt;
                const RwRaw& cr_ = raw;
                bf16x8 AfW[2], AfA[2];
#pragma unroll
                for (int ks = 0; ks < 2; ++ks) { const int m0 = ks * 32 + fq * 8;
                    const f32x4 mw0 = *(const f32x4*)(cst + 576 + m0), mw1 = *(const f32x4*)(cst + 576 + m0 + 4), ma0 = *(const f32x4*)(cst + 640 + m0), ma1 = *(const f32x4*)(cst + 640 + m0 + 4);
                    const float muw[8] = {mw0[0], mw0[1], mw0[2], mw0[3], mw1[0], mw1[1], mw1[2], mw1[3]}, mua[8] = {ma0[0], ma0[1], ma0[2], ma0[3], ma1[0], ma1[1], ma1[2], ma1[3]};
                    const unsigned cwv[4] = {cr_.cw[ks].x, cr_.cw[ks].y, cr_.cw[ks].z, cr_.cw[ks].w}, pwq[4] = {cr_.pw[ks].x, cr_.pw[ks].y, cr_.pw[ks].z, cr_.pw[ks].w};
                    const unsigned cav[4] = {cr_.ca[ks].x, cr_.ca[ks].y, cr_.ca[ks].z, cr_.ca[ks].w}, pav[4] = {cr_.pa[ks].x, cr_.pa[ks].y, cr_.pa[ks].z, cr_.pa[ks].w};
                    unsigned ow[4], oa[4];
#pragma unroll
                    for (int e = 0; e < 4; ++e) {
                        const float c0 = bflo(cwv[e]), c1 = bfhi(cwv[e]), q0 = bflo(pwq[e]), q1 = bfhi(pwq[e]);
                        ow[e] = cvt_pk_bf16(tanh_fast(c0 + muw[2 * e] * (q0 - c0)), tanh_fast(c1 + muw[2 * e + 1] * (q1 - c1)));
                        const float d0 = bflo(cav[e]), d1 = bfhi(cav[e]), r0 = bflo(pav[e]), r1 = bfhi(pav[e]);
                        oa[e] = cvt_pk_bf16(d0 + mua[2 * e] * (r0 - d0), d1 + mua[2 * e + 1] * (r1 - d1)); }
                    AfW[ks] = __builtin_bit_cast(bf16x8, ((u32x4){ow[0], ow[1], ow[2], ow[3]})); AfA[ks] = __builtin_bit_cast(bf16x8, ((u32x4){oa[0], oa[1], oa[2], oa[3]})); }
                f32x4 accW[2], accA[2], accV = (f32x4){0.f, 0.f, 0.f, 0.f};
#pragma unroll
                for (int q = 0; q < 2; ++q) { const int nt = chh * 2 + q; accW[q] = (f32x4){0.f, 0.f, 0.f, 0.f}; accA[q] = (f32x4){0.f, 0.f, 0.f, 0.f};
#pragma unroll
                    for (int ks = 0; ks < 2; ++ks) { const bf16x8 bw = *(const bf16x8*)(w2T + (nt * 16 + fr) * 72 + ks * 32 + fq * 8), ba = *(const bf16x8*)(a2T + (nt * 16 + fr) * 72 + ks * 32 + fq * 8);
                        accW[q] = __builtin_amdgcn_mfma_f32_16x16x32_bf16(bw, AfW[ks], accW[q], 0, 0, 0); accA[q] = __builtin_amdgcn_mfma_f32_16x16x32_bf16(ba, AfA[ks], accA[q], 0, 0, 0); } }
                if (l > 0) { const bf16x8 bv = *(const bf16x8*)(v2T + (vnt * 16 + fr) * 40 + fq * 8); accV = __builtin_amdgcn_mfma_f32_16x16x32_bf16(bv, __builtin_bit_cast(bf16x8, cr_.vl), accV, 0, 0, 0); }
                float ss = 0.f, rk = 0.f;
#pragma unroll
                for (int q = 0; q < 2; ++q) { const int ch0 = (chh * 2 + q) * 16 + fq * 4;
                    const float fr_[4] = {bflo(cr_.cr[q].x), bfhi(cr_.cr[q].x), bflo(cr_.cr[q].y), bfhi(cr_.cr[q].y)}, fpr[4] = {bflo(cr_.pr[q].x), bfhi(cr_.pr[q].x), bflo(cr_.pr[q].y), bfhi(cr_.pr[q].y)};
                    const float fk_[4] = {bflo(cr_.ck[q].x), bfhi(cr_.ck[q].x), bflo(cr_.ck[q].y), bfhi(cr_.ck[q].y)}, fpk[4] = {bflo(cr_.pk[q].x), bfhi(cr_.pk[q].x), bflo(cr_.pk[q].y), bfhi(cr_.pk[q].y)};
                    const f32x4 mur = *(const f32x4*)(cst + ch0), muk = *(const f32x4*)(cst + 64 + ch0), w0v = *(const f32x4*)(cst + 192 + ch0), a0v = *(const f32x4*)(cst + 256 + ch0),
                        kkv = *(const f32x4*)(cst + 384 + ch0), kav = *(const f32x4*)(cst + 448 + ch0), rkv = *(const f32x4*)(cst + 512 + ch0);
                    f32x4 ro, wo, ko, ao, bo;
#pragma unroll
                    for (int e = 0; e < 4; ++e) {
                        const float r = fr_[e] + mur[e] * (fpr[e] - fr_[e]), k = fk_[e] + muk[e] * (fpk[e] - fk_[e]);
                        wo[e] = __expf(-0.60653065971f * sigmoidf_(w0v[e] + accW[q][e]));
                        const float a = sigmoidf_(a0v[e] + accA[q][e]);
                        const float kq = k * kkv[e]; ss += kq * kq; ao[e] = -kq; bo[e] = kq * a;
                        const float km = k * (1.0f + (a - 1.0f) * kav[e]); rk += r * km * rkv[e]; ro[e] = r; ko[e] = km; }
                    *(f32x4*)(sR + tt * RS + ch0) = ro; *(f32x4*)(sW + tt * RS + ch0) = wo; *(f32x4*)(sK + tt * RS + ch0) = ko; *(f32x4*)(sA + tt * RS + ch0) = ao; *(f32x4*)(sB + tt * RS + ch0) = bo; }
                ss += __shfl_xor(ss, 16); ss += __shfl_xor(ss, 32); rk += __shfl_xor(rk, 16); rk += __shfl_xor(rk, 32);
                if (fq == 0) { sS[tt * 2 + chh] = ss; if (half == 0) p.rkbuf[(size_t)((b * 16 + h) * 2 + chh) * SEQ + (c + 1) * TC + tt] = rk; }
                { const int ch0 = vnt * 16 + fq * 4, cb = h * 64 + ch0;
                  const float fv_[4] = {bflo(cr_.cv.x), bfhi(cr_.cv.x), bflo(cr_.cv.y), bfhi(cr_.cv.y)}, fpv[4] = {bflo(cr_.pv.x), bfhi(cr_.pv.x), bflo(cr_.pv.y), bfhi(cr_.pv.y)};
                  const f32x4 muv = *(const f32x4*)(cst + 128 + ch0), v0v = *(const f32x4*)(cst + 320 + ch0);
                  f32x4 vo;
#pragma unroll
                  for (int e = 0; e < 4; ++e) vo[e] = fv_[e] + muv[e] * (fpv[e] - fv_[e]);
                  if (l > 0) { const float vfv[4] = {bflo(cr_.vf.x), bfhi(cr_.vf.x), bflo(cr_.vf.y), bfhi(cr_.vf.y)};
#pragma unroll
                      for (int e = 0; e < 4; ++e) vo[e] = vo[e] + (vfv[e] - vo[e]) * sigmoidf_(v0v[e] + accV[e]); }
                  u32x2 w; w.x = cvt_pk_bf16(vo[0], vo[1]); w.y = cvt_pk_bf16(vo[2], vo[3]); *(u32x2*)(p.vf + tok * DM + cb) = w;
                  *(f32x4*)(sV + tt * 32 + chh * 16 + fq * 4) = vo; }
            }
            if (wid >= 4 && c + 2 < NCH && !(mode & 2)) rw_load(raw, p.H, p.vf, l, (size_t)b * SEQ + (size_t)(c + 2) * TC + tt, true, h, chh, vnt, fq);
            if (wid < 4 && c >= 0 && !(mode & 1)) {
                const float* B_ = buf0 + (c & 1) * BUFSZ;
                const float* sR = B_; const float* sW = sR + TC * RS; const float* sK = sW + TC * RS; const float* sA = sK + TC * RS; const float* sB = sA + TC * RS; const float* sV = sB + TC * RS; const float* sS = sV + TC * 32;
                float* yp = ypart + wid * (TC * 64) + lane;
                float ivreg = 0.f;
                if (lane < TC) { const f32x2 ps = *(const f32x2*)(sS + lane * 2); ivreg = __builtin_amdgcn_rcpf(fmaxf(ps.x + ps.y, 1e-24f)); }
                struct ScOp { f32x4 a0, a1, w0, w1, b0, b1, k0, k1, r0, r1; float vi, iv; };
                auto sc_load = [&](ScOp& o, const int s_) { const int o_ = s_ * RS + seg * 8;
                    o.a0 = *(const f32x4*)(sA + o_); o.a1 = *(const f32x4*)(sA + o_ + 4); o.w0 = *(const f32x4*)(sW + o_); o.w1 = *(const f32x4*)(sW + o_ + 4);
                    o.b0 = *(const f32x4*)(sB + o_); o.b1 = *(const f32x4*)(sB + o_ + 4); o.k0 = *(const f32x4*)(sK + o_); o.k1 = *(const f32x4*)(sK + o_ + 4);
                    o.r0 = *(const f32x4*)(sR + o_); o.r1 = *(const f32x4*)(sR + o_ + 4); o.vi = sV[s_ * 32 + si]; o.iv = __int_as_float(__builtin_amdgcn_readlane(__float_as_int(ivreg), s_)); };
                auto sc_step = [&](const ScOp& o, const int s_) {
                    const f32x2 av[4] = {{o.a0[0], o.a0[1]}, {o.a0[2], o.a0[3]}, {o.a1[0], o.a1[1]}, {o.a1[2], o.a1[3]}}, wv[4] = {{o.w0[0], o.w0[1]}, {o.w0[2], o.w0[3]}, {o.w1[0], o.w1[1]}, {o.w1[2], o.w1[3]}};
                    const f32x2 bv[4] = {{o.b0[0], o.b0[1]}, {o.b0[2], o.b0[3]}, {o.b1[0], o.b1[1]}, {o.b1[2], o.b1[3]}}, kv[4] = {{o.k0[0], o.k0[1]}, {o.k0[2], o.k0[3]}, {o.k1[0], o.k1[1]}, {o.k1[2], o.k1[3]}};
                    const f32x2 rv[4] = {{o.r0[0], o.r0[1]}, {o.r0[2], o.r0[3]}, {o.r1[0], o.r1[1]}, {o.r1[2], o.r1[3]}};
                    const f32x2 vi2 = {o.vi, o.vi};
                    f32x2 vk[4];
#pragma unroll
                    for (int j = 0; j < 4; ++j) vk[j] = vi2 * kv[j];
                    f32x2 pc = st[0] * av[0]; pc += st[1] * av[1]; pc += st[2] * av[2]; pc += st[3] * av[3];
                    const float sa = red8(pc.x + pc.y) * o.iv;
                    const f32x2 sa2 = {sa, sa};
#pragma unroll
                    for (int j = 0; j < 4; ++j) st[j] = st[j] * wv[j] + (sa2 * bv[j] + vk[j]);
                    f32x2 qc = st[0] * rv[0]; qc += st[1] * rv[1]; qc += st[2] * rv[2]; qc += st[3] * rv[3];
                    yp[s_ * 64] = qc.x + qc.y;
                };
                ScOp opX, opY; sc_load(opX, 0);
#pragma unroll 4
                for (int s = 0; s < TC; s += 2) {
                    sc_load(opY, s + 1); __builtin_amdgcn_sched_barrier(0); sc_step(opX, s);
                    if (s + 2 < TC) sc_load(opX, s + 2);
                    __builtin_amdgcn_sched_barrier(0); sc_step(opY, s + 1);
                }
                { const int tk = lane >> 1, rq = (lane & 1) * 4; const float* yr = ypart + wid * (TC * 64) + tk * 64 + rq * 8; float yv[4];
#pragma unroll
                  for (int r_ = 0; r_ < 4; ++r_) { const f32x4 u0 = *(const f32x4*)(yr + r_ * 8), u1 = *(const f32x4*)(yr + r_ * 8 + 4); yv[r_] = ((u0[0] + u0[1]) + (u0[2] + u0[3])) + ((u1[0] + u1[1]) + (u1[2] + u1[3])); }
                  u32x2 w; w.x = cvt_pk_bf16(yv[0], yv[1]); w.y = cvt_pk_bf16(yv[2], yv[3]);
                  *(u32x2*)(p.y + ((size_t)b * SEQ + c * TC + tk) * DM + h * 64 + half * 32 + wid * 8 + rq) = w; }
            }
            __syncthreads();
        }
    }
    __syncthreads();
}

__device__ void phase_rwkv_post(int l, bf16_t* oalt) {
    const Params p = load_params();
    const int tid = opaque_tid(), l8 = tid & 7;
    const int ngrp = T_TOK * 16;
    for (int g = blockIdx.x * 64 + (tid >> 3); g < ngrp; g += gridDim.x * 64) {
        const int tok = g >> 4, h = g & 15, cb = h * 64 + l8 * 8;
        const u32x4 y4 = *(const u32x4*)(p.y + (size_t)tok * DM + cb), b4 = *(const u32x4*)(p.vf + (size_t)tok * DM + cb);
        const int bb = tok / SEQ, tq = tok % SEQ; const float rk = p.rkbuf[(size_t)((bb * 16 + h) * 2) * SEQ + tq] + p.rkbuf[(size_t)((bb * 16 + h) * 2 + 1) * SEQ + tq];
        bf16_t* zp = p.H + (size_t)tok * LDA_H + 3200 + cb; const u32x4 z4 = *(const u32x4*)zp;
        const float yv[8] = {bflo(y4.x), bfhi(y4.x), bflo(y4.y), bfhi(y4.y), bflo(y4.z), bfhi(y4.z), bflo(y4.w), bfhi(y4.w)};
        const float bv[8] = {bflo(b4.x), bfhi(b4.x), bflo(b4.y), bfhi(b4.y), bflo(b4.z), bfhi(b4.z), bflo(b4.w), bfhi(b4.w)};
        const float zv[8] = {bflo(z4.x), bfhi(z4.x), bflo(z4.y), bfhi(z4.y), bflo(z4.z), bfhi(z4.z), bflo(z4.w), bfhi(z4.w)};
        float sm = 0.f;
#pragma unroll
        for (int e = 0; e < 8; ++e) sm += yv[e];
        sm = red8(sm); const float mean = sm * (1.0f / 64.f); float d[8], vs = 0.f;
#pragma unroll
        for (int e = 0; e < 8; ++e) { d[e] = yv[e] - mean; vs += d[e] * d[e]; }
        vs = red8(vs); const float rstd = rsqrtf(vs * (1.0f / 64.f) + GN_EPS);
        const f32x4 g0 = *(const f32x4*)(p.lnx_g + l * DM + cb), g1 = *(const f32x4*)(p.lnx_g + l * DM + cb + 4), c0 = *(const f32x4*)(p.lnx_b + l * DM + cb), c1 = *(const f32x4*)(p.lnx_b + l * DM + cb + 4);
        const float gg[8] = {g0[0], g0[1], g0[2], g0[3], g1[0], g1[1], g1[2], g1[3]}, cc[8] = {c0[0], c0[1], c0[2], c0[3], c1[0], c1[1], c1[2], c1[3]};
        float o[8];
#pragma unroll
        for (int e = 0; e < 8; ++e) o[e] = (d[e] * rstd * gg[e] + cc[e] + rk * bv[e]) * siluf_(zv[e]);
        u32x4 w; w.x = cvt_pk_bf16(o[0], o[1]); w.y = cvt_pk_bf16(o[2], o[3]); w.z = cvt_pk_bf16(o[4], o[5]); w.w = cvt_pk_bf16(o[6], o[7]);
        *(u32x4*)(oalt ? oalt + (size_t)tok * DM + cb : zp) = w;
    }
}

__device__ __forceinline__ float wave_sum64(float v) {
    v = red16(v);
    const float a = __int_as_float(__builtin_amdgcn_readlane(__float_as_int(v), 0)), b = __int_as_float(__builtin_amdgcn_readlane(__float_as_int(v), 16));
    const float c = __int_as_float(__builtin_amdgcn_readlane(__float_as_int(v), 32)), d = __int_as_float(__builtin_amdgcn_readlane(__float_as_int(v), 48));
    return (a + b) + (c + d);
}
__device__ void phase_sgu(int l, unsigned char* smem, bf16_t* oalt) {
    const Params p = load_params();
    bf16_t* vnTb = (bf16_t*)smem;
    float* stat = (float*)(smem + 2 * 128 * 136 * 2);
    float* lnG = stat + 256; float* lnB = lnG + DM;
    const int tid = opaque_tid(), wid = tid >> 6, lane = tid & 63, fr = lane & 15, fq = lane >> 4;
    __syncthreads();
    for (int e = tid; e < DM; e += 512) { lnG[e] = p.sgu_ln_g[(size_t)l * DM + e]; lnB[e] = p.sgu_ln_b[(size_t)l * DM + e]; }
    for (int item = blockIdx.x; item < T_TOK / 128; item += gridDim.x) {
        bf16_t* Hb = p.H + (size_t)item * 128 * LDB_H;
        __syncthreads();
#pragma unroll
        for (int hb = 0; hb < 2; ++hb) {
            u32x4 va[8], vb[8];
#pragma unroll
            for (int q = 0; q < 8; ++q) { const bf16_t* vr = Hb + (size_t)(wid * 16 + hb * 8 + q) * LDB_H + 1024 + lane * 16; va[q] = *(const u32x4*)vr; vb[q] = *(const u32x4*)(vr + 8); }
#pragma unroll
            for (int q = 0; q < 8; ++q) {
                const float f[16] = {bflo(va[q].x), bfhi(va[q].x), bflo(va[q].y), bfhi(va[q].y), bflo(va[q].z), bfhi(va[q].z), bflo(va[q].w), bfhi(va[q].w), bflo(vb[q].x), bfhi(vb[q].x), bflo(vb[q].y), bfhi(vb[q].y), bflo(vb[q].z), bfhi(vb[q].z), bflo(vb[q].w), bfhi(vb[q].w)};
                float sm = 0.f, sq = 0.f;
#pragma unroll
                for (int e = 0; e < 16; ++e) { sm += f[e]; sq += f[e] * f[e]; }
                sm = wave_sum64(sm); sq = wave_sum64(sq);
                const float mean = sm * (1.0f / DM), var = fmaxf(sq * (1.0f / DM) - mean * mean, 0.f);
                if (lane == 0) { const int s = wid * 16 + hb * 8 + q; stat[s * 2] = mean; stat[s * 2 + 1] = rsqrtf(var + EPS); } }
        }
        __syncthreads();
        const int trow = wid * 16 + fr; bf16_t* hr = Hb + (size_t)trow * LDB_H;
        const int nks = (wid < 4) ? 2 : 4;
        for (int g = 0; g < 8; ++g) {
            bf16_t* vnT = vnTb + (g & 1) * (128 * 136);
            const int s = tid >> 2, c0 = (tid & 3) * 32;
            const bf16_t* vr = Hb + (size_t)s * LDB_H + 1024 + g * 128 + c0;
            u32x4 vv[4];
#pragma unroll
            for (int q = 0; q < 4; ++q) vv[q] = *(const u32x4*)(vr + q * 8);
            const float* Wg = p.sgu_w + (((size_t)l * 8 + g) * 128 + trow) * 128;
            f32x4 wa[4], wb[4];
#pragma unroll
            for (int ks = 0; ks < 4; ++ks) if (ks < nks) { wa[ks] = *(const f32x4*)(Wg + ks * 32 + fq * 8); wb[ks] = *(const f32x4*)(Wg + ks * 32 + fq * 8 + 4); }
            u32x2 u2[8], z2[8];
#pragma unroll
            for (int ct = 0; ct < 8; ++ct) { const int c = g * 128 + ct * 16 + fq * 4; u2[ct] = *(const u32x2*)(hr + c); z2[ct] = *(const u32x2*)(hr + 2048 + c); }
            const float bs = p.sgu_b[((size_t)l * 8 + g) * 128 + trow];
            { const float mean = stat[s * 2], rstd = stat[s * 2 + 1];
#pragma unroll
              for (int q = 0; q < 4; ++q) { const float f[8] = {bflo(vv[q].x), bfhi(vv[q].x), bflo(vv[q].y), bfhi(vv[q].y), bflo(vv[q].z), bfhi(vv[q].z), bflo(vv[q].w), bfhi(vv[q].w)};
                  const f32x4 g0 = *(const f32x4*)(lnG + g * 128 + c0 + q * 8), g1 = *(const f32x4*)(lnG + g * 128 + c0 + q * 8 + 4), b0 = *(const f32x4*)(lnB + g * 128 + c0 + q * 8), b1 = *(const f32x4*)(lnB + g * 128 + c0 + q * 8 + 4);
                  const float gg[8] = {g0[0], g0[1], g0[2], g0[3], g1[0], g1[1], g1[2], g1[3]}, bb[8] = {b0[0], b0[1], b0[2], b0[3], b1[0], b1[1], b1[2], b1[3]};
#pragma unroll
                  for (int e = 0; e < 8; ++e) { const int c = c0 + q * 8 + e; const float a_ = rstd * gg[e]; vnT[c * 136 + s] = f2bf(f[e] * a_ + (bb[e] - mean * a_)); } } }
            __syncthreads();
            f32x4 acc[8];
#pragma unroll
            for (int i = 0; i < 8; ++i) acc[i] = (f32x4){0.f, 0.f, 0.f, 0.f};
#pragma unroll
            for (int ks = 0; ks < 4; ++ks) if (ks < nks) {
                u32x4 wp; wp.x = cvt_pk_bf16(wa[ks][0], wa[ks][1]); wp.y = cvt_pk_bf16(wa[ks][2], wa[ks][3]); wp.z = cvt_pk_bf16(wb[ks][0], wb[ks][1]); wp.w = cvt_pk_bf16(wb[ks][2], wb[ks][3]);
                const bf16x8 wfrag = __builtin_bit_cast(bf16x8, wp);
#pragma unroll
                for (int ct = 0; ct < 8; ++ct) { const bf16x8 vfrag = *(const bf16x8*)(vnT + (ct * 16 + fr) * 136 + ks * 32 + fq * 8);
                    acc[ct] = __builtin_amdgcn_mfma_f32_16x16x32_bf16(vfrag, wfrag, acc[ct], 0, 0, 0); }
            }
#pragma unroll
            for (int ct = 0; ct < 8; ++ct) { const int c = g * 128 + ct * 16 + fq * 4;
                const float uf[4] = {bflo(u2[ct].x), bfhi(u2[ct].x), bflo(u2[ct].y), bfhi(u2[ct].y)}, zf[4] = {bflo(z2[ct].x), bfhi(z2[ct].x), bflo(z2[ct].y), bfhi(z2[ct].y)};
                float o[4];
#pragma unroll
                for (int j = 0; j < 4; ++j) o[j] = uf[j] * (acc[ct][j] + bs) * siluf_(zf[j]);
                u32x2 w; w.x = cvt_pk_bf16(o[0], o[1]); w.y = cvt_pk_bf16(o[2], o[3]); *(u32x2*)(oalt ? oalt + ((size_t)item * 128 + trow) * DM + c : hr + 2048 + c) = w; }
        }
    }
    __syncthreads();
}

__device__ void phase_hgrn_pre(int l, unsigned char* smem, bool dry) {
    const Params p = load_params();
    float* LF = (float*)smem;
    bf16_t* IB = (bf16_t*)(LF + 64 * 132);
    bf16_t* KB = IB + 64 * 136;
    float* psum = (float*)(KB + 64 * 136);
    float* lbs = psum + 512;
    const int tid = opaque_tid();
    bf16_t* xtra = (l == 0) ? (bf16_t*)p.out : p.vf;
    __syncthreads();
    for (int e = tid; e < DM; e += 512) { float lb = 0.f; if (l == 1) { const float l0 = p.lb_logits[e], l1 = p.lb_logits[DM + e]; lb = __builtin_amdgcn_rcpf(1.0f + __expf(l0 - l1)); } lbs[e] = lb; }
    __syncthreads();
    const int t = tid >> 3, c0 = (tid & 7) * 16;
    const int cc = tid & 127, tq = tid >> 7;
    u32x4 nq0, nq1, nf0, nf1, ni0, ni1;
#define HP_ISSUE(it_) do { const int h_ = (it_) & 7, ch_ = ((it_) >> 3) & 63, b_ = (it_) >> 9; const bf16_t* hr_ = p.H + ((size_t)b_ * SEQ + ch_ * 64 + t) * LDC_H + h_ * 128 + c0; \
        nq0 = *(const u32x4*)hr_; nq1 = *(const u32x4*)(hr_ + 8); nf0 = *(const u32x4*)(hr_ + 1024); nf1 = *(const u32x4*)(hr_ + 1032); ni0 = *(const u32x4*)(hr_ + 2048); ni1 = *(const u32x4*)(hr_ + 2056); } while (0)
    if ((int)blockIdx.x < NB * 64 * 8) HP_ISSUE((int)blockIdx.x);
    for (int item = blockIdx.x; item < NB * 64 * 8; item += gridDim.x) {
        const int h = item & 7, ch = (item >> 3) & 63, b = item >> 9;
        const size_t r0 = (size_t)b * SEQ + ch * 64;
        bf16_t* hr = p.H + (r0 + t) * LDC_H + h * 128 + c0;
        float qv[16], kv[16];
        {
            const u32x4 q0 = nq0, q1 = nq1, f0 = nf0, f1 = nf1, i0 = ni0, i1 = ni1;
            if (item + (int)gridDim.x < NB * 64 * 8) HP_ISSUE(item + (int)gridDim.x);
            const unsigned qa[8] = {q0.x, q0.y, q0.z, q0.w, q1.x, q1.y, q1.z, q1.w}, fa[8] = {f0.x, f0.y, f0.z, f0.w, f1.x, f1.y, f1.z, f1.w};
            *(u32x4*)(IB + t * 136 + c0) = i0; *(u32x4*)(IB + t * 136 + c0 + 8) = i1;
            float lf[16];
#pragma unroll
            for (int e = 0; e < 8; ++e) {
                const float lb0 = lbs[h * 128 + c0 + 2 * e], lb1 = lbs[h * 128 + c0 + 2 * e + 1];
                qv[2 * e] = siluf_(bflo(qa[e])); qv[2 * e + 1] = siluf_(bfhi(qa[e]));
                const float g0 = lb0 + (1.0f - lb0) * sigmoidf_(bflo(fa[e])), g1 = lb1 + (1.0f - lb1) * sigmoidf_(bfhi(fa[e]));
                kv[2 * e] = 1.0f - g0; kv[2 * e + 1] = 1.0f - g1; lf[2 * e] = __logf(g0); lf[2 * e + 1] = __logf(g1); }
#pragma unroll
            for (int e = 0; e < 4; ++e) *(f32x4*)(LF + t * 132 + c0 + e * 4) = (f32x4){lf[e * 4], lf[e * 4 + 1], lf[e * 4 + 2], lf[e * 4 + 3]};
        }
        __syncthreads();
        { float run = 0.f;
#pragma unroll
          for (int e = 0; e < 16; ++e) { run += LF[(tq * 16 + e) * 132 + cc]; LF[(tq * 16 + e) * 132 + cc] = run; }
          psum[tq * 128 + cc] = run; }
        __syncthreads();
        {
            const int tqt = t >> 4;
            unsigned qo[8], ko[8];
#pragma unroll
            for (int e4 = 0; e4 < 4; ++e4) {
                const f32x4 p0 = *(const f32x4*)(psum + c0 + e4 * 4), p1 = *(const f32x4*)(psum + 128 + c0 + e4 * 4), p2 = *(const f32x4*)(psum + 256 + c0 + e4 * 4), p3 = *(const f32x4*)(psum + 384 + c0 + e4 * 4);
                const f32x4 bl = *(const f32x4*)(LF + t * 132 + c0 + e4 * 4);
                float q2[4], k2[4];
#pragma unroll
                for (int j = 0; j < 4; ++j) {
                    const float off = (tqt > 0 ? p0[j] : 0.f) + (tqt > 1 ? p1[j] : 0.f) + (tqt > 2 ? p2[j] : 0.f);
                    const float bmid = p0[j] + p1[j], bb = bl[j] + off;
                    q2[j] = qv[e4 * 4 + j] * __expf(bb - bmid); k2[j] = kv[e4 * 4 + j] * __expf(bmid - bb); }
                qo[e4 * 2] = cvt_pk_bf16(q2[0], q2[1]); qo[e4 * 2 + 1] = cvt_pk_bf16(q2[2], q2[3]); ko[e4 * 2] = cvt_pk_bf16(k2[0], k2[1]); ko[e4 * 2 + 1] = cvt_pk_bf16(k2[2], k2[3]);
                if (t == 0) { f32x4 e1, e3;
#pragma unroll
                    for (int j = 0; j < 4; ++j) { e1[j] = __expf(p0[j] + p1[j]); e3[j] = __expf(p2[j] + p3[j]); }
                    float* gs = p.rkbuf + (size_t)(((b * 64 + ch) * 8 + h)) * 256 + c0 + e4 * 4; *(f32x4*)gs = e1; *(f32x4*)(gs + 128) = e3; }
            }
            const u32x4 qw0 = {qo[0], qo[1], qo[2], qo[3]}, qw1 = {qo[4], qo[5], qo[6], qo[7]}, kw0 = {ko[0], ko[1], ko[2], ko[3]}, kw1 = {ko[4], ko[5], ko[6], ko[7]};
            if (!dry) { *(u32x4*)hr = qw0; *(u32x4*)(hr + 8) = qw1; *(u32x4*)(hr + 1024) = kw0; *(u32x4*)(hr + 1032) = kw1; }
            *(u32x4*)(KB + t * 136 + c0) = kw0; *(u32x4*)(KB + t * 136 + c0 + 8) = kw1;
        }
        __syncthreads();
        {
            unsigned iw[8], kw[8];
#pragma unroll
            for (int e = 0; e < 8; ++e) {
                iw[e] = (unsigned)IB[(tq * 16 + 2 * e) * 136 + cc] | ((unsigned)IB[(tq * 16 + 2 * e + 1) * 136 + cc] << 16);
                kw[e] = (unsigned)KB[(tq * 16 + 2 * e) * 136 + cc] | ((unsigned)KB[(tq * 16 + 2 * e + 1) * 136 + cc] << 16); }
            bf16_t* ir = p.H + (r0 + (cc >> 1)) * LDC_H + 2048 + h * 128 + (cc & 1) * 64 + tq * 16;
            if (!dry) { *(u32x4*)ir = (u32x4){iw[0], iw[1], iw[2], iw[3]}; *(u32x4*)(ir + 8) = (u32x4){iw[4], iw[5], iw[6], iw[7]}; }
            bf16_t* kr = xtra + (r0 + (cc >> 1)) * DM + h * 128 + (cc & 1) * 64 + tq * 16;
            *(u32x4*)kr = (u32x4){kw[0], kw[1], kw[2], kw[3]}; *(u32x4*)(kr + 8) = (u32x4){kw[4], kw[5], kw[6], kw[7]};
        }
        __syncthreads();
    }
}

struct HgSet { u32x4 r[7]; };
__device__ __forceinline__ void hg_issue(HgSet& R, const bf16_t* H, const bf16_t* xtra, const float* gsc, int b, int ch, int h, int vs, int tid) {
    const size_t r0 = (size_t)b * SEQ + (size_t)ch * 64;
    const int row = tid >> 4, wi = tid & 15;
#pragma unroll
    for (int j = 0; j < 2; ++j) { const int t = j * 32 + row; R.r[j] = *(const u32x4*)(H + (r0 + t) * LDC_H + h * 128 + wi * 8); R.r[2 + j] = *(const u32x4*)(H + (r0 + t) * LDC_H + 1024 + h * 128 + wi * 8); }
#pragma unroll
    for (int j = 0; j < 2; ++j) { const int kp = j * 32 + row; R.r[4 + j] = *(const u32x4*)(xtra + (r0 + kp) * DM + h * 128 + wi * 8); }
    const u32x4 z4 = {0u, 0u, 0u, 0u}; R.r[6] = z4;
    if (tid < 256) R.r[6] = *(const u32x4*)(H + (r0 + vs * 16 + row) * LDC_H + 2048 + h * 128 + wi * 8);
    else if (tid < 320) R.r[6] = *(const u32x4*)(gsc + (size_t)(((b * 64 + ch) * 8 + h)) * 256 + (tid - 256) * 4);
}
constexpr int HG_QM = 0, HG_KM = 16 * 65 * 16, HG_KT = 2 * 16 * 65 * 16, HG_IT = HG_KT + 8 * 129 * 16, HG_E = HG_IT + 8 * 33 * 16, HG_BUF = HG_E + 1024;
__device__ __forceinline__ void hg_stage(const HgSet& R, unsigned char* B, int tid) {
    const int row = tid >> 4, wi = tid & 15;
#pragma unroll
    for (int j = 0; j < 2; ++j) { const int t = j * 32 + row; *(u32x4*)(B + HG_QM + (wi * 65 + t) * 16) = R.r[j]; *(u32x4*)(B + HG_KM + (wi * 65 + t) * 16) = R.r[2 + j]; }
#pragma unroll
    for (int j = 0; j < 2; ++j) { const int k = (j * 32 + row) * 2 + (wi >> 3), sc = wi & 7; *(u32x4*)(B + HG_KT + (sc * 129 + k) * 16) = R.r[4 + j]; }
    if (tid < 256) { const int vv = row * 2 + (wi >> 3), sc = wi & 7; *(u32x4*)(B + HG_IT + (sc * 33 + vv) * 16) = R.r[6]; }
    else if (tid < 320) *(u32x4*)(B + HG_E + (tid - 256) * 16) = R.r[6];
}

__device__ void phase_hgrn_seq(int l, unsigned char* smem, bool dry) {
    const Params p = load_params();
    unsigned char* img = smem;
    bf16_t* att = (bf16_t*)(smem + 2 * HG_BUF);
    bf16_t* STs = att + 64 * 72;
    const int tid = opaque_tid(), w = __builtin_amdgcn_readfirstlane(tid >> 6), lane = tid & 63, fr = lane & 15, fq = lane >> 4;
    const bf16_t* xtra = (l == 0) ? (const bf16_t*)p.out : p.vf;
    const int tt_ = w >> 1, sp = w & 1;
    for (int item = blockIdx.x; item < NB * 32; item += gridDim.x) {
        const int xc_ = item & 7, sl_ = item >> 3, vs = sl_ & 3, gi_ = (sl_ >> 2) * 8 + xc_, h = gi_ & 7, b = gi_ >> 3;
        __syncthreads();
        for (int e = tid; e < 32 * 136 / 2; e += 512) ((unsigned*)STs)[e] = 0u;
        f32x4 S[2] = {{0.f, 0.f, 0.f, 0.f}, {0.f, 0.f, 0.f, 0.f}};
        u32x2 o0 = {0u, 0u};
        HgSet R0, R1;
        hg_issue(R0, p.H, xtra, p.rkbuf, b, 0, h, vs, tid); hg_stage(R0, img, tid);
        hg_issue(R1, p.H, xtra, p.rkbuf, b, 1, h, vs, tid); hg_issue(R0, p.H, xtra, p.rkbuf, b, 2, h, vs, tid);
        __syncthreads();
        auto iter = [&](const int ch, HgSet& RS) {
            const size_t r0 = (size_t)b * SEQ + (size_t)ch * 64;
            const unsigned char* B = img + (ch & 1) * HG_BUF; unsigned char* Bn = img + ((ch + 1) & 1) * HG_BUF;
            bf16x8 qf[4];
#pragma unroll
            for (int ks = 0; ks < 4; ++ks) qf[ks] = *(const bf16x8*)(B + HG_QM + ((ks * 4 + fq) * 65 + tt_ * 16 + fr) * 16);
#pragma unroll
            for (int q = 0; q < 2; ++q) { const int stile = sp * 2 + q; f32x4 a = {0.f, 0.f, 0.f, 0.f};
                if (stile <= tt_) {
#pragma unroll
                    for (int ks = 0; ks < 4; ++ks) { const bf16x8 kf = *(const bf16x8*)(B + HG_KM + ((ks * 4 + fq) * 65 + stile * 16 + fr) * 16); a = __builtin_amdgcn_mfma_f32_16x16x32_bf16(qf[ks], kf, a, 0, 0, 0); } }
#pragma unroll
                for (int j = 0; j < 4; ++j) { const int t = tt_ * 16 + fq * 4 + j, s = stile * 16 + fr; att[t * 72 + s] = f2bf(s <= t ? a[j] : 0.f); } }
            if (ch + 1 < 64) hg_stage(RS, Bn, tid);
            if (ch + 3 < 64) hg_issue(RS, p.H, xtra, p.rkbuf, b, ch + 3, h, vs, tid);
            __syncthreads();
            f32x4 o = {0.f, 0.f, 0.f, 0.f};
#pragma unroll
            for (int ks = 0; ks < 2; ++ks) { const bf16x8 af = *(const bf16x8*)(att + (tt_ * 16 + fr) * 72 + ks * 32 + fq * 8); const bf16x8 itf = *(const bf16x8*)(B + HG_IT + ((ks * 4 + fq) * 33 + sp * 16 + fr) * 16);
                o = __builtin_amdgcn_mfma_f32_16x16x32_bf16(itf, af, o, 0, 0, 0); }
#pragma unroll
            for (int ks = 0; ks < 4; ++ks) { const bf16x8 sf = *(const bf16x8*)(STs + (sp * 16 + fr) * 136 + ks * 32 + fq * 8);
                o = __builtin_amdgcn_mfma_f32_16x16x32_bf16(sf, qf[ks], o, 0, 0, 0); }
            { u32x2 ow; ow.x = cvt_pk_bf16(o[0], o[1]); ow.y = cvt_pk_bf16(o[2], o[3]);
              if (ch == 0) o0 = ow;
              else if (!dry) { const int t = tt_ * 16 + fr; *(u32x2*)(p.H + (r0 - 64 + vs * 16 + (t >> 2)) * LDC_H + 2048 + h * 128 + (t & 3) * 32 + sp * 16 + fq * 4) = ow; } }
            const f32x4 e1 = *(const f32x4*)(B + HG_E + (w * 16 + fq * 4) * 4), e3 = *(const f32x4*)(B + HG_E + 512 + (w * 16 + fq * 4) * 4);
            bf16x8 ktf[2];
#pragma unroll
            for (int ks = 0; ks < 2; ++ks) ktf[ks] = *(const bf16x8*)(B + HG_KT + ((ks * 4 + fq) * 129 + w * 16 + fr) * 16);
#pragma unroll
            for (int vt = 0; vt < 2; ++vt) { f32x4 u = {0.f, 0.f, 0.f, 0.f};
#pragma unroll
                for (int ks = 0; ks < 2; ++ks) { const bf16x8 itf = *(const bf16x8*)(B + HG_IT + ((ks * 4 + fq) * 33 + vt * 16 + fr) * 16); u = __builtin_amdgcn_mfma_f32_16x16x32_bf16(ktf[ks], itf, u, 0, 0, 0); }
#pragma unroll
                for (int j = 0; j < 4; ++j) S[vt][j] = e3[j] * (e1[j] * S[vt][j] + u[j]); }
            __syncthreads();
            if (ch + 1 < 64) { const f32x4 e1n = *(const f32x4*)(Bn + HG_E + (w * 16 + fq * 4) * 4);
#pragma unroll
                for (int vt = 0; vt < 2; ++vt) { u32x2 sw; sw.x = cvt_pk_bf16(S[vt][0] * e1n[0], S[vt][1] * e1n[1]); sw.y = cvt_pk_bf16(S[vt][2] * e1n[2], S[vt][3] * e1n[3]);
                    *(u32x2*)(STs + (vt * 16 + fr) * 136 + w * 16 + fq * 4) = sw; } }
        };
        for (int ch = 0; ch < 64; ch += 2) { iter(ch, R1); iter(ch + 1, R0); }
        if (!dry) { const int t = tt_ * 16 + fr; *(u32x2*)(p.H + ((size_t)b * SEQ + 63 * 64 + vs * 16 + (t >> 2)) * LDC_H + 2048 + h * 128 + (t & 3) * 32 + sp * 16 + fq * 4) = o0; }
    }
    __syncthreads();
}

__device__ void phase_hgrn_post(int l) {
    const Params p = load_params();
    const int tid = opaque_tid(), l8 = tid & 7;
    const int ngrp = T_TOK * 8;
    for (int g = blockIdx.x * 64 + (tid >> 3); g < ngrp; g += gridDim.x * 64) {
        const int tok = g >> 3, h = g & 7, b = tok / SEQ, tin = tok % SEQ, ch = tin >> 6, t = tin & 63, slot = (ch + 63) & 63, vs = l8 >> 1, vv0 = (l8 & 1) * 16;
        const bf16_t* op = p.H + ((size_t)b * SEQ + slot * 64 + vs * 16 + (t >> 2)) * LDC_H + 2048 + h * 128 + (t & 3) * 32 + vv0;
        bf16_t* zp = p.H + (size_t)tok * LDC_H + 3072 + h * 128 + l8 * 16;
        const u32x4 a0 = *(const u32x4*)op, a1 = *(const u32x4*)(op + 8), z0 = *(const u32x4*)zp, z1 = *(const u32x4*)(zp + 8);
        const float ov[16] = {bflo(a0.x), bfhi(a0.x), bflo(a0.y), bfhi(a0.y), bflo(a0.z), bfhi(a0.z), bflo(a0.w), bfhi(a0.w), bflo(a1.x), bfhi(a1.x), bflo(a1.y), bfhi(a1.y), bflo(a1.z), bfhi(a1.z), bflo(a1.w), bfhi(a1.w)};
        const float zf[16] = {bflo(z0.x), bfhi(z0.x), bflo(z0.y), bfhi(z0.y), bflo(z0.z), bfhi(z0.z), bflo(z0.w), bfhi(z0.w), bflo(z1.x), bfhi(z1.x), bflo(z1.y), bfhi(z1.y), bflo(z1.z), bfhi(z1.z), bflo(z1.w), bfhi(z1.w)};
        float ss = 0.f;
#pragma unroll
        for (int e = 0; e < 16; ++e) ss += ov[e] * ov[e];
        ss = red8(ss); const float rinv = rsqrtf(ss * (1.0f / 128.f) + EPS);
        const float* gn = p.hgrn_g + (size_t)l * DM + h * 128 + l8 * 16;
        float r[16];
#pragma unroll
        for (int e = 0; e < 16; ++e) r[e] = ov[e] * rinv * gn[e] * siluf_(zf[e]);
        u32x4 w0, w1; w0.x = cvt_pk_bf16(r[0], r[1]); w0.y = cvt_pk_bf16(r[2], r[3]); w0.z = cvt_pk_bf16(r[4], r[5]); w0.w = cvt_pk_bf16(r[6], r[7]);
        w1.x = cvt_pk_bf16(r[8], r[9]); w1.y = cvt_pk_bf16(r[10], r[11]); w1.z = cvt_pk_bf16(r[12], r[13]); w1.w = cvt_pk_bf16(r[14], r[15]);
        *(u32x4*)zp = w0; *(u32x4*)(zp + 8) = w1;
    }
}


#define XB_TMO      128
#define XB_XCNT(j)  (256  + 64 * (j))
#define XB_XSUB(j)  (1280 + 64 * (j))
#define XB_XGEN(j)  (2304 + 64 * (j))
#define XB_TOP      3328
#define XB_TOPGEN   3392
#define XCD_BAR_WORDS 3456
#define XB_SPIN_CAP (1u << 18)
__device__ __forceinline__ unsigned xb_ld(unsigned* p)              { return __hip_atomic_load(p, __ATOMIC_RELAXED, __HIP_MEMORY_SCOPE_AGENT); }
__device__ __forceinline__ unsigned xb_add(unsigned* p, unsigned v) { return __hip_atomic_fetch_add(p, v, __ATOMIC_RELAXED, __HIP_MEMORY_SCOPE_AGENT); }
__device__ __forceinline__ unsigned xb_xcc_id() { return (unsigned)__builtin_amdgcn_s_getreg((3 << 11) | 20) & 0xFu; }
#define XB_SPIN(cond, bar) do { unsigned _sp = 0; while (cond) { __builtin_amdgcn_s_sleep(1); \
    if ((++_sp & 255u) == 0u) { if (xb_ld(&(bar)[XB_TMO])) break; if (_sp > XB_SPIN_CAP) { atomicAdd(&(bar)[XB_TMO], 1u); break; } } } } while (0)
struct XcdBarrier { unsigned* bar; unsigned x; volatile LAS unsigned* st; };
__device__ __forceinline__ XcdBarrier xcd_barrier_post(unsigned* bar, volatile LAS unsigned* st) {
    XcdBarrier b; b.bar = bar; b.x = xb_xcc_id(); b.st = st;
    if (threadIdx.x == 0) (void)xb_add(&bar[XB_XCNT(b.x)], 1u);
    return b;
}
__device__ __forceinline__ void xcd_barrier_complete(unsigned* bar, unsigned x, unsigned& nloc, unsigned& nx) {
    const unsigned G = gridDim.x * gridDim.y * gridDim.z;
    unsigned sum, cnt, mine, sp = 0u;
    for (;;) {
        sum = 0u; cnt = 0u; mine = 0u;
#pragma unroll
        for (unsigned j = 0; j < 16; ++j) { const unsigned c = xb_ld(&bar[XB_XCNT(j)]); sum += c; cnt += (c > 0u) ? 1u : 0u; mine = (j == x) ? c : mine; }
        if (sum == G) break;
        __builtin_amdgcn_s_sleep(1);
        if ((++sp & 255u) == 0u) { if (xb_ld(&bar[XB_TMO])) break; if (sp > XB_SPIN_CAP) { atomicAdd(&bar[XB_TMO], 1u); break; } }
    }
    nloc = mine > 0u ? mine : 1u; nx = cnt > 0u ? cnt : 1u;
}
__device__ __forceinline__ void xcd_barrier(const XcdBarrier& b) {
    asm volatile("s_waitcnt vmcnt(0)" ::: "memory");
    __syncthreads();
    if (threadIdx.x == 0) {
        unsigned* bar = b.bar;
        __builtin_amdgcn_s_waitcnt(0);
        unsigned nloc = b.st[0], nx = b.st[1];
        if (nloc == 0u) { xcd_barrier_complete(bar, b.x, nloc, nx); b.st[0] = nloc; b.st[1] = nx; }
        const unsigned old = xb_add(&bar[XB_XSUB(b.x)], 1u);
        const unsigned gen = old / nloc;
        if (old + 1u == (gen + 1u) * nloc) {
            __builtin_amdgcn_fence(__ATOMIC_RELEASE, "agent");
            asm volatile("s_waitcnt vmcnt(0)" ::: "memory");
            const unsigned og = xb_add(&bar[XB_TOP], 1u);
            const unsigned tg = og / nx;
            if (og + 1u == (tg + 1u) * nx) xb_add(&bar[XB_TOPGEN], 1u);
            else XB_SPIN(xb_ld(&bar[XB_TOPGEN]) == tg, bar);
            __builtin_amdgcn_fence(__ATOMIC_ACQUIRE, "agent");
            xb_add(&bar[XB_XGEN(b.x)], 1u);
            asm volatile("s_waitcnt vmcnt(0)" ::: "memory");
        } else {
            XB_SPIN(xb_ld(&bar[XB_XGEN(b.x)]) == gen, bar);
            __builtin_amdgcn_fence(__ATOMIC_ACQUIRE, "agent");
            asm volatile("s_waitcnt vmcnt(0)" ::: "memory");
        }
    }
    __syncthreads();
}

constexpr int PH_PER_LAYER = 14, N_PHASES = 2 * PH_PER_LAYER + 1;

__global__ void __launch_bounds__(512, 2) fwd_megakernel(Params pk) {
    extern __shared__ __attribute__((aligned(16))) unsigned char shm[];
    LAS unsigned char* lds = (LAS unsigned char*)shm;
    cg::grid_group grid = cg::this_grid();
    const int phase_lo = pk.phase_lo, phase_hi = pk.phase_hi;
    volatile LAS unsigned* xst = (volatile LAS unsigned*)(lds + LDS_BYTES - 16);
    XcdBarrier xb; xb.bar = pk.bar; xb.x = 0; xb.st = xst;
    if (phase_hi - phase_lo > 1) { if (threadIdx.x == 0) { xst[0] = 0u; xst[1] = 0u; } __syncthreads(); xb = xcd_barrier_post(pk.bar, xst); }
    for (int ph = phase_lo; ph < phase_hi; ++ph) {
        const int l = ph / PH_PER_LAYER, q = ph % PH_PER_LAYER;
        if (ph == N_PHASES - 1) {
            const Params p = load_params();
            phase_rmsnorm(p.out, p.final_g, nullptr, p.out);
        } else if (q == 0) {
            { const int nrep = (PROBE_Q == 0 && l == 0) ? 2 : 1; for (int rep = 0; rep < nrep; ++rep) {
            phase_convert(l, shm);
            const Params p = load_params();
            phase_rmsnorm(l == 0 ? p.x : p.out, p.norm_g + (size_t)l * DM, p.xn, nullptr); } }
        } else if (q == 1 || q == 5 || q == 8) {
            const Params p = load_params(); const int G = gridDim.x, cidx = opaque_bid();
            const int N = (q == 1) ? LDA_H : (q == 5) ? LDB_H : LDC_H; const int r0 = (q == 1) ? 0 : (q == 5) ? LDA_H : (LDA_H + LDB_H);
            pg8::GemmDesc g; g.A = p.xn; g.Bt = p.Wt + (size_t)r0 * DM; g.lda = DM;
            pg8::Sched S; S.init(T_TOK, N, G, cidx, 1);
            pg8::EpiStore E; E.O = p.H; E.ldc = N;
{ const int nrep = ((PROBE_Q == 1 && l == 0 && q == 1) || (PROBE_Q == 50 && l == 0 && q == 5) || (PROBE_Q == 80 && l == 0 && q == 8)) ? 2 : 1; for (int rep = 0; rep < nrep; ++rep) pg8::gemm_phase(lds, g, g, S, E); }
        } else if (q == 2) {
{ const int nrep = (PROBE_Q == 2 && l == 0) ? 2 : 1; for (int rep = 0; rep < nrep; ++rep) phase_rwkv(l, shm, rep + 1 < nrep ? PROBE_MODE : 0); }
        } else if (q == 3) {
            phase_rwkv_post(l, nullptr);
        } else if (q == 6) {
{ const int nrep = (PROBE_Q == 6 && l == 0) ? 2 : 1; for (int rep = 0; rep < nrep; ++rep) { const Params p = load_params(); phase_sgu(l, shm, rep + 1 < nrep ? (bf16_t*)p.out : nullptr); } }
        } else if (q == 9) {
            { const int nrep = (PROBE_Q == 9 && l == 0) ? 2 : 1; for (int rep = 0; rep < nrep; ++rep) phase_hgrn_pre(l, shm, rep + 1 < nrep); }
        } else if (q == 10) {
            { const int nrep = (PROBE_Q == 10 && l == 0) ? 2 : 1; for (int rep = 0; rep < nrep; ++rep) phase_hgrn_seq(l, shm, rep + 1 < nrep); }
        } else if (q == 11) {
            phase_hgrn_post(l);
        } else if (q == 4 || q == 7 || q == 12) {
            const Params p = load_params(); const int G = gridDim.x, cidx = opaque_bid();
            bf16_t* WtBr = p.Wt + (size_t)WT_ROWS * DM;
            const int n = (q == 4) ? 0 : (q == 7) ? 1 : 2; const int ldh = (n == 0) ? LDA_H : (n == 1) ? LDB_H : LDC_H; const int ocol = (n == 0) ? 3200 : (n == 1) ? 2048 : 3072;
            pg8::GemmDesc g0, g1; g0.A = p.xn; g0.Bt = p.Wt + (size_t)(LDA_H + LDB_H + LDC_H + n * DM) * DM; g0.lda = DM;
            g1.A = p.H + ocol; g1.Bt = WtBr + (size_t)n * DM * DM; g1.lda = ldh;
            pg8::Sched S; S.init(T_TOK, DM, G, cidx, 2);
            pg8::EpiMerge E; E.G = p.H; E.ldg = ldh; E.bias = p.b_merge + ((size_t)l * 3 + n) * DM; E.Y = p.y; E.accum = (n > 0);
            { const int nrep = (PROBE_Q == 4 && l == 0 && q == 4) ? 2 : 1; for (int rep = 0; rep < nrep; ++rep) pg8::gemm_phase(lds, g0, g1, S, E); }
        } else {
            const Params p = load_params(); const int G = gridDim.x, cidx = opaque_bid();
            bf16_t* WtOut = p.Wt + (size_t)WT_ROWS * DM + (size_t)3 * DM * DM;
            pg8::GemmDesc g; g.A = p.y; g.Bt = WtOut; g.lda = DM;
            pg8::Sched S; S.init(T_TOK, DM, G, cidx, 1);
            pg8::EpiResid E; E.Xin = (l == 0) ? p.x : p.out; E.Xout = p.out;
            { const int nrep = (PROBE_Q == 13 && l == 0) ? 2 : 1; for (int rep = 0; rep < nrep; ++rep) pg8::gemm_phase(lds, g, g, S, E); }
        }
        if (ph + 1 < phase_hi) { if (ph == phase_lo) grid.sync(); else xcd_barrier(xb); }
    }
}

extern "C" void kernel_launch(void* const* d_in, const int* in_sizes, int n_in, void* d_out, int out_size, void* d_ws, size_t ws_size, hipStream_t stream) {
    static int grid_blocks = 0;
    if (!grid_blocks) {
        int dev = 0, cus = 0, per_cu = 0;
        hipGetDevice(&dev);
        hipDeviceGetAttribute(&cus, hipDeviceAttributeMultiprocessorCount, dev);
        if (hipFuncSetAttribute((const void*)fwd_megakernel, hipFuncAttributeMaxDynamicSharedMemorySize, LDS_BYTES) != hipSuccess) { fprintf(stderr, "hipFuncSetAttribute failed\n"); return; }
        hipOccupancyMaxActiveBlocksPerMultiprocessor(&per_cu, (const void*)fwd_megakernel, 512, LDS_BYTES);
        if (per_cu < 1) { fprintf(stderr, "occupancy query says 0 blocks per CU\n"); return; }
        grid_blocks = cus * 1;
    }
    Params p{};
    const float** fp = (const float**)&p;
    for (int i = 0; i < 26; ++i) fp[i] = (const float*)d_in[i];
    p.out = (float*)d_out;
    unsigned char* ws = (unsigned char*)d_ws; size_t off = 0;
    auto take = [&](size_t bytes) { unsigned char* r = ws + off; off += (bytes + 255) & ~(size_t)255; return r; };
    p.Wt = (bf16_t*)take(((size_t)WT_ROWS * DM + 4 * (size_t)DM * DM) * 2);
    p.xn = (bf16_t*)take((size_t)T_TOK * DM * 2);
    p.vf = (bf16_t*)take((size_t)T_TOK * DM * 2);
    p.y = (bf16_t*)take((size_t)T_TOK * DM * 2);
    p.H = (bf16_t*)take((size_t)T_TOK * LDA_H * 2);
    p.rkbuf = (float*)take((size_t)T_TOK * 16 * 2 * 4);
    p.bar = (unsigned*)take((size_t)XCD_BAR_WORDS * 4);
    if (off > ws_size) { fprintf(stderr, "workspace too small: need %zu have %zu\n", off, ws_size); return; }
#if SINGLE_LAUNCH
    p.phase_lo = 0; p.phase_hi = N_PHASES;
    void* args[] = {&p};
    if (hipMemsetAsync(p.bar, 0, (size_t)XCD_BAR_WORDS * 4, stream) != hipSuccess) { fprintf(stderr, "memset failed\n"); return; }
    hipError_t e = hipLaunchCooperativeKernel((const void*)fwd_megakernel, dim3(grid_blocks), dim3(512), args, LDS_BYTES, stream);
    if (e != hipSuccess) fprintf(stderr, "cooperative launch failed: %s (grid %d)\n", hipGetErrorString(e), grid_blocks);
#else
    for (int ph = 0; ph < N_PHASES; ++ph) {
        p.phase_lo = ph; p.phase_hi = ph + 1;
        hipLaunchKernelGGL(fwd_megakernel, dim3(grid_blocks), dim3(512), LDS_BYTES, stream, p);
    }
#endif
}
```

```cpp
#include <hip/hip_runtime.h>
#include <hip/hip_cooperative_groups.h>
#include <cstdio>
namespace cg = cooperative_groups;

#ifndef PROBE_MODE
#define PROBE_MODE 0
#endif
#ifndef PROBE_Q
#define PROBE_Q -1
#endif
#ifndef SINGLE_LAUNCH
#define SINGLE_LAUNCH 1
#endif

typedef unsigned short bf16_t;
typedef short bf16x8 __attribute__((ext_vector_type(8)));
typedef float f32x4 __attribute__((ext_vector_type(4)));
typedef float f32x2 __attribute__((ext_vector_type(2)));
typedef unsigned u32x4 __attribute__((ext_vector_type(4)));
typedef unsigned u32x2 __attribute__((ext_vector_type(2)));
#define LAS __attribute__((address_space(3)))

constexpr int T_TOK = 32768, DM = 1024, SEQ = 4096, NB = 8;
constexpr int N_IN = 14464;
constexpr int LDA_H = 4352, LDB_H = 3072, LDC_H = 4096;
constexpr int WT_ROWS = 14592;
constexpr int LDS_BYTES = 163840;
constexpr float EPS = 1e-6f, GN_EPS = 64e-5f;

struct Params {
    const float *x, *norm_g, *w_in, *b_merge, *mu, *w0, *w_w2, *a0, *a_w2, *v0, *v_w1, *v_w2, *k_k, *k_a, *r_k, *lnx_g, *lnx_b,
        *sgu_ln_g, *sgu_ln_b, *sgu_w, *sgu_b, *lb_logits, *hgrn_g, *w_branch, *w_out, *final_g;
    float* out;
    bf16_t *Wt, *xn, *vf, *y, *H;
    float* rkbuf;
    unsigned* bar;
    int phase_lo, phase_hi;
};

__device__ __forceinline__ float bf2f(bf16_t h) { return __uint_as_float(((unsigned)h) << 16); }
__device__ __forceinline__ float bflo(unsigned u) { return __uint_as_float(u << 16); }
__device__ __forceinline__ float bfhi(unsigned u) { return __uint_as_float(u & 0xffff0000u); }
typedef __bf16 bf16x2_t __attribute__((ext_vector_type(2)));
__device__ __forceinline__ unsigned cvt_pk_bf16(float lo, float hi) { const f32x2 v = {lo, hi}; const bf16x2_t r = __builtin_convertvector(v, bf16x2_t); return __builtin_bit_cast(unsigned, r); }
__device__ __forceinline__ bf16_t f2bf(float f) { return (bf16_t)(cvt_pk_bf16(f, 0.f) & 0xffffu); }
__device__ __forceinline__ float sigmoidf_(float x) { return __builtin_amdgcn_rcpf(1.0f + __expf(-x)); }
__device__ __forceinline__ float siluf_(float x) { return x * __builtin_amdgcn_rcpf(1.0f + __expf(-x)); }
__device__ __forceinline__ float tanh_fast(float x) { return 1.0f - 2.0f * __builtin_amdgcn_rcpf(1.0f + __expf(2.0f * x)); }

__device__ __forceinline__ Params load_params() {
#if defined(__HIP_DEVICE_COMPILE__)
    typedef const Params __attribute__((address_space(4)))* KP;
    KP kp = (KP)__builtin_amdgcn_kernarg_segment_ptr(); asm volatile("" : "+s"(kp)); return *kp;
#else
    return Params{};
#endif
}
__device__ __forceinline__ int opaque_tid() { int t = threadIdx.x; asm volatile("" : "+v"(t)); return t; }
__device__ __forceinline__ int opaque_bid() { int t = blockIdx.x; asm volatile("" : "+s"(t)); return t; }

namespace pg8 {
constexpr int BM = 256, BK = 64, HALF = 128, HTB = HALF * BK * 2, STAGE_BYTES = 8 * HTB, NXCD = 8, WGM = 8, KD = 1024;
__device__ __forceinline__ int lds_byte(int r, int c) { const int st = (r >> 4) * 2 + (c >> 5), rr = r & 15, cc = c & 31, ob = rr * 64 + cc * 2; return st * 1024 + (ob ^ (((ob >> 9) & 1) << 5)); }
__device__ __forceinline__ void stage_rc(int b, int& R, int& C) { const int st = b / 1024, sb = b % 1024, swz = sb ^ (((sb >> 9) & 1) << 5); R = (st >> 1) * 16 + swz / 64; C = (st & 1) * 32 + (swz % 64) / 2; }
__device__ __forceinline__ int perm32(int rho) { const int n = rho >> 4, i = rho & 15; return 8 * (i >> 2) + 4 * n + (i & 3); }

struct Unit { int pm, pn, sel; };
struct GemmDesc { const bf16_t* A; const bf16_t* Bt; int lda; };
struct Sched {
    int nM, nN, nwg, G, c, nsel;
    __device__ void init(int M, int N, int G_, int c_, int nsel_) { nM = M / BM; nN = N / BM; nwg = nM * nN; G = G_; c = c_; nsel = nsel_; }
    __device__ bool next(int i, Unit& u) const {
        const int ti = (nsel == 2) ? (i >> 1) : i; u.sel = (nsel == 2) ? (i & 1) : 0;
        const long L = (long)ti * G + c; if (L >= nwg) return false;
        int wgid = (int)L; { const int q = nwg / NXCD, r = nwg % NXCD, xcd = wgid % NXCD, off = wgid / NXCD; wgid = (xcd < r ? xcd * (q + 1) : r * (q + 1) + (xcd - r) * q) + off; }
        const int nig = WGM * nN, gid = wgid / nig, fm = gid * WGM, gsz = (nM - fm) < WGM ? (nM - fm) : WGM;
        u.pm = fm + ((wgid % nig) % gsz); u.pn = (wgid % nig) / gsz; return true;
    }
};

template <class Epi>
__device__ __forceinline__ void gemm_phase(LAS unsigned char* lds, const GemmDesc g0, const GemmDesc g1, const Sched& S, const Epi& E) {
    const int tid = opaque_tid(), wid = __builtin_amdgcn_readfirstlane(tid >> 6), lane = tid & 63, wr = wid >> 2, wc = wid & 3, fr = lane & 15, fq = lane >> 4;
    constexpr int K = KD, nt = K / BK;
    unsigned voffA0[2], voffA1[2], voffB[2];
#pragma unroll
    for (int i = 0; i < 2; ++i) { int R, C; stage_rc(tid * 16 + i * 8192, R, C); const int Rb = Epi::PERM ? ((R & ~31) + perm32(R & 31)) : R;
        voffA0[i] = (unsigned)(R * g0.lda + C) * 2u; voffA1[i] = (unsigned)(R * g1.lda + C) * 2u; voffB[i] = (unsigned)(Rb * K + C) * 2u; }
    const size_t kstep = (size_t)(BK * 2);
    const size_t hstepB = (size_t)HALF * K * 2;
    const unsigned ldsw = (unsigned)wid * 1024u;
    const int aoff = lds_byte(wr * 64 + fr, fq * 8), boff = lds_byte(wc * 32 + fr, fq * 8);
#define PG8_SA(b, h) (((b) * 2 + (h)) * HTB)
#define PG8_SB(b, h) ((4 + (b) * 2 + (h)) * HTB)
#define PG8_STAGE(bufoff, gbase, v0, v1) do { \
        __builtin_amdgcn_global_load_lds((const unsigned*)((const char*)(gbase) + (v0)), (LAS unsigned*)(lds + (bufoff) + ldsw), 16, 0, 0); \
        __builtin_amdgcn_global_load_lds((const unsigned*)((const char*)(gbase) + (v1)), (LAS unsigned*)(lds + (bufoff) + ldsw + 8192), 16, 0, 0); } while (0)
#define PG8_STAGEB(bufoff, gbase) PG8_STAGE(bufoff, gbase, voffB[0], voffB[1])
#define PG8_LDA(dst, b, h) do { _Pragma("unroll") for (int m = 0; m < 4; ++m) _Pragma("unroll") for (int k = 0; k < 2; ++k) dst[m][k] = *(const LAS bf16x8*)(lds + PG8_SA(b, h) + aoff + m * 2048 + k * 1024); } while (0)
#define PG8_LDB(dst, b, h) do { _Pragma("unroll") for (int n = 0; n < 2; ++n) _Pragma("unroll") for (int k = 0; k < 2; ++k) dst[n][k] = *(const LAS bf16x8*)(lds + PG8_SB(b, h) + boff + n * 2048 + k * 1024); } while (0)
#define PG8_MMA(ai, bj, At, Bt) do { __builtin_amdgcn_s_setprio(1); _Pragma("unroll") for (int m = 0; m < 4; ++m) _Pragma("unroll") for (int n = 0; n < 2; ++n) _Pragma("unroll") for (int k = 0; k < 2; ++k) \
        acc[ai][bj][m][n] = __builtin_amdgcn_mfma_f32_16x16x32_bf16(Bt[n][k], At[m][k], acc[ai][bj][m][n], 0, 0, 0); __builtin_amdgcn_s_setprio(0); } while (0)
#define PG8_WAIT_V(n) asm volatile("s_waitcnt vmcnt(" #n ")" ::: "memory")
#define PG8_WAIT_L(n) asm volatile("s_waitcnt lgkmcnt(" #n ")" ::: "memory")
#define PG8_BAR __builtin_amdgcn_s_barrier()
#define PG8_SCHED __builtin_amdgcn_sched_barrier(0)
    Unit cur, nxt; int ui = 0;
    if (!S.next(0, cur)) return;
    f32x4 acc[2][2][4][2];
#pragma unroll
    for (int a = 0; a < 2; ++a)
#pragma unroll
        for (int b = 0; b < 2; ++b)
#pragma unroll
            for (int m = 0; m < 4; ++m)
#pragma unroll
                for (int n = 0; n < 2; ++n) acc[a][b][m][n] = (f32x4){0.f, 0.f, 0.f, 0.f};
    bf16x8 At[4][2], B0[2][2], B1[2][2];
    const char* cA = (const char*)(cur.sel ? g1.A : g0.A) + (size_t)cur.pm * 256 * (size_t)(cur.sel ? g1.lda : g0.lda) * 2;
    const char* cB = (const char*)(cur.sel ? g1.Bt : g0.Bt) + (size_t)cur.pn * 256 * K * 2;
    size_t chA = (size_t)HALF * (cur.sel ? g1.lda : g0.lda) * 2;
    unsigned cv0 = cur.sel ? voffA1[0] : voffA0[0], cv1 = cur.sel ? voffA1[1] : voffA0[1];
    PG8_STAGEB(PG8_SB(0, 0), cB); PG8_STAGEB(PG8_SB(0, 1), cB + hstepB); PG8_STAGE(PG8_SA(0, 0), cA, cv0, cv1); PG8_STAGE(PG8_SA(0, 1), cA + chA, cv0, cv1);
    if (wr == 1) PG8_BAR;
    PG8_WAIT_V(2); PG8_BAR;
    PG8_STAGEB(PG8_SB(1, 0), cB + kstep); PG8_STAGE(PG8_SA(1, 0), cA + kstep, cv0, cv1); PG8_STAGEB(PG8_SB(1, 1), cB + hstepB + kstep);
    PG8_WAIT_V(6); PG8_BAR;
    for (;;) {
        const bool has_next = S.next(ui + 1, nxt);
        const int nsel = has_next ? nxt.sel : cur.sel;
        const char* nA = has_next ? (const char*)(nsel ? g1.A : g0.A) + (size_t)nxt.pm * 256 * (size_t)(nsel ? g1.lda : g0.lda) * 2 : cA;
        const char* nB = has_next ? (const char*)(nsel ? g1.Bt : g0.Bt) + (size_t)nxt.pn * 256 * K * 2 : cB;
        const size_t nhA = (size_t)HALF * (nsel ? g1.lda : g0.lda) * 2;
        const unsigned nv0 = nsel ? voffA1[0] : voffA0[0], nv1 = nsel ? voffA1[1] : voffA0[1];
        for (int t = 0; t < nt; t += 2) {
            const bool last = (t == nt - 2);
            const char* a1 = cA + (size_t)(t + 1) * kstep;
            const char* a2 = last ? nA : cA + (size_t)(t + 2) * kstep; const char* b2 = last ? nB : cB + (size_t)(t + 2) * kstep;
            const char* a3 = a2 + kstep; const char* b3 = b2 + kstep;
            const size_t h2 = last ? nhA : chA; const unsigned w0 = last ? nv0 : cv0, w1 = last ? nv1 : cv1;
            PG8_LDB(B0, 0, 0); PG8_LDB(B1, 0, 1); PG8_SCHED; PG8_LDA(At, 0, 0); PG8_STAGE(PG8_SA(1, 1), a1 + chA, cv0, cv1);
            PG8_WAIT_V(8); PG8_WAIT_L(0); PG8_BAR; PG8_MMA(0, 0, At, B0); PG8_MMA(0, 1, At, B1); PG8_BAR; PG8_SCHED;
            PG8_LDA(At, 0, 1); PG8_STAGEB(PG8_SB(0, 0), b2); PG8_STAGEB(PG8_SB(0, 1), b2 + hstepB); PG8_STAGE(PG8_SA(0, 0), a2, w0, w1);
            PG8_WAIT_V(8); PG8_WAIT_L(0); PG8_BAR; PG8_MMA(1, 0, At, B0); PG8_MMA(1, 1, At, B1); PG8_BAR; PG8_SCHED;
            PG8_LDB(B0, 1, 0); PG8_LDB(B1, 1, 1); PG8_SCHED; PG8_LDA(At, 1, 0); PG8_STAGE(PG8_SA(0, 1), a2 + h2, w0, w1);
            PG8_WAIT_V(8); PG8_WAIT_L(0); PG8_BAR; PG8_MMA(0, 0, At, B0); PG8_MMA(0, 1, At, B1); PG8_BAR; PG8_SCHED;
            PG8_LDA(At, 1, 1); PG8_STAGEB(PG8_SB(1, 0), b3); PG8_STAGEB(PG8_SB(1, 1), b3 + hstepB); PG8_STAGE(PG8_SA(1, 0), a3, w0, w1);
            PG8_WAIT_V(8); PG8_WAIT_L(0); PG8_BAR; PG8_MMA(1, 0, At, B0); PG8_MMA(1, 1, At, B1); PG8_BAR; PG8_SCHED;
        }
        if (wr == 0) PG8_BAR;
        E(acc, cur, wr, wc, fr, fq);
        if (!has_next) break;
#pragma unroll
        for (int a = 0; a < 2; ++a)
#pragma unroll
            for (int b = 0; b < 2; ++b)
#pragma unroll
                for (int m = 0; m < 4; ++m)
#pragma unroll
                    for (int n = 0; n < 2; ++n) acc[a][b][m][n] = (f32x4){0.f, 0.f, 0.f, 0.f};
        cur = nxt; cA = nA; cB = nB; chA = nhA; cv0 = nv0; cv1 = nv1; ++ui;
        if (wr == 1) PG8_BAR;
    }
    PG8_WAIT_V(0);
    PG8_BAR;
#undef PG8_SA
#undef PG8_SB
#undef PG8_STAGE
#undef PG8_STAGEB
#undef PG8_LDA
#undef PG8_LDB
#undef PG8_MMA
#undef PG8_WAIT_V
#undef PG8_WAIT_L
#undef PG8_BAR
#undef PG8_SCHED
}

struct EpiStore {
    static constexpr bool PERM = true;
    bf16_t* O; int ldc;
    __device__ __forceinline__ void operator()(const f32x4 (&acc)[2][2][4][2], const Unit& u, int wr, int wc, int fr, int fq) const {
        const int row0 = u.pm * BM + wr * 64 + fr, col0 = u.pn * BM + wc * 32 + 8 * fq;
#pragma unroll
        for (int ai = 0; ai < 2; ++ai)
#pragma unroll
            for (int m = 0; m < 4; ++m) { bf16_t* rowp = O + (size_t)(row0 + ai * HALF + m * 16) * ldc + col0;
#pragma unroll
                for (int bj = 0; bj < 2; ++bj) { const f32x4 v0 = acc[ai][bj][m][0], v1 = acc[ai][bj][m][1];
                    u32x4 w; w.x = cvt_pk_bf16(v0[0], v0[1]); w.y = cvt_pk_bf16(v0[2], v0[3]); w.z = cvt_pk_bf16(v1[0], v1[1]); w.w = cvt_pk_bf16(v1[2], v1[3]);
                    *(u32x4*)(rowp + bj * HALF) = w; } }
    }
};
struct EpiMerge {
    static constexpr bool PERM = true;
    bf16_t* G; int ldg; const float* bias; bf16_t* Y; int accum;
    __device__ __forceinline__ void operator()(const f32x4 (&acc)[2][2][4][2], const Unit& u, int wr, int wc, int fr, int fq) const {
        const int row0 = u.pm * BM + wr * 64 + fr, col0 = u.pn * BM + wc * 32 + 8 * fq;
        if (u.sel == 0) {
            f32x4 bv[2][2];
#pragma unroll
            for (int bj = 0; bj < 2; ++bj)
#pragma unroll
                for (int n = 0; n < 2; ++n) bv[bj][n] = *(const f32x4*)(bias + col0 + bj * HALF + 4 * n);
#pragma unroll
            for (int ai = 0; ai < 2; ++ai)
#pragma unroll
                for (int m = 0; m < 4; ++m) { bf16_t* rowp = G + (size_t)(row0 + ai * HALF + m * 16) * ldg + col0;
#pragma unroll
                    for (int bj = 0; bj < 2; ++bj) { f32x4 v0 = acc[ai][bj][m][0] + bv[bj][0], v1 = acc[ai][bj][m][1] + bv[bj][1];
#pragma unroll
                        for (int j = 0; j < 4; ++j) { v0[j] = sigmoidf_(v0[j]); v1[j] = sigmoidf_(v1[j]); }
                        u32x4 w; w.x = cvt_pk_bf16(v0[0], v0[1]); w.y = cvt_pk_bf16(v0[2], v0[3]); w.z = cvt_pk_bf16(v1[0], v1[1]); w.w = cvt_pk_bf16(v1[2], v1[3]);
                        *(u32x4*)(rowp + bj * HALF) = w; } }
        } else {
#pragma unroll
            for (int ai = 0; ai < 2; ++ai)
#pragma unroll
                for (int m = 0; m < 4; ++m) { const size_t r = (size_t)(row0 + ai * HALF + m * 16);
                    const unsigned long long* gp = (const unsigned long long*)(G + r * ldg + col0); bf16_t* yp = Y + r * DM + col0;
#pragma unroll
                    for (int bj = 0; bj < 2; ++bj) {
                        const unsigned long long g0 = __hip_atomic_load(gp + bj * (HALF / 4), __ATOMIC_RELAXED, __HIP_MEMORY_SCOPE_AGENT);
                        const unsigned long long g1 = __hip_atomic_load(gp + bj * (HALF / 4) + 1, __ATOMIC_RELAXED, __HIP_MEMORY_SCOPE_AGENT);
                        const unsigned gw[4] = {(unsigned)g0, (unsigned)(g0 >> 32), (unsigned)g1, (unsigned)(g1 >> 32)};
                        u32x4 yo = {0u, 0u, 0u, 0u}; if (accum) yo = *(const u32x4*)(yp + bj * HALF);
                        const f32x4 v0 = acc[ai][bj][m][0], v1 = acc[ai][bj][m][1];
                        u32x4 w;
                        w.x = cvt_pk_bf16(bflo(yo.x) + bflo(gw[0]) * v0[0], bfhi(yo.x) + bfhi(gw[0]) * v0[1]);
                        w.y = cvt_pk_bf16(bflo(yo.y) + bflo(gw[1]) * v0[2], bfhi(yo.y) + bfhi(gw[1]) * v0[3]);
                        w.z = cvt_pk_bf16(bflo(yo.z) + bflo(gw[2]) * v1[0], bfhi(yo.z) + bfhi(gw[2]) * v1[1]);
                        w.w = cvt_pk_bf16(bflo(yo.w) + bflo(gw[3]) * v1[2], bfhi(yo.w) + bfhi(gw[3]) * v1[3]);
                        *(u32x4*)(yp + bj * HALF) = w; } }
        }
    }
};
struct EpiResid {
    static constexpr bool PERM = false;
    const float* Xin; float* Xout;
    __device__ __forceinline__ void operator()(const f32x4 (&acc)[2][2][4][2], const Unit& u, int wr, int wc, int fr, int fq) const {
        const int row0 = u.pm * BM + wr * 64 + fr, col0 = u.pn * BM + wc * 32 + 4 * fq;
#pragma unroll
        for (int ai = 0; ai < 2; ++ai)
#pragma unroll
            for (int m = 0; m < 4; ++m) { const size_t ro = (size_t)(row0 + ai * HALF + m * 16) * DM + col0;
#pragma unroll
                for (int bj = 0; bj < 2; ++bj)
#pragma unroll
                    for (int n = 0; n < 2; ++n) { const f32x4 xi = *(const f32x4*)(Xin + ro + bj * HALF + n * 16); *(f32x4*)(Xout + ro + bj * HALF + n * 16) = xi + acc[ai][bj][m][n]; } }
    }
};
}

__device__ void phase_convert(int l, unsigned char* smem) {
    const Params p = load_params();
    float* tile = (float*)smem;
    const int tid = opaque_tid();
    const float* win = p.w_in + (size_t)l * DM * N_IN;
    bf16_t* WtIn = p.Wt; bf16_t* WtBr = p.Wt + (size_t)WT_ROWS * DM; bf16_t* WtOut = WtBr + (size_t)3 * DM * DM;
    const int NT_IN = WT_ROWS / 64;
    const int total = (NT_IN + 48 + 16) * 16;
    for (int it = blockIdx.x; it < total; it += gridDim.x) {
        const int ntile = it >> 4, kt = it & 15, k0 = kt * 64;
        const float* src = nullptr; int ld = 0, c0 = 0, valid = 64; bf16_t* dst;
        if (ntile < NT_IN) {
            const int n0 = ntile * 64; dst = WtIn + (size_t)n0 * DM;
            if (n0 < 4224) { src = win; ld = N_IN; c0 = n0; }
            else if (n0 < 4352) { if (n0 == 4224 && l > 0) { src = p.v_w1 + (size_t)(l - 1) * DM * 32; ld = 32; c0 = 0; valid = 32; } else { valid = 0; } }
            else { src = win; ld = N_IN; c0 = n0 - 128; }
        } else if (ntile < NT_IN + 48) {
            const int q = ntile - NT_IN, n = q >> 4, n0 = (q & 15) * 64;
            src = p.w_branch + ((size_t)l * 3 + n) * DM * DM; ld = DM; c0 = n0; dst = WtBr + ((size_t)n * DM + n0) * DM;
        } else {
            const int n0 = (ntile - NT_IN - 48) * 64; src = p.w_out + (size_t)l * DM * DM; ld = DM; c0 = n0; dst = WtOut + (size_t)n0 * DM;
        }
        __syncthreads();
        if (valid == 64) {
            const int kr = tid >> 4, nc = (tid & 15) * 4;
#pragma unroll
            for (int ps = 0; ps < 2; ++ps) { const int k = kr + ps * 32; const f32x4 v = *(const f32x4*)(src + (size_t)(k0 + k) * ld + c0 + nc);
                tile[k * 65 + nc] = v[0]; tile[k * 65 + nc + 1] = v[1]; tile[k * 65 + nc + 2] = v[2]; tile[k * 65 + nc + 3] = v[3]; }
        } else {
            for (int e = tid; e < 4096; e += 512) { const int k = e >> 6, n = e & 63; tile[k * 65 + n] = (n < valid) ? src[(size_t)(k0 + k) * ld + c0 + n] : 0.f; }
        }
        __syncthreads();
        { const int nr = tid >> 3, kc = (tid & 7) * 8; u32x4 w;
          w.x = cvt_pk_bf16(tile[(kc + 0) * 65 + nr], tile[(kc + 1) * 65 + nr]); w.y = cvt_pk_bf16(tile[(kc + 2) * 65 + nr], tile[(kc + 3) * 65 + nr]);
          w.z = cvt_pk_bf16(tile[(kc + 4) * 65 + nr], tile[(kc + 5) * 65 + nr]); w.w = cvt_pk_bf16(tile[(kc + 6) * 65 + nr], tile[(kc + 7) * 65 + nr]);
          *(u32x4*)(dst + (size_t)nr * DM + k0 + kc) = w; }
    }
    __syncthreads();
}

__device__ void phase_rmsnorm(const float* x, const float* g, bf16_t* xn, float* outf) {
    const int tid_ = opaque_tid(); const int lane = tid_ & 63, wv = tid_ >> 6;
    f32x4 gv[4];
#pragma unroll
    for (int q = 0; q < 4; ++q) gv[q] = *(const f32x4*)(g + q * 256 + lane * 4);
    for (int row = blockIdx.x * 8 + wv; row < T_TOK; row += gridDim.x * 8) {
        const float* xr = x + (size_t)row * DM; f32x4 v[4]; float ss = 0.f;
#pragma unroll
        for (int q = 0; q < 4; ++q) { v[q] = *(const f32x4*)(xr + q * 256 + lane * 4); ss += v[q][0] * v[q][0] + v[q][1] * v[q][1] + v[q][2] * v[q][2] + v[q][3] * v[q][3]; }
#pragma unroll
        for (int o = 32; o > 0; o >>= 1) ss += __shfl_xor(ss, o);
        const float rinv = rsqrtf(ss * (1.0f / DM) + EPS);
#pragma unroll
        for (int q = 0; q < 4; ++q) { const f32x4 o = v[q] * rinv * gv[q];
            if (xn) { u32x2 w; w.x = cvt_pk_bf16(o[0], o[1]); w.y = cvt_pk_bf16(o[2], o[3]); *(u32x2*)(xn + (size_t)row * DM + q * 256 + lane * 4) = w; }
            else *(f32x4*)(outf + (size_t)row * DM + q * 256 + lane * 4) = o; }
    }
}

template <int CTRL> __device__ __forceinline__ float dpp_f(float v) { return __int_as_float(__builtin_amdgcn_update_dpp(0, __float_as_int(v), CTRL, 0xf, 0xf, false)); }
__device__ __forceinline__ float red8(float v) { v += dpp_f<0xB1>(v); v += dpp_f<0x4E>(v); v += dpp_f<0x141>(v); return v; }
__device__ __forceinline__ float red16(float v) { v = red8(v); v += dpp_f<0x140>(v); return v; }

struct RwRaw { u32x4 cw[2], pw[2], ca[2], pa[2], vl; u32x2 cr[2], pr[2], ck[2], pk[2], cv, pv, vf; };
__device__ __forceinline__ void rw_load(RwRaw& R, const bf16_t* H, const bf16_t* vfp, int l, size_t tok, bool hasp, int h, int chh, int vnt, int fq) {
    const bf16_t* cur = H + tok * LDA_H; const bf16_t* prev = cur - LDA_H;
    const u32x4 z4 = {0u, 0u, 0u, 0u}; const u32x2 z2 = {0u, 0u};
#pragma unroll
    for (int ks = 0; ks < 2; ++ks) { const int m0 = ks * 32 + fq * 8;
        R.cw[ks] = *(const u32x4*)(cur + 3072 + m0); R.ca[ks] = *(const u32x4*)(cur + 3136 + m0);
        R.pw[ks] = hasp ? *(const u32x4*)(prev + 3072 + m0) : z4; R.pa[ks] = hasp ? *(const u32x4*)(prev + 3136 + m0) : z4; }
#pragma unroll
    for (int q = 0; q < 2; ++q) { const int cb = h * 64 + (chh * 2 + q) * 16 + fq * 4;
        R.cr[q] = *(const u32x2*)(cur + cb); R.ck[q] = *(const u32x2*)(cur + 1024 + cb);
        R.pr[q] = hasp ? *(const u32x2*)(prev + cb) : z2; R.pk[q] = hasp ? *(const u32x2*)(prev + 1024 + cb) : z2; }
    const int cbv = h * 64 + vnt * 16 + fq * 4;
    R.cv = *(const u32x2*)(cur + 2048 + cbv); R.pv = hasp ? *(const u32x2*)(prev + 2048 + cbv) : z2;
    R.vf = z2; R.vl = z4;
    if (l > 0) { R.vf = *(const u32x2*)(vfp + tok * DM + cbv); R.vl = *(const u32x4*)(cur + 4224 + fq * 8); }
}

__device__ void phase_rwkv(int l, unsigned char* smem, int mode) {
    const Params p = load_params();
    constexpr int TC = 32, NCH = SEQ / TC, RS = 68  , BUFSZ = 5 * TC * RS + TC * 32 + TC * 2;
    bf16_t* w2T = (bf16_t*)smem;
    bf16_t* a2T = w2T + 64 * 72;
    bf16_t* v2T = a2T + 64 * 72;
    float* cst = (float*)(v2T + 64 * 40);
    float* buf0 = cst + 11 * 64;
    float* ypart = buf0 + 2 * BUFSZ;
    float* sI = ypart + 4 * TC * 64;
    const int tid = opaque_tid(), wid = __builtin_amdgcn_readfirstlane(tid >> 6), lane = tid & 63, fr = lane & 15, fq = lane >> 4;
    for (int item = blockIdx.x; item < NB * 32; item += gridDim.x) {
        const int xc_ = item & 7, sl_ = item >> 3, half = sl_ & 1, pi_ = (sl_ >> 1) * 8 + xc_, b = pi_ >> 4, h = pi_ & 15;
        __syncthreads();
        for (int e = tid; e < 4096; e += 512) { const int m = e >> 6, j = e & 63; w2T[j * 72 + m] = f2bf(p.w_w2[((size_t)l * 64 + m) * DM + h * 64 + j]); a2T[j * 72 + m] = f2bf(p.a_w2[((size_t)l * 64 + m) * DM + h * 64 + j]); }
        if (l > 0) for (int e = tid; e < 2048; e += 512) { const int m = e >> 6, j = e & 63; v2T[j * 40 + m] = f2bf(p.v_w2[((size_t)(l - 1) * 32 + m) * DM + h * 64 + j]); }
        if (tid < 64) { const float* mu = p.mu + (size_t)l * 3200; const int cc = h * 64 + tid;
            cst[tid] = mu[cc]; cst[64 + tid] = mu[1024 + cc]; cst[128 + tid] = mu[2048 + cc]; cst[192 + tid] = p.w0[l * DM + cc]; cst[256 + tid] = p.a0[l * DM + cc];
            cst[320 + tid] = (l > 0) ? p.v0[(l - 1) * DM + cc] : 0.f; cst[384 + tid] = p.k_k[l * DM + cc]; cst[448 + tid] = p.k_a[l * DM + cc]; cst[512 + tid] = p.r_k[l * DM + cc];
            cst[576 + tid] = mu[3072 + tid]; cst[640 + tid] = mu[3136 + tid]; }
        __syncthreads();
        f32x2 st[4];
#pragma unroll
        for (int j = 0; j < 4; ++j) st[j] = (f32x2){0.f, 0.f};
        const int si = tid >> 3, seg = tid & 7;
        const int pwv = wid - 4, tti = pwv & 1, chh = (pwv >> 1) & 1, vnt = half * 2 + chh, tt = tti * 16 + fr;
        RwRaw raw;
        if (wid >= 4) rw_load(raw, p.H, p.vf, l, (size_t)b * SEQ + tt, tt > 0, h, chh, vnt, fq);
        for (int c = -1; c < NCH; ++c) {
            if (wid >= 4 && c + 1 < NCH && !(mode & 2)) {
                float* B_ = buf0 + ((c + 1) & 1) * BUFSZ;
                float* sR = B_; float* sW = sR + TC * RS; float* sK = sW + TC * RS; float* sA = sK + TC * RS; float* sB = sA + TC * RS; float* sV = sB + TC * RS; float* sS = sV + TC * 32;
                const size_t tok = (size_t)b * SEQ + (c + 1) * TC + tt;
                const RwRaw& cr_ = raw;
                bf16x8 AfW[2], AfA[2];
#pragma unroll
                for (int ks = 0; ks < 2; ++ks) { const int m0 = ks * 32 + fq * 8;
                    const f32x4 mw0 = *(const f32x4*)(cst + 576 + m0), mw1 = *(const f32x4*)(cst + 576 + m0 + 4), ma0 = *(const f32x4*)(cst + 640 + m0), ma1 = *(const f32x4*)(cst + 640 + m0 + 4);
                    const float muw[8] = {mw0[0], mw0[1], mw0[2], mw0[3], mw1[0], mw1[1], mw1[2], mw1[3]}, mua[8] = {ma0[0], ma0[1], ma0[2], ma0[3], ma1[0], ma1[1], ma1[2], ma1[3]};
                    const unsigned cwv[4] = {cr_.cw[ks].x, cr_.cw[ks].y, cr_.cw[ks].z, cr_.cw[ks].w}, pwq[4] = {cr_.pw[ks].x, cr_.pw[ks].y, cr_.pw[ks].z, cr_.pw[ks].w};
                    const unsigned cav[4] = {cr_.ca[ks].x, cr_.ca[ks].y, cr_.ca[ks].z, cr_.ca[ks].w}, pav[4] = {cr_.pa[ks].x, cr_.pa[ks].y, cr_.pa[ks].z, cr_.pa[ks].w};
                    unsigned ow[4], oa[4];
#pragma unroll
                    for (int e = 0; e < 4; ++e) {
                        const float c0 = bflo(cwv[e]), c1 = bfhi(cwv[e]), q0 = bflo(pwq[e]), q1 = bfhi(pwq[e]);
                        ow[e] = cvt_pk_bf16(tanh_fast(c0 + muw[2 * e] * (q0 - c0)), tanh_fast(c1 + muw[2 * e + 1] * (q1 - c1)));
                        const float d0 = bflo(cav[e]), d1 = bfhi(cav[e]), r0 = bflo(pav[e]), r1 = bfhi(pav[e]);
                        oa[e] = cvt_pk_bf16(d0 + mua[2 * e] * (r0 - d0), d1 + mua[2 * e + 1] * (r1 - d1)); }
                    AfW[ks] = __builtin_bit_cast(bf16x8, ((u32x4){ow[0], ow[1], ow[2], ow[3]})); AfA[ks] = __builtin_bit_cast(bf16x8, ((u32x4){oa[0], oa[1], oa[2], oa[3]})); }
                f32x4 accW[2], accA[2], accV = (f32x4){0.f, 0.f, 0.f, 0.f};
#pragma unroll
                for (int q = 0; q < 2; ++q) { const int nt = chh * 2 + q; accW[q] = (f32x4){0.f, 0.f, 0.f, 0.f}; accA[q] = (f32x4){0.f, 0.f, 0.f, 0.f};
#pragma unroll
                    for (int ks = 0; ks < 2; ++ks) { const bf16x8 bw = *(const bf16x8*)(w2T + (nt * 16 + fr) * 72 + ks * 32 + fq * 8), ba = *(const bf16x8*)(a2T + (nt * 16 + fr) * 72 + ks * 32 + fq * 8);
                        accW[q] = __builtin_amdgcn_mfma_f32_16x16x32_bf16(bw, AfW[ks], accW[q], 0, 0, 0); accA[q] = __builtin_amdgcn_mfma_f32_16x16x32_bf16(ba, AfA[ks], accA[q], 0, 0, 0); } }
                if (l > 0) { const bf16x8 bv = *(const bf16x8*)(v2T + (vnt * 16 + fr) * 40 + fq * 8); accV = __builtin_amdgcn_mfma_f32_16x16x32_bf16(bv, __builtin_bit_cast(bf16x8, cr_.vl), accV, 0, 0, 0); }
                float ss = 0.f, rk = 0.f;
#pragma unroll
                for (int q = 0; q < 2; ++q) { const int ch0 = (chh * 2 + q) * 16 + fq * 4;
                    const float fr_[4] = {bflo(cr_.cr[q].x), bfhi(cr_.cr[q].x), bflo(cr_.cr[q].y), bfhi(cr_.cr[q].y)}, fpr[4] = {bflo(cr_.pr[q].x), bfhi(cr_.pr[q].x), bflo(cr_.pr[q].y), bfhi(cr_.pr[q].y)};
                    const float fk_[4] = {bflo(cr_.ck[q].x), bfhi(cr_.ck[q].x), bflo(cr_.ck[q].y), bfhi(cr_.ck[q].y)}, fpk[4] = {bflo(cr_.pk[q].x), bfhi(cr_.pk[q].x), bflo(cr_.pk[q].y), bfhi(cr_.pk[q].y)};
                    const f32x4 mur = *(const f32x4*)(cst + ch0), muk = *(const f32x4*)(cst + 64 + ch0), w0v = *(const f32x4*)(cst + 192 + ch0), a0v = *(const f32x4*)(cst + 256 + ch0),
                        kkv = *(const f32x4*)(cst + 384 + ch0), kav = *(const f32x4*)(cst + 448 + ch0), rkv = *(const f32x4*)(cst + 512 + ch0);
                    f32x4 ro, wo, ko, ao, bo;
#pragma unroll
                    for (int e = 0; e < 4; ++e) {
                        const float r = fr_[e] + mur[e] * (fpr[e] - fr_[e]), k = fk_[e] + muk[e] * (fpk[e] - fk_[e]);
                        wo[e] = __expf(-0.60653065971f * sigmoidf_(w0v[e] + accW[q][e]));
                        const float a = sigmoidf_(a0v[e] + accA[q][e]);
                        const float kq = k * kkv[e]; ss += kq * kq; ao[e] = -kq; bo[e] = kq * a;
                        const float km = k * (1.0f + (a - 1.0f) * kav[e]); rk += r * km * rkv[e]; ro[e] = r; ko[e] = km; }
                    *(f32x4*)(sR + tt * RS + ch0) = ro; *(f32x4*)(sW + tt * RS + ch0) = wo; *(f32x4*)(sK + tt * RS + ch0) = ko; *(f32x4*)(sA + tt * RS + ch0) = ao; *(f32x4*)(sB + tt * RS + ch0) = bo; }
                ss += __shfl_xor(ss, 16); ss += __shfl_xor(ss, 32); rk += __shfl_xor(rk, 16); rk += __shfl_xor(rk, 32);
                if (fq == 0) { sS[tt * 2 + chh] = ss; if (half == 0) p.rkbuf[(size_t)((b * 16 + h) * 2 + chh) * SEQ + (c + 1) * TC + tt] = rk; }
                { const int ch0 = vnt * 16 + fq * 4, cb = h * 64 + ch0;
                  const float fv_[4] = {bflo(cr_.cv.x), bfhi(cr_.cv.x), bflo(cr_.cv.y), bfhi(cr_.cv.y)}, fpv[4] = {bflo(cr_.pv.x), bfhi(cr_.pv.x), bflo(cr_.pv.y), bfhi(cr_.pv.y)};
                  const f32x4 muv = *(const f32x4*)(cst + 128 + ch0), v0v = *(const f32x4*)(cst + 320 + ch0);
                  f32x4 vo;
#pragma unroll
                  for (int e = 0; e < 4; ++e) vo[e] = fv_[e] + muv[e] * (fpv[e] - fv_[e]);
                  if (l > 0) { const float vfv[4] = {bflo(cr_.vf.x), bfhi(cr_.vf.x), bflo(cr_.vf.y), bfhi(cr_.vf.y)};
#pragma unroll
                      for (int e = 0; e < 4; ++e) vo[e] = vo[e] + (vfv[e] - vo[e]) * sigmoidf_(v0v[e] + accV[e]); }
                  u32x2 w; w.x = cvt_pk_bf16(vo[0], vo[1]); w.y = cvt_pk_bf16(vo[2], vo[3]); *(u32x2*)(p.vf + tok * DM + cb) = w;
                  *(f32x4*)(sV + tt * 32 + chh * 16 + fq * 4) = vo; }
            }
            if (wid >= 4 && c + 2 < NCH && !(mode & 2)) rw_load(raw, p.H, p.vf, l, (size_t)b * SEQ + (size_t)(c + 2) * TC + tt, true, h, chh, vnt, fq);
            if (wid < 4 && c >= 0 && !(mode & 1)) {
                const float* B_ = buf0 + (c & 1) * BUFSZ;
                const float* sR = B_; const float* sW = sR + TC * RS; const float* sK = sW + TC * RS; const float* sA = sK + TC * RS; const float* sB = sA + TC * RS; const float* sV = sB + TC * RS; const float* sS = sV + TC * 32;
                float* yp = ypart + wid * (TC * 64) + lane; const float* svp = sV + si;
                { unsigned a_ = (unsigned)(size_t)(LAS float*)yp, b_ = (unsigned)(size_t)(LAS const float*)svp; asm volatile("" : "+v"(a_), "+v"(b_)); yp = (float*)(LAS float*)(size_t)a_; svp = (const float*)(LAS const float*)(size_t)b_; }
                float ivreg = 0.f;
                if (lane < TC) { const f32x2 ps = *(const f32x2*)(sS + lane * 2); ivreg = __builtin_amdgcn_rcpf(fmaxf(ps.x + ps.y, 1e-24f)); }
                struct ScOp { f32x4 a0, a1, w0, w1, b0, b1, k0, k1, r0, r1; float vi, iv; };
                auto sc_load = [&](ScOp& o, const int s_) { const int o_ = s_ * RS + seg * 8;
                    o.a0 = *(const f32x4*)(sA + o_); o.a1 = *(const f32x4*)(sA + o_ + 4); o.w0 = *(const f32x4*)(sW + o_); o.w1 = *(const f32x4*)(sW + o_ + 4);
                    o.b0 = *(const f32x4*)(sB + o_); o.b1 = *(const f32x4*)(sB + o_ + 4); o.k0 = *(const f32x4*)(sK + o_); o.k1 = *(const f32x4*)(sK + o_ + 4);
                    o.r0 = *(const f32x4*)(sR + o_); o.r1 = *(const f32x4*)(sR + o_ + 4); o.vi = svp[s_ * 32]; o.iv = __int_as_float(__builtin_amdgcn_readlane(__float_as_int(ivreg), s_)); };
                auto sc_step = [&](const ScOp& o, const int s_) {
                    const f32x2 av[4] = {{o.a0[0], o.a0[1]}, {o.a0[2], o.a0[3]}, {o.a1[0], o.a1[1]}, {o.a1[2], o.a1[3]}}, wv[4] = {{o.w0[0], o.w0[1]}, {o.w0[2], o.w0[3]}, {o.w1[0], o.w1[1]}, {o.w1[2], o.w1[3]}};
                    const f32x2 bv[4] = {{o.b0[0], o.b0[1]}, {o.b0[2], o.b0[3]}, {o.b1[0], o.b1[1]}, {o.b1[2], o.b1[3]}}, kv[4] = {{o.k0[0], o.k0[1]}, {o.k0[2], o.k0[3]}, {o.k1[0], o.k1[1]}, {o.k1[2], o.k1[3]}};
                    const f32x2 rv[4] = {{o.r0[0], o.r0[1]}, {o.r0[2], o.r0[3]}, {o.r1[0], o.r1[1]}, {o.r1[2], o.r1[3]}};
                    const f32x2 vi2 = {o.vi, o.vi};
                    f32x2 vk[4];
#pragma unroll
                    for (int j = 0; j < 4; ++j) vk[j] = vi2 * kv[j];
                    f32x2 pc = st[0] * av[0]; pc += st[1] * av[1]; pc += st[2] * av[2]; pc += st[3] * av[3];
                    const float sa = red8(pc.x + pc.y) * o.iv;
                    const f32x2 sa2 = {sa, sa};
#pragma unroll
                    for (int j = 0; j < 4; ++j) st[j] = st[j] * wv[j] + (sa2 * bv[j] + vk[j]);
                    f32x2 qc = st[0] * rv[0]; qc += st[1] * rv[1]; qc += st[2] * rv[2]; qc += st[3] * rv[3];
                    yp[s_ * 64] = qc.x + qc.y;
                };
                ScOp opX, opY; sc_load(opX, 0);
#pragma unroll 4
                for (int s = 0; s < TC; s += 2) {
                    sc_load(opY, s + 1); __builtin_amdgcn_sched_barrier(0); sc_step(opX, s);
                    if (s + 2 < TC) sc_load(opX, s + 2);
                    __builtin_amdgcn_sched_barrier(0); sc_step(opY, s + 1);
                }
                { const int tk = lane >> 1, rq = (lane & 1) * 4; const float* yr = ypart + wid * (TC * 64) + tk * 64 + rq * 8; float yv[4];
#pragma unroll
                  for (int r_ = 0; r_ < 4; ++r_) { const f32x4 u0 = *(const f32x4*)(yr + r_ * 8), u1 = *(const f32x4*)(yr + r_ * 8 + 4); yv[r_] = ((u0[0] + u0[1]) + (u0[2] + u0[3])) + ((u1[0] + u1[1]) + (u1[2] + u1[3])); }
                  u32x2 w; w.x = cvt_pk_bf16(yv[0], yv[1]); w.y = cvt_pk_bf16(yv[2], yv[3]);
                  *(u32x2*)(p.y + ((size_t)b * SEQ + c * TC + tk) * DM + h * 64 + half * 32 + wid * 8 + rq) = w; }
            }
            __syncthreads();
        }
    }
    __syncthreads();
}

__device__ void phase_rwkv_post(int l, bf16_t* oalt) {
    const Params p = load_params();
    const int tid = opaque_tid(), l8 = tid & 7;
    const int ngrp = T_TOK * 16;
    for (int g = blockIdx.x * 64 + (tid >> 3); g < ngrp; g += gridDim.x * 64) {
        const int tok = g >> 4, h = g & 15, cb = h * 64 + l8 * 8;
        const u32x4 y4 = *(const u32x4*)(p.y + (size_t)tok * DM + cb), b4 = *(const u32x4*)(p.vf + (size_t)tok * DM + cb);
        const int bb = tok / SEQ, tq = tok % SEQ; const float rk = p.rkbuf[(size_t)((bb * 16 + h) * 2) * SEQ + tq] + p.rkbuf[(size_t)((bb * 16 + h) * 2 + 1) * SEQ + tq];
        bf16_t* zp = p.H + (size_t)tok * LDA_H + 3200 + cb; const u32x4 z4 = *(const u32x4*)zp;
        const float yv[8] = {bflo(y4.x), bfhi(y4.x), bflo(y4.y), bfhi(y4.y), bflo(y4.z), bfhi(y4.z), bflo(y4.w), bfhi(y4.w)};
        const float bv[8] = {bflo(b4.x), bfhi(b4.x), bflo(b4.y), bfhi(b4.y), bflo(b4.z), bfhi(b4.z), bflo(b4.w), bfhi(b4.w)};
        const float zv[8] = {bflo(z4.x), bfhi(z4.x), bflo(z4.y), bfhi(z4.y), bflo(z4.z), bfhi(z4.z), bflo(z4.w), bfhi(z4.w)};
        float sm = 0.f;
#pragma unroll
        for (int e = 0; e < 8; ++e) sm += yv[e];
        sm = red8(sm); const float mean = sm * (1.0f / 64.f); float d[8], vs = 0.f;
#pragma unroll
        for (int e = 0; e < 8; ++e) { d[e] = yv[e] - mean; vs += d[e] * d[e]; }
        vs = red8(vs); const float rstd = rsqrtf(vs * (1.0f / 64.f) + GN_EPS);
        const f32x4 g0 = *(const f32x4*)(p.lnx_g + l * DM + cb), g1 = *(const f32x4*)(p.lnx_g + l * DM + cb + 4), c0 = *(const f32x4*)(p.lnx_b + l * DM + cb), c1 = *(const f32x4*)(p.lnx_b + l * DM + cb + 4);
        const float gg[8] = {g0[0], g0[1], g0[2], g0[3], g1[0], g1[1], g1[2], g1[3]}, cc[8] = {c0[0], c0[1], c0[2], c0[3], c1[0], c1[1], c1[2], c1[3]};
        float o[8];
#pragma unroll
        for (int e = 0; e < 8; ++e) o[e] = (d[e] * rstd * gg[e] + cc[e] + rk * bv[e]) * siluf_(zv[e]);
        u32x4 w; w.x = cvt_pk_bf16(o[0], o[1]); w.y = cvt_pk_bf16(o[2], o[3]); w.z = cvt_pk_bf16(o[4], o[5]); w.w = cvt_pk_bf16(o[6], o[7]);
        *(u32x4*)(oalt ? oalt + (size_t)tok * DM + cb : zp) = w;
    }
}

__device__ __forceinline__ float wave_sum64(float v) {
    v = red16(v);
    const float a = __int_as_float(__builtin_amdgcn_readlane(__float_as_int(v), 0)), b = __int_as_float(__builtin_amdgcn_readlane(__float_as_int(v), 16));
    const float c = __int_as_float(__builtin_amdgcn_readlane(__float_as_int(v), 32)), d = __int_as_float(__builtin_amdgcn_readlane(__float_as_int(v), 48));
    return (a + b) + (c + d);
}
__device__ void phase_sgu(int l, unsigned char* smem, bf16_t* oalt) {
    const Params p = load_params();
    bf16_t* vnTb = (bf16_t*)smem;
    float* stat = (float*)(smem + 2 * 128 * 136 * 2);
    float* lnG = stat + 256; float* lnB = lnG + DM;
    const int tid = opaque_tid(), wid = tid >> 6, lane = tid & 63, fr = lane & 15, fq = lane >> 4;
    __syncthreads();
    for (int e = tid; e < DM; e += 512) { lnG[e] = p.sgu_ln_g[(size_t)l * DM + e]; lnB[e] = p.sgu_ln_b[(size_t)l * DM + e]; }
    for (int item = blockIdx.x; item < T_TOK / 128; item += gridDim.x) {
        bf16_t* Hb = p.H + (size_t)item * 128 * LDB_H;
        __syncthreads();
#pragma unroll
        for (int hb = 0; hb < 2; ++hb) {
            u32x4 va[8], vb[8];
#pragma unroll
            for (int q = 0; q < 8; ++q) { const bf16_t* vr = Hb + (size_t)(wid * 16 + hb * 8 + q) * LDB_H + 1024 + lane * 16; va[q] = *(const u32x4*)vr; vb[q] = *(const u32x4*)(vr + 8); }
#pragma unroll
            for (int q = 0; q < 8; ++q) {
                const float f[16] = {bflo(va[q].x), bfhi(va[q].x), bflo(va[q].y), bfhi(va[q].y), bflo(va[q].z), bfhi(va[q].z), bflo(va[q].w), bfhi(va[q].w), bflo(vb[q].x), bfhi(vb[q].x), bflo(vb[q].y), bfhi(vb[q].y), bflo(vb[q].z), bfhi(vb[q].z), bflo(vb[q].w), bfhi(vb[q].w)};
                float sm = 0.f, sq = 0.f;
#pragma unroll
                for (int e = 0; e < 16; ++e) { sm += f[e]; sq += f[e] * f[e]; }
                sm = wave_sum64(sm); sq = wave_sum64(sq);
                const float mean = sm * (1.0f / DM), var = fmaxf(sq * (1.0f / DM) - mean * mean, 0.f);
                if (lane == 0) { const int s = wid * 16 + hb * 8 + q; stat[s * 2] = mean; stat[s * 2 + 1] = rsqrtf(var + EPS); } }
        }
        __syncthreads();
        const int trow = wid * 16 + fr; bf16_t* hr = Hb + (size_t)trow * LDB_H;
        const int nks = (wid < 4) ? 2 : 4;
        for (int g = 0; g < 8; ++g) {
            bf16_t* vnT = vnTb + (g & 1) * (128 * 136);
            const int s = tid >> 2, c0 = (tid & 3) * 32;
            const bf16_t* vr = Hb + (size_t)s * LDB_H + 1024 + g * 128 + c0;
            u32x4 vv[4];
#pragma unroll
            for (int q = 0; q < 4; ++q) vv[q] = *(const u32x4*)(vr + q * 8);
            const float* Wg = p.sgu_w + (((size_t)l * 8 + g) * 128 + trow) * 128;
            f32x4 wa[4], wb[4];
#pragma unroll
            for (int ks = 0; ks < 4; ++ks) if (ks < nks) { wa[ks] = *(const f32x4*)(Wg + ks * 32 + fq * 8); wb[ks] = *(const f32x4*)(Wg + ks * 32 + fq * 8 + 4); }
            u32x2 u2[8], z2[8];
#pragma unroll
            for (int ct = 0; ct < 8; ++ct) { const int c = g * 128 + ct * 16 + fq * 4; u2[ct] = *(const u32x2*)(hr + c); z2[ct] = *(const u32x2*)(hr + 2048 + c); }
            const float bs = p.sgu_b[((size_t)l * 8 + g) * 128 + trow];
            { const float mean = stat[s * 2], rstd = stat[s * 2 + 1];
#pragma unroll
              for (int q = 0; q < 4; ++q) { const float f[8] = {bflo(vv[q].x), bfhi(vv[q].x), bflo(vv[q].y), bfhi(vv[q].y), bflo(vv[q].z), bfhi(vv[q].z), bflo(vv[q].w), bfhi(vv[q].w)};
                  const f32x4 g0 = *(const f32x4*)(lnG + g * 128 + c0 + q * 8), g1 = *(const f32x4*)(lnG + g * 128 + c0 + q * 8 + 4), b0 = *(const f32x4*)(lnB + g * 128 + c0 + q * 8), b1 = *(const f32x4*)(lnB + g * 128 + c0 + q * 8 + 4);
                  const float gg[8] = {g0[0], g0[1], g0[2], g0[3], g1[0], g1[1], g1[2], g1[3]}, bb[8] = {b0[0], b0[1], b0[2], b0[3], b1[0], b1[1], b1[2], b1[3]};
#pragma unroll
                  for (int e = 0; e < 8; ++e) { const int c = c0 + q * 8 + e; const float a_ = rstd * gg[e]; vnT[c * 136 + s] = f2bf(f[e] * a_ + (bb[e] - mean * a_)); } } }
            __syncthreads();
            f32x4 acc[8];
#pragma unroll
            for (int i = 0; i < 8; ++i) acc[i] = (f32x4){0.f, 0.f, 0.f, 0.f};
#pragma unroll
            for (int ks = 0; ks < 4; ++ks) if (ks < nks) {
                u32x4 wp; wp.x = cvt_pk_bf16(wa[ks][0], wa[ks][1]); wp.y = cvt_pk_bf16(wa[ks][2], wa[ks][3]); wp.z = cvt_pk_bf16(wb[ks][0], wb[ks][1]); wp.w = cvt_pk_bf16(wb[ks][2], wb[ks][3]);
                const bf16x8 wfrag = __builtin_bit_cast(bf16x8, wp);
#pragma unroll
                for (int ct = 0; ct < 8; ++ct) { const bf16x8 vfrag = *(const bf16x8*)(vnT + (ct * 16 + fr) * 136 + ks * 32 + fq * 8);
                    acc[ct] = __builtin_amdgcn_mfma_f32_16x16x32_bf16(vfrag, wfrag, acc[ct], 0, 0, 0); }
            }
#pragma unroll
            for (int ct = 0; ct < 8; ++ct) { const int c = g * 128 + ct * 16 + fq * 4;
                const float uf[4] = {bflo(u2[ct].x), bfhi(u2[ct].x), bflo(u2[ct].y), bfhi(u2[ct].y)}, zf[4] = {bflo(z2[ct].x), bfhi(z2[ct].x), bflo(z2[ct].y), bfhi(z2[ct].y)};
                float o[4];
#pragma unroll
                for (int j = 0; j < 4; ++j) o[j] = uf[j] * (acc[ct][j] + bs) * siluf_(zf[j]);
                u32x2 w; w.x = cvt_pk_bf16(o[0], o[1]); w.y = cvt_pk_bf16(o[2], o[3]); *(u32x2*)(oalt ? oalt + ((size_t)item * 128 + trow) * DM + c : hr + 2048 + c) = w; }
        }
    }
    __syncthreads();
}

__device__ void phase_hgrn_pre(int l, unsigned char* smem, bool dry) {
    const Params p = load_params();
    float* LF = (float*)smem;
    bf16_t* IB = (bf16_t*)(LF + 64 * 132);
    bf16_t* KB = IB + 64 * 136;
    float* psum = (float*)(KB + 64 * 136);
    float* lbs = psum + 512;
    const int tid = opaque_tid();
    bf16_t* xtra = (l == 0) ? (bf16_t*)p.out : p.vf;
    __syncthreads();
    for (int e = tid; e < DM; e += 512) { float lb = 0.f; if (l == 1) { const float l0 = p.lb_logits[e], l1 = p.lb_logits[DM + e]; lb = __builtin_amdgcn_rcpf(1.0f + __expf(l0 - l1)); } lbs[e] = lb; }
    __syncthreads();
    const int t = tid >> 3, c0 = (tid & 7) * 16;
    const int cc = tid & 127, tq = tid >> 7;
    u32x4 nq0, nq1, nf0, nf1, ni0, ni1;
#define HP_ISSUE(it_) do { const int h_ = (it_) & 7, ch_ = ((it_) >> 3) & 63, b_ = (it_) >> 9; const bf16_t* hr_ = p.H + ((size_t)b_ * SEQ + ch_ * 64 + t) * LDC_H + h_ * 128 + c0; \
        nq0 = *(const u32x4*)hr_; nq1 = *(const u32x4*)(hr_ + 8); nf0 = *(const u32x4*)(hr_ + 1024); nf1 = *(const u32x4*)(hr_ + 1032); ni0 = *(const u32x4*)(hr_ + 2048); ni1 = *(const u32x4*)(hr_ + 2056); } while (0)
    if ((int)blockIdx.x < NB * 64 * 8) HP_ISSUE((int)blockIdx.x);
    for (int item = blockIdx.x; item < NB * 64 * 8; item += gridDim.x) {
        const int h = item & 7, ch = (item >> 3) & 63, b = item >> 9;
        const size_t r0 = (size_t)b * SEQ + ch * 64;
        bf16_t* hr = p.H + (r0 + t) * LDC_H + h * 128 + c0;
        float qv[16], kv[16];
        {
            const u32x4 q0 = nq0, q1 = nq1, f0 = nf0, f1 = nf1, i0 = ni0, i1 = ni1;
            if (item + (int)gridDim.x < NB * 64 * 8) HP_ISSUE(item + (int)gridDim.x);
            const unsigned qa[8] = {q0.x, q0.y, q0.z, q0.w, q1.x, q1.y, q1.z, q1.w}, fa[8] = {f0.x, f0.y, f0.z, f0.w, f1.x, f1.y, f1.z, f1.w};
            *(u32x4*)(IB + t * 136 + c0) = i0; *(u32x4*)(IB + t * 136 + c0 + 8) = i1;
            float lf[16];
#pragma unroll
            for (int e = 0; e < 8; ++e) {
                const float lb0 = lbs[h * 128 + c0 + 2 * e], lb1 = lbs[h * 128 + c0 + 2 * e + 1];
                qv[2 * e] = siluf_(bflo(qa[e])); qv[2 * e + 1] = siluf_(bfhi(qa[e]));
                const float g0 = lb0 + (1.0f - lb0) * sigmoidf_(bflo(fa[e])), g1 = lb1 + (1.0f - lb1) * sigmoidf_(bfhi(fa[e]));
                kv[2 * e] = 1.0f - g0; kv[2 * e + 1] = 1.0f - g1; lf[2 * e] = __logf(g0); lf[2 * e + 1] = __logf(g1); }
#pragma unroll
            for (int e = 0; e < 4; ++e) *(f32x4*)(LF + t * 132 + c0 + e * 4) = (f32x4){lf[e * 4], lf[e * 4 + 1], lf[e * 4 + 2], lf[e * 4 + 3]};
        }
        __syncthreads();
        { float run = 0.f;
#pragma unroll
          for (int e = 0; e < 16; ++e) { run += LF[(tq * 16 + e) * 132 + cc]; LF[(tq * 16 + e) * 132 + cc] = run; }
          psum[tq * 128 + cc] = run; }
        __syncthreads();
        {
            const int tqt = t >> 4;
            unsigned qo[8], ko[8];
#pragma unroll
            for (int e4 = 0; e4 < 4; ++e4) {
                const f32x4 p0 = *(const f32x4*)(psum + c0 + e4 * 4), p1 = *(const f32x4*)(psum + 128 + c0 + e4 * 4), p2 = *(const f32x4*)(psum + 256 + c0 + e4 * 4), p3 = *(const f32x4*)(psum + 384 + c0 + e4 * 4);
                const f32x4 bl = *(const f32x4*)(LF + t * 132 + c0 + e4 * 4);
                float q2[4], k2[4];
#pragma unroll
                for (int j = 0; j < 4; ++j) {
                    const float off = (tqt > 0 ? p0[j] : 0.f) + (tqt > 1 ? p1[j] : 0.f) + (tqt > 2 ? p2[j] : 0.f);
                    const float bmid = p0[j] + p1[j], bb = bl[j] + off;
                    q2[j] = qv[e4 * 4 + j] * __expf(bb - bmid); k2[j] = kv[e4 * 4 + j] * __expf(bmid - bb); }
                qo[e4 * 2] = cvt_pk_bf16(q2[0], q2[1]); qo[e4 * 2 + 1] = cvt_pk_bf16(q2[2], q2[3]); ko[e4 * 2] = cvt_pk_bf16(k2[0], k2[1]); ko[e4 * 2 + 1] = cvt_pk_bf16(k2[2], k2[3]);
                if (t == 0) { f32x4 e1, e3;
#pragma unroll
                    for (int j = 0; j < 4; ++j) { e1[j] = __expf(p0[j] + p1[j]); e3[j] = __expf(p2[j] + p3[j]); }
                    float* gs = p.rkbuf + (size_t)(((b * 64 + ch) * 8 + h)) * 256 + c0 + e4 * 4; *(f32x4*)gs = e1; *(f32x4*)(gs + 128) = e3; }
            }
            const u32x4 qw0 = {qo[0], qo[1], qo[2], qo[3]}, qw1 = {qo[4], qo[5], qo[6], qo[7]}, kw0 = {ko[0], ko[1], ko[2], ko[3]}, kw1 = {ko[4], ko[5], ko[6], ko[7]};
            if (!dry) { *(u32x4*)hr = qw0; *(u32x4*)(hr + 8) = qw1; *(u32x4*)(hr + 1024) = kw0; *(u32x4*)(hr + 1032) = kw1; }
            *(u32x4*)(KB + t * 136 + c0) = kw0; *(u32x4*)(KB + t * 136 + c0 + 8) = kw1;
        }
        __syncthreads();
        {
            unsigned iw[8], kw[8];
#pragma unroll
            for (int e = 0; e < 8; ++e) {
                iw[e] = (unsigned)IB[(tq * 16 + 2 * e) * 136 + cc] | ((unsigned)IB[(tq * 16 + 2 * e + 1) * 136 + cc] << 16);
                kw[e] = (unsigned)KB[(tq * 16 + 2 * e) * 136 + cc] | ((unsigned)KB[(tq * 16 + 2 * e + 1) * 136 + cc] << 16); }
            bf16_t* ir = p.H + (r0 + (cc >> 1)) * LDC_H + 2048 + h * 128 + (cc & 1) * 64 + tq * 16;
            if (!dry) { *(u32x4*)ir = (u32x4){iw[0], iw[1], iw[2], iw[3]}; *(u32x4*)(ir + 8) = (u32x4){iw[4], iw[5], iw[6], iw[7]}; }
            bf16_t* kr = xtra + (r0 + (cc >> 1)) * DM + h * 128 + (cc & 1) * 64 + tq * 16;
            *(u32x4*)kr = (u32x4){kw[0], kw[1], kw[2], kw[3]}; *(u32x4*)(kr + 8) = (u32x4){kw[4], kw[5], kw[6], kw[7]};
        }
        __syncthreads();
    }
}

struct HgSet { u32x4 r[7]; };
__device__ __forceinline__ void hg_issue(HgSet& R, const bf16_t* H, const bf16_t* xtra, const float* gsc, int b, int ch, int h, int vs, int tid) {
    const size_t r0 = (size_t)b * SEQ + (size_t)ch * 64;
    const int row = tid >> 4, wi = tid & 15;
#pragma unroll
    for (int j = 0; j < 2; ++j) { const int t = j * 32 + row; R.r[j] = *(const u32x4*)(H + (r0 + t) * LDC_H + h * 128 + wi * 8); R.r[2 + j] = *(const u32x4*)(H + (r0 + t) * LDC_H + 1024 + h * 128 + wi * 8); }
#pragma unroll
    for (int j = 0; j < 2; ++j) { const int kp = j * 32 + row; R.r[4 + j] = *(const u32x4*)(xtra + (r0 + kp) * DM + h * 128 + wi * 8); }
    const u32x4 z4 = {0u, 0u, 0u, 0u}; R.r[6] = z4;
    if (tid < 256) R.r[6] = *(const u32x4*)(H + (r0 + vs * 16 + row) * LDC_H + 2048 + h * 128 + wi * 8);
    else if (tid < 320) R.r[6] = *(const u32x4*)(gsc + (size_t)(((b * 64 + ch) * 8 + h)) * 256 + (tid - 256) * 4);
}
constexpr int HG_QM = 0, HG_KM = 16 * 65 * 16, HG_KT = 2 * 16 * 65 * 16, HG_IT = HG_KT + 8 * 129 * 16, HG_E = HG_IT + 8 * 33 * 16, HG_BUF = HG_E + 1024;
__device__ __forceinline__ void hg_stage(const HgSet& R, unsigned char* B, int tid) {
    const int row = tid >> 4, wi = tid & 15;
#pragma unroll
    for (int j = 0; j < 2; ++j) { const int t = j * 32 + row; *(u32x4*)(B + HG_QM + (wi * 65 + t) * 16) = R.r[j]; *(u32x4*)(B + HG_KM + (wi * 65 + t) * 16) = R.r[2 + j]; }
#pragma unroll
    for (int j = 0; j < 2; ++j) { const int k = (j * 32 + row) * 2 + (wi >> 3), sc = wi & 7; *(u32x4*)(B + HG_KT + (sc * 129 + k) * 16) = R.r[4 + j]; }
    if (tid < 256) { const int vv = row * 2 + (wi >> 3), sc = wi & 7; *(u32x4*)(B + HG_IT + (sc * 33 + vv) * 16) = R.r[6]; }
    else if (tid < 320) *(u32x4*)(B + HG_E + (tid - 256) * 16) = R.r[6];
}

__device__ void phase_hgrn_seq(int l, unsigned char* smem, bool dry) {
    const Params p = load_params();
    unsigned char* img = smem;
    bf16_t* att = (bf16_t*)(smem + 2 * HG_BUF);
    bf16_t* STs = att + 64 * 72;
    const int tid = opaque_tid(), w = __builtin_amdgcn_readfirstlane(tid >> 6), lane = tid & 63, fr = lane & 15, fq = lane >> 4;
    const bf16_t* xtra = (l == 0) ? (const bf16_t*)p.out : p.vf;
    const int tt_ = w >> 1, sp = w & 1;
    for (int item = blockIdx.x; item < NB * 32; item += gridDim.x) {
        const int xc_ = item & 7, sl_ = item >> 3, vs = sl_ & 3, gi_ = (sl_ >> 2) * 8 + xc_, h = gi_ & 7, b = gi_ >> 3;
        __syncthreads();
        for (int e = tid; e < 32 * 136 / 2; e += 512) ((unsigned*)STs)[e] = 0u;
        f32x4 S[2] = {{0.f, 0.f, 0.f, 0.f}, {0.f, 0.f, 0.f, 0.f}};
        u32x2 o0 = {0u, 0u};
        HgSet R0, R1;
        hg_issue(R0, p.H, xtra, p.rkbuf, b, 0, h, vs, tid); hg_stage(R0, img, tid);
        hg_issue(R1, p.H, xtra, p.rkbuf, b, 1, h, vs, tid); hg_issue(R0, p.H, xtra, p.rkbuf, b, 2, h, vs, tid);
        __syncthreads();
        auto iter = [&](const int ch, HgSet& RS) {
            const size_t r0 = (size_t)b * SEQ + (size_t)ch * 64;
            const unsigned char* B = img + (ch & 1) * HG_BUF; unsigned char* Bn = img + ((ch + 1) & 1) * HG_BUF;
            bf16x8 qf[4];
#pragma unroll
            for (int ks = 0; ks < 4; ++ks) qf[ks] = *(const bf16x8*)(B + HG_QM + ((ks * 4 + fq) * 65 + tt_ * 16 + fr) * 16);
#pragma unroll
            for (int q = 0; q < 2; ++q) { const int stile = sp * 2 + q; f32x4 a = {0.f, 0.f, 0.f, 0.f};
                if (stile <= tt_) {
#pragma unroll
                    for (int ks = 0; ks < 4; ++ks) { const bf16x8 kf = *(const bf16x8*)(B + HG_KM + ((ks * 4 + fq) * 65 + stile * 16 + fr) * 16); a = __builtin_amdgcn_mfma_f32_16x16x32_bf16(qf[ks], kf, a, 0, 0, 0); } }
#pragma unroll
                for (int j = 0; j < 4; ++j) { const int t = tt_ * 16 + fq * 4 + j, s = stile * 16 + fr; att[t * 72 + s] = f2bf(s <= t ? a[j] : 0.f); } }
            if (ch + 1 < 64) hg_stage(RS, Bn, tid);
            if (ch + 3 < 64) hg_issue(RS, p.H, xtra, p.rkbuf, b, ch + 3, h, vs, tid);
            __syncthreads();
            f32x4 o = {0.f, 0.f, 0.f, 0.f};
#pragma unroll
            for (int ks = 0; ks < 2; ++ks) { const bf16x8 af = *(const bf16x8*)(att + (tt_ * 16 + fr) * 72 + ks * 32 + fq * 8); const bf16x8 itf = *(const bf16x8*)(B + HG_IT + ((ks * 4 + fq) * 33 + sp * 16 + fr) * 16);
                o = __builtin_amdgcn_mfma_f32_16x16x32_bf16(itf, af, o, 0, 0, 0); }
#pragma unroll
            for (int ks = 0; ks < 4; ++ks) { const bf16x8 sf = *(const bf16x8*)(STs + (sp * 16 + fr) * 136 + ks * 32 + fq * 8);
                o = __builtin_amdgcn_mfma_f32_16x16x32_bf16(sf, qf[ks], o, 0, 0, 0); }
            { u32x2 ow; ow.x = cvt_pk_bf16(o[0], o[1]); ow.y = cvt_pk_bf16(o[2], o[3]);
              if (ch == 0) o0 = ow;
              else if (!dry) { const int t = tt_ * 16 + fr; *(u32x2*)(p.H + (r0 - 64 + vs * 16 + (t >> 2)) * LDC_H + 2048 + h * 128 + (t & 3) * 32 + sp * 16 + fq * 4) = ow; } }
            const f32x4 e1 = *(const f32x4*)(B + HG_E + (w * 16 + fq * 4) * 4), e3 = *(const f32x4*)(B + HG_E + 512 + (w * 16 + fq * 4) * 4);
            bf16x8 ktf[2];
#pragma unroll
            for (int ks = 0; ks < 2; ++ks) ktf[ks] = *(const bf16x8*)(B + HG_KT + ((ks * 4 + fq) * 129 + w * 16 + fr) * 16);
#pragma unroll
            for (int vt = 0; vt < 2; ++vt) { f32x4 u = {0.f, 0.f, 0.f, 0.f};
#pragma unroll
                for (int ks = 0; ks < 2; ++ks) { const bf16x8 itf = *(const bf16x8*)(B + HG_IT + ((ks * 4 + fq) * 33 + vt * 16 + fr) * 16); u = __builtin_amdgcn_mfma_f32_16x16x32_bf16(ktf[ks], itf, u, 0, 0, 0); }
#pragma unroll
                for (int j = 0; j < 4; ++j) S[vt][j] = e3[j] * (e1[j] * S[vt][j] + u[j]); }
            __syncthreads();
            if (ch + 1 < 64) { const f32x4 e1n = *(const f32x4*)(Bn + HG_E + (w * 16 + fq * 4) * 4);
#pragma unroll
                for (int vt = 0; vt < 2; ++vt) { u32x2 sw; sw.x = cvt_pk_bf16(S[vt][0] * e1n[0], S[vt][1] * e1n[1]); sw.y = cvt_pk_bf16(S[vt][2] * e1n[2], S[vt][3] * e1n[3]);
                    *(u32x2*)(STs + (vt * 16 + fr) * 136 + w * 16 + fq * 4) = sw; } }
        };
        for (int ch = 0; ch < 64; ch += 2) { iter(ch, R1); iter(ch + 1, R0); }
        if (!dry) { const int t = tt_ * 16 + fr; *(u32x2*)(p.H + ((size_t)b * SEQ + 63 * 64 + vs * 16 + (t >> 2)) * LDC_H + 2048 + h * 128 + (t & 3) * 32 + sp * 16 + fq * 4) = o0; }
    }
    __syncthreads();
}

__device__ void phase_hgrn_post(int l) {
    const Params p = load_params();
    const int tid = opaque_tid(), l8 = tid & 7;
    const int ngrp = T_TOK * 8;
    for (int g = blockIdx.x * 64 + (tid >> 3); g < ngrp; g += gridDim.x * 64) {
        const int tok = g >> 3, h = g & 7, b = tok / SEQ, tin = tok % SEQ, ch = tin >> 6, t = tin & 63, slot = (ch + 63) & 63, vs = l8 >> 1, vv0 = (l8 & 1) * 16;
        const bf16_t* op = p.H + ((size_t)b * SEQ + slot * 64 + vs * 16 + (t >> 2)) * LDC_H + 2048 + h * 128 + (t & 3) * 32 + vv0;
        bf16_t* zp = p.H + (size_t)tok * LDC_H + 3072 + h * 128 + l8 * 16;
        const u32x4 a0 = *(const u32x4*)op, a1 = *(const u32x4*)(op + 8), z0 = *(const u32x4*)zp, z1 = *(const u32x4*)(zp + 8);
        const float ov[16] = {bflo(a0.x), bfhi(a0.x), bflo(a0.y), bfhi(a0.y), bflo(a0.z), bfhi(a0.z), bflo(a0.w), bfhi(a0.w), bflo(a1.x), bfhi(a1.x), bflo(a1.y), bfhi(a1.y), bflo(a1.z), bfhi(a1.z), bflo(a1.w), bfhi(a1.w)};
        const float zf[16] = {bflo(z0.x), bfhi(z0.x), bflo(z0.y), bfhi(z0.y), bflo(z0.z), bfhi(z0.z), bflo(z0.w), bfhi(z0.w), bflo(z1.x), bfhi(z1.x), bflo(z1.y), bfhi(z1.y), bflo(z1.z), bfhi(z1.z), bflo(z1.w), bfhi(z1.w)};
        float ss = 0.f;
#pragma unroll
        for (int e = 0; e < 16; ++e) ss += ov[e] * ov[e];
        ss = red8(ss); const float rinv = rsqrtf(ss * (1.0f / 128.f) + EPS);
        const float* gn = p.hgrn_g + (size_t)l * DM + h * 128 + l8 * 16;
        float r[16];
#pragma unroll
        for (int e = 0; e < 16; ++e) r[e] = ov[e] * rinv * gn[e] * siluf_(zf[e]);
        u32x4 w0, w1; w0.x = cvt_pk_bf16(r[0], r[1]); w0.y = cvt_pk_bf16(r[2], r[3]); w0.z = cvt_pk_bf16(r[4], r[5]); w0.w = cvt_pk_bf16(r[6], r[7]);
        w1.x = cvt_pk_bf16(r[8], r[9]); w1.y = cvt_pk_bf16(r[10], r[11]); w1.z = cvt_pk_bf16(r[12], r[13]); w1.w = cvt_pk_bf16(r[14], r[15]);
        *(u32x4*)zp = w0; *(u32x4*)(zp + 8) = w1;
    }
}


#define XB_TMO      128
#define XB_XCNT(j)  (256  + 64 * (j))
#define XB_XSUB(j)  (1280 + 64 * (j))
#define XB_XGEN(j)  (2304 + 64 * (j))
#define XB_TOP      3328
#define XB_TOPGEN   3392
#define XCD_BAR_WORDS 3456
#define XB_SPIN_CAP (1u << 18)
__device__ __forceinline__ unsigned xb_ld(unsigned* p)              { return __hip_atomic_load(p, __ATOMIC_RELAXED, __HIP_MEMORY_SCOPE_AGENT); }
__device__ __forceinline__ unsigned xb_add(unsigned* p, unsigned v) { return __hip_atomic_fetch_add(p, v, __ATOMIC_RELAXED, __HIP_MEMORY_SCOPE_AGENT); }
__device__ __forceinline__ unsigned xb_xcc_id() { return (unsigned)__builtin_amdgcn_s_getreg((3 << 11) | 20) & 0xFu; }
#define XB_SPIN(cond, bar) do { unsigned _sp = 0; while (cond) { __builtin_amdgcn_s_sleep(1); \
    if ((++_sp & 255u) == 0u) { if (xb_ld(&(bar)[XB_TMO])) break; if (_sp > XB_SPIN_CAP) { atomicAdd(&(bar)[XB_TMO], 1u); break; } } } } while (0)
struct XcdBarrier { unsigned* bar; unsigned x; volatile LAS unsigned* st; };
__device__ __forceinline__ XcdBarrier xcd_barrier_post(unsigned* bar, volatile LAS unsigned* st) {
    XcdBarrier b; b.bar = bar; b.x = xb_xcc_id(); b.st = st;
    if (threadIdx.x == 0) (void)xb_add(&bar[XB_XCNT(b.x)], 1u);
    return b;
}
__device__ __forceinline__ void xcd_barrier_complete(unsigned* bar, unsigned x, unsigned& nloc, unsigned& nx) {
    const unsigned G = gridDim.x * gridDim.y * gridDim.z;
    unsigned sum, cnt, mine, sp = 0u;
    for (;;) {
        sum = 0u; cnt = 0u; mine = 0u;
#pragma unroll
        for (unsigned j = 0; j < 16; ++j) { const unsigned c = xb_ld(&bar[XB_XCNT(j)]); sum += c; cnt += (c > 0u) ? 1u : 0u; mine = (j == x) ? c : mine; }
        if (sum == G) break;
        __builtin_amdgcn_s_sleep(1);
        if ((++sp & 255u) == 0u) { if (xb_ld(&bar[XB_TMO])) break; if (sp > XB_SPIN_CAP) { atomicAdd(&bar[XB_TMO], 1u); break; } }
    }
    nloc = mine > 0u ? mine : 1u; nx = cnt > 0u ? cnt : 1u;
}
__device__ __forceinline__ void xcd_barrier(const XcdBarrier& b) {
    asm volatile("s_waitcnt vmcnt(0)" ::: "memory");
    __syncthreads();
    if (threadIdx.x == 0) {
        unsigned* bar = b.bar;
        __builtin_amdgcn_s_waitcnt(0);
        unsigned nloc = b.st[0], nx = b.st[1];
        if (nloc == 0u) { xcd_barrier_complete(bar, b.x, nloc, nx); b.st[0] = nloc; b.st[1] = nx; }
        const unsigned old = xb_add(&bar[XB_XSUB(b.x)], 1u);
        const unsigned gen = old / nloc;
        if (old + 1u == (gen + 1u) * nloc) {
            __builtin_amdgcn_fence(__ATOMIC_RELEASE, "agent");
            asm volatile("s_waitcnt vmcnt(0)" ::: "memory");
            const unsigned og = xb_add(&bar[XB_TOP], 1u);
            const unsigned tg = og / nx;
            if (og + 1u == (tg + 1u) * nx) xb_add(&bar[XB_TOPGEN], 1u);
            else XB_SPIN(xb_ld(&bar[XB_TOPGEN]) == tg, bar);
            __builtin_amdgcn_fence(__ATOMIC_ACQUIRE, "agent");
            xb_add(&bar[XB_XGEN(b.x)], 1u);
            asm volatile("s_waitcnt vmcnt(0)" ::: "memory");
        } else {
            XB_SPIN(xb_ld(&bar[XB_XGEN(b.x)]) == gen, bar);
            __builtin_amdgcn_fence(__ATOMIC_ACQUIRE, "agent");
            asm volatile("s_waitcnt vmcnt(0)" ::: "memory");
        }
    }
    __syncthreads();
}

constexpr int PH_PER_LAYER = 14, N_PHASES = 2 * PH_PER_LAYER + 1;

__global__ void __launch_bounds__(512, 2) fwd_megakernel(Params pk) {
    extern __shared__ __attribute__((aligned(16))) unsigned char shm[];
    LAS unsigned char* lds = (LAS unsigned char*)shm;
    cg::grid_group grid = cg::this_grid();
    const int phase_lo = pk.phase_lo, phase_hi = pk.phase_hi;
    volatile LAS unsigned* xst = (volatile LAS unsigned*)(lds + LDS_BYTES - 16);
    XcdBarrier xb; xb.bar = pk.bar; xb.x = 0; xb.st = xst;
    if (phase_hi - phase_lo > 1) { if (threadIdx.x == 0) { xst[0] = 0u; xst[1] = 0u; } __syncthreads(); xb = xcd_barrier_post(pk.bar, xst); }
    for (int ph = phase_lo; ph < phase_hi; ++ph) {
        const int l = ph / PH_PER_LAYER, q = ph % PH_PER_LAYER;
        if (ph == N_PHASES - 1) {
            const Params p = load_params();
            phase_rmsnorm(p.out, p.final_g, nullptr, p.out);
        } else if (q == 0) {
            { const int nrep = (PROBE_Q == 0 && l == 0) ? 2 : 1; for (int rep = 0; rep < nrep; ++rep) {
            phase_convert(l, shm);
            const Params p = load_params();
            phase_rmsnorm(l == 0 ? p.x : p.out, p.norm_g + (size_t)l * DM, p.xn, nullptr); } }
        } else if (q == 1 || q == 5 || q == 8) {
            const Params p = load_params(); const int G = gridDim.x, cidx = opaque_bid();
            const int N = (q == 1) ? LDA_H : (q == 5) ? LDB_H : LDC_H; const int r0 = (q == 1) ? 0 : (q == 5) ? LDA_H : (LDA_H + LDB_H);
            pg8::GemmDesc g; g.A = p.xn; g.Bt = p.Wt + (size_t)r0 * DM; g.lda = DM;
            pg8::Sched S; S.init(T_TOK, N, G, cidx, 1);
            pg8::EpiStore E; E.O = p.H; E.ldc = N;
{ const int nrep = ((PROBE_Q == 1 && l == 0 && q == 1) || (PROBE_Q == 50 && l == 0 && q == 5) || (PROBE_Q == 80 && l == 0 && q == 8)) ? 2 : 1; for (int rep = 0; rep < nrep; ++rep) pg8::gemm_phase(lds, g, g, S, E); }
        } else if (q == 2) {
{ const int nrep = (PROBE_Q == 2 && l == 0) ? 2 : 1; for (int rep = 0; rep < nrep; ++rep) phase_rwkv(l, shm, rep + 1 < nrep ? PROBE_MODE : 0); }
        } else if (q == 3) {
            phase_rwkv_post(l, nullptr);
        } else if (q == 6) {
{ const int nrep = (PROBE_Q == 6 && l == 0) ? 2 : 1; for (int rep = 0; rep < nrep; ++rep) { const Params p = load_params(); phase_sgu(l, shm, rep + 1 < nrep ? (bf16_t*)p.out : nullptr); } }
        } else if (q == 9) {
            { const int nrep = (PROBE_Q == 9 && l == 0) ? 2 : 1; for (int rep = 0; rep < nrep; ++rep) phase_hgrn_pre(l, shm, rep + 1 < nrep); }
        } else if (q == 10) {
            { const int nrep = (PROBE_Q == 10 && l == 0) ? 2 : 1; for (int rep = 0; rep < nrep; ++rep) phase_hgrn_seq(l, shm, rep + 1 < nrep); }
        } else if (q == 11) {
            phase_hgrn_post(l);
        } else if (q == 4 || q == 7 || q == 12) {
            const Params p = load_params(); const int G = gridDim.x, cidx = opaque_bid();
            bf16_t* WtBr = p.Wt + (size_t)WT_ROWS * DM;
            const int n = (q == 4) ? 0 : (q == 7) ? 1 : 2; const int ldh = (n == 0) ? LDA_H : (n == 1) ? LDB_H : LDC_H; const int ocol = (n == 0) ? 3200 : (n == 1) ? 2048 : 3072;
            pg8::GemmDesc g0, g1; g0.A = p.xn; g0.Bt = p.Wt + (size_t)(LDA_H + LDB_H + LDC_H + n * DM) * DM; g0.lda = DM;
            g1.A = p.H + ocol; g1.Bt = WtBr + (size_t)n * DM * DM; g1.lda = ldh;
            pg8::Sched S; S.init(T_TOK, DM, G, cidx, 2);
            pg8::EpiMerge E; E.G = p.H; E.ldg = ldh; E.bias = p.b_merge + ((size_t)l * 3 + n) * DM; E.Y = p.y; E.accum = (n > 0);
            { const int nrep = (PROBE_Q == 4 && l == 0 && q == 4) ? 2 : 1; for (int rep = 0; rep < nrep; ++rep) pg8::gemm_phase(lds, g0, g1, S, E); }
        } else {
            const Params p = load_params(); const int G = gridDim.x, cidx = opaque_bid();
            bf16_t* WtOut = p.Wt + (size_t)WT_ROWS * DM + (size_t)3 * DM * DM;
            pg8::GemmDesc g; g.A = p.y; g.Bt = WtOut; g.lda = DM;
            pg8::Sched S; S.init(T_TOK, DM, G, cidx, 1);
            pg8::EpiResid E; E.Xin = (l == 0) ? p.x : p.out; E.Xout = p.out;
            { const int nrep = (PROBE_Q == 13 && l == 0) ? 2 : 1; for (int rep = 0; rep < nrep; ++rep) pg8::gemm_phase(lds, g, g, S, E); }
        }
        if (ph + 1 < phase_hi) { if (ph == phase_lo) grid.sync(); else xcd_barrier(xb); }
    }
}

extern "C" void kernel_launch(void* const* d_in, const int* in_sizes, int n_in, void* d_out, int out_size, void* d_ws, size_t ws_size, hipStream_t stream) {
    static int grid_blocks = 0;
    if (!grid_blocks) {
        int dev = 0, cus = 0, per_cu = 0;
        hipGetDevice(&dev);
        hipDeviceGetAttribute(&cus, hipDeviceAttributeMultiprocessorCount, dev);
        if (hipFuncSetAttribute((const void*)fwd_megakernel, hipFuncAttributeMaxDynamicSharedMemorySize, LDS_BYTES) != hipSuccess) { fprintf(stderr, "hipFuncSetAttribute failed\n"); return; }
        hipOccupancyMaxActiveBlocksPerMultiprocessor(&per_cu, (const void*)fwd_megakernel, 512, LDS_BYTES);
        if (per_cu < 1) { fprintf(stderr, "occupancy query says 0 blocks per CU\n"); return; }
        grid_blocks = cus * 1;
    }
    Params p{};
    const float** fp = (const float**)&p;
    for (int i = 0; i < 26; ++i) fp[i] = (const float*)d_in[i];
    p.out = (float*)d_out;
    unsigned char* ws = (unsigned char*)d_ws; size_t off = 0;
    auto take = [&](size_t bytes) { unsigned char* r = ws + off; off += (bytes + 255) & ~(size_t)255; return r; };
    p.Wt = (bf16_t*)take(((size_t)WT_ROWS * DM + 4 * (size_t)DM * DM) * 2);
    p.xn = (bf16_t*)take((size_t)T_TOK * DM * 2);
    p.vf = (bf16_t*)take((size_t)T_TOK * DM * 2);
    p.y = (bf16_t*)take((size_t)T_TOK * DM * 2);
    p.H = (bf16_t*)take((size_t)T_TOK * LDA_H * 2);
    p.rkbuf = (float*)take((size_t)T_TOK * 16 * 2 * 4);
    p.bar = (unsigned*)take((size_t)XCD_BAR_WORDS * 4);
    if (off > ws_size) { fprintf(stderr, "workspace too small: need %zu have %zu\n", off, ws_size); return; }
#if SINGLE_LAUNCH
    p.phase_lo = 0; p.phase_hi = N_PHASES;
    void* args[] = {&p};
    if (hipMemsetAsync(p.bar, 0, (size_t)XCD_BAR_WORDS * 4, stream) != hipSuccess) { fprintf(stderr, "memset failed\n"); return; }
    hipError_t e = hipLaunchCooperativeKernel((const void*)fwd_megakernel, dim3(grid_blocks), dim3(512), args, LDS_BYTES, stream);
    if (e != hipSuccess) fprintf(stderr, "cooperative launch failed: %s (grid %d)\n", hipGetErrorString(e), grid_blocks);
#else
    for (int ph = 0; ph < N_PHASES; ++ph) {
        p.phase_lo = ph; p.phase_hi = ph + 1;
        hipLaunchKernelGGL(fwd_megakernel, dim3(grid_blocks), dim3(512), LDS_BYTES, stream, p);
    }
#endif
}
```

```cpp
#include <hip/hip_runtime.h>
#include <hip/hip_cooperative_groups.h>
#include <cstdio>
namespace cg = cooperative_groups;

#ifndef PROBE_MODE
#define PROBE_MODE 0
#endif
#ifndef PROBE_Q
#define PROBE_Q -1
#endif
#ifndef SINGLE_LAUNCH
#define SINGLE_LAUNCH 1
#endif

typedef unsigned short bf16_t;
typedef short bf16x8 __attribute__((ext_vector_type(8)));
typedef float f32x4 __attribute__((ext_vector_type(4)));
typedef float f32x2 __attribute__((ext_vector_type(2)));
typedef unsigned u32x4 __attribute__((ext_vector_type(4)));
typedef unsigned u32x2 __attribute__((ext_vector_type(2)));
#define LAS __attribute__((address_space(3)))

constexpr int T_TOK = 32768, DM = 1024, SEQ = 4096, NB = 8;
constexpr int N_IN = 14464;
constexpr int LDA_H = 4352, LDB_H = 3072, LDC_H = 4096;
constexpr int WT_ROWS = 14592;
constexpr int LDS_BYTES = 163840;
constexpr float EPS = 1e-6f, GN_EPS = 64e-5f;

struct Params {
    const float *x, *norm_g, *w_in, *b_merge, *mu, *w0, *w_w2, *a0, *a_w2, *v0, *v_w1, *v_w2, *k_k, *k_a, *r_k, *lnx_g, *lnx_b,
        *sgu_ln_g, *sgu_ln_b, *sgu_w, *sgu_b, *lb_logits, *hgrn_g, *w_branch, *w_out, *final_g;
    float* out;
    bf16_t *Wt, *xn, *vf, *y, *H;
    float* rkbuf;
    unsigned* bar;
    int phase_lo, phase_hi;
};

__device__ __forceinline__ float bf2f(bf16_t h) { return __uint_as_float(((unsigned)h) << 16); }
__device__ __forceinline__ float bflo(unsigned u) { return __uint_as_float(u << 16); }
__device__ __forceinline__ float bfhi(unsigned u) { return __uint_as_float(u & 0xffff0000u); }
typedef __bf16 bf16x2_t __attribute__((ext_vector_type(2)));
__device__ __forceinline__ unsigned cvt_pk_bf16(float lo, float hi) { const f32x2 v = {lo, hi}; const bf16x2_t r = __builtin_convertvector(v, bf16x2_t); return __builtin_bit_cast(unsigned, r); }
__device__ __forceinline__ bf16_t f2bf(float f) { return (bf16_t)(cvt_pk_bf16(f, 0.f) & 0xffffu); }
__device__ __forceinline__ float sigmoidf_(float x) { return __builtin_amdgcn_rcpf(1.0f + __expf(-x)); }
__device__ __forceinline__ float siluf_(float x) { return x * __builtin_amdgcn_rcpf(1.0f + __expf(-x)); }
__device__ __forceinline__ float tanh_fast(float x) { return 1.0f - 2.0f * __builtin_amdgcn_rcpf(1.0f + __expf(2.0f * x)); }

__device__ __forceinline__ Params load_params() {
#if defined(__HIP_DEVICE_COMPILE__)
    typedef const Params __attribute__((address_space(4)))* KP;
    KP kp = (KP)__builtin_amdgcn_kernarg_segment_ptr(); asm volatile("" : "+s"(kp)); return *kp;
#else
    return Params{};
#endif
}
__device__ __forceinline__ int opaque_tid() { int t = threadIdx.x; asm volatile("" : "+v"(t)); return t; }
__device__ __forceinline__ int opaque_bid() { int t = blockIdx.x; asm volatile("" : "+s"(t)); return t; }

namespace pg8 {
constexpr int BM = 256, BK = 64, HALF = 128, HTB = HALF * BK * 2, STAGE_BYTES = 8 * HTB, NXCD = 8, WGM = 8, KD = 1024;
__device__ __forceinline__ int lds_byte(int r, int c) { const int st = (r >> 4) * 2 + (c >> 5), rr = r & 15, cc = c & 31, ob = rr * 64 + cc * 2; return st * 1024 + (ob ^ (((ob >> 9) & 1) << 5)); }
__device__ __forceinline__ void stage_rc(int b, int& R, int& C) { const int st = b / 1024, sb = b % 1024, swz = sb ^ (((sb >> 9) & 1) << 5); R = (st >> 1) * 16 + swz / 64; C = (st & 1) * 32 + (swz % 64) / 2; }
__device__ __forceinline__ int perm32(int rho) { const int n = rho >> 4, i = rho & 15; return 8 * (i >> 2) + 4 * n + (i & 3); }

struct Unit { int pm, pn, sel; };
struct GemmDesc { const bf16_t* A; const bf16_t* Bt; int lda; };
struct Sched {
    int nM, nN, nwg, G, c, nsel;
    __device__ void init(int M, int N, int G_, int c_, int nsel_) { nM = M / BM; nN = N / BM; nwg = nM * nN; G = G_; c = c_; nsel = nsel_; }
    __device__ bool next(int i, Unit& u) const {
        const int ti = (nsel == 2) ? (i >> 1) : i; u.sel = (nsel == 2) ? (i & 1) : 0;
        const long L = (long)ti * G + c; if (L >= nwg) return false;
        int wgid = (int)L; { const int q = nwg / NXCD, r = nwg % NXCD, xcd = wgid % NXCD, off = wgid / NXCD; wgid = (xcd < r ? xcd * (q + 1) : r * (q + 1) + (xcd - r) * q) + off; }
        const int nig = WGM * nN, gid = wgid / nig, fm = gid * WGM, gsz = (nM - fm) < WGM ? (nM - fm) : WGM;
        u.pm = fm + ((wgid % nig) % gsz); u.pn = (wgid % nig) / gsz; return true;
    }
};

template <class Epi>
__device__ __forceinline__ void gemm_phase(LAS unsigned char* lds, const GemmDesc g0, const GemmDesc g1, const Sched& S, const Epi& E) {
    const int tid = opaque_tid(), wid = __builtin_amdgcn_readfirstlane(tid >> 6), lane = tid & 63, wr = wid >> 2, wc = wid & 3, fr = lane & 15, fq = lane >> 4;
    constexpr int K = KD, nt = K / BK;
    unsigned voffA0[2], voffA1[2], voffB[2];
#pragma unroll
    for (int i = 0; i < 2; ++i) { int R, C; stage_rc(tid * 16 + i * 8192, R, C); const int Rb = Epi::PERM ? ((R & ~31) + perm32(R & 31)) : R;
        voffA0[i] = (unsigned)(R * g0.lda + C) * 2u; voffA1[i] = (unsigned)(R * g1.lda + C) * 2u; voffB[i] = (unsigned)(Rb * K + C) * 2u; }
    const size_t kstep = (size_t)(BK * 2);
    const size_t hstepB = (size_t)HALF * K * 2;
    const unsigned ldsw = (unsigned)wid * 1024u;
    const int aoff = lds_byte(wr * 64 + fr, fq * 8), boff = lds_byte(wc * 32 + fr, fq * 8);
#define PG8_SA(b, h) (((b) * 2 + (h)) * HTB)
#define PG8_SB(b, h) ((4 + (b) * 2 + (h)) * HTB)
#define PG8_STAGE(bufoff, gbase, v0, v1) do { \
        __builtin_amdgcn_global_load_lds((const unsigned*)((const char*)(gbase) + (v0)), (LAS unsigned*)(lds + (bufoff) + ldsw), 16, 0, 0); \
        __builtin_amdgcn_global_load_lds((const unsigned*)((const char*)(gbase) + (v1)), (LAS unsigned*)(lds + (bufoff) + ldsw + 8192), 16, 0, 0); } while (0)
#define PG8_STAGEB(bufoff, gbase) PG8_STAGE(bufoff, gbase, voffB[0], voffB[1])
#define PG8_LDA(dst, b, h) do { _Pragma("unroll") for (int m = 0; m < 4; ++m) _Pragma("unroll") for (int k = 0; k < 2; ++k) dst[m][k] = *(const LAS bf16x8*)(lds + PG8_SA(b, h) + aoff + m * 2048 + k * 1024); } while (0)
#define PG8_LDB(dst, b, h) do { _Pragma("unroll") for (int n = 0; n < 2; ++n) _Pragma("unroll") for (int k = 0; k < 2; ++k) dst[n][k] = *(const LAS bf16x8*)(lds + PG8_SB(b, h) + boff + n * 2048 + k * 1024); } while (0)
#define PG8_MMA(ai, bj, At, Bt) do { __builtin_amdgcn_s_setprio(1); _Pragma("unroll") for (int m = 0; m < 4; ++m) _Pragma("unroll") for (int n = 0; n < 2; ++n) _Pragma("unroll") for (int k = 0; k < 2; ++k) \
        acc[ai][bj][m][n] = __builtin_amdgcn_mfma_f32_16x16x32_bf16(Bt[n][k], At[m][k], acc[ai][bj][m][n], 0, 0, 0); __builtin_amdgcn_s_setprio(0); } while (0)
#define PG8_WAIT_V(n) asm volatile("s_waitcnt vmcnt(" #n ")" ::: "memory")
#define PG8_WAIT_L(n) asm volatile("s_waitcnt lgkmcnt(" #n ")" ::: "memory")
#define PG8_BAR __builtin_amdgcn_s_barrier()
#define PG8_SCHED __builtin_amdgcn_sched_barrier(0)
    Unit cur, nxt; int ui = 0;
    if (!S.next(0, cur)) return;
    f32x4 acc[2][2][4][2];
#pragma unroll
    for (int a = 0; a < 2; ++a)
#pragma unroll
        for (int b = 0; b < 2; ++b)
#pragma unroll
            for (int m = 0; m < 4; ++m)
#pragma unroll
                for (int n = 0; n < 2; ++n) acc[a][b][m][n] = (f32x4){0.f, 0.f, 0.f, 0.f};
    bf16x8 At[4][2], B0[2][2], B1[2][2];
    const char* cA = (const char*)(cur.sel ? g1.A : g0.A) + (size_t)cur.pm * 256 * (size_t)(cur.sel ? g1.lda : g0.lda) * 2;
    const char* cB = (const char*)(cur.sel ? g1.Bt : g0.Bt) + (size_t)cur.pn * 256 * K * 2;
    size_t chA = (size_t)HALF * (cur.sel ? g1.lda : g0.lda) * 2;
    unsigned cv0 = cur.sel ? voffA1[0] : voffA0[0], cv1 = cur.sel ? voffA1[1] : voffA0[1];
    PG8_STAGEB(PG8_SB(0, 0), cB); PG8_STAGEB(PG8_SB(0, 1), cB + hstepB); PG8_STAGE(PG8_SA(0, 0), cA, cv0, cv1); PG8_STAGE(PG8_SA(0, 1), cA + chA, cv0, cv1);
    if (wr == 1) PG8_BAR;
    PG8_WAIT_V(2); PG8_BAR;
    PG8_STAGEB(PG8_SB(1, 0), cB + kstep); PG8_STAGE(PG8_SA(1, 0), cA + kstep, cv0, cv1); PG8_STAGEB(PG8_SB(1, 1), cB + hstepB + kstep);
    PG8_WAIT_V(6); PG8_BAR;
    for (;;) {
        const bool has_next = S.next(ui + 1, nxt);
        const int nsel = has_next ? nxt.sel : cur.sel;
        const char* nA = has_next ? (const char*)(nsel ? g1.A : g0.A) + (size_t)nxt.pm * 256 * (size_t)(nsel ? g1.lda : g0.lda) * 2 : cA;
        const char* nB = has_next ? (const char*)(nsel ? g1.Bt : g0.Bt) + (size_t)nxt.pn * 256 * K * 2 : cB;
        const size_t nhA = (size_t)HALF * (nsel ? g1.lda : g0.lda) * 2;
        const unsigned nv0 = nsel ? voffA1[0] : voffA0[0], nv1 = nsel ? voffA1[1] : voffA0[1];
        for (int t = 0; t < nt; t += 2) {
            const bool last = (t == nt - 2);
            const char* a1 = cA + (size_t)(t + 1) * kstep;
            const char* a2 = last ? nA : cA + (size_t)(t + 2) * kstep; const char* b2 = last ? nB : cB + (size_t)(t + 2) * kstep;
            const char* a3 = a2 + kstep; const char* b3 = b2 + kstep;
            const size_t h2 = last ? nhA : chA; const unsigned w0 = last ? nv0 : cv0, w1 = last ? nv1 : cv1;
            PG8_LDB(B0, 0, 0); PG8_LDB(B1, 0, 1); PG8_SCHED; PG8_LDA(At, 0, 0); PG8_STAGE(PG8_SA(1, 1), a1 + chA, cv0, cv1);
            PG8_WAIT_V(8); PG8_WAIT_L(0); PG8_BAR; PG8_MMA(0, 0, At, B0); PG8_MMA(0, 1, At, B1); PG8_BAR; PG8_SCHED;
            PG8_LDA(At, 0, 1); PG8_STAGEB(PG8_SB(0, 0), b2); PG8_STAGEB(PG8_SB(0, 1), b2 + hstepB); PG8_STAGE(PG8_SA(0, 0), a2, w0, w1);
            PG8_WAIT_V(8); PG8_WAIT_L(0); PG8_BAR; PG8_MMA(1, 0, At, B0); PG8_MMA(1, 1, At, B1); PG8_BAR; PG8_SCHED;
            PG8_LDB(B0, 1, 0); PG8_LDB(B1, 1, 1); PG8_SCHED; PG8_LDA(At, 1, 0); PG8_STAGE(PG8_SA(0, 1), a2 + h2, w0, w1);
            PG8_WAIT_V(8); PG8_WAIT_L(0); PG8_BAR; PG8_MMA(0, 0, At, B0); PG8_MMA(0, 1, At, B1); PG8_BAR; PG8_SCHED;
            PG8_LDA(At, 1, 1); PG8_STAGEB(PG8_SB(1, 0), b3); PG8_STAGEB(PG8_SB(1, 1), b3 + hstepB); PG8_STAGE(PG8_SA(1, 0), a3, w0, w1);
            PG8_WAIT_V(8); PG8_WAIT_L(0); PG8_BAR; PG8_MMA(1, 0, At, B0); PG8_MMA(1, 1, At, B1); PG8_BAR; PG8_SCHED;
        }
        if (wr == 0) PG8_BAR;
        E(acc, cur, wr, wc, fr, fq);
        if (!has_next) break;
#pragma unroll
        for (int a = 0; a < 2; ++a)
#pragma unroll
            for (int b = 0; b < 2; ++b)
#pragma unroll
                for (int m = 0; m < 4; ++m)
#pragma unroll
                    for (int n = 0; n < 2; ++n) acc[a][b][m][n] = (f32x4){0.f, 0.f, 0.f, 0.f};
        cur = nxt; cA = nA; cB = nB; chA = nhA; cv0 = nv0; cv1 = nv1; ++ui;
        if (wr == 1) PG8_BAR;
    }
    PG8_WAIT_V(0);
    PG8_BAR;
#undef PG8_SA
#undef PG8_SB
#undef PG8_STAGE
#undef PG8_STAGEB
#undef PG8_LDA
#undef PG8_LDB
#undef PG8_MMA
#undef PG8_WAIT_V
#undef PG8_WAIT_L
#undef PG8_BAR
#undef PG8_SCHED
}

struct EpiStore {
    static constexpr bool PERM = true;
    bf16_t* O; int ldc;
    __device__ __forceinline__ void operator()(const f32x4 (&acc)[2][2][4][2], const Unit& u, int wr, int wc, int fr, int fq) const {
        const int row0 = u.pm * BM + wr * 64 + fr, col0 = u.pn * BM + wc * 32 + 8 * fq;
#pragma unroll
        for (int ai = 0; ai < 2; ++ai)
#pragma unroll
            for (int m = 0; m < 4; ++m) { bf16_t* rowp = O + (size_t)(row0 + ai * HALF + m * 16) * ldc + col0;
#pragma unroll
                for (int bj = 0; bj < 2; ++bj) { const f32x4 v0 = acc[ai][bj][m][0], v1 = acc[ai][bj][m][1];
                    u32x4 w; w.x = cvt_pk_bf16(v0[0], v0[1]); w.y = cvt_pk_bf16(v0[2], v0[3]); w.z = cvt_pk_bf16(v1[0], v1[1]); w.w = cvt_pk_bf16(v1[2], v1[3]);
                    *(u32x4*)(rowp + bj * HALF) = w; } }
    }
};
struct EpiMerge {
    static constexpr bool PERM = true;
    bf16_t* G; int ldg; const float* bias; bf16_t* Y; int accum;
    __device__ __forceinline__ void operator()(const f32x4 (&acc)[2][2][4][2], const Unit& u, int wr, int wc, int fr, int fq) const {
        const int row0 = u.pm * BM + wr * 64 + fr, col0 = u.pn * BM + wc * 32 + 8 * fq;
        if (u.sel == 0) {
            f32x4 bv[2][2];
#pragma unroll
            for (int bj = 0; bj < 2; ++bj)
#pragma unroll
                for (int n = 0; n < 2; ++n) bv[bj][n] = *(const f32x4*)(bias + col0 + bj * HALF + 4 * n);
#pragma unroll
            for (int ai = 0; ai < 2; ++ai)
#pragma unroll
                for (int m = 0; m < 4; ++m) { bf16_t* rowp = G + (size_t)(row0 + ai * HALF + m * 16) * ldg + col0;
#pragma unroll
                    for (int bj = 0; bj < 2; ++bj) { f32x4 v0 = acc[ai][bj][m][0] + bv[bj][0], v1 = acc[ai][bj][m][1] + bv[bj][1];
#pragma unroll
                        for (int j = 0; j < 4; ++j) { v0[j] = sigmoidf_(v0[j]); v1[j] = sigmoidf_(v1[j]); }
                        u32x4 w; w.x = cvt_pk_bf16(v0[0], v0[1]); w.y = cvt_pk_bf16(v0[2], v0[3]); w.z = cvt_pk_bf16(v1[0], v1[1]); w.w = cvt_pk_bf16(v1[2], v1[3]);
                        *(u32x4*)(rowp + bj * HALF) = w; } }
        } else {
#pragma unroll
            for (int ai = 0; ai < 2; ++ai)
#pragma unroll
                for (int m = 0; m < 4; ++m) { const size_t r = (size_t)(row0 + ai * HALF + m * 16);
                    const unsigned long long* gp = (const unsigned long long*)(G + r * ldg + col0); bf16_t* yp = Y + r * DM + col0;
#pragma unroll
                    for (int bj = 0; bj < 2; ++bj) {
                        const unsigned long long g0 = __hip_atomic_load(gp + bj * (HALF / 4), __ATOMIC_RELAXED, __HIP_MEMORY_SCOPE_AGENT);
                        const unsigned long long g1 = __hip_atomic_load(gp + bj * (HALF / 4) + 1, __ATOMIC_RELAXED, __HIP_MEMORY_SCOPE_AGENT);
                        const unsigned gw[4] = {(unsigned)g0, (unsigned)(g0 >> 32), (unsigned)g1, (unsigned)(g1 >> 32)};
                        u32x4 yo = {0u, 0u, 0u, 0u}; if (accum) yo = *(const u32x4*)(yp + bj * HALF);
                        const f32x4 v0 = acc[ai][bj][m][0], v1 = acc[ai][bj][m][1];
                        u32x4 w;
                        w.x = cvt_pk_bf16(bflo(yo.x) + bflo(gw[0]) * v0[0], bfhi(yo.x) + bfhi(gw[0]) * v0[1]);
                        w.y = cvt_pk_bf16(bflo(yo.y) + bflo(gw[1]) * v0[2], bfhi(yo.y) + bfhi(gw[1]) * v0[3]);
                        w.z = cvt_pk_bf16(bflo(yo.z) + bflo(gw[2]) * v1[0], bfhi(yo.z) + bfhi(gw[2]) * v1[1]);
                        w.w = cvt_pk_bf16(bflo(yo.w) + bflo(gw[3]) * v1[2], bfhi(yo.w) + bfhi(gw[3]) * v1[3]);
                        *(u32x4*)(yp + bj * HALF) = w; } }
        }
    }
};
struct EpiResid {
    static constexpr bool PERM = false;
    const float* Xin; float* Xout;
    __device__ __forceinline__ void operator()(const f32x4 (&acc)[2][2][4][2], const Unit& u, int wr, int wc, int fr, int fq) const {
        const int row0 = u.pm * BM + wr * 64 + fr, col0 = u.pn * BM + wc * 32 + 4 * fq;
#pragma unroll
        for (int ai = 0; ai < 2; ++ai)
#pragma unroll
            for (int m = 0; m < 4; ++m) { const size_t ro = (size_t)(row0 + ai * HALF + m * 16) * DM + col0;
#pragma unroll
                for (int bj = 0; bj < 2; ++bj)
#pragma unroll
                    for (int n = 0; n < 2; ++n) { const f32x4 xi = *(const f32x4*)(Xin + ro + bj * HALF + n * 16); *(f32x4*)(Xout + ro + bj * HALF + n * 16) = xi + acc[ai][bj][m][n]; } }
    }
};
}

__device__ void phase_convert(int l, unsigned char* smem) {
    const Params p = load_params();
    float* tile = (float*)smem;
    const int tid = opaque_tid();
    const float* win = p.w_in + (size_t)l * DM * N_IN;
    bf16_t* WtIn = p.Wt; bf16_t* WtBr = p.Wt + (size_t)WT_ROWS * DM; bf16_t* WtOut = WtBr + (size_t)3 * DM * DM;
    const int NT_IN = WT_ROWS / 64;
    const int total = (NT_IN + 48 + 16) * 16;
    for (int it = blockIdx.x; it < total; it += gridDim.x) {
        const int ntile = it >> 4, kt = it & 15, k0 = kt * 64;
        const float* src = nullptr; int ld = 0, c0 = 0, valid = 64; bf16_t* dst;
        if (ntile < NT_IN) {
            const int n0 = ntile * 64; dst = WtIn + (size_t)n0 * DM;
            if (n0 < 4224) { src = win; ld = N_IN; c0 = n0; }
            else if (n0 < 4352) { if (n0 == 4224 && l > 0) { src = p.v_w1 + (size_t)(l - 1) * DM * 32; ld = 32; c0 = 0; valid = 32; } else { valid = 0; } }
            else { src = win; ld = N_IN; c0 = n0 - 128; }
        } else if (ntile < NT_IN + 48) {
            const int q = ntile - NT_IN, n = q >> 4, n0 = (q & 15) * 64;
            src = p.w_branch + ((size_t)l * 3 + n) * DM * DM; ld = DM; c0 = n0; dst = WtBr + ((size_t)n * DM + n0) * DM;
        } else {
            const int n0 = (ntile - NT_IN - 48) * 64; src = p.w_out + (size_t)l * DM * DM; ld = DM; c0 = n0; dst = WtOut + (size_t)n0 * DM;
        }
        __syncthreads();
        if (valid == 64) {
            const int kr = tid >> 4, nc = (tid & 15) * 4;
#pragma unroll
            for (int ps = 0; ps < 2; ++ps) { const int k = kr + ps * 32; const f32x4 v = *(const f32x4*)(src + (size_t)(k0 + k) * ld + c0 + nc);
                tile[k * 65 + nc] = v[0]; tile[k * 65 + nc + 1] = v[1]; tile[k * 65 + nc + 2] = v[2]; tile[k * 65 + nc + 3] = v[3]; }
        } else {
            for (int e = tid; e < 4096; e += 512) { const int k = e >> 6, n = e & 63; tile[k * 65 + n] = (n < valid) ? src[(size_t)(k0 + k) * ld + c0 + n] : 0.f; }
        }
        __syncthreads();
        { const int nr = tid >> 3, kc = (tid & 7) * 8; u32x4 w;
          w.x = cvt_pk_bf16(tile[(kc + 0) * 65 + nr], tile[(kc + 1) * 65 + nr]); w.y = cvt_pk_bf16(tile[(kc + 2) * 65 + nr], tile[(kc + 3) * 65 + nr]);
          w.z = cvt_pk_bf16(tile[(kc + 4) * 65 + nr], tile[(kc + 5) * 65 + nr]); w.w = cvt_pk_bf16(tile[(kc + 6) * 65 + nr], tile[(kc + 7) * 65 + nr]);
          *(u32x4*)(dst + (size_t)nr * DM + k0 + kc) = w; }
    }
    __syncthreads();
}

__device__ void phase_rmsnorm(const float* x, const float* g, bf16_t* xn, float* outf) {
    const int tid_ = opaque_tid(); const int lane = tid_ & 63, wv = tid_ >> 6;
    f32x4 gv[4];
#pragma unroll
    for (int q = 0; q < 4; ++q) gv[q] = *(const f32x4*)(g + q * 256 + lane * 4);
    for (int row = blockIdx.x * 8 + wv; row < T_TOK; row += gridDim.x * 8) {
        const float* xr = x + (size_t)row * DM; f32x4 v[4]; float ss = 0.f;
#pragma unroll
        for (int q = 0; q < 4; ++q) { v[q] = *(const f32x4*)(xr + q * 256 + lane * 4); ss += v[q][0] * v[q][0] + v[q][1] * v[q][1] + v[q][2] * v[q][2] + v[q][3] * v[q][3]; }
#pragma unroll
        for (int o = 32; o > 0; o >>= 1) ss += __shfl_xor(ss, o);
        const float rinv = rsqrtf(ss * (1.0f / DM) + EPS);
#pragma unroll
        for (int q = 0; q < 4; ++q) { const f32x4 o = v[q] * rinv * gv[q];
            if (xn) { u32x2 w; w.x = cvt_pk_bf16(o[0], o[1]); w.y = cvt_pk_bf16(o[2], o[3]); *(u32x2*)(xn + (size_t)row * DM + q * 256 + lane * 4) = w; }
            else *(f32x4*)(outf + (size_t)row * DM + q * 256 + lane * 4) = o; }
    }
}

template <int CTRL> __device__ __forceinline__ float dpp_f(float v) { return __int_as_float(__builtin_amdgcn_update_dpp(0, __float_as_int(v), CTRL, 0xf, 0xf, false)); }
__device__ __forceinline__ float red8(float v) { v += dpp_f<0xB1>(v); v += dpp_f<0x4E>(v); v += dpp_f<0x141>(v); return v; }
__device__ __forceinline__ float red16(float v) { v = red8(v); v += dpp_f<0x140>(v); return v; }

struct RwRaw { u32x4 cw[2], pw[2], ca[2], pa[2], vl; u32x2 cr[2], pr[2], ck[2], pk[2], cv, pv, vf; };
__device__ __forceinline__ void rw_load(RwRaw& R, const bf16_t* H, const bf16_t* vfp, int l, size_t tok, bool hasp, int h, int chh, int vnt, int fq) {
    const bf16_t* cur = H + tok * LDA_H; const bf16_t* prev = cur - LDA_H;
    const u32x4 z4 = {0u, 0u, 0u, 0u}; const u32x2 z2 = {0u, 0u};
#pragma unroll
    for (int ks = 0; ks < 2; ++ks) { const int m0 = ks * 32 + fq * 8;
        R.cw[ks] = *(const u32x4*)(cur + 3072 + m0); R.ca[ks] = *(const u32x4*)(cur + 3136 + m0);
        R.pw[ks] = hasp ? *(const u32x4*)(prev + 3072 + m0) : z4; R.pa[ks] = hasp ? *(const u32x4*)(prev + 3136 + m0) : z4; }
#pragma unroll
    for (int q = 0; q < 2; ++q) { const int cb = h * 64 + (chh * 2 + q) * 16 + fq * 4;
        R.cr[q] = *(const u32x2*)(cur + cb); R.ck[q] = *(const u32x2*)(cur + 1024 + cb);
        R.pr[q] = hasp ? *(const u32x2*)(prev + cb) : z2; R.pk[q] = hasp ? *(const u32x2*)(prev + 1024 + cb) : z2; }
    const int cbv = h * 64 + vnt * 16 + fq * 4;
    R.cv = *(const u32x2*)(cur + 2048 + cbv); R.pv = hasp ? *(const u32x2*)(prev + 2048 + cbv) : z2;
    R.vf = z2; R.vl = z4;
    if (l > 0) { R.vf = *(const u32x2*)(vfp + tok * DM + cbv); R.vl = *(const u32x4*)(cur + 4224 + fq * 8); }
}

__device__ void phase_rwkv(int l, unsigned char* smem, int mode) {
    const Params p = load_params();
    constexpr int TC = 32, NCH = SEQ / TC, RS = 68  , BUFSZ = 5 * TC * RS + TC * 32 + TC * 2;
    bf16_t* w2T = (bf16_t*)smem;
    bf16_t* a2T = w2T + 64 * 72;
    bf16_t* v2T = a2T + 64 * 72;
    float* cst = (float*)(v2T + 64 * 40);
    float* buf0 = cst + 11 * 64;
    float* ypart = buf0 + 2 * BUFSZ;
    float* sI = ypart + 4 * TC * 64;
    const int tid = opaque_tid(), wid = __builtin_amdgcn_readfirstlane(tid >> 6), lane = tid & 63, fr = lane & 15, fq = lane >> 4;
    for (int item = blockIdx.x; item < NB * 32; item += gridDim.x) {
        const int xc_ = item & 7, sl_ = item >> 3, half = sl_ & 1, pi_ = (sl_ >> 1) * 8 + xc_, b = pi_ >> 4, h = pi_ & 15;
        __syncthreads();
        for (int e = tid; e < 4096; e += 512) { const int m = e >> 6, j = e & 63; w2T[j * 72 + m] = f2bf(p.w_w2[((size_t)l * 64 + m) * DM + h * 64 + j]); a2T[j * 72 + m] = f2bf(p.a_w2[((size_t)l * 64 + m) * DM + h * 64 + j]); }
        if (l > 0) for (int e = tid; e < 2048; e += 512) { const int m = e >> 6, j = e & 63; v2T[j * 40 + m] = f2bf(p.v_w2[((size_t)(l - 1) * 32 + m) * DM + h * 64 + j]); }
        if (tid < 64) { const float* mu = p.mu + (size_t)l * 3200; const int cc = h * 64 + tid;
            cst[tid] = mu[cc]; cst[64 + tid] = mu[1024 + cc]; cst[128 + tid] = mu[2048 + cc]; cst[192 + tid] = p.w0[l * DM + cc]; cst[256 + tid] = p.a0[l * DM + cc];
            cst[320 + tid] = (l > 0) ? p.v0[(l - 1) * DM + cc] : 0.f; cst[384 + tid] = p.k_k[l * DM + cc]; cst[448 + tid] = p.k_a[l * DM + cc]; cst[512 + tid] = p.r_k[l * DM + cc];
            cst[576 + tid] = mu[3072 + tid]; cst[640 + tid] = mu[3136 + tid]; }
        __syncthreads();
        f32x2 st[4];
#pragma unroll
        for (int j = 0; j < 4; ++j) st[j] = (f32x2){0.f, 0.f};
        const int si = tid >> 3, seg = tid & 7;
        const int pwv = wid - 4, tti = pwv & 1, chh = (pwv >> 1) & 1, vnt = half * 2 + chh, tt = tti * 16 + fr;
        RwRaw raw;
        if (wid >= 4) rw_load(raw, p.H, p.vf, l, (size_t)b * SEQ + tt, tt > 0, h, chh, vnt, fq);
        for (int c = -1; c < NCH; ++c) {
            if (wid >= 4 && c + 1 < NCH && !(mode & 2)) {
                float* B_ = buf0 + ((c + 1) & 1) * BUFSZ;
                float* sR = B_; float* sW = sR + TC * RS; float* sK = sW + TC * RS; float* sA = sK + TC * RS; float* sB = sA + TC * RS; float* sV = sB + TC * RS; float* sS = sV + TC * 32;
                const size_t tok = (size_t)b * SEQ + (c + 1) * TC + tt;
                const RwRaw& cr_ = raw;
                bf16x8 AfW[2], AfA[2];
#pragma unroll
                for (int ks = 0; ks < 2; ++ks) { const int m0 = ks * 32 + fq * 8;
                    const f32x4 mw0 = *(const f32x4*)(cst + 576 + m0), mw1 = *(const f32x4*)(cst + 576 + m0 + 4), ma0 = *(const f32x4*)(cst + 640 + m0), ma1 = *(const f32x4*)(cst + 640 + m0 + 4);
                    const float muw[8] = {mw0[0], mw0[1], mw0[2], mw0[3], mw1[0], mw1[1], mw1[2], mw1[3]}, mua[8] = {ma0[0], ma0[1], ma0[2], ma0[3], ma1[0], ma1[1], ma1[2], ma1[3]};
                    const unsigned cwv[4] = {cr_.cw[ks].x, cr_.cw[ks].y, cr_.cw[ks].z, cr_.cw[ks].w}, pwq[4] = {cr_.pw[ks].x, cr_.pw[ks].y, cr_.pw[ks].z, cr_.pw[ks].w};
                    const unsigned cav[4] = {cr_.ca[ks].x, cr_.ca[ks].y, cr_.ca[ks].z, cr_.ca[ks].w}, pav[4] = {cr_.pa[ks].x, cr_.pa[ks].y, cr_.pa[ks].z, cr_.pa[ks].w};
                    unsigned ow[4], oa[4];
#pragma unroll
                    for (int e = 0; e < 4; ++e) {
                        const float c0 = bflo(cwv[e]), c1 = bfhi(cwv[e]), q0 = bflo(pwq[e]), q1 = bfhi(pwq[e]);
                        ow[e] = cvt_pk_bf16(tanh_fast(c0 + muw[2 * e] * (q0 - c0)), tanh_fast(c1 + muw[2 * e + 1] * (q1 - c1)));
                        const float d0 = bflo(cav[e]), d1 = bfhi(cav[e]), r0 = bflo(pav[e]), r1 = bfhi(pav[e]);
                        oa[e] = cvt_pk_bf16(d0 + mua[2 * e] * (r0 - d0), d1 + mua[2 * e + 1] * (r1 - d1)); }
                    AfW[ks] = __builtin_bit_cast(bf16x8, ((u32x4){ow[0], ow[1], ow[2], ow[3]})); AfA[ks] = __builtin_bit_cast(bf16x8, ((u32x4){oa[0], oa[1], oa[2], oa[3]})); }
                f32x4 accW[2], accA[2], accV = (f32x4){0.f, 0.f, 0.f, 0.f};
#pragma unroll
                for (int q = 0; q < 2; ++q) { const int nt = chh * 2 + q; accW[q] = (f32x4){0.f, 0.f, 0.f, 0.f}; accA[q] = (f32x4){0.f, 0.f, 0.f, 0.f};
#pragma unroll
                    for (int ks = 0; ks < 2; ++ks) { const bf16x8 bw = *(const bf16x8*)(w2T + (nt * 16 + fr) * 72 + ks * 32 + fq * 8), ba = *(const bf16x8*)(a2T + (nt * 16 + fr) * 72 + ks * 32 + fq * 8);
                        accW[q] = __builtin_amdgcn_mfma_f32_16x16x32_bf16(bw, AfW[ks], accW[q], 0, 0, 0); accA[q] = __builtin_amdgcn_mfma_f32_16x16x32_bf16(ba, AfA[ks], accA[q], 0, 0, 0); } }
                if (l > 0) { const bf16x8 bv = *(const bf16x8*)(v2T + (vnt * 16 + fr) * 40 + fq * 8); accV = __builtin_amdgcn_mfma_f32_16x16x32_bf16(bv, __builtin_bit_cast(bf16x8, cr_.vl), accV, 0, 0, 0); }
                float ss = 0.f, rk = 0.f;
#pragma unroll
                for (int q = 0; q < 2; ++q) { const int ch0 = (chh * 2 + q) * 16 + fq * 4;
                    const float fr_[4] = {bflo(cr_.cr[q].x), bfhi(cr_.cr[q].x), bflo(cr_.cr[q].y), bfhi(cr_.cr[q].y)}, fpr[4] = {bflo(cr_.pr[q].x), bfhi(cr_.pr[q].x), bflo(cr_.pr[q].y), bfhi(cr_.pr[q].y)};
                    const float fk_[4] = {bflo(cr_.ck[q].x), bfhi(cr_.ck[q].x), bflo(cr_.ck[q].y), bfhi(cr_.ck[q].y)}, fpk[4] = {bflo(cr_.pk[q].x), bfhi(cr_.pk[q].x), bflo(cr_.pk[q].y), bfhi(cr_.pk[q].y)};
                    const f32x4 mur = *(const f32x4*)(cst + ch0), muk = *(const f32x4*)(cst + 64 + ch0), w0v = *(const f32x4*)(cst + 192 + ch0), a0v = *(const f32x4*)(cst + 256 + ch0),
                        kkv = *(const f32x4*)(cst + 384 + ch0), kav = *(const f32x4*)(cst + 448 + ch0), rkv = *(const f32x4*)(cst + 512 + ch0);
                    f32x4 ro, wo, ko, ao, bo;
#pragma unroll
                    for (int e = 0; e < 4; ++e) {
                        const float r = fr_[e] + mur[e] * (fpr[e] - fr_[e]), k = fk_[e] + muk[e] * (fpk[e] - fk_[e]);
                        wo[e] = __expf(-0.60653065971f * sigmoidf_(w0v[e] + accW[q][e]));
                        const float a = sigmoidf_(a0v[e] + accA[q][e]);
                        const float kq = k * kkv[e]; ss += kq * kq; ao[e] = -kq; bo[e] = kq * a;
                        const float km = k * (1.0f + (a - 1.0f) * kav[e]); rk += r * km * rkv[e]; ro[e] = r; ko[e] = km; }
                    *(f32x4*)(sR + tt * RS + ch0) = ro; *(f32x4*)(sW + tt * RS + ch0) = wo; *(f32x4*)(sK + tt * RS + ch0) = ko; *(f32x4*)(sA + tt * RS + ch0) = ao; *(f32x4*)(sB + tt * RS + ch0) = bo; }
                ss += __shfl_xor(ss, 16); ss += __shfl_xor(ss, 32); rk += __shfl_xor(rk, 16); rk += __shfl_xor(rk, 32);
                if (fq == 0) { sS[tt * 2 + chh] = ss; if (half == 0) p.rkbuf[(size_t)((b * 16 + h) * 2 + chh) * SEQ + (c + 1) * TC + tt] = rk; }
                { const int ch0 = vnt * 16 + fq * 4, cb = h * 64 + ch0;
                  const float fv_[4] = {bflo(cr_.cv.x), bfhi(cr_.cv.x), bflo(cr_.cv.y), bfhi(cr_.cv.y)}, fpv[4] = {bflo(cr_.pv.x), bfhi(cr_.pv.x), bflo(cr_.pv.y), bfhi(cr_.pv.y)};
                  const f32x4 muv = *(const f32x4*)(cst + 128 + ch0), v0v = *(const f32x4*)(cst + 320 + ch0);
                  f32x4 vo;
#pragma unroll
                  for (int e = 0; e < 4; ++e) vo[e] = fv_[e] + muv[e] * (fpv[e] - fv_[e]);
                  if (l > 0) { const float vfv[4] = {bflo(cr_.vf.x), bfhi(cr_.vf.x), bflo(cr_.vf.y), bfhi(cr_.vf.y)};
#pragma unroll
                      for (int e = 0; e < 4; ++e) vo[e] = vo[e] + (vfv[e] - vo[e]) * sigmoidf_(v0v[e] + accV[e]); }
                  u32x2 w; w.x = cvt_pk_bf16(vo[0], vo[1]); w.y = cvt_pk_bf16(vo[2], vo[3]); *(u32x2*)(p.vf + tok * DM + cb) = w;
                  *(f32x4*)(sV + tt * 32 + chh * 16 + fq * 4) = vo; }
            }
            if (wid >= 4 && c + 2 < NCH && !(mode & 2)) rw_load(raw, p.H, p.vf, l, (size_t)b * SEQ + (size_t)(c + 2) * TC + tt, true, h, chh, vnt, fq);
            if (wid < 4 && c >= 0 && !(mode & 1)) {
                const float* B_ = buf0 + (c & 1) * BUFSZ;
                const float* sR = B_; const float* sW = sR + TC * RS; const float* sK = sW + TC * RS; const float* sA = sK + TC * RS; const float* sB = sA + TC * RS; const float* sV = sB + TC * RS; const float* sS = sV + TC * 32;
                float* yp = ypart + wid * (TC * 64) + lane; const float* svp = sV + si;
                { unsigned a_ = (unsigned)(size_t)(LAS float*)yp, b_ = (unsigned)(size_t)(LAS const float*)svp; asm volatile("" : "+v"(a_), "+v"(b_)); yp = (float*)(LAS float*)(size_t)a_; svp = (const float*)(LAS const float*)(size_t)b_; }
                float ivreg = 0.f;
                if (lane < TC) { const f32x2 ps = *(const f32x2*)(sS + lane * 2); ivreg = __builtin_amdgcn_rcpf(fmaxf(ps.x + ps.y, 1e-24f)); }
                struct ScOp { f32x4 a0, a1, w0, w1, b0, b1, k0, k1, r0, r1; float vi, iv; };
                auto sc_load = [&](ScOp& o, const int s_) { const int o_ = s_ * RS + seg * 8;
                    o.a0 = *(const f32x4*)(sA + o_); o.a1 = *(const f32x4*)(sA + o_ + 4); o.w0 = *(const f32x4*)(sW + o_); o.w1 = *(const f32x4*)(sW + o_ + 4);
                    o.b0 = *(const f32x4*)(sB + o_); o.b1 = *(const f32x4*)(sB + o_ + 4); o.k0 = *(const f32x4*)(sK + o_); o.k1 = *(const f32x4*)(sK + o_ + 4);
                    o.r0 = *(const f32x4*)(sR + o_); o.r1 = *(const f32x4*)(sR + o_ + 4); o.vi = svp[s_ * 32]; o.iv = __int_as_float(__builtin_amdgcn_readlane(__float_as_int(ivreg), s_)); };
                auto sc_step = [&](const ScOp& o, const int s_) {
                    const f32x2 av[4] = {{o.a0[0], o.a0[1]}, {o.a0[2], o.a0[3]}, {o.a1[0], o.a1[1]}, {o.a1[2], o.a1[3]}}, wv[4] = {{o.w0[0], o.w0[1]}, {o.w0[2], o.w0[3]}, {o.w1[0], o.w1[1]}, {o.w1[2], o.w1[3]}};
                    const f32x2 bv[4] = {{o.b0[0], o.b0[1]}, {o.b0[2], o.b0[3]}, {o.b1[0], o.b1[1]}, {o.b1[2], o.b1[3]}}, kv[4] = {{o.k0[0], o.k0[1]}, {o.k0[2], o.k0[3]}, {o.k1[0], o.k1[1]}, {o.k1[2], o.k1[3]}};
                    const f32x2 rv[4] = {{o.r0[0], o.r0[1]}, {o.r0[2], o.r0[3]}, {o.r1[0], o.r1[1]}, {o.r1[2], o.r1[3]}};
                    const f32x2 vi2 = {o.vi, o.vi};
                    f32x2 vk[4];
#pragma unroll
                    for (int j = 0; j < 4; ++j) vk[j] = vi2 * kv[j];
                    f32x2 pc = st[0] * av[0]; pc += st[1] * av[1]; pc += st[2] * av[2]; pc += st[3] * av[3];
                    const float sa = red8(pc.x + pc.y) * o.iv;
                    const f32x2 sa2 = {sa, sa};
#pragma unroll
                    for (int j = 0; j < 4; ++j) st[j] = st[j] * wv[j] + (sa2 * bv[j] + vk[j]);
                    f32x2 qc = st[0] * rv[0]; qc += st[1] * rv[1]; qc += st[2] * rv[2]; qc += st[3] * rv[3];
                    yp[s_ * 64] = qc.x + qc.y;
                };
                ScOp opX, opY; sc_load(opX, 0);
#pragma unroll 4
                for (int s = 0; s < TC; s += 2) {
                    sc_load(opY, s + 1); sc_step(opX, s);
                    if (s + 2 < TC) sc_load(opX, s + 2);
                    sc_step(opY, s + 1);
                }
                { const int tk = lane >> 1, rq = (lane & 1) * 4; const float* yr = ypart + wid * (TC * 64) + tk * 64 + rq * 8; float yv[4];
#pragma unroll
                  for (int r_ = 0; r_ < 4; ++r_) { const f32x4 u0 = *(const f32x4*)(yr + r_ * 8), u1 = *(const f32x4*)(yr + r_ * 8 + 4); yv[r_] = ((u0[0] + u0[1]) + (u0[2] + u0[3])) + ((u1[0] + u1[1]) + (u1[2] + u1[3])); }
                  u32x2 w; w.x = cvt_pk_bf16(yv[0], yv[1]); w.y = cvt_pk_bf16(yv[2], yv[3]);
                  *(u32x2*)(p.y + ((size_t)b * SEQ + c * TC + tk) * DM + h * 64 + half * 32 + wid * 8 + rq) = w; }
            }
            __syncthreads();
        }
    }
    __syncthreads();
}

__device__ void phase_rwkv_post(int l, bf16_t* oalt) {
    const Params p = load_params();
    const int tid = opaque_tid(), l8 = tid & 7;
    const int ngrp = T_TOK * 16;
    for (int g = blockIdx.x * 64 + (tid >> 3); g < ngrp; g += gridDim.x * 64) {
        const int tok = g >> 4, h = g & 15, cb = h * 64 + l8 * 8;
        const u32x4 y4 = *(const u32x4*)(p.y + (size_t)tok * DM + cb), b4 = *(const u32x4*)(p.vf + (size_t)tok * DM + cb);
        const int bb = tok / SEQ, tq = tok % SEQ; const float rk = p.rkbuf[(size_t)((bb * 16 + h) * 2) * SEQ + tq] + p.rkbuf[(size_t)((bb * 16 + h) * 2 + 1) * SEQ + tq];
        bf16_t* zp = p.H + (size_t)tok * LDA_H + 3200 + cb; const u32x4 z4 = *(const u32x4*)zp;
        const float yv[8] = {bflo(y4.x), bfhi(y4.x), bflo(y4.y), bfhi(y4.y), bflo(y4.z), bfhi(y4.z), bflo(y4.w), bfhi(y4.w)};
        const float bv[8] = {bflo(b4.x), bfhi(b4.x), bflo(b4.y), bfhi(b4.y), bflo(b4.z), bfhi(b4.z), bflo(b4.w), bfhi(b4.w)};
        const float zv[8] = {bflo(z4.x), bfhi(z4.x), bflo(z4.y), bfhi(z4.y), bflo(z4.z), bfhi(z4.z), bflo(z4.w), bfhi(z4.w)};
        float sm = 0.f;
#pragma unroll
        for (int e = 0; e < 8; ++e) sm += yv[e];
        sm = red8(sm); const float mean = sm * (1.0f / 64.f); float d[8], vs = 0.f;
#pragma unroll
        for (int e = 0; e < 8; ++e) { d[e] = yv[e] - mean; vs += d[e] * d[e]; }
        vs = red8(vs); const float rstd = rsqrtf(vs * (1.0f / 64.f) + GN_EPS);
        const f32x4 g0 = *(const f32x4*)(p.lnx_g + l * DM + cb), g1 = *(const f32x4*)(p.lnx_g + l * DM + cb + 4), c0 = *(const f32x4*)(p.lnx_b + l * DM + cb), c1 = *(const f32x4*)(p.lnx_b + l * DM + cb + 4);
        const float gg[8] = {g0[0], g0[1], g0[2], g0[3], g1[0], g1[1], g1[2], g1[3]}, cc[8] = {c0[0], c0[1], c0[2], c0[3], c1[0], c1[1], c1[2], c1[3]};
        float o[8];
#pragma unroll
        for (int e = 0; e < 8; ++e) o[e] = (d[e] * rstd * gg[e] + cc[e] + rk * bv[e]) * siluf_(zv[e]);
        u32x4 w; w.x = cvt_pk_bf16(o[0], o[1]); w.y = cvt_pk_bf16(o[2], o[3]); w.z = cvt_pk_bf16(o[4], o[5]); w.w = cvt_pk_bf16(o[6], o[7]);
        *(u32x4*)(oalt ? oalt + (size_t)tok * DM + cb : zp) = w;
    }
}

__device__ __forceinline__ float wave_sum64(float v) {
    v = red16(v);
    const float a = __int_as_float(__builtin_amdgcn_readlane(__float_as_int(v), 0)), b = __int_as_float(__builtin_amdgcn_readlane(__float_as_int(v), 16));
    const float c = __int_as_float(__builtin_amdgcn_readlane(__float_as_int(v), 32)), d = __int_as_float(__builtin_amdgcn_readlane(__float_as_int(v), 48));
    return (a + b) + (c + d);
}
__device__ void phase_sgu(int l, unsigned char* smem, bf16_t* oalt) {
    const Params p = load_params();
    bf16_t* vnTb = (bf16_t*)smem;
    float* stat = (float*)(smem + 2 * 128 * 136 * 2);
    float* lnG = stat + 256; float* lnB = lnG + DM;
    const int tid = opaque_tid(), wid = tid >> 6, lane = tid & 63, fr = lane & 15, fq = lane >> 4;
    __syncthreads();
    for (int e = tid; e < DM; e += 512) { lnG[e] = p.sgu_ln_g[(size_t)l * DM + e]; lnB[e] = p.sgu_ln_b[(size_t)l * DM + e]; }
    for (int item = blockIdx.x; item < T_TOK / 128; item += gridDim.x) {
        bf16_t* Hb = p.H + (size_t)item * 128 * LDB_H;
        __syncthreads();
#pragma unroll
        for (int hb = 0; hb < 2; ++hb) {
            u32x4 va[8], vb[8];
#pragma unroll
            for (int q = 0; q < 8; ++q) { const bf16_t* vr = Hb + (size_t)(wid * 16 + hb * 8 + q) * LDB_H + 1024 + lane * 16; va[q] = *(const u32x4*)vr; vb[q] = *(const u32x4*)(vr + 8); }
#pragma unroll
            for (int q = 0; q < 8; ++q) {
                const float f[16] = {bflo(va[q].x), bfhi(va[q].x), bflo(va[q].y), bfhi(va[q].y), bflo(va[q].z), bfhi(va[q].z), bflo(va[q].w), bfhi(va[q].w), bflo(vb[q].x), bfhi(vb[q].x), bflo(vb[q].y), bfhi(vb[q].y), bflo(vb[q].z), bfhi(vb[q].z), bflo(vb[q].w), bfhi(vb[q].w)};
                float sm = 0.f, sq = 0.f;
#pragma unroll
                for (int e = 0; e < 16; ++e) { sm += f[e]; sq += f[e] * f[e]; }
                sm = wave_sum64(sm); sq = wave_sum64(sq);
                const float mean = sm * (1.0f / DM), var = fmaxf(sq * (1.0f / DM) - mean * mean, 0.f);
                if (lane == 0) { const int s = wid * 16 + hb * 8 + q; stat[s * 2] = mean; stat[s * 2 + 1] = rsqrtf(var + EPS); } }
        }
        __syncthreads();
        const int trow = wid * 16 + fr; bf16_t* hr = Hb + (size_t)trow * LDB_H;
        const int nks = (wid < 4) ? 2 : 4;
        for (int g = 0; g < 8; ++g) {
            bf16_t* vnT = vnTb + (g & 1) * (128 * 136);
            const int s = tid >> 2, c0 = (tid & 3) * 32;
            const bf16_t* vr = Hb + (size_t)s * LDB_H + 1024 + g * 128 + c0;
            u32x4 vv[4];
#pragma unroll
            for (int q = 0; q < 4; ++q) vv[q] = *(const u32x4*)(vr + q * 8);
            const float* Wg = p.sgu_w + (((size_t)l * 8 + g) * 128 + trow) * 128;
            f32x4 wa[4], wb[4];
#pragma unroll
            for (int ks = 0; ks < 4; ++ks) if (ks < nks) { wa[ks] = *(const f32x4*)(Wg + ks * 32 + fq * 8); wb[ks] = *(const f32x4*)(Wg + ks * 32 + fq * 8 + 4); }
            u32x2 u2[8], z2[8];
#pragma unroll
            for (int ct = 0; ct < 8; ++ct) { const int c = g * 128 + ct * 16 + fq * 4; u2[ct] = *(const u32x2*)(hr + c); z2[ct] = *(const u32x2*)(hr + 2048 + c); }
            const float bs = p.sgu_b[((size_t)l * 8 + g) * 128 + trow];
            { const float mean = stat[s * 2], rstd = stat[s * 2 + 1];
#pragma unroll
              for (int q = 0; q < 4; ++q) { const float f[8] = {bflo(vv[q].x), bfhi(vv[q].x), bflo(vv[q].y), bfhi(vv[q].y), bflo(vv[q].z), bfhi(vv[q].z), bflo(vv[q].w), bfhi(vv[q].w)};
                  const f32x4 g0 = *(const f32x4*)(lnG + g * 128 + c0 + q * 8), g1 = *(const f32x4*)(lnG + g * 128 + c0 + q * 8 + 4), b0 = *(const f32x4*)(lnB + g * 128 + c0 + q * 8), b1 = *(const f32x4*)(lnB + g * 128 + c0 + q * 8 + 4);
                  const float gg[8] = {g0[0], g0[1], g0[2], g0[3], g1[0], g1[1], g1[2], g1[3]}, bb[8] = {b0[0], b0[1], b0[2], b0[3], b1[0], b1[1], b1[2], b1[3]};
#pragma unroll
                  for (int e = 0; e < 8; ++e) { const int c = c0 + q * 8 + e; const float a_ = rstd * gg[e]; vnT[c * 136 + s] = f2bf(f[e] * a_ + (bb[e] - mean * a_)); } } }
            __syncthreads();
            f32x4 acc[8];
#pragma unroll
            for (int i = 0; i < 8; ++i) acc[i] = (f32x4){0.f, 0.f, 0.f, 0.f};
#pragma unroll
            for (int ks = 0; ks < 4; ++ks) if (ks < nks) {
                u32x4 wp; wp.x = cvt_pk_bf16(wa[ks][0], wa[ks][1]); wp.y = cvt_pk_bf16(wa[ks][2], wa[ks][3]); wp.z = cvt_pk_bf16(wb[ks][0], wb[ks][1]); wp.w = cvt_pk_bf16(wb[ks][2], wb[ks][3]);
                const bf16x8 wfrag = __builtin_bit_cast(bf16x8, wp);
#pragma unroll
                for (int ct = 0; ct < 8; ++ct) { const bf16x8 vfrag = *(const bf16x8*)(vnT + (ct * 16 + fr) * 136 + ks * 32 + fq * 8);
                    acc[ct] = __builtin_amdgcn_mfma_f32_16x16x32_bf16(vfrag, wfrag, acc[ct], 0, 0, 0); }
            }
#pragma unroll
            for (int ct = 0; ct < 8; ++ct) { const int c = g * 128 + ct * 16 + fq * 4;
                const float uf[4] = {bflo(u2[ct].x), bfhi(u2[ct].x), bflo(u2[ct].y), bfhi(u2[ct].y)}, zf[4] = {bflo(z2[ct].x), bfhi(z2[ct].x), bflo(z2[ct].y), bfhi(z2[ct].y)};
                float o[4];
#pragma unroll
                for (int j = 0; j < 4; ++j) o[j] = uf[j] * (acc[ct][j] + bs) * siluf_(zf[j]);
                u32x2 w; w.x = cvt_pk_bf16(o[0], o[1]); w.y = cvt_pk_bf16(o[2], o[3]); *(u32x2*)(oalt ? oalt + ((size_t)item * 128 + trow) * DM + c : hr + 2048 + c) = w; }
        }
    }
    __syncthreads();
}

__device__ void phase_hgrn_pre(int l, unsigned char* smem, bool dry) {
    const Params p = load_params();
    float* LF = (float*)smem;
    bf16_t* IB = (bf16_t*)(LF + 64 * 132);
    bf16_t* KB = IB + 64 * 136;
    float* psum = (float*)(KB + 64 * 136);
    float* lbs = psum + 512;
    const int tid = opaque_tid();
    bf16_t* xtra = (l == 0) ? (bf16_t*)p.out : p.vf;
    __syncthreads();
    for (int e = tid; e < DM; e += 512) { float lb = 0.f; if (l == 1) { const float l0 = p.lb_logits[e], l1 = p.lb_logits[DM + e]; lb = __builtin_amdgcn_rcpf(1.0f + __expf(l0 - l1)); } lbs[e] = lb; }
    __syncthreads();
    const int t = tid >> 3, c0 = (tid & 7) * 16;
    const int cc = tid & 127, tq = tid >> 7;
    u32x4 nq0, nq1, nf0, nf1, ni0, ni1;
#define HP_ISSUE(it_) do { const int h_ = (it_) & 7, ch_ = ((it_) >> 3) & 63, b_ = (it_) >> 9; const bf16_t* hr_ = p.H + ((size_t)b_ * SEQ + ch_ * 64 + t) * LDC_H + h_ * 128 + c0; \
        nq0 = *(const u32x4*)hr_; nq1 = *(const u32x4*)(hr_ + 8); nf0 = *(const u32x4*)(hr_ + 1024); nf1 = *(const u32x4*)(hr_ + 1032); ni0 = *(const u32x4*)(hr_ + 2048); ni1 = *(const u32x4*)(hr_ + 2056); } while (0)
    if ((int)blockIdx.x < NB * 64 * 8) HP_ISSUE((int)blockIdx.x);
    for (int item = blockIdx.x; item < NB * 64 * 8; item += gridDim.x) {
        const int h = item & 7, ch = (item >> 3) & 63, b = item >> 9;
        const size_t r0 = (size_t)b * SEQ + ch * 64;
        bf16_t* hr = p.H + (r0 + t) * LDC_H + h * 128 + c0;
        float qv[16], kv[16];
        {
            const u32x4 q0 = nq0, q1 = nq1, f0 = nf0, f1 = nf1, i0 = ni0, i1 = ni1;
            if (item + (int)gridDim.x < NB * 64 * 8) HP_ISSUE(item + (int)gridDim.x);
            const unsigned qa[8] = {q0.x, q0.y, q0.z, q0.w, q1.x, q1.y, q1.z, q1.w}, fa[8] = {f0.x, f0.y, f0.z, f0.w, f1.x, f1.y, f1.z, f1.w};
            *(u32x4*)(IB + t * 136 + c0) = i0; *(u32x4*)(IB + t * 136 + c0 + 8) = i1;
            float lf[16];
#pragma unroll
            for (int e = 0; e < 8; ++e) {
                const float lb0 = lbs[h * 128 + c0 + 2 * e], lb1 = lbs[h * 128 + c0 + 2 * e + 1];
                qv[2 * e] = siluf_(bflo(qa[e])); qv[2 * e + 1] = siluf_(bfhi(qa[e]));
                const float g0 = lb0 + (1.0f - lb0) * sigmoidf_(bflo(fa[e])), g1 = lb1 + (1.0f - lb1) * sigmoidf_(bfhi(fa[e]));
                kv[2 * e] = 1.0f - g0; kv[2 * e + 1] = 1.0f - g1; lf[2 * e] = __logf(g0); lf[2 * e + 1] = __logf(g1); }
#pragma unroll
            for (int e = 0; e < 4; ++e) *(f32x4*)(LF + t * 132 + c0 + e * 4) = (f32x4){lf[e * 4], lf[e * 4 + 1], lf[e * 4 + 2], lf[e * 4 + 3]};
        }
        __syncthreads();
        { float run = 0.f;
#pragma unroll
          for (int e = 0; e < 16; ++e) { run += LF[(tq * 16 + e) * 132 + cc]; LF[(tq * 16 + e) * 132 + cc] = run; }
          psum[tq * 128 + cc] = run; }
        __syncthreads();
        {
            const int tqt = t >> 4;
            unsigned qo[8], ko[8];
#pragma unroll
            for (int e4 = 0; e4 < 4; ++e4) {
                const f32x4 p0 = *(const f32x4*)(psum + c0 + e4 * 4), p1 = *(const f32x4*)(psum + 128 + c0 + e4 * 4), p2 = *(const f32x4*)(psum + 256 + c0 + e4 * 4), p3 = *(const f32x4*)(psum + 384 + c0 + e4 * 4);
                const f32x4 bl = *(const f32x4*)(LF + t * 132 + c0 + e4 * 4);
                float q2[4], k2[4];
#pragma unroll
                for (int j = 0; j < 4; ++j) {
                    const float off = (tqt > 0 ? p0[j] : 0.f) + (tqt > 1 ? p1[j] : 0.f) + (tqt > 2 ? p2[j] : 0.f);
                    const float bmid = p0[j] + p1[j], bb = bl[j] + off;
                    q2[j] = qv[e4 * 4 + j] * __expf(bb - bmid); k2[j] = kv[e4 * 4 + j] * __expf(bmid - bb); }
                qo[e4 * 2] = cvt_pk_bf16(q2[0], q2[1]); qo[e4 * 2 + 1] = cvt_pk_bf16(q2[2], q2[3]); ko[e4 * 2] = cvt_pk_bf16(k2[0], k2[1]); ko[e4 * 2 + 1] = cvt_pk_bf16(k2[2], k2[3]);
                if (t == 0) { f32x4 e1, e3;
#pragma unroll
                    for (int j = 0; j < 4; ++j) { e1[j] = __expf(p0[j] + p1[j]); e3[j] = __expf(p2[j] + p3[j]); }
                    float* gs = p.rkbuf + (size_t)(((b * 64 + ch) * 8 + h)) * 256 + c0 + e4 * 4; *(f32x4*)gs = e1; *(f32x4*)(gs + 128) = e3; }
            }
            const u32x4 qw0 = {qo[0], qo[1], qo[2], qo[3]}, qw1 = {qo[4], qo[5], qo[6], qo[7]}, kw0 = {ko[0], ko[1], ko[2], ko[3]}, kw1 = {ko[4], ko[5], ko[6], ko[7]};
            if (!dry) { *(u32x4*)hr = qw0; *(u32x4*)(hr + 8) = qw1; *(u32x4*)(hr + 1024) = kw0; *(u32x4*)(hr + 1032) = kw1; }
            *(u32x4*)(KB + t * 136 + c0) = kw0; *(u32x4*)(KB + t * 136 + c0 + 8) = kw1;
        }
        __syncthreads();
        {
            unsigned iw[8], kw[8];
#pragma unroll
            for (int e = 0; e < 8; ++e) {
                iw[e] = (unsigned)IB[(tq * 16 + 2 * e) * 136 + cc] | ((unsigned)IB[(tq * 16 + 2 * e + 1) * 136 + cc] << 16);
                kw[e] = (unsigned)KB[(tq * 16 + 2 * e) * 136 + cc] | ((unsigned)KB[(tq * 16 + 2 * e + 1) * 136 + cc] << 16); }
            bf16_t* ir = p.H + (r0 + (cc >> 1)) * LDC_H + 2048 + h * 128 + (cc & 1) * 64 + tq * 16;
            if (!dry) { *(u32x4*)ir = (u32x4){iw[0], iw[1], iw[2], iw[3]}; *(u32x4*)(ir + 8) = (u32x4){iw[4], iw[5], iw[6], iw[7]}; }
            bf16_t* kr = xtra + (r0 + (cc >> 1)) * DM + h * 128 + (cc & 1) * 64 + tq * 16;
            *(u32x4*)kr = (u32x4){kw[0], kw[1], kw[2], kw[3]}; *(u32x4*)(kr + 8) = (u32x4){kw[4], kw[5], kw[6], kw[7]};
        }
        __syncthreads();
    }
}

struct HgSet { u32x4 r[7]; };
__device__ __forceinline__ void hg_issue(HgSet& R, const bf16_t* H, const bf16_t* xtra, const float* gsc, int b, int ch, int h, int vs, int tid) {
    const size_t r0 = (size_t)b * SEQ + (size_t)ch * 64;
    const int row = tid >> 4, wi = tid & 15;
#pragma unroll
    for (int j = 0; j < 2; ++j) { const int t = j * 32 + row; R.r[j] = *(const u32x4*)(H + (r0 + t) * LDC_H + h * 128 + wi * 8); R.r[2 + j] = *(const u32x4*)(H + (r0 + t) * LDC_H + 1024 + h * 128 + wi * 8); }
#pragma unroll
    for (int j = 0; j < 2; ++j) { const int kp = j * 32 + row; R.r[4 + j] = *(const u32x4*)(xtra + (r0 + kp) * DM + h * 128 + wi * 8); }
    const u32x4 z4 = {0u, 0u, 0u, 0u}; R.r[6] = z4;
    if (tid < 256) R.r[6] = *(const u32x4*)(H + (r0 + vs * 16 + row) * LDC_H + 2048 + h * 128 + wi * 8);
    else if (tid < 320) R.r[6] = *(const u32x4*)(gsc + (size_t)(((b * 64 + ch) * 8 + h)) * 256 + (tid - 256) * 4);
}
constexpr int HG_QM = 0, HG_KM = 16 * 65 * 16, HG_KT = 2 * 16 * 65 * 16, HG_IT = HG_KT + 8 * 129 * 16, HG_E = HG_IT + 8 * 33 * 16, HG_BUF = HG_E + 1024;
__device__ __forceinline__ void hg_stage(const HgSet& R, unsigned char* B, int tid) {
    const int row = tid >> 4, wi = tid & 15;
#pragma unroll
    for (int j = 0; j < 2; ++j) { const int t = j * 32 + row; *(u32x4*)(B + HG_QM + (wi * 65 + t) * 16) = R.r[j]; *(u32x4*)(B + HG_KM + (wi * 65 + t) * 16) = R.r[2 + j]; }
#pragma unroll
    for (int j = 0; j < 2; ++j) { const int k = (j * 32 + row) * 2 + (wi >> 3), sc = wi & 7; *(u32x4*)(B + HG_KT + (sc * 129 + k) * 16) = R.r[4 + j]; }
    if (tid < 256) { const int vv = row * 2 + (wi >> 3), sc = wi & 7; *(u32x4*)(B + HG_IT + (sc * 33 + vv) * 16) = R.r[6]; }
    else if (tid < 320) *(u32x4*)(B + HG_E + (tid - 256) * 16) = R.r[6];
}

__device__ void phase_hgrn_seq(int l, unsigned char* smem, bool dry) {
    const Params p = load_params();
    unsigned char* img = smem;
    bf16_t* att = (bf16_t*)(smem + 2 * HG_BUF);
    bf16_t* STs = att + 64 * 72;
    const int tid = opaque_tid(), w = __builtin_amdgcn_readfirstlane(tid >> 6), lane = tid & 63, fr = lane & 15, fq = lane >> 4;
    const bf16_t* xtra = (l == 0) ? (const bf16_t*)p.out : p.vf;
    const int tt_ = w >> 1, sp = w & 1;
    for (int item = blockIdx.x; item < NB * 32; item += gridDim.x) {
        const int xc_ = item & 7, sl_ = item >> 3, vs = sl_ & 3, gi_ = (sl_ >> 2) * 8 + xc_, h = gi_ & 7, b = gi_ >> 3;
        __syncthreads();
        for (int e = tid; e < 32 * 136 / 2; e += 512) ((unsigned*)STs)[e] = 0u;
        f32x4 S[2] = {{0.f, 0.f, 0.f, 0.f}, {0.f, 0.f, 0.f, 0.f}};
        u32x2 o0 = {0u, 0u};
        HgSet R0, R1;
        hg_issue(R0, p.H, xtra, p.rkbuf, b, 0, h, vs, tid); hg_stage(R0, img, tid);
        hg_issue(R1, p.H, xtra, p.rkbuf, b, 1, h, vs, tid); hg_issue(R0, p.H, xtra, p.rkbuf, b, 2, h, vs, tid);
        __syncthreads();
        auto iter = [&](const int ch, HgSet& RS) {
            const size_t r0 = (size_t)b * SEQ + (size_t)ch * 64;
            const unsigned char* B = img + (ch & 1) * HG_BUF; unsigned char* Bn = img + ((ch + 1) & 1) * HG_BUF;
            bf16x8 qf[4];
#pragma unroll
            for (int ks = 0; ks < 4; ++ks) qf[ks] = *(const bf16x8*)(B + HG_QM + ((ks * 4 + fq) * 65 + tt_ * 16 + fr) * 16);
#pragma unroll
            for (int q = 0; q < 2; ++q) { const int stile = sp * 2 + q; f32x4 a = {0.f, 0.f, 0.f, 0.f};
                if (stile <= tt_) {
#pragma unroll
                    for (int ks = 0; ks < 4; ++ks) { const bf16x8 kf = *(const bf16x8*)(B + HG_KM + ((ks * 4 + fq) * 65 + stile * 16 + fr) * 16); a = __builtin_amdgcn_mfma_f32_16x16x32_bf16(qf[ks], kf, a, 0, 0, 0); } }
#pragma unroll
                for (int j = 0; j < 4; ++j) { const int t = tt_ * 16 + fq * 4 + j, s = stile * 16 + fr; att[t * 72 + s] = f2bf(s <= t ? a[j] : 0.f); } }
            if (ch + 1 < 64) hg_stage(RS, Bn, tid);
            if (ch + 3 < 64) hg_issue(RS, p.H, xtra, p.rkbuf, b, ch + 3, h, vs, tid);
            __syncthreads();
            f32x4 o = {0.f, 0.f, 0.f, 0.f};
#pragma unroll
            for (int ks = 0; ks < 2; ++ks) { const bf16x8 af = *(const bf16x8*)(att + (tt_ * 16 + fr) * 72 + ks * 32 + fq * 8); const bf16x8 itf = *(const bf16x8*)(B + HG_IT + ((ks * 4 + fq) * 33 + sp * 16 + fr) * 16);
                o = __builtin_amdgcn_mfma_f32_16x16x32_bf16(itf, af, o, 0, 0, 0); }
#pragma unroll
            for (int ks = 0; ks < 4; ++ks) { const bf16x8 sf = *(const bf16x8*)(STs + (sp * 16 + fr) * 136 + ks * 32 + fq * 8);
                o = __builtin_amdgcn_mfma_f32_16x16x32_bf16(sf, qf[ks], o, 0, 0, 0); }
            { u32x2 ow; ow.x = cvt_pk_bf16(o[0], o[1]); ow.y = cvt_pk_bf16(o[2], o[3]);
              if (ch == 0) o0 = ow;
              else if (!dry) { const int t = tt_ * 16 + fr; *(u32x2*)(p.H + (r0 - 64 + vs * 16 + (t >> 2)) * LDC_H + 2048 + h * 128 + (t & 3) * 32 + sp * 16 + fq * 4) = ow; } }
            const f32x4 e1 = *(const f32x4*)(B + HG_E + (w * 16 + fq * 4) * 4), e3 = *(const f32x4*)(B + HG_E + 512 + (w * 16 + fq * 4) * 4);
            bf16x8 ktf[2];
#pragma unroll
            for (int ks = 0; ks < 2; ++ks) ktf[ks] = *(const bf16x8*)(B + HG_KT + ((ks * 4 + fq) * 129 + w * 16 + fr) * 16);
#pragma unroll
            for (int vt = 0; vt < 2; ++vt) { f32x4 u = {0.f, 0.f, 0.f, 0.f};
#pragma unroll
                for (int ks = 0; ks < 2; ++ks) { const bf16x8 itf = *(const bf16x8*)(B + HG_IT + ((ks * 4 + fq) * 33 + vt * 16 + fr) * 16); u = __builtin_amdgcn_mfma_f32_16x16x32_bf16(ktf[ks], itf, u, 0, 0, 0); }
#pragma unroll
                for (int j = 0; j < 4; ++j) S[vt][j] = e3[j] * (e1[j] * S[vt][j] + u[j]); }
            __syncthreads();
            if (ch + 1 < 64) { const f32x4 e1n = *(const f32x4*)(Bn + HG_E + (w * 16 + fq * 4) * 4);
#pragma unroll
                for (int vt = 0; vt < 2; ++vt) { u32x2 sw; sw.x = cvt_pk_bf16(S[vt][0] * e1n[0], S[vt][1] * e1n[1]); sw.y = cvt_pk_bf16(S[vt][2] * e1n[2], S[vt][3] * e1n[3]);
                    *(u32x2*)(STs + (vt * 16 + fr) * 136 + w * 16 + fq * 4) = sw; } }
        };
        for (int ch = 0; ch < 64; ch += 2) { iter(ch, R1); iter(ch + 1, R0); }
        if (!dry) { const int t = tt_ * 16 + fr; *(u32x2*)(p.H + ((size_t)b * SEQ + 63 * 64 + vs * 16 + (t >> 2)) * LDC_H + 2048 + h * 128 + (t & 3) * 32 + sp * 16 + fq * 4) = o0; }
    }
    __syncthreads();
}

__device__ void phase_hgrn_post(int l) {
    const Params p = load_params();
    const int tid = opaque_tid(), l8 = tid & 7;
    const int ngrp = T_TOK * 8;
    for (int g = blockIdx.x * 64 + (tid >> 3); g < ngrp; g += gridDim.x * 64) {
        const int tok = g >> 3, h = g & 7, b = tok / SEQ, tin = tok % SEQ, ch = tin >> 6, t = tin & 63, slot = (ch + 63) & 63, vs = l8 >> 1, vv0 = (l8 & 1) * 16;
        const bf16_t* op = p.H + ((size_t)b * SEQ + slot * 64 + vs * 16 + (t >> 2)) * LDC_H + 2048 + h * 128 + (t & 3) * 32 + vv0;
        bf16_t* zp = p.H + (size_t)tok * LDC_H + 3072 + h * 128 + l8 * 16;
        const u32x4 a0 = *(const u32x4*)op, a1 = *(const u32x4*)(op + 8), z0 = *(const u32x4*)zp, z1 = *(const u32x4*)(zp + 8);
        const float ov[16] = {bflo(a0.x), bfhi(a0.x), bflo(a0.y), bfhi(a0.y), bflo(a0.z), bfhi(a0.z), bflo(a0.w), bfhi(a0.w), bflo(a1.x), bfhi(a1.x), bflo(a1.y), bfhi(a1.y), bflo(a1.z), bfhi(a1.z), bflo(a1.w), bfhi(a1.w)};
        const float zf[16] = {bflo(z0.x), bfhi(z0.x), bflo(z0.y), bfhi(z0.y), bflo(z0.z), bfhi(z0.z), bflo(z0.w), bfhi(z0.w), bflo(z1.x), bfhi(z1.x), bflo(z1.y), bfhi(z1.y), bflo(z1.z), bfhi(z1.z), bflo(z1.w), bfhi(z1.w)};
        float ss = 0.f;
#pragma unroll
        for (int e = 0; e < 16; ++e) ss += ov[e] * ov[e];
        ss = red8(ss); const float rinv = rsqrtf(ss * (1.0f / 128.f) + EPS);
        const float* gn = p.hgrn_g + (size_t)l * DM + h * 128 + l8 * 16;
        float r[16];
#pragma unroll
        for (int e = 0; e < 16; ++e) r[e] = ov[e] * rinv * gn[e] * siluf_(zf[e]);
        u32x4 w0, w1; w0.x = cvt_pk_bf16(r[0], r[1]); w0.y = cvt_pk_bf16(r[2], r[3]); w0.z = cvt_pk_bf16(r[4], r[5]); w0.w = cvt_pk_bf16(r[6], r[7]);
        w1.x = cvt_pk_bf16(r[8], r[9]); w1.y = cvt_pk_bf16(r[10], r[11]); w1.z = cvt_pk_bf16(r[12], r[13]); w1.w = cvt_pk_bf16(r[14], r[15]);
        *(u32x4*)zp = w0; *(u32x4*)(zp + 8) = w1;
    }
}


#define XB_TMO      128
#define XB_XCNT(j)  (256  + 64 * (j))
#define XB_XSUB(j)  (1280 + 64 * (j))
#define XB_XGEN(j)  (2304 + 64 * (j))
#define XB_TOP      3328
#define XB_TOPGEN   3392
#define XCD_BAR_WORDS 3456
#define XB_SPIN_CAP (1u << 18)
__device__ __forceinline__ unsigned xb_ld(unsigned* p)              { return __hip_atomic_load(p, __ATOMIC_RELAXED, __HIP_MEMORY_SCOPE_AGENT); }
__device__ __forceinline__ unsigned xb_add(unsigned* p, unsigned v) { return __hip_atomic_fetch_add(p, v, __ATOMIC_RELAXED, __HIP_MEMORY_SCOPE_AGENT); }
__device__ __forceinline__ unsigned xb_xcc_id() { return (unsigned)__builtin_amdgcn_s_getreg((3 << 11) | 20) & 0xFu; }
#define XB_SPIN(cond, bar) do { unsigned _sp = 0; while (cond) { __builtin_amdgcn_s_sleep(1); \
    if ((++_sp & 255u) == 0u) { if (xb_ld(&(bar)[XB_TMO])) break; if (_sp > XB_SPIN_CAP) { atomicAdd(&(bar)[XB_TMO], 1u); break; } } } } while (0)
struct XcdBarrier { unsigned* bar; unsigned x; volatile LAS unsigned* st; };
__device__ __forceinline__ XcdBarrier xcd_barrier_post(unsigned* bar, volatile LAS unsigned* st) {
    XcdBarrier b; b.bar = bar; b.x = xb_xcc_id(); b.st = st;
    if (threadIdx.x == 0) (void)xb_add(&bar[XB_XCNT(b.x)], 1u);
    return b;
}
__device__ __forceinline__ void xcd_barrier_complete(unsigned* bar, unsigned x, unsigned& nloc, unsigned& nx) {
    const unsigned G = gridDim.x * gridDim.y * gridDim.z;
    unsigned sum, cnt, mine, sp = 0u;
    for (;;) {
        sum = 0u; cnt = 0u; mine = 0u;
#pragma unroll
        for (unsigned j = 0; j < 16; ++j) { const unsigned c = xb_ld(&bar[XB_XCNT(j)]); sum += c; cnt += (c > 0u) ? 1u : 0u; mine = (j == x) ? c : mine; }
        if (sum == G) break;
        __builtin_amdgcn_s_sleep(1);
        if ((++sp & 255u) == 0u) { if (xb_ld(&bar[XB_TMO])) break; if (sp > XB_SPIN_CAP) { atomicAdd(&bar[XB_TMO], 1u); break; } }
    }
    nloc = mine > 0u ? mine : 1u; nx = cnt > 0u ? cnt : 1u;
}
__device__ __forceinline__ void xcd_barrier(const XcdBarrier& b) {
    asm volatile("s_waitcnt vmcnt(0)" ::: "memory");
    __syncthreads();
    if (threadIdx.x == 0) {
        unsigned* bar = b.bar;
        __builtin_amdgcn_s_waitcnt(0);
        unsigned nloc = b.st[0], nx = b.st[1];
        if (nloc == 0u) { xcd_barrier_complete(bar, b.x, nloc, nx); b.st[0] = nloc; b.st[1] = nx; }
        const unsigned old = xb_add(&bar[XB_XSUB(b.x)], 1u);
        const unsigned gen = old / nloc;
        if (old + 1u == (gen + 1u) * nloc) {
            __builtin_amdgcn_fence(__ATOMIC_RELEASE, "agent");
            asm volatile("s_waitcnt vmcnt(0)" ::: "memory");
            const unsigned og = xb_add(&bar[XB_TOP], 1u);
            const unsigned tg = og / nx;
            if (og + 1u == (tg + 1u) * nx) xb_add(&bar[XB_TOPGEN], 1u);
            else XB_SPIN(xb_ld(&bar[XB_TOPGEN]) == tg, bar);
            __builtin_amdgcn_fence(__ATOMIC_ACQUIRE, "agent");
            xb_add(&bar[XB_XGEN(b.x)], 1u);
            asm volatile("s_waitcnt vmcnt(0)" ::: "memory");
        } else {
            XB_SPIN(xb_ld(&bar[XB_XGEN(b.x)]) == gen, bar);
            __builtin_amdgcn_fence(__ATOMIC_ACQUIRE, "agent");
            asm volatile("s_waitcnt vmcnt(0)" ::: "memory");
        }
    }
    __syncthreads();
}

constexpr int PH_PER_LAYER = 14, N_PHASES = 2 * PH_PER_LAYER + 1;

__global__ void __launch_bounds__(512, 2) fwd_megakernel(Params pk) {
    extern __shared__ __attribute__((aligned(16))) unsigned char shm[];
    LAS unsigned char* lds = (LAS unsigned char*)shm;
    cg::grid_group grid = cg::this_grid();
    const int phase_lo = pk.phase_lo, phase_hi = pk.phase_hi;
    volatile LAS unsigned* xst = (volatile LAS unsigned*)(lds + LDS_BYTES - 16);
    XcdBarrier xb; xb.bar = pk.bar; xb.x = 0; xb.st = xst;
    if (phase_hi - phase_lo > 1) { if (threadIdx.x == 0) { xst[0] = 0u; xst[1] = 0u; } __syncthreads(); xb = xcd_barrier_post(pk.bar, xst); }
    for (int ph = phase_lo; ph < phase_hi; ++ph) {
        const int l = ph / PH_PER_LAYER, q = ph % PH_PER_LAYER;
        if (ph == N_PHASES - 1) {
            const Params p = load_params();
            phase_rmsnorm(p.out, p.final_g, nullptr, p.out);
        } else if (q == 0) {
            { const int nrep = (PROBE_Q == 0 && l == 0) ? 2 : 1; for (int rep = 0; rep < nrep; ++rep) {
            phase_convert(l, shm);
            const Params p = load_params();
            phase_rmsnorm(l == 0 ? p.x : p.out, p.norm_g + (size_t)l * DM, p.xn, nullptr); } }
        } else if (q == 1 || q == 5 || q == 8) {
            const Params p = load_params(); const int G = gridDim.x, cidx = opaque_bid();
            const int N = (q == 1) ? LDA_H : (q == 5) ? LDB_H : LDC_H; const int r0 = (q == 1) ? 0 : (q == 5) ? LDA_H : (LDA_H + LDB_H);
            pg8::GemmDesc g; g.A = p.xn; g.Bt = p.Wt + (size_t)r0 * DM; g.lda = DM;
            pg8::Sched S; S.init(T_TOK, N, G, cidx, 1);
            pg8::EpiStore E; E.O = p.H; E.ldc = N;
{ const int nrep = ((PROBE_Q == 1 && l == 0 && q == 1) || (PROBE_Q == 50 && l == 0 && q == 5) || (PROBE_Q == 80 && l == 0 && q == 8)) ? 2 : 1; for (int rep = 0; rep < nrep; ++rep) pg8::gemm_phase(lds, g, g, S, E); }
        } else if (q == 2) {
{ const int nrep = (PROBE_Q == 2 && l == 0) ? 2 : 1; for (int rep = 0; rep < nrep; ++rep) phase_rwkv(l, shm, rep + 1 < nrep ? PROBE_MODE : 0); }
        } else if (q == 3) {
            phase_rwkv_post(l, nullptr);
        } else if (q == 6) {
{ const int nrep = (PROBE_Q == 6 && l == 0) ? 2 : 1; for (int rep = 0; rep < nrep; ++rep) { const Params p = load_params(); phase_sgu(l, shm, rep + 1 < nrep ? (bf16_t*)p.out : nullptr); } }
        } else if (q == 9) {
            { const int nrep = (PROBE_Q == 9 && l == 0) ? 2 : 1; for (int rep = 0; rep < nrep; ++rep) phase_hgrn_pre(l, shm, rep + 1 < nrep); }
        } else if (q == 10) {
            { const int nrep = (PROBE_Q == 10 && l == 0) ? 2 : 1; for (int rep = 0; rep < nrep; ++rep) phase_hgrn_seq(l, shm, rep + 1 < nrep); }
        } else if (q == 11) {
            phase_hgrn_post(l);
        } else if (q == 4 || q == 7 || q == 12) {
            const Params p = load_params(); const int G = gridDim.x, cidx = opaque_bid();
            bf16_t* WtBr = p.Wt + (size_t)WT_ROWS * DM;
            const int n = (q == 4) ? 0 : (q == 7) ? 1 : 2; const int ldh = (n == 0) ? LDA_H : (n == 1) ? LDB_H : LDC_H; const int ocol = (n == 0) ? 3200 : (n == 1) ? 2048 : 3072;
            pg8::GemmDesc g0, g1; g0.A = p.xn; g0.Bt = p.Wt + (size_t)(LDA_H + LDB_H + LDC_H + n * DM) * DM; g0.lda = DM;
            g1.A = p.H + ocol; g1.Bt = WtBr + (size_t)n * DM * DM; g1.lda = ldh;
            pg8::Sched S; S.init(T_TOK, DM, G, cidx, 2);
            pg8::EpiMerge E; E.G = p.H; E.ldg = ldh; E.bias = p.b_merge + ((size_t)l * 3 + n) * DM; E.Y = p.y; E.accum = (n > 0);
            { const int nrep = (PROBE_Q == 4 && l == 0 && q == 4) ? 2 : 1; for (int rep = 0; rep < nrep; ++rep) pg8::gemm_phase(lds, g0, g1, S, E); }
        } else {
            const Params p = load_params(); const int G = gridDim.x, cidx = opaque_bid();
            bf16_t* WtOut = p.Wt + (size_t)WT_ROWS * DM + (size_t)3 * DM * DM;
            pg8::GemmDesc g; g.A = p.y; g.Bt = WtOut; g.lda = DM;
            pg8::Sched S; S.init(T_TOK, DM, G, cidx, 1);
            pg8::EpiResid E; E.Xin = (l == 0) ? p.x : p.out; E.Xout = p.out;
            { const int nrep = (PROBE_Q == 13 && l == 0) ? 2 : 1; for (int rep = 0; rep < nrep; ++rep) pg8::gemm_phase(lds, g, g, S, E); }
        }
        if (ph + 1 < phase_hi) { if (ph == phase_lo) grid.sync(); else xcd_barrier(xb); }
    }
}

extern "C" void kernel_launch(void* const* d_in, const int* in_sizes, int n_in, void* d_out, int out_size, void* d_ws, size_t ws_size, hipStream_t stream) {
    static int grid_blocks = 0;
    if (!grid_blocks) {
        int dev = 0, cus = 0, per_cu = 0;
        hipGetDevice(&dev);
        hipDeviceGetAttribute(&cus, hipDeviceAttributeMultiprocessorCount, dev);
        if (hipFuncSetAttribute((const void*)fwd_megakernel, hipFuncAttributeMaxDynamicSharedMemorySize, LDS_BYTES) != hipSuccess) { fprintf(stderr, "hipFuncSetAttribute failed\n"); return; }
        hipOccupancyMaxActiveBlocksPerMultiprocessor(&per_cu, (const void*)fwd_megakernel, 512, LDS_BYTES);
        if (per_cu < 1) { fprintf(stderr, "occupancy query says 0 blocks per CU\n"); return; }
        grid_blocks = cus * 1;
    }
    Params p{};
    const float** fp = (const float**)&p;
    for (int i = 0; i < 26; ++i) fp[i] = (const float*)d_in[i];
    p.out = (float*)d_out;
    unsigned char* ws = (unsigned char*)d_ws; size_t off = 0;
    auto take = [&](size_t bytes) { unsigned char* r = ws + off; off += (bytes + 255) & ~(size_t)255; return r; };
    p.Wt = (bf16_t*)take(((size_t)WT_ROWS * DM + 4 * (size_t)DM * DM) * 2);
    p.xn = (bf16_t*)take((size_t)T_TOK * DM * 2);
    p.vf = (bf16_t*)take((size_t)T_TOK * DM * 2);
    p.y = (bf16_t*)take((size_t)T_TOK * DM * 2);
    p.H = (bf16_t*)take((size_t)T_TOK * LDA_H * 2);
    p.rkbuf = (float*)take((size_t)T_TOK * 16 * 2 * 4);
    p.bar = (unsigned*)take((size_t)XCD_BAR_WORDS * 4);
    if (off > ws_size) { fprintf(stderr, "workspace too small: need %zu have %zu\n", off, ws_size); return; }
#if SINGLE_LAUNCH
    p.phase_lo = 0; p.phase_hi = N_PHASES;
    void* args[] = {&p};
    if (hipMemsetAsync(p.bar, 0, (size_t)XCD_BAR_WORDS * 4, stream) != hipSuccess) { fprintf(stderr, "memset failed\n"); return; }
    hipError_t e = hipLaunchCooperativeKernel((const void*)fwd_megakernel, dim3(grid_blocks), dim3(512), args, LDS_BYTES, stream);
    if (e != hipSuccess) fprintf(stderr, "cooperative launch failed: %s (grid %d)\n", hipGetErrorString(e), grid_blocks);
#else
    for (int ph = 0; ph < N_PHASES; ++ph) {
        p.phase_lo = ph; p.phase_hi = ph + 1;
        hipLaunchKernelGGL(fwd_megakernel, dim3(grid_blocks), dim3(512), LDS_BYTES, stream, p);
    }
#endif
}
```
